# Optimizing an MI355X kernel written in HIP

```python
import math
import jax, jax.numpy as jnp
from jax import lax
import numpy as np

D_MODEL = 1024
BATCH = 2
SEQ = 16384
DEPTH = 4

HEAD_DIM = 64
BLK = 128
GRID_W = 64
WIN_HEADS = 4
WIN_KV_HEADS = 2
WINDOW = 128
MLA_HEADS = 4
MLA_Q_RANK = 256
MLA_KV_RANK = 128
MLA_NOPE = 64
MLA_ROPE = 32
MLA_V = 64
AX_HEADS = 4
AX_KV_HEADS = 2
DIFF_HEADS = 4
DIFF_QK = 32
DIFF_V = 64
A_COLS = (WIN_HEADS + 2 * WIN_KV_HEADS) * HEAD_DIM
B_COLS = MLA_Q_RANK + MLA_KV_RANK + MLA_ROPE
C_COLS = (AX_HEADS + 2 * AX_KV_HEADS) * HEAD_DIM
D_COLS = DIFF_HEADS * (4 * DIFF_QK + DIFF_V)
N_IN = A_COLS + B_COLS + C_COLS + D_COLS
D_MIX = WIN_HEADS * HEAD_DIM + MLA_HEADS * MLA_V + AX_HEADS * HEAD_DIM + DIFF_HEADS * DIFF_V
D_FF = 2816
ROPE_BASE = 10000.0
NORM_EPS = 1e-5
NEG_INF = -1e30

kernel_name = "hybrid_parallel_heads_deepnorm_encoder"


def _layer_norm(x, g, b):
    xf = x.astype(jnp.float32)
    mu = jnp.mean(xf, -1, keepdims=True)
    xc = xf - mu
    var = jnp.mean(xc * xc, -1, keepdims=True)
    y = xc * lax.rsqrt(var + NORM_EPS) * g.astype(jnp.float32) + b.astype(jnp.float32)
    return y.astype(x.dtype)


def _rms_norm(x, g):
    xf = x.astype(jnp.float32)
    y = xf * lax.rsqrt(jnp.mean(xf * xf, -1, keepdims=True) + NORM_EPS)
    return (y * g.astype(jnp.float32)).astype(x.dtype)


def _swiglu(h, w_gu, w_down):
    gate, up = jnp.split(h @ w_gu, 2, axis=-1)
    return (jax.nn.silu(gate) * up) @ w_down


def _alibi_slopes(n):
    return 2.0 ** (-8.0 * (jnp.arange(n, dtype=jnp.float32) + 1.0) / n)


def _rope_angles(pos, dim):
    inv = ROPE_BASE ** (-jnp.arange(0, dim, 2, dtype=jnp.float32) / dim)
    ang = pos.astype(jnp.float32)[:, None] * inv[None, :]
    return jnp.cos(ang), jnp.sin(ang)


def _apply_rope(x, cos, sin):
    c = cos[:, None, :]
    s = sin[:, None, :]
    x1, x2 = jnp.split(x.astype(jnp.float32), 2, axis=-1)
    return jnp.concatenate([x1 * c - x2 * s, x1 * s + x2 * c], -1).astype(x.dtype)


def _dense_attention(q, k, v, scale):
    B, S, Hq, Dk = q.shape
    Hkv = k.shape[2]
    G = Hq // Hkv
    nb = S // BLK
    qb = q.reshape(B, nb, BLK, Hkv, G, Dk).transpose(1, 0, 2, 3, 4, 5)

    def block(qi):
        s = jnp.einsum('bqhgd,bkhd->bhgqk', qi, k).astype(jnp.float32) * scale
        p = jax.nn.softmax(s, axis=-1)
        return jnp.einsum('bhgqk,bkhd->bqhgd', p.astype(v.dtype), v)

    o = lax.map(block, qb)
    return o.transpose(1, 0, 2, 3, 4, 5).reshape(B, S, Hq * v.shape[-1])


def _mixer_window(a, sink, slopes):
    B, S, _ = a.shape
    nb = S // BLK
    G = WIN_HEADS // WIN_KV_HEADS
    q, k, v = jnp.split(a, [WIN_HEADS * HEAD_DIM, (WIN_HEADS + WIN_KV_HEADS) * HEAD_DIM], axis=-1)
    qb = q.reshape(B, nb, BLK, WIN_KV_HEADS, G, HEAD_DIM)

    def band(t):
        tp = jnp.pad(t.reshape(B, S, WIN_KV_HEADS, HEAD_DIM), ((0, 0), (BLK, BLK), (0, 0), (0, 0)))
        tp = tp.reshape(B, nb + 2, BLK, WIN_KV_HEADS, HEAD_DIM)
        return jnp.concatenate([tp[:, :-2], tp[:, 1:-1], tp[:, 2:]], axis=2)

    kw = band(k)
    vw = band(v)
    s = jnp.einsum('bnqhgd,bnkhd->bnhgqk', qb, kw).astype(jnp.float32) * (HEAD_DIM ** -0.5)
    dist = jnp.abs(jnp.arange(BLK)[:, None] - jnp.arange(3 * BLK)[None, :] + BLK)
    kpos = jnp.arange(nb)[:, None] * BLK - BLK + jnp.arange(3 * BLK)[None, :]
    allowed = (dist <= WINDOW)[None] & ((kpos >= 0) & (kpos < S))[:, None, :]
    bias = -slopes.reshape(WIN_KV_HEADS, G, 1, 1) * dist.astype(jnp.float32)
    s = jnp.where(allowed[None, :, None, None], s + bias, NEG_INF)
    sink_logit = jnp.broadcast_to(sink.astype(jnp.float32).reshape(1, 1, WIN_KV_HEADS, G, 1, 1),
                                  s.shape[:-1] + (1,))
    p = jax.nn.softmax(jnp.concatenate([s, sink_logit], axis=-1), axis=-1)[..., :-1]
    o = jnp.einsum('bnhgqk,bnkhd->bnqhgd', p.astype(vw.dtype), vw)
    return o.reshape(B, S, WIN_HEADS * HEAD_DIM)


def _mixer_mla(b, q_norm_g, w_uq, kv_norm_g, w_ukv, pos):
    B, S, _ = b.shape
    c_q, c_kv, k_rope = jnp.split(b, [MLA_Q_RANK, MLA_Q_RANK + MLA_KV_RANK], axis=-1)
    q = (_rms_norm(c_q, q_norm_g) @ w_uq).reshape(B, S, MLA_HEADS, MLA_NOPE + MLA_ROPE)
    kv = (_rms_norm(c_kv, kv_norm_g) @ w_ukv).reshape(B, S, MLA_HEADS, MLA_NOPE + MLA_V)
    cos, sin = _rope_angles(pos, MLA_ROPE)
    q = jnp.concatenate([q[..., :MLA_NOPE], _apply_rope(q[..., MLA_NOPE:], cos, sin)], axis=-1)
    k_r = _apply_rope(k_rope[:, :, None, :], cos, sin)
    k = jnp.concatenate([kv[..., :MLA_NOPE], jnp.broadcast_to(k_r, (B, S, MLA_HEADS, MLA_ROPE))], axis=-1)
    v = kv[..., MLA_NOPE:]
    return _dense_attention(q, k, v, (MLA_NOPE + MLA_ROPE) ** -0.5)


def _mixer_axial(c, q_g, k_g):
    B, S, _ = c.shape
    q, k, v = jnp.split(c, [AX_HEADS * HEAD_DIM, (AX_HEADS + AX_KV_HEADS) * HEAD_DIM], axis=-1)
    q = _rms_norm(q.reshape(B, S, AX_HEADS, HEAD_DIM), q_g)
    k = _rms_norm(k.reshape(B, S, AX_KV_HEADS, HEAD_DIM), k_g)
    v = v.reshape(B, S, AX_KV_HEADS, HEAD_DIM)
    rows = S // GRID_W
    row = jnp.repeat(jnp.arange(rows, dtype=jnp.int32), GRID_W)
    col = jnp.tile(jnp.arange(GRID_W, dtype=jnp.int32), rows)
    half = HEAD_DIM // 2
    cr, sr = _rope_angles(row, half)
    cc, sc = _rope_angles(col, half)

    def axial(t):
        return jnp.concatenate([_apply_rope(t[..., :half], cr, sr), _apply_rope(t[..., half:], cc, sc)], axis=-1)

    return _dense_attention(axial(q), axial(k), v, HEAD_DIM ** -0.5)


def _mixer_diff(d, lam_params, subln_g, slopes, layer_idx):
    B, S, _ = d.shape
    H = DIFF_HEADS
    q, k, v = jnp.split(d, [H * 2 * DIFF_QK, H * 4 * DIFF_QK], axis=-1)
    q = q.reshape(B, S, H, 2, DIFF_QK)
    k = k.reshape(B, S, H, 2, DIFF_QK)
    v = v.reshape(B, S, H, DIFF_V)
    lam_init = 0.8 - 0.6 * math.exp(-0.3 * layer_idx)
    lp = lam_params.astype(jnp.float32)
    lam = jnp.exp(jnp.sum(lp[0] * lp[1])) - jnp.exp(jnp.sum(lp[2] * lp[3])) + lam_init
    nb = S // BLK
    qb = q.reshape(B, nb, BLK, H, 2, DIFF_QK).transpose(1, 0, 2, 3, 4, 5)
    kpos = jnp.arange(S)
    scale = DIFF_QK ** -0.5

    def block(args):
        qi, i = args
        tq = i * BLK + jnp.arange(BLK)
        dist = jnp.abs(tq[:, None] - kpos[None, :]).astype(jnp.float32)
        bias = -slopes[:, None, None] * dist
        s = jnp.einsum('bqhmd,bkhmd->bhmqk', qi, k).astype(jnp.float32) * scale + bias[None, :, None]
        p = jax.nn.softmax(s, axis=-1)
        w = p[:, :, 0] - lam * p[:, :, 1]
        return jnp.einsum('bhqk,bkhd->bqhd', w.astype(v.dtype), v)

    o = lax.map(block, (qb, jnp.arange(nb)))
    o = o.transpose(1, 0, 2, 3, 4).reshape(B, S, H, DIFF_V)
    o = _rms_norm(o, subln_g) * (1.0 - lam_init)
    return o.reshape(B, S, H * DIFF_V)


def _token_mixers(h, w_in, sink, mla_q_norm, mla_w_uq, mla_kv_norm, mla_w_ukv,
                  ax_q_norm, ax_k_norm, diff_lambda, diff_subln, w_out, layer_idx):
    S = h.shape[1]
    proj = h @ w_in
    a, b, c, d = jnp.split(proj, [A_COLS, A_COLS + B_COLS, A_COLS + B_COLS + C_COLS], axis=-1)
    pos = jnp.arange(S, dtype=jnp.int32)
    slopes = _alibi_slopes(WIN_HEADS + DIFF_HEADS)
    o_a = _mixer_window(a, sink, slopes[:WIN_HEADS])
    o_b = _mixer_mla(b, mla_q_norm, mla_w_uq, mla_kv_norm, mla_w_ukv, pos)
    o_c = _mixer_axial(c, ax_q_norm, ax_k_norm)
    o_d = _mixer_diff(d, diff_lambda, diff_subln, slopes[WIN_HEADS:], layer_idx)
    return jnp.concatenate([o_a, o_b, o_c, o_d], axis=-1) @ w_out


def setup_inputs(seed: int = 0) -> dict:
    key = jax.random.key(seed)
    ks = jax.random.split(key, 20)
    f32 = jnp.float32
    beta = (8 * DEPTH) ** -0.25

    def nrm(k, shape, scale):
        return jax.random.normal(k, shape, f32) * scale

    return {
        "x": nrm(ks[0], (BATCH, SEQ, D_MODEL), 1.0),
        "w_in": nrm(ks[1], (DEPTH, D_MODEL, N_IN), D_MODEL ** -0.5),
        "win_sink": nrm(ks[2], (DEPTH, WIN_HEADS), 0.5),
        "mla_q_norm": 1.0 + nrm(ks[3], (DEPTH, MLA_Q_RANK), 0.02),
        "mla_w_uq": nrm(ks[4], (DEPTH, MLA_Q_RANK, MLA_HEADS * (MLA_NOPE + MLA_ROPE)), MLA_Q_RANK ** -0.5),
        "mla_kv_norm": 1.0 + nrm(ks[5], (DEPTH, MLA_KV_RANK), 0.02),
        "mla_w_ukv": nrm(ks[6], (DEPTH, MLA_KV_RANK, MLA_HEADS * (MLA_NOPE + MLA_V)), MLA_KV_RANK ** -0.5),
        "ax_q_norm": 1.0 + nrm(ks[7], (DEPTH, HEAD_DIM), 0.02),
        "ax_k_norm": 1.0 + nrm(ks[8], (DEPTH, HEAD_DIM), 0.02),
        "diff_lambda": nrm(ks[9], (DEPTH, 4, DIFF_QK), 0.1),
        "diff_subln": 1.0 + nrm(ks[10], (DEPTH, DIFF_V), 0.02),
        "w_out": nrm(ks[11], (DEPTH, D_MIX, D_MODEL), beta * D_MIX ** -0.5),
        "ffn_w_gu": nrm(ks[12], (DEPTH, 2, D_MODEL, 2 * D_FF), D_MODEL ** -0.5),
        "ffn_w_down": nrm(ks[13], (DEPTH, 2, D_FF, D_MODEL), beta * D_FF ** -0.5),
        "ln_g": 1.0 + nrm(ks[14], (DEPTH, 3, D_MODEL), 0.02),
        "ln_b": nrm(ks[15], (DEPTH, 3, D_MODEL), 0.02),
    }


def reference(x, w_in, win_sink, mla_q_norm, mla_w_uq, mla_kv_norm, mla_w_ukv,
              ax_q_norm, ax_k_norm, diff_lambda, diff_subln, w_out,
              ffn_w_gu, ffn_w_down, ln_g, ln_b):
    alpha = (2 * DEPTH) ** 0.25
    for l in range(DEPTH):
        x = _layer_norm(alpha * x + 0.5 * _swiglu(x, ffn_w_gu[l, 0], ffn_w_down[l, 0]), ln_g[l, 0], ln_b[l, 0])
        mix = _token_mixers(x, w_in[l], win_sink[l], mla_q_norm[l], mla_w_uq[l], mla_kv_norm[l], mla_w_ukv[l],
                            ax_q_norm[l], ax_k_norm[l], diff_lambda[l], diff_subln[l], w_out[l], l)
        x = _layer_norm(alpha * x + mix, ln_g[l, 1], ln_b[l, 1])
        x = _layer_norm(alpha * x + 0.5 * _swiglu(x, ffn_w_gu[l, 1], ffn_w_down[l, 1]), ln_g[l, 2], ln_b[l, 2])
    return x
```

```cpp
#include <hip/hip_runtime.h>
#include <hip/hip_cooperative_groups.h>
#include <cstdio>
#include <cstdint>
#include <cmath>
namespace cg = cooperative_groups;
namespace pg8 {
#define PG8_LAS __attribute__((address_space(3)))
typedef unsigned short bf16_t;
typedef short bf16x8 __attribute__((ext_vector_type(8)));
typedef float f32x4 __attribute__((ext_vector_type(4)));
typedef unsigned u32x4 __attribute__((ext_vector_type(4)));
constexpr int BM = 256, BK = 64, HALF = 128, HTB = HALF * BK * 2  , STAGE_BYTES = 8 * HTB, NXCD = 8, WGM = 8;

__host__ __device__ __forceinline__ int lds_byte(int r, int c) { const int st = (r >> 4) * 2 + (c >> 5), rr = r & 15, cc = c & 31, ob = rr * 64 + cc * 2; return st * 1024 + (ob ^ (((ob >> 9) & 1) << 5)); }
__host__ __device__ __forceinline__ void stage_rc(int b, int& R, int& C) { const int st = b / 1024, sb = b % 1024, swz = sb ^ (((sb >> 9) & 1) << 5); R = (st >> 1) * 16 + swz / 64; C = (st & 1) * 32 + (swz % 64) / 2; }
__host__ __device__ __forceinline__ int perm32(int rho) { const int n = rho >> 4, i = rho & 15; return 8 * (i >> 2) + 4 * n + (i & 3); }

struct Unit { int pm, pn; };
struct Gemm { const bf16_t* A; const bf16_t* Bt; int M, N, K; };

struct StaticOrder {
    int nM, nN, nwg, G, c;
    __host__ __device__ void init(int M, int N, int G_, int c_) { nM = M / BM; nN = N / BM; nwg = nM * nN; G = G_; c = c_; }
    __host__ __device__ bool next(int i, Unit& u) const {
        const long L = (long)i * G + c; if (L >= nwg) return false;
        int wgid = (int)L; { const int q = nwg / NXCD, r = nwg % NXCD, xcd = wgid % NXCD, off = wgid / NXCD; wgid = (xcd < r ? xcd * (q + 1) : r * (q + 1) + (xcd - r) * q) + off; }
        const int nig = WGM * nN, gid = wgid / nig, fm = gid * WGM, gsz = (nM - fm) < WGM ? (nM - fm) : WGM;
        u.pm = fm + ((wgid % nig) % gsz); u.pn = (wgid % nig) / gsz; return true;
    }
    __device__ __forceinline__ void a_ready(const Unit&) const {}
    __device__ __forceinline__ void done(const Unit&) const {}
};

__device__ __forceinline__ unsigned cvt_pk_bf16(float lo, float hi) { unsigned r; asm volatile("v_cvt_pk_bf16_f32 %0, %1, %2" : "=v"(r) : "v"(lo), "v"(hi)); return r; }
typedef float f32x2 __attribute__((ext_vector_type(2)));
typedef float f32x2 __attribute__((ext_vector_type(2)));
typedef unsigned u32x2 __attribute__((ext_vector_type(2)));

struct EpiStoreBf16 {
    static constexpr bool PERM = true, AFTER_DRAIN = false;
    bf16_t* O; int ldc;
    __device__ __forceinline__ void operator()(const f32x4 (&acc)[2][2][4][2], const Unit& u, int wr, int wc, int fr, int fq) const {
        const int row0 = u.pm * BM + wr * 64 + fr; const int col0 = u.pn * BM + wc * 32 + 8 * fq;
#pragma unroll
        for (int ai = 0; ai < 2; ++ai)
#pragma unroll
            for (int m = 0; m < 4; ++m) { bf16_t* rowp = O + (size_t)(row0 + ai * HALF + m * 16) * ldc + col0;
#pragma unroll
                for (int bj = 0; bj < 2; ++bj) { const f32x4 v0 = acc[ai][bj][m][0], v1 = acc[ai][bj][m][1];
                    u32x4 w; w.x = cvt_pk_bf16(v0[0], v0[1]); w.y = cvt_pk_bf16(v0[2], v0[3]); w.z = cvt_pk_bf16(v1[0], v1[1]); w.w = cvt_pk_bf16(v1[2], v1[3]);
                    *(u32x4*)(rowp + bj * HALF) = w; } }
    }
};

__device__ __forceinline__ float silu_mul(float g, float u) {
    const float e = __builtin_amdgcn_exp2f(-1.4426950408889634f * g);
    return g * u * __builtin_amdgcn_rcpf(1.0f + e);
}
struct EpiSwiGLU {
    static constexpr bool PERM = true, AFTER_DRAIN = false;
    bf16_t* H; int ldh;
    __device__ __forceinline__ void operator()(const f32x4 (&acc)[2][2][4][2], const Unit& u, int wr, int wc, int fr, int fq) const {
        const int row0 = u.pm * BM + wr * 64 + fr; const int col0 = u.pn * HALF + wc * 32 + 8 * fq;
#pragma unroll
        for (int ai = 0; ai < 2; ++ai)
#pragma unroll
            for (int m = 0; m < 4; ++m) { bf16_t* rowp = H + (size_t)(row0 + ai * HALF + m * 16) * ldh + col0;
                const f32x4 g0 = acc[ai][0][m][0], g1 = acc[ai][0][m][1], u0 = acc[ai][1][m][0], u1 = acc[ai][1][m][1];
                u32x4 w;
                w.x = cvt_pk_bf16(silu_mul(g0[0], u0[0]), silu_mul(g0[1], u0[1])); w.y = cvt_pk_bf16(silu_mul(g0[2], u0[2]), silu_mul(g0[3], u0[3]));
                w.z = cvt_pk_bf16(silu_mul(g1[0], u1[0]), silu_mul(g1[1], u1[1])); w.w = cvt_pk_bf16(silu_mul(g1[2], u1[2]), silu_mul(g1[3], u1[3]));
                *(u32x4*)rowp = w; }
    }
};

struct EpiResid {
    static constexpr bool PERM = false, AFTER_DRAIN = false;
    const float* src; float* dst; int ld; float alpha, beta;
    __device__ __forceinline__ void operator()(const f32x4 (&acc)[2][2][4][2], const Unit& u, int wr, int wc, int fr, int fq) const {
        const int col0 = u.pn * BM + wc * 32 + 4 * fq;
#pragma unroll
        for (int ai = 0; ai < 2; ++ai)
#pragma unroll
            for (int m = 0; m < 4; ++m) { const size_t off = (size_t)(u.pm * BM + ai * HALF + wr * 64 + m * 16 + fr) * ld + col0;
#pragma unroll
                for (int bj = 0; bj < 2; ++bj)
#pragma unroll
                    for (int n = 0; n < 2; ++n) { const f32x4 s = *(const f32x4*)(src + off + bj * HALF + n * 16);
                        *(f32x4*)(dst + off + bj * HALF + n * 16) = s * alpha + acc[ai][bj][m][n] * beta; } }
    }
};
template <class Epi, class Sched, bool ALIGN_EPI = false, bool SP2 = false>
__device__ __forceinline__ void gemm_phase(PG8_LAS unsigned char* lds, const Gemm g, const Sched& S, const Epi& E) {
    int tid_ = threadIdx.x; asm volatile("" : "+v"(tid_));
    const int tid = tid_, wid = __builtin_amdgcn_readfirstlane(tid >> 6), lane = tid & 63, wr = wid >> 2, wc = wid & 3, fr = lane & 15, fq = lane >> 4;
    const int K = g.K, nt = K / BK;
    unsigned voffA[2], voffB[2];
#pragma unroll
    for (int i = 0; i < 2; ++i) { int R, C; stage_rc(tid * 16 + i * 8192, R, C); const int Rb = Epi::PERM ? ((R & ~31) + perm32(R & 31)) : R;
        voffA[i] = (unsigned)(R * K + C) * 2u; voffB[i] = (unsigned)(Rb * K + C) * 2u; }
    const size_t kstep = (size_t)(BK * 2);
    const size_t hstep = (size_t)HALF * K * 2;
    const size_t tstep = 2 * hstep;
    const unsigned ldsw = (unsigned)wid * 1024u;
    const int aoff = lds_byte(wr * 64 + fr, fq * 8), boff = lds_byte(wc * 32 + fr, fq * 8);
#define PG8_SA(b, h) (((b) * 2 + (h)) * HTB)
#define PG8_SB(b, h) ((4 + (b) * 2 + (h)) * HTB)
#define PG8_STAGE(bufoff, gbase, voff) do { _Pragma("unroll") for (int _i = 0; _i < 2; ++_i) \
        __builtin_amdgcn_global_load_lds((const unsigned*)((const char*)(gbase) + (voff)[_i]), (PG8_LAS unsigned*)(lds + (bufoff) + ldsw + _i * 8192), 16, 0, 0); } while (0)
#define PG8_LDA(dst, b, h) do { _Pragma("unroll") for (int m = 0; m < 4; ++m) _Pragma("unroll") for (int k = 0; k < 2; ++k) dst[m][k] = *(const PG8_LAS bf16x8*)(lds + PG8_SA(b, h) + aoff + m * 2048 + k * 1024); } while (0)
#define PG8_LDB(dst, b, h) do { _Pragma("unroll") for (int n = 0; n < 2; ++n) _Pragma("unroll") for (int k = 0; k < 2; ++k) dst[n][k] = *(const PG8_LAS bf16x8*)(lds + PG8_SB(b, h) + boff + n * 2048 + k * 1024); } while (0)
#define PG8_MMA(ai, bj, At, Bt) do { __builtin_amdgcn_s_setprio(1); _Pragma("unroll") for (int m = 0; m < 4; ++m) _Pragma("unroll") for (int n = 0; n < 2; ++n) _Pragma("unroll") for (int k = 0; k < 2; ++k) \
        acc[ai][bj][m][n] = __builtin_amdgcn_mfma_f32_16x16x32_bf16(Bt[n][k], At[m][k], acc[ai][bj][m][n], 0, 0, 0); __builtin_amdgcn_s_setprio(0); } while (0)
#define PG8_WAIT_V(n) asm volatile("s_waitcnt vmcnt(" #n ")" ::: "memory")
#define PG8_WAIT_L(n) asm volatile("s_waitcnt lgkmcnt(" #n ")" ::: "memory")
#define PG8_BAR __builtin_amdgcn_s_barrier()
#define PG8_SCHED __builtin_amdgcn_sched_barrier(0)
    Unit cur, nxt; int ui = 0;
    if (!S.next(0, cur)) return;
    f32x4 acc[2][2][4][2];
#pragma unroll
    for (int a = 0; a < 2; ++a)
#pragma unroll
        for (int b = 0; b < 2; ++b)
#pragma unroll
            for (int m = 0; m < 4; ++m)
#pragma unroll
                for (int n = 0; n < 2; ++n) acc[a][b][m][n] = (f32x4){0.f, 0.f, 0.f, 0.f};
    bf16x8 At[4][2], B0[2][2], B1[2][2];
    const char* cA = (const char*)g.A + (size_t)cur.pm * tstep; const char* cB = (const char*)g.Bt + (size_t)cur.pn * tstep;
    S.a_ready(cur);
    if constexpr (SP2) {
        PG8_STAGE(PG8_SB(0, 0), cB, voffB); PG8_STAGE(PG8_SB(0, 1), cB + hstep, voffB); PG8_STAGE(PG8_SA(0, 0), cA, voffA); PG8_STAGE(PG8_SA(0, 1), cA + hstep, voffA);
        if (wr == 1) PG8_BAR;
        PG8_WAIT_V(2); PG8_BAR;
        PG8_STAGE(PG8_SB(1, 0), cB + kstep, voffB); PG8_STAGE(PG8_SA(1, 0), cA + kstep, voffA); PG8_STAGE(PG8_SB(1, 1), cB + hstep + kstep, voffB);
        PG8_WAIT_V(6); PG8_BAR;
    } else {
        PG8_STAGE(PG8_SB(0, 0), cB, voffB); PG8_STAGE(PG8_SA(0, 0), cA, voffA); PG8_STAGE(PG8_SB(0, 1), cB + hstep, voffB); PG8_STAGE(PG8_SA(0, 1), cA + hstep, voffA);
        if (wr == 1) PG8_BAR;
        PG8_WAIT_V(4); PG8_BAR;
        PG8_STAGE(PG8_SB(1, 0), cB + kstep, voffB); PG8_STAGE(PG8_SA(1, 0), cA + kstep, voffA); PG8_STAGE(PG8_SB(1, 1), cB + hstep + kstep, voffB);
        PG8_WAIT_V(6); PG8_BAR;
    }
    for (;;) {
        const bool has_next = S.next(ui + 1, nxt);
        const char* nA = has_next ? (const char*)g.A + (size_t)nxt.pm * tstep : cA; const char* nB = has_next ? (const char*)g.Bt + (size_t)nxt.pn * tstep : cB;
        for (int t = 0; t < nt; t += 2) {
            const bool last = (t == nt - 2);
            const char* a1 = cA + (size_t)(t + 1) * kstep;
            const char* a2 = last ? nA : cA + (size_t)(t + 2) * kstep; const char* b2 = last ? nB : cB + (size_t)(t + 2) * kstep;
            const char* a3 = a2 + kstep; const char* b3 = b2 + kstep;
            if (last && has_next) S.a_ready(nxt);
            if constexpr (SP2) {
            PG8_LDB(B0, 0, 0); PG8_LDB(B1, 0, 1); PG8_SCHED; PG8_LDA(At, 0, 0); PG8_STAGE(PG8_SA(1, 1), a1 + hstep, voffA);
            PG8_WAIT_V(8); PG8_WAIT_L(0); PG8_BAR; PG8_MMA(0, 0, At, B0); PG8_MMA(0, 1, At, B1); PG8_BAR; PG8_SCHED;
            PG8_LDA(At, 0, 1); PG8_STAGE(PG8_SB(0, 0), b2, voffB); PG8_STAGE(PG8_SB(0, 1), b2 + hstep, voffB); PG8_STAGE(PG8_SA(0, 0), a2, voffA);
            PG8_WAIT_V(8); PG8_WAIT_L(0); PG8_BAR; PG8_MMA(1, 0, At, B0); PG8_MMA(1, 1, At, B1); PG8_BAR; PG8_SCHED;
            PG8_LDB(B0, 1, 0); PG8_LDB(B1, 1, 1); PG8_SCHED; PG8_LDA(At, 1, 0); PG8_STAGE(PG8_SA(0, 1), a2 + hstep, voffA);
            PG8_WAIT_V(8); PG8_WAIT_L(0); PG8_BAR; PG8_MMA(0, 0, At, B0); PG8_MMA(0, 1, At, B1); PG8_BAR; PG8_SCHED;
            PG8_LDA(At, 1, 1); PG8_STAGE(PG8_SB(1, 0), b3, voffB); PG8_STAGE(PG8_SB(1, 1), b3 + hstep, voffB); PG8_STAGE(PG8_SA(1, 0), a3, voffA);
            PG8_WAIT_V(8); PG8_WAIT_L(0); PG8_BAR; PG8_MMA(1, 0, At, B0); PG8_MMA(1, 1, At, B1); PG8_BAR; PG8_SCHED;
            } else {
            PG8_LDB(B0, 0, 0); PG8_SCHED; PG8_LDA(At, 0, 0); PG8_STAGE(PG8_SA(1, 1), a1 + hstep, voffA);
            PG8_WAIT_L(8); PG8_BAR; PG8_WAIT_L(0); PG8_MMA(0, 0, At, B0); PG8_BAR; PG8_SCHED;
            PG8_LDB(B1, 0, 1); PG8_STAGE(PG8_SB(0, 0), b2, voffB);
            PG8_BAR; PG8_WAIT_L(0); PG8_MMA(0, 1, At, B1); PG8_BAR;
            PG8_LDA(At, 0, 1); PG8_STAGE(PG8_SA(0, 0), a2, voffA);
            PG8_BAR; PG8_WAIT_L(0); PG8_MMA(1, 0, At, B0); PG8_BAR; PG8_SCHED;
            PG8_STAGE(PG8_SB(0, 1), b2 + hstep, voffB);
            PG8_WAIT_V(6); PG8_BAR; PG8_MMA(1, 1, At, B1); PG8_BAR;
            PG8_LDB(B0, 1, 0); PG8_SCHED; PG8_LDA(At, 1, 0); PG8_STAGE(PG8_SA(0, 1), a2 + hstep, voffA);
            PG8_WAIT_L(8); PG8_BAR; PG8_WAIT_L(0); PG8_MMA(0, 0, At, B0); PG8_BAR; PG8_SCHED;
            PG8_LDB(B1, 1, 1); PG8_STAGE(PG8_SB(1, 0), b3, voffB);
            PG8_BAR; PG8_WAIT_L(0); PG8_MMA(0, 1, At, B1); PG8_BAR;
            PG8_LDA(At, 1, 1); PG8_STAGE(PG8_SA(1, 0), a3, voffA);
            PG8_BAR; PG8_WAIT_L(0); PG8_MMA(1, 0, At, B0); PG8_BAR; PG8_SCHED;
            PG8_STAGE(PG8_SB(1, 1), b3 + hstep, voffB);
            PG8_WAIT_V(6); PG8_BAR; PG8_MMA(1, 1, At, B1); PG8_BAR;
            }
        }
        if constexpr (ALIGN_EPI) { if (wr == 0) PG8_BAR; }
        if constexpr (!Epi::AFTER_DRAIN) { E(acc, cur, wr, wc, fr, fq); S.done(cur); }
        if (!has_next) break;
#pragma unroll
        for (int a = 0; a < 2; ++a)
#pragma unroll
            for (int b = 0; b < 2; ++b)
#pragma unroll
                for (int m = 0; m < 4; ++m)
#pragma unroll
                    for (int n = 0; n < 2; ++n) acc[a][b][m][n] = (f32x4){0.f, 0.f, 0.f, 0.f};
        cur = nxt; cA = nA; cB = nB; ++ui;
        if constexpr (ALIGN_EPI) { if (wr == 1) PG8_BAR; }
    }
    PG8_WAIT_V(0);
    if constexpr (!ALIGN_EPI) { if (wr == 0) PG8_BAR; }
    PG8_BAR;
    if constexpr (Epi::AFTER_DRAIN) { E.fused(acc, cur, wr, wc, fr, fq, lds, wid, lane); S.done(cur); }
#undef PG8_SA
#undef PG8_SB
#undef PG8_STAGE
#undef PG8_LDA
#undef PG8_LDB
#undef PG8_MMA
#undef PG8_WAIT_V
#undef PG8_WAIT_L
#undef PG8_BAR
#undef PG8_SCHED
}
}
#define LAS __attribute__((address_space(3)))
typedef unsigned short bf16_t;
typedef short bf16x8 __attribute__((ext_vector_type(8)));
typedef short s16x4 __attribute__((ext_vector_type(4)));
typedef float f32x4 __attribute__((ext_vector_type(4)));
typedef float f32x16 __attribute__((ext_vector_type(16)));
typedef unsigned u32x4 __attribute__((ext_vector_type(4)));
typedef unsigned u32x2 __attribute__((ext_vector_type(2)));
typedef float f32x2_t __attribute__((ext_vector_type(2)));
typedef __bf16 bf16x2_t __attribute__((ext_vector_type(2)));

constexpr int NB = 2, SEQ = 16384, T = NB * SEQ, DM = 1024, DEPTH = 4, DFF = 2816, NGU = 2 * DFF;
constexpr int NIN_SRC = 2208, NPROJ = 3328;
constexpr int PA = 0, PC = 512, PD = 1024, PCQ = 1792, PCKV = 2048, PKR = 2176, PQUP = 2208, PKVUP = 2592, PEND = 3104;
constexpr float LOG2E = 1.4426950408889634f;
constexpr float NORM_EPS = 1e-5f;
constexpr int NWAVES = 8, NTHREADS = 512;
constexpr int LDS_BYTES = 147456;

constexpr size_t MiB = 1u << 20;
constexpr size_t WS_WGU = 0, WS_WD = 88 * MiB, WS_WIN = 132 * MiB, WS_WOUT = 158 * MiB, WS_XB = 166 * MiB;
constexpr size_t WS_H = 230 * MiB, WS_PROJ = 230 * MiB, WS_QB = 438 * MiB, WS_KB = 462 * MiB, WS_VB = 486 * MiB, WS_MIX = 502 * MiB, WS_END = 566 * MiB;
constexpr size_t WGU_L = (size_t)2 * NGU * DM, WGU_F = (size_t)NGU * DM;
constexpr size_t WD_L = (size_t)2 * DM * DFF, WD_F = (size_t)DM * DFF;
constexpr size_t WIN_L = (size_t)NPROJ * DM, WOUT_L = (size_t)DM * DM;

struct Params {
    const float* x; const float* w_in; const float* win_sink; const float* mla_q_norm; const float* mla_w_uq; const float* mla_kv_norm; const float* mla_w_ukv;
    const float* ax_q_norm; const float* ax_k_norm; const float* diff_lambda; const float* diff_subln; const float* w_out; const float* ffn_w_gu; const float* ffn_w_down;
    const float* ln_g; const float* ln_b;
    float* out; unsigned char* ws;
    float lam_init[4];
    float inv32[16];
};

typedef const __attribute__((address_space(4))) Params* KP;
#define GETP(name) KP name = (KP)__builtin_amdgcn_kernarg_segment_ptr(); asm volatile("" : "+s"(name))

__device__ __forceinline__ int tid_fresh() { int t = threadIdx.x; asm volatile("" : "+v"(t)); return t; }
__device__ __forceinline__ unsigned pkbf(float lo, float hi) { f32x2_t v = {lo, hi}; bf16x2_t b = __builtin_convertvector(v, bf16x2_t); return __builtin_bit_cast(unsigned, b); }
__device__ __forceinline__ float bflo(unsigned w) { return __builtin_bit_cast(float, w << 16); }
__device__ __forceinline__ float bfhi(unsigned w) { return __builtin_bit_cast(float, w & 0xffff0000u); }
__device__ __forceinline__ float wave_sum(float v) {
#pragma unroll
    for (int o = 1; o < 64; o <<= 1) v += __shfl_xor(v, o);
    return v;
}
__device__ __forceinline__ void unpack8(const u32x4 w, float (&v)[8]) {
    v[0] = bflo(w.x); v[1] = bfhi(w.x); v[2] = bflo(w.y); v[3] = bfhi(w.y); v[4] = bflo(w.z); v[5] = bfhi(w.z); v[6] = bflo(w.w); v[7] = bfhi(w.w);
}
__device__ __forceinline__ u32x4 pack8(const float (&v)[8]) { u32x4 w; w.x = pkbf(v[0], v[1]); w.y = pkbf(v[2], v[3]); w.z = pkbf(v[4], v[5]); w.w = pkbf(v[6], v[7]); return w; }

__device__ __forceinline__ void transpose_item(const float* __restrict__ W, int ldw, int src_col0, float scale, bf16_t* __restrict__ WT, int K, int dst_row0, int k0, LAS float* scr, int lane) {
    if (src_col0 < 0) {
        const int c = lane & 7;
#pragma unroll
        for (int j = 0; j < 4; ++j) { const int n = (lane >> 3) + 8 * j; *(u32x4*)(WT + (size_t)(dst_row0 + n) * K + k0 + 8 * c) = (u32x4){0u, 0u, 0u, 0u}; }
        return;
    }
#pragma unroll 8
    for (int i = 0; i < 32; ++i) { const int kk = 2 * i + (lane >> 5); scr[kk * 33 + (lane & 31)] = W[(size_t)(k0 + kk) * ldw + src_col0 + (lane & 31)] * scale; }
    asm volatile("s_waitcnt lgkmcnt(0)" ::: "memory");
    const int c = lane & 7;
#pragma unroll
    for (int j = 0; j < 4; ++j) { const int n = (lane >> 3) + 8 * j; const LAS float* s = scr + (8 * c) * 33 + n;
        u32x4 o; o.x = pkbf(s[0 * 33], s[1 * 33]); o.y = pkbf(s[2 * 33], s[3 * 33]); o.z = pkbf(s[4 * 33], s[5 * 33]); o.w = pkbf(s[6 * 33], s[7 * 33]);
        *(u32x4*)(WT + (size_t)(dst_row0 + n) * K + k0 + 8 * c) = o; }
    asm volatile("s_waitcnt lgkmcnt(0)" ::: "memory");
}

__device__ __forceinline__ void phase0(KP p, LAS unsigned char* lds, int vcu, int G) {
    const int tid = tid_fresh(), lane = tid & 63, wave = __builtin_amdgcn_readfirstlane(tid >> 6);
    LAS float* scr = (LAS float*)(lds + wave * 16384);
    const int gw = vcu * NWAVES + wave, NGW = G * NWAVES;
    bf16_t* wgu = (bf16_t*)(p->ws + WS_WGU); bf16_t* wd = (bf16_t*)(p->ws + WS_WD); bf16_t* win = (bf16_t*)(p->ws + WS_WIN); bf16_t* wout = (bf16_t*)(p->ws + WS_WOUT);
    constexpr int I_GU = 176 * 16, I_WD = 32 * 44, I_IN = 104 * 16, I_OUT = 32 * 16, I_CMP = 112 * 16;
    constexpr int I_LAYER = 2 * I_GU + 2 * I_WD + I_IN + I_OUT + I_CMP;
    for (int it = gw; it < DEPTH * I_LAYER; it += NGW) {
        const int l = it / I_LAYER; int r = it % I_LAYER;
        if (r < 2 * I_GU) { const int f = r / I_GU; r %= I_GU; const int nb = r / 16, kb = r % 16; const int n0 = 32 * nb;
            const int pn = n0 >> 8, bj = (n0 >> 7) & 1, i0 = n0 & 127;
            transpose_item(p->ffn_w_gu + ((size_t)l * 2 + f) * DM * NGU, NGU, bj * DFF + 128 * pn + i0, 1.f, wgu + l * WGU_L + f * WGU_F, DM, n0, 64 * kb, scr, lane); continue; }
        r -= 2 * I_GU;
        if (r < 2 * I_WD) { const int f = r / I_WD; r %= I_WD; const int nb = r / 44, kb = r % 44;
            transpose_item(p->ffn_w_down + ((size_t)l * 2 + f) * DFF * DM, DM, 32 * nb, 1.f, wd + l * WD_L + f * WD_F, DFF, 32 * nb, 64 * kb, scr, lane); continue; }
        r -= 2 * I_WD;
        if (r < I_IN) { const int nb = r / 16, kb = r % 16; const int n0 = 32 * nb; int src; float sc = 1.f;
            if (n0 < PC) { src = n0; if (n0 < 256) sc = 0.125f * LOG2E; }
            else if (n0 < PD) src = 928 + (n0 - PC);
            else if (n0 < PCQ) { src = 1440 + (n0 - PD); if (n0 - PD < 256) sc = 0.17677669529663687f * LOG2E; }
            else if (n0 < PCKV) src = 512 + (n0 - PCQ);
            else if (n0 < PKR) src = 768 + (n0 - PCKV);
            else if (n0 < PQUP) src = 896;
            else if (n0 < PEND) continue;
            else src = -1;
            transpose_item(p->w_in + (size_t)l * DM * NIN_SRC, NIN_SRC, src, sc, win + l * WIN_L, DM, n0, 64 * kb, scr, lane); continue; }
        r -= I_IN;
        if (r < I_OUT) { const int nb = r / 16, kb = r % 16;
            transpose_item(p->w_out + (size_t)l * DM * DM, DM, 32 * nb, 1.f, wout + l * WOUT_L, DM, 32 * nb, 64 * kb, scr, lane); continue; }
        r -= I_OUT;
        {
            const int ng = r / 16, kb = r % 16; const int n0 = 8 * ng; const int k = 64 * kb + lane;
            int J, cA, ldu, nc; const float* g; const float* U;
            if (n0 < 384) { J = 256; cA = 512; g = p->mla_q_norm + l * 256; U = p->mla_w_uq + (size_t)l * 256 * 384; ldu = 384; nc = n0; }
            else { J = 128; cA = 768; g = p->mla_kv_norm + l * 128; U = p->mla_w_ukv + (size_t)l * 128 * 512; ldu = 512; nc = n0 - 384; }
            const float* a = p->w_in + (size_t)l * DM * NIN_SRC + (size_t)k * NIN_SRC + cA;
            float acc[8];
#pragma unroll
            for (int e = 0; e < 8; ++e) acc[e] = 0.f;
            for (int j = 0; j < J; j += 4) {
                const f32x4 av = *(const f32x4*)(a + j);
#pragma unroll
                for (int jj = 0; jj < 4; ++jj) { const float ag = av[jj] * g[j + jj]; const float* ur = U + (size_t)(j + jj) * ldu + nc;
#pragma unroll
                    for (int e = 0; e < 8; ++e) acc[e] = fmaf(ag, ur[e], acc[e]); }
            }
            bf16_t* o = win + l * WIN_L + (size_t)(PQUP + n0) * DM + k;
#pragma unroll
            for (int e = 0; e < 8; ++e) o[(size_t)e * DM] = (bf16_t)(pkbf(acc[e], 0.f) & 0xffffu);
        }
    }
    bf16_t* xb = (bf16_t*)(p->ws + WS_XB);
    for (int m = gw; m < T; m += NGW) {
        const f32x4* xr = (const f32x4*)(p->x + (size_t)m * DM) + lane; u32x2* o8 = (u32x2*)(xb + (size_t)m * DM) + lane;
#pragma unroll
        for (int j = 0; j < 4; ++j) { const f32x4 v = xr[64 * j]; u32x2 w; w.x = pkbf(v.x, v.y); w.y = pkbf(v.z, v.w); o8[64 * j] = w; }
    }
}

__device__ __forceinline__ void ln_phase(float* X, bf16_t* xb, const float* __restrict__ g, const float* __restrict__ b, int vcu, int G) {
    const int tid = tid_fresh(), lane = tid & 63, wave = __builtin_amdgcn_readfirstlane(tid >> 6);
    const int gw = vcu * NWAVES + wave, NGW = G * NWAVES;
    f32x4 gv[4], bv[4];
#pragma unroll
    for (int j = 0; j < 4; ++j) { gv[j] = ((const f32x4*)g)[64 * j + lane]; bv[j] = ((const f32x4*)b)[64 * j + lane]; }
    for (int m = gw; m < T; m += NGW) {
        f32x4* xr = (f32x4*)(X + (size_t)m * DM) + lane; u32x2* o8 = (u32x2*)(xb + (size_t)m * DM) + lane;
        f32x4 v[4]; float s = 0.f;
#pragma unroll
        for (int j = 0; j < 4; ++j) { v[j] = xr[64 * j]; s += (v[j].x + v[j].y) + (v[j].z + v[j].w); }
        const float mean = wave_sum(s) * (1.f / DM); float s2 = 0.f;
#pragma unroll
        for (int j = 0; j < 4; ++j) { v[j] = v[j] - mean; s2 += (v[j].x * v[j].x + v[j].y * v[j].y) + (v[j].z * v[j].z + v[j].w * v[j].w); }
        const float rstd = 1.f / sqrtf(wave_sum(s2) * (1.f / DM) + NORM_EPS);
#pragma unroll
        for (int j = 0; j < 4; ++j) { const f32x4 y = v[j] * rstd * gv[j] + bv[j]; xr[64 * j] = y; u32x2 w; w.x = pkbf(y.x, y.y); w.y = pkbf(y.z, y.w); o8[64 * j] = w; }
    }
}

__device__ __forceinline__ void sincos_rev(float ang, float& s, float& c) {
    double d = (double)ang * 0.15915494309189535; d -= __builtin_rint(d); const float f = (float)d;
    s = __builtin_amdgcn_sinf(f); c = __builtin_amdgcn_cosf(f);
}
__device__ __forceinline__ void rope8(float (&v)[8], bool first, float pos, int i0, KP p) {
#pragma unroll
    for (int e = 0; e < 8; ++e) {
        const float other = __shfl_xor(v[e], 2);
        const float inv = i0 ? p->inv32[8 + e] : p->inv32[e];
        float s, c; sincos_rev(pos * inv, s, c);
        v[e] = first ? (v[e] * c - other * s) : (other * s + v[e] * c);
    }
}
__device__ __forceinline__ void prep_phase(KP p, int l, int vcu, int G) {
    const int tid = tid_fresh(), lane = tid & 63, wave = __builtin_amdgcn_readfirstlane(tid >> 6);
    const int gw = vcu * NWAVES + wave, NGW = G * NWAVES;
    bf16_t* proj = (bf16_t*)(p->ws + WS_PROJ); bf16_t* qb = (bf16_t*)(p->ws + WS_QB); bf16_t* kb = (bf16_t*)(p->ws + WS_KB); bf16_t* vb = (bf16_t*)(p->ws + WS_VB);
    float cg[8];
    { const float* gsrc = (lane < 32 ? p->ax_q_norm : p->ax_k_norm) + l * 64 + 8 * (lane & 7);
#pragma unroll
      for (int e = 0; e < 8; ++e) cg[e] = gsrc[e]; }
    for (int tok = gw; tok < T; tok += NGW) {
        const int t = tok & (SEQ - 1);
        bf16_t* pr = proj + (size_t)tok * NPROJ;
        float ssq = 0.f;
        if (lane < 48) { float v[8]; unpack8(*(const u32x4*)(pr + PCQ + 8 * lane), v);
#pragma unroll
            for (int e = 0; e < 8; ++e) ssq += v[e] * v[e]; }
        const float ssq_q = wave_sum(lane < 32 ? ssq : 0.f), ssq_kv = wave_sum(lane >= 32 ? ssq : 0.f);
        const float rstd_q = 1.f / sqrtf(ssq_q * (1.f / 256.f) + NORM_EPS), rstd_kv = 1.f / sqrtf(ssq_kv * (1.f / 128.f) + NORM_EPS);
        {
            const int r = lane % 12; float v[8];
            if (lane < 48) unpack8(*(const u32x4*)(pr + PQUP + 8 * lane), v); else {
#pragma unroll
                for (int e = 0; e < 8; ++e) v[e] = 0.f; }
#pragma unroll
            for (int e = 0; e < 8; ++e) v[e] *= rstd_q;
            float w[8];
#pragma unroll
            for (int e = 0; e < 8; ++e) w[e] = v[e];
            rope8(w, r < 10, (float)t, 8 * (r & 1), p);
            const bool isr = (r >= 8); const float qs = 0.10206207261596575f * LOG2E;
#pragma unroll
            for (int e = 0; e < 8; ++e) v[e] = (isr ? w[e] : v[e]) * qs;
            if (lane < 48) *(u32x4*)(qb + (size_t)tok * 384 + 8 * lane) = pack8(v);
        }
        {
            float v[8]; unpack8(*(const u32x4*)(pr + PKVUP + 8 * lane), v);
#pragma unroll
            for (int e = 0; e < 8; ++e) v[e] *= rstd_kv;
            const int hd = lane >> 4, r = lane & 15;
            if (r < 8) *(u32x4*)(kb + (size_t)tok * 384 + hd * 96 + 8 * r) = pack8(v);
            else *(u32x4*)(vb + (size_t)tok * 256 + hd * 64 + 8 * (r - 8)) = pack8(v);
        }
        {
            float v[8];
            if (lane < 4) unpack8(*(const u32x4*)(pr + PKR + 8 * lane), v); else {
#pragma unroll
                for (int e = 0; e < 8; ++e) v[e] = 0.f; }
            rope8(v, (lane & 3) < 2, (float)t, 8 * (lane & 1), p);
            if (lane < 4) { const u32x4 w = pack8(v);
#pragma unroll
                for (int hd = 0; hd < 4; ++hd) *(u32x4*)(kb + (size_t)tok * 384 + hd * 96 + 64 + 8 * lane) = w; }
        }
        {
            float v[8];
            if (lane < 48) unpack8(*(const u32x4*)(pr + PC + 8 * lane), v); else {
#pragma unroll
                for (int e = 0; e < 8; ++e) v[e] = 0.f; }
            float s = 0.f;
#pragma unroll
            for (int e = 0; e < 8; ++e) s += v[e] * v[e];
            s += __shfl_xor(s, 1); s += __shfl_xor(s, 2); s += __shfl_xor(s, 4);
            const float rs = 1.f / sqrtf(s * (1.f / 64.f) + NORM_EPS);
#pragma unroll
            for (int e = 0; e < 8; ++e) v[e] = v[e] * rs * cg[e];
            const int r = lane & 7; const float pos = (r < 4) ? (float)(t >> 6) : (float)(t & 63);
            rope8(v, (r & 3) < 2, pos, 8 * (r & 1), p);
            if (lane < 32) {
#pragma unroll
                for (int e = 0; e < 8; ++e) v[e] *= 0.125f * LOG2E; }
            if (lane < 48) *(u32x4*)(pr + PC + 8 * lane) = pack8(v);
        }
    }
}

#ifndef ATT_TYPES
#define ATT_TYPES 15
#endif
namespace att {
constexpr int VPITCH = 144, KBUF = 64 * 208, VBUF = 64 * VPITCH;
constexpr int ATT_LDS = 2 * KBUF + 2 * VBUF;
__device__ __forceinline__ s16x4 vtr(const LAS char* p) { return __builtin_bit_cast(s16x4, __builtin_amdgcn_ds_read_tr16_b64_v4i16((LAS s16x4*)p)); }
__device__ __forceinline__ void xhalf_swap(float m, float& a, float& b) {
    a = m; b = m;
    asm volatile("s_nop 1\n\tv_permlane32_swap_b32 %0, %1\n\ts_nop 1" : "+v"(a), "+v"(b));
}
__device__ __forceinline__ float xhalf_max(float m) { float a, b; xhalf_swap(m, a, b); return fmaxf(a, b); }
__device__ __forceinline__ float xhalf_sum(float m) { float a, b; xhalf_swap(m, a, b); return a + b; }
__device__ __forceinline__ bf16x8 pack_frag(const f32x16& x, int s) {
    u32x4 w; w.x = pkbf(x[8 * s + 0], x[8 * s + 1]); w.y = pkbf(x[8 * s + 2], x[8 * s + 3]); w.z = pkbf(x[8 * s + 4], x[8 * s + 5]); w.w = pkbf(x[8 * s + 6], x[8 * s + 7]);
    return __builtin_bit_cast(bf16x8, w);
}
#define ATT_MFMA(a, b, c) __builtin_amdgcn_mfma_f32_32x32x16_bf16((a), (b), (c), 0, 0, 0)

template <int DK, bool ALIBI, bool WINDOW>
__device__ __forceinline__ void flash_pass(LAS char* lds, const bf16_t* __restrict__ Qg, int qp, const bf16_t* __restrict__ Kg, int kp, const bf16_t* __restrict__ Vg, int vp,
                                           int q0, int kt0, int kt1, float slope2, f32x16& O0, f32x16& O1, float& Mout, float& Lout) {
    constexpr int KPITCH = DK * 2 + 16, NKC = 8 * DK, CPR = DK / 8, NKS = DK / 16;
    const int tid = tid_fresh(), lane = tid & 63, r32 = lane & 31, hi = lane >> 5; const int wid = __builtin_amdgcn_readfirstlane(tid >> 6);
    const int qrow = q0 + wid * 32 + r32;
    bf16x8 qf[NKS];
#pragma unroll
    for (int ks = 0; ks < NKS; ++ks) qf[ks] = *(const bf16x8*)(Qg + (size_t)qrow * qp + 16 * ks + 8 * hi);
    const int kc1 = tid + 512;
    const bool k0v = tid < NKC, k1v = kc1 < NKC;
    const int kr0 = tid / CPR, kcc0 = tid % CPR, kr1 = kc1 / CPR, kcc1 = kc1 % CPR, vr = tid >> 3, vcc = tid & 7;
    const bf16_t* kg0 = Kg + (size_t)kr0 * kp + 8 * kcc0; const bf16_t* kg1 = Kg + (size_t)kr1 * kp + 8 * kcc1; const bf16_t* vg = Vg + (size_t)vr * vp + 8 * vcc;
    const int kl0 = kr0 * KPITCH + 16 * kcc0, kl1 = kr1 * KPITCH + 16 * kcc1, vl = 2 * KBUF + vr * VPITCH + 16 * vcc;
    u32x4 rk0 = {0u, 0u, 0u, 0u}, rk1 = {0u, 0u, 0u, 0u}, rv;
#define ATT_LOAD(kt) do { const size_t ro_ = (size_t)(kt) * 64; if (k0v) rk0 = *(const u32x4*)(kg0 + ro_ * kp); if (k1v) rk1 = *(const u32x4*)(kg1 + ro_ * kp); rv = *(const u32x4*)(vg + ro_ * vp); } while (0)
#define ATT_STORE(buf) do { if (k0v) *(LAS u32x4*)(lds + (buf) * KBUF + kl0) = rk0; if (k1v) *(LAS u32x4*)(lds + (buf) * KBUF + kl1) = rk1; *(LAS u32x4*)(lds + (buf) * VBUF + vl) = rv; } while (0)
    ATT_LOAD(kt0); ATT_STORE(0);
    __syncthreads();
    float M = -1e20f, L = 0.f;
#pragma unroll
    for (int i = 0; i < 16; ++i) { O0[i] = 0.f; O1[i] = 0.f; }
    const int q4 = (lane & 15) >> 2, p4 = lane & 3, b16 = (lane >> 4) & 1;
    const int vbase = (4 * hi + q4) * VPITCH + 32 * b16 + 8 * p4;
    const int kbase = r32 * KPITCH + 16 * hi;
    for (int kt = kt0; kt < kt1; ++kt) {
        const int cur = (kt - kt0) & 1; const bool more = (kt + 1 < kt1);
        if (more) ATT_LOAD(kt + 1);
        bool active = true;
        if (WINDOW) { const int k0 = kt * 64, qw = q0 + wid * 32; active = !(k0 + 63 < qw - 128 || k0 > qw + 31 + 128); }
        if (active) {
            const LAS char* Kb = lds + cur * KBUF + kbase; const LAS char* Vb = lds + 2 * KBUF + cur * VBUF + vbase;
            f32x16 s0, s1;
#pragma unroll
            for (int i = 0; i < 16; ++i) { s0[i] = 0.f; s1[i] = 0.f; }
#pragma unroll
            for (int ks = 0; ks < NKS; ++ks) {
                const bf16x8 a0 = *(const LAS bf16x8*)(Kb + 32 * ks), a1 = *(const LAS bf16x8*)(Kb + 32 * KPITCH + 32 * ks);
                s0 = ATT_MFMA(a0, qf[ks], s0); s1 = ATT_MFMA(a1, qf[ks], s1);
            }
            if (ALIBI) {
                const float dbase = (float)(kt * 64 + 4 * hi - qrow);
#pragma unroll
                for (int i = 0; i < 16; ++i) {
                    const float c = (float)((i & 3) + 8 * (i >> 2));
                    const float d0 = fabsf(dbase + c), d1 = fabsf(dbase + (c + 32.f));
                    if (WINDOW) { s0[i] = (d0 <= 128.f) ? fmaf(-slope2, d0, s0[i]) : -1e30f; s1[i] = (d1 <= 128.f) ? fmaf(-slope2, d1, s1[i]) : -1e30f; }
                    else { s0[i] = fmaf(-slope2, d0, s0[i]); s1[i] = fmaf(-slope2, d1, s1[i]); }
                }
            }
            float mx = fmaxf(s0[0], s1[0]);
#pragma unroll
            for (int i = 1; i < 16; ++i) mx = fmaxf(mx, fmaxf(s0[i], s1[i]));
            mx = xhalf_max(mx);
            const float Mn = fmaxf(M, mx); const float alpha = __builtin_amdgcn_exp2f(M - Mn); M = Mn;
            float ps = 0.f;
#pragma unroll
            for (int i = 0; i < 16; ++i) { s0[i] = __builtin_amdgcn_exp2f(s0[i] - Mn); s1[i] = __builtin_amdgcn_exp2f(s1[i] - Mn); ps += s0[i] + s1[i]; }
            L = L * alpha + ps;
#pragma unroll
            for (int i = 0; i < 16; ++i) { O0[i] *= alpha; O1[i] *= alpha; }
            bf16x8 pf[2][2];
            pf[0][0] = pack_frag(s0, 0); pf[0][1] = pack_frag(s0, 1); pf[1][0] = pack_frag(s1, 0); pf[1][1] = pack_frag(s1, 1);
#pragma unroll
            for (int kb = 0; kb < 2; ++kb)
#pragma unroll
                for (int st = 0; st < 2; ++st) {
                    const LAS char* vp0 = Vb + (32 * kb + 16 * st) * VPITCH;
                    { const s16x4 lo = vtr(vp0), hh = vtr(vp0 + 8 * VPITCH); const bf16x8 vf = __builtin_shufflevector(lo, hh, 0, 1, 2, 3, 4, 5, 6, 7); O0 = ATT_MFMA(vf, pf[kb][st], O0); }
                    { const s16x4 lo = vtr(vp0 + 64), hh = vtr(vp0 + 8 * VPITCH + 64); const bf16x8 vf = __builtin_shufflevector(lo, hh, 0, 1, 2, 3, 4, 5, 6, 7); O1 = ATT_MFMA(vf, pf[kb][st], O1); }
                }
        }
        if (more) ATT_STORE(cur ^ 1);
        __syncthreads();
    }
#undef ATT_LOAD
#undef ATT_STORE
    Mout = M; Lout = L;
}

__device__ __forceinline__ void store_o(bf16_t* orow, const f32x16& O0, const f32x16& O1, int hi) {
#pragma unroll
    for (int g = 0; g < 4; ++g) {
        u32x2 w0, w1; w0.x = pkbf(O0[4 * g], O0[4 * g + 1]); w0.y = pkbf(O0[4 * g + 2], O0[4 * g + 3]); w1.x = pkbf(O1[4 * g], O1[4 * g + 1]); w1.y = pkbf(O1[4 * g + 2], O1[4 * g + 3]);
        *(u32x2*)(orow + 8 * g + 4 * hi) = w0; *(u32x2*)(orow + 32 + 8 * g + 4 * hi) = w1;
    }
}

__device__ __forceinline__ void attn_phase(KP p, int l, LAS char* lds, int vcu, int G) {
    const int tid = tid_fresh(), lane = tid & 63, r32 = lane & 31, hi = lane >> 5; const int wid = __builtin_amdgcn_readfirstlane(tid >> 6);
    const bf16_t* proj = (const bf16_t*)(p->ws + WS_PROJ); const bf16_t* qb = (const bf16_t*)(p->ws + WS_QB); const bf16_t* kb = (const bf16_t*)(p->ws + WS_KB); const bf16_t* vb = (const bf16_t*)(p->ws + WS_VB);
    bf16_t* mix = (bf16_t*)(p->ws + WS_MIX);
    float lam;
    { const float* lp = p->diff_lambda + l * 128; const float a = (lane < 32) ? lp[lane] * lp[32 + lane] : 0.f, b2 = (lane < 32) ? lp[64 + lane] * lp[96 + lane] : 0.f;
      lam = expf(wave_sum(a)) - expf(wave_sum(b2)) + p->lam_init[l]; }
    const float one_m_li = 1.f - p->lam_init[l];
    for (int u = vcu; u < 2048; u += G) {
        if (!((ATT_TYPES >> (u >> 9)) & 1)) continue;
        const int type = u >> 9, idx = u & 511, bh = idx >> 6, qblk = idx & 63, b = bh >> 2, hd = bh & 3, q0 = qblk * 256;
        const int qrow = q0 + wid * 32 + r32;
        const size_t tok0 = (size_t)b * SEQ;
        bf16_t* orow = mix + (tok0 + qrow) * DM;
        f32x16 O0, O1; float M, L;
        if (type == 0) {
            const float slope2 = __builtin_amdgcn_exp2f(-(float)(5 + hd)) * LOG2E;
            const bf16_t* base = proj + tok0 * NPROJ + PD;
            flash_pass<32, true, false>(lds, base + 64 * hd, NPROJ, base + 256 + 64 * hd, NPROJ, base + 512 + 64 * hd, NPROJ, q0, 0, SEQ / 64, slope2, O0, O1, M, L);
            const float i1 = 1.f / xhalf_sum(L);
            f32x16 A0, A1;
#pragma unroll
            for (int i = 0; i < 16; ++i) { A0[i] = O0[i] * i1; A1[i] = O1[i] * i1; }
            flash_pass<32, true, false>(lds, base + 64 * hd + 32, NPROJ, base + 256 + 64 * hd + 32, NPROJ, base + 512 + 64 * hd, NPROJ, q0, 0, SEQ / 64, slope2, O0, O1, M, L);
            const float i2 = lam / xhalf_sum(L);
            float ss = 0.f;
#pragma unroll
            for (int i = 0; i < 16; ++i) { A0[i] -= O0[i] * i2; A1[i] -= O1[i] * i2; ss += A0[i] * A0[i] + A1[i] * A1[i]; }
            ss = xhalf_sum(ss);
            const float rs = one_m_li / sqrtf(ss * (1.f / 64.f) + NORM_EPS);
            const float* sg = p->diff_subln + l * 64;
#pragma unroll
            for (int i = 0; i < 16; ++i) { const int dv = (i & 3) + 8 * (i >> 2) + 4 * hi; A0[i] *= rs * sg[dv]; A1[i] *= rs * sg[32 + dv]; }
            store_o(orow + 768 + 64 * hd, A0, A1, hi);
        } else if (type == 1) {
            flash_pass<96, false, false>(lds, qb + tok0 * 384 + 96 * hd, 384, kb + tok0 * 384 + 96 * hd, 384, vb + tok0 * 256 + 64 * hd, 256, q0, 0, SEQ / 64, 0.f, O0, O1, M, L);
            const float il = 1.f / xhalf_sum(L);
#pragma unroll
            for (int i = 0; i < 16; ++i) { O0[i] *= il; O1[i] *= il; }
            store_o(orow + 256 + 64 * hd, O0, O1, hi);
        } else if (type == 2) {
            const bf16_t* base = proj + tok0 * NPROJ + PC; const int hk = hd >> 1;
            flash_pass<64, false, false>(lds, base + 64 * hd, NPROJ, base + 256 + 64 * hk, NPROJ, base + 384 + 64 * hk, NPROJ, q0, 0, SEQ / 64, 0.f, O0, O1, M, L);
            const float il = 1.f / xhalf_sum(L);
#pragma unroll
            for (int i = 0; i < 16; ++i) { O0[i] *= il; O1[i] *= il; }
            store_o(orow + 512 + 64 * hd, O0, O1, hi);
        } else {
            const bf16_t* base = proj + tok0 * NPROJ + PA; const int hk = hd >> 1;
            const float slope2 = __builtin_amdgcn_exp2f(-(float)(1 + hd)) * LOG2E;
            const int kt0 = (q0 >= 128) ? (q0 - 128) / 64 : 0; int kt1 = (q0 + 256 + 128) / 64; if (kt1 > SEQ / 64) kt1 = SEQ / 64;
            flash_pass<64, true, true>(lds, base + 64 * hd, NPROJ, base + 256 + 64 * hk, NPROJ, base + 384 + 64 * hk, NPROJ, q0, kt0, kt1, slope2, O0, O1, M, L);
            const float sink2 = p->win_sink[l * 4 + hd] * LOG2E;
            const float il = 1.f / (xhalf_sum(L) + __builtin_amdgcn_exp2f(sink2 - M));
#pragma unroll
            for (int i = 0; i < 16; ++i) { O0[i] *= il; O1[i] *= il; }
            store_o(orow + 64 * hd, O0, O1, hi);
        }
    }
}
}

#define GRID_SYNC() do { __builtin_amdgcn_fence(__ATOMIC_RELEASE, "agent"); grid.sync(); __builtin_amdgcn_fence(__ATOMIC_ACQUIRE, "agent"); } while (0)
#ifndef PH_MASK
#define PH_MASK 255
#endif
__global__ void __launch_bounds__(NTHREADS, 2) mega_fwd(Params p_by_value) {
    extern __shared__ __attribute__((aligned(16))) unsigned char lds_raw[];
    cg::grid_group grid = cg::this_grid();
    LAS unsigned char* lds = (LAS unsigned char*)lds_raw;
#define VCU(G_, bx_) (((G_) % 8 == 0) ? ((bx_) % 8) * ((G_) / 8) + (bx_) / 8 : (bx_))
    const float alpha = 1.681792830507429f;

    if (PH_MASK & 1) { GETP(p); const int G = gridDim.x, bx = blockIdx.x; phase0(p, lds, VCU(G, bx), G); }
    GRID_SYNC();
#pragma unroll 1
    for (int li = 0; li < DEPTH; ++li) {
#pragma unroll 1
        for (int fi = 0; fi < 2; ++fi) {
            if (fi == 1) {
                if (PH_MASK & 2) { GETP(p); int l = li; asm volatile("" : "+s"(l)); const int G = gridDim.x, bx = blockIdx.x;
                  pg8::Gemm g{(const bf16_t*)(p->ws + WS_XB), (const bf16_t*)(p->ws + WS_WIN) + l * WIN_L, T, NPROJ, DM}; pg8::StaticOrder S; S.init(T, NPROJ, G, bx);
                  pg8::EpiStoreBf16 E{(bf16_t*)(p->ws + WS_PROJ), NPROJ};
                  pg8::gemm_phase<pg8::EpiStoreBf16, pg8::StaticOrder, true, true>(lds, g, S, E); }
                GRID_SYNC();
                if (PH_MASK & 4) { GETP(p); int l = li; asm volatile("" : "+s"(l)); const int G = gridDim.x, bx = blockIdx.x; prep_phase(p, l, VCU(G, bx), G); }
                GRID_SYNC();
                if (PH_MASK & 8) { GETP(p); int l = li; asm volatile("" : "+s"(l)); const int G = gridDim.x, bx = blockIdx.x; att::attn_phase(p, l, (LAS char*)lds, VCU(G, bx), G); }
                GRID_SYNC();
                if (PH_MASK & 16) { GETP(p); int l = li; asm volatile("" : "+s"(l)); const int G = gridDim.x, bx = blockIdx.x;
                  pg8::Gemm g{(const bf16_t*)(p->ws + WS_MIX), (const bf16_t*)(p->ws + WS_WOUT) + l * WOUT_L, T, DM, DM}; pg8::StaticOrder S; S.init(T, DM, G, bx);
                  pg8::EpiResid E{p->out, p->out, DM, alpha, 1.0f};
                  pg8::gemm_phase<pg8::EpiResid, pg8::StaticOrder, true, true>(lds, g, S, E); }
                GRID_SYNC();
                if (PH_MASK & 32) { GETP(p); int l = li; asm volatile("" : "+s"(l)); const int G = gridDim.x, bx = blockIdx.x;
                  ln_phase(p->out, (bf16_t*)(p->ws + WS_XB), p->ln_g + (l * 3 + 1) * DM, p->ln_b + (l * 3 + 1) * DM, VCU(G, bx), G); }
                GRID_SYNC();
            }
            if (PH_MASK & 64) { GETP(p); int l = li, f = fi; asm volatile("" : "+s"(l), "+s"(f)); const int G = gridDim.x, bx = blockIdx.x;
              pg8::Gemm g{(const bf16_t*)(p->ws + WS_XB), (const bf16_t*)(p->ws + WS_WGU) + l * WGU_L + f * WGU_F, T, NGU, DM}; pg8::StaticOrder S; S.init(T, NGU, G, bx);
              pg8::EpiSwiGLU E{(bf16_t*)(p->ws + WS_H), DFF};
              pg8::gemm_phase<pg8::EpiSwiGLU, pg8::StaticOrder, true, true>(lds, g, S, E); }
            GRID_SYNC();
            if (PH_MASK & 128) { GETP(p); int l = li, f = fi; asm volatile("" : "+s"(l), "+s"(f)); const int G = gridDim.x, bx = blockIdx.x;
              pg8::Gemm g{(const bf16_t*)(p->ws + WS_H), (const bf16_t*)(p->ws + WS_WD) + l * WD_L + f * WD_F, T, DM, DFF}; pg8::StaticOrder S; S.init(T, DM, G, bx);
              pg8::EpiResid E{(l == 0 && f == 0) ? p->x : (const float*)p->out, p->out, DM, alpha, 0.5f};
              pg8::gemm_phase<pg8::EpiResid, pg8::StaticOrder, true, true>(lds, g, S, E); }
            GRID_SYNC();
            if (PH_MASK & 32) { GETP(p); int l = li, f = fi; asm volatile("" : "+s"(l), "+s"(f)); const int G = gridDim.x, bx = blockIdx.x;
              ln_phase(p->out, (bf16_t*)(p->ws + WS_XB), p->ln_g + (l * 3 + 2 * f) * DM, p->ln_b + (l * 3 + 2 * f) * DM, VCU(G, bx), G); }
            GRID_SYNC();
        }
    }
}

extern "C" void kernel_launch(void* const* d_in, const int* in_sizes, int n_in, void* d_out, int out_size, void* d_ws, size_t ws_size, hipStream_t stream) {
    static int grid = 0;
    if (grid == 0) {
        if (n_in != 16 || in_sizes[0] != T * DM || out_size != T * DM || ws_size < WS_END) { fprintf(stderr, "kernel_launch: unexpected shapes (n_in %d, in0 %d, out %d, ws %zu); nothing launched\n", n_in, n_in > 0 ? in_sizes[0] : -1, out_size, ws_size); grid = -1; return; }
        int dev = 0, cus = 0, per_cu = 0;
        hipGetDevice(&dev); hipDeviceGetAttribute(&cus, hipDeviceAttributeMultiprocessorCount, dev);
        if (hipFuncSetAttribute((const void*)mega_fwd, hipFuncAttributeMaxDynamicSharedMemorySize, LDS_BYTES) != hipSuccess) { fprintf(stderr, "kernel_launch: hipFuncSetAttribute failed\n"); grid = -1; return; }
        if (hipOccupancyMaxActiveBlocksPerMultiprocessor(&per_cu, (const void*)mega_fwd, NTHREADS, LDS_BYTES) != hipSuccess || per_cu < 1) { fprintf(stderr, "kernel_launch: occupancy query gave %d\n", per_cu); per_cu = 1; }
        (void)hipGetLastError();
        grid = cus * 1;
    }
    if (grid < 0) return;
    Params p{};
    p.x = (const float*)d_in[0]; p.w_in = (const float*)d_in[1]; p.win_sink = (const float*)d_in[2]; p.mla_q_norm = (const float*)d_in[3]; p.mla_w_uq = (const float*)d_in[4];
    p.mla_kv_norm = (const float*)d_in[5]; p.mla_w_ukv = (const float*)d_in[6]; p.ax_q_norm = (const float*)d_in[7]; p.ax_k_norm = (const float*)d_in[8]; p.diff_lambda = (const float*)d_in[9];
    p.diff_subln = (const float*)d_in[10]; p.w_out = (const float*)d_in[11]; p.ffn_w_gu = (const float*)d_in[12]; p.ffn_w_down = (const float*)d_in[13]; p.ln_g = (const float*)d_in[14]; p.ln_b = (const float*)d_in[15];
    p.out = (float*)d_out; p.ws = (unsigned char*)d_ws;
    for (int l = 0; l < 4; ++l) p.lam_init[l] = (float)(0.8 - 0.6 * exp(-0.3 * (double)l));
    for (int i = 0; i < 16; ++i) p.inv32[i] = (float)pow(10000.0, -(double)i / 16.0);
    void* args[] = {&p};
    hipError_t e = hipLaunchCooperativeKernel((const void*)mega_fwd, dim3(grid), dim3(NTHREADS), args, LDS_BYTES, stream);
    if (e != hipSuccess) fprintf(stderr, "kernel_launch: cooperative launch failed: %s (grid %d)\n", hipGetErrorString(e), grid);
}
```

```cpp
#include <hip/hip_runtime.h>
#include <hip/hip_cooperative_groups.h>
#include <cstdio>
#include <cstdint>
#include <cmath>
namespace cg = cooperative_groups;
namespace pg8 {
#define PG8_LAS __attribute__((address_space(3)))
typedef unsigned short bf16_t;
typedef short bf16x8 __attribute__((ext_vector_type(8)));
typedef float f32x4 __attribute__((ext_vector_type(4)));
typedef unsigned u32x4 __attribute__((ext_vector_type(4)));
constexpr int BM = 256, BK = 64, HALF = 128, HTB = HALF * BK * 2  , STAGE_BYTES = 8 * HTB, NXCD = 8, WGM = 8;

__host__ __device__ __forceinline__ int lds_byte(int r, int c) { const int st = (r >> 4) * 2 + (c >> 5), rr = r & 15, cc = c & 31, ob = rr * 64 + cc * 2; return st * 1024 + (ob ^ (((ob >> 9) & 1) << 5)); }
__host__ __device__ __forceinline__ void stage_rc(int b, int& R, int& C) { const int st = b / 1024, sb = b % 1024, swz = sb ^ (((sb >> 9) & 1) << 5); R = (st >> 1) * 16 + swz / 64; C = (st & 1) * 32 + (swz % 64) / 2; }
__host__ __device__ __forceinline__ int perm32(int rho) { const int n = rho >> 4, i = rho & 15; return 8 * (i >> 2) + 4 * n + (i & 3); }

struct Unit { int pm, pn; };
struct Gemm { const bf16_t* A; const bf16_t* Bt; int M, N, K; };

struct StaticOrder {
    int nM, nN, nwg, G, c;
    __host__ __device__ void init(int M, int N, int G_, int c_) { nM = M / BM; nN = N / BM; nwg = nM * nN; G = G_; c = c_; }
    __host__ __device__ bool next(int i, Unit& u) const {
        const long L = (long)i * G + c; if (L >= nwg) return false;
        int wgid = (int)L; { const int q = nwg / NXCD, r = nwg % NXCD, xcd = wgid % NXCD, off = wgid / NXCD; wgid = (xcd < r ? xcd * (q + 1) : r * (q + 1) + (xcd - r) * q) + off; }
        const int nig = WGM * nN, gid = wgid / nig, fm = gid * WGM, gsz = (nM - fm) < WGM ? (nM - fm) : WGM;
        u.pm = fm + ((wgid % nig) % gsz); u.pn = (wgid % nig) / gsz; return true;
    }
    __device__ __forceinline__ void a_ready(const Unit&) const {}
    __device__ __forceinline__ void done(const Unit&) const {}
};

__device__ __forceinline__ unsigned cvt_pk_bf16(float lo, float hi) { unsigned r; asm volatile("v_cvt_pk_bf16_f32 %0, %1, %2" : "=v"(r) : "v"(lo), "v"(hi)); return r; }
typedef float f32x2 __attribute__((ext_vector_type(2)));
typedef float f32x2 __attribute__((ext_vector_type(2)));
typedef unsigned u32x2 __attribute__((ext_vector_type(2)));

struct EpiStoreBf16 {
    static constexpr bool PERM = true, AFTER_DRAIN = false;
    bf16_t* O; int ldc;
    __device__ __forceinline__ void operator()(const f32x4 (&acc)[2][2][4][2], const Unit& u, int wr, int wc, int fr, int fq) const {
        const int row0 = u.pm * BM + wr * 64 + fr; const int col0 = u.pn * BM + wc * 32 + 8 * fq;
#pragma unroll
        for (int ai = 0; ai < 2; ++ai)
#pragma unroll
            for (int m = 0; m < 4; ++m) { bf16_t* rowp = O + (size_t)(row0 + ai * HALF + m * 16) * ldc + col0;
#pragma unroll
                for (int bj = 0; bj < 2; ++bj) { const f32x4 v0 = acc[ai][bj][m][0], v1 = acc[ai][bj][m][1];
                    u32x4 w; w.x = cvt_pk_bf16(v0[0], v0[1]); w.y = cvt_pk_bf16(v0[2], v0[3]); w.z = cvt_pk_bf16(v1[0], v1[1]); w.w = cvt_pk_bf16(v1[2], v1[3]);
                    *(u32x4*)(rowp + bj * HALF) = w; } }
    }
};

__device__ __forceinline__ float silu_mul(float g, float u) {
    const float e = __builtin_amdgcn_exp2f(-1.4426950408889634f * g);
    return g * u * __builtin_amdgcn_rcpf(1.0f + e);
}
struct EpiSwiGLU {
    static constexpr bool PERM = true, AFTER_DRAIN = false;
    bf16_t* H; int ldh;
    __device__ __forceinline__ void operator()(const f32x4 (&acc)[2][2][4][2], const Unit& u, int wr, int wc, int fr, int fq) const {
        const int row0 = u.pm * BM + wr * 64 + fr; const int col0 = u.pn * HALF + wc * 32 + 8 * fq;
#pragma unroll
        for (int ai = 0; ai < 2; ++ai)
#pragma unroll
            for (int m = 0; m < 4; ++m) { bf16_t* rowp = H + (size_t)(row0 + ai * HALF + m * 16) * ldh + col0;
                const f32x4 g0 = acc[ai][0][m][0], g1 = acc[ai][0][m][1], u0 = acc[ai][1][m][0], u1 = acc[ai][1][m][1];
                u32x4 w;
                w.x = cvt_pk_bf16(silu_mul(g0[0], u0[0]), silu_mul(g0[1], u0[1])); w.y = cvt_pk_bf16(silu_mul(g0[2], u0[2]), silu_mul(g0[3], u0[3]));
                w.z = cvt_pk_bf16(silu_mul(g1[0], u1[0]), silu_mul(g1[1], u1[1])); w.w = cvt_pk_bf16(silu_mul(g1[2], u1[2]), silu_mul(g1[3], u1[3]));
                *(u32x4*)rowp = w; }
    }
};

struct EpiResid {
    static constexpr bool PERM = false, AFTER_DRAIN = false;
    const float* src; float* dst; int ld; float alpha, beta;
    __device__ __forceinline__ void operator()(const f32x4 (&acc)[2][2][4][2], const Unit& u, int wr, int wc, int fr, int fq) const {
        const int col0 = u.pn * BM + wc * 32 + 4 * fq;
#pragma unroll
        for (int ai = 0; ai < 2; ++ai)
#pragma unroll
            for (int m = 0; m < 4; ++m) { const size_t off = (size_t)(u.pm * BM + ai * HALF + wr * 64 + m * 16 + fr) * ld + col0;
#pragma unroll
                for (int bj = 0; bj < 2; ++bj)
#pragma unroll
                    for (int n = 0; n < 2; ++n) { const f32x4 s = *(const f32x4*)(src + off + bj * HALF + n * 16);
                        *(f32x4*)(dst + off + bj * HALF + n * 16) = s * alpha + acc[ai][bj][m][n] * beta; } }
    }
};
template <class Epi, class Sched, bool ALIGN_EPI = false, bool SP2 = false>
__device__ __forceinline__ void gemm_phase(PG8_LAS unsigned char* lds, const Gemm g, const Sched& S, const Epi& E) {
    int tid_ = threadIdx.x; asm volatile("" : "+v"(tid_));
    const int tid = tid_, wid = __builtin_amdgcn_readfirstlane(tid >> 6), lane = tid & 63, wr = wid >> 2, wc = wid & 3, fr = lane & 15, fq = lane >> 4;
    const int K = g.K, nt = K / BK;
    unsigned voffA[2], voffB[2];
#pragma unroll
    for (int i = 0; i < 2; ++i) { int R, C; stage_rc(tid * 16 + i * 8192, R, C); const int Rb = Epi::PERM ? ((R & ~31) + perm32(R & 31)) : R;
        voffA[i] = (unsigned)(R * K + C) * 2u; voffB[i] = (unsigned)(Rb * K + C) * 2u; }
    const size_t kstep = (size_t)(BK * 2);
    const size_t hstep = (size_t)HALF * K * 2;
    const size_t tstep = 2 * hstep;
    const unsigned ldsw = (unsigned)wid * 1024u;
    const int aoff = lds_byte(wr * 64 + fr, fq * 8), boff = lds_byte(wc * 32 + fr, fq * 8);
#define PG8_SA(b, h) (((b) * 2 + (h)) * HTB)
#define PG8_SB(b, h) ((4 + (b) * 2 + (h)) * HTB)
#define PG8_STAGE(bufoff, gbase, voff) do { _Pragma("unroll") for (int _i = 0; _i < 2; ++_i) \
        __builtin_amdgcn_global_load_lds((const unsigned*)((const char*)(gbase) + (voff)[_i]), (PG8_LAS unsigned*)(lds + (bufoff) + ldsw + _i * 8192), 16, 0, 0); } while (0)
#define PG8_LDA(dst, b, h) do { _Pragma("unroll") for (int m = 0; m < 4; ++m) _Pragma("unroll") for (int k = 0; k < 2; ++k) dst[m][k] = *(const PG8_LAS bf16x8*)(lds + PG8_SA(b, h) + aoff + m * 2048 + k * 1024); } while (0)
#define PG8_LDB(dst, b, h) do { _Pragma("unroll") for (int n = 0; n < 2; ++n) _Pragma("unroll") for (int k = 0; k < 2; ++k) dst[n][k] = *(const PG8_LAS bf16x8*)(lds + PG8_SB(b, h) + boff + n * 2048 + k * 1024); } while (0)
#define PG8_MMA(ai, bj, At, Bt) do { __builtin_amdgcn_s_setprio(1); _Pragma("unroll") for (int m = 0; m < 4; ++m) _Pragma("unroll") for (int n = 0; n < 2; ++n) _Pragma("unroll") for (int k = 0; k < 2; ++k) \
        acc[ai][bj][m][n] = __builtin_amdgcn_mfma_f32_16x16x32_bf16(Bt[n][k], At[m][k], acc[ai][bj][m][n], 0, 0, 0); __builtin_amdgcn_s_setprio(0); } while (0)
#define PG8_WAIT_V(n) asm volatile("s_waitcnt vmcnt(" #n ")" ::: "memory")
#define PG8_WAIT_L(n) asm volatile("s_waitcnt lgkmcnt(" #n ")" ::: "memory")
#define PG8_BAR __builtin_amdgcn_s_barrier()
#define PG8_SCHED __builtin_amdgcn_sched_barrier(0)
    Unit cur, nxt; int ui = 0;
    if (!S.next(0, cur)) return;
    f32x4 acc[2][2][4][2];
#pragma unroll
    for (int a = 0; a < 2; ++a)
#pragma unroll
        for (int b = 0; b < 2; ++b)
#pragma unroll
            for (int m = 0; m < 4; ++m)
#pragma unroll
                for (int n = 0; n < 2; ++n) acc[a][b][m][n] = (f32x4){0.f, 0.f, 0.f, 0.f};
    bf16x8 At[4][2], B0[2][2], B1[2][2];
    const char* cA = (const char*)g.A + (size_t)cur.pm * tstep; const char* cB = (const char*)g.Bt + (size_t)cur.pn * tstep;
    S.a_ready(cur);
    if constexpr (SP2) {
        PG8_STAGE(PG8_SB(0, 0), cB, voffB); PG8_STAGE(PG8_SB(0, 1), cB + hstep, voffB); PG8_STAGE(PG8_SA(0, 0), cA, voffA); PG8_STAGE(PG8_SA(0, 1), cA + hstep, voffA);
        if (wr == 1) PG8_BAR;
        PG8_WAIT_V(2); PG8_BAR;
        PG8_STAGE(PG8_SB(1, 0), cB + kstep, voffB); PG8_STAGE(PG8_SA(1, 0), cA + kstep, voffA); PG8_STAGE(PG8_SB(1, 1), cB + hstep + kstep, voffB);
        PG8_WAIT_V(6); PG8_BAR;
    } else {
        PG8_STAGE(PG8_SB(0, 0), cB, voffB); PG8_STAGE(PG8_SA(0, 0), cA, voffA); PG8_STAGE(PG8_SB(0, 1), cB + hstep, voffB); PG8_STAGE(PG8_SA(0, 1), cA + hstep, voffA);
        if (wr == 1) PG8_BAR;
        PG8_WAIT_V(4); PG8_BAR;
        PG8_STAGE(PG8_SB(1, 0), cB + kstep, voffB); PG8_STAGE(PG8_SA(1, 0), cA + kstep, voffA); PG8_STAGE(PG8_SB(1, 1), cB + hstep + kstep, voffB);
        PG8_WAIT_V(6); PG8_BAR;
    }
    for (;;) {
        const bool has_next = S.next(ui + 1, nxt);
        const char* nA = has_next ? (const char*)g.A + (size_t)nxt.pm * tstep : cA; const char* nB = has_next ? (const char*)g.Bt + (size_t)nxt.pn * tstep : cB;
        for (int t = 0; t < nt; t += 2) {
            const bool last = (t == nt - 2);
            const char* a1 = cA + (size_t)(t + 1) * kstep;
            const char* a2 = last ? nA : cA + (size_t)(t + 2) * kstep; const char* b2 = last ? nB : cB + (size_t)(t + 2) * kstep;
            const char* a3 = a2 + kstep; const char* b3 = b2 + kstep;
            if (last && has_next) S.a_ready(nxt);
            if constexpr (SP2) {
            PG8_LDB(B0, 0, 0); PG8_LDB(B1, 0, 1); PG8_SCHED; PG8_LDA(At, 0, 0); PG8_STAGE(PG8_SA(1, 1), a1 + hstep, voffA);
            PG8_WAIT_V(8); PG8_WAIT_L(0); PG8_BAR; PG8_MMA(0, 0, At, B0); PG8_MMA(0, 1, At, B1); PG8_BAR; PG8_SCHED;
            PG8_LDA(At, 0, 1); PG8_STAGE(PG8_SB(0, 0), b2, voffB); PG8_STAGE(PG8_SB(0, 1), b2 + hstep, voffB); PG8_STAGE(PG8_SA(0, 0), a2, voffA);
            PG8_WAIT_V(8); PG8_WAIT_L(0); PG8_BAR; PG8_MMA(1, 0, At, B0); PG8_MMA(1, 1, At, B1); PG8_BAR; PG8_SCHED;
            PG8_LDB(B0, 1, 0); PG8_LDB(B1, 1, 1); PG8_SCHED; PG8_LDA(At, 1, 0); PG8_STAGE(PG8_SA(0, 1), a2 + hstep, voffA);
            PG8_WAIT_V(8); PG8_WAIT_L(0); PG8_BAR; PG8_MMA(0, 0, At, B0); PG8_MMA(0, 1, At, B1); PG8_BAR; PG8_SCHED;
            PG8_LDA(At, 1, 1); PG8_STAGE(PG8_SB(1, 0), b3, voffB); PG8_STAGE(PG8_SB(1, 1), b3 + hstep, voffB); PG8_STAGE(PG8_SA(1, 0), a3, voffA);
            PG8_WAIT_V(8); PG8_WAIT_L(0); PG8_BAR; PG8_MMA(1, 0, At, B0); PG8_MMA(1, 1, At, B1); PG8_BAR; PG8_SCHED;
            } else {
            PG8_LDB(B0, 0, 0); PG8_SCHED; PG8_LDA(At, 0, 0); PG8_STAGE(PG8_SA(1, 1), a1 + hstep, voffA);
            PG8_WAIT_L(8); PG8_BAR; PG8_WAIT_L(0); PG8_MMA(0, 0, At, B0); PG8_BAR; PG8_SCHED;
            PG8_LDB(B1, 0, 1); PG8_STAGE(PG8_SB(0, 0), b2, voffB);
            PG8_BAR; PG8_WAIT_L(0); PG8_MMA(0, 1, At, B1); PG8_BAR;
            PG8_LDA(At, 0, 1); PG8_STAGE(PG8_SA(0, 0), a2, voffA);
            PG8_BAR; PG8_WAIT_L(0); PG8_MMA(1, 0, At, B0); PG8_BAR; PG8_SCHED;
            PG8_STAGE(PG8_SB(0, 1), b2 + hstep, voffB);
            PG8_WAIT_V(6); PG8_BAR; PG8_MMA(1, 1, At, B1); PG8_BAR;
            PG8_LDB(B0, 1, 0); PG8_SCHED; PG8_LDA(At, 1, 0); PG8_STAGE(PG8_SA(0, 1), a2 + hstep, voffA);
            PG8_WAIT_L(8); PG8_BAR; PG8_WAIT_L(0); PG8_MMA(0, 0, At, B0); PG8_BAR; PG8_SCHED;
            PG8_LDB(B1, 1, 1); PG8_STAGE(PG8_SB(1, 0), b3, voffB);
            PG8_BAR; PG8_WAIT_L(0); PG8_MMA(0, 1, At, B1); PG8_BAR;
            PG8_LDA(At, 1, 1); PG8_STAGE(PG8_SA(1, 0), a3, voffA);
            PG8_BAR; PG8_WAIT_L(0); PG8_MMA(1, 0, At, B0); PG8_BAR; PG8_SCHED;
            PG8_STAGE(PG8_SB(1, 1), b3 + hstep, voffB);
            PG8_WAIT_V(6); PG8_BAR; PG8_MMA(1, 1, At, B1); PG8_BAR;
            }
        }
        if constexpr (ALIGN_EPI) { if (wr == 0) PG8_BAR; }
        if constexpr (!Epi::AFTER_DRAIN) { E(acc, cur, wr, wc, fr, fq); S.done(cur); }
        if (!has_next) break;
#pragma unroll
        for (int a = 0; a < 2; ++a)
#pragma unroll
            for (int b = 0; b < 2; ++b)
#pragma unroll
                for (int m = 0; m < 4; ++m)
#pragma unroll
                    for (int n = 0; n < 2; ++n) acc[a][b][m][n] = (f32x4){0.f, 0.f, 0.f, 0.f};
        cur = nxt; cA = nA; cB = nB; ++ui;
        if constexpr (ALIGN_EPI) { if (wr == 1) PG8_BAR; }
    }
    PG8_WAIT_V(0);
    if constexpr (!ALIGN_EPI) { if (wr == 0) PG8_BAR; }
    PG8_BAR;
    if constexpr (Epi::AFTER_DRAIN) { E.fused(acc, cur, wr, wc, fr, fq, lds, wid, lane); S.done(cur); }
#undef PG8_SA
#undef PG8_SB
#undef PG8_STAGE
#undef PG8_LDA
#undef PG8_LDB
#undef PG8_MMA
#undef PG8_WAIT_V
#undef PG8_WAIT_L
#undef PG8_BAR
#undef PG8_SCHED
}
}
#define LAS __attribute__((address_space(3)))
typedef unsigned short bf16_t;
typedef short bf16x8 __attribute__((ext_vector_type(8)));
typedef short s16x4 __attribute__((ext_vector_type(4)));
typedef float f32x4 __attribute__((ext_vector_type(4)));
typedef float f32x16 __attribute__((ext_vector_type(16)));
typedef unsigned u32x4 __attribute__((ext_vector_type(4)));
typedef unsigned u32x2 __attribute__((ext_vector_type(2)));
typedef float f32x2_t __attribute__((ext_vector_type(2)));
typedef __bf16 bf16x2_t __attribute__((ext_vector_type(2)));

constexpr int NB = 2, SEQ = 16384, T = NB * SEQ, DM = 1024, DEPTH = 4, DFF = 2816, NGU = 2 * DFF;
constexpr int NIN_SRC = 2208, NPROJ = 3328;
constexpr int PA = 0, PC = 512, PD = 1024, PCQ = 1792, PCKV = 2048, PKR = 2176, PQUP = 2208, PKVUP = 2592, PEND = 3104;
constexpr float LOG2E = 1.4426950408889634f;
constexpr float NORM_EPS = 1e-5f;
constexpr int NWAVES = 8, NTHREADS = 512;
constexpr int LDS_BYTES = 147456;

constexpr size_t MiB = 1u << 20;
constexpr size_t WS_WGU = 0, WS_WD = 88 * MiB, WS_WIN = 132 * MiB, WS_WOUT = 158 * MiB, WS_XB = 166 * MiB;
constexpr size_t WS_H = 230 * MiB, WS_PROJ = 230 * MiB, WS_QB = 438 * MiB, WS_KB = 462 * MiB, WS_VB = 486 * MiB, WS_MIX = 502 * MiB, WS_AUG = 566 * MiB, WS_END = 568 * MiB;
constexpr size_t WGU_L = (size_t)2 * NGU * DM, WGU_F = (size_t)NGU * DM;
constexpr size_t WD_L = (size_t)2 * DM * DFF, WD_F = (size_t)DM * DFF;
constexpr size_t WIN_L = (size_t)NPROJ * DM, WOUT_L = (size_t)DM * DM;

struct Params {
    const float* x; const float* w_in; const float* win_sink; const float* mla_q_norm; const float* mla_w_uq; const float* mla_kv_norm; const float* mla_w_ukv;
    const float* ax_q_norm; const float* ax_k_norm; const float* diff_lambda; const float* diff_subln; const float* w_out; const float* ffn_w_gu; const float* ffn_w_down;
    const float* ln_g; const float* ln_b;
    float* out; unsigned char* ws;
    float lam_init[4];
    float inv32[16];
};

typedef const __attribute__((address_space(4))) Params* KP;
#define GETP(name) KP name = (KP)__builtin_amdgcn_kernarg_segment_ptr(); asm volatile("" : "+s"(name))

__device__ __forceinline__ int tid_fresh() { int t = threadIdx.x; asm volatile("" : "+v"(t)); return t; }
__device__ __forceinline__ unsigned pkbf(float lo, float hi) { f32x2_t v = {lo, hi}; bf16x2_t b = __builtin_convertvector(v, bf16x2_t); return __builtin_bit_cast(unsigned, b); }
__device__ __forceinline__ float bflo(unsigned w) { return __builtin_bit_cast(float, w << 16); }
__device__ __forceinline__ float bfhi(unsigned w) { return __builtin_bit_cast(float, w & 0xffff0000u); }
__device__ __forceinline__ float wave_sum(float v) {
#pragma unroll
    for (int o = 1; o < 64; o <<= 1) v += __shfl_xor(v, o);
    return v;
}
__device__ __forceinline__ void unpack8(const u32x4 w, float (&v)[8]) {
    v[0] = bflo(w.x); v[1] = bfhi(w.x); v[2] = bflo(w.y); v[3] = bfhi(w.y); v[4] = bflo(w.z); v[5] = bfhi(w.z); v[6] = bflo(w.w); v[7] = bfhi(w.w);
}
__device__ __forceinline__ u32x4 pack8(const float (&v)[8]) { u32x4 w; w.x = pkbf(v[0], v[1]); w.y = pkbf(v[2], v[3]); w.z = pkbf(v[4], v[5]); w.w = pkbf(v[6], v[7]); return w; }

__device__ __forceinline__ void transpose_item(const float* __restrict__ W, int ldw, int src_col0, float scale, bf16_t* __restrict__ WT, int K, int dst_row0, int k0, LAS float* scr, int lane) {
    if (src_col0 < 0) {
        const int c = lane & 7;
#pragma unroll
        for (int j = 0; j < 4; ++j) { const int n = (lane >> 3) + 8 * j; *(u32x4*)(WT + (size_t)(dst_row0 + n) * K + k0 + 8 * c) = (u32x4){0u, 0u, 0u, 0u}; }
        return;
    }
#pragma unroll 8
    for (int i = 0; i < 32; ++i) { const int kk = 2 * i + (lane >> 5); scr[kk * 33 + (lane & 31)] = W[(size_t)(k0 + kk) * ldw + src_col0 + (lane & 31)] * scale; }
    asm volatile("s_waitcnt lgkmcnt(0)" ::: "memory");
    const int c = lane & 7;
#pragma unroll
    for (int j = 0; j < 4; ++j) { const int n = (lane >> 3) + 8 * j; const LAS float* s = scr + (8 * c) * 33 + n;
        u32x4 o; o.x = pkbf(s[0 * 33], s[1 * 33]); o.y = pkbf(s[2 * 33], s[3 * 33]); o.z = pkbf(s[4 * 33], s[5 * 33]); o.w = pkbf(s[6 * 33], s[7 * 33]);
        *(u32x4*)(WT + (size_t)(dst_row0 + n) * K + k0 + 8 * c) = o; }
    asm volatile("s_waitcnt lgkmcnt(0)" ::: "memory");
}

__device__ __forceinline__ void phase0(KP p, LAS unsigned char* lds, int vcu, int G) {
    const int tid = tid_fresh(), lane = tid & 63, wave = __builtin_amdgcn_readfirstlane(tid >> 6);
    LAS float* scr = (LAS float*)(lds + wave * 16384);
    const int gw = vcu * NWAVES + wave, NGW = G * NWAVES;
    bf16_t* wgu = (bf16_t*)(p->ws + WS_WGU); bf16_t* wd = (bf16_t*)(p->ws + WS_WD); bf16_t* win = (bf16_t*)(p->ws + WS_WIN); bf16_t* wout = (bf16_t*)(p->ws + WS_WOUT);
    constexpr int I_GU = 176 * 16, I_WD = 32 * 44, I_IN = 104 * 16, I_OUT = 32 * 16, I_CMP = 112 * 16;
    constexpr int I_LAYER = 2 * I_GU + 2 * I_WD + I_IN + I_OUT + I_CMP;
    for (int it = gw; it < DEPTH * I_LAYER; it += NGW) {
        const int l = it / I_LAYER; int r = it % I_LAYER;
        if (r < 2 * I_GU) { const int f = r / I_GU; r %= I_GU; const int nb = r / 16, kb = r % 16; const int n0 = 32 * nb;
            const int pn = n0 >> 8, bj = (n0 >> 7) & 1, i0 = n0 & 127;
            transpose_item(p->ffn_w_gu + ((size_t)l * 2 + f) * DM * NGU, NGU, bj * DFF + 128 * pn + i0, 1.f, wgu + l * WGU_L + f * WGU_F, DM, n0, 64 * kb, scr, lane); continue; }
        r -= 2 * I_GU;
        if (r < 2 * I_WD) { const int f = r / I_WD; r %= I_WD; const int nb = r / 44, kb = r % 44;
            transpose_item(p->ffn_w_down + ((size_t)l * 2 + f) * DFF * DM, DM, 32 * nb, 1.f, wd + l * WD_L + f * WD_F, DFF, 32 * nb, 64 * kb, scr, lane); continue; }
        r -= 2 * I_WD;
        if (r < I_IN) { const int nb = r / 16, kb = r % 16; const int n0 = 32 * nb; int src; float sc = 1.f;
            if (n0 < PC) { src = n0; if (n0 < 256) sc = 0.125f; }
            else if (n0 < PD) src = 928 + (n0 - PC);
            else if (n0 < PCQ) { src = 1440 + (n0 - PD); if (n0 - PD < 256) sc = 0.17677669529663687f; }
            else if (n0 < PCKV) src = 512 + (n0 - PCQ);
            else if (n0 < PKR) src = 768 + (n0 - PCKV);
            else if (n0 < PQUP) src = 896;
            else if (n0 < PEND) continue;
            else src = -1;
            transpose_item(p->w_in + (size_t)l * DM * NIN_SRC, NIN_SRC, src, sc, win + l * WIN_L, DM, n0, 64 * kb, scr, lane); continue; }
        r -= I_IN;
        if (r < I_OUT) { const int nb = r / 16, kb = r % 16;
            transpose_item(p->w_out + (size_t)l * DM * DM, DM, 32 * nb, 1.f, wout + l * WOUT_L, DM, 32 * nb, 64 * kb, scr, lane); continue; }
        r -= I_OUT;
        {
            const int ng = r / 16, kb = r % 16; const int n0 = 8 * ng; const int k = 64 * kb + lane;
            int J, cA, ldu, nc; const float* g; const float* U;
            if (n0 < 384) { J = 256; cA = 512; g = p->mla_q_norm + l * 256; U = p->mla_w_uq + (size_t)l * 256 * 384; ldu = 384; nc = n0; }
            else { J = 128; cA = 768; g = p->mla_kv_norm + l * 128; U = p->mla_w_ukv + (size_t)l * 128 * 512; ldu = 512; nc = n0 - 384; }
            const float* a = p->w_in + (size_t)l * DM * NIN_SRC + (size_t)k * NIN_SRC + cA;
            float acc[8];
#pragma unroll
            for (int e = 0; e < 8; ++e) acc[e] = 0.f;
            for (int j = 0; j < J; j += 4) {
                const f32x4 av = *(const f32x4*)(a + j);
#pragma unroll
                for (int jj = 0; jj < 4; ++jj) { const float ag = av[jj] * g[j + jj]; const float* ur = U + (size_t)(j + jj) * ldu + nc;
#pragma unroll
                    for (int e = 0; e < 8; ++e) acc[e] = fmaf(ag, ur[e], acc[e]); }
            }
            bf16_t* o = win + l * WIN_L + (size_t)(PQUP + n0) * DM + k;
#pragma unroll
            for (int e = 0; e < 8; ++e) o[(size_t)e * DM] = (bf16_t)(pkbf(acc[e], 0.f) & 0xffffu);
        }
    }
    { u32x4* ag = (u32x4*)(p->ws + WS_AUG);
      for (int i = (vcu * NWAVES + wave) * 64 + lane; i < SEQ * 4; i += G * NWAVES * 64) { const int t = i >> 2, h = i & 3;
          const float sl = __builtin_amdgcn_exp2f(-(float)(5 + h));
          u32x4 w = {pkbf(sl * (float)(128 * (t >> 7)), sl * (float)(t & 127)), 0u, 0u, 0u}; ag[2 * i] = w; ag[2 * i + 1] = (u32x4){0u, 0u, 0u, 0u}; } }
    bf16_t* xb = (bf16_t*)(p->ws + WS_XB);
    for (int m = gw; m < T; m += NGW) {
        const f32x4* xr = (const f32x4*)(p->x + (size_t)m * DM) + lane; u32x2* o8 = (u32x2*)(xb + (size_t)m * DM) + lane;
#pragma unroll
        for (int j = 0; j < 4; ++j) { const f32x4 v = xr[64 * j]; u32x2 w; w.x = pkbf(v.x, v.y); w.y = pkbf(v.z, v.w); o8[64 * j] = w; }
    }
}

__device__ __forceinline__ void ln_phase(float* X, bf16_t* xb, const float* __restrict__ g, const float* __restrict__ b, int vcu, int G) {
    const int tid = tid_fresh(), lane = tid & 63, wave = __builtin_amdgcn_readfirstlane(tid >> 6);
    const int gw = vcu * NWAVES + wave, NGW = G * NWAVES;
    f32x4 gv[4], bv[4];
#pragma unroll
    for (int j = 0; j < 4; ++j) { gv[j] = ((const f32x4*)g)[64 * j + lane]; bv[j] = ((const f32x4*)b)[64 * j + lane]; }
    for (int m = gw; m < T; m += NGW) {
        f32x4* xr = (f32x4*)(X + (size_t)m * DM) + lane; u32x2* o8 = (u32x2*)(xb + (size_t)m * DM) + lane;
        f32x4 v[4]; float s = 0.f;
#pragma unroll
        for (int j = 0; j < 4; ++j) { v[j] = xr[64 * j]; s += (v[j].x + v[j].y) + (v[j].z + v[j].w); }
        const float mean = wave_sum(s) * (1.f / DM); float s2 = 0.f;
#pragma unroll
        for (int j = 0; j < 4; ++j) { v[j] = v[j] - mean; s2 += (v[j].x * v[j].x + v[j].y * v[j].y) + (v[j].z * v[j].z + v[j].w * v[j].w); }
        const float rstd = 1.f / sqrtf(wave_sum(s2) * (1.f / DM) + NORM_EPS);
#pragma unroll
        for (int j = 0; j < 4; ++j) { const f32x4 y = v[j] * rstd * gv[j] + bv[j]; xr[64 * j] = y; u32x2 w; w.x = pkbf(y.x, y.y); w.y = pkbf(y.z, y.w); o8[64 * j] = w; }
    }
}

__device__ __forceinline__ void sincos_rev(float ang, float& s, float& c) {
    double d = (double)ang * 0.15915494309189535; d -= __builtin_rint(d); const float f = (float)d;
    s = __builtin_amdgcn_sinf(f); c = __builtin_amdgcn_cosf(f);
}
__device__ __forceinline__ void rope8(float (&v)[8], bool first, float pos, int i0, KP p) {
#pragma unroll
    for (int e = 0; e < 8; ++e) {
        const float other = __shfl_xor(v[e], 2);
        const float inv = i0 ? p->inv32[8 + e] : p->inv32[e];
        float s, c; sincos_rev(pos * inv, s, c);
        v[e] = first ? (v[e] * c - other * s) : (other * s + v[e] * c);
    }
}
__device__ __forceinline__ void prep_phase(KP p, int l, int vcu, int G) {
    const int tid = tid_fresh(), lane = tid & 63, wave = __builtin_amdgcn_readfirstlane(tid >> 6);
    const int gw = vcu * NWAVES + wave, NGW = G * NWAVES;
    bf16_t* proj = (bf16_t*)(p->ws + WS_PROJ); bf16_t* qb = (bf16_t*)(p->ws + WS_QB); bf16_t* kb = (bf16_t*)(p->ws + WS_KB); bf16_t* vb = (bf16_t*)(p->ws + WS_VB);
    float cg[8];
    { const float* gsrc = (lane < 32 ? p->ax_q_norm : p->ax_k_norm) + l * 64 + 8 * (lane & 7);
#pragma unroll
      for (int e = 0; e < 8; ++e) cg[e] = gsrc[e]; }
    for (int tok = gw; tok < T; tok += NGW) {
        const int t = tok & (SEQ - 1);
        bf16_t* pr = proj + (size_t)tok * NPROJ;
        float ssq = 0.f;
        if (lane < 48) { float v[8]; unpack8(*(const u32x4*)(pr + PCQ + 8 * lane), v);
#pragma unroll
            for (int e = 0; e < 8; ++e) ssq += v[e] * v[e]; }
        const float ssq_q = wave_sum(lane < 32 ? ssq : 0.f), ssq_kv = wave_sum(lane >= 32 ? ssq : 0.f);
        const float rstd_q = 1.f / sqrtf(ssq_q * (1.f / 256.f) + NORM_EPS), rstd_kv = 1.f / sqrtf(ssq_kv * (1.f / 128.f) + NORM_EPS);
        {
            const int r = lane % 12; float v[8];
            if (lane < 48) unpack8(*(const u32x4*)(pr + PQUP + 8 * lane), v); else {
#pragma unroll
                for (int e = 0; e < 8; ++e) v[e] = 0.f; }
#pragma unroll
            for (int e = 0; e < 8; ++e) v[e] *= rstd_q;
            float w[8];
#pragma unroll
            for (int e = 0; e < 8; ++e) w[e] = v[e];
            rope8(w, r < 10, (float)t, 8 * (r & 1), p);
            const bool isr = (r >= 8); const float qs = 0.10206207261596575f;
#pragma unroll
            for (int e = 0; e < 8; ++e) v[e] = (isr ? w[e] : v[e]) * qs;
            if (lane < 48) *(u32x4*)(qb + (size_t)tok * 384 + 8 * lane) = pack8(v);
        }
        {
            float v[8]; unpack8(*(const u32x4*)(pr + PKVUP + 8 * lane), v);
#pragma unroll
            for (int e = 0; e < 8; ++e) v[e] *= rstd_kv;
            const int hd = lane >> 4, r = lane & 15;
            if (r < 8) *(u32x4*)(kb + (size_t)tok * 384 + hd * 96 + 8 * r) = pack8(v);
            else *(u32x4*)(vb + (size_t)tok * 256 + hd * 64 + 8 * (r - 8)) = pack8(v);
        }
        {
            float v[8];
            if (lane < 4) unpack8(*(const u32x4*)(pr + PKR + 8 * lane), v); else {
#pragma unroll
                for (int e = 0; e < 8; ++e) v[e] = 0.f; }
            rope8(v, (lane & 3) < 2, (float)t, 8 * (lane & 1), p);
            if (lane < 4) { const u32x4 w = pack8(v);
#pragma unroll
                for (int hd = 0; hd < 4; ++hd) *(u32x4*)(kb + (size_t)tok * 384 + hd * 96 + 64 + 8 * lane) = w; }
        }
        {
            float v[8];
            if (lane < 48) unpack8(*(const u32x4*)(pr + PC + 8 * lane), v); else {
#pragma unroll
                for (int e = 0; e < 8; ++e) v[e] = 0.f; }
            float s = 0.f;
#pragma unroll
            for (int e = 0; e < 8; ++e) s += v[e] * v[e];
            s += __shfl_xor(s, 1); s += __shfl_xor(s, 2); s += __shfl_xor(s, 4);
            const float rs = 1.f / sqrtf(s * (1.f / 64.f) + NORM_EPS);
#pragma unroll
            for (int e = 0; e < 8; ++e) v[e] = v[e] * rs * cg[e];
            const int r = lane & 7; const float pos = (r < 4) ? (float)(t >> 6) : (float)(t & 63);
            rope8(v, (r & 3) < 2, pos, 8 * (r & 1), p);
            if (lane < 32) {
#pragma unroll
                for (int e = 0; e < 8; ++e) v[e] *= 0.125f; }
            if (lane < 48) *(u32x4*)(pr + PC + 8 * lane) = pack8(v);
        }
    }
}

#ifndef ATT_TYPES
#define ATT_TYPES 15
#endif
namespace att {
typedef float f32x2 __attribute__((ext_vector_type(2)));
constexpr int VPITCH = 144, KBUF = 64 * 208, VBUF = 64 * VPITCH;
constexpr int ATT_LDS = 2 * KBUF + 2 * VBUF;
constexpr float RESCALE_T = 5.0f;
__device__ __forceinline__ s16x4 vtr(const LAS char* p) { return __builtin_bit_cast(s16x4, __builtin_amdgcn_ds_read_tr16_b64_v4i16((LAS s16x4*)p)); }
__device__ __forceinline__ void xhalf_swap(float m, float& a, float& b) {
    a = m; b = m;
    asm volatile("s_nop 1\n\tv_permlane32_swap_b32 %0, %1\n\ts_nop 1" : "+v"(a), "+v"(b));
}
__device__ __forceinline__ float xhalf_max(float m) { float a, b; xhalf_swap(m, a, b); return fmaxf(a, b); }
__device__ __forceinline__ float xhalf_sum(float m) { float a, b; xhalf_swap(m, a, b); return a + b; }
__device__ __forceinline__ float max3f(float a, float b, float c) { return fmaxf(fmaxf(a, b), c); }
#define ATT_MFMA(a, b, c) __builtin_amdgcn_mfma_f32_32x32x16_bf16((a), (b), (c), 0, 0, 0)

template <int DK, int MODE>
__device__ __forceinline__ void flash_pass(LAS char* lds, const bf16_t* __restrict__ Qg, int qp, const bf16_t* __restrict__ Kg, int kp, const bf16_t* __restrict__ Vg, int vp,
                                           const bf16_t* __restrict__ AUGg, int q0, int kt0, int nt, int koff, float slope, f32x16& O0, f32x16& O1, float& Mout, float& Lout) {
    constexpr int DKL = DK + (MODE == 1 ? 16 : 0);
    constexpr int KPITCH = DKL * 2 + 16, NKC = 8 * DKL, CPR = DKL / 8, NKS = DK / 16;
    const int tid = tid_fresh(), lane = tid & 63, r32 = lane & 31, hi = lane >> 5; const int wid = __builtin_amdgcn_readfirstlane(tid >> 6);
    const int qrow = q0 + wid * 32 + r32;
    bf16x8 qf[NKS];
#pragma unroll
    for (int ks = 0; ks < NKS; ++ks) qf[ks] = *(const bf16x8*)(Qg + (size_t)qrow * qp + 16 * ks + 8 * hi);
    const int kc1 = tid + 512;
    const bool k0v = tid < NKC, k1v = kc1 < NKC;
    const int kr0 = tid / CPR, kcc0 = tid % CPR, kr1 = kc1 / CPR, kcc1 = kc1 % CPR, vr = tid >> 3, vcc = tid & 7;
    const bf16_t* kg0; size_t kst0;
    if (MODE == 1 && kcc0 >= DK / 8) { kg0 = AUGg + (size_t)kr0 * 64 + 8 * (kcc0 - DK / 8); kst0 = (size_t)64 * 64; } else { kg0 = Kg + (size_t)kr0 * kp + 8 * kcc0; kst0 = (size_t)64 * kp; }
    const bf16_t* kg1 = Kg + (size_t)kr1 * kp + 8 * kcc1; const size_t kst1 = (size_t)64 * kp;
    const bf16_t* vg = Vg + (size_t)vr * vp + 8 * vcc; const size_t vst = (size_t)64 * vp;
    const int kl0 = kr0 * KPITCH + 16 * kcc0, kl1 = kr1 * KPITCH + 16 * kcc1, vl = 2 * KBUF + vr * VPITCH + 16 * vcc;
    u32x4 rk0 = {0u, 0u, 0u, 0u}, rk1 = {0u, 0u, 0u, 0u}, rv;
#define ATT_KT(i) (kt0 + (((koff) + (i)) >= nt ? ((koff) + (i)) - nt : ((koff) + (i))))
#define ATT_LOAD(kt) do { const size_t t_ = (size_t)(kt); if (k0v) rk0 = *(const u32x4*)(kg0 + t_ * kst0); if (k1v) rk1 = *(const u32x4*)(kg1 + t_ * kst1); rv = *(const u32x4*)(vg + t_ * vst); } while (0)
#define ATT_STORE(buf) do { if (k0v) *(LAS u32x4*)(lds + (buf) * KBUF + kl0) = rk0; if (k1v) *(LAS u32x4*)(lds + (buf) * KBUF + kl1) = rk1; *(LAS u32x4*)(lds + (buf) * VBUF + vl) = rv; } while (0)
    ATT_LOAD(ATT_KT(0)); ATT_STORE(0);
    __syncthreads();
    float M = -1e20f, L = 0.f;
#pragma unroll
    for (int i = 0; i < 16; ++i) { O0[i] = 0.f; O1[i] = 0.f; }
    const int q4 = (lane & 15) >> 2, p4 = lane & 3, b16 = (lane >> 4) & 1;
    const int vbase = (4 * hi + q4) * VPITCH + 32 * b16 + 8 * p4;
    const int kbase = r32 * KPITCH + 16 * hi;
    const int qw = q0 + wid * 32;
    const float stq = slope * (float)qrow;
    bf16x8 qpos = {0, 0, 0, 0, 0, 0, 0, 0}, qneg = {0, 0, 0, 0, 0, 0, 0, 0};
    if (MODE == 1 && hi == 0) { qpos[0] = (short)0x3F80; qpos[1] = (short)0x3F80; qneg[0] = (short)0xBF80; qneg[1] = (short)0xBF80; }
    for (int i = 0; i < nt; ++i) {
        const int kt = ATT_KT(i);
        const int cur = i & 1; const bool more = (i + 1 < nt);
        if (more) ATT_LOAD(ATT_KT(i + 1));
        const int k0 = kt * 64;
        bool active = true;
        if (MODE == 2) active = !(k0 + 63 < qw - 128 || k0 > qw + 31 + 128);
        if (active) {
            const LAS char* Kb = lds + cur * KBUF + kbase; const LAS char* Vb = lds + 2 * KBUF + cur * VBUF + vbase;
            f32x16 s0, s1;
#pragma unroll
            for (int e = 0; e < 16; ++e) { s0[e] = 0.f; s1[e] = 0.f; }
#pragma unroll
            for (int ks = 0; ks < NKS; ++ks) {
                const bf16x8 a0 = *(const LAS bf16x8*)(Kb + 32 * ks), a1 = *(const LAS bf16x8*)(Kb + 32 * KPITCH + 32 * ks);
                s0 = ATT_MFMA(a0, qf[ks], s0); s1 = ATT_MFMA(a1, qf[ks], s1);
            }
            float rc = 0.f;
            if (MODE == 1) {
                const bool left = (k0 + 63 < qw), right = (k0 > qw + 31);
                if (left || right) {
                    const bf16x8 a0 = *(const LAS bf16x8*)(Kb + 32 * NKS), a1 = *(const LAS bf16x8*)(Kb + 32 * KPITCH + 32 * NKS);
                    const bf16x8 qa = left ? qpos : qneg;
                    s0 = ATT_MFMA(a0, qa, s0); s1 = ATT_MFMA(a1, qa, s1);
                    rc = left ? -stq : stq;
                } else {
                    const float dbase = (float)(k0 + 4 * hi - qrow);
#pragma unroll
                    for (int e = 0; e < 16; ++e) { const float c = (float)((e & 3) + 8 * (e >> 2));
                        s0[e] = fmaf(-slope, fabsf(dbase + c), s0[e]); s1[e] = fmaf(-slope, fabsf(dbase + (c + 32.f)), s1[e]); }
                }
            }
            if (MODE == 2) {
                const float dbase = (float)(k0 + 4 * hi - qrow);
#pragma unroll
                for (int e = 0; e < 16; ++e) { const float c = (float)((e & 3) + 8 * (e >> 2));
                    const float d0 = fabsf(dbase + c), d1 = fabsf(dbase + (c + 32.f));
                    s0[e] = (d0 <= 128.f) ? fmaf(-slope, d0, s0[e]) : -1e30f; s1[e] = (d1 <= 128.f) ? fmaf(-slope, d1, s1[e]) : -1e30f; }
            }
            float mx = max3f(s0[0], s1[0], s0[1]);
#pragma unroll
            for (int e = 1; e < 15; e += 2) { mx = max3f(mx, s1[e], s0[e + 1]); mx = max3f(mx, s1[e + 1], s0[e + 2 > 15 ? 15 : e + 2]); }
            mx = fmaxf(mx, s1[15]);
            const float mt = xhalf_max(mx) + rc;
            if (__builtin_amdgcn_ballot_w64(mt > M + RESCALE_T) != 0ull) {
                const float Mn = fmaxf(M, mt); const float alpha = __builtin_amdgcn_exp2f((M - Mn) * LOG2E); M = Mn;
                L *= alpha;
#pragma unroll
                for (int e = 0; e < 16; ++e) { O0[e] *= alpha; O1[e] *= alpha; }
            }
            const float cc = (rc - M) * LOG2E;
            const f32x2 k2 = {LOG2E, LOG2E}, c2 = {cc, cc};
            f32x2 ps2 = {0.f, 0.f};
#pragma unroll
            for (int e = 0; e < 16; e += 2) {
                f32x2 a = {s0[e], s0[e + 1]}, b = {s1[e], s1[e + 1]};
                a = a * k2 + c2; b = b * k2 + c2;
                a.x = __builtin_amdgcn_exp2f(a.x); a.y = __builtin_amdgcn_exp2f(a.y); b.x = __builtin_amdgcn_exp2f(b.x); b.y = __builtin_amdgcn_exp2f(b.y);
                ps2 += a; ps2 += b;
                s0[e] = a.x; s0[e + 1] = a.y; s1[e] = b.x; s1[e + 1] = b.y;
            }
            L += ps2.x + ps2.y;
            bf16x8 pf[2][2];
#pragma unroll
            for (int st = 0; st < 2; ++st) {
                u32x4 w0, w1;
                w0.x = pkbf(s0[8 * st + 0], s0[8 * st + 1]); w0.y = pkbf(s0[8 * st + 2], s0[8 * st + 3]); w0.z = pkbf(s0[8 * st + 4], s0[8 * st + 5]); w0.w = pkbf(s0[8 * st + 6], s0[8 * st + 7]);
                w1.x = pkbf(s1[8 * st + 0], s1[8 * st + 1]); w1.y = pkbf(s1[8 * st + 2], s1[8 * st + 3]); w1.z = pkbf(s1[8 * st + 4], s1[8 * st + 5]); w1.w = pkbf(s1[8 * st + 6], s1[8 * st + 7]);
                pf[0][st] = __builtin_bit_cast(bf16x8, w0); pf[1][st] = __builtin_bit_cast(bf16x8, w1);
            }
#pragma unroll
            for (int kb = 0; kb < 2; ++kb)
#pragma unroll
                for (int st = 0; st < 2; ++st) {
                    const LAS char* vp0 = Vb + (32 * kb + 16 * st) * VPITCH;
                    { const s16x4 lo = vtr(vp0), hh = vtr(vp0 + 8 * VPITCH); const bf16x8 vf = __builtin_shufflevector(lo, hh, 0, 1, 2, 3, 4, 5, 6, 7); O0 = ATT_MFMA(vf, pf[kb][st], O0); }
                    { const s16x4 lo = vtr(vp0 + 64), hh = vtr(vp0 + 8 * VPITCH + 64); const bf16x8 vf = __builtin_shufflevector(lo, hh, 0, 1, 2, 3, 4, 5, 6, 7); O1 = ATT_MFMA(vf, pf[kb][st], O1); }
                }
        }
        if (more) ATT_STORE(cur ^ 1);
        __syncthreads();
    }
#undef ATT_LOAD
#undef ATT_STORE
#undef ATT_KT
    Mout = M; Lout = L;
}

__device__ __forceinline__ void store_o(bf16_t* orow, const f32x16& O0, const f32x16& O1, int hi) {
#pragma unroll
    for (int g = 0; g < 4; ++g) {
        u32x2 w0, w1; w0.x = pkbf(O0[4 * g], O0[4 * g + 1]); w0.y = pkbf(O0[4 * g + 2], O0[4 * g + 3]); w1.x = pkbf(O1[4 * g], O1[4 * g + 1]); w1.y = pkbf(O1[4 * g + 2], O1[4 * g + 3]);
        *(u32x2*)(orow + 8 * g + 4 * hi) = w0; *(u32x2*)(orow + 32 + 8 * g + 4 * hi) = w1;
    }
}

__device__ __forceinline__ void attn_phase(KP p, int l, LAS char* lds, int vcu, int G) {
    const int tid = tid_fresh(), lane = tid & 63, r32 = lane & 31, hi = lane >> 5; const int wid = __builtin_amdgcn_readfirstlane(tid >> 6);
    const bf16_t* proj = (const bf16_t*)(p->ws + WS_PROJ); const bf16_t* qb = (const bf16_t*)(p->ws + WS_QB); const bf16_t* kb = (const bf16_t*)(p->ws + WS_KB); const bf16_t* vb = (const bf16_t*)(p->ws + WS_VB);
    const bf16_t* aug = (const bf16_t*)(p->ws + WS_AUG);
    bf16_t* mix = (bf16_t*)(p->ws + WS_MIX);
    float lam;
    { const float* lp = p->diff_lambda + l * 128; const float a = (lane < 32) ? lp[lane] * lp[32 + lane] : 0.f, b2 = (lane < 32) ? lp[64 + lane] * lp[96 + lane] : 0.f;
      lam = expf(wave_sum(a)) - expf(wave_sum(b2)) + p->lam_init[l]; }
    const float one_m_li = 1.f - p->lam_init[l];
    for (int u = vcu; u < 2048; u += G) {
        if (!((ATT_TYPES >> (u >> 9)) & 1)) continue;
        const int type = u >> 9, idx = u & 511, bh = idx >> 6, qblk = idx & 63, b = bh >> 2, hd = bh & 3, q0 = qblk * 256;
        const int qrow = q0 + wid * 32 + r32;
        const size_t tok0 = (size_t)b * SEQ;
        bf16_t* orow = mix + (tok0 + qrow) * DM;
        f32x16 O0, O1; float M, L;
        if (type == 0) {
            const float slope = __builtin_amdgcn_exp2f(-(float)(5 + hd));
            const bf16_t* base = proj + tok0 * NPROJ + PD;
            flash_pass<32, 1>(lds, base + 64 * hd, NPROJ, base + 256 + 64 * hd, NPROJ, base + 512 + 64 * hd, NPROJ, aug + 16 * hd, q0, 0, SEQ / 64, q0 / 64, slope, O0, O1, M, L);
            const float i1 = 1.f / xhalf_sum(L);
            f32x16 A0, A1;
#pragma unroll
            for (int i = 0; i < 16; ++i) { A0[i] = O0[i] * i1; A1[i] = O1[i] * i1; }
            flash_pass<32, 1>(lds, base + 64 * hd + 32, NPROJ, base + 256 + 64 * hd + 32, NPROJ, base + 512 + 64 * hd, NPROJ, aug + 16 * hd, q0, 0, SEQ / 64, q0 / 64, slope, O0, O1, M, L);
            const float i2 = lam / xhalf_sum(L);
            float ss = 0.f;
#pragma unroll
            for (int i = 0; i < 16; ++i) { A0[i] -= O0[i] * i2; A1[i] -= O1[i] * i2; ss += A0[i] * A0[i] + A1[i] * A1[i]; }
            ss = xhalf_sum(ss);
            const float rs = one_m_li / sqrtf(ss * (1.f / 64.f) + NORM_EPS);
            const float* sg = p->diff_subln + l * 64;
#pragma unroll
            for (int i = 0; i < 16; ++i) { const int dv = (i & 3) + 8 * (i >> 2) + 4 * hi; A0[i] *= rs * sg[dv]; A1[i] *= rs * sg[32 + dv]; }
            store_o(orow + 768 + 64 * hd, A0, A1, hi);
        } else if (type == 1) {
            flash_pass<96, 0>(lds, qb + tok0 * 384 + 96 * hd, 384, kb + tok0 * 384 + 96 * hd, 384, vb + tok0 * 256 + 64 * hd, 256, nullptr, q0, 0, SEQ / 64, q0 / 64, 0.f, O0, O1, M, L);
            const float il = 1.f / xhalf_sum(L);
#pragma unroll
            for (int i = 0; i < 16; ++i) { O0[i] *= il; O1[i] *= il; }
            store_o(orow + 256 + 64 * hd, O0, O1, hi);
        } else if (type == 2) {
            const bf16_t* base = proj + tok0 * NPROJ + PC; const int hk = hd >> 1;
            flash_pass<64, 0>(lds, base + 64 * hd, NPROJ, base + 256 + 64 * hk, NPROJ, base + 384 + 64 * hk, NPROJ, nullptr, q0, 0, SEQ / 64, q0 / 64, 0.f, O0, O1, M, L);
            const float il = 1.f / xhalf_sum(L);
#pragma unroll
            for (int i = 0; i < 16; ++i) { O0[i] *= il; O1[i] *= il; }
            store_o(orow + 512 + 64 * hd, O0, O1, hi);
        } else {
            const bf16_t* base = proj + tok0 * NPROJ + PA; const int hk = hd >> 1;
            const float slope = __builtin_amdgcn_exp2f(-(float)(1 + hd));
            const int kt0 = (q0 >= 128) ? (q0 - 128) / 64 : 0; int kt1 = (q0 + 256 + 128) / 64; if (kt1 > SEQ / 64) kt1 = SEQ / 64;
            flash_pass<64, 2>(lds, base + 64 * hd, NPROJ, base + 256 + 64 * hk, NPROJ, base + 384 + 64 * hk, NPROJ, nullptr, q0, kt0, kt1 - kt0, 0, slope, O0, O1, M, L);
            const float sink = p->win_sink[l * 4 + hd];
            const float il = 1.f / (xhalf_sum(L) + __builtin_amdgcn_exp2f((sink - M) * LOG2E));
#pragma unroll
            for (int i = 0; i < 16; ++i) { O0[i] *= il; O1[i] *= il; }
            store_o(orow + 64 * hd, O0, O1, hi);
        }
    }
}
}

#define GRID_SYNC() do { __builtin_amdgcn_fence(__ATOMIC_RELEASE, "agent"); grid.sync(); __builtin_amdgcn_fence(__ATOMIC_ACQUIRE, "agent"); } while (0)
#ifndef PH_MASK
#define PH_MASK 255
#endif
__global__ void __launch_bounds__(NTHREADS, 2) mega_fwd(Params p_by_value) {
    extern __shared__ __attribute__((aligned(16))) unsigned char lds_raw[];
    cg::grid_group grid = cg::this_grid();
    LAS unsigned char* lds = (LAS unsigned char*)lds_raw;
#define VCU(G_, bx_) (((G_) % 8 == 0) ? ((bx_) % 8) * ((G_) / 8) + (bx_) / 8 : (bx_))
    const float alpha = 1.681792830507429f;

    if (PH_MASK & 1) { GETP(p); const int G = gridDim.x, bx = blockIdx.x; phase0(p, lds, VCU(G, bx), G); }
    GRID_SYNC();
#pragma unroll 1
    for (int li = 0; li < DEPTH; ++li) {
#pragma unroll 1
        for (int fi = 0; fi < 2; ++fi) {
            if (fi == 1) {
                if (PH_MASK & 2) { GETP(p); int l = li; asm volatile("" : "+s"(l)); const int G = gridDim.x, bx = blockIdx.x;
                  pg8::Gemm g{(const bf16_t*)(p->ws + WS_XB), (const bf16_t*)(p->ws + WS_WIN) + l * WIN_L, T, NPROJ, DM}; pg8::StaticOrder S; S.init(T, NPROJ, G, bx);
                  pg8::EpiStoreBf16 E{(bf16_t*)(p->ws + WS_PROJ), NPROJ};
                  pg8::gemm_phase<pg8::EpiStoreBf16, pg8::StaticOrder, true, true>(lds, g, S, E); }
                GRID_SYNC();
                if (PH_MASK & 4) { GETP(p); int l = li; asm volatile("" : "+s"(l)); const int G = gridDim.x, bx = blockIdx.x; prep_phase(p, l, VCU(G, bx), G); }
                GRID_SYNC();
                if (PH_MASK & 8) { GETP(p); int l = li; asm volatile("" : "+s"(l)); const int G = gridDim.x, bx = blockIdx.x; att::attn_phase(p, l, (LAS char*)lds, VCU(G, bx), G); }
                GRID_SYNC();
                if (PH_MASK & 16) { GETP(p); int l = li; asm volatile("" : "+s"(l)); const int G = gridDim.x, bx = blockIdx.x;
                  pg8::Gemm g{(const bf16_t*)(p->ws + WS_MIX), (const bf16_t*)(p->ws + WS_WOUT) + l * WOUT_L, T, DM, DM}; pg8::StaticOrder S; S.init(T, DM, G, bx);
                  pg8::EpiResid E{p->out, p->out, DM, alpha, 1.0f};
                  pg8::gemm_phase<pg8::EpiResid, pg8::StaticOrder, true, true>(lds, g, S, E); }
                GRID_SYNC();
                if (PH_MASK & 32) { GETP(p); int l = li; asm volatile("" : "+s"(l)); const int G = gridDim.x, bx = blockIdx.x;
                  ln_phase(p->out, (bf16_t*)(p->ws + WS_XB), p->ln_g + (l * 3 + 1) * DM, p->ln_b + (l * 3 + 1) * DM, VCU(G, bx), G); }
                GRID_SYNC();
            }
            if (PH_MASK & 64) { GETP(p); int l = li, f = fi; asm volatile("" : "+s"(l), "+s"(f)); const int G = gridDim.x, bx = blockIdx.x;
              pg8::Gemm g{(const bf16_t*)(p->ws + WS_XB), (const bf16_t*)(p->ws + WS_WGU) + l * WGU_L + f * WGU_F, T, NGU, DM}; pg8::StaticOrder S; S.init(T, NGU, G, bx);
              pg8::EpiSwiGLU E{(bf16_t*)(p->ws + WS_H), DFF};
              pg8::gemm_phase<pg8::EpiSwiGLU, pg8::StaticOrder, true, true>(lds, g, S, E); }
            GRID_SYNC();
            if (PH_MASK & 128) { GETP(p); int l = li, f = fi; asm volatile("" : "+s"(l), "+s"(f)); const int G = gridDim.x, bx = blockIdx.x;
              pg8::Gemm g{(const bf16_t*)(p->ws + WS_H), (const bf16_t*)(p->ws + WS_WD) + l * WD_L + f * WD_F, T, DM, DFF}; pg8::StaticOrder S; S.init(T, DM, G, bx);
              pg8::EpiResid E{(l == 0 && f == 0) ? p->x : (const float*)p->out, p->out, DM, alpha, 0.5f};
              pg8::gemm_phase<pg8::EpiResid, pg8::StaticOrder, true, true>(lds, g, S, E); }
            GRID_SYNC();
            if (PH_MASK & 32) { GETP(p); int l = li, f = fi; asm volatile("" : "+s"(l), "+s"(f)); const int G = gridDim.x, bx = blockIdx.x;
              ln_phase(p->out, (bf16_t*)(p->ws + WS_XB), p->ln_g + (l * 3 + 2 * f) * DM, p->ln_b + (l * 3 + 2 * f) * DM, VCU(G, bx), G); }
            GRID_SYNC();
        }
    }
}

extern "C" void kernel_launch(void* const* d_in, const int* in_sizes, int n_in, void* d_out, int out_size, void* d_ws, size_t ws_size, hipStream_t stream) {
    static int grid = 0;
    if (grid == 0) {
        if (n_in != 16 || in_sizes[0] != T * DM || out_size != T * DM || ws_size < WS_END) { fprintf(stderr, "kernel_launch: unexpected shapes (n_in %d, in0 %d, out %d, ws %zu); nothing launched\n", n_in, n_in > 0 ? in_sizes[0] : -1, out_size, ws_size); grid = -1; return; }
        int dev = 0, cus = 0, per_cu = 0;
        hipGetDevice(&dev); hipDeviceGetAttribute(&cus, hipDeviceAttributeMultiprocessorCount, dev);
        if (hipFuncSetAttribute((const void*)mega_fwd, hipFuncAttributeMaxDynamicSharedMemorySize, LDS_BYTES) != hipSuccess) { fprintf(stderr, "kernel_launch: hipFuncSetAttribute failed\n"); grid = -1; return; }
        if (hipOccupancyMaxActiveBlocksPerMultiprocessor(&per_cu, (const void*)mega_fwd, NTHREADS, LDS_BYTES) != hipSuccess || per_cu < 1) { fprintf(stderr, "kernel_launch: occupancy query gave %d\n", per_cu); per_cu = 1; }
        (void)hipGetLastError();
        grid = cus * 1;
    }
    if (grid < 0) return;
    Params p{};
    p.x = (const float*)d_in[0]; p.w_in = (const float*)d_in[1]; p.win_sink = (const float*)d_in[2]; p.mla_q_norm = (const float*)d_in[3]; p.mla_w_uq = (const float*)d_in[4];
    p.mla_kv_norm = (const float*)d_in[5]; p.mla_w_ukv = (const float*)d_in[6]; p.ax_q_norm = (const float*)d_in[7]; p.ax_k_norm = (const float*)d_in[8]; p.diff_lambda = (const float*)d_in[9];
    p.diff_subln = (const float*)d_in[10]; p.w_out = (const float*)d_in[11]; p.ffn_w_gu = (const float*)d_in[12]; p.ffn_w_down = (const float*)d_in[13]; p.ln_g = (const float*)d_in[14]; p.ln_b = (const float*)d_in[15];
    p.out = (float*)d_out; p.ws = (unsigned char*)d_ws;
    for (int l = 0; l < 4; ++l) p.lam_init[l] = (float)(0.8 - 0.6 * exp(-0.3 * (double)l));
    for (int i = 0; i < 16; ++i) p.inv32[i] = (float)pow(10000.0, -(double)i / 16.0);
    void* args[] = {&p};
    hipError_t e = hipLaunchCooperativeKernel((const void*)mega_fwd, dim3(grid), dim3(NTHREADS), args, LDS_BYTES, stream);
    if (e != hipSuccess) fprintf(stderr, "kernel_launch: cooperative launch failed: %s (grid %d)\n", hipGetErrorString(e), grid);
}
```

```cpp
#include <hip/hip_runtime.h>
#include <hip/hip_cooperative_groups.h>
#include <cstdio>
#include <cstdint>
#include <cmath>
namespace cg = cooperative_groups;
namespace pg8 {
#define PG8_LAS __attribute__((address_space(3)))
typedef unsigned short bf16_t;
typedef short bf16x8 __attribute__((ext_vector_type(8)));
typedef float f32x4 __attribute__((ext_vector_type(4)));
typedef unsigned u32x4 __attribute__((ext_vector_type(4)));
constexpr int BM = 256, BK = 64, HALF = 128, HTB = HALF * BK * 2  , STAGE_BYTES = 8 * HTB, NXCD = 8, WGM = 8;

__host__ __device__ __forceinline__ int lds_byte(int r, int c) { const int st = (r >> 4) * 2 + (c >> 5), rr = r & 15, cc = c & 31, ob = rr * 64 + cc * 2; return st * 1024 + (ob ^ (((ob >> 9) & 1) << 5)); }
__host__ __device__ __forceinline__ void stage_rc(int b, int& R, int& C) { const int st = b / 1024, sb = b % 1024, swz = sb ^ (((sb >> 9) & 1) << 5); R = (st >> 1) * 16 + swz / 64; C = (st & 1) * 32 + (swz % 64) / 2; }
__host__ __device__ __forceinline__ int perm32(int rho) { const int n = rho >> 4, i = rho & 15; return 8 * (i >> 2) + 4 * n + (i & 3); }

struct Unit { int pm, pn; };
struct Gemm { const bf16_t* A; const bf16_t* Bt; int M, N, K; };

struct StaticOrder {
    int nM, nN, nwg, G, c;
    __host__ __device__ void init(int M, int N, int G_, int c_) { nM = M / BM; nN = N / BM; nwg = nM * nN; G = G_; c = c_; }
    __host__ __device__ bool next(int i, Unit& u) const {
        const long L = (long)i * G + c; if (L >= nwg) return false;
        int wgid = (int)L; { const int q = nwg / NXCD, r = nwg % NXCD, xcd = wgid % NXCD, off = wgid / NXCD; wgid = (xcd < r ? xcd * (q + 1) : r * (q + 1) + (xcd - r) * q) + off; }
        const int nig = WGM * nN, gid = wgid / nig, fm = gid * WGM, gsz = (nM - fm) < WGM ? (nM - fm) : WGM;
        u.pm = fm + ((wgid % nig) % gsz); u.pn = (wgid % nig) / gsz; return true;
    }
    __device__ __forceinline__ void a_ready(const Unit&) const {}
    __device__ __forceinline__ void done(const Unit&) const {}
};

__device__ __forceinline__ unsigned cvt_pk_bf16(float lo, float hi) { unsigned r; asm volatile("v_cvt_pk_bf16_f32 %0, %1, %2" : "=v"(r) : "v"(lo), "v"(hi)); return r; }
typedef float f32x2 __attribute__((ext_vector_type(2)));
typedef float f32x2 __attribute__((ext_vector_type(2)));
typedef unsigned u32x2 __attribute__((ext_vector_type(2)));

struct EpiStoreBf16 {
    static constexpr bool PERM = true, AFTER_DRAIN = false;
    bf16_t* O; int ldc;
    __device__ __forceinline__ void operator()(const f32x4 (&acc)[2][2][4][2], const Unit& u, int wr, int wc, int fr, int fq) const {
        const int row0 = u.pm * BM + wr * 64 + fr; const int col0 = u.pn * BM + wc * 32 + 8 * fq;
#pragma unroll
        for (int ai = 0; ai < 2; ++ai)
#pragma unroll
            for (int m = 0; m < 4; ++m) { bf16_t* rowp = O + (size_t)(row0 + ai * HALF + m * 16) * ldc + col0;
#pragma unroll
                for (int bj = 0; bj < 2; ++bj) { const f32x4 v0 = acc[ai][bj][m][0], v1 = acc[ai][bj][m][1];
                    u32x4 w; w.x = cvt_pk_bf16(v0[0], v0[1]); w.y = cvt_pk_bf16(v0[2], v0[3]); w.z = cvt_pk_bf16(v1[0], v1[1]); w.w = cvt_pk_bf16(v1[2], v1[3]);
                    *(u32x4*)(rowp + bj * HALF) = w; } }
    }
};

__device__ __forceinline__ float silu_mul(float g, float u) {
    const float e = __builtin_amdgcn_exp2f(-1.4426950408889634f * g);
    return g * u * __builtin_amdgcn_rcpf(1.0f + e);
}
struct EpiSwiGLU {
    static constexpr bool PERM = true, AFTER_DRAIN = false;
    bf16_t* H; int ldh;
    __device__ __forceinline__ void operator()(const f32x4 (&acc)[2][2][4][2], const Unit& u, int wr, int wc, int fr, int fq) const {
        const int row0 = u.pm * BM + wr * 64 + fr; const int col0 = u.pn * HALF + wc * 32 + 8 * fq;
#pragma unroll
        for (int ai = 0; ai < 2; ++ai)
#pragma unroll
            for (int m = 0; m < 4; ++m) { bf16_t* rowp = H + (size_t)(row0 + ai * HALF + m * 16) * ldh + col0;
                const f32x4 g0 = acc[ai][0][m][0], g1 = acc[ai][0][m][1], u0 = acc[ai][1][m][0], u1 = acc[ai][1][m][1];
                u32x4 w;
                w.x = cvt_pk_bf16(silu_mul(g0[0], u0[0]), silu_mul(g0[1], u0[1])); w.y = cvt_pk_bf16(silu_mul(g0[2], u0[2]), silu_mul(g0[3], u0[3]));
                w.z = cvt_pk_bf16(silu_mul(g1[0], u1[0]), silu_mul(g1[1], u1[1])); w.w = cvt_pk_bf16(silu_mul(g1[2], u1[2]), silu_mul(g1[3], u1[3]));
                *(u32x4*)rowp = w; }
    }
};

struct EpiResid {
    static constexpr bool PERM = false, AFTER_DRAIN = false;
    const float* src; float* dst; int ld; float alpha, beta;
    __device__ __forceinline__ void operator()(const f32x4 (&acc)[2][2][4][2], const Unit& u, int wr, int wc, int fr, int fq) const {
        const int col0 = u.pn * BM + wc * 32 + 4 * fq;
#pragma unroll
        for (int ai = 0; ai < 2; ++ai)
#pragma unroll
            for (int m = 0; m < 4; ++m) { const size_t off = (size_t)(u.pm * BM + ai * HALF + wr * 64 + m * 16 + fr) * ld + col0;
#pragma unroll
                for (int bj = 0; bj < 2; ++bj)
#pragma unroll
                    for (int n = 0; n < 2; ++n) { const f32x4 s = *(const f32x4*)(src + off + bj * HALF + n * 16);
                        *(f32x4*)(dst + off + bj * HALF + n * 16) = s * alpha + acc[ai][bj][m][n] * beta; } }
    }
};
template <class Epi, class Sched, bool ALIGN_EPI = false, bool SP2 = false>
__device__ __forceinline__ void gemm_phase(PG8_LAS unsigned char* lds, const Gemm g, const Sched& S, const Epi& E) {
    int tid_ = threadIdx.x; asm volatile("" : "+v"(tid_));
    const int tid = tid_, wid = __builtin_amdgcn_readfirstlane(tid >> 6), lane = tid & 63, wr = wid >> 2, wc = wid & 3, fr = lane & 15, fq = lane >> 4;
    const int K = g.K, nt = K / BK;
    unsigned voffA[2], voffB[2];
#pragma unroll
    for (int i = 0; i < 2; ++i) { int R, C; stage_rc(tid * 16 + i * 8192, R, C); const int Rb = Epi::PERM ? ((R & ~31) + perm32(R & 31)) : R;
        voffA[i] = (unsigned)(R * K + C) * 2u; voffB[i] = (unsigned)(Rb * K + C) * 2u; }
    const size_t kstep = (size_t)(BK * 2);
    const size_t hstep = (size_t)HALF * K * 2;
    const size_t tstep = 2 * hstep;
    const unsigned ldsw = (unsigned)wid * 1024u;
    const int aoff = lds_byte(wr * 64 + fr, fq * 8), boff = lds_byte(wc * 32 + fr, fq * 8);
#define PG8_SA(b, h) (((b) * 2 + (h)) * HTB)
#define PG8_SB(b, h) ((4 + (b) * 2 + (h)) * HTB)
#define PG8_STAGE(bufoff, gbase, voff) do { _Pragma("unroll") for (int _i = 0; _i < 2; ++_i) \
        __builtin_amdgcn_global_load_lds((const unsigned*)((const char*)(gbase) + (voff)[_i]), (PG8_LAS unsigned*)(lds + (bufoff) + ldsw + _i * 8192), 16, 0, 0); } while (0)
#define PG8_LDA(dst, b, h) do { _Pragma("unroll") for (int m = 0; m < 4; ++m) _Pragma("unroll") for (int k = 0; k < 2; ++k) dst[m][k] = *(const PG8_LAS bf16x8*)(lds + PG8_SA(b, h) + aoff + m * 2048 + k * 1024); } while (0)
#define PG8_LDB(dst, b, h) do { _Pragma("unroll") for (int n = 0; n < 2; ++n) _Pragma("unroll") for (int k = 0; k < 2; ++k) dst[n][k] = *(const PG8_LAS bf16x8*)(lds + PG8_SB(b, h) + boff + n * 2048 + k * 1024); } while (0)
#define PG8_MMA(ai, bj, At, Bt) do { __builtin_amdgcn_s_setprio(1); _Pragma("unroll") for (int m = 0; m < 4; ++m) _Pragma("unroll") for (int n = 0; n < 2; ++n) _Pragma("unroll") for (int k = 0; k < 2; ++k) \
        acc[ai][bj][m][n] = __builtin_amdgcn_mfma_f32_16x16x32_bf16(Bt[n][k], At[m][k], acc[ai][bj][m][n], 0, 0, 0); __builtin_amdgcn_s_setprio(0); } while (0)
#define PG8_WAIT_V(n) asm volatile("s_waitcnt vmcnt(" #n ")" ::: "memory")
#define PG8_WAIT_L(n) asm volatile("s_waitcnt lgkmcnt(" #n ")" ::: "memory")
#define PG8_BAR __builtin_amdgcn_s_barrier()
#define PG8_SCHED __builtin_amdgcn_sched_barrier(0)
    Unit cur, nxt; int ui = 0;
    if (!S.next(0, cur)) return;
    f32x4 acc[2][2][4][2];
#pragma unroll
    for (int a = 0; a < 2; ++a)
#pragma unroll
        for (int b = 0; b < 2; ++b)
#pragma unroll
            for (int m = 0; m < 4; ++m)
#pragma unroll
                for (int n = 0; n < 2; ++n) acc[a][b][m][n] = (f32x4){0.f, 0.f, 0.f, 0.f};
    bf16x8 At[4][2], B0[2][2], B1[2][2];
    const char* cA = (const char*)g.A + (size_t)cur.pm * tstep; const char* cB = (const char*)g.Bt + (size_t)cur.pn * tstep;
    S.a_ready(cur);
    if constexpr (SP2) {
        PG8_STAGE(PG8_SB(0, 0), cB, voffB); PG8_STAGE(PG8_SB(0, 1), cB + hstep, voffB); PG8_STAGE(PG8_SA(0, 0), cA, voffA); PG8_STAGE(PG8_SA(0, 1), cA + hstep, voffA);
        if (wr == 1) PG8_BAR;
        PG8_WAIT_V(2); PG8_BAR;
        PG8_STAGE(PG8_SB(1, 0), cB + kstep, voffB); PG8_STAGE(PG8_SA(1, 0), cA + kstep, voffA); PG8_STAGE(PG8_SB(1, 1), cB + hstep + kstep, voffB);
        PG8_WAIT_V(6); PG8_BAR;
    } else {
        PG8_STAGE(PG8_SB(0, 0), cB, voffB); PG8_STAGE(PG8_SA(0, 0), cA, voffA); PG8_STAGE(PG8_SB(0, 1), cB + hstep, voffB); PG8_STAGE(PG8_SA(0, 1), cA + hstep, voffA);
        if (wr == 1) PG8_BAR;
        PG8_WAIT_V(4); PG8_BAR;
        PG8_STAGE(PG8_SB(1, 0), cB + kstep, voffB); PG8_STAGE(PG8_SA(1, 0), cA + kstep, voffA); PG8_STAGE(PG8_SB(1, 1), cB + hstep + kstep, voffB);
        PG8_WAIT_V(6); PG8_BAR;
    }
    for (;;) {
        const bool has_next = S.next(ui + 1, nxt);
        const char* nA = has_next ? (const char*)g.A + (size_t)nxt.pm * tstep : cA; const char* nB = has_next ? (const char*)g.Bt + (size_t)nxt.pn * tstep : cB;
        for (int t = 0; t < nt; t += 2) {
            const bool last = (t == nt - 2);
            const char* a1 = cA + (size_t)(t + 1) * kstep;
            const char* a2 = last ? nA : cA + (size_t)(t + 2) * kstep; const char* b2 = last ? nB : cB + (size_t)(t + 2) * kstep;
            const char* a3 = a2 + kstep; const char* b3 = b2 + kstep;
            if (last && has_next) S.a_ready(nxt);
            if constexpr (SP2) {
            PG8_LDB(B0, 0, 0); PG8_LDB(B1, 0, 1); PG8_SCHED; PG8_LDA(At, 0, 0); PG8_STAGE(PG8_SA(1, 1), a1 + hstep, voffA);
            PG8_WAIT_V(8); PG8_WAIT_L(0); PG8_BAR; PG8_MMA(0, 0, At, B0); PG8_MMA(0, 1, At, B1); PG8_BAR; PG8_SCHED;
            PG8_LDA(At, 0, 1); PG8_STAGE(PG8_SB(0, 0), b2, voffB); PG8_STAGE(PG8_SB(0, 1), b2 + hstep, voffB); PG8_STAGE(PG8_SA(0, 0), a2, voffA);
            PG8_WAIT_V(8); PG8_WAIT_L(0); PG8_BAR; PG8_MMA(1, 0, At, B0); PG8_MMA(1, 1, At, B1); PG8_BAR; PG8_SCHED;
            PG8_LDB(B0, 1, 0); PG8_LDB(B1, 1, 1); PG8_SCHED; PG8_LDA(At, 1, 0); PG8_STAGE(PG8_SA(0, 1), a2 + hstep, voffA);
            PG8_WAIT_V(8); PG8_WAIT_L(0); PG8_BAR; PG8_MMA(0, 0, At, B0); PG8_MMA(0, 1, At, B1); PG8_BAR; PG8_SCHED;
            PG8_LDA(At, 1, 1); PG8_STAGE(PG8_SB(1, 0), b3, voffB); PG8_STAGE(PG8_SB(1, 1), b3 + hstep, voffB); PG8_STAGE(PG8_SA(1, 0), a3, voffA);
            PG8_WAIT_V(8); PG8_WAIT_L(0); PG8_BAR; PG8_MMA(1, 0, At, B0); PG8_MMA(1, 1, At, B1); PG8_BAR; PG8_SCHED;
            } else {
            PG8_LDB(B0, 0, 0); PG8_SCHED; PG8_LDA(At, 0, 0); PG8_STAGE(PG8_SA(1, 1), a1 + hstep, voffA);
            PG8_WAIT_L(8); PG8_BAR; PG8_WAIT_L(0); PG8_MMA(0, 0, At, B0); PG8_BAR; PG8_SCHED;
            PG8_LDB(B1, 0, 1); PG8_STAGE(PG8_SB(0, 0), b2, voffB);
            PG8_BAR; PG8_WAIT_L(0); PG8_MMA(0, 1, At, B1); PG8_BAR;
            PG8_LDA(At, 0, 1); PG8_STAGE(PG8_SA(0, 0), a2, voffA);
            PG8_BAR; PG8_WAIT_L(0); PG8_MMA(1, 0, At, B0); PG8_BAR; PG8_SCHED;
            PG8_STAGE(PG8_SB(0, 1), b2 + hstep, voffB);
            PG8_WAIT_V(6); PG8_BAR; PG8_MMA(1, 1, At, B1); PG8_BAR;
            PG8_LDB(B0, 1, 0); PG8_SCHED; PG8_LDA(At, 1, 0); PG8_STAGE(PG8_SA(0, 1), a2 + hstep, voffA);
            PG8_WAIT_L(8); PG8_BAR; PG8_WAIT_L(0); PG8_MMA(0, 0, At, B0); PG8_BAR; PG8_SCHED;
            PG8_LDB(B1, 1, 1); PG8_STAGE(PG8_SB(1, 0), b3, voffB);
            PG8_BAR; PG8_WAIT_L(0); PG8_MMA(0, 1, At, B1); PG8_BAR;
            PG8_LDA(At, 1, 1); PG8_STAGE(PG8_SA(1, 0), a3, voffA);
            PG8_BAR; PG8_WAIT_L(0); PG8_MMA(1, 0, At, B0); PG8_BAR; PG8_SCHED;
            PG8_STAGE(PG8_SB(1, 1), b3 + hstep, voffB);
            PG8_WAIT_V(6); PG8_BAR; PG8_MMA(1, 1, At, B1); PG8_BAR;
            }
        }
        if constexpr (ALIGN_EPI) { if (wr == 0) PG8_BAR; }
        if constexpr (!Epi::AFTER_DRAIN) { E(acc, cur, wr, wc, fr, fq); S.done(cur); }
        if (!has_next) break;
#pragma unroll
        for (int a = 0; a < 2; ++a)
#pragma unroll
            for (int b = 0; b < 2; ++b)
#pragma unroll
                for (int m = 0; m < 4; ++m)
#pragma unroll
                    for (int n = 0; n < 2; ++n) acc[a][b][m][n] = (f32x4){0.f, 0.f, 0.f, 0.f};
        cur = nxt; cA = nA; cB = nB; ++ui;
        if constexpr (ALIGN_EPI) { if (wr == 1) PG8_BAR; }
    }
    PG8_WAIT_V(0);
    if constexpr (!ALIGN_EPI) { if (wr == 0) PG8_BAR; }
    PG8_BAR;
    if constexpr (Epi::AFTER_DRAIN) { E.fused(acc, cur, wr, wc, fr, fq, lds, wid, lane); S.done(cur); }
#undef PG8_SA
#undef PG8_SB
#undef PG8_STAGE
#undef PG8_LDA
#undef PG8_LDB
#undef PG8_MMA
#undef PG8_WAIT_V
#undef PG8_WAIT_L
#undef PG8_BAR
#undef PG8_SCHED
}
}
#define LAS __attribute__((address_space(3)))
typedef unsigned short bf16_t;
typedef short bf16x8 __attribute__((ext_vector_type(8)));
typedef short s16x4 __attribute__((ext_vector_type(4)));
typedef float f32x4 __attribute__((ext_vector_type(4)));
typedef float f32x16 __attribute__((ext_vector_type(16)));
typedef unsigned u32x4 __attribute__((ext_vector_type(4)));
typedef unsigned u32x2 __attribute__((ext_vector_type(2)));
typedef float f32x2_t __attribute__((ext_vector_type(2)));
typedef __bf16 bf16x2_t __attribute__((ext_vector_type(2)));

constexpr int NB = 2, SEQ = 16384, T = NB * SEQ, DM = 1024, DEPTH = 4, DFF = 2816, NGU = 2 * DFF;
constexpr int NIN_SRC = 2208, NPROJ = 3328;
constexpr int PA = 0, PC = 512, PD = 1024, PCQ = 1792, PCKV = 2048, PKR = 2176, PQUP = 2208, PKVUP = 2592, PEND = 3104;
constexpr float LOG2E = 1.4426950408889634f;
constexpr float NORM_EPS = 1e-5f;
constexpr int NWAVES = 8, NTHREADS = 512;
constexpr int LDS_BYTES = 147456;

constexpr size_t MiB = 1u << 20;
constexpr size_t WS_WGU = 0, WS_WD = 88 * MiB, WS_WIN = 132 * MiB, WS_WOUT = 158 * MiB, WS_XB = 166 * MiB;
constexpr size_t WS_H = 230 * MiB, WS_PROJ = 230 * MiB, WS_QB = 438 * MiB, WS_KB = 462 * MiB, WS_VB = 486 * MiB, WS_MIX = 502 * MiB, WS_AUG = 566 * MiB, WS_END = 568 * MiB;
constexpr size_t WGU_L = (size_t)2 * NGU * DM, WGU_F = (size_t)NGU * DM;
constexpr size_t WD_L = (size_t)2 * DM * DFF, WD_F = (size_t)DM * DFF;
constexpr size_t WIN_L = (size_t)NPROJ * DM, WOUT_L = (size_t)DM * DM;

struct Params {
    const float* x; const float* w_in; const float* win_sink; const float* mla_q_norm; const float* mla_w_uq; const float* mla_kv_norm; const float* mla_w_ukv;
    const float* ax_q_norm; const float* ax_k_norm; const float* diff_lambda; const float* diff_subln; const float* w_out; const float* ffn_w_gu; const float* ffn_w_down;
    const float* ln_g; const float* ln_b;
    float* out; unsigned char* ws;
    float lam_init[4];
    float inv32[16];
};

typedef const __attribute__((address_space(4))) Params* KP;
#define GETP(name) KP name = (KP)__builtin_amdgcn_kernarg_segment_ptr(); asm volatile("" : "+s"(name))

__device__ __forceinline__ int tid_fresh() { int t = threadIdx.x; asm volatile("" : "+v"(t)); return t; }
__device__ __forceinline__ unsigned pkbf(float lo, float hi) { f32x2_t v = {lo, hi}; bf16x2_t b = __builtin_convertvector(v, bf16x2_t); return __builtin_bit_cast(unsigned, b); }
__device__ __forceinline__ float bflo(unsigned w) { return __builtin_bit_cast(float, w << 16); }
__device__ __forceinline__ float bfhi(unsigned w) { return __builtin_bit_cast(float, w & 0xffff0000u); }
__device__ __forceinline__ float wave_sum(float v) {
#pragma unroll
    for (int o = 1; o < 64; o <<= 1) v += __shfl_xor(v, o);
    return v;
}
__device__ __forceinline__ void unpack8(const u32x4 w, float (&v)[8]) {
    v[0] = bflo(w.x); v[1] = bfhi(w.x); v[2] = bflo(w.y); v[3] = bfhi(w.y); v[4] = bflo(w.z); v[5] = bfhi(w.z); v[6] = bflo(w.w); v[7] = bfhi(w.w);
}
__device__ __forceinline__ u32x4 pack8(const float (&v)[8]) { u32x4 w; w.x = pkbf(v[0], v[1]); w.y = pkbf(v[2], v[3]); w.z = pkbf(v[4], v[5]); w.w = pkbf(v[6], v[7]); return w; }

__device__ __forceinline__ void transpose_item(const float* __restrict__ W, int ldw, int src_col0, float scale, bf16_t* __restrict__ WT, int K, int dst_row0, int k0, LAS float* scr, int lane) {
    if (src_col0 < 0) {
        const int c = lane & 7;
#pragma unroll
        for (int j = 0; j < 4; ++j) { const int n = (lane >> 3) + 8 * j; *(u32x4*)(WT + (size_t)(dst_row0 + n) * K + k0 + 8 * c) = (u32x4){0u, 0u, 0u, 0u}; }
        return;
    }
#pragma unroll 8
    for (int i = 0; i < 32; ++i) { const int kk = 2 * i + (lane >> 5); scr[kk * 33 + (lane & 31)] = W[(size_t)(k0 + kk) * ldw + src_col0 + (lane & 31)] * scale; }
    asm volatile("s_waitcnt lgkmcnt(0)" ::: "memory");
    const int c = lane & 7;
#pragma unroll
    for (int j = 0; j < 4; ++j) { const int n = (lane >> 3) + 8 * j; const LAS float* s = scr + (8 * c) * 33 + n;
        u32x4 o; o.x = pkbf(s[0 * 33], s[1 * 33]); o.y = pkbf(s[2 * 33], s[3 * 33]); o.z = pkbf(s[4 * 33], s[5 * 33]); o.w = pkbf(s[6 * 33], s[7 * 33]);
        *(u32x4*)(WT + (size_t)(dst_row0 + n) * K + k0 + 8 * c) = o; }
    asm volatile("s_waitcnt lgkmcnt(0)" ::: "memory");
}

__device__ __forceinline__ void phase0(KP p, LAS unsigned char* lds, int vcu, int G) {
    const int tid = tid_fresh(), lane = tid & 63, wave = __builtin_amdgcn_readfirstlane(tid >> 6);
    LAS float* scr = (LAS float*)(lds + wave * 16384);
    const int gw = vcu * NWAVES + wave, NGW = G * NWAVES;
    bf16_t* wgu = (bf16_t*)(p->ws + WS_WGU); bf16_t* wd = (bf16_t*)(p->ws + WS_WD); bf16_t* win = (bf16_t*)(p->ws + WS_WIN); bf16_t* wout = (bf16_t*)(p->ws + WS_WOUT);
    constexpr int I_GU = 176 * 16, I_WD = 32 * 44, I_IN = 104 * 16, I_OUT = 32 * 16, I_CMP = 112 * 16;
    constexpr int I_LAYER = 2 * I_GU + 2 * I_WD + I_IN + I_OUT + I_CMP;
    for (int it = gw; it < DEPTH * I_LAYER; it += NGW) {
        const int l = it / I_LAYER; int r = it % I_LAYER;
        if (r < 2 * I_GU) { const int f = r / I_GU; r %= I_GU; const int nb = r / 16, kb = r % 16; const int n0 = 32 * nb;
            const int pn = n0 >> 8, bj = (n0 >> 7) & 1, i0 = n0 & 127;
            transpose_item(p->ffn_w_gu + ((size_t)l * 2 + f) * DM * NGU, NGU, bj * DFF + 128 * pn + i0, 1.f, wgu + l * WGU_L + f * WGU_F, DM, n0, 64 * kb, scr, lane); continue; }
        r -= 2 * I_GU;
        if (r < 2 * I_WD) { const int f = r / I_WD; r %= I_WD; const int nb = r / 44, kb = r % 44;
            transpose_item(p->ffn_w_down + ((size_t)l * 2 + f) * DFF * DM, DM, 32 * nb, 1.f, wd + l * WD_L + f * WD_F, DFF, 32 * nb, 64 * kb, scr, lane); continue; }
        r -= 2 * I_WD;
        if (r < I_IN) { const int nb = r / 16, kb = r % 16; const int n0 = 32 * nb; int src; float sc = 1.f;
            if (n0 < PC) { src = n0; if (n0 < 256) sc = 0.125f; }
            else if (n0 < PD) src = 928 + (n0 - PC);
            else if (n0 < PCQ) { src = 1440 + (n0 - PD); if (n0 - PD < 256) sc = 0.17677669529663687f; }
            else if (n0 < PCKV) src = 512 + (n0 - PCQ);
            else if (n0 < PKR) src = 768 + (n0 - PCKV);
            else if (n0 < PQUP) src = 896;
            else if (n0 < PEND) continue;
            else src = -1;
            transpose_item(p->w_in + (size_t)l * DM * NIN_SRC, NIN_SRC, src, sc, win + l * WIN_L, DM, n0, 64 * kb, scr, lane); continue; }
        r -= I_IN;
        if (r < I_OUT) { const int nb = r / 16, kb = r % 16;
            transpose_item(p->w_out + (size_t)l * DM * DM, DM, 32 * nb, 1.f, wout + l * WOUT_L, DM, 32 * nb, 64 * kb, scr, lane); continue; }
        r -= I_OUT;
        {
            const int ng = r / 16, kb = r % 16; const int n0 = 8 * ng; const int k = 64 * kb + lane;
            int J, cA, ldu, nc; const float* g; const float* U;
            if (n0 < 384) { J = 256; cA = 512; g = p->mla_q_norm + l * 256; U = p->mla_w_uq + (size_t)l * 256 * 384; ldu = 384; nc = n0; }
            else { J = 128; cA = 768; g = p->mla_kv_norm + l * 128; U = p->mla_w_ukv + (size_t)l * 128 * 512; ldu = 512; nc = n0 - 384; }
            const float* a = p->w_in + (size_t)l * DM * NIN_SRC + (size_t)k * NIN_SRC + cA;
            float acc[8];
#pragma unroll
            for (int e = 0; e < 8; ++e) acc[e] = 0.f;
            for (int j = 0; j < J; j += 4) {
                const f32x4 av = *(const f32x4*)(a + j);
#pragma unroll
                for (int jj = 0; jj < 4; ++jj) { const float ag = av[jj] * g[j + jj]; const float* ur = U + (size_t)(j + jj) * ldu + nc;
#pragma unroll
                    for (int e = 0; e < 8; ++e) acc[e] = fmaf(ag, ur[e], acc[e]); }
            }
            bf16_t* o = win + l * WIN_L + (size_t)(PQUP + n0) * DM + k;
#pragma unroll
            for (int e = 0; e < 8; ++e) o[(size_t)e * DM] = (bf16_t)(pkbf(acc[e], 0.f) & 0xffffu);
        }
    }
    { u32x4* ag = (u32x4*)(p->ws + WS_AUG);
      for (int i = (vcu * NWAVES + wave) * 64 + lane; i < SEQ * 4; i += G * NWAVES * 64) { const int t = i >> 2, h = i & 3;
          const float sl = __builtin_amdgcn_exp2f(-(float)(5 + h));
          u32x4 w = {pkbf(sl * (float)(128 * (t >> 7)), sl * (float)(t & 127)), 0u, 0u, 0u}; ag[2 * i] = w; ag[2 * i + 1] = (u32x4){0u, 0u, 0u, 0u}; } }
    bf16_t* xb = (bf16_t*)(p->ws + WS_XB);
    for (int m = gw; m < T; m += NGW) {
        const f32x4* xr = (const f32x4*)(p->x + (size_t)m * DM) + lane; u32x2* o8 = (u32x2*)(xb + (size_t)m * DM) + lane;
#pragma unroll
        for (int j = 0; j < 4; ++j) { const f32x4 v = xr[64 * j]; u32x2 w; w.x = pkbf(v.x, v.y); w.y = pkbf(v.z, v.w); o8[64 * j] = w; }
    }
}

__device__ __forceinline__ void ln_phase(float* X, bf16_t* xb, const float* __restrict__ g, const float* __restrict__ b, int vcu, int G) {
    const int tid = tid_fresh(), lane = tid & 63, wave = __builtin_amdgcn_readfirstlane(tid >> 6);
    const int gw = vcu * NWAVES + wave, NGW = G * NWAVES;
    f32x4 gv[4], bv[4];
#pragma unroll
    for (int j = 0; j < 4; ++j) { gv[j] = ((const f32x4*)g)[64 * j + lane]; bv[j] = ((const f32x4*)b)[64 * j + lane]; }
    for (int m = gw; m < T; m += NGW) {
        f32x4* xr = (f32x4*)(X + (size_t)m * DM) + lane; u32x2* o8 = (u32x2*)(xb + (size_t)m * DM) + lane;
        f32x4 v[4]; float s = 0.f;
#pragma unroll
        for (int j = 0; j < 4; ++j) { v[j] = xr[64 * j]; s += (v[j].x + v[j].y) + (v[j].z + v[j].w); }
        const float mean = wave_sum(s) * (1.f / DM); float s2 = 0.f;
#pragma unroll
        for (int j = 0; j < 4; ++j) { v[j] = v[j] - mean; s2 += (v[j].x * v[j].x + v[j].y * v[j].y) + (v[j].z * v[j].z + v[j].w * v[j].w); }
        const float rstd = 1.f / sqrtf(wave_sum(s2) * (1.f / DM) + NORM_EPS);
#pragma unroll
        for (int j = 0; j < 4; ++j) { const f32x4 y = v[j] * rstd * gv[j] + bv[j]; xr[64 * j] = y; u32x2 w; w.x = pkbf(y.x, y.y); w.y = pkbf(y.z, y.w); o8[64 * j] = w; }
    }
}

__device__ __forceinline__ void sincos_rev(float ang, float& s, float& c) {
    double d = (double)ang * 0.15915494309189535; d -= __builtin_rint(d); const float f = (float)d;
    s = __builtin_amdgcn_sinf(f); c = __builtin_amdgcn_cosf(f);
}
__device__ __forceinline__ void rope8(float (&v)[8], bool first, float pos, int i0, KP p) {
#pragma unroll
    for (int e = 0; e < 8; ++e) {
        const float other = __shfl_xor(v[e], 2);
        const float inv = i0 ? p->inv32[8 + e] : p->inv32[e];
        float s, c; sincos_rev(pos * inv, s, c);
        v[e] = first ? (v[e] * c - other * s) : (other * s + v[e] * c);
    }
}
__device__ __forceinline__ void prep_phase(KP p, int l, int vcu, int G) {
    const int tid = tid_fresh(), lane = tid & 63, wave = __builtin_amdgcn_readfirstlane(tid >> 6);
    const int gw = vcu * NWAVES + wave, NGW = G * NWAVES;
    bf16_t* proj = (bf16_t*)(p->ws + WS_PROJ); bf16_t* qb = (bf16_t*)(p->ws + WS_QB); bf16_t* kb = (bf16_t*)(p->ws + WS_KB); bf16_t* vb = (bf16_t*)(p->ws + WS_VB);
    float cg[8];
    { const float* gsrc = (lane < 32 ? p->ax_q_norm : p->ax_k_norm) + l * 64 + 8 * (lane & 7);
#pragma unroll
      for (int e = 0; e < 8; ++e) cg[e] = gsrc[e]; }
    for (int tok = gw; tok < T; tok += NGW) {
        const int t = tok & (SEQ - 1);
        bf16_t* pr = proj + (size_t)tok * NPROJ;
        float ssq = 0.f;
        if (lane < 48) { float v[8]; unpack8(*(const u32x4*)(pr + PCQ + 8 * lane), v);
#pragma unroll
            for (int e = 0; e < 8; ++e) ssq += v[e] * v[e]; }
        const float ssq_q = wave_sum(lane < 32 ? ssq : 0.f), ssq_kv = wave_sum(lane >= 32 ? ssq : 0.f);
        const float rstd_q = 1.f / sqrtf(ssq_q * (1.f / 256.f) + NORM_EPS), rstd_kv = 1.f / sqrtf(ssq_kv * (1.f / 128.f) + NORM_EPS);
        {
            const int r = lane % 12; float v[8];
            if (lane < 48) unpack8(*(const u32x4*)(pr + PQUP + 8 * lane), v); else {
#pragma unroll
                for (int e = 0; e < 8; ++e) v[e] = 0.f; }
#pragma unroll
            for (int e = 0; e < 8; ++e) v[e] *= rstd_q;
            float w[8];
#pragma unroll
            for (int e = 0; e < 8; ++e) w[e] = v[e];
            rope8(w, r < 10, (float)t, 8 * (r & 1), p);
            const bool isr = (r >= 8); const float qs = 0.10206207261596575f;
#pragma unroll
            for (int e = 0; e < 8; ++e) v[e] = (isr ? w[e] : v[e]) * qs;
            if (lane < 48) *(u32x4*)(qb + (size_t)tok * 384 + 8 * lane) = pack8(v);
        }
        {
            float v[8]; unpack8(*(const u32x4*)(pr + PKVUP + 8 * lane), v);
#pragma unroll
            for (int e = 0; e < 8; ++e) v[e] *= rstd_kv;
            const int hd = lane >> 4, r = lane & 15;
            if (r < 8) *(u32x4*)(kb + (size_t)tok * 384 + hd * 96 + 8 * r) = pack8(v);
            else *(u32x4*)(vb + (size_t)tok * 256 + hd * 64 + 8 * (r - 8)) = pack8(v);
        }
        {
            float v[8];
            if (lane < 4) unpack8(*(const u32x4*)(pr + PKR + 8 * lane), v); else {
#pragma unroll
                for (int e = 0; e < 8; ++e) v[e] = 0.f; }
            rope8(v, (lane & 3) < 2, (float)t, 8 * (lane & 1), p);
            if (lane < 4) { const u32x4 w = pack8(v);
#pragma unroll
                for (int hd = 0; hd < 4; ++hd) *(u32x4*)(kb + (size_t)tok * 384 + hd * 96 + 64 + 8 * lane) = w; }
        }
        {
            float v[8];
            if (lane < 48) unpack8(*(const u32x4*)(pr + PC + 8 * lane), v); else {
#pragma unroll
                for (int e = 0; e < 8; ++e) v[e] = 0.f; }
            float s = 0.f;
#pragma unroll
            for (int e = 0; e < 8; ++e) s += v[e] * v[e];
            s += __shfl_xor(s, 1); s += __shfl_xor(s, 2); s += __shfl_xor(s, 4);
            const float rs = 1.f / sqrtf(s * (1.f / 64.f) + NORM_EPS);
#pragma unroll
            for (int e = 0; e < 8; ++e) v[e] = v[e] * rs * cg[e];
            const int r = lane & 7; const float pos = (r < 4) ? (float)(t >> 6) : (float)(t & 63);
            rope8(v, (r & 3) < 2, pos, 8 * (r & 1), p);
            if (lane < 32) {
#pragma unroll
                for (int e = 0; e < 8; ++e) v[e] *= 0.125f; }
            if (lane < 48) *(u32x4*)(pr + PC + 8 * lane) = pack8(v);
        }
    }
}

#ifndef ATT_TYPES
#define ATT_TYPES 15
#endif
namespace att {
typedef float f32x2 __attribute__((ext_vector_type(2)));
constexpr int VPITCH = 144, KBUF = 64 * 208, VBUF = 64 * VPITCH;
constexpr int ATT_LDS = 2 * KBUF + 2 * VBUF;
constexpr float RESCALE_T = 5.0f;
__device__ __forceinline__ s16x4 vtr(const LAS char* p) { return __builtin_bit_cast(s16x4, __builtin_amdgcn_ds_read_tr16_b64_v4i16((LAS s16x4*)p)); }
__device__ __forceinline__ void xhalf_swap(float m, float& a, float& b) {
    a = m; b = m;
    asm volatile("s_nop 1\n\tv_permlane32_swap_b32 %0, %1\n\ts_nop 1" : "+v"(a), "+v"(b));
}
__device__ __forceinline__ float xhalf_max(float m) { float a, b; xhalf_swap(m, a, b); return fmaxf(a, b); }
__device__ __forceinline__ float xhalf_sum(float m) { float a, b; xhalf_swap(m, a, b); return a + b; }
__device__ __forceinline__ float max3f(float a, float b, float c) { return fmaxf(fmaxf(a, b), c); }
#define ATT_MFMA(a, b, c) __builtin_amdgcn_mfma_f32_32x32x16_bf16((a), (b), (c), 0, 0, 0)

template <int DK, int MODE>
__device__ __forceinline__ void flash_pass(LAS char* lds, const bf16_t* __restrict__ Qg, int qp, const bf16_t* __restrict__ Kg, int kp, const bf16_t* __restrict__ Vg, int vp,
                                           const bf16_t* __restrict__ AUGg, int q0, int kt0, int nt, int koff, float slope, f32x16& O0, f32x16& O1, float& Mout, float& Lout) {
    constexpr int DKL = DK + (MODE == 1 ? 16 : 0);
    constexpr int KPITCH = DKL * 2 + 16, NKC = 8 * DKL, CPR = DKL / 8, NKS = DK / 16;
    constexpr bool HAS_K1 = NKC > 512;
    constexpr int DUMMY = 2 * KBUF + 2 * VBUF;
    const int tid = tid_fresh(), lane = tid & 63, r32 = lane & 31, hi = lane >> 5; const int wid = __builtin_amdgcn_readfirstlane(tid >> 6);
    const int qrow = q0 + wid * 32 + r32;
    bf16x8 qf[NKS];
#pragma unroll
    for (int ks = 0; ks < NKS; ++ks) qf[ks] = *(const bf16x8*)(Qg + (size_t)qrow * qp + 16 * ks + 8 * hi);
    const int kc1 = tid + 512;
    const bool k0v = tid < NKC, k1v = HAS_K1 && kc1 < NKC;
    const int kr0 = k0v ? tid / CPR : 0, kcc0 = k0v ? tid % CPR : 0, kr1 = k1v ? kc1 / CPR : 0, kcc1 = k1v ? kc1 % CPR : 0, vr = tid >> 3, vcc = tid & 7;
    const bf16_t* kg0; size_t kst0;
    if (MODE == 1 && kcc0 >= DK / 8) { kg0 = AUGg + (size_t)kr0 * 64 + 8 * (kcc0 - DK / 8); kst0 = (size_t)64 * 64; } else { kg0 = Kg + (size_t)kr0 * kp + 8 * kcc0; kst0 = (size_t)64 * kp; }
    const bf16_t* kg1 = Kg + (size_t)kr1 * kp + 8 * kcc1; const size_t kst1 = (size_t)64 * kp;
    const bf16_t* vg = Vg + (size_t)vr * vp + 8 * vcc; const size_t vst = (size_t)64 * vp;
    const int kl0 = k0v ? kr0 * KPITCH + 16 * kcc0 : -1, kl1 = k1v ? kr1 * KPITCH + 16 * kcc1 : -1, vl = 2 * KBUF + vr * VPITCH + 16 * vcc;
    u32x4 rk0 = {0u, 0u, 0u, 0u}, rk1 = {0u, 0u, 0u, 0u}, rv = {0u, 0u, 0u, 0u};
#define ATT_KT(i) (kt0 + (((koff) + (i)) >= nt ? ((koff) + (i)) - nt : ((koff) + (i))))
#define ATT_LOADK(kt) do { const size_t t_ = (size_t)(kt); rk0 = *(const u32x4*)(kg0 + t_ * kst0); if (HAS_K1) rk1 = *(const u32x4*)(kg1 + t_ * kst1); } while (0)
#define ATT_LOADV(kt) do { rv = *(const u32x4*)(vg + (size_t)(kt) * vst); } while (0)
#define ATT_STOREK(buf) do { *(LAS u32x4*)(lds + (kl0 >= 0 ? (buf) * KBUF + kl0 : DUMMY + tid * 16)) = rk0; if (HAS_K1) *(LAS u32x4*)(lds + (kl1 >= 0 ? (buf) * KBUF + kl1 : DUMMY + tid * 16)) = rk1; } while (0)
#define ATT_STOREV(buf) do { *(LAS u32x4*)(lds + (buf) * VBUF + vl) = rv; } while (0)
    const int q4 = (lane & 15) >> 2, p4 = lane & 3, b16 = (lane >> 4) & 1;
    const int vbase = 2 * KBUF + (4 * hi + q4) * VPITCH + 32 * b16 + 8 * p4;
    const int kbase = r32 * KPITCH + 16 * hi;
    const int qw = q0 + wid * 32;
    const float stq = slope * (float)qrow;
    const bf16x8 qzero = {0, 0, 0, 0, 0, 0, 0, 0};
    bf16x8 qpos = qzero, qneg = qzero;
    if (MODE == 1 && hi == 0) { qpos[0] = (short)0x3F80; qpos[1] = (short)0x3F80; qneg[0] = (short)0xBF80; qneg[1] = (short)0xBF80; }
    constexpr int NKF = NKS + (MODE == 1 ? 1 : 0);
    constexpr int KPRE = NKF > 4 ? 4 : NKF;
    bf16x8 kfa[NKF], kfb[NKF];
#define ATT_KREAD(kbuf, f0, f1) do { const LAS char* Kb_ = lds + (kbuf) * KBUF + kbase; \
        _Pragma("unroll") for (int ks_ = (f0); ks_ < (f1); ++ks_) { kfa[ks_] = *(const LAS bf16x8*)(Kb_ + 32 * ks_); kfb[ks_] = *(const LAS bf16x8*)(Kb_ + 32 * KPITCH + 32 * ks_); } } while (0)
#define ATT_QKM(sa, sb, side) do { \
        _Pragma("unroll") for (int e_ = 0; e_ < 16; ++e_) { sa[e_] = 0.f; sb[e_] = 0.f; } \
        _Pragma("unroll") for (int ks_ = 0; ks_ < NKS; ++ks_) { sa = ATT_MFMA(kfa[ks_], qf[ks_], sa); sb = ATT_MFMA(kfb[ks_], qf[ks_], sb); } \
        if (MODE == 1) { const bf16x8 qa_ = (side) < 0 ? qpos : ((side) > 0 ? qneg : qzero); sa = ATT_MFMA(kfa[NKS], qa_, sa); sb = ATT_MFMA(kfb[NKS], qa_, sb); } } while (0)
#define ATT_QK(sa, sb, kbuf, side) do { ATT_KREAD(kbuf, 0, NKF); ATT_QKM(sa, sb, side); } while (0)
    bf16x8 vfa[4], vfb[4];
#define ATT_VREAD(vbuf) do { const LAS char* Vb_ = lds + (vbuf) * VBUF + vbase; \
        _Pragma("unroll") for (int j_ = 0; j_ < 4; ++j_) { const LAS char* vp0_ = Vb_ + (16 * j_) * VPITCH; \
            { const s16x4 lo_ = vtr(vp0_), hh_ = vtr(vp0_ + 8 * VPITCH); vfa[j_] = __builtin_shufflevector(lo_, hh_, 0, 1, 2, 3, 4, 5, 6, 7); } \
            { const s16x4 lo_ = vtr(vp0_ + 64), hh_ = vtr(vp0_ + 8 * VPITCH + 64); vfb[j_] = __builtin_shufflevector(lo_, hh_, 0, 1, 2, 3, 4, 5, 6, 7); } } } while (0)
#define ATT_PVM() do { _Pragma("unroll") for (int j_ = 0; j_ < 4; ++j_) { O0 = ATT_MFMA(vfa[j_], pf[j_ >> 1][j_ & 1], O0); O1 = ATT_MFMA(vfb[j_], pf[j_ >> 1][j_ & 1], O1); } } while (0)
#define ATT_PV(vbuf) do { ATT_VREAD(vbuf); ATT_PVM(); } while (0)
#define ATT_SIDE(kt) ((MODE != 1) ? 0 : (((kt) * 64 + 63 < qw) ? -1 : (((kt) * 64 > qw + 31) ? 1 : 0)))
    ATT_LOADK(ATT_KT(0)); ATT_STOREK(0);
    ATT_LOADK(ATT_KT(1)); ATT_STOREK(1);
    ATT_STOREV(1);
    __syncthreads();
    float M = -1e20f, L = 0.f;
#pragma unroll
    for (int i = 0; i < 16; ++i) { O0[i] = 0.f; O1[i] = 0.f; }
    bf16x8 pf[2][2];
#pragma unroll
    for (int kb = 0; kb < 2; ++kb)
#pragma unroll
        for (int st = 0; st < 2; ++st) pf[kb][st] = qzero;
    f32x16 s0, s1, n0, n1;
    int side_cur = ATT_SIDE(ATT_KT(0));
    ATT_QK(s0, s1, 0, side_cur);
#pragma unroll
    for (int e = 0; e < 16; ++e) { n0[e] = 0.f; n1[e] = 0.f; }
    __syncthreads();
    constexpr int NMF = 2 * NKS + (MODE == 1 ? 2 : 0) + 8;
#define ATT_ITER(i, C0, C1, N0, N1, HASN, HASK2) do { \
        const int kt = ATT_KT(i); \
        if (HASK2) ATT_LOADK(ATT_KT((i) + 2)); \
        ATT_LOADV(kt); \
        if (HASN) ATT_KREAD(((i) + 1) & 1, 0, KPRE); \
        const int k0 = kt * 64; \
          \
        float rc = 0.f; \
        if (MODE == 1) { \
            if (side_cur != 0) rc = side_cur < 0 ? -stq : stq; \
            else { const float dbase = (float)(k0 + 4 * hi - qrow); \
                _Pragma("unroll") for (int e = 0; e < 16; ++e) { const float c = (float)((e & 3) + 8 * (e >> 2)); \
                    C0[e] = fmaf(-slope, fabsf(dbase + c), C0[e]); C1[e] = fmaf(-slope, fabsf(dbase + (c + 32.f)), C1[e]); } } \
        } \
        if (MODE == 2) { const float dbase = (float)(k0 + 4 * hi - qrow); \
            _Pragma("unroll") for (int e = 0; e < 16; ++e) { const float c = (float)((e & 3) + 8 * (e >> 2)); \
                const float d0 = fabsf(dbase + c), d1 = fabsf(dbase + (c + 32.f)); \
                C0[e] = (d0 <= 128.f) ? fmaf(-slope, d0, C0[e]) : -1e30f; C1[e] = (d1 <= 128.f) ? fmaf(-slope, d1, C1[e]) : -1e30f; } } \
        float mx = max3f(C0[0], C1[0], C0[1]); \
        _Pragma("unroll") for (int e = 1; e < 15; e += 2) { mx = max3f(mx, C1[e], C0[e + 1]); mx = max3f(mx, C1[e + 1], C0[e + 2]); } \
        mx = fmaxf(mx, C1[15]); \
        const float mt = xhalf_max(mx) + rc;                     \
        if (__builtin_amdgcn_ballot_w64(mt > M + RESCALE_T) != 0ull) {         \
            ATT_PV(((i) + 1) & 1); \
            _Pragma("unroll") for (int kb = 0; kb < 2; ++kb) _Pragma("unroll") for (int st = 0; st < 2; ++st) pf[kb][st] = qzero; \
            const float Mn = fmaxf(M, mt); const float alpha = __builtin_amdgcn_exp2f((M - Mn) * LOG2E); M = Mn; \
            L *= alpha; \
            _Pragma("unroll") for (int e = 0; e < 16; ++e) { O0[e] *= alpha; O1[e] *= alpha; } \
        } \
          \
        const int side_next = HASN ? ATT_SIDE(ATT_KT((i) + 1)) : 0; \
        if (HASN) ATT_KREAD(((i) + 1) & 1, KPRE, NKF); \
        ATT_VREAD(((i) + 1) & 1); \
        if (HASN) ATT_QKM(N0, N1, side_next); \
        ATT_PVM();                                   \
        const float cc = (rc - M) * LOG2E; \
        const f32x2 k2 = {LOG2E, LOG2E}, c2 = {cc, cc}; \
        f32x2 ps2 = {0.f, 0.f}; \
        _Pragma("unroll") for (int e = 0; e < 16; e += 2) { \
            f32x2 a = {C0[e], C0[e + 1]}, b = {C1[e], C1[e + 1]}; \
            a = a * k2 + c2; b = b * k2 + c2; \
            a.x = __builtin_amdgcn_exp2f(a.x); a.y = __builtin_amdgcn_exp2f(a.y); b.x = __builtin_amdgcn_exp2f(b.x); b.y = __builtin_amdgcn_exp2f(b.y); \
            ps2 += a; ps2 += b; \
            C0[e] = a.x; C0[e + 1] = a.y; C1[e] = b.x; C1[e + 1] = b.y; } \
        L += ps2.x + ps2.y; \
        _Pragma("unroll") for (int st = 0; st < 2; ++st) { u32x4 w0, w1; \
            w0.x = pkbf(C0[8 * st + 0], C0[8 * st + 1]); w0.y = pkbf(C0[8 * st + 2], C0[8 * st + 3]); w0.z = pkbf(C0[8 * st + 4], C0[8 * st + 5]); w0.w = pkbf(C0[8 * st + 6], C0[8 * st + 7]); \
            w1.x = pkbf(C1[8 * st + 0], C1[8 * st + 1]); w1.y = pkbf(C1[8 * st + 2], C1[8 * st + 3]); w1.z = pkbf(C1[8 * st + 4], C1[8 * st + 5]); w1.w = pkbf(C1[8 * st + 6], C1[8 * st + 7]); \
            pf[0][st] = __builtin_bit_cast(bf16x8, w0); pf[1][st] = __builtin_bit_cast(bf16x8, w1); } \
        side_cur = side_next; \
        if (HASN) { __builtin_amdgcn_sched_group_barrier(0x100, 16 + 2 * (NKF - KPRE), 0); \
            _Pragma("unroll") for (int g_ = 0; g_ < NMF; ++g_) { __builtin_amdgcn_sched_group_barrier(0x008, 1, 0); __builtin_amdgcn_sched_group_barrier(0x002, 6, 0); } } \
        if (HASK2) ATT_STOREK((i) & 1); \
        ATT_STOREV((i) & 1); \
        __syncthreads(); } while (0)
    for (int i = 0; i + 2 < nt; i += 2) {
        ATT_ITER(i, s0, s1, n0, n1, true, true);
        ATT_ITER(i + 1, n0, n1, s0, s1, true, true);
    }
    ATT_ITER(nt - 2, s0, s1, n0, n1, true, false);
    ATT_ITER(nt - 1, n0, n1, s0, s1, false, false);
    ATT_PV((nt - 1) & 1);
    __syncthreads();
#undef ATT_ITER
#undef ATT_LOADK
#undef ATT_LOADV
#undef ATT_STOREK
#undef ATT_STOREV
#undef ATT_KT
#undef ATT_QK
#undef ATT_PV
#undef ATT_KREAD
#undef ATT_QKM
#undef ATT_VREAD
#undef ATT_PVM
#undef ATT_SIDE
    Mout = M; Lout = L;
}

__device__ __forceinline__ void store_o(bf16_t* orow, const f32x16& O0, const f32x16& O1, int hi) {
#pragma unroll
    for (int g = 0; g < 4; ++g) {
        u32x2 w0, w1; w0.x = pkbf(O0[4 * g], O0[4 * g + 1]); w0.y = pkbf(O0[4 * g + 2], O0[4 * g + 3]); w1.x = pkbf(O1[4 * g], O1[4 * g + 1]); w1.y = pkbf(O1[4 * g + 2], O1[4 * g + 3]);
        *(u32x2*)(orow + 8 * g + 4 * hi) = w0; *(u32x2*)(orow + 32 + 8 * g + 4 * hi) = w1;
    }
}

__device__ __forceinline__ void attn_phase(KP p, int l, LAS char* lds, int vcu, int G) {
    const int tid = tid_fresh(), lane = tid & 63, r32 = lane & 31, hi = lane >> 5; const int wid = __builtin_amdgcn_readfirstlane(tid >> 6);
    const bf16_t* proj = (const bf16_t*)(p->ws + WS_PROJ); const bf16_t* qb = (const bf16_t*)(p->ws + WS_QB); const bf16_t* kb = (const bf16_t*)(p->ws + WS_KB); const bf16_t* vb = (const bf16_t*)(p->ws + WS_VB);
    const bf16_t* aug = (const bf16_t*)(p->ws + WS_AUG);
    bf16_t* mix = (bf16_t*)(p->ws + WS_MIX);
    float lam;
    { const float* lp = p->diff_lambda + l * 128; const float a = (lane < 32) ? lp[lane] * lp[32 + lane] : 0.f, b2 = (lane < 32) ? lp[64 + lane] * lp[96 + lane] : 0.f;
      lam = expf(wave_sum(a)) - expf(wave_sum(b2)) + p->lam_init[l]; }
    const float one_m_li = 1.f - p->lam_init[l];
    for (int u = vcu; u < 2048; u += G) {
        if (!((ATT_TYPES >> (u >> 9)) & 1)) continue;
        const int type = u >> 9, idx = u & 511, bh = idx >> 6, qblk = idx & 63, b = bh >> 2, hd = bh & 3, q0 = qblk * 256;
        const int qrow = q0 + wid * 32 + r32;
        const size_t tok0 = (size_t)b * SEQ;
        bf16_t* orow = mix + (tok0 + qrow) * DM;
        f32x16 O0, O1; float M, L;
        if (type == 0) {
            const float slope = __builtin_amdgcn_exp2f(-(float)(5 + hd));
            const bf16_t* base = proj + tok0 * NPROJ + PD;
            flash_pass<32, 1>(lds, base + 64 * hd, NPROJ, base + 256 + 64 * hd, NPROJ, base + 512 + 64 * hd, NPROJ, aug + 16 * hd, q0, 0, SEQ / 64, q0 / 64, slope, O0, O1, M, L);
            const float i1 = 1.f / xhalf_sum(L);
            f32x16 A0, A1;
#pragma unroll
            for (int i = 0; i < 16; ++i) { A0[i] = O0[i] * i1; A1[i] = O1[i] * i1; }
            flash_pass<32, 1>(lds, base + 64 * hd + 32, NPROJ, base + 256 + 64 * hd + 32, NPROJ, base + 512 + 64 * hd, NPROJ, aug + 16 * hd, q0, 0, SEQ / 64, q0 / 64, slope, O0, O1, M, L);
            const float i2 = lam / xhalf_sum(L);
            float ss = 0.f;
#pragma unroll
            for (int i = 0; i < 16; ++i) { A0[i] -= O0[i] * i2; A1[i] -= O1[i] * i2; ss += A0[i] * A0[i] + A1[i] * A1[i]; }
            ss = xhalf_sum(ss);
            const float rs = one_m_li / sqrtf(ss * (1.f / 64.f) + NORM_EPS);
            const float* sg = p->diff_subln + l * 64;
#pragma unroll
            for (int i = 0; i < 16; ++i) { const int dv = (i & 3) + 8 * (i >> 2) + 4 * hi; A0[i] *= rs * sg[dv]; A1[i] *= rs * sg[32 + dv]; }
            store_o(orow + 768 + 64 * hd, A0, A1, hi);
        } else if (type == 1) {
            flash_pass<96, 0>(lds, qb + tok0 * 384 + 96 * hd, 384, kb + tok0 * 384 + 96 * hd, 384, vb + tok0 * 256 + 64 * hd, 256, nullptr, q0, 0, SEQ / 64, q0 / 64, 0.f, O0, O1, M, L);
            const float il = 1.f / xhalf_sum(L);
#pragma unroll
            for (int i = 0; i < 16; ++i) { O0[i] *= il; O1[i] *= il; }
            store_o(orow + 256 + 64 * hd, O0, O1, hi);
        } else if (type == 2) {
            const bf16_t* base = proj + tok0 * NPROJ + PC; const int hk = hd >> 1;
            flash_pass<64, 0>(lds, base + 64 * hd, NPROJ, base + 256 + 64 * hk, NPROJ, base + 384 + 64 * hk, NPROJ, nullptr, q0, 0, SEQ / 64, q0 / 64, 0.f, O0, O1, M, L);
            const float il = 1.f / xhalf_sum(L);
#pragma unroll
            for (int i = 0; i < 16; ++i) { O0[i] *= il; O1[i] *= il; }
            store_o(orow + 512 + 64 * hd, O0, O1, hi);
        } else {
            const bf16_t* base = proj + tok0 * NPROJ + PA; const int hk = hd >> 1;
            const float slope = __builtin_amdgcn_exp2f(-(float)(1 + hd));
            const int kt0 = (q0 >= 128) ? (q0 - 128) / 64 : 0; int kt1 = (q0 + 256 + 128) / 64; if (kt1 > SEQ / 64) kt1 = SEQ / 64;
            flash_pass<64, 2>(lds, base + 64 * hd, NPROJ, base + 256 + 64 * hk, NPROJ, base + 384 + 64 * hk, NPROJ, nullptr, q0, kt0, kt1 - kt0, 0, slope, O0, O1, M, L);
            const float sink = p->win_sink[l * 4 + hd];
            const float il = 1.f / (xhalf_sum(L) + __builtin_amdgcn_exp2f((sink - M) * LOG2E));
#pragma unroll
            for (int i = 0; i < 16; ++i) { O0[i] *= il; O1[i] *= il; }
            store_o(orow + 64 * hd, O0, O1, hi);
        }
    }
}
}

#define GRID_SYNC() do { __builtin_amdgcn_fence(__ATOMIC_RELEASE, "agent"); grid.sync(); __builtin_amdgcn_fence(__ATOMIC_ACQUIRE, "agent"); } while (0)
#ifndef PH_MASK
#define PH_MASK 255
#endif
__global__ void __launch_bounds__(NTHREADS, 2) mega_fwd(Params p_by_value) {
    extern __shared__ __attribute__((aligned(16))) unsigned char lds_raw[];
    cg::grid_group grid = cg::this_grid();
    LAS unsigned char* lds = (LAS unsigned char*)lds_raw;
#define VCU(G_, bx_) (((G_) % 8 == 0) ? ((bx_) % 8) * ((G_) / 8) + (bx_) / 8 : (bx_))
    const float alpha = 1.681792830507429f;

    if (PH_MASK & 1) { GETP(p); const int G = gridDim.x, bx = blockIdx.x; phase0(p, lds, VCU(G, bx), G); }
    GRID_SYNC();
#pragma unroll 1
    for (int li = 0; li < DEPTH; ++li) {
#pragma unroll 1
        for (int fi = 0; fi < 2; ++fi) {
            if (fi == 1) {
                if (PH_MASK & 2) { GETP(p); int l = li; asm volatile("" : "+s"(l)); const int G = gridDim.x, bx = blockIdx.x;
                  pg8::Gemm g{(const bf16_t*)(p->ws + WS_XB), (const bf16_t*)(p->ws + WS_WIN) + l * WIN_L, T, NPROJ, DM}; pg8::StaticOrder S; S.init(T, NPROJ, G, bx);
                  pg8::EpiStoreBf16 E{(bf16_t*)(p->ws + WS_PROJ), NPROJ};
                  pg8::gemm_phase<pg8::EpiStoreBf16, pg8::StaticOrder, true, true>(lds, g, S, E); }
                GRID_SYNC();
                if (PH_MASK & 4) { GETP(p); int l = li; asm volatile("" : "+s"(l)); const int G = gridDim.x, bx = blockIdx.x; prep_phase(p, l, VCU(G, bx), G); }
                GRID_SYNC();
                if (PH_MASK & 8) { GETP(p); int l = li; asm volatile("" : "+s"(l)); const int G = gridDim.x, bx = blockIdx.x; att::attn_phase(p, l, (LAS char*)lds, VCU(G, bx), G); }
                GRID_SYNC();
                if (PH_MASK & 16) { GETP(p); int l = li; asm volatile("" : "+s"(l)); const int G = gridDim.x, bx = blockIdx.x;
                  pg8::Gemm g{(const bf16_t*)(p->ws + WS_MIX), (const bf16_t*)(p->ws + WS_WOUT) + l * WOUT_L, T, DM, DM}; pg8::StaticOrder S; S.init(T, DM, G, bx);
                  pg8::EpiResid E{p->out, p->out, DM, alpha, 1.0f};
                  pg8::gemm_phase<pg8::EpiResid, pg8::StaticOrder, true, true>(lds, g, S, E); }
                GRID_SYNC();
                if (PH_MASK & 32) { GETP(p); int l = li; asm volatile("" : "+s"(l)); const int G = gridDim.x, bx = blockIdx.x;
                  ln_phase(p->out, (bf16_t*)(p->ws + WS_XB), p->ln_g + (l * 3 + 1) * DM, p->ln_b + (l * 3 + 1) * DM, VCU(G, bx), G); }
                GRID_SYNC();
            }
            if (PH_MASK & 64) { GETP(p); int l = li, f = fi; asm volatile("" : "+s"(l), "+s"(f)); const int G = gridDim.x, bx = blockIdx.x;
              pg8::Gemm g{(const bf16_t*)(p->ws + WS_XB), (const bf16_t*)(p->ws + WS_WGU) + l * WGU_L + f * WGU_F, T, NGU, DM}; pg8::StaticOrder S; S.init(T, NGU, G, bx);
              pg8::EpiSwiGLU E{(bf16_t*)(p->ws + WS_H), DFF};
              pg8::gemm_phase<pg8::EpiSwiGLU, pg8::StaticOrder, true, true>(lds, g, S, E); }
            GRID_SYNC();
            if (PH_MASK & 128) { GETP(p); int l = li, f = fi; asm volatile("" : "+s"(l), "+s"(f)); const int G = gridDim.x, bx = blockIdx.x;
              pg8::Gemm g{(const bf16_t*)(p->ws + WS_H), (const bf16_t*)(p->ws + WS_WD) + l * WD_L + f * WD_F, T, DM, DFF}; pg8::StaticOrder S; S.init(T, DM, G, bx);
              pg8::EpiResid E{(l == 0 && f == 0) ? p->x : (const float*)p->out, p->out, DM, alpha, 0.5f};
              pg8::gemm_phase<pg8::EpiResid, pg8::StaticOrder, true, true>(lds, g, S, E); }
            GRID_SYNC();
            if (PH_MASK & 32) { GETP(p); int l = li, f = fi; asm volatile("" : "+s"(l), "+s"(f)); const int G = gridDim.x, bx = blockIdx.x;
              ln_phase(p->out, (bf16_t*)(p->ws + WS_XB), p->ln_g + (l * 3 + 2 * f) * DM, p->ln_b + (l * 3 + 2 * f) * DM, VCU(G, bx), G); }
            GRID_SYNC();
        }
    }
}

extern "C" void kernel_launch(void* const* d_in, const int* in_sizes, int n_in, void* d_out, int out_size, void* d_ws, size_t ws_size, hipStream_t stream) {
    static int grid = 0;
    if (grid == 0) {
        if (n_in != 16 || in_sizes[0] != T * DM || out_size != T * DM || ws_size < WS_END) { fprintf(stderr, "kernel_launch: unexpected shapes (n_in %d, in0 %d, out %d, ws %zu); nothing launched\n", n_in, n_in > 0 ? in_sizes[0] : -1, out_size, ws_size); grid = -1; return; }
        int dev = 0, cus = 0, per_cu = 0;
        hipGetDevice(&dev); hipDeviceGetAttribute(&cus, hipDeviceAttributeMultiprocessorCount, dev);
        if (hipFuncSetAttribute((const void*)mega_fwd, hipFuncAttributeMaxDynamicSharedMemorySize, LDS_BYTES) != hipSuccess) { fprintf(stderr, "kernel_launch: hipFuncSetAttribute failed\n"); grid = -1; return; }
        if (hipOccupancyMaxActiveBlocksPerMultiprocessor(&per_cu, (const void*)mega_fwd, NTHREADS, LDS_BYTES) != hipSuccess || per_cu < 1) { fprintf(stderr, "kernel_launch: occupancy query gave %d\n", per_cu); per_cu = 1; }
        (void)hipGetLastError();
        grid = cus * 1;
    }
    if (grid < 0) return;
    Params p{};
    p.x = (const float*)d_in[0]; p.w_in = (const float*)d_in[1]; p.win_sink = (const float*)d_in[2]; p.mla_q_norm = (const float*)d_in[3]; p.mla_w_uq = (const float*)d_in[4];
    p.mla_kv_norm = (const float*)d_in[5]; p.mla_w_ukv = (const float*)d_in[6]; p.ax_q_norm = (const float*)d_in[7]; p.ax_k_norm = (const float*)d_in[8]; p.diff_lambda = (const float*)d_in[9];
    p.diff_subln = (const float*)d_in[10]; p.w_out = (const float*)d_in[11]; p.ffn_w_gu = (const float*)d_in[12]; p.ffn_w_down = (const float*)d_in[13]; p.ln_g = (const float*)d_in[14]; p.ln_b = (const float*)d_in[15];
    p.out = (float*)d_out; p.ws = (unsigned char*)d_ws;
    for (int l = 0; l < 4; ++l) p.lam_init[l] = (float)(0.8 - 0.6 * exp(-0.3 * (double)l));
    for (int i = 0; i < 16; ++i) p.inv32[i] = (float)pow(10000.0, -(double)i / 16.0);
    void* args[] = {&p};
    hipError_t e = hipLaunchCooperativeKernel((const void*)mega_fwd, dim3(grid), dim3(NTHREADS), args, LDS_BYTES, stream);
    if (e != hipSuccess) fprintf(stderr, "kernel_launch: cooperative launch failed: %s (grid %d)\n", hipGetErrorString(e), grid);
}
```

```cpp
#include <hip/hip_runtime.h>
#include <hip/hip_cooperative_groups.h>
#include <cstdio>
#include <cstdint>
#include <cmath>
namespace cg = cooperative_groups;
namespace pg8 {
#define PG8_LAS __attribute__((address_space(3)))
typedef unsigned short bf16_t;
typedef short bf16x8 __attribute__((ext_vector_type(8)));
typedef float f32x4 __attribute__((ext_vector_type(4)));
typedef unsigned u32x4 __attribute__((ext_vector_type(4)));
constexpr int BM = 256, BK = 64, HALF = 128, HTB = HALF * BK * 2  , STAGE_BYTES = 8 * HTB, NXCD = 8, WGM = 8;

__host__ __device__ __forceinline__ int lds_byte(int r, int c) { const int st = (r >> 4) * 2 + (c >> 5), rr = r & 15, cc = c & 31, ob = rr * 64 + cc * 2; return st * 1024 + (ob ^ (((ob >> 9) & 1) << 5)); }
__host__ __device__ __forceinline__ void stage_rc(int b, int& R, int& C) { const int st = b / 1024, sb = b % 1024, swz = sb ^ (((sb >> 9) & 1) << 5); R = (st >> 1) * 16 + swz / 64; C = (st & 1) * 32 + (swz % 64) / 2; }
__host__ __device__ __forceinline__ int perm32(int rho) { const int n = rho >> 4, i = rho & 15; return 8 * (i >> 2) + 4 * n + (i & 3); }

struct Unit { int pm, pn; };
struct Gemm { const bf16_t* A; const bf16_t* Bt; int M, N, K; };

struct StaticOrder {
    int nM, nN, nwg, G, c;
    __host__ __device__ void init(int M, int N, int G_, int c_) { nM = M / BM; nN = N / BM; nwg = nM * nN; G = G_; c = c_; }
    __host__ __device__ bool next(int i, Unit& u) const {
        const long L = (long)i * G + c; if (L >= nwg) return false;
        int wgid = (int)L; { const int q = nwg / NXCD, r = nwg % NXCD, xcd = wgid % NXCD, off = wgid / NXCD; wgid = (xcd < r ? xcd * (q + 1) : r * (q + 1) + (xcd - r) * q) + off; }
        const int nig = WGM * nN, gid = wgid / nig, fm = gid * WGM, gsz = (nM - fm) < WGM ? (nM - fm) : WGM;
        u.pm = fm + ((wgid % nig) % gsz); u.pn = (wgid % nig) / gsz; return true;
    }
    __device__ __forceinline__ void a_ready(const Unit&) const {}
    __device__ __forceinline__ void done(const Unit&) const {}
};

__device__ __forceinline__ unsigned cvt_pk_bf16(float lo, float hi) { unsigned r; asm volatile("v_cvt_pk_bf16_f32 %0, %1, %2" : "=v"(r) : "v"(lo), "v"(hi)); return r; }
typedef float f32x2 __attribute__((ext_vector_type(2)));
typedef float f32x2 __attribute__((ext_vector_type(2)));
typedef unsigned u32x2 __attribute__((ext_vector_type(2)));

struct EpiStoreBf16 {
    static constexpr bool PERM = true, AFTER_DRAIN = false;
    bf16_t* O; int ldc;
    __device__ __forceinline__ void operator()(const f32x4 (&acc)[2][2][4][2], const Unit& u, int wr, int wc, int fr, int fq) const {
        const int row0 = u.pm * BM + wr * 64 + fr; const int col0 = u.pn * BM + wc * 32 + 8 * fq;
#pragma unroll
        for (int ai = 0; ai < 2; ++ai)
#pragma unroll
            for (int m = 0; m < 4; ++m) { bf16_t* rowp = O + (size_t)(row0 + ai * HALF + m * 16) * ldc + col0;
#pragma unroll
                for (int bj = 0; bj < 2; ++bj) { const f32x4 v0 = acc[ai][bj][m][0], v1 = acc[ai][bj][m][1];
                    u32x4 w; w.x = cvt_pk_bf16(v0[0], v0[1]); w.y = cvt_pk_bf16(v0[2], v0[3]); w.z = cvt_pk_bf16(v1[0], v1[1]); w.w = cvt_pk_bf16(v1[2], v1[3]);
                    *(u32x4*)(rowp + bj * HALF) = w; } }
    }
};

__device__ __forceinline__ float silu_mul(float g, float u) {
    const float e = __builtin_amdgcn_exp2f(-1.4426950408889634f * g);
    return g * u * __builtin_amdgcn_rcpf(1.0f + e);
}
struct EpiSwiGLU {
    static constexpr bool PERM = true, AFTER_DRAIN = false;
    bf16_t* H; int ldh;
    __device__ __forceinline__ void operator()(const f32x4 (&acc)[2][2][4][2], const Unit& u, int wr, int wc, int fr, int fq) const {
        const int row0 = u.pm * BM + wr * 64 + fr; const int col0 = u.pn * HALF + wc * 32 + 8 * fq;
#pragma unroll
        for (int ai = 0; ai < 2; ++ai)
#pragma unroll
            for (int m = 0; m < 4; ++m) { bf16_t* rowp = H + (size_t)(row0 + ai * HALF + m * 16) * ldh + col0;
                const f32x4 g0 = acc[ai][0][m][0], g1 = acc[ai][0][m][1], u0 = acc[ai][1][m][0], u1 = acc[ai][1][m][1];
                u32x4 w;
                w.x = cvt_pk_bf16(silu_mul(g0[0], u0[0]), silu_mul(g0[1], u0[1])); w.y = cvt_pk_bf16(silu_mul(g0[2], u0[2]), silu_mul(g0[3], u0[3]));
                w.z = cvt_pk_bf16(silu_mul(g1[0], u1[0]), silu_mul(g1[1], u1[1])); w.w = cvt_pk_bf16(silu_mul(g1[2], u1[2]), silu_mul(g1[3], u1[3]));
                *(u32x4*)rowp = w; }
    }
};

struct EpiResid {
    static constexpr bool PERM = false, AFTER_DRAIN = false;
    const float* src; float* dst; int ld; float alpha, beta;
    __device__ __forceinline__ void operator()(const f32x4 (&acc)[2][2][4][2], const Unit& u, int wr, int wc, int fr, int fq) const {
        const int col0 = u.pn * BM + wc * 32 + 4 * fq;
#pragma unroll
        for (int ai = 0; ai < 2; ++ai)
#pragma unroll
            for (int m = 0; m < 4; ++m) { const size_t off = (size_t)(u.pm * BM + ai * HALF + wr * 64 + m * 16 + fr) * ld + col0;
#pragma unroll
                for (int bj = 0; bj < 2; ++bj)
#pragma unroll
                    for (int n = 0; n < 2; ++n) { const f32x4 s = *(const f32x4*)(src + off + bj * HALF + n * 16);
                        *(f32x4*)(dst + off + bj * HALF + n * 16) = s * alpha + acc[ai][bj][m][n] * beta; } }
    }
};
template <class Epi, class Sched, bool ALIGN_EPI = false, bool SP2 = false>
__device__ __forceinline__ void gemm_phase(PG8_LAS unsigned char* lds, const Gemm g, const Sched& S, const Epi& E) {
    int tid_ = threadIdx.x; asm volatile("" : "+v"(tid_));
    const int tid = tid_, wid = __builtin_amdgcn_readfirstlane(tid >> 6), lane = tid & 63, wr = wid >> 2, wc = wid & 3, fr = lane & 15, fq = lane >> 4;
    const int K = g.K, nt = K / BK;
    unsigned voffA[2], voffB[2];
#pragma unroll
    for (int i = 0; i < 2; ++i) { int R, C; stage_rc(tid * 16 + i * 8192, R, C); const int Rb = Epi::PERM ? ((R & ~31) + perm32(R & 31)) : R;
        voffA[i] = (unsigned)(R * K + C) * 2u; voffB[i] = (unsigned)(Rb * K + C) * 2u; }
    const size_t kstep = (size_t)(BK * 2);
    const size_t hstep = (size_t)HALF * K * 2;
    const size_t tstep = 2 * hstep;
    const unsigned ldsw = (unsigned)wid * 1024u;
    const int aoff = lds_byte(wr * 64 + fr, fq * 8), boff = lds_byte(wc * 32 + fr, fq * 8);
#define PG8_SA(b, h) (((b) * 2 + (h)) * HTB)
#define PG8_SB(b, h) ((4 + (b) * 2 + (h)) * HTB)
#define PG8_STAGE(bufoff, gbase, voff) do { _Pragma("unroll") for (int _i = 0; _i < 2; ++_i) \
        __builtin_amdgcn_global_load_lds((const unsigned*)((const char*)(gbase) + (voff)[_i]), (PG8_LAS unsigned*)(lds + (bufoff) + ldsw + _i * 8192), 16, 0, 0); } while (0)
#define PG8_LDA(dst, b, h) do { _Pragma("unroll") for (int m = 0; m < 4; ++m) _Pragma("unroll") for (int k = 0; k < 2; ++k) dst[m][k] = *(const PG8_LAS bf16x8*)(lds + PG8_SA(b, h) + aoff + m * 2048 + k * 1024); } while (0)
#define PG8_LDB(dst, b, h) do { _Pragma("unroll") for (int n = 0; n < 2; ++n) _Pragma("unroll") for (int k = 0; k < 2; ++k) dst[n][k] = *(const PG8_LAS bf16x8*)(lds + PG8_SB(b, h) + boff + n * 2048 + k * 1024); } while (0)
#define PG8_MMA(ai, bj, At, Bt) do { __builtin_amdgcn_s_setprio(1); _Pragma("unroll") for (int m = 0; m < 4; ++m) _Pragma("unroll") for (int n = 0; n < 2; ++n) _Pragma("unroll") for (int k = 0; k < 2; ++k) \
        acc[ai][bj][m][n] = __builtin_amdgcn_mfma_f32_16x16x32_bf16(Bt[n][k], At[m][k], acc[ai][bj][m][n], 0, 0, 0); __builtin_amdgcn_s_setprio(0); } while (0)
#define PG8_WAIT_V(n) asm volatile("s_waitcnt vmcnt(" #n ")" ::: "memory")
#define PG8_WAIT_L(n) asm volatile("s_waitcnt lgkmcnt(" #n ")" ::: "memory")
#define PG8_BAR __builtin_amdgcn_s_barrier()
#define PG8_SCHED __builtin_amdgcn_sched_barrier(0)
    Unit cur, nxt; int ui = 0;
    if (!S.next(0, cur)) return;
    f32x4 acc[2][2][4][2];
#pragma unroll
    for (int a = 0; a < 2; ++a)
#pragma unroll
        for (int b = 0; b < 2; ++b)
#pragma unroll
            for (int m = 0; m < 4; ++m)
#pragma unroll
                for (int n = 0; n < 2; ++n) acc[a][b][m][n] = (f32x4){0.f, 0.f, 0.f, 0.f};
    bf16x8 At[4][2], B0[2][2], B1[2][2];
    const char* cA = (const char*)g.A + (size_t)cur.pm * tstep; const char* cB = (const char*)g.Bt + (size_t)cur.pn * tstep;
    S.a_ready(cur);
    if constexpr (SP2) {
        PG8_STAGE(PG8_SB(0, 0), cB, voffB); PG8_STAGE(PG8_SB(0, 1), cB + hstep, voffB); PG8_STAGE(PG8_SA(0, 0), cA, voffA); PG8_STAGE(PG8_SA(0, 1), cA + hstep, voffA);
        if (wr == 1) PG8_BAR;
        PG8_WAIT_V(2); PG8_BAR;
        PG8_STAGE(PG8_SB(1, 0), cB + kstep, voffB); PG8_STAGE(PG8_SA(1, 0), cA + kstep, voffA); PG8_STAGE(PG8_SB(1, 1), cB + hstep + kstep, voffB);
        PG8_WAIT_V(6); PG8_BAR;
    } else {
        PG8_STAGE(PG8_SB(0, 0), cB, voffB); PG8_STAGE(PG8_SA(0, 0), cA, voffA); PG8_STAGE(PG8_SB(0, 1), cB + hstep, voffB); PG8_STAGE(PG8_SA(0, 1), cA + hstep, voffA);
        if (wr == 1) PG8_BAR;
        PG8_WAIT_V(4); PG8_BAR;
        PG8_STAGE(PG8_SB(1, 0), cB + kstep, voffB); PG8_STAGE(PG8_SA(1, 0), cA + kstep, voffA); PG8_STAGE(PG8_SB(1, 1), cB + hstep + kstep, voffB);
        PG8_WAIT_V(6); PG8_BAR;
    }
    for (;;) {
        const bool has_next = S.next(ui + 1, nxt);
        const char* nA = has_next ? (const char*)g.A + (size_t)nxt.pm * tstep : cA; const char* nB = has_next ? (const char*)g.Bt + (size_t)nxt.pn * tstep : cB;
        for (int t = 0; t < nt; t += 2) {
            const bool last = (t == nt - 2);
            const char* a1 = cA + (size_t)(t + 1) * kstep;
            const char* a2 = last ? nA : cA + (size_t)(t + 2) * kstep; const char* b2 = last ? nB : cB + (size_t)(t + 2) * kstep;
            const char* a3 = a2 + kstep; const char* b3 = b2 + kstep;
            if (last && has_next) S.a_ready(nxt);
            if constexpr (SP2) {
            PG8_LDB(B0, 0, 0); PG8_LDB(B1, 0, 1); PG8_SCHED; PG8_LDA(At, 0, 0); PG8_STAGE(PG8_SA(1, 1), a1 + hstep, voffA);
            PG8_WAIT_V(8); PG8_WAIT_L(0); PG8_BAR; PG8_MMA(0, 0, At, B0); PG8_MMA(0, 1, At, B1); PG8_BAR; PG8_SCHED;
            PG8_LDA(At, 0, 1); PG8_STAGE(PG8_SB(0, 0), b2, voffB); PG8_STAGE(PG8_SB(0, 1), b2 + hstep, voffB); PG8_STAGE(PG8_SA(0, 0), a2, voffA);
            PG8_WAIT_V(8); PG8_WAIT_L(0); PG8_BAR; PG8_MMA(1, 0, At, B0); PG8_MMA(1, 1, At, B1); PG8_BAR; PG8_SCHED;
            PG8_LDB(B0, 1, 0); PG8_LDB(B1, 1, 1); PG8_SCHED; PG8_LDA(At, 1, 0); PG8_STAGE(PG8_SA(0, 1), a2 + hstep, voffA);
            PG8_WAIT_V(8); PG8_WAIT_L(0); PG8_BAR; PG8_MMA(0, 0, At, B0); PG8_MMA(0, 1, At, B1); PG8_BAR; PG8_SCHED;
            PG8_LDA(At, 1, 1); PG8_STAGE(PG8_SB(1, 0), b3, voffB); PG8_STAGE(PG8_SB(1, 1), b3 + hstep, voffB); PG8_STAGE(PG8_SA(1, 0), a3, voffA);
            PG8_WAIT_V(8); PG8_WAIT_L(0); PG8_BAR; PG8_MMA(1, 0, At, B0); PG8_MMA(1, 1, At, B1); PG8_BAR; PG8_SCHED;
            } else {
            PG8_LDB(B0, 0, 0); PG8_SCHED; PG8_LDA(At, 0, 0); PG8_STAGE(PG8_SA(1, 1), a1 + hstep, voffA);
            PG8_WAIT_L(8); PG8_BAR; PG8_WAIT_L(0); PG8_MMA(0, 0, At, B0); PG8_BAR; PG8_SCHED;
            PG8_LDB(B1, 0, 1); PG8_STAGE(PG8_SB(0, 0), b2, voffB);
            PG8_BAR; PG8_WAIT_L(0); PG8_MMA(0, 1, At, B1); PG8_BAR;
            PG8_LDA(At, 0, 1); PG8_STAGE(PG8_SA(0, 0), a2, voffA);
            PG8_BAR; PG8_WAIT_L(0); PG8_MMA(1, 0, At, B0); PG8_BAR; PG8_SCHED;
            PG8_STAGE(PG8_SB(0, 1), b2 + hstep, voffB);
            PG8_WAIT_V(6); PG8_BAR; PG8_MMA(1, 1, At, B1); PG8_BAR;
            PG8_LDB(B0, 1, 0); PG8_SCHED; PG8_LDA(At, 1, 0); PG8_STAGE(PG8_SA(0, 1), a2 + hstep, voffA);
            PG8_WAIT_L(8); PG8_BAR; PG8_WAIT_L(0); PG8_MMA(0, 0, At, B0); PG8_BAR; PG8_SCHED;
            PG8_LDB(B1, 1, 1); PG8_STAGE(PG8_SB(1, 0), b3, voffB);
            PG8_BAR; PG8_WAIT_L(0); PG8_MMA(0, 1, At, B1); PG8_BAR;
            PG8_LDA(At, 1, 1); PG8_STAGE(PG8_SA(1, 0), a3, voffA);
            PG8_BAR; PG8_WAIT_L(0); PG8_MMA(1, 0, At, B0); PG8_BAR; PG8_SCHED;
            PG8_STAGE(PG8_SB(1, 1), b3 + hstep, voffB);
            PG8_WAIT_V(6); PG8_BAR; PG8_MMA(1, 1, At, B1); PG8_BAR;
            }
        }
        if constexpr (ALIGN_EPI) { if (wr == 0) PG8_BAR; }
        if constexpr (!Epi::AFTER_DRAIN) { E(acc, cur, wr, wc, fr, fq); S.done(cur); }
        if (!has_next) break;
#pragma unroll
        for (int a = 0; a < 2; ++a)
#pragma unroll
            for (int b = 0; b < 2; ++b)
#pragma unroll
                for (int m = 0; m < 4; ++m)
#pragma unroll
                    for (int n = 0; n < 2; ++n) acc[a][b][m][n] = (f32x4){0.f, 0.f, 0.f, 0.f};
        cur = nxt; cA = nA; cB = nB; ++ui;
        if constexpr (ALIGN_EPI) { if (wr == 1) PG8_BAR; }
    }
    PG8_WAIT_V(0);
    if constexpr (!ALIGN_EPI) { if (wr == 0) PG8_BAR; }
    PG8_BAR;
    if constexpr (Epi::AFTER_DRAIN) { E.fused(acc, cur, wr, wc, fr, fq, lds, wid, lane); S.done(cur); }
#undef PG8_SA
#undef PG8_SB
#undef PG8_STAGE
#undef PG8_LDA
#undef PG8_LDB
#undef PG8_MMA
#undef PG8_WAIT_V
#undef PG8_WAIT_L
#undef PG8_BAR
#undef PG8_SCHED
}
}
#define LAS __attribute__((address_space(3)))
typedef unsigned short bf16_t;
typedef short bf16x8 __attribute__((ext_vector_type(8)));
typedef short s16x4 __attribute__((ext_vector_type(4)));
typedef float f32x4 __attribute__((ext_vector_type(4)));
typedef float f32x16 __attribute__((ext_vector_type(16)));
typedef unsigned u32x4 __attribute__((ext_vector_type(4)));
typedef unsigned u32x2 __attribute__((ext_vector_type(2)));
typedef float f32x2_t __attribute__((ext_vector_type(2)));
typedef __bf16 bf16x2_t __attribute__((ext_vector_type(2)));

constexpr int NB = 2, SEQ = 16384, T = NB * SEQ, DM = 1024, DEPTH = 4, DFF = 2816, NGU = 2 * DFF;
constexpr int NIN_SRC = 2208, NPROJ = 3328;
constexpr int PA = 0, PC = 512, PD = 1024, PCQ = 1792, PCKV = 2048, PKR = 2176, PQUP = 2208, PKVUP = 2592, PEND = 3104;
constexpr float LOG2E = 1.4426950408889634f;
constexpr float NORM_EPS = 1e-5f;
constexpr int NWAVES = 8, NTHREADS = 512;
constexpr int LDS_BYTES = 147456;

constexpr size_t MiB = 1u << 20;
constexpr size_t WS_WGU = 0, WS_WD = 88 * MiB, WS_WIN = 132 * MiB, WS_WOUT = 158 * MiB, WS_XB = 166 * MiB;
constexpr size_t WS_H = 230 * MiB, WS_PROJ = 230 * MiB, WS_QB = 438 * MiB, WS_KB = 462 * MiB, WS_VB = 486 * MiB, WS_MIX = 502 * MiB, WS_AUG = 566 * MiB, WS_KMAX = 568 * MiB, WS_END = 569 * MiB;
constexpr size_t WGU_L = (size_t)2 * NGU * DM, WGU_F = (size_t)NGU * DM;
constexpr size_t WD_L = (size_t)2 * DM * DFF, WD_F = (size_t)DM * DFF;
constexpr size_t WIN_L = (size_t)NPROJ * DM, WOUT_L = (size_t)DM * DM;

struct Params {
    const float* x; const float* w_in; const float* win_sink; const float* mla_q_norm; const float* mla_w_uq; const float* mla_kv_norm; const float* mla_w_ukv;
    const float* ax_q_norm; const float* ax_k_norm; const float* diff_lambda; const float* diff_subln; const float* w_out; const float* ffn_w_gu; const float* ffn_w_down;
    const float* ln_g; const float* ln_b;
    float* out; unsigned char* ws;
    float lam_init[4];
    float inv32[16];
};

typedef const __attribute__((address_space(4))) Params* KP;
#define GETP(name) KP name = (KP)__builtin_amdgcn_kernarg_segment_ptr(); asm volatile("" : "+s"(name))

__device__ __forceinline__ int tid_fresh() { int t = threadIdx.x; asm volatile("" : "+v"(t)); return t; }
__device__ __forceinline__ unsigned pkbf(float lo, float hi) { f32x2_t v = {lo, hi}; bf16x2_t b = __builtin_convertvector(v, bf16x2_t); return __builtin_bit_cast(unsigned, b); }
__device__ __forceinline__ float bflo(unsigned w) { return __builtin_bit_cast(float, w << 16); }
__device__ __forceinline__ float bfhi(unsigned w) { return __builtin_bit_cast(float, w & 0xffff0000u); }
__device__ __forceinline__ float wave_sum(float v) {
#pragma unroll
    for (int o = 1; o < 64; o <<= 1) v += __shfl_xor(v, o);
    return v;
}
__device__ __forceinline__ void unpack8(const u32x4 w, float (&v)[8]) {
    v[0] = bflo(w.x); v[1] = bfhi(w.x); v[2] = bflo(w.y); v[3] = bfhi(w.y); v[4] = bflo(w.z); v[5] = bfhi(w.z); v[6] = bflo(w.w); v[7] = bfhi(w.w);
}
__device__ __forceinline__ u32x4 pack8(const float (&v)[8]) { u32x4 w; w.x = pkbf(v[0], v[1]); w.y = pkbf(v[2], v[3]); w.z = pkbf(v[4], v[5]); w.w = pkbf(v[6], v[7]); return w; }

__device__ __forceinline__ void transpose_item(const float* __restrict__ W, int ldw, int src_col0, float scale, bf16_t* __restrict__ WT, int K, int dst_row0, int k0, LAS float* scr, int lane) {
    if (src_col0 < 0) {
        const int c = lane & 7;
#pragma unroll
        for (int j = 0; j < 4; ++j) { const int n = (lane >> 3) + 8 * j; *(u32x4*)(WT + (size_t)(dst_row0 + n) * K + k0 + 8 * c) = (u32x4){0u, 0u, 0u, 0u}; }
        return;
    }
#pragma unroll 8
    for (int i = 0; i < 32; ++i) { const int kk = 2 * i + (lane >> 5); scr[kk * 33 + (lane & 31)] = W[(size_t)(k0 + kk) * ldw + src_col0 + (lane & 31)] * scale; }
    asm volatile("s_waitcnt lgkmcnt(0)" ::: "memory");
    const int c = lane & 7;
#pragma unroll
    for (int j = 0; j < 4; ++j) { const int n = (lane >> 3) + 8 * j; const LAS float* s = scr + (8 * c) * 33 + n;
        u32x4 o; o.x = pkbf(s[0 * 33], s[1 * 33]); o.y = pkbf(s[2 * 33], s[3 * 33]); o.z = pkbf(s[4 * 33], s[5 * 33]); o.w = pkbf(s[6 * 33], s[7 * 33]);
        *(u32x4*)(WT + (size_t)(dst_row0 + n) * K + k0 + 8 * c) = o; }
    asm volatile("s_waitcnt lgkmcnt(0)" ::: "memory");
}

__device__ __forceinline__ void phase0(KP p, LAS unsigned char* lds, int vcu, int G) {
    const int tid = tid_fresh(), lane = tid & 63, wave = __builtin_amdgcn_readfirstlane(tid >> 6);
    LAS float* scr = (LAS float*)(lds + wave * 16384);
    const int gw = vcu * NWAVES + wave, NGW = G * NWAVES;
    bf16_t* wgu = (bf16_t*)(p->ws + WS_WGU); bf16_t* wd = (bf16_t*)(p->ws + WS_WD); bf16_t* win = (bf16_t*)(p->ws + WS_WIN); bf16_t* wout = (bf16_t*)(p->ws + WS_WOUT);
    constexpr int I_GU = 176 * 16, I_WD = 32 * 44, I_IN = 104 * 16, I_OUT = 32 * 16, I_CMP = 112 * 16;
    constexpr int I_LAYER = 2 * I_GU + 2 * I_WD + I_IN + I_OUT + I_CMP;
    for (int it = gw; it < DEPTH * I_LAYER; it += NGW) {
        const int l = it / I_LAYER; int r = it % I_LAYER;
        if (r < 2 * I_GU) { const int f = r / I_GU; r %= I_GU; const int nb = r / 16, kb = r % 16; const int n0 = 32 * nb;
            const int pn = n0 >> 8, bj = (n0 >> 7) & 1, i0 = n0 & 127;
            transpose_item(p->ffn_w_gu + ((size_t)l * 2 + f) * DM * NGU, NGU, bj * DFF + 128 * pn + i0, 1.f, wgu + l * WGU_L + f * WGU_F, DM, n0, 64 * kb, scr, lane); continue; }
        r -= 2 * I_GU;
        if (r < 2 * I_WD) { const int f = r / I_WD; r %= I_WD; const int nb = r / 44, kb = r % 44;
            transpose_item(p->ffn_w_down + ((size_t)l * 2 + f) * DFF * DM, DM, 32 * nb, 1.f, wd + l * WD_L + f * WD_F, DFF, 32 * nb, 64 * kb, scr, lane); continue; }
        r -= 2 * I_WD;
        if (r < I_IN) { const int nb = r / 16, kb = r % 16; const int n0 = 32 * nb; int src; float sc = 1.f;
            if (n0 < PC) { src = n0; if (n0 < 256) sc = 0.125f; }
            else if (n0 < PD) src = 928 + (n0 - PC);
            else if (n0 < PCQ) { src = 1440 + (n0 - PD); if (n0 - PD < 256) sc = 0.17677669529663687f; }
            else if (n0 < PCKV) src = 512 + (n0 - PCQ);
            else if (n0 < PKR) src = 768 + (n0 - PCKV);
            else if (n0 < PQUP) src = 896;
            else if (n0 < PEND) continue;
            else src = -1;
            transpose_item(p->w_in + (size_t)l * DM * NIN_SRC, NIN_SRC, src, sc, win + l * WIN_L, DM, n0, 64 * kb, scr, lane); continue; }
        r -= I_IN;
        if (r < I_OUT) { const int nb = r / 16, kb = r % 16;
            transpose_item(p->w_out + (size_t)l * DM * DM, DM, 32 * nb, 1.f, wout + l * WOUT_L, DM, 32 * nb, 64 * kb, scr, lane); continue; }
        r -= I_OUT;
        {
            const int ng = r / 16, kb = r % 16; const int n0 = 8 * ng; const int k = 64 * kb + lane;
            int J, cA, ldu, nc; const float* g; const float* U;
            if (n0 < 384) { J = 256; cA = 512; g = p->mla_q_norm + l * 256; U = p->mla_w_uq + (size_t)l * 256 * 384; ldu = 384; nc = n0; }
            else { J = 128; cA = 768; g = p->mla_kv_norm + l * 128; U = p->mla_w_ukv + (size_t)l * 128 * 512; ldu = 512; nc = n0 - 384; }
            const float* a = p->w_in + (size_t)l * DM * NIN_SRC + (size_t)k * NIN_SRC + cA;
            float acc[8];
#pragma unroll
            for (int e = 0; e < 8; ++e) acc[e] = 0.f;
            for (int j = 0; j < J; j += 4) {
                const f32x4 av = *(const f32x4*)(a + j);
#pragma unroll
                for (int jj = 0; jj < 4; ++jj) { const float ag = av[jj] * g[j + jj]; const float* ur = U + (size_t)(j + jj) * ldu + nc;
#pragma unroll
                    for (int e = 0; e < 8; ++e) acc[e] = fmaf(ag, ur[e], acc[e]); }
            }
            bf16_t* o = win + l * WIN_L + (size_t)(PQUP + n0) * DM + k;
#pragma unroll
            for (int e = 0; e < 8; ++e) o[(size_t)e * DM] = (bf16_t)(pkbf(acc[e], 0.f) & 0xffffu);
        }
    }
    { u32x4* ag = (u32x4*)(p->ws + WS_AUG);
      for (int i = (vcu * NWAVES + wave) * 64 + lane; i < SEQ * 4; i += G * NWAVES * 64) { const int t = i >> 2, h = i & 3;
          const float sl = __builtin_amdgcn_exp2f(-(float)(5 + h));
          u32x4 w = {pkbf(sl * (float)(128 * (t >> 7)), sl * (float)(t & 127)), 0u, 0u, 0u}; ag[2 * i] = w; ag[2 * i + 1] = (u32x4){0u, 0u, 0u, 0u}; } }
    if (vcu == 0 && tid < DEPTH * 16) ((unsigned*)(p->ws + WS_KMAX))[tid] = 0u;
    bf16_t* xb = (bf16_t*)(p->ws + WS_XB);
    for (int m = gw; m < T; m += NGW) {
        const f32x4* xr = (const f32x4*)(p->x + (size_t)m * DM) + lane; u32x2* o8 = (u32x2*)(xb + (size_t)m * DM) + lane;
#pragma unroll
        for (int j = 0; j < 4; ++j) { const f32x4 v = xr[64 * j]; u32x2 w; w.x = pkbf(v.x, v.y); w.y = pkbf(v.z, v.w); o8[64 * j] = w; }
    }
}

__device__ __forceinline__ void ln_phase(float* X, bf16_t* xb, const float* __restrict__ g, const float* __restrict__ b, int vcu, int G) {
    const int tid = tid_fresh(), lane = tid & 63, wave = __builtin_amdgcn_readfirstlane(tid >> 6);
    const int gw = vcu * NWAVES + wave, NGW = G * NWAVES;
    f32x4 gv[4], bv[4];
#pragma unroll
    for (int j = 0; j < 4; ++j) { gv[j] = ((const f32x4*)g)[64 * j + lane]; bv[j] = ((const f32x4*)b)[64 * j + lane]; }
    for (int m = gw; m < T; m += NGW) {
        f32x4* xr = (f32x4*)(X + (size_t)m * DM) + lane; u32x2* o8 = (u32x2*)(xb + (size_t)m * DM) + lane;
        f32x4 v[4]; float s = 0.f;
#pragma unroll
        for (int j = 0; j < 4; ++j) { v[j] = xr[64 * j]; s += (v[j].x + v[j].y) + (v[j].z + v[j].w); }
        const float mean = wave_sum(s) * (1.f / DM); float s2 = 0.f;
#pragma unroll
        for (int j = 0; j < 4; ++j) { v[j] = v[j] - mean; s2 += (v[j].x * v[j].x + v[j].y * v[j].y) + (v[j].z * v[j].z + v[j].w * v[j].w); }
        const float rstd = 1.f / sqrtf(wave_sum(s2) * (1.f / DM) + NORM_EPS);
#pragma unroll
        for (int j = 0; j < 4; ++j) { const f32x4 y = v[j] * rstd * gv[j] + bv[j]; xr[64 * j] = y; u32x2 w; w.x = pkbf(y.x, y.y); w.y = pkbf(y.z, y.w); o8[64 * j] = w; }
    }
}

__device__ __forceinline__ void sincos_rev(float ang, float& s, float& c) {
    double d = (double)ang * 0.15915494309189535; d -= __builtin_rint(d); const float f = (float)d;
    s = __builtin_amdgcn_sinf(f); c = __builtin_amdgcn_cosf(f);
}
__device__ __forceinline__ void rope8(float (&v)[8], bool first, float pos, int i0, KP p) {
#pragma unroll
    for (int e = 0; e < 8; ++e) {
        const float other = __shfl_xor(v[e], 2);
        const float inv = i0 ? p->inv32[8 + e] : p->inv32[e];
        float s, c; sincos_rev(pos * inv, s, c);
        v[e] = first ? (v[e] * c - other * s) : (other * s + v[e] * c);
    }
}
__device__ __forceinline__ void prep_phase(KP p, int l, int vcu, int G) {
    const int tid = tid_fresh(), lane = tid & 63, wave = __builtin_amdgcn_readfirstlane(tid >> 6);
    const int gw = vcu * NWAVES + wave, NGW = G * NWAVES;
    bf16_t* proj = (bf16_t*)(p->ws + WS_PROJ); bf16_t* qb = (bf16_t*)(p->ws + WS_QB); bf16_t* kb = (bf16_t*)(p->ws + WS_KB); bf16_t* vb = (bf16_t*)(p->ws + WS_VB);
    float cg[8];
    { const float* gsrc = (lane < 32 ? p->ax_q_norm : p->ax_k_norm) + l * 64 + 8 * (lane & 7);
#pragma unroll
      for (int e = 0; e < 8; ++e) cg[e] = gsrc[e]; }
    float km0 = 0.f, km1 = 0.f;
    for (int tok = gw; tok < T; tok += NGW) {
        const int t = tok & (SEQ - 1);
        bf16_t* pr = proj + (size_t)tok * NPROJ;
        { float s = 0.f;
          if (lane < 32) { float v[8]; unpack8(*(const u32x4*)(pr + PD + 256 + 8 * lane), v);
#pragma unroll
              for (int e = 0; e < 8; ++e) s += v[e] * v[e]; }
          s += __shfl_xor(s, 1); s += __shfl_xor(s, 2);
          if (tok < SEQ) km0 = fmaxf(km0, s); else km1 = fmaxf(km1, s); }
        float ssq = 0.f;
        if (lane < 48) { float v[8]; unpack8(*(const u32x4*)(pr + PCQ + 8 * lane), v);
#pragma unroll
            for (int e = 0; e < 8; ++e) ssq += v[e] * v[e]; }
        const float ssq_q = wave_sum(lane < 32 ? ssq : 0.f), ssq_kv = wave_sum(lane >= 32 ? ssq : 0.f);
        const float rstd_q = 1.f / sqrtf(ssq_q * (1.f / 256.f) + NORM_EPS), rstd_kv = 1.f / sqrtf(ssq_kv * (1.f / 128.f) + NORM_EPS);
        {
            const int r = lane % 12; float v[8];
            if (lane < 48) unpack8(*(const u32x4*)(pr + PQUP + 8 * lane), v); else {
#pragma unroll
                for (int e = 0; e < 8; ++e) v[e] = 0.f; }
#pragma unroll
            for (int e = 0; e < 8; ++e) v[e] *= rstd_q;
            float w[8];
#pragma unroll
            for (int e = 0; e < 8; ++e) w[e] = v[e];
            rope8(w, r < 10, (float)t, 8 * (r & 1), p);
            const bool isr = (r >= 8); const float qs = 0.10206207261596575f;
#pragma unroll
            for (int e = 0; e < 8; ++e) v[e] = (isr ? w[e] : v[e]) * qs;
            if (lane < 48) *(u32x4*)(qb + (size_t)tok * 384 + 8 * lane) = pack8(v);
        }
        {
            float v[8]; unpack8(*(const u32x4*)(pr + PKVUP + 8 * lane), v);
#pragma unroll
            for (int e = 0; e < 8; ++e) v[e] *= rstd_kv;
            const int hd = lane >> 4, r = lane & 15;
            if (r < 8) *(u32x4*)(kb + (size_t)tok * 384 + hd * 96 + 8 * r) = pack8(v);
            else *(u32x4*)(vb + (size_t)tok * 256 + hd * 64 + 8 * (r - 8)) = pack8(v);
        }
        {
            float v[8];
            if (lane < 4) unpack8(*(const u32x4*)(pr + PKR + 8 * lane), v); else {
#pragma unroll
                for (int e = 0; e < 8; ++e) v[e] = 0.f; }
            rope8(v, (lane & 3) < 2, (float)t, 8 * (lane & 1), p);
            if (lane < 4) { const u32x4 w = pack8(v);
#pragma unroll
                for (int hd = 0; hd < 4; ++hd) *(u32x4*)(kb + (size_t)tok * 384 + hd * 96 + 64 + 8 * lane) = w; }
        }
        {
            float v[8];
            if (lane < 48) unpack8(*(const u32x4*)(pr + PC + 8 * lane), v); else {
#pragma unroll
                for (int e = 0; e < 8; ++e) v[e] = 0.f; }
            float s = 0.f;
#pragma unroll
            for (int e = 0; e < 8; ++e) s += v[e] * v[e];
            s += __shfl_xor(s, 1); s += __shfl_xor(s, 2); s += __shfl_xor(s, 4);
            const float rs = 1.f / sqrtf(s * (1.f / 64.f) + NORM_EPS);
#pragma unroll
            for (int e = 0; e < 8; ++e) v[e] = v[e] * rs * cg[e];
            const int r = lane & 7; const float pos = (r < 4) ? (float)(t >> 6) : (float)(t & 63);
            rope8(v, (r & 3) < 2, pos, 8 * (r & 1), p);
            if (lane < 32) {
#pragma unroll
                for (int e = 0; e < 8; ++e) v[e] *= 0.125f; }
            if (lane < 48) *(u32x4*)(pr + PC + 8 * lane) = pack8(v);
        }
    }
    if (lane < 32 && (lane & 3) == 0) { unsigned* km = (unsigned*)(p->ws + WS_KMAX) + l * 16 + (lane >> 2);
        atomicMax(km, __builtin_bit_cast(unsigned, km0)); atomicMax(km + 8, __builtin_bit_cast(unsigned, km1)); }
}

#ifndef ATT_TYPES
#define ATT_TYPES 15
#endif
namespace att {
typedef float f32x2 __attribute__((ext_vector_type(2)));
constexpr int VPITCH = 144, KBUF = 64 * 208, VBUF = 64 * VPITCH;
constexpr int ATT_LDS = 2 * KBUF + 2 * VBUF;
constexpr float RESCALE_T = 5.0f;
__device__ __forceinline__ s16x4 vtr(const LAS char* p) { return __builtin_bit_cast(s16x4, __builtin_amdgcn_ds_read_tr16_b64_v4i16((LAS s16x4*)p)); }
__device__ __forceinline__ void xhalf_swap(float m, float& a, float& b) {
    a = m; b = m;
    asm volatile("s_nop 1\n\tv_permlane32_swap_b32 %0, %1\n\ts_nop 1" : "+v"(a), "+v"(b));
}
__device__ __forceinline__ float xhalf_max(float m) { float a, b; xhalf_swap(m, a, b); return fmaxf(a, b); }
__device__ __forceinline__ float xhalf_sum(float m) { float a, b; xhalf_swap(m, a, b); return a + b; }
__device__ __forceinline__ float max3f(float a, float b, float c) { return fmaxf(fmaxf(a, b), c); }
#define ATT_MFMA(a, b, c) __builtin_amdgcn_mfma_f32_32x32x16_bf16((a), (b), (c), 0, 0, 0)

template <int DK, int MODE, bool INIT = true>
__device__ __forceinline__ void flash_pass(LAS char* lds, const bf16_t* __restrict__ Qg, int qp, const bf16_t* __restrict__ Kg, int kp, const bf16_t* __restrict__ Vg, int vp,
                                           const bf16_t* __restrict__ AUGg, int q0, int a0, int nA, int b0, int nt, float slope, f32x16& O0, f32x16& O1, float& Mout, float& Lout) {
    constexpr int DKL = DK + (MODE == 1 ? 16 : 0);
    constexpr int KPITCH = DKL * 2 + 16, NKC = 8 * DKL, CPR = DKL / 8, NKS = DK / 16;
    constexpr bool HAS_K1 = NKC > 512;
    constexpr int DUMMY = 2 * KBUF + 2 * VBUF;
    const int tid = tid_fresh(), lane = tid & 63, r32 = lane & 31, hi = lane >> 5; const int wid = __builtin_amdgcn_readfirstlane(tid >> 6);
    const int qrow = q0 + wid * 32 + r32;
    bf16x8 qf[NKS];
#pragma unroll
    for (int ks = 0; ks < NKS; ++ks) qf[ks] = *(const bf16x8*)(Qg + (size_t)qrow * qp + 16 * ks + 8 * hi);
    const int kc1 = tid + 512;
    const bool k0v = tid < NKC, k1v = HAS_K1 && kc1 < NKC;
    const int kr0 = k0v ? tid / CPR : 0, kcc0 = k0v ? tid % CPR : 0, kr1 = k1v ? kc1 / CPR : 0, kcc1 = k1v ? kc1 % CPR : 0, vr = tid >> 3, vcc = tid & 7;
    const bf16_t* kg0; size_t kst0;
    if (MODE == 1 && kcc0 >= DK / 8) { kg0 = AUGg + (size_t)kr0 * 64 + 8 * (kcc0 - DK / 8); kst0 = (size_t)64 * 64; } else { kg0 = Kg + (size_t)kr0 * kp + 8 * kcc0; kst0 = (size_t)64 * kp; }
    const bf16_t* kg1 = Kg + (size_t)kr1 * kp + 8 * kcc1; const size_t kst1 = (size_t)64 * kp;
    const bf16_t* vg = Vg + (size_t)vr * vp + 8 * vcc; const size_t vst = (size_t)64 * vp;
    const int kl0 = k0v ? kr0 * KPITCH + 16 * kcc0 : -1, kl1 = k1v ? kr1 * KPITCH + 16 * kcc1 : -1, vl = 2 * KBUF + vr * VPITCH + 16 * vcc;
    u32x4 rk0 = {0u, 0u, 0u, 0u}, rk1 = {0u, 0u, 0u, 0u}, rv = {0u, 0u, 0u, 0u};
#define ATT_KT(i) ((i) < nA ? a0 + (i) : b0 + ((i) - nA))
#define ATT_LOADK(kt) do { const size_t t_ = (size_t)(kt); rk0 = *(const u32x4*)(kg0 + t_ * kst0); if (HAS_K1) rk1 = *(const u32x4*)(kg1 + t_ * kst1); } while (0)
#define ATT_LOADV(kt) do { rv = *(const u32x4*)(vg + (size_t)(kt) * vst); } while (0)
#define ATT_STOREK(buf) do { *(LAS u32x4*)(lds + (kl0 >= 0 ? (buf) * KBUF + kl0 : DUMMY + tid * 16)) = rk0; if (HAS_K1) *(LAS u32x4*)(lds + (kl1 >= 0 ? (buf) * KBUF + kl1 : DUMMY + tid * 16)) = rk1; } while (0)
#define ATT_STOREV(buf) do { *(LAS u32x4*)(lds + (buf) * VBUF + vl) = rv; } while (0)
    const int q4 = (lane & 15) >> 2, p4 = lane & 3, b16 = (lane >> 4) & 1;
    const int vbase = 2 * KBUF + (4 * hi + q4) * VPITCH + 32 * b16 + 8 * p4;
    const int kbase = r32 * KPITCH + 16 * hi;
    const int qw = q0 + wid * 32;
    const float stq = slope * (float)qrow;
    const bf16x8 qzero = {0, 0, 0, 0, 0, 0, 0, 0};
    bf16x8 qpos = qzero, qneg = qzero;
    if (MODE == 1 && hi == 0) { qpos[0] = (short)0x3F80; qpos[1] = (short)0x3F80; qneg[0] = (short)0xBF80; qneg[1] = (short)0xBF80; }
    constexpr int NKF = NKS + (MODE == 1 ? 1 : 0);
    constexpr int KPRE = NKF > 4 ? 4 : NKF;
    bf16x8 kfa[NKF], kfb[NKF];
#define ATT_KREAD(kbuf, f0, f1) do { const LAS char* Kb_ = lds + (kbuf) * KBUF + kbase; \
        _Pragma("unroll") for (int ks_ = (f0); ks_ < (f1); ++ks_) { kfa[ks_] = *(const LAS bf16x8*)(Kb_ + 32 * ks_); kfb[ks_] = *(const LAS bf16x8*)(Kb_ + 32 * KPITCH + 32 * ks_); } } while (0)
#define ATT_QKM(sa, sb, side) do { \
        _Pragma("unroll") for (int e_ = 0; e_ < 16; ++e_) { sa[e_] = 0.f; sb[e_] = 0.f; } \
        _Pragma("unroll") for (int ks_ = 0; ks_ < NKS; ++ks_) { sa = ATT_MFMA(kfa[ks_], qf[ks_], sa); sb = ATT_MFMA(kfb[ks_], qf[ks_], sb); } \
        if (MODE == 1) { const bf16x8 qa_ = (side) < 0 ? qpos : ((side) > 0 ? qneg : qzero); sa = ATT_MFMA(kfa[NKS], qa_, sa); sb = ATT_MFMA(kfb[NKS], qa_, sb); } } while (0)
#define ATT_QK(sa, sb, kbuf, side) do { ATT_KREAD(kbuf, 0, NKF); ATT_QKM(sa, sb, side); } while (0)
    bf16x8 vfa[4], vfb[4];
#define ATT_VREAD(vbuf) do { const LAS char* Vb_ = lds + (vbuf) * VBUF + vbase; \
        _Pragma("unroll") for (int j_ = 0; j_ < 4; ++j_) { const LAS char* vp0_ = Vb_ + (16 * j_) * VPITCH; \
            { const s16x4 lo_ = vtr(vp0_), hh_ = vtr(vp0_ + 8 * VPITCH); vfa[j_] = __builtin_shufflevector(lo_, hh_, 0, 1, 2, 3, 4, 5, 6, 7); } \
            { const s16x4 lo_ = vtr(vp0_ + 64), hh_ = vtr(vp0_ + 8 * VPITCH + 64); vfb[j_] = __builtin_shufflevector(lo_, hh_, 0, 1, 2, 3, 4, 5, 6, 7); } } } while (0)
#define ATT_PVM() do { _Pragma("unroll") for (int j_ = 0; j_ < 4; ++j_) { O0 = ATT_MFMA(vfa[j_], pf[j_ >> 1][j_ & 1], O0); O1 = ATT_MFMA(vfb[j_], pf[j_ >> 1][j_ & 1], O1); } } while (0)
#define ATT_PV(vbuf) do { ATT_VREAD(vbuf); ATT_PVM(); } while (0)
#define ATT_SIDE(kt) ((MODE != 1) ? 0 : (((kt) * 64 + 63 < qw) ? -1 : (((kt) * 64 > qw + 31) ? 1 : 0)))
    ATT_LOADK(ATT_KT(0)); ATT_STOREK(0);
    ATT_LOADK(ATT_KT(1)); ATT_STOREK(1);
    ATT_STOREV(1);
    __syncthreads();
    float M = INIT ? -1e20f : Mout, L = INIT ? 0.f : Lout;
    if (INIT) {
#pragma unroll
        for (int i = 0; i < 16; ++i) { O0[i] = 0.f; O1[i] = 0.f; } }
    bf16x8 pf[2][2];
#pragma unroll
    for (int kb = 0; kb < 2; ++kb)
#pragma unroll
        for (int st = 0; st < 2; ++st) pf[kb][st] = qzero;
    f32x16 s0, s1, n0, n1;
    int side_cur = ATT_SIDE(ATT_KT(0));
    ATT_QK(s0, s1, 0, side_cur);
#pragma unroll
    for (int e = 0; e < 16; ++e) { n0[e] = 0.f; n1[e] = 0.f; }
    __syncthreads();
    constexpr int NMF = 2 * NKS + (MODE == 1 ? 2 : 0) + 8;
#define ATT_ITER(i, C0, C1, N0, N1, HASN, HASK2) do { \
        const int kt = ATT_KT(i); \
        if (HASK2) ATT_LOADK(ATT_KT((i) + 2)); \
        ATT_LOADV(kt); \
        if (HASN) ATT_KREAD(((i) + 1) & 1, 0, KPRE); \
        const int k0 = kt * 64; \
          \
        float rc = 0.f; \
        if (MODE == 1) { \
            if (side_cur != 0) rc = side_cur < 0 ? -stq : stq; \
            else { const float dbase = (float)(k0 + 4 * hi - qrow); \
                _Pragma("unroll") for (int e = 0; e < 16; ++e) { const float c = (float)((e & 3) + 8 * (e >> 2)); \
                    C0[e] = fmaf(-slope, fabsf(dbase + c), C0[e]); C1[e] = fmaf(-slope, fabsf(dbase + (c + 32.f)), C1[e]); } } \
        } \
        if (MODE == 2) { const float dbase = (float)(k0 + 4 * hi - qrow); \
            _Pragma("unroll") for (int e = 0; e < 16; ++e) { const float c = (float)((e & 3) + 8 * (e >> 2)); \
                const float d0 = fabsf(dbase + c), d1 = fabsf(dbase + (c + 32.f)); \
                C0[e] = (d0 <= 128.f) ? fmaf(-slope, d0, C0[e]) : -1e30f; C1[e] = (d1 <= 128.f) ? fmaf(-slope, d1, C1[e]) : -1e30f; } } \
        float mx = max3f(C0[0], C1[0], C0[1]); \
        _Pragma("unroll") for (int e = 1; e < 15; e += 2) { mx = max3f(mx, C1[e], C0[e + 1]); mx = max3f(mx, C1[e + 1], C0[e + 2]); } \
        mx = fmaxf(mx, C1[15]); \
        const float mt = xhalf_max(mx) + rc;                     \
        if (__builtin_amdgcn_ballot_w64(mt > M + RESCALE_T) != 0ull) {         \
            ATT_PV(((i) + 1) & 1); \
            _Pragma("unroll") for (int kb = 0; kb < 2; ++kb) _Pragma("unroll") for (int st = 0; st < 2; ++st) pf[kb][st] = qzero; \
            const float Mn = fmaxf(M, mt); const float alpha = __builtin_amdgcn_exp2f((M - Mn) * LOG2E); M = Mn; \
            L *= alpha; \
            _Pragma("unroll") for (int e = 0; e < 16; ++e) { O0[e] *= alpha; O1[e] *= alpha; } \
        } \
          \
        const int side_next = HASN ? ATT_SIDE(ATT_KT((i) + 1)) : 0; \
        if (HASN) ATT_KREAD(((i) + 1) & 1, KPRE, NKF); \
        ATT_VREAD(((i) + 1) & 1); \
        if (HASN) ATT_QKM(N0, N1, side_next); \
        ATT_PVM();                                   \
        const float cc = (rc - M) * LOG2E; \
        const f32x2 k2 = {LOG2E, LOG2E}, c2 = {cc, cc}; \
        f32x2 ps2 = {0.f, 0.f}; \
        _Pragma("unroll") for (int e = 0; e < 16; e += 2) { \
            f32x2 a = {C0[e], C0[e + 1]}, b = {C1[e], C1[e + 1]}; \
            a = a * k2 + c2; b = b * k2 + c2; \
            a.x = __builtin_amdgcn_exp2f(a.x); a.y = __builtin_amdgcn_exp2f(a.y); b.x = __builtin_amdgcn_exp2f(b.x); b.y = __builtin_amdgcn_exp2f(b.y); \
            ps2 += a; ps2 += b; \
            C0[e] = a.x; C0[e + 1] = a.y; C1[e] = b.x; C1[e + 1] = b.y; } \
        L += ps2.x + ps2.y; \
        _Pragma("unroll") for (int st = 0; st < 2; ++st) { u32x4 w0, w1; \
            w0.x = pkbf(C0[8 * st + 0], C0[8 * st + 1]); w0.y = pkbf(C0[8 * st + 2], C0[8 * st + 3]); w0.z = pkbf(C0[8 * st + 4], C0[8 * st + 5]); w0.w = pkbf(C0[8 * st + 6], C0[8 * st + 7]); \
            w1.x = pkbf(C1[8 * st + 0], C1[8 * st + 1]); w1.y = pkbf(C1[8 * st + 2], C1[8 * st + 3]); w1.z = pkbf(C1[8 * st + 4], C1[8 * st + 5]); w1.w = pkbf(C1[8 * st + 6], C1[8 * st + 7]); \
            pf[0][st] = __builtin_bit_cast(bf16x8, w0); pf[1][st] = __builtin_bit_cast(bf16x8, w1); } \
        side_cur = side_next; \
        if (HASN) { __builtin_amdgcn_sched_group_barrier(0x100, 16 + 2 * (NKF - KPRE), 0); \
            _Pragma("unroll") for (int g_ = 0; g_ < NMF; ++g_) { __builtin_amdgcn_sched_group_barrier(0x008, 1, 0); __builtin_amdgcn_sched_group_barrier(0x002, 6, 0); } } \
        if (HASK2) ATT_STOREK((i) & 1); \
        ATT_STOREV((i) & 1); \
        __syncthreads(); } while (0)
    for (int i = 0; i + 2 < nt; i += 2) {
        ATT_ITER(i, s0, s1, n0, n1, true, true);
        ATT_ITER(i + 1, n0, n1, s0, s1, true, true);
    }
    ATT_ITER(nt - 2, s0, s1, n0, n1, true, false);
    ATT_ITER(nt - 1, n0, n1, s0, s1, false, false);
    ATT_PV((nt - 1) & 1);
    __syncthreads();
#undef ATT_ITER
#undef ATT_LOADK
#undef ATT_LOADV
#undef ATT_STOREK
#undef ATT_STOREV
#undef ATT_KT
#undef ATT_QK
#undef ATT_PV
#undef ATT_KREAD
#undef ATT_QKM
#undef ATT_VREAD
#undef ATT_PVM
#undef ATT_SIDE
    Mout = M; Lout = L;
}

__device__ __forceinline__ void store_o(bf16_t* orow, const f32x16& O0, const f32x16& O1, int hi) {
#pragma unroll
    for (int g = 0; g < 4; ++g) {
        u32x2 w0, w1; w0.x = pkbf(O0[4 * g], O0[4 * g + 1]); w0.y = pkbf(O0[4 * g + 2], O0[4 * g + 3]); w1.x = pkbf(O1[4 * g], O1[4 * g + 1]); w1.y = pkbf(O1[4 * g + 2], O1[4 * g + 3]);
        *(u32x2*)(orow + 8 * g + 4 * hi) = w0; *(u32x2*)(orow + 32 + 8 * g + 4 * hi) = w1;
    }
}

__device__ __forceinline__ void attn_phase(KP p, int l, LAS char* lds, int vcu, int G) {
    const int tid = tid_fresh(), lane = tid & 63, r32 = lane & 31, hi = lane >> 5; const int wid = __builtin_amdgcn_readfirstlane(tid >> 6);
    const bf16_t* proj = (const bf16_t*)(p->ws + WS_PROJ); const bf16_t* qb = (const bf16_t*)(p->ws + WS_QB); const bf16_t* kb = (const bf16_t*)(p->ws + WS_KB); const bf16_t* vb = (const bf16_t*)(p->ws + WS_VB);
    const bf16_t* aug = (const bf16_t*)(p->ws + WS_AUG);
    bf16_t* mix = (bf16_t*)(p->ws + WS_MIX);
    float lam;
    { const float* lp = p->diff_lambda + l * 128; const float a = (lane < 32) ? lp[lane] * lp[32 + lane] : 0.f, b2 = (lane < 32) ? lp[64 + lane] * lp[96 + lane] : 0.f;
      lam = expf(wave_sum(a)) - expf(wave_sum(b2)) + p->lam_init[l]; }
    const float one_m_li = 1.f - p->lam_init[l];
    for (int u = vcu; u < 2048; u += G) {
        if (!((ATT_TYPES >> (u >> 9)) & 1)) continue;
        const int type = u >> 9, idx = u & 511, bh = idx >> 6, qblk = idx & 63, b = bh >> 2, hd = bh & 3, q0 = qblk * 256;
        const int qrow = q0 + wid * 32 + r32;
        const size_t tok0 = (size_t)b * SEQ;
        bf16_t* orow = mix + (tok0 + qrow) * DM;
        f32x16 O0, O1; float M, L;
        if (type == 0) {
            const int bD = idx >> 8, hD = ((idx >> 6) & 3) ^ (bD ? 3 : 0);
            const size_t tokD = (size_t)bD * SEQ;
            bf16_t* orowD = mix + (tokD + qrow) * DM;
            const float slope = __builtin_amdgcn_exp2f(-(float)(5 + hD));
            const bf16_t* base = proj + tokD * NPROJ + PD;
            const int d0 = q0 / 64;
            LAS float* asave = (LAS float*)(lds + 65536) + tid;
#pragma unroll 1
            for (int mp = 0; mp < 2; ++mp) {
                const bf16_t* Qm = base + 64 * hD + 32 * mp; const bf16_t* Km = base + 256 + 64 * hD + 32 * mp; const bf16_t* Vm = base + 512 + 64 * hD;
                flash_pass<32, 1, true>(lds, Qm, NPROJ, Km, NPROJ, Vm, NPROJ, aug + 16 * hD, q0, d0, 4, 0, 4, slope, O0, O1, M, L);
                float qn2 = 0.f;
                { const u32x4* qr = (const u32x4*)(Qm + (size_t)qrow * NPROJ);
#pragma unroll
                  for (int c = 0; c < 4; ++c) { float v[8]; unpack8(qr[c], v);
#pragma unroll
                      for (int e = 0; e < 8; ++e) qn2 += v[e] * v[e]; } }
                const float kmax = sqrtf(__builtin_bit_cast(float, ((const unsigned*)(p->ws + WS_KMAX))[l * 16 + bD * 8 + hD * 2 + mp]));
                float dc = (sqrtf(qn2) * kmax * 1.001f + 40.f - M) / slope;
                dc = fminf(fmaxf(dc, 0.f), 1.0e8f);
#pragma unroll
                for (int o = 1; o < 64; o <<= 1) dc = fmaxf(dc, __shfl_xor(dc, o));
                LAS float* red = (LAS float*)(lds + ATT_LDS + 16384);
                if (lane == 0) red[wid] = dc;
                __syncthreads();
#pragma unroll
                for (int w = 0; w < 8; ++w) dc = fmaxf(dc, red[w]);
                __syncthreads();
                const int dci = (int)dc + 1;
                const int lo_key = q0 - dci - 63;
                int ktlo = lo_key <= 0 ? 0 : (lo_key + 63) / 64; int kthi = (q0 + 255 + dci) / 64; if (kthi > SEQ / 64 - 1) kthi = SEQ / 64 - 1;
                if (ktlo > d0) ktlo = d0; if (kthi < d0 + 3) kthi = d0 + 3;
                if (((kthi - ktlo + 1) & 1) != 0) { if (ktlo > 0) --ktlo; else ++kthi; }
                const int nR = kthi - (d0 + 3), nL = d0 - ktlo;
                if (nR + nL > 0) flash_pass<32, 1, false>(lds, Qm, NPROJ, Km, NPROJ, Vm, NPROJ, aug + 16 * hD, q0, d0 + 4, nR, ktlo, nR + nL, slope, O0, O1, M, L);
                if (mp == 0) { const float i1 = 1.f / xhalf_sum(L);
#pragma unroll
                    for (int i = 0; i < 16; ++i) { asave[(2 * i) * NTHREADS] = O0[i] * i1; asave[(2 * i + 1) * NTHREADS] = O1[i] * i1; } }
            }
            const float i2 = lam / xhalf_sum(L);
            float ss = 0.f;
            f32x16 A0, A1;
#pragma unroll
            for (int i = 0; i < 16; ++i) { A0[i] = asave[(2 * i) * NTHREADS] - O0[i] * i2; A1[i] = asave[(2 * i + 1) * NTHREADS] - O1[i] * i2; ss += A0[i] * A0[i] + A1[i] * A1[i]; }
            ss = xhalf_sum(ss);
            const float rs = one_m_li / sqrtf(ss * (1.f / 64.f) + NORM_EPS);
            const float* sg = p->diff_subln + l * 64;
#pragma unroll
            for (int i = 0; i < 16; ++i) { const int dv = (i & 3) + 8 * (i >> 2) + 4 * hi; A0[i] *= rs * sg[dv]; A1[i] *= rs * sg[32 + dv]; }
            store_o(orowD + 768 + 64 * hD, A0, A1, hi);
        } else if (type == 1) {
            flash_pass<96, 0>(lds, qb + tok0 * 384 + 96 * hd, 384, kb + tok0 * 384 + 96 * hd, 384, vb + tok0 * 256 + 64 * hd, 256, nullptr, q0, q0 / 64, SEQ / 64 - q0 / 64, 0, SEQ / 64, 0.f, O0, O1, M, L);
            const float il = 1.f / xhalf_sum(L);
#pragma unroll
            for (int i = 0; i < 16; ++i) { O0[i] *= il; O1[i] *= il; }
            store_o(orow + 256 + 64 * hd, O0, O1, hi);
        } else if (type == 2) {
            const bf16_t* base = proj + tok0 * NPROJ + PC; const int hk = hd >> 1;
            flash_pass<64, 0>(lds, base + 64 * hd, NPROJ, base + 256 + 64 * hk, NPROJ, base + 384 + 64 * hk, NPROJ, nullptr, q0, q0 / 64, SEQ / 64 - q0 / 64, 0, SEQ / 64, 0.f, O0, O1, M, L);
            const float il = 1.f / xhalf_sum(L);
#pragma unroll
            for (int i = 0; i < 16; ++i) { O0[i] *= il; O1[i] *= il; }
            store_o(orow + 512 + 64 * hd, O0, O1, hi);
        } else {
            const bf16_t* base = proj + tok0 * NPROJ + PA; const int hk = hd >> 1;
            const float slope = __builtin_amdgcn_exp2f(-(float)(1 + hd));
            const int kt0 = (q0 >= 128) ? (q0 - 128) / 64 : 0; int kt1 = (q0 + 256 + 128) / 64; if (kt1 > SEQ / 64) kt1 = SEQ / 64;
            flash_pass<64, 2>(lds, base + 64 * hd, NPROJ, base + 256 + 64 * hk, NPROJ, base + 384 + 64 * hk, NPROJ, nullptr, q0, kt0, kt1 - kt0, 0, kt1 - kt0, slope, O0, O1, M, L);
            const float sink = p->win_sink[l * 4 + hd];
            const float il = 1.f / (xhalf_sum(L) + __builtin_amdgcn_exp2f((sink - M) * LOG2E));
#pragma unroll
            for (int i = 0; i < 16; ++i) { O0[i] *= il; O1[i] *= il; }
            store_o(orow + 64 * hd, O0, O1, hi);
        }
    }
}
}

#define GRID_SYNC() do { __builtin_amdgcn_fence(__ATOMIC_RELEASE, "agent"); grid.sync(); __builtin_amdgcn_fence(__ATOMIC_ACQUIRE, "agent"); } while (0)
#ifndef PH_MASK
#define PH_MASK 255
#endif
__global__ void __launch_bounds__(NTHREADS, 2) mega_fwd(Params p_by_value) {
    extern __shared__ __attribute__((aligned(16))) unsigned char lds_raw[];
    cg::grid_group grid = cg::this_grid();
    LAS unsigned char* lds = (LAS unsigned char*)lds_raw;
#define VCU(G_, bx_) (((G_) % 8 == 0) ? ((bx_) % 8) * ((G_) / 8) + (bx_) / 8 : (bx_))
    const float alpha = 1.681792830507429f;

    if (PH_MASK & 1) { GETP(p); const int G = gridDim.x, bx = blockIdx.x; phase0(p, lds, VCU(G, bx), G); }
    GRID_SYNC();
#pragma unroll 1
    for (int li = 0; li < DEPTH; ++li) {
#pragma unroll 1
        for (int fi = 0; fi < 2; ++fi) {
            if (fi == 1) {
                if (PH_MASK & 2) { GETP(p); int l = li; asm volatile("" : "+s"(l)); const int G = gridDim.x, bx = blockIdx.x;
                  pg8::Gemm g{(const bf16_t*)(p->ws + WS_XB), (const bf16_t*)(p->ws + WS_WIN) + l * WIN_L, T, NPROJ, DM}; pg8::StaticOrder S; S.init(T, NPROJ, G, bx);
                  pg8::EpiStoreBf16 E{(bf16_t*)(p->ws + WS_PROJ), NPROJ};
                  pg8::gemm_phase<pg8::EpiStoreBf16, pg8::StaticOrder, true, true>(lds, g, S, E); }
                GRID_SYNC();
                if (PH_MASK & 4) { GETP(p); int l = li; asm volatile("" : "+s"(l)); const int G = gridDim.x, bx = blockIdx.x; prep_phase(p, l, VCU(G, bx), G); }
                GRID_SYNC();
                if (PH_MASK & 8) { GETP(p); int l = li; asm volatile("" : "+s"(l)); const int G = gridDim.x, bx = blockIdx.x; att::attn_phase(p, l, (LAS char*)lds, VCU(G, bx), G); }
                GRID_SYNC();
                if (PH_MASK & 16) { GETP(p); int l = li; asm volatile("" : "+s"(l)); const int G = gridDim.x, bx = blockIdx.x;
                  pg8::Gemm g{(const bf16_t*)(p->ws + WS_MIX), (const bf16_t*)(p->ws + WS_WOUT) + l * WOUT_L, T, DM, DM}; pg8::StaticOrder S; S.init(T, DM, G, bx);
                  pg8::EpiResid E{p->out, p->out, DM, alpha, 1.0f};
                  pg8::gemm_phase<pg8::EpiResid, pg8::StaticOrder, true, true>(lds, g, S, E); }
                GRID_SYNC();
                if (PH_MASK & 32) { GETP(p); int l = li; asm volatile("" : "+s"(l)); const int G = gridDim.x, bx = blockIdx.x;
                  ln_phase(p->out, (bf16_t*)(p->ws + WS_XB), p->ln_g + (l * 3 + 1) * DM, p->ln_b + (l * 3 + 1) * DM, VCU(G, bx), G); }
                GRID_SYNC();
            }
            if (PH_MASK & 64) { GETP(p); int l = li, f = fi; asm volatile("" : "+s"(l), "+s"(f)); const int G = gridDim.x, bx = blockIdx.x;
              pg8::Gemm g{(const bf16_t*)(p->ws + WS_XB), (const bf16_t*)(p->ws + WS_WGU) + l * WGU_L + f * WGU_F, T, NGU, DM}; pg8::StaticOrder S; S.init(T, NGU, G, bx);
              pg8::EpiSwiGLU E{(bf16_t*)(p->ws + WS_H), DFF};
              pg8::gemm_phase<pg8::EpiSwiGLU, pg8::StaticOrder, true, true>(lds, g, S, E); }
            GRID_SYNC();
            if (PH_MASK & 128) { GETP(p); int l = li, f = fi; asm volatile("" : "+s"(l), "+s"(f)); const int G = gridDim.x, bx = blockIdx.x;
              pg8::Gemm g{(const bf16_t*)(p->ws + WS_H), (const bf16_t*)(p->ws + WS_WD) + l * WD_L + f * WD_F, T, DM, DFF}; pg8::StaticOrder S; S.init(T, DM, G, bx);
              pg8::EpiResid E{(l == 0 && f == 0) ? p->x : (const float*)p->out, p->out, DM, alpha, 0.5f};
              pg8::gemm_phase<pg8::EpiResid, pg8::StaticOrder, true, true>(lds, g, S, E); }
            GRID_SYNC();
            if (PH_MASK & 32) { GETP(p); int l = li, f = fi; asm volatile("" : "+s"(l), "+s"(f)); const int G = gridDim.x, bx = blockIdx.x;
              ln_phase(p->out, (bf16_t*)(p->ws + WS_XB), p->ln_g + (l * 3 + 2 * f) * DM, p->ln_b + (l * 3 + 2 * f) * DM, VCU(G, bx), G); }
            GRID_SYNC();
        }
    }
}

extern "C" void kernel_launch(void* const* d_in, const int* in_sizes, int n_in, void* d_out, int out_size, void* d_ws, size_t ws_size, hipStream_t stream) {
    static int grid = 0;
    if (grid == 0) {
        if (n_in != 16 || in_sizes[0] != T * DM || out_size != T * DM || ws_size < WS_END) { fprintf(stderr, "kernel_launch: unexpected shapes (n_in %d, in0 %d, out %d, ws %zu); nothing launched\n", n_in, n_in > 0 ? in_sizes[0] : -1, out_size, ws_size); grid = -1; return; }
        int dev = 0, cus = 0, per_cu = 0;
        hipGetDevice(&dev); hipDeviceGetAttribute(&cus, hipDeviceAttributeMultiprocessorCount, dev);
        if (hipFuncSetAttribute((const void*)mega_fwd, hipFuncAttributeMaxDynamicSharedMemorySize, LDS_BYTES) != hipSuccess) { fprintf(stderr, "kernel_launch: hipFuncSetAttribute failed\n"); grid = -1; return; }
        if (hipOccupancyMaxActiveBlocksPerMultiprocessor(&per_cu, (const void*)mega_fwd, NTHREADS, LDS_BYTES) != hipSuccess || per_cu < 1) { fprintf(stderr, "kernel_launch: occupancy query gave %d\n", per_cu); per_cu = 1; }
        (void)hipGetLastError();
        grid = cus * 1;
    }
    if (grid < 0) return;
    Params p{};
    p.x = (const float*)d_in[0]; p.w_in = (const float*)d_in[1]; p.win_sink = (const float*)d_in[2]; p.mla_q_norm = (const float*)d_in[3]; p.mla_w_uq = (const float*)d_in[4];
    p.mla_kv_norm = (const float*)d_in[5]; p.mla_w_ukv = (const float*)d_in[6]; p.ax_q_norm = (const float*)d_in[7]; p.ax_k_norm = (const float*)d_in[8]; p.diff_lambda = (const float*)d_in[9];
    p.diff_subln = (const float*)d_in[10]; p.w_out = (const float*)d_in[11]; p.ffn_w_gu = (const float*)d_in[12]; p.ffn_w_down = (const float*)d_in[13]; p.ln_g = (const float*)d_in[14]; p.ln_b = (const float*)d_in[15];
    p.out = (float*)d_out; p.ws = (unsigned char*)d_ws;
    for (int l = 0; l < 4; ++l) p.lam_init[l] = (float)(0.8 - 0.6 * exp(-0.3 * (double)l));
    for (int i = 0; i < 16; ++i) p.inv32[i] = (float)pow(10000.0, -(double)i / 16.0);
    void* args[] = {&p};
    hipError_t e = hipLaunchCooperativeKernel((const void*)mega_fwd, dim3(grid), dim3(NTHREADS), args, LDS_BYTES, stream);
    if (e != hipSuccess) fprintf(stderr, "kernel_launch: cooperative launch failed: %s (grid %d)\n", hipGetErrorString(e), grid);
}
```

```cpp
#include <hip/hip_runtime.h>
#include <hip/hip_cooperative_groups.h>
#include <cstdio>
#include <cstdint>
#include <cmath>
namespace cg = cooperative_groups;
namespace pg8 {
#define PG8_LAS __attribute__((address_space(3)))
typedef unsigned short bf16_t;
typedef short bf16x8 __attribute__((ext_vector_type(8)));
typedef float f32x4 __attribute__((ext_vector_type(4)));
typedef unsigned u32x4 __attribute__((ext_vector_type(4)));
constexpr int BM = 256, BK = 64, HALF = 128, HTB = HALF * BK * 2  , STAGE_BYTES = 8 * HTB, NXCD = 8, WGM = 8;

__host__ __device__ __forceinline__ int lds_byte(int r, int c) { const int st = (r >> 4) * 2 + (c >> 5), rr = r & 15, cc = c & 31, ob = rr * 64 + cc * 2; return st * 1024 + (ob ^ (((ob >> 9) & 1) << 5)); }
__host__ __device__ __forceinline__ void stage_rc(int b, int& R, int& C) { const int st = b / 1024, sb = b % 1024, swz = sb ^ (((sb >> 9) & 1) << 5); R = (st >> 1) * 16 + swz / 64; C = (st & 1) * 32 + (swz % 64) / 2; }
__host__ __device__ __forceinline__ int perm32(int rho) { const int n = rho >> 4, i = rho & 15; return 8 * (i >> 2) + 4 * n + (i & 3); }

struct Unit { int pm, pn; };
struct Gemm { const bf16_t* A; const bf16_t* Bt; int M, N, K; };

struct StaticOrder {
    int nM, nN, nwg, G, c;
    __host__ __device__ void init(int M, int N, int G_, int c_) { nM = M / BM; nN = N / BM; nwg = nM * nN; G = G_; c = c_; }
    __host__ __device__ bool next(int i, Unit& u) const {
        const long L = (long)i * G + c; if (L >= nwg) return false;
        int wgid = (int)L; { const int q = nwg / NXCD, r = nwg % NXCD, xcd = wgid % NXCD, off = wgid / NXCD; wgid = (xcd < r ? xcd * (q + 1) : r * (q + 1) + (xcd - r) * q) + off; }
        const int nig = WGM * nN, gid = wgid / nig, fm = gid * WGM, gsz = (nM - fm) < WGM ? (nM - fm) : WGM;
        u.pm = fm + ((wgid % nig) % gsz); u.pn = (wgid % nig) / gsz; return true;
    }
    __device__ __forceinline__ void a_ready(const Unit&) const {}
    __device__ __forceinline__ void done(const Unit&) const {}
};

__device__ __forceinline__ unsigned cvt_pk_bf16(float lo, float hi) { unsigned r; asm volatile("v_cvt_pk_bf16_f32 %0, %1, %2" : "=v"(r) : "v"(lo), "v"(hi)); return r; }
typedef float f32x2 __attribute__((ext_vector_type(2)));
typedef float f32x2 __attribute__((ext_vector_type(2)));
typedef unsigned u32x2 __attribute__((ext_vector_type(2)));

struct EpiStoreBf16 {
    static constexpr bool PERM = true, AFTER_DRAIN = false;
    bf16_t* O; int ldc;
    __device__ __forceinline__ void operator()(const f32x4 (&acc)[2][2][4][2], const Unit& u, int wr, int wc, int fr, int fq) const {
        const int row0 = u.pm * BM + wr * 64 + fr; const int col0 = u.pn * BM + wc * 32 + 8 * fq;
#pragma unroll
        for (int ai = 0; ai < 2; ++ai)
#pragma unroll
            for (int m = 0; m < 4; ++m) { bf16_t* rowp = O + (size_t)(row0 + ai * HALF + m * 16) * ldc + col0;
#pragma unroll
                for (int bj = 0; bj < 2; ++bj) { const f32x4 v0 = acc[ai][bj][m][0], v1 = acc[ai][bj][m][1];
                    u32x4 w; w.x = cvt_pk_bf16(v0[0], v0[1]); w.y = cvt_pk_bf16(v0[2], v0[3]); w.z = cvt_pk_bf16(v1[0], v1[1]); w.w = cvt_pk_bf16(v1[2], v1[3]);
                    *(u32x4*)(rowp + bj * HALF) = w; } }
    }
};

__device__ __forceinline__ float silu_mul(float g, float u) {
    const float e = __builtin_amdgcn_exp2f(-1.4426950408889634f * g);
    return g * u * __builtin_amdgcn_rcpf(1.0f + e);
}
struct EpiSwiGLU {
    static constexpr bool PERM = true, AFTER_DRAIN = false;
    bf16_t* H; int ldh;
    __device__ __forceinline__ void operator()(const f32x4 (&acc)[2][2][4][2], const Unit& u, int wr, int wc, int fr, int fq) const {
        const int row0 = u.pm * BM + wr * 64 + fr; const int col0 = u.pn * HALF + wc * 32 + 8 * fq;
#pragma unroll
        for (int ai = 0; ai < 2; ++ai)
#pragma unroll
            for (int m = 0; m < 4; ++m) { bf16_t* rowp = H + (size_t)(row0 + ai * HALF + m * 16) * ldh + col0;
                const f32x4 g0 = acc[ai][0][m][0], g1 = acc[ai][0][m][1], u0 = acc[ai][1][m][0], u1 = acc[ai][1][m][1];
                u32x4 w;
                w.x = cvt_pk_bf16(silu_mul(g0[0], u0[0]), silu_mul(g0[1], u0[1])); w.y = cvt_pk_bf16(silu_mul(g0[2], u0[2]), silu_mul(g0[3], u0[3]));
                w.z = cvt_pk_bf16(silu_mul(g1[0], u1[0]), silu_mul(g1[1], u1[1])); w.w = cvt_pk_bf16(silu_mul(g1[2], u1[2]), silu_mul(g1[3], u1[3]));
                *(u32x4*)rowp = w; }
    }
};

struct EpiResid {
    static constexpr bool PERM = false, AFTER_DRAIN = false;
    const float* src; float* dst; int ld; float alpha, beta;
    __device__ __forceinline__ void operator()(const f32x4 (&acc)[2][2][4][2], const Unit& u, int wr, int wc, int fr, int fq) const {
        const int col0 = u.pn * BM + wc * 32 + 4 * fq;
#pragma unroll
        for (int ai = 0; ai < 2; ++ai)
#pragma unroll
            for (int m = 0; m < 4; ++m) { const size_t off = (size_t)(u.pm * BM + ai * HALF + wr * 64 + m * 16 + fr) * ld + col0;
#pragma unroll
                for (int bj = 0; bj < 2; ++bj)
#pragma unroll
                    for (int n = 0; n < 2; ++n) { const f32x4 s = *(const f32x4*)(src + off + bj * HALF + n * 16);
                        *(f32x4*)(dst + off + bj * HALF + n * 16) = s * alpha + acc[ai][bj][m][n] * beta; } }
    }
};

constexpr float LN_EPS_F = 1e-5f;
template <bool HAS> __device__ __forceinline__ void ln_row_stats(const float* st, int row, float& mu, float& rs) {
    if (!HAS) { mu = 0.f; rs = 1.f; return; }
    const f32x2 s = *(const f32x2*)(st + 2 * (size_t)row);
    mu = s.x * (1.0f / 1024.0f); const float var = fmaxf(s.y * (1.0f / 1024.0f) - mu * mu, 0.f); rs = 1.0f / sqrtf(var + LN_EPS_F);
}
struct EpiStoreBf16LN {
    static constexpr bool PERM = true, AFTER_DRAIN = false;
    bf16_t* O; int ldc; const float* st; const float* c1; const float* c2;
    __device__ __forceinline__ void operator()(const f32x4 (&acc)[2][2][4][2], const Unit& u, int wr, int wc, int fr, int fq) const {
        int row0 = u.pm * BM + wr * 64 + fr; int col0 = u.pn * BM + wc * 32 + 8 * fq;
        asm volatile("" : "+v"(row0), "+v"(col0));
        f32x4 c1v[2][2], c2v[2][2];
#pragma unroll
        for (int bj = 0; bj < 2; ++bj)
#pragma unroll
            for (int n = 0; n < 2; ++n) { c1v[bj][n] = *(const f32x4*)(c1 + col0 + bj * HALF + 4 * n); c2v[bj][n] = *(const f32x4*)(c2 + col0 + bj * HALF + 4 * n); }
#pragma unroll
        for (int ai = 0; ai < 2; ++ai)
#pragma unroll
            for (int m = 0; m < 4; ++m) { const int row = row0 + ai * HALF + m * 16; float mu, rs; ln_row_stats<true>(st, row, mu, rs);
                bf16_t* rowp = O + (size_t)row * ldc + col0;
#pragma unroll
                for (int bj = 0; bj < 2; ++bj) { const f32x4 v0 = (acc[ai][bj][m][0] - c1v[bj][0] * mu) * rs + c2v[bj][0], v1 = (acc[ai][bj][m][1] - c1v[bj][1] * mu) * rs + c2v[bj][1];
                    u32x4 w; w.x = cvt_pk_bf16(v0[0], v0[1]); w.y = cvt_pk_bf16(v0[2], v0[3]); w.z = cvt_pk_bf16(v1[0], v1[1]); w.w = cvt_pk_bf16(v1[2], v1[3]);
                    *(u32x4*)(rowp + bj * HALF) = w; } }
    }
};
template <bool HAS_LN> struct EpiSwiGLULN {
    static constexpr bool PERM = true, AFTER_DRAIN = false;
    bf16_t* H; int ldh; const float* st; const float* c1; const float* c2;
    __device__ __forceinline__ void operator()(const f32x4 (&acc)[2][2][4][2], const Unit& u, int wr, int wc, int fr, int fq) const {
        int row0 = u.pm * BM + wr * 64 + fr; const int col0 = u.pn * HALF + wc * 32 + 8 * fq; int wcol0 = u.pn * BM + wc * 32 + 8 * fq;
        asm volatile("" : "+v"(row0), "+v"(wcol0));
        f32x4 c1v[2][2], c2v[2][2];
#pragma unroll
        for (int bj = 0; bj < 2; ++bj)
#pragma unroll
            for (int n = 0; n < 2; ++n) { c1v[bj][n] = *(const f32x4*)(c1 + wcol0 + bj * HALF + 4 * n); c2v[bj][n] = *(const f32x4*)(c2 + wcol0 + bj * HALF + 4 * n); }
#pragma unroll
        for (int ai = 0; ai < 2; ++ai)
#pragma unroll
            for (int m = 0; m < 4; ++m) { const int row = row0 + ai * HALF + m * 16; float mu, rs; ln_row_stats<HAS_LN>(st, row, mu, rs);
                bf16_t* rowp = H + (size_t)row * ldh + col0;
                const f32x4 g0 = (acc[ai][0][m][0] - c1v[0][0] * mu) * rs + c2v[0][0], g1 = (acc[ai][0][m][1] - c1v[0][1] * mu) * rs + c2v[0][1];
                const f32x4 u0 = (acc[ai][1][m][0] - c1v[1][0] * mu) * rs + c2v[1][0], u1 = (acc[ai][1][m][1] - c1v[1][1] * mu) * rs + c2v[1][1];
                u32x4 w;
                w.x = cvt_pk_bf16(silu_mul(g0[0], u0[0]), silu_mul(g0[1], u0[1])); w.y = cvt_pk_bf16(silu_mul(g0[2], u0[2]), silu_mul(g0[3], u0[3]));
                w.z = cvt_pk_bf16(silu_mul(g1[0], u1[0]), silu_mul(g1[1], u1[1])); w.w = cvt_pk_bf16(silu_mul(g1[2], u1[2]), silu_mul(g1[3], u1[3]));
                *(u32x4*)rowp = w; }
    }
};
constexpr size_t EPI_WS_XB = (size_t)166 << 20, EPI_WS_STATS = ((size_t)568 << 20) + ((size_t)1 << 20); constexpr int EPI_T = 32768;
template <bool HAS_LN> struct EpiResidLN {
    static constexpr bool PERM = false, AFTER_DRAIN = false;
    static constexpr int ld = 1024;
    const float* src; float* dst; unsigned char* ws; const float* g_in; const float* b_in; int s_in; float alpha, beta;
    __device__ __forceinline__ void operator()(const f32x4 (&acc)[2][2][4][2], const Unit& u, int wr, int wc, int fr, int fq) const {
        int col0 = u.pn * BM + wc * 32 + 4 * fq; int rowb = u.pm * BM + wr * 64 + fr;
        asm volatile("" : "+v"(col0), "+v"(rowb));
        const float* rd = HAS_LN ? (const float*)dst : src;
        bf16_t* yb = (bf16_t*)(ws + EPI_WS_XB);
        const float* st_in = (const float*)(ws + EPI_WS_STATS) + (size_t)s_in * EPI_T * 2; float* st_out = (float*)(ws + EPI_WS_STATS) + (size_t)(s_in + 1) * EPI_T * 2;
        f32x4 gv[2][2], bv[2][2];
#pragma unroll
        for (int bj = 0; bj < 2; ++bj)
#pragma unroll
            for (int n = 0; n < 2; ++n) { if (HAS_LN) { gv[bj][n] = *(const f32x4*)(g_in + col0 + bj * HALF + n * 16); bv[bj][n] = *(const f32x4*)(b_in + col0 + bj * HALF + n * 16); }
                                          else { gv[bj][n] = (f32x4){1.f, 1.f, 1.f, 1.f}; bv[bj][n] = (f32x4){0.f, 0.f, 0.f, 0.f}; } }
#pragma unroll
        for (int ai = 0; ai < 2; ++ai)
#pragma unroll
            for (int m = 0; m < 4; ++m) { const int row = rowb + ai * HALF + m * 16; const size_t off = (size_t)row * ld + col0;
                float mu, rs; ln_row_stats<HAS_LN>(st_in, row, mu, rs);
                float ps = 0.f, pq = 0.f;
#pragma unroll
                for (int bj = 0; bj < 2; ++bj)
#pragma unroll
                    for (int n = 0; n < 2; ++n) { const f32x4 y = *(const f32x4*)(rd + off + bj * HALF + n * 16);
                        const f32x4 x = HAS_LN ? (y - mu) * rs * gv[bj][n] + bv[bj][n] : y;
                        const f32x4 yn = x * alpha + acc[ai][bj][m][n] * beta;
                        *(f32x4*)(dst + off + bj * HALF + n * 16) = yn;
                        u32x2 w; w.x = cvt_pk_bf16(yn[0], yn[1]); w.y = cvt_pk_bf16(yn[2], yn[3]); *(u32x2*)(yb + off + bj * HALF + n * 16) = w;
                        ps += (yn[0] + yn[1]) + (yn[2] + yn[3]); pq += (yn[0] * yn[0] + yn[1] * yn[1]) + (yn[2] * yn[2] + yn[3] * yn[3]); }
                ps += __shfl_xor(ps, 16); ps += __shfl_xor(ps, 32); pq += __shfl_xor(pq, 16); pq += __shfl_xor(pq, 32);
                if (fq == 0) { atomicAdd(st_out + 2 * (size_t)row, ps); atomicAdd(st_out + 2 * (size_t)row + 1, pq); } }
    }
};
template <class Epi, class Sched, bool ALIGN_EPI = false, bool SP2 = false>
__device__ __forceinline__ void gemm_phase(PG8_LAS unsigned char* lds, const Gemm g, const Sched S, const Epi E) {
    int tid_ = threadIdx.x; asm volatile("" : "+v"(tid_));
    const int tid = tid_, wid = __builtin_amdgcn_readfirstlane(tid >> 6), lane = tid & 63, wr = wid >> 2, wc = wid & 3, fr = lane & 15, fq = lane >> 4;
    const int K = g.K, nt = K / BK;
    unsigned voffA[2], voffB[2];
#pragma unroll
    for (int i = 0; i < 2; ++i) { int R, C; stage_rc(tid * 16 + i * 8192, R, C); const int Rb = Epi::PERM ? ((R & ~31) + perm32(R & 31)) : R;
        voffA[i] = (unsigned)(R * K + C) * 2u; voffB[i] = (unsigned)(Rb * K + C) * 2u; }
    const size_t kstep = (size_t)(BK * 2);
    const size_t hstep = (size_t)HALF * K * 2;
    const size_t tstep = 2 * hstep;
    const unsigned ldsw = (unsigned)wid * 1024u;
    const int aoff = lds_byte(wr * 64 + fr, fq * 8), boff = lds_byte(wc * 32 + fr, fq * 8);
#define PG8_SA(b, h) (((b) * 2 + (h)) * HTB)
#define PG8_SB(b, h) ((4 + (b) * 2 + (h)) * HTB)
#define PG8_STAGE(bufoff, gbase, voff) do { _Pragma("unroll") for (int _i = 0; _i < 2; ++_i) \
        __builtin_amdgcn_global_load_lds((const unsigned*)((const char*)(gbase) + (voff)[_i]), (PG8_LAS unsigned*)(lds + (bufoff) + ldsw + _i * 8192), 16, 0, 0); } while (0)
#define PG8_LDA(dst, b, h) do { _Pragma("unroll") for (int m = 0; m < 4; ++m) _Pragma("unroll") for (int k = 0; k < 2; ++k) dst[m][k] = *(const PG8_LAS bf16x8*)(lds + PG8_SA(b, h) + aoff + m * 2048 + k * 1024); } while (0)
#define PG8_LDB(dst, b, h) do { _Pragma("unroll") for (int n = 0; n < 2; ++n) _Pragma("unroll") for (int k = 0; k < 2; ++k) dst[n][k] = *(const PG8_LAS bf16x8*)(lds + PG8_SB(b, h) + boff + n * 2048 + k * 1024); } while (0)
#define PG8_MMA(ai, bj, At, Bt) do { __builtin_amdgcn_s_setprio(1); _Pragma("unroll") for (int m = 0; m < 4; ++m) _Pragma("unroll") for (int n = 0; n < 2; ++n) _Pragma("unroll") for (int k = 0; k < 2; ++k) \
        acc[ai][bj][m][n] = __builtin_amdgcn_mfma_f32_16x16x32_bf16(Bt[n][k], At[m][k], acc[ai][bj][m][n], 0, 0, 0); __builtin_amdgcn_s_setprio(0); } while (0)
#define PG8_WAIT_V(n) asm volatile("s_waitcnt vmcnt(" #n ")" ::: "memory")
#define PG8_WAIT_L(n) asm volatile("s_waitcnt lgkmcnt(" #n ")" ::: "memory")
#define PG8_BAR __builtin_amdgcn_s_barrier()
#define PG8_SCHED __builtin_amdgcn_sched_barrier(0)
    Unit cur, nxt; int ui = 0;
    if (!S.next(0, cur)) return;
    f32x4 acc[2][2][4][2];
#pragma unroll
    for (int a = 0; a < 2; ++a)
#pragma unroll
        for (int b = 0; b < 2; ++b)
#pragma unroll
            for (int m = 0; m < 4; ++m)
#pragma unroll
                for (int n = 0; n < 2; ++n) acc[a][b][m][n] = (f32x4){0.f, 0.f, 0.f, 0.f};
    bf16x8 At[4][2], B0[2][2], B1[2][2];
    const char* cA = (const char*)g.A + (size_t)cur.pm * tstep; const char* cB = (const char*)g.Bt + (size_t)cur.pn * tstep;
    S.a_ready(cur);
    if constexpr (SP2) {
        PG8_STAGE(PG8_SB(0, 0), cB, voffB); PG8_STAGE(PG8_SB(0, 1), cB + hstep, voffB); PG8_STAGE(PG8_SA(0, 0), cA, voffA); PG8_STAGE(PG8_SA(0, 1), cA + hstep, voffA);
        if (wr == 1) PG8_BAR;
        PG8_WAIT_V(2); PG8_BAR;
        PG8_STAGE(PG8_SB(1, 0), cB + kstep, voffB); PG8_STAGE(PG8_SA(1, 0), cA + kstep, voffA); PG8_STAGE(PG8_SB(1, 1), cB + hstep + kstep, voffB);
        PG8_WAIT_V(6); PG8_BAR;
    } else {
        PG8_STAGE(PG8_SB(0, 0), cB, voffB); PG8_STAGE(PG8_SA(0, 0), cA, voffA); PG8_STAGE(PG8_SB(0, 1), cB + hstep, voffB); PG8_STAGE(PG8_SA(0, 1), cA + hstep, voffA);
        if (wr == 1) PG8_BAR;
        PG8_WAIT_V(4); PG8_BAR;
        PG8_STAGE(PG8_SB(1, 0), cB + kstep, voffB); PG8_STAGE(PG8_SA(1, 0), cA + kstep, voffA); PG8_STAGE(PG8_SB(1, 1), cB + hstep + kstep, voffB);
        PG8_WAIT_V(6); PG8_BAR;
    }
    for (;;) {
        const bool has_next = S.next(ui + 1, nxt);
        const char* nA = has_next ? (const char*)g.A + (size_t)nxt.pm * tstep : cA; const char* nB = has_next ? (const char*)g.Bt + (size_t)nxt.pn * tstep : cB;
        for (int t = 0; t < nt; t += 2) {
            const bool last = (t == nt - 2);
            const char* a1 = cA + (size_t)(t + 1) * kstep;
            const char* a2 = last ? nA : cA + (size_t)(t + 2) * kstep; const char* b2 = last ? nB : cB + (size_t)(t + 2) * kstep;
            const char* a3 = a2 + kstep; const char* b3 = b2 + kstep;
            if (last && has_next) S.a_ready(nxt);
            if constexpr (SP2) {
            PG8_LDB(B0, 0, 0); PG8_LDB(B1, 0, 1); PG8_SCHED; PG8_LDA(At, 0, 0); PG8_STAGE(PG8_SA(1, 1), a1 + hstep, voffA);
            PG8_WAIT_V(8); PG8_WAIT_L(0); PG8_BAR; PG8_MMA(0, 0, At, B0); PG8_MMA(0, 1, At, B1); PG8_BAR; PG8_SCHED;
            PG8_LDA(At, 0, 1); PG8_STAGE(PG8_SB(0, 0), b2, voffB); PG8_STAGE(PG8_SB(0, 1), b2 + hstep, voffB); PG8_STAGE(PG8_SA(0, 0), a2, voffA);
            PG8_WAIT_V(8); PG8_WAIT_L(0); PG8_BAR; PG8_MMA(1, 0, At, B0); PG8_MMA(1, 1, At, B1); PG8_BAR; PG8_SCHED;
            PG8_LDB(B0, 1, 0); PG8_LDB(B1, 1, 1); PG8_SCHED; PG8_LDA(At, 1, 0); PG8_STAGE(PG8_SA(0, 1), a2 + hstep, voffA);
            PG8_WAIT_V(8); PG8_WAIT_L(0); PG8_BAR; PG8_MMA(0, 0, At, B0); PG8_MMA(0, 1, At, B1); PG8_BAR; PG8_SCHED;
            PG8_LDA(At, 1, 1); PG8_STAGE(PG8_SB(1, 0), b3, voffB); PG8_STAGE(PG8_SB(1, 1), b3 + hstep, voffB); PG8_STAGE(PG8_SA(1, 0), a3, voffA);
            PG8_WAIT_V(8); PG8_WAIT_L(0); PG8_BAR; PG8_MMA(1, 0, At, B0); PG8_MMA(1, 1, At, B1); PG8_BAR; PG8_SCHED;
            } else {
            PG8_LDB(B0, 0, 0); PG8_SCHED; PG8_LDA(At, 0, 0); PG8_STAGE(PG8_SA(1, 1), a1 + hstep, voffA);
            PG8_WAIT_L(8); PG8_BAR; PG8_WAIT_L(0); PG8_MMA(0, 0, At, B0); PG8_BAR; PG8_SCHED;
            PG8_LDB(B1, 0, 1); PG8_STAGE(PG8_SB(0, 0), b2, voffB);
            PG8_BAR; PG8_WAIT_L(0); PG8_MMA(0, 1, At, B1); PG8_BAR;
            PG8_LDA(At, 0, 1); PG8_STAGE(PG8_SA(0, 0), a2, voffA);
            PG8_BAR; PG8_WAIT_L(0); PG8_MMA(1, 0, At, B0); PG8_BAR; PG8_SCHED;
            PG8_STAGE(PG8_SB(0, 1), b2 + hstep, voffB);
            PG8_WAIT_V(6); PG8_BAR; PG8_MMA(1, 1, At, B1); PG8_BAR;
            PG8_LDB(B0, 1, 0); PG8_SCHED; PG8_LDA(At, 1, 0); PG8_STAGE(PG8_SA(0, 1), a2 + hstep, voffA);
            PG8_WAIT_L(8); PG8_BAR; PG8_WAIT_L(0); PG8_MMA(0, 0, At, B0); PG8_BAR; PG8_SCHED;
            PG8_LDB(B1, 1, 1); PG8_STAGE(PG8_SB(1, 0), b3, voffB);
            PG8_BAR; PG8_WAIT_L(0); PG8_MMA(0, 1, At, B1); PG8_BAR;
            PG8_LDA(At, 1, 1); PG8_STAGE(PG8_SA(1, 0), a3, voffA);
            PG8_BAR; PG8_WAIT_L(0); PG8_MMA(1, 0, At, B0); PG8_BAR; PG8_SCHED;
            PG8_STAGE(PG8_SB(1, 1), b3 + hstep, voffB);
            PG8_WAIT_V(6); PG8_BAR; PG8_MMA(1, 1, At, B1); PG8_BAR;
            }
        }
        if constexpr (ALIGN_EPI) { if (wr == 0) PG8_BAR; }
        if constexpr (!Epi::AFTER_DRAIN) { E(acc, cur, wr, wc, fr, fq); S.done(cur); }
        if (!has_next) break;
#pragma unroll
        for (int a = 0; a < 2; ++a)
#pragma unroll
            for (int b = 0; b < 2; ++b)
#pragma unroll
                for (int m = 0; m < 4; ++m)
#pragma unroll
                    for (int n = 0; n < 2; ++n) acc[a][b][m][n] = (f32x4){0.f, 0.f, 0.f, 0.f};
        cur = nxt; cA = nA; cB = nB; ++ui;
        if constexpr (ALIGN_EPI) { if (wr == 1) PG8_BAR; }
    }
    PG8_WAIT_V(0);
    if constexpr (!ALIGN_EPI) { if (wr == 0) PG8_BAR; }
    PG8_BAR;
    if constexpr (Epi::AFTER_DRAIN) { E.fused(acc, cur, wr, wc, fr, fq, lds, wid, lane); S.done(cur); }
#undef PG8_SA
#undef PG8_SB
#undef PG8_STAGE
#undef PG8_LDA
#undef PG8_LDB
#undef PG8_MMA
#undef PG8_WAIT_V
#undef PG8_WAIT_L
#undef PG8_BAR
#undef PG8_SCHED
}
}
#define LAS __attribute__((address_space(3)))
typedef unsigned short bf16_t;
typedef short bf16x8 __attribute__((ext_vector_type(8)));
typedef short s16x4 __attribute__((ext_vector_type(4)));
typedef float f32x4 __attribute__((ext_vector_type(4)));
typedef float f32x16 __attribute__((ext_vector_type(16)));
typedef unsigned u32x4 __attribute__((ext_vector_type(4)));
typedef unsigned u32x2 __attribute__((ext_vector_type(2)));
typedef float f32x2_t __attribute__((ext_vector_type(2)));
typedef __bf16 bf16x2_t __attribute__((ext_vector_type(2)));

constexpr int NB = 2, SEQ = 16384, T = NB * SEQ, DM = 1024, DEPTH = 4, DFF = 2816, NGU = 2 * DFF;
constexpr int NIN_SRC = 2208, NPROJ = 3328;
constexpr int PA = 0, PC = 512, PD = 1024, PCQ = 1792, PCKV = 2048, PKR = 2176, PQUP = 2208, PKVUP = 2592, PEND = 3104;
constexpr float LOG2E = 1.4426950408889634f;
constexpr float NORM_EPS = 1e-5f;
constexpr int NWAVES = 8, NTHREADS = 512;
constexpr int LDS_BYTES = 147456;

constexpr size_t MiB = 1u << 20;
constexpr size_t WS_WGU = 0, WS_WD = 88 * MiB, WS_WIN = 132 * MiB, WS_WOUT = 158 * MiB, WS_XB = 166 * MiB;
constexpr size_t WS_H = 230 * MiB, WS_PROJ = 230 * MiB, WS_QB = 438 * MiB, WS_KB = 462 * MiB, WS_VB = 486 * MiB, WS_MIX = 502 * MiB, WS_AUG = 566 * MiB, WS_CTL = 568 * MiB, WS_KMAX = WS_CTL, WS_C12 = WS_CTL + 4096, WS_STATS = WS_CTL + 1 * MiB, CTL_BYTES = 4 * MiB, WS_END = 572 * MiB;
constexpr int C12_L = 2 * NGU + NPROJ;
constexpr size_t C2_OFF = (size_t)DEPTH * C12_L;
static_assert(pg8::EPI_WS_XB == WS_XB && pg8::EPI_WS_STATS == WS_STATS && pg8::EPI_T == T, "part1's copies of the workspace map");
static_assert(WS_C12 + 2 * C2_OFF * 4 <= WS_STATS && WS_STATS + (size_t)12 * T * 8 <= WS_CTL + CTL_BYTES, "control region");
constexpr size_t WGU_L = (size_t)2 * NGU * DM, WGU_F = (size_t)NGU * DM;
constexpr size_t WD_L = (size_t)2 * DM * DFF, WD_F = (size_t)DM * DFF;
constexpr size_t WIN_L = (size_t)NPROJ * DM, WOUT_L = (size_t)DM * DM;

struct Params {
    const float* x; const float* w_in; const float* win_sink; const float* mla_q_norm; const float* mla_w_uq; const float* mla_kv_norm; const float* mla_w_ukv;
    const float* ax_q_norm; const float* ax_k_norm; const float* diff_lambda; const float* diff_subln; const float* w_out; const float* ffn_w_gu; const float* ffn_w_down;
    const float* ln_g; const float* ln_b;
    float* out; unsigned char* ws;
    float lam_init[4];
    float inv32[16];
};

typedef const __attribute__((address_space(4))) Params* KP;
#define GETP(name) KP name = (KP)__builtin_amdgcn_kernarg_segment_ptr(); asm volatile("" : "+s"(name))

__device__ __forceinline__ int tid_fresh() { int t = threadIdx.x; asm volatile("" : "+v"(t)); return t; }
__device__ __forceinline__ unsigned pkbf(float lo, float hi) { f32x2_t v = {lo, hi}; bf16x2_t b = __builtin_convertvector(v, bf16x2_t); return __builtin_bit_cast(unsigned, b); }
__device__ __forceinline__ float bflo(unsigned w) { return __builtin_bit_cast(float, w << 16); }
__device__ __forceinline__ float bfhi(unsigned w) { return __builtin_bit_cast(float, w & 0xffff0000u); }
__device__ __forceinline__ float wave_sum(float v) {
#pragma unroll
    for (int o = 1; o < 64; o <<= 1) v += __shfl_xor(v, o);
    return v;
}
__device__ __forceinline__ void unpack8(const u32x4 w, float (&v)[8]) {
    v[0] = bflo(w.x); v[1] = bfhi(w.x); v[2] = bflo(w.y); v[3] = bfhi(w.y); v[4] = bflo(w.z); v[5] = bfhi(w.z); v[6] = bflo(w.w); v[7] = bfhi(w.w);
}
__device__ __forceinline__ u32x4 pack8(const float (&v)[8]) { u32x4 w; w.x = pkbf(v[0], v[1]); w.y = pkbf(v[2], v[3]); w.z = pkbf(v[4], v[5]); w.w = pkbf(v[6], v[7]); return w; }

__device__ __forceinline__ void transpose_item(const float* __restrict__ W, int ldw, int src_col0, float scale, bf16_t* __restrict__ WT, int K, int dst_row0, int k0, LAS float* scr, int lane,
                                               const float* __restrict__ lng, const float* __restrict__ lnb, float* c1, float* c2) {
    if (src_col0 < 0) {
        const int c = lane & 7;
#pragma unroll
        for (int j = 0; j < 4; ++j) { const int n = (lane >> 3) + 8 * j; *(u32x4*)(WT + (size_t)(dst_row0 + n) * K + k0 + 8 * c) = (u32x4){0u, 0u, 0u, 0u}; }
        return;
    }
    float a1 = 0.f, a2 = 0.f;
#pragma unroll 8
    for (int i = 0; i < 32; ++i) { const int kk = 2 * i + (lane >> 5); float w = W[(size_t)(k0 + kk) * ldw + src_col0 + (lane & 31)] * scale;
        if (lng) { a2 = fmaf(lnb[k0 + kk], w, a2); w *= lng[k0 + kk]; a1 += bflo(pkbf(w, 0.f)); }
        scr[kk * 33 + (lane & 31)] = w; }
    asm volatile("s_waitcnt lgkmcnt(0)" ::: "memory");
    const int c = lane & 7;
#pragma unroll
    for (int j = 0; j < 4; ++j) { const int n = (lane >> 3) + 8 * j; const LAS float* s = scr + (8 * c) * 33 + n;
        u32x4 o; o.x = pkbf(s[0 * 33], s[1 * 33]); o.y = pkbf(s[2 * 33], s[3 * 33]); o.z = pkbf(s[4 * 33], s[5 * 33]); o.w = pkbf(s[6 * 33], s[7 * 33]);
        *(u32x4*)(WT + (size_t)(dst_row0 + n) * K + k0 + 8 * c) = o; }
    asm volatile("s_waitcnt lgkmcnt(0)" ::: "memory");
    if (lng) { a1 += __shfl_xor(a1, 32); a2 += __shfl_xor(a2, 32);
        if (lane < 32) { atomicAdd(c1 + dst_row0 + lane, a1); atomicAdd(c2 + dst_row0 + lane, a2); } }
}

__device__ __forceinline__ void phase0(KP p, LAS unsigned char* lds, int vcu, int G) {
    const int tid = tid_fresh(), lane = tid & 63, wave = __builtin_amdgcn_readfirstlane(tid >> 6);
    LAS float* scr = (LAS float*)(lds + wave * 16384);
    const int gw = vcu * NWAVES + wave, NGW = G * NWAVES;
    bf16_t* wgu = (bf16_t*)(p->ws + WS_WGU); bf16_t* wd = (bf16_t*)(p->ws + WS_WD); bf16_t* win = (bf16_t*)(p->ws + WS_WIN); bf16_t* wout = (bf16_t*)(p->ws + WS_WOUT);
    float* c12 = (float*)(p->ws + WS_C12);
    constexpr int I_GU = 176 * 16, I_WD = 32 * 44, I_IN = 104 * 16, I_OUT = 32 * 16, I_CMP = 112 * 16;
    constexpr int I_LAYER = 2 * I_GU + 2 * I_WD + I_IN + I_OUT + I_CMP;
    for (int it = gw; it < DEPTH * I_LAYER; it += NGW) {
        const int l = it / I_LAYER; int r = it % I_LAYER;
        if (r < 2 * I_GU) { const int f = r / I_GU; r %= I_GU; const int nb = r / 16, kb = r % 16; const int n0 = 32 * nb;
            const int pn = n0 >> 8, bj = (n0 >> 7) & 1, i0 = n0 & 127;
            const int s = 3 * l + 2 * f - 1;
            transpose_item(p->ffn_w_gu + ((size_t)l * 2 + f) * DM * NGU, NGU, bj * DFF + 128 * pn + i0, 1.f, wgu + l * WGU_L + f * WGU_F, DM, n0, 64 * kb, scr, lane,
                           s >= 0 ? p->ln_g + s * DM : nullptr, s >= 0 ? p->ln_b + s * DM : nullptr, c12 + l * C12_L + f * NGU, c12 + C2_OFF + l * C12_L + f * NGU); continue; }
        r -= 2 * I_GU;
        if (r < 2 * I_WD) { const int f = r / I_WD; r %= I_WD; const int nb = r / 44, kb = r % 44;
            transpose_item(p->ffn_w_down + ((size_t)l * 2 + f) * DFF * DM, DM, 32 * nb, 1.f, wd + l * WD_L + f * WD_F, DFF, 32 * nb, 64 * kb, scr, lane, nullptr, nullptr, nullptr, nullptr); continue; }
        r -= 2 * I_WD;
        if (r < I_IN) { const int nb = r / 16, kb = r % 16; const int n0 = 32 * nb; int src; float sc = 1.f;
            if (n0 < PC) { src = n0; if (n0 < 256) sc = 0.125f; }
            else if (n0 < PD) src = 928 + (n0 - PC);
            else if (n0 < PCQ) { src = 1440 + (n0 - PD); if (n0 - PD < 256) sc = 0.17677669529663687f; }
            else if (n0 < PCKV) src = 512 + (n0 - PCQ);
            else if (n0 < PKR) src = 768 + (n0 - PCKV);
            else if (n0 < PQUP) src = 896;
            else if (n0 < PEND) continue;
            else src = -1;
            transpose_item(p->w_in + (size_t)l * DM * NIN_SRC, NIN_SRC, src, sc, win + l * WIN_L, DM, n0, 64 * kb, scr, lane,
                           p->ln_g + (3 * l) * DM, p->ln_b + (3 * l) * DM, c12 + l * C12_L + 2 * NGU, c12 + C2_OFF + l * C12_L + 2 * NGU); continue; }
        r -= I_IN;
        if (r < I_OUT) { const int nb = r / 16, kb = r % 16;
            transpose_item(p->w_out + (size_t)l * DM * DM, DM, 32 * nb, 1.f, wout + l * WOUT_L, DM, 32 * nb, 64 * kb, scr, lane, nullptr, nullptr, nullptr, nullptr); continue; }
        r -= I_OUT;
        {
            const int ng = r / 16, kb = r % 16; const int n0 = 8 * ng; const int k = 64 * kb + lane;
            int J, cA, ldu, nc; const float* g; const float* U;
            if (n0 < 384) { J = 256; cA = 512; g = p->mla_q_norm + l * 256; U = p->mla_w_uq + (size_t)l * 256 * 384; ldu = 384; nc = n0; }
            else { J = 128; cA = 768; g = p->mla_kv_norm + l * 128; U = p->mla_w_ukv + (size_t)l * 128 * 512; ldu = 512; nc = n0 - 384; }
            const float* a = p->w_in + (size_t)l * DM * NIN_SRC + (size_t)k * NIN_SRC + cA;
            float acc[8];
#pragma unroll
            for (int e = 0; e < 8; ++e) acc[e] = 0.f;
            for (int j = 0; j < J; j += 4) {
                const f32x4 av = *(const f32x4*)(a + j);
#pragma unroll
                for (int jj = 0; jj < 4; ++jj) { const float ag = av[jj] * g[j + jj]; const float* ur = U + (size_t)(j + jj) * ldu + nc;
#pragma unroll
                    for (int e = 0; e < 8; ++e) acc[e] = fmaf(ag, ur[e], acc[e]); }
            }
            bf16_t* o = win + l * WIN_L + (size_t)(PQUP + n0) * DM + k;
            const float lg = p->ln_g[(3 * l) * DM + k], lb = p->ln_b[(3 * l) * DM + k];
            float* c1p = c12 + l * C12_L + 2 * NGU + PQUP + n0; float* c2p = c12 + C2_OFF + l * C12_L + 2 * NGU + PQUP + n0;
#pragma unroll
            for (int e = 0; e < 8; ++e) { const unsigned wb = pkbf(acc[e] * lg, 0.f) & 0xffffu; o[(size_t)e * DM] = (bf16_t)wb;
                const float s1 = wave_sum(bflo(wb)), s2 = wave_sum(acc[e] * lb);
                if (lane == 0) { atomicAdd(c1p + e, s1); atomicAdd(c2p + e, s2); } }
        }
    }
    { u32x4* ag = (u32x4*)(p->ws + WS_AUG);
      for (int i = (vcu * NWAVES + wave) * 64 + lane; i < SEQ * 4; i += G * NWAVES * 64) { const int t = i >> 2, h = i & 3;
          const float sl = __builtin_amdgcn_exp2f(-(float)(5 + h));
          u32x4 w = {pkbf(sl * (float)(128 * (t >> 7)), sl * (float)(t & 127)), 0u, 0u, 0u}; ag[2 * i] = w; ag[2 * i + 1] = (u32x4){0u, 0u, 0u, 0u}; } }
    bf16_t* xb = (bf16_t*)(p->ws + WS_XB);
    for (int m = gw; m < T; m += NGW) {
        const f32x4* xr = (const f32x4*)(p->x + (size_t)m * DM) + lane; u32x2* o8 = (u32x2*)(xb + (size_t)m * DM) + lane;
#pragma unroll
        for (int j = 0; j < 4; ++j) { const f32x4 v = xr[64 * j]; u32x2 w; w.x = pkbf(v.x, v.y); w.y = pkbf(v.z, v.w); o8[64 * j] = w; }
    }
}

__device__ __forceinline__ void ln_phase(float* X, bf16_t* xb, const float* __restrict__ g, const float* __restrict__ b, int vcu, int G) {
    const int tid = tid_fresh(), lane = tid & 63, wave = __builtin_amdgcn_readfirstlane(tid >> 6);
    const int gw = vcu * NWAVES + wave, NGW = G * NWAVES;
    f32x4 gv[4], bv[4];
#pragma unroll
    for (int j = 0; j < 4; ++j) { gv[j] = ((const f32x4*)g)[64 * j + lane]; bv[j] = ((const f32x4*)b)[64 * j + lane]; }
    for (int m = gw; m < T; m += NGW) {
        f32x4* xr = (f32x4*)(X + (size_t)m * DM) + lane; u32x2* o8 = (u32x2*)(xb + (size_t)m * DM) + lane;
        f32x4 v[4]; float s = 0.f;
#pragma unroll
        for (int j = 0; j < 4; ++j) { v[j] = xr[64 * j]; s += (v[j].x + v[j].y) + (v[j].z + v[j].w); }
        const float mean = wave_sum(s) * (1.f / DM); float s2 = 0.f;
#pragma unroll
        for (int j = 0; j < 4; ++j) { v[j] = v[j] - mean; s2 += (v[j].x * v[j].x + v[j].y * v[j].y) + (v[j].z * v[j].z + v[j].w * v[j].w); }
        const float rstd = 1.f / sqrtf(wave_sum(s2) * (1.f / DM) + NORM_EPS);
#pragma unroll
        for (int j = 0; j < 4; ++j) { const f32x4 y = v[j] * rstd * gv[j] + bv[j]; xr[64 * j] = y; u32x2 w; w.x = pkbf(y.x, y.y); w.y = pkbf(y.z, y.w); o8[64 * j] = w; }
    }
}

__device__ __forceinline__ void sincos_rev(float ang, float& s, float& c) {
    double d = (double)ang * 0.15915494309189535; d -= __builtin_rint(d); const float f = (float)d;
    s = __builtin_amdgcn_sinf(f); c = __builtin_amdgcn_cosf(f);
}
__device__ __forceinline__ void rope8(float (&v)[8], bool first, float pos, int i0, KP p) {
#pragma unroll
    for (int e = 0; e < 8; ++e) {
        const float other = __shfl_xor(v[e], 2);
        const float inv = i0 ? p->inv32[8 + e] : p->inv32[e];
        float s, c; sincos_rev(pos * inv, s, c);
        v[e] = first ? (v[e] * c - other * s) : (other * s + v[e] * c);
    }
}
__device__ __forceinline__ void prep_phase(KP p, int l, int vcu, int G) {
    const int tid = tid_fresh(), lane = tid & 63, wave = __builtin_amdgcn_readfirstlane(tid >> 6);
    const int gw = vcu * NWAVES + wave, NGW = G * NWAVES;
    bf16_t* proj = (bf16_t*)(p->ws + WS_PROJ); bf16_t* qb = (bf16_t*)(p->ws + WS_QB); bf16_t* kb = (bf16_t*)(p->ws + WS_KB); bf16_t* vb = (bf16_t*)(p->ws + WS_VB);
    float cg[8];
    { const float* gsrc = (lane < 32 ? p->ax_q_norm : p->ax_k_norm) + l * 64 + 8 * (lane & 7);
#pragma unroll
      for (int e = 0; e < 8; ++e) cg[e] = gsrc[e]; }
    float km0 = 0.f, km1 = 0.f;
    for (int tok = gw; tok < T; tok += NGW) {
        const int t = tok & (SEQ - 1);
        bf16_t* pr = proj + (size_t)tok * NPROJ;
        { float s = 0.f;
          if (lane < 32) { float v[8]; unpack8(*(const u32x4*)(pr + PD + 256 + 8 * lane), v);
#pragma unroll
              for (int e = 0; e < 8; ++e) s += v[e] * v[e]; }
          s += __shfl_xor(s, 1); s += __shfl_xor(s, 2);
          if (tok < SEQ) km0 = fmaxf(km0, s); else km1 = fmaxf(km1, s); }
        float ssq = 0.f;
        if (lane < 48) { float v[8]; unpack8(*(const u32x4*)(pr + PCQ + 8 * lane), v);
#pragma unroll
            for (int e = 0; e < 8; ++e) ssq += v[e] * v[e]; }
        const float ssq_q = wave_sum(lane < 32 ? ssq : 0.f), ssq_kv = wave_sum(lane >= 32 ? ssq : 0.f);
        const float rstd_q = 1.f / sqrtf(ssq_q * (1.f / 256.f) + NORM_EPS), rstd_kv = 1.f / sqrtf(ssq_kv * (1.f / 128.f) + NORM_EPS);
        {
            const int r = lane % 12; float v[8];
            if (lane < 48) unpack8(*(const u32x4*)(pr + PQUP + 8 * lane), v); else {
#pragma unroll
                for (int e = 0; e < 8; ++e) v[e] = 0.f; }
#pragma unroll
            for (int e = 0; e < 8; ++e) v[e] *= rstd_q;
            float w[8];
#pragma unroll
            for (int e = 0; e < 8; ++e) w[e] = v[e];
            rope8(w, r < 10, (float)t, 8 * (r & 1), p);
            const bool isr = (r >= 8); const float qs = 0.10206207261596575f;
#pragma unroll
            for (int e = 0; e < 8; ++e) v[e] = (isr ? w[e] : v[e]) * qs;
            if (lane < 48) *(u32x4*)(qb + (size_t)tok * 384 + 8 * lane) = pack8(v);
        }
        {
            float v[8]; unpack8(*(const u32x4*)(pr + PKVUP + 8 * lane), v);
#pragma unroll
            for (int e = 0; e < 8; ++e) v[e] *= rstd_kv;
            const int hd = lane >> 4, r = lane & 15;
            if (r < 8) *(u32x4*)(kb + (size_t)tok * 384 + hd * 96 + 8 * r) = pack8(v);
            else *(u32x4*)(vb + (size_t)tok * 256 + hd * 64 + 8 * (r - 8)) = pack8(v);
        }
        {
            float v[8];
            if (lane < 4) unpack8(*(const u32x4*)(pr + PKR + 8 * lane), v); else {
#pragma unroll
                for (int e = 0; e < 8; ++e) v[e] = 0.f; }
            rope8(v, (lane & 3) < 2, (float)t, 8 * (lane & 1), p);
            if (lane < 4) { const u32x4 w = pack8(v);
#pragma unroll
                for (int hd = 0; hd < 4; ++hd) *(u32x4*)(kb + (size_t)tok * 384 + hd * 96 + 64 + 8 * lane) = w; }
        }
        {
            float v[8];
            if (lane < 48) unpack8(*(const u32x4*)(pr + PC + 8 * lane), v); else {
#pragma unroll
                for (int e = 0; e < 8; ++e) v[e] = 0.f; }
            float s = 0.f;
#pragma unroll
            for (int e = 0; e < 8; ++e) s += v[e] * v[e];
            s += __shfl_xor(s, 1); s += __shfl_xor(s, 2); s += __shfl_xor(s, 4);
            const float rs = 1.f / sqrtf(s * (1.f / 64.f) + NORM_EPS);
#pragma unroll
            for (int e = 0; e < 8; ++e) v[e] = v[e] * rs * cg[e];
            const int r = lane & 7; const float pos = (r < 4) ? (float)(t >> 6) : (float)(t & 63);
            rope8(v, (r & 3) < 2, pos, 8 * (r & 1), p);
            if (lane < 32) {
#pragma unroll
                for (int e = 0; e < 8; ++e) v[e] *= 0.125f; }
            if (lane < 48) *(u32x4*)(pr + PC + 8 * lane) = pack8(v);
        }
    }
    if (lane < 32 && (lane & 3) == 0) { unsigned* km = (unsigned*)(p->ws + WS_KMAX) + l * 16 + (lane >> 2);
        atomicMax(km, __builtin_bit_cast(unsigned, km0)); atomicMax(km + 8, __builtin_bit_cast(unsigned, km1)); }
}

#ifndef ATT_TYPES
#define ATT_TYPES 15
#endif
namespace att {
typedef float f32x2 __attribute__((ext_vector_type(2)));
constexpr int VPITCH = 144, KBUF = 64 * 208, VBUF = 64 * VPITCH;
constexpr int ATT_LDS = 2 * KBUF + 2 * VBUF;
constexpr float RESCALE_T = 5.0f;
__device__ __forceinline__ s16x4 vtr(const LAS char* p) { return __builtin_bit_cast(s16x4, __builtin_amdgcn_ds_read_tr16_b64_v4i16((LAS s16x4*)p)); }
__device__ __forceinline__ void xhalf_swap(float m, float& a, float& b) {
    a = m; b = m;
    asm volatile("s_nop 1\n\tv_permlane32_swap_b32 %0, %1\n\ts_nop 1" : "+v"(a), "+v"(b));
}
__device__ __forceinline__ float xhalf_max(float m) { float a, b; xhalf_swap(m, a, b); return fmaxf(a, b); }
__device__ __forceinline__ float xhalf_sum(float m) { float a, b; xhalf_swap(m, a, b); return a + b; }
__device__ __forceinline__ float max3f(float a, float b, float c) { return fmaxf(fmaxf(a, b), c); }
#define ATT_MFMA(a, b, c) __builtin_amdgcn_mfma_f32_32x32x16_bf16((a), (b), (c), 0, 0, 0)

template <int DK, int MODE, bool INIT = true>
__device__ __forceinline__ void flash_pass(LAS char* lds, const bf16_t* __restrict__ Qg, int qp, const bf16_t* __restrict__ Kg, int kp, const bf16_t* __restrict__ Vg, int vp,
                                           const bf16_t* __restrict__ AUGg, int q0, int a0, int nA, int b0, int nt, float slope, f32x16& O0, f32x16& O1, float& Mout, float& Lout) {
    constexpr int DKL = DK + (MODE == 1 ? 16 : 0);
    constexpr int KPITCH = DKL * 2 + 16, NKC = 8 * DKL, CPR = DKL / 8, NKS = DK / 16;
    constexpr bool HAS_K1 = NKC > 512;
    constexpr int DUMMY = 2 * KBUF + 2 * VBUF;
    const int tid = tid_fresh(), lane = tid & 63, r32 = lane & 31, hi = lane >> 5; const int wid = __builtin_amdgcn_readfirstlane(tid >> 6);
    const int qrow = q0 + wid * 32 + r32;
    bf16x8 qf[NKS];
#pragma unroll
    for (int ks = 0; ks < NKS; ++ks) qf[ks] = *(const bf16x8*)(Qg + (size_t)qrow * qp + 16 * ks + 8 * hi);
    const int kc1 = tid + 512;
    const bool k0v = tid < NKC, k1v = HAS_K1 && kc1 < NKC;
    const int kr0 = k0v ? tid / CPR : 0, kcc0 = k0v ? tid % CPR : 0, kr1 = k1v ? kc1 / CPR : 0, kcc1 = k1v ? kc1 % CPR : 0, vr = tid >> 3, vcc = tid & 7;
    const bf16_t* kg0; size_t kst0;
    if (MODE == 1 && kcc0 >= DK / 8) { kg0 = AUGg + (size_t)kr0 * 64 + 8 * (kcc0 - DK / 8); kst0 = (size_t)64 * 64; } else { kg0 = Kg + (size_t)kr0 * kp + 8 * kcc0; kst0 = (size_t)64 * kp; }
    const bf16_t* kg1 = Kg + (size_t)kr1 * kp + 8 * kcc1; const size_t kst1 = (size_t)64 * kp;
    const bf16_t* vg = Vg + (size_t)vr * vp + 8 * vcc; const size_t vst = (size_t)64 * vp;
    const int kl0 = k0v ? kr0 * KPITCH + 16 * kcc0 : -1, kl1 = k1v ? kr1 * KPITCH + 16 * kcc1 : -1, vl = 2 * KBUF + vr * VPITCH + 16 * vcc;
    u32x4 rk0 = {0u, 0u, 0u, 0u}, rk1 = {0u, 0u, 0u, 0u}, rv = {0u, 0u, 0u, 0u};
#define ATT_KT(i) ((i) < nA ? a0 + (i) : b0 + ((i) - nA))
#define ATT_LOADK(kt) do { const size_t t_ = (size_t)(kt); rk0 = *(const u32x4*)(kg0 + t_ * kst0); if (HAS_K1) rk1 = *(const u32x4*)(kg1 + t_ * kst1); } while (0)
#define ATT_LOADV(kt) do { rv = *(const u32x4*)(vg + (size_t)(kt) * vst); } while (0)
#define ATT_STOREK(buf) do { *(LAS u32x4*)(lds + (kl0 >= 0 ? (buf) * KBUF + kl0 : DUMMY + tid * 16)) = rk0; if (HAS_K1) *(LAS u32x4*)(lds + (kl1 >= 0 ? (buf) * KBUF + kl1 : DUMMY + tid * 16)) = rk1; } while (0)
#define ATT_STOREV(buf) do { *(LAS u32x4*)(lds + (buf) * VBUF + vl) = rv; } while (0)
    const int q4 = (lane & 15) >> 2, p4 = lane & 3, b16 = (lane >> 4) & 1;
    const int vbase = 2 * KBUF + (4 * hi + q4) * VPITCH + 32 * b16 + 8 * p4;
    const int kbase = r32 * KPITCH + 16 * hi;
    const int qw = q0 + wid * 32;
    const float stq = slope * (float)qrow;
    const bf16x8 qzero = {0, 0, 0, 0, 0, 0, 0, 0};
    bf16x8 qpos = qzero, qneg = qzero;
    if (MODE == 1 && hi == 0) { qpos[0] = (short)0x3F80; qpos[1] = (short)0x3F80; qneg[0] = (short)0xBF80; qneg[1] = (short)0xBF80; }
    constexpr int NKF = NKS + (MODE == 1 ? 1 : 0);
    constexpr int KPRE = NKF > 4 ? 4 : NKF;
    bf16x8 kfa[NKF], kfb[NKF];
#define ATT_KREAD(kbuf, f0, f1) do { const LAS char* Kb_ = lds + (kbuf) * KBUF + kbase; \
        _Pragma("unroll") for (int ks_ = (f0); ks_ < (f1); ++ks_) { kfa[ks_] = *(const LAS bf16x8*)(Kb_ + 32 * ks_); kfb[ks_] = *(const LAS bf16x8*)(Kb_ + 32 * KPITCH + 32 * ks_); } } while (0)
#define ATT_QKM(sa, sb, side) do { \
        _Pragma("unroll") for (int e_ = 0; e_ < 16; ++e_) { sa[e_] = 0.f; sb[e_] = 0.f; } \
        _Pragma("unroll") for (int ks_ = 0; ks_ < NKS; ++ks_) { sa = ATT_MFMA(kfa[ks_], qf[ks_], sa); sb = ATT_MFMA(kfb[ks_], qf[ks_], sb); } \
        if (MODE == 1) { const bf16x8 qa_ = (side) < 0 ? qpos : ((side) > 0 ? qneg : qzero); sa = ATT_MFMA(kfa[NKS], qa_, sa); sb = ATT_MFMA(kfb[NKS], qa_, sb); } } while (0)
#define ATT_QK(sa, sb, kbuf, side) do { ATT_KREAD(kbuf, 0, NKF); ATT_QKM(sa, sb, side); } while (0)
    bf16x8 vfa[4], vfb[4];
#define ATT_VREAD(vbuf) do { const LAS char* Vb_ = lds + (vbuf) * VBUF + vbase; \
        _Pragma("unroll") for (int j_ = 0; j_ < 4; ++j_) { const LAS char* vp0_ = Vb_ + (16 * j_) * VPITCH; \
            { const s16x4 lo_ = vtr(vp0_), hh_ = vtr(vp0_ + 8 * VPITCH); vfa[j_] = __builtin_shufflevector(lo_, hh_, 0, 1, 2, 3, 4, 5, 6, 7); } \
            { const s16x4 lo_ = vtr(vp0_ + 64), hh_ = vtr(vp0_ + 8 * VPITCH + 64); vfb[j_] = __builtin_shufflevector(lo_, hh_, 0, 1, 2, 3, 4, 5, 6, 7); } } } while (0)
#define ATT_PVM() do { _Pragma("unroll") for (int j_ = 0; j_ < 4; ++j_) { O0 = ATT_MFMA(vfa[j_], pf[j_ >> 1][j_ & 1], O0); O1 = ATT_MFMA(vfb[j_], pf[j_ >> 1][j_ & 1], O1); } } while (0)
#define ATT_PV(vbuf) do { ATT_VREAD(vbuf); ATT_PVM(); } while (0)
#define ATT_SIDE(kt) ((MODE != 1) ? 0 : (((kt) * 64 + 63 < qw) ? -1 : (((kt) * 64 > qw + 31) ? 1 : 0)))
    ATT_LOADK(ATT_KT(0)); ATT_STOREK(0);
    ATT_LOADK(ATT_KT(1)); ATT_STOREK(1);
    ATT_STOREV(1);
    __syncthreads();
    float M = INIT ? -1e20f : Mout, L = INIT ? 0.f : Lout;
    if (INIT) {
#pragma unroll
        for (int i = 0; i < 16; ++i) { O0[i] = 0.f; O1[i] = 0.f; } }
    bf16x8 pf[2][2];
#pragma unroll
    for (int kb = 0; kb < 2; ++kb)
#pragma unroll
        for (int st = 0; st < 2; ++st) pf[kb][st] = qzero;
    f32x16 s0, s1, n0, n1;
    int side_cur = ATT_SIDE(ATT_KT(0));
    ATT_QK(s0, s1, 0, side_cur);
#pragma unroll
    for (int e = 0; e < 16; ++e) { n0[e] = 0.f; n1[e] = 0.f; }
    __syncthreads();
    constexpr int NMF = 2 * NKS + (MODE == 1 ? 2 : 0) + 8;
#define ATT_ITER(i, C0, C1, N0, N1, HASN, HASK2) do { \
        const int kt = ATT_KT(i); \
        if (HASK2) ATT_LOADK(ATT_KT((i) + 2)); \
        ATT_LOADV(kt); \
        if (HASN) ATT_KREAD(((i) + 1) & 1, 0, KPRE); \
        const int k0 = kt * 64; \
          \
        float rc = 0.f; \
        if (MODE == 1) { \
            if (side_cur != 0) rc = side_cur < 0 ? -stq : stq; \
            else { const float dbase = (float)(k0 + 4 * hi - qrow); \
                _Pragma("unroll") for (int e = 0; e < 16; ++e) { const float c = (float)((e & 3) + 8 * (e >> 2)); \
                    C0[e] = fmaf(-slope, fabsf(dbase + c), C0[e]); C1[e] = fmaf(-slope, fabsf(dbase + (c + 32.f)), C1[e]); } } \
        } \
        if (MODE == 2) { const float dbase = (float)(k0 + 4 * hi - qrow); \
            _Pragma("unroll") for (int e = 0; e < 16; ++e) { const float c = (float)((e & 3) + 8 * (e >> 2)); \
                const float d0 = fabsf(dbase + c), d1 = fabsf(dbase + (c + 32.f)); \
                C0[e] = (d0 <= 128.f) ? fmaf(-slope, d0, C0[e]) : -1e30f; C1[e] = (d1 <= 128.f) ? fmaf(-slope, d1, C1[e]) : -1e30f; } } \
        float mx = max3f(C0[0], C1[0], C0[1]); \
        _Pragma("unroll") for (int e = 1; e < 15; e += 2) { mx = max3f(mx, C1[e], C0[e + 1]); mx = max3f(mx, C1[e + 1], C0[e + 2]); } \
        mx = fmaxf(mx, C1[15]); \
        const float mt = xhalf_max(mx) + rc;                     \
        if (__builtin_amdgcn_ballot_w64(mt > M + RESCALE_T) != 0ull) {         \
            ATT_PV(((i) + 1) & 1); \
            _Pragma("unroll") for (int kb = 0; kb < 2; ++kb) _Pragma("unroll") for (int st = 0; st < 2; ++st) pf[kb][st] = qzero; \
            const float Mn = fmaxf(M, mt); const float alpha = __builtin_amdgcn_exp2f((M - Mn) * LOG2E); M = Mn; \
            L *= alpha; \
            _Pragma("unroll") for (int e = 0; e < 16; ++e) { O0[e] *= alpha; O1[e] *= alpha; } \
        } \
          \
        const int side_next = HASN ? ATT_SIDE(ATT_KT((i) + 1)) : 0; \
        if (HASN) ATT_KREAD(((i) + 1) & 1, KPRE, NKF); \
        ATT_VREAD(((i) + 1) & 1); \
        if (HASN) ATT_QKM(N0, N1, side_next); \
        ATT_PVM();                                   \
        const float cc = (rc - M) * LOG2E; \
        const f32x2 k2 = {LOG2E, LOG2E}, c2 = {cc, cc}; \
        f32x2 ps2 = {0.f, 0.f}; \
        _Pragma("unroll") for (int e = 0; e < 16; e += 2) { \
            f32x2 a = {C0[e], C0[e + 1]}, b = {C1[e], C1[e + 1]}; \
            a = a * k2 + c2; b = b * k2 + c2; \
            a.x = __builtin_amdgcn_exp2f(a.x); a.y = __builtin_amdgcn_exp2f(a.y); b.x = __builtin_amdgcn_exp2f(b.x); b.y = __builtin_amdgcn_exp2f(b.y); \
            ps2 += a; ps2 += b; \
            C0[e] = a.x; C0[e + 1] = a.y; C1[e] = b.x; C1[e + 1] = b.y; } \
        L += ps2.x + ps2.y; \
        _Pragma("unroll") for (int st = 0; st < 2; ++st) { u32x4 w0, w1; \
            w0.x = pkbf(C0[8 * st + 0], C0[8 * st + 1]); w0.y = pkbf(C0[8 * st + 2], C0[8 * st + 3]); w0.z = pkbf(C0[8 * st + 4], C0[8 * st + 5]); w0.w = pkbf(C0[8 * st + 6], C0[8 * st + 7]); \
            w1.x = pkbf(C1[8 * st + 0], C1[8 * st + 1]); w1.y = pkbf(C1[8 * st + 2], C1[8 * st + 3]); w1.z = pkbf(C1[8 * st + 4], C1[8 * st + 5]); w1.w = pkbf(C1[8 * st + 6], C1[8 * st + 7]); \
            pf[0][st] = __builtin_bit_cast(bf16x8, w0); pf[1][st] = __builtin_bit_cast(bf16x8, w1); } \
        side_cur = side_next; \
        if (HASN) { __builtin_amdgcn_sched_group_barrier(0x100, 16 + 2 * (NKF - KPRE), 0); \
            _Pragma("unroll") for (int g_ = 0; g_ < NMF; ++g_) { __builtin_amdgcn_sched_group_barrier(0x008, 1, 0); __builtin_amdgcn_sched_group_barrier(0x002, 6, 0); } } \
        if (HASK2) ATT_STOREK((i) & 1); \
        ATT_STOREV((i) & 1); \
        __syncthreads(); } while (0)
    for (int i = 0; i + 2 < nt; i += 2) {
        ATT_ITER(i, s0, s1, n0, n1, true, true);
        ATT_ITER(i + 1, n0, n1, s0, s1, true, true);
    }
    ATT_ITER(nt - 2, s0, s1, n0, n1, true, false);
    ATT_ITER(nt - 1, n0, n1, s0, s1, false, false);
    ATT_PV((nt - 1) & 1);
    __syncthreads();
#undef ATT_ITER
#undef ATT_LOADK
#undef ATT_LOADV
#undef ATT_STOREK
#undef ATT_STOREV
#undef ATT_KT
#undef ATT_QK
#undef ATT_PV
#undef ATT_KREAD
#undef ATT_QKM
#undef ATT_VREAD
#undef ATT_PVM
#undef ATT_SIDE
    Mout = M; Lout = L;
}

__device__ __forceinline__ void store_o(bf16_t* orow, const f32x16& O0, const f32x16& O1, int hi) {
#pragma unroll
    for (int g = 0; g < 4; ++g) {
        u32x2 w0, w1; w0.x = pkbf(O0[4 * g], O0[4 * g + 1]); w0.y = pkbf(O0[4 * g + 2], O0[4 * g + 3]); w1.x = pkbf(O1[4 * g], O1[4 * g + 1]); w1.y = pkbf(O1[4 * g + 2], O1[4 * g + 3]);
        *(u32x2*)(orow + 8 * g + 4 * hi) = w0; *(u32x2*)(orow + 32 + 8 * g + 4 * hi) = w1;
    }
}

__device__ __forceinline__ void attn_phase(KP p, int l, LAS char* lds, int vcu, int G) {
    const int tid = tid_fresh(), lane = tid & 63, r32 = lane & 31, hi = lane >> 5; const int wid = __builtin_amdgcn_readfirstlane(tid >> 6);
    const bf16_t* proj = (const bf16_t*)(p->ws + WS_PROJ); const bf16_t* qb = (const bf16_t*)(p->ws + WS_QB); const bf16_t* kb = (const bf16_t*)(p->ws + WS_KB); const bf16_t* vb = (const bf16_t*)(p->ws + WS_VB);
    const bf16_t* aug = (const bf16_t*)(p->ws + WS_AUG);
    bf16_t* mix = (bf16_t*)(p->ws + WS_MIX);
    float lam;
    { const float* lp = p->diff_lambda + l * 128; const float a = (lane < 32) ? lp[lane] * lp[32 + lane] : 0.f, b2 = (lane < 32) ? lp[64 + lane] * lp[96 + lane] : 0.f;
      lam = expf(wave_sum(a)) - expf(wave_sum(b2)) + p->lam_init[l]; }
    const float one_m_li = 1.f - p->lam_init[l];
    for (int u = vcu; u < 2048; u += G) {
        if (!((ATT_TYPES >> (u >> 9)) & 1)) continue;
        const int type = u >> 9, idx = u & 511, bh = idx >> 6, qblk = idx & 63, b = bh >> 2, hd = bh & 3, q0 = qblk * 256;
        const int qrow = q0 + wid * 32 + r32;
        const size_t tok0 = (size_t)b * SEQ;
        bf16_t* orow = mix + (tok0 + qrow) * DM;
        f32x16 O0, O1; float M, L;
        if (type == 0) {
            const int bD = idx >> 8, hD = ((idx >> 6) & 3) ^ (bD ? 3 : 0);
            const size_t tokD = (size_t)bD * SEQ;
            bf16_t* orowD = mix + (tokD + qrow) * DM;
            const float slope = __builtin_amdgcn_exp2f(-(float)(5 + hD));
            const bf16_t* base = proj + tokD * NPROJ + PD;
            const int d0 = q0 / 64;
            LAS float* asave = (LAS float*)(lds + 65536) + tid;
#pragma unroll 1
            for (int mp = 0; mp < 2; ++mp) {
                const bf16_t* Qm = base + 64 * hD + 32 * mp; const bf16_t* Km = base + 256 + 64 * hD + 32 * mp; const bf16_t* Vm = base + 512 + 64 * hD;
                flash_pass<32, 1, true>(lds, Qm, NPROJ, Km, NPROJ, Vm, NPROJ, aug + 16 * hD, q0, d0, 4, 0, 4, slope, O0, O1, M, L);
                float qn2 = 0.f;
                { const u32x4* qr = (const u32x4*)(Qm + (size_t)qrow * NPROJ);
#pragma unroll
                  for (int c = 0; c < 4; ++c) { float v[8]; unpack8(qr[c], v);
#pragma unroll
                      for (int e = 0; e < 8; ++e) qn2 += v[e] * v[e]; } }
                const float kmax = sqrtf(__builtin_bit_cast(float, ((const unsigned*)(p->ws + WS_KMAX))[l * 16 + bD * 8 + hD * 2 + mp]));
                float dc = (sqrtf(qn2) * kmax * 1.001f + 40.f - M) / slope;
                dc = fminf(fmaxf(dc, 0.f), 1.0e8f);
#pragma unroll
                for (int o = 1; o < 64; o <<= 1) dc = fmaxf(dc, __shfl_xor(dc, o));
                LAS float* red = (LAS float*)(lds + ATT_LDS + 16384);
                if (lane == 0) red[wid] = dc;
                __syncthreads();
#pragma unroll
                for (int w = 0; w < 8; ++w) dc = fmaxf(dc, red[w]);
                __syncthreads();
                const int dci = (int)dc + 1;
                const int lo_key = q0 - dci - 63;
                int ktlo = lo_key <= 0 ? 0 : (lo_key + 63) / 64; int kthi = (q0 + 255 + dci) / 64; if (kthi > SEQ / 64 - 1) kthi = SEQ / 64 - 1;
                if (ktlo > d0) ktlo = d0; if (kthi < d0 + 3) kthi = d0 + 3;
                if (((kthi - ktlo + 1) & 1) != 0) { if (ktlo > 0) --ktlo; else ++kthi; }
                const int nR = kthi - (d0 + 3), nL = d0 - ktlo;
                if (nR + nL > 0) flash_pass<32, 1, false>(lds, Qm, NPROJ, Km, NPROJ, Vm, NPROJ, aug + 16 * hD, q0, d0 + 4, nR, ktlo, nR + nL, slope, O0, O1, M, L);
                if (mp == 0) { const float i1 = 1.f / xhalf_sum(L);
#pragma unroll
                    for (int i = 0; i < 16; ++i) { asave[(2 * i) * NTHREADS] = O0[i] * i1; asave[(2 * i + 1) * NTHREADS] = O1[i] * i1; } }
            }
            const float i2 = lam / xhalf_sum(L);
            float ss = 0.f;
            f32x16 A0, A1;
#pragma unroll
            for (int i = 0; i < 16; ++i) { A0[i] = asave[(2 * i) * NTHREADS] - O0[i] * i2; A1[i] = asave[(2 * i + 1) * NTHREADS] - O1[i] * i2; ss += A0[i] * A0[i] + A1[i] * A1[i]; }
            ss = xhalf_sum(ss);
            const float rs = one_m_li / sqrtf(ss * (1.f / 64.f) + NORM_EPS);
            const float* sg = p->diff_subln + l * 64;
#pragma unroll
            for (int i = 0; i < 16; ++i) { const int dv = (i & 3) + 8 * (i >> 2) + 4 * hi; A0[i] *= rs * sg[dv]; A1[i] *= rs * sg[32 + dv]; }
            store_o(orowD + 768 + 64 * hD, A0, A1, hi);
        } else if (type == 1) {
            flash_pass<96, 0>(lds, qb + tok0 * 384 + 96 * hd, 384, kb + tok0 * 384 + 96 * hd, 384, vb + tok0 * 256 + 64 * hd, 256, nullptr, q0, q0 / 64, SEQ / 64 - q0 / 64, 0, SEQ / 64, 0.f, O0, O1, M, L);
            const float il = 1.f / xhalf_sum(L);
#pragma unroll
            for (int i = 0; i < 16; ++i) { O0[i] *= il; O1[i] *= il; }
            store_o(orow + 256 + 64 * hd, O0, O1, hi);
        } else if (type == 2) {
            const bf16_t* base = proj + tok0 * NPROJ + PC; const int hk = hd >> 1;
            flash_pass<64, 0>(lds, base + 64 * hd, NPROJ, base + 256 + 64 * hk, NPROJ, base + 384 + 64 * hk, NPROJ, nullptr, q0, q0 / 64, SEQ / 64 - q0 / 64, 0, SEQ / 64, 0.f, O0, O1, M, L);
            const float il = 1.f / xhalf_sum(L);
#pragma unroll
            for (int i = 0; i < 16; ++i) { O0[i] *= il; O1[i] *= il; }
            store_o(orow + 512 + 64 * hd, O0, O1, hi);
        } else {
            const bf16_t* base = proj + tok0 * NPROJ + PA; const int hk = hd >> 1;
            const float slope = __builtin_amdgcn_exp2f(-(float)(1 + hd));
            const int kt0 = (q0 >= 128) ? (q0 - 128) / 64 : 0; int kt1 = (q0 + 256 + 128) / 64; if (kt1 > SEQ / 64) kt1 = SEQ / 64;
            flash_pass<64, 2>(lds, base + 64 * hd, NPROJ, base + 256 + 64 * hk, NPROJ, base + 384 + 64 * hk, NPROJ, nullptr, q0, kt0, kt1 - kt0, 0, kt1 - kt0, slope, O0, O1, M, L);
            const float sink = p->win_sink[l * 4 + hd];
            const float il = 1.f / (xhalf_sum(L) + __builtin_amdgcn_exp2f((sink - M) * LOG2E));
#pragma unroll
            for (int i = 0; i < 16; ++i) { O0[i] *= il; O1[i] *= il; }
            store_o(orow + 64 * hd, O0, O1, hi);
        }
    }
}
}

#define GRID_SYNC() do { __builtin_amdgcn_fence(__ATOMIC_RELEASE, "agent"); grid.sync(); __builtin_amdgcn_fence(__ATOMIC_ACQUIRE, "agent"); } while (0)
#ifndef PH_MASK
#define PH_MASK 255
#endif
__global__ void __launch_bounds__(NTHREADS, 2) mega_fwd(Params p_by_value) {
    extern __shared__ __attribute__((aligned(16))) unsigned char lds_raw[];
    cg::grid_group grid = cg::this_grid();
    LAS unsigned char* lds = (LAS unsigned char*)lds_raw;
#define VCU(G_, bx_) (((G_) % 8 == 0) ? ((bx_) % 8) * ((G_) / 8) + (bx_) / 8 : (bx_))
    const float alpha = 1.681792830507429f;
#define STATS(s_) ((float*)(p->ws + WS_STATS) + (size_t)(s_) * T * 2)
#define C1(l_, off_) ((const float*)(p->ws + WS_C12) + (l_) * C12_L + (off_))
#define C2(l_, off_) ((const float*)(p->ws + WS_C12) + C2_OFF + (l_) * C12_L + (off_))

    if (PH_MASK & 1) { GETP(p); const int G = gridDim.x, bx = blockIdx.x; phase0(p, lds, VCU(G, bx), G); }
    GRID_SYNC();
#pragma unroll 1
    for (int li = 0; li < DEPTH; ++li) {
#pragma unroll 1
        for (int fi = 0; fi < 2; ++fi) {
            if (fi == 1) {
                if (PH_MASK & 2) { GETP(p); int l = li; asm volatile("" : "+s"(l)); const int G = gridDim.x, bx = blockIdx.x;
                  pg8::Gemm g{(const bf16_t*)(p->ws + WS_XB), (const bf16_t*)(p->ws + WS_WIN) + l * WIN_L, T, NPROJ, DM}; pg8::StaticOrder S; S.init(T, NPROJ, G, bx);
                  pg8::EpiStoreBf16LN E{(bf16_t*)(p->ws + WS_PROJ), NPROJ, STATS(3 * l), C1(l, 2 * NGU), C2(l, 2 * NGU)};
                  pg8::gemm_phase<pg8::EpiStoreBf16LN, pg8::StaticOrder, true, true>(lds, g, S, E); }
                GRID_SYNC();
                if (PH_MASK & 4) { GETP(p); int l = li; asm volatile("" : "+s"(l)); const int G = gridDim.x, bx = blockIdx.x; prep_phase(p, l, VCU(G, bx), G); }
                GRID_SYNC();
                if (PH_MASK & 8) { GETP(p); int l = li; asm volatile("" : "+s"(l)); const int G = gridDim.x, bx = blockIdx.x; att::attn_phase(p, l, (LAS char*)lds, VCU(G, bx), G); }
                GRID_SYNC();
                if (PH_MASK & 16) { GETP(p); int l = li; asm volatile("" : "+s"(l)); const int G = gridDim.x, bx = blockIdx.x;
                  pg8::Gemm g{(const bf16_t*)(p->ws + WS_MIX), (const bf16_t*)(p->ws + WS_WOUT) + l * WOUT_L, T, DM, DM}; pg8::StaticOrder S; S.init(T, DM, G, bx);
                  pg8::EpiResidLN<true> E{nullptr, p->out, p->ws, p->ln_g + (3 * l) * DM, p->ln_b + (3 * l) * DM, 3 * l, alpha, 1.0f};
                  pg8::gemm_phase<pg8::EpiResidLN<true>, pg8::StaticOrder, true, true>(lds, g, S, E); }
                GRID_SYNC();
            }
            if (PH_MASK & 64) { GETP(p); int l = li, f = fi; asm volatile("" : "+s"(l), "+s"(f)); const int G = gridDim.x, bx = blockIdx.x;
              const int s = 3 * l + 2 * f - 1;
              pg8::Gemm g{(const bf16_t*)(p->ws + WS_XB), (const bf16_t*)(p->ws + WS_WGU) + l * WGU_L + f * WGU_F, T, NGU, DM}; pg8::StaticOrder S; S.init(T, NGU, G, bx);
              if (s >= 0) { pg8::EpiSwiGLULN<true> E{(bf16_t*)(p->ws + WS_H), DFF, STATS(s), C1(l, f * NGU), C2(l, f * NGU)};
                            pg8::gemm_phase<pg8::EpiSwiGLULN<true>, pg8::StaticOrder, true, true>(lds, g, S, E); }
              else { pg8::EpiSwiGLULN<false> E{(bf16_t*)(p->ws + WS_H), DFF, nullptr, C1(l, f * NGU), C2(l, f * NGU)};
                     pg8::gemm_phase<pg8::EpiSwiGLULN<false>, pg8::StaticOrder, true, true>(lds, g, S, E); } }
            GRID_SYNC();
            if (PH_MASK & 128) { GETP(p); int l = li, f = fi; asm volatile("" : "+s"(l), "+s"(f)); const int G = gridDim.x, bx = blockIdx.x;
              const int s = 3 * l + 2 * f - 1;
              pg8::Gemm g{(const bf16_t*)(p->ws + WS_H), (const bf16_t*)(p->ws + WS_WD) + l * WD_L + f * WD_F, T, DM, DFF}; pg8::StaticOrder S; S.init(T, DM, G, bx);
              if (s >= 0) { pg8::EpiResidLN<true> E{nullptr, p->out, p->ws, p->ln_g + s * DM, p->ln_b + s * DM, s, alpha, 0.5f};
                            pg8::gemm_phase<pg8::EpiResidLN<true>, pg8::StaticOrder, true, true>(lds, g, S, E); }
              else { pg8::EpiResidLN<false> E{p->x, p->out, p->ws, nullptr, nullptr, -1, alpha, 0.5f};
                     pg8::gemm_phase<pg8::EpiResidLN<false>, pg8::StaticOrder, true, true>(lds, g, S, E); } }
            GRID_SYNC();
        }
    }
    if (PH_MASK & 32) { GETP(p); const int G = gridDim.x, bx = blockIdx.x;
      ln_phase(p->out, (bf16_t*)(p->ws + WS_XB), p->ln_g + (3 * DEPTH - 1) * DM, p->ln_b + (3 * DEPTH - 1) * DM, VCU(G, bx), G); }
}

extern "C" void kernel_launch(void* const* d_in, const int* in_sizes, int n_in, void* d_out, int out_size, void* d_ws, size_t ws_size, hipStream_t stream) {
    static int grid = 0;
    if (grid == 0) {
        if (n_in != 16 || in_sizes[0] != T * DM || out_size != T * DM || ws_size < WS_END) { fprintf(stderr, "kernel_launch: unexpected shapes (n_in %d, in0 %d, out %d, ws %zu); nothing launched\n", n_in, n_in > 0 ? in_sizes[0] : -1, out_size, ws_size); grid = -1; return; }
        int dev = 0, cus = 0, per_cu = 0;
        hipGetDevice(&dev); hipDeviceGetAttribute(&cus, hipDeviceAttributeMultiprocessorCount, dev);
        if (hipFuncSetAttribute((const void*)mega_fwd, hipFuncAttributeMaxDynamicSharedMemorySize, LDS_BYTES) != hipSuccess) { fprintf(stderr, "kernel_launch: hipFuncSetAttribute failed\n"); grid = -1; return; }
        if (hipOccupancyMaxActiveBlocksPerMultiprocessor(&per_cu, (const void*)mega_fwd, NTHREADS, LDS_BYTES) != hipSuccess || per_cu < 1) { fprintf(stderr, "kernel_launch: occupancy query gave %d\n", per_cu); per_cu = 1; }
        (void)hipGetLastError();
        grid = cus * 1;
    }
    if (grid < 0) return;
    Params p{};
    p.x = (const float*)d_in[0]; p.w_in = (const float*)d_in[1]; p.win_sink = (const float*)d_in[2]; p.mla_q_norm = (const float*)d_in[3]; p.mla_w_uq = (const float*)d_in[4];
    p.mla_kv_norm = (const float*)d_in[5]; p.mla_w_ukv = (const float*)d_in[6]; p.ax_q_norm = (const float*)d_in[7]; p.ax_k_norm = (const float*)d_in[8]; p.diff_lambda = (const float*)d_in[9];
    p.diff_subln = (const float*)d_in[10]; p.w_out = (const float*)d_in[11]; p.ffn_w_gu = (const float*)d_in[12]; p.ffn_w_down = (const float*)d_in[13]; p.ln_g = (const float*)d_in[14]; p.ln_b = (const float*)d_in[15];
    p.out = (float*)d_out; p.ws = (unsigned char*)d_ws;
    for (int l = 0; l < 4; ++l) p.lam_init[l] = (float)(0.8 - 0.6 * exp(-0.3 * (double)l));
    for (int i = 0; i < 16; ++i) p.inv32[i] = (float)pow(10000.0, -(double)i / 16.0);
    if (hipMemsetAsync((char*)d_ws + WS_CTL, 0, CTL_BYTES, stream) != hipSuccess) { fprintf(stderr, "kernel_launch: hipMemsetAsync of the control region failed\n"); return; }
    void* args[] = {&p};
    hipError_t e = hipLaunchCooperativeKernel((const void*)mega_fwd, dim3(grid), dim3(NTHREADS), args, LDS_BYTES, stream);
    if (e != hipSuccess) fprintf(stderr, "kernel_launch: cooperative launch failed: %s (grid %d)\n", hipGetErrorString(e), grid);
}
```

```cpp
#include <hip/hip_runtime.h>
#include <hip/hip_cooperative_groups.h>
#include <cstdio>
#include <cstdint>
#include <cmath>
namespace cg = cooperative_groups;
namespace pg8 {
#define PG8_LAS __attribute__((address_space(3)))
typedef unsigned short bf16_t;
typedef short bf16x8 __attribute__((ext_vector_type(8)));
typedef float f32x4 __attribute__((ext_vector_type(4)));
typedef unsigned u32x4 __attribute__((ext_vector_type(4)));
constexpr int BM = 256, BK = 64, HALF = 128, HTB = HALF * BK * 2  , STAGE_BYTES = 8 * HTB, NXCD = 8, WGM = 8;

__host__ __device__ __forceinline__ int lds_byte(int r, int c) { const int st = (r >> 4) * 2 + (c >> 5), rr = r & 15, cc = c & 31, ob = rr * 64 + cc * 2; return st * 1024 + (ob ^ (((ob >> 9) & 1) << 5)); }
__host__ __device__ __forceinline__ void stage_rc(int b, int& R, int& C) { const int st = b / 1024, sb = b % 1024, swz = sb ^ (((sb >> 9) & 1) << 5); R = (st >> 1) * 16 + swz / 64; C = (st & 1) * 32 + (swz % 64) / 2; }
__host__ __device__ __forceinline__ int perm32(int rho) { const int n = rho >> 4, i = rho & 15; return 8 * (i >> 2) + 4 * n + (i & 3); }

struct Unit { int pm, pn; };
struct Gemm { const bf16_t* A; const bf16_t* Bt; int M, N, K; };

struct StaticOrder {
    int nM, nN, nwg, G, c;
    __host__ __device__ void init(int M, int N, int G_, int c_) { nM = M / BM; nN = N / BM; nwg = nM * nN; G = G_; c = c_; }
    __host__ __device__ bool next(int i, Unit& u) const {
        const long L = (long)i * G + c; if (L >= nwg) return false;
        int wgid = (int)L; { const int q = nwg / NXCD, r = nwg % NXCD, xcd = wgid % NXCD, off = wgid / NXCD; wgid = (xcd < r ? xcd * (q + 1) : r * (q + 1) + (xcd - r) * q) + off; }
        const int nig = WGM * nN, gid = wgid / nig, fm = gid * WGM, gsz = (nM - fm) < WGM ? (nM - fm) : WGM;
        u.pm = fm + ((wgid % nig) % gsz); u.pn = (wgid % nig) / gsz; return true;
    }
    __device__ __forceinline__ void a_ready(const Unit&) const {}
    __device__ __forceinline__ void done(const Unit&) const {}
};

__device__ __forceinline__ unsigned cvt_pk_bf16(float lo, float hi) { unsigned r; asm volatile("v_cvt_pk_bf16_f32 %0, %1, %2" : "=v"(r) : "v"(lo), "v"(hi)); return r; }
typedef float f32x2 __attribute__((ext_vector_type(2)));
typedef float f32x2 __attribute__((ext_vector_type(2)));
typedef unsigned u32x2 __attribute__((ext_vector_type(2)));

struct EpiStoreBf16 {
    static constexpr bool PERM = true, AFTER_DRAIN = false;
    bf16_t* O; int ldc;
    __device__ __forceinline__ void operator()(const f32x4 (&acc)[2][2][4][2], const Unit& u, int wr, int wc, int fr, int fq) const {
        const int row0 = u.pm * BM + wr * 64 + fr; const int col0 = u.pn * BM + wc * 32 + 8 * fq;
#pragma unroll
        for (int ai = 0; ai < 2; ++ai)
#pragma unroll
            for (int m = 0; m < 4; ++m) { bf16_t* rowp = O + (size_t)(row0 + ai * HALF + m * 16) * ldc + col0;
#pragma unroll
                for (int bj = 0; bj < 2; ++bj) { const f32x4 v0 = acc[ai][bj][m][0], v1 = acc[ai][bj][m][1];
                    u32x4 w; w.x = cvt_pk_bf16(v0[0], v0[1]); w.y = cvt_pk_bf16(v0[2], v0[3]); w.z = cvt_pk_bf16(v1[0], v1[1]); w.w = cvt_pk_bf16(v1[2], v1[3]);
                    *(u32x4*)(rowp + bj * HALF) = w; } }
    }
};

__device__ __forceinline__ float silu_mul(float g, float u) {
    const float e = __builtin_amdgcn_exp2f(-1.4426950408889634f * g);
    return g * u * __builtin_amdgcn_rcpf(1.0f + e);
}
struct EpiSwiGLU {
    static constexpr bool PERM = true, AFTER_DRAIN = false;
    bf16_t* H; int ldh;
    __device__ __forceinline__ void operator()(const f32x4 (&acc)[2][2][4][2], const Unit& u, int wr, int wc, int fr, int fq) const {
        const int row0 = u.pm * BM + wr * 64 + fr; const int col0 = u.pn * HALF + wc * 32 + 8 * fq;
#pragma unroll
        for (int ai = 0; ai < 2; ++ai)
#pragma unroll
            for (int m = 0; m < 4; ++m) { bf16_t* rowp = H + (size_t)(row0 + ai * HALF + m * 16) * ldh + col0;
                const f32x4 g0 = acc[ai][0][m][0], g1 = acc[ai][0][m][1], u0 = acc[ai][1][m][0], u1 = acc[ai][1][m][1];
                u32x4 w;
                w.x = cvt_pk_bf16(silu_mul(g0[0], u0[0]), silu_mul(g0[1], u0[1])); w.y = cvt_pk_bf16(silu_mul(g0[2], u0[2]), silu_mul(g0[3], u0[3]));
                w.z = cvt_pk_bf16(silu_mul(g1[0], u1[0]), silu_mul(g1[1], u1[1])); w.w = cvt_pk_bf16(silu_mul(g1[2], u1[2]), silu_mul(g1[3], u1[3]));
                *(u32x4*)rowp = w; }
    }
};

struct EpiResid {
    static constexpr bool PERM = false, AFTER_DRAIN = false;
    const float* src; float* dst; int ld; float alpha, beta;
    __device__ __forceinline__ void operator()(const f32x4 (&acc)[2][2][4][2], const Unit& u, int wr, int wc, int fr, int fq) const {
        const int col0 = u.pn * BM + wc * 32 + 4 * fq;
#pragma unroll
        for (int ai = 0; ai < 2; ++ai)
#pragma unroll
            for (int m = 0; m < 4; ++m) { const size_t off = (size_t)(u.pm * BM + ai * HALF + wr * 64 + m * 16 + fr) * ld + col0;
#pragma unroll
                for (int bj = 0; bj < 2; ++bj)
#pragma unroll
                    for (int n = 0; n < 2; ++n) { const f32x4 s = *(const f32x4*)(src + off + bj * HALF + n * 16);
                        *(f32x4*)(dst + off + bj * HALF + n * 16) = s * alpha + acc[ai][bj][m][n] * beta; } }
    }
};

constexpr float LN_EPS_F = 1e-5f;
template <bool HAS> __device__ __forceinline__ void ln_row_stats(const float* st, int row, float& mu, float& rs) {
    if (!HAS) { mu = 0.f; rs = 1.f; return; }
    const f32x2 s = *(const f32x2*)(st + 2 * (size_t)row);
    mu = s.x * (1.0f / 1024.0f); const float var = fmaxf(s.y * (1.0f / 1024.0f) - mu * mu, 0.f); rs = 1.0f / sqrtf(var + LN_EPS_F);
}
struct EpiStoreBf16LN {
    static constexpr bool PERM = true, AFTER_DRAIN = false;
    bf16_t* O; int ldc; const float* st; const float* c1; const float* c2;
    __device__ __forceinline__ void operator()(const f32x4 (&acc)[2][2][4][2], const Unit& u, int wr, int wc, int fr, int fq) const {
        int row0 = u.pm * BM + wr * 64 + fr; int col0 = u.pn * BM + wc * 32 + 8 * fq;
        asm volatile("" : "+v"(row0), "+v"(col0));
        f32x4 c1v[2][2], c2v[2][2];
#pragma unroll
        for (int bj = 0; bj < 2; ++bj)
#pragma unroll
            for (int n = 0; n < 2; ++n) { c1v[bj][n] = *(const f32x4*)(c1 + col0 + bj * HALF + 4 * n); c2v[bj][n] = *(const f32x4*)(c2 + col0 + bj * HALF + 4 * n); }
#pragma unroll
        for (int ai = 0; ai < 2; ++ai)
#pragma unroll
            for (int m = 0; m < 4; ++m) { const int row = row0 + ai * HALF + m * 16; float mu, rs; ln_row_stats<true>(st, row, mu, rs);
                bf16_t* rowp = O + (size_t)row * ldc + col0;
#pragma unroll
                for (int bj = 0; bj < 2; ++bj) { const f32x4 v0 = (acc[ai][bj][m][0] - c1v[bj][0] * mu) * rs + c2v[bj][0], v1 = (acc[ai][bj][m][1] - c1v[bj][1] * mu) * rs + c2v[bj][1];
                    u32x4 w; w.x = cvt_pk_bf16(v0[0], v0[1]); w.y = cvt_pk_bf16(v0[2], v0[3]); w.z = cvt_pk_bf16(v1[0], v1[1]); w.w = cvt_pk_bf16(v1[2], v1[3]);
                    *(u32x4*)(rowp + bj * HALF) = w; } }
    }
};
template <bool HAS_LN> struct EpiSwiGLULN {
    static constexpr bool PERM = true, AFTER_DRAIN = false;
    bf16_t* H; int ldh; const float* st; const float* c1; const float* c2;
    __device__ __forceinline__ void operator()(const f32x4 (&acc)[2][2][4][2], const Unit& u, int wr, int wc, int fr, int fq) const {
        int row0 = u.pm * BM + wr * 64 + fr; const int col0 = u.pn * HALF + wc * 32 + 8 * fq; int wcol0 = u.pn * BM + wc * 32 + 8 * fq;
        asm volatile("" : "+v"(row0), "+v"(wcol0));
        f32x4 c1v[2][2], c2v[2][2];
#pragma unroll
        for (int bj = 0; bj < 2; ++bj)
#pragma unroll
            for (int n = 0; n < 2; ++n) { c1v[bj][n] = *(const f32x4*)(c1 + wcol0 + bj * HALF + 4 * n); c2v[bj][n] = *(const f32x4*)(c2 + wcol0 + bj * HALF + 4 * n); }
#pragma unroll
        for (int ai = 0; ai < 2; ++ai)
#pragma unroll
            for (int m = 0; m < 4; ++m) { const int row = row0 + ai * HALF + m * 16; float mu, rs; ln_row_stats<HAS_LN>(st, row, mu, rs);
                bf16_t* rowp = H + (size_t)row * ldh + col0;
                const f32x4 g0 = (acc[ai][0][m][0] - c1v[0][0] * mu) * rs + c2v[0][0], g1 = (acc[ai][0][m][1] - c1v[0][1] * mu) * rs + c2v[0][1];
                const f32x4 u0 = (acc[ai][1][m][0] - c1v[1][0] * mu) * rs + c2v[1][0], u1 = (acc[ai][1][m][1] - c1v[1][1] * mu) * rs + c2v[1][1];
                u32x4 w;
                w.x = cvt_pk_bf16(silu_mul(g0[0], u0[0]), silu_mul(g0[1], u0[1])); w.y = cvt_pk_bf16(silu_mul(g0[2], u0[2]), silu_mul(g0[3], u0[3]));
                w.z = cvt_pk_bf16(silu_mul(g1[0], u1[0]), silu_mul(g1[1], u1[1])); w.w = cvt_pk_bf16(silu_mul(g1[2], u1[2]), silu_mul(g1[3], u1[3]));
                *(u32x4*)rowp = w; }
    }
};
constexpr size_t EPI_WS_XB = (size_t)166 << 20, EPI_WS_STATS = ((size_t)568 << 20) + ((size_t)1 << 20); constexpr int EPI_T = 32768;
template <bool HAS_LN> struct EpiResidLN {
    static constexpr bool PERM = false, AFTER_DRAIN = false;
    static constexpr int ld = 1024;
    const float* src; float* dst; unsigned char* ws; const float* g_in; const float* b_in; int s_in; float alpha, beta;
    __device__ __forceinline__ void operator()(const f32x4 (&acc)[2][2][4][2], const Unit& u, int wr, int wc, int fr, int fq) const {
        int col0 = u.pn * BM + wc * 32 + 4 * fq; int rowb = u.pm * BM + wr * 64 + fr;
        asm volatile("" : "+v"(col0), "+v"(rowb));
        const float* rd = HAS_LN ? (const float*)dst : src;
        bf16_t* yb = (bf16_t*)(ws + EPI_WS_XB);
        const float* st_in = (const float*)(ws + EPI_WS_STATS) + (size_t)s_in * EPI_T * 2; float* st_out = (float*)(ws + EPI_WS_STATS) + (size_t)(s_in + 1) * EPI_T * 2;
        f32x4 gv[2][2], bv[2][2];
#pragma unroll
        for (int bj = 0; bj < 2; ++bj)
#pragma unroll
            for (int n = 0; n < 2; ++n) { if (HAS_LN) { gv[bj][n] = *(const f32x4*)(g_in + col0 + bj * HALF + n * 16); bv[bj][n] = *(const f32x4*)(b_in + col0 + bj * HALF + n * 16); }
                                          else { gv[bj][n] = (f32x4){1.f, 1.f, 1.f, 1.f}; bv[bj][n] = (f32x4){0.f, 0.f, 0.f, 0.f}; } }
#pragma unroll
        for (int ai = 0; ai < 2; ++ai)
#pragma unroll
            for (int m = 0; m < 4; ++m) { const int row = rowb + ai * HALF + m * 16; const size_t off = (size_t)row * ld + col0;
                float mu, rs; ln_row_stats<HAS_LN>(st_in, row, mu, rs);
                float ps = 0.f, pq = 0.f;
#pragma unroll
                for (int bj = 0; bj < 2; ++bj)
#pragma unroll
                    for (int n = 0; n < 2; ++n) { const f32x4 y = *(const f32x4*)(rd + off + bj * HALF + n * 16);
                        const f32x4 x = HAS_LN ? (y - mu) * rs * gv[bj][n] + bv[bj][n] : y;
                        const f32x4 yn = x * alpha + acc[ai][bj][m][n] * beta;
                        *(f32x4*)(dst + off + bj * HALF + n * 16) = yn;
                        u32x2 w; w.x = cvt_pk_bf16(yn[0], yn[1]); w.y = cvt_pk_bf16(yn[2], yn[3]); *(u32x2*)(yb + off + bj * HALF + n * 16) = w;
                        ps += (yn[0] + yn[1]) + (yn[2] + yn[3]); pq += (yn[0] * yn[0] + yn[1] * yn[1]) + (yn[2] * yn[2] + yn[3] * yn[3]); }
                ps += __shfl_xor(ps, 16); ps += __shfl_xor(ps, 32); pq += __shfl_xor(pq, 16); pq += __shfl_xor(pq, 32);
                if (fq == 0) { atomicAdd(st_out + 2 * (size_t)row, ps); atomicAdd(st_out + 2 * (size_t)row + 1, pq); } }
    }
};
template <class Epi, class Sched, bool ALIGN_EPI = false, bool SP2 = false>
__device__ __forceinline__ void gemm_phase(PG8_LAS unsigned char* lds, const Gemm g, const Sched S, const Epi E) {
    int tid_ = threadIdx.x; asm volatile("" : "+v"(tid_));
    const int tid = tid_, wid = __builtin_amdgcn_readfirstlane(tid >> 6), lane = tid & 63, wr = wid >> 2, wc = wid & 3, fr = lane & 15, fq = lane >> 4;
    const int K = g.K, nt = K / BK;
    unsigned voffA[2], voffB[2];
#pragma unroll
    for (int i = 0; i < 2; ++i) { int R, C; stage_rc(tid * 16 + i * 8192, R, C); const int Rb = Epi::PERM ? ((R & ~31) + perm32(R & 31)) : R;
        voffA[i] = (unsigned)(R * K + C) * 2u; voffB[i] = (unsigned)(Rb * K + C) * 2u; }
    const size_t kstep = (size_t)(BK * 2);
    const size_t hstep = (size_t)HALF * K * 2;
    const size_t tstep = 2 * hstep;
    const unsigned ldsw = (unsigned)wid * 1024u;
    const int aoff = lds_byte(wr * 64 + fr, fq * 8), boff = lds_byte(wc * 32 + fr, fq * 8);
#define PG8_SA(b, h) (((b) * 2 + (h)) * HTB)
#define PG8_SB(b, h) ((4 + (b) * 2 + (h)) * HTB)
#define PG8_STAGE(bufoff, gbase, voff) do { _Pragma("unroll") for (int _i = 0; _i < 2; ++_i) \
        __builtin_amdgcn_global_load_lds((const unsigned*)((const char*)(gbase) + (voff)[_i]), (PG8_LAS unsigned*)(lds + (bufoff) + ldsw + _i * 8192), 16, 0, 0); } while (0)
#define PG8_LDA(dst, b, h) do { _Pragma("unroll") for (int m = 0; m < 4; ++m) _Pragma("unroll") for (int k = 0; k < 2; ++k) dst[m][k] = *(const PG8_LAS bf16x8*)(lds + PG8_SA(b, h) + aoff + m * 2048 + k * 1024); } while (0)
#define PG8_LDB(dst, b, h) do { _Pragma("unroll") for (int n = 0; n < 2; ++n) _Pragma("unroll") for (int k = 0; k < 2; ++k) dst[n][k] = *(const PG8_LAS bf16x8*)(lds + PG8_SB(b, h) + boff + n * 2048 + k * 1024); } while (0)
#define PG8_MMA(ai, bj, At, Bt) do { __builtin_amdgcn_s_setprio(1); _Pragma("unroll") for (int m = 0; m < 4; ++m) _Pragma("unroll") for (int n = 0; n < 2; ++n) _Pragma("unroll") for (int k = 0; k < 2; ++k) \
        acc[ai][bj][m][n] = __builtin_amdgcn_mfma_f32_16x16x32_bf16(Bt[n][k], At[m][k], acc[ai][bj][m][n], 0, 0, 0); __builtin_amdgcn_s_setprio(0); } while (0)
#define PG8_WAIT_V(n) asm volatile("s_waitcnt vmcnt(" #n ")" ::: "memory")
#define PG8_WAIT_L(n) asm volatile("s_waitcnt lgkmcnt(" #n ")" ::: "memory")
#define PG8_BAR __builtin_amdgcn_s_barrier()
#define PG8_SCHED __builtin_amdgcn_sched_barrier(0)
    Unit cur, nxt; int ui = 0;
    if (!S.next(0, cur)) return;
    f32x4 acc[2][2][4][2];
#pragma unroll
    for (int a = 0; a < 2; ++a)
#pragma unroll
        for (int b = 0; b < 2; ++b)
#pragma unroll
            for (int m = 0; m < 4; ++m)
#pragma unroll
                for (int n = 0; n < 2; ++n) acc[a][b][m][n] = (f32x4){0.f, 0.f, 0.f, 0.f};
    bf16x8 At[4][2], B0[2][2], B1[2][2];
    const char* cA = (const char*)g.A + (size_t)cur.pm * tstep; const char* cB = (const char*)g.Bt + (size_t)cur.pn * tstep;
    S.a_ready(cur);
    if constexpr (SP2) {
        PG8_STAGE(PG8_SB(0, 0), cB, voffB); PG8_STAGE(PG8_SB(0, 1), cB + hstep, voffB); PG8_STAGE(PG8_SA(0, 0), cA, voffA); PG8_STAGE(PG8_SA(0, 1), cA + hstep, voffA);
        if (wr == 1) PG8_BAR;
        PG8_WAIT_V(2); PG8_BAR;
        PG8_STAGE(PG8_SB(1, 0), cB + kstep, voffB); PG8_STAGE(PG8_SA(1, 0), cA + kstep, voffA); PG8_STAGE(PG8_SB(1, 1), cB + hstep + kstep, voffB);
        PG8_WAIT_V(6); PG8_BAR;
    } else {
        PG8_STAGE(PG8_SB(0, 0), cB, voffB); PG8_STAGE(PG8_SA(0, 0), cA, voffA); PG8_STAGE(PG8_SB(0, 1), cB + hstep, voffB); PG8_STAGE(PG8_SA(0, 1), cA + hstep, voffA);
        if (wr == 1) PG8_BAR;
        PG8_WAIT_V(4); PG8_BAR;
        PG8_STAGE(PG8_SB(1, 0), cB + kstep, voffB); PG8_STAGE(PG8_SA(1, 0), cA + kstep, voffA); PG8_STAGE(PG8_SB(1, 1), cB + hstep + kstep, voffB);
        PG8_WAIT_V(6); PG8_BAR;
    }
    for (;;) {
        const bool has_next = S.next(ui + 1, nxt);
        const char* nA = has_next ? (const char*)g.A + (size_t)nxt.pm * tstep : cA; const char* nB = has_next ? (const char*)g.Bt + (size_t)nxt.pn * tstep : cB;
        for (int t = 0; t < nt; t += 2) {
            const bool last = (t == nt - 2);
            const char* a1 = cA + (size_t)(t + 1) * kstep;
            const char* a2 = last ? nA : cA + (size_t)(t + 2) * kstep; const char* b2 = last ? nB : cB + (size_t)(t + 2) * kstep;
            const char* a3 = a2 + kstep; const char* b3 = b2 + kstep;
            if (last && has_next) S.a_ready(nxt);
            if constexpr (SP2) {
            PG8_LDB(B0, 0, 0); PG8_LDB(B1, 0, 1); PG8_SCHED; PG8_LDA(At, 0, 0); PG8_STAGE(PG8_SA(1, 1), a1 + hstep, voffA);
            PG8_WAIT_V(8); PG8_WAIT_L(0); PG8_BAR; PG8_MMA(0, 0, At, B0); PG8_MMA(0, 1, At, B1); PG8_BAR; PG8_SCHED;
            PG8_LDA(At, 0, 1); PG8_STAGE(PG8_SB(0, 0), b2, voffB); PG8_STAGE(PG8_SB(0, 1), b2 + hstep, voffB); PG8_STAGE(PG8_SA(0, 0), a2, voffA);
            PG8_WAIT_V(8); PG8_WAIT_L(0); PG8_BAR; PG8_MMA(1, 0, At, B0); PG8_MMA(1, 1, At, B1); PG8_BAR; PG8_SCHED;
            PG8_LDB(B0, 1, 0); PG8_LDB(B1, 1, 1); PG8_SCHED; PG8_LDA(At, 1, 0); PG8_STAGE(PG8_SA(0, 1), a2 + hstep, voffA);
            PG8_WAIT_V(8); PG8_WAIT_L(0); PG8_BAR; PG8_MMA(0, 0, At, B0); PG8_MMA(0, 1, At, B1); PG8_BAR; PG8_SCHED;
            PG8_LDA(At, 1, 1); PG8_STAGE(PG8_SB(1, 0), b3, voffB); PG8_STAGE(PG8_SB(1, 1), b3 + hstep, voffB); PG8_STAGE(PG8_SA(1, 0), a3, voffA);
            PG8_WAIT_V(8); PG8_WAIT_L(0); PG8_BAR; PG8_MMA(1, 0, At, B0); PG8_MMA(1, 1, At, B1); PG8_BAR; PG8_SCHED;
            } else {
            PG8_LDB(B0, 0, 0); PG8_SCHED; PG8_LDA(At, 0, 0); PG8_STAGE(PG8_SA(1, 1), a1 + hstep, voffA);
            PG8_WAIT_L(8); PG8_BAR; PG8_WAIT_L(0); PG8_MMA(0, 0, At, B0); PG8_BAR; PG8_SCHED;
            PG8_LDB(B1, 0, 1); PG8_STAGE(PG8_SB(0, 0), b2, voffB);
            PG8_BAR; PG8_WAIT_L(0); PG8_MMA(0, 1, At, B1); PG8_BAR;
            PG8_LDA(At, 0, 1); PG8_STAGE(PG8_SA(0, 0), a2, voffA);
            PG8_BAR; PG8_WAIT_L(0); PG8_MMA(1, 0, At, B0); PG8_BAR; PG8_SCHED;
            PG8_STAGE(PG8_SB(0, 1), b2 + hstep, voffB);
            PG8_WAIT_V(6); PG8_BAR; PG8_MMA(1, 1, At, B1); PG8_BAR;
            PG8_LDB(B0, 1, 0); PG8_SCHED; PG8_LDA(At, 1, 0); PG8_STAGE(PG8_SA(0, 1), a2 + hstep, voffA);
            PG8_WAIT_L(8); PG8_BAR; PG8_WAIT_L(0); PG8_MMA(0, 0, At, B0); PG8_BAR; PG8_SCHED;
            PG8_LDB(B1, 1, 1); PG8_STAGE(PG8_SB(1, 0), b3, voffB);
            PG8_BAR; PG8_WAIT_L(0); PG8_MMA(0, 1, At, B1); PG8_BAR;
            PG8_LDA(At, 1, 1); PG8_STAGE(PG8_SA(1, 0), a3, voffA);
            PG8_BAR; PG8_WAIT_L(0); PG8_MMA(1, 0, At, B0); PG8_BAR; PG8_SCHED;
            PG8_STAGE(PG8_SB(1, 1), b3 + hstep, voffB);
            PG8_WAIT_V(6); PG8_BAR; PG8_MMA(1, 1, At, B1); PG8_BAR;
            }
        }
        if constexpr (ALIGN_EPI) { if (wr == 0) PG8_BAR; }
        if constexpr (!Epi::AFTER_DRAIN) { E(acc, cur, wr, wc, fr, fq); S.done(cur); }
        if (!has_next) break;
#pragma unroll
        for (int a = 0; a < 2; ++a)
#pragma unroll
            for (int b = 0; b < 2; ++b)
#pragma unroll
                for (int m = 0; m < 4; ++m)
#pragma unroll
                    for (int n = 0; n < 2; ++n) acc[a][b][m][n] = (f32x4){0.f, 0.f, 0.f, 0.f};
        cur = nxt; cA = nA; cB = nB; ++ui;
        if constexpr (ALIGN_EPI) { if (wr == 1) PG8_BAR; }
    }
    PG8_WAIT_V(0);
    if constexpr (!ALIGN_EPI) { if (wr == 0) PG8_BAR; }
    PG8_BAR;
    if constexpr (Epi::AFTER_DRAIN) { E.fused(acc, cur, wr, wc, fr, fq, lds, wid, lane); S.done(cur); }
#undef PG8_SA
#undef PG8_SB
#undef PG8_STAGE
#undef PG8_LDA
#undef PG8_LDB
#undef PG8_MMA
#undef PG8_WAIT_V
#undef PG8_WAIT_L
#undef PG8_BAR
#undef PG8_SCHED
}
}
#define LAS __attribute__((address_space(3)))
typedef unsigned short bf16_t;
typedef short bf16x8 __attribute__((ext_vector_type(8)));
typedef short s16x4 __attribute__((ext_vector_type(4)));
typedef float f32x4 __attribute__((ext_vector_type(4)));
typedef float f32x16 __attribute__((ext_vector_type(16)));
typedef unsigned u32x4 __attribute__((ext_vector_type(4)));
typedef unsigned u32x2 __attribute__((ext_vector_type(2)));
typedef float f32x2_t __attribute__((ext_vector_type(2)));
typedef __bf16 bf16x2_t __attribute__((ext_vector_type(2)));

constexpr int NB = 2, SEQ = 16384, T = NB * SEQ, DM = 1024, DEPTH = 4, DFF = 2816, NGU = 2 * DFF;
constexpr int NIN_SRC = 2208, NPROJ = 3328;
constexpr int PA = 0, PC = 512, PD = 1024, PCQ = 1792, PCKV = 2048, PKR = 2176, PQUP = 2208, PKVUP = 2592, PEND = 3104;
constexpr float LOG2E = 1.4426950408889634f;
constexpr float NORM_EPS = 1e-5f;
constexpr int NWAVES = 8, NTHREADS = 512;
constexpr int LDS_BYTES = 147456;

constexpr size_t MiB = 1u << 20;
constexpr size_t WS_WGU = 0, WS_WD = 88 * MiB, WS_WIN = 132 * MiB, WS_WOUT = 158 * MiB, WS_XB = 166 * MiB;
constexpr size_t WS_H = 230 * MiB, WS_PROJ = 230 * MiB, WS_QB = 438 * MiB, WS_KB = 462 * MiB, WS_VB = 486 * MiB, WS_MIX = 502 * MiB, WS_AUG = 566 * MiB, WS_CTL = 568 * MiB, WS_KMAX = WS_CTL, WS_C12 = WS_CTL + 4096, WS_STATS = WS_CTL + 1 * MiB, CTL_BYTES = 4 * MiB, WS_END = 572 * MiB;
constexpr int C12_L = 2 * NGU + NPROJ;
constexpr size_t C2_OFF = (size_t)DEPTH * C12_L;
static_assert(pg8::EPI_WS_XB == WS_XB && pg8::EPI_WS_STATS == WS_STATS && pg8::EPI_T == T, "part1's copies of the workspace map");
static_assert(WS_C12 + 2 * C2_OFF * 4 <= WS_STATS && WS_STATS + (size_t)12 * T * 8 <= WS_CTL + CTL_BYTES, "control region");
constexpr size_t WGU_L = (size_t)2 * NGU * DM, WGU_F = (size_t)NGU * DM;
constexpr size_t WD_L = (size_t)2 * DM * DFF, WD_F = (size_t)DM * DFF;
constexpr size_t WIN_L = (size_t)NPROJ * DM, WOUT_L = (size_t)DM * DM;

struct Params {
    const float* x; const float* w_in; const float* win_sink; const float* mla_q_norm; const float* mla_w_uq; const float* mla_kv_norm; const float* mla_w_ukv;
    const float* ax_q_norm; const float* ax_k_norm; const float* diff_lambda; const float* diff_subln; const float* w_out; const float* ffn_w_gu; const float* ffn_w_down;
    const float* ln_g; const float* ln_b;
    float* out; unsigned char* ws;
    float lam_init[4];
    float inv32[16];
};

typedef const __attribute__((address_space(4))) Params* KP;
#define GETP(name) KP name = (KP)__builtin_amdgcn_kernarg_segment_ptr(); asm volatile("" : "+s"(name))

__device__ __forceinline__ int tid_fresh() { int t = threadIdx.x; asm volatile("" : "+v"(t)); return t; }
__device__ __forceinline__ unsigned pkbf(float lo, float hi) { f32x2_t v = {lo, hi}; bf16x2_t b = __builtin_convertvector(v, bf16x2_t); return __builtin_bit_cast(unsigned, b); }
__device__ __forceinline__ float bflo(unsigned w) { return __builtin_bit_cast(float, w << 16); }
__device__ __forceinline__ float bfhi(unsigned w) { return __builtin_bit_cast(float, w & 0xffff0000u); }
__device__ __forceinline__ float wave_sum(float v) {
#pragma unroll
    for (int o = 1; o < 64; o <<= 1) v += __shfl_xor(v, o);
    return v;
}
__device__ __forceinline__ void unpack8(const u32x4 w, float (&v)[8]) {
    v[0] = bflo(w.x); v[1] = bfhi(w.x); v[2] = bflo(w.y); v[3] = bfhi(w.y); v[4] = bflo(w.z); v[5] = bfhi(w.z); v[6] = bflo(w.w); v[7] = bfhi(w.w);
}
__device__ __forceinline__ u32x4 pack8(const float (&v)[8]) { u32x4 w; w.x = pkbf(v[0], v[1]); w.y = pkbf(v[2], v[3]); w.z = pkbf(v[4], v[5]); w.w = pkbf(v[6], v[7]); return w; }

__device__ __forceinline__ void transpose_item(const float* __restrict__ W, int ldw, int src_col0, float scale, bf16_t* __restrict__ WT, int K, int dst_row0, int k0, LAS float* scr, int lane,
                                               const float* __restrict__ lng, const float* __restrict__ lnb, float* c1, float* c2) {
    if (src_col0 < 0) {
        const int c = lane & 7;
#pragma unroll
        for (int j = 0; j < 4; ++j) { const int n = (lane >> 3) + 8 * j; *(u32x4*)(WT + (size_t)(dst_row0 + n) * K + k0 + 8 * c) = (u32x4){0u, 0u, 0u, 0u}; }
        return;
    }
    float a1 = 0.f, a2 = 0.f;
#pragma unroll
    for (int i = 0; i < 32; ++i) { const int kk = 2 * i + (lane >> 5); float w = W[(size_t)(k0 + kk) * ldw + src_col0 + (lane & 31)] * scale;
        if (lng) { a2 = fmaf(lnb[k0 + kk], w, a2); w *= lng[k0 + kk]; a1 += bflo(pkbf(w, 0.f)); }
        scr[kk * 33 + (lane & 31)] = w; }
    asm volatile("s_waitcnt lgkmcnt(0)" ::: "memory");
    const int c = lane & 7;
#pragma unroll
    for (int j = 0; j < 4; ++j) { const int n = (lane >> 3) + 8 * j; const LAS float* s = scr + (8 * c) * 33 + n;
        u32x4 o; o.x = pkbf(s[0 * 33], s[1 * 33]); o.y = pkbf(s[2 * 33], s[3 * 33]); o.z = pkbf(s[4 * 33], s[5 * 33]); o.w = pkbf(s[6 * 33], s[7 * 33]);
        *(u32x4*)(WT + (size_t)(dst_row0 + n) * K + k0 + 8 * c) = o; }
    asm volatile("s_waitcnt lgkmcnt(0)" ::: "memory");
    if (lng) { a1 += __shfl_xor(a1, 32); a2 += __shfl_xor(a2, 32);
        if (lane < 32) { atomicAdd(c1 + dst_row0 + lane, a1); atomicAdd(c2 + dst_row0 + lane, a2); } }
}

__device__ __forceinline__ void phase0(KP p, LAS unsigned char* lds, int vcu, int G) {
    const int tid = tid_fresh(), lane = tid & 63, wave = __builtin_amdgcn_readfirstlane(tid >> 6);
    LAS float* scr = (LAS float*)(lds + wave * 16384);
    const int gw = vcu * NWAVES + wave, NGW = G * NWAVES;
    bf16_t* wgu = (bf16_t*)(p->ws + WS_WGU); bf16_t* wd = (bf16_t*)(p->ws + WS_WD); bf16_t* win = (bf16_t*)(p->ws + WS_WIN); bf16_t* wout = (bf16_t*)(p->ws + WS_WOUT);
    float* c12 = (float*)(p->ws + WS_C12);
    constexpr int I_GU = 176 * 16, I_WD = 32 * 44, I_IN = 104 * 16, I_OUT = 32 * 16, I_CMP = 128 * 14;
    constexpr int I_LAYER = 2 * I_GU + 2 * I_WD + I_IN + I_OUT + I_CMP;
    for (int it = gw; it < DEPTH * I_LAYER; it += NGW) {
        const int l = it / I_LAYER; int r = it % I_LAYER;
        if (r < 2 * I_GU) { const int f = r / I_GU; r %= I_GU; const int nb = r / 16, kb = r % 16; const int n0 = 32 * nb;
            const int pn = n0 >> 8, bj = (n0 >> 7) & 1, i0 = n0 & 127;
            const int s = 3 * l + 2 * f - 1;
            transpose_item(p->ffn_w_gu + ((size_t)l * 2 + f) * DM * NGU, NGU, bj * DFF + 128 * pn + i0, 1.f, wgu + l * WGU_L + f * WGU_F, DM, n0, 64 * kb, scr, lane,
                           s >= 0 ? p->ln_g + s * DM : nullptr, s >= 0 ? p->ln_b + s * DM : nullptr, c12 + l * C12_L + f * NGU, c12 + C2_OFF + l * C12_L + f * NGU); continue; }
        r -= 2 * I_GU;
        if (r < 2 * I_WD) { const int f = r / I_WD; r %= I_WD; const int nb = r / 44, kb = r % 44;
            transpose_item(p->ffn_w_down + ((size_t)l * 2 + f) * DFF * DM, DM, 32 * nb, 1.f, wd + l * WD_L + f * WD_F, DFF, 32 * nb, 64 * kb, scr, lane, nullptr, nullptr, nullptr, nullptr); continue; }
        r -= 2 * I_WD;
        if (r < I_IN) { const int nb = r / 16, kb = r % 16; const int n0 = 32 * nb; int src; float sc = 1.f;
            if (n0 < PC) { src = n0; if (n0 < 256) sc = 0.125f; }
            else if (n0 < PD) src = 928 + (n0 - PC);
            else if (n0 < PCQ) { src = 1440 + (n0 - PD); if (n0 - PD < 256) sc = 0.17677669529663687f; }
            else if (n0 < PCKV) src = 512 + (n0 - PCQ);
            else if (n0 < PKR) src = 768 + (n0 - PCKV);
            else if (n0 < PQUP) src = 896;
            else if (n0 < PEND) continue;
            else src = -1;
            transpose_item(p->w_in + (size_t)l * DM * NIN_SRC, NIN_SRC, src, sc, win + l * WIN_L, DM, n0, 64 * kb, scr, lane,
                           p->ln_g + (3 * l) * DM, p->ln_b + (3 * l) * DM, c12 + l * C12_L + 2 * NGU, c12 + C2_OFF + l * C12_L + 2 * NGU); continue; }
        r -= I_IN;
        if (r < I_OUT) { const int nb = r / 16, kb = r % 16;
            transpose_item(p->w_out + (size_t)l * DM * DM, DM, 32 * nb, 1.f, wout + l * WOUT_L, DM, 32 * nb, 64 * kb, scr, lane, nullptr, nullptr, nullptr, nullptr); continue; }
        r -= I_OUT;
        {
            const int kb8 = r / 14, ng = r % 14; const int k0 = 8 * kb8;
            int J, cA, ldu, nc; const float* g; const float* U;
            if (ng < 6) { J = 256; cA = 512; g = p->mla_q_norm + l * 256; U = p->mla_w_uq + (size_t)l * 256 * 384; ldu = 384; nc = 64 * ng; }
            else { J = 128; cA = 768; g = p->mla_kv_norm + l * 128; U = p->mla_w_ukv + (size_t)l * 128 * 512; ldu = 512; nc = 64 * (ng - 6); }
            const int nglob = (ng < 6 ? 0 : 384) + nc + lane;
            const float* a = p->w_in + (size_t)l * DM * NIN_SRC + (size_t)k0 * NIN_SRC + cA;
            const float* up = U + nc + lane;
            float acc[8];
#pragma unroll
            for (int e = 0; e < 8; ++e) acc[e] = 0.f;
#pragma unroll 4
            for (int j = 0; j < J; ++j) { const float u = up[(size_t)j * ldu] * g[j];
#pragma unroll
                for (int e = 0; e < 8; ++e) acc[e] = fmaf(a[(size_t)e * NIN_SRC + j], u, acc[e]); }
            const float* lg = p->ln_g + (3 * l) * DM + k0; const float* lb = p->ln_b + (3 * l) * DM + k0;
            float s1 = 0.f, s2 = 0.f; unsigned wb[8];
#pragma unroll
            for (int e = 0; e < 8; ++e) { wb[e] = pkbf(acc[e] * lg[e], 0.f) & 0xffffu; s1 += bflo(wb[e]); s2 = fmaf(acc[e], lb[e], s2); }
            u32x4 o; o.x = wb[0] | (wb[1] << 16); o.y = wb[2] | (wb[3] << 16); o.z = wb[4] | (wb[5] << 16); o.w = wb[6] | (wb[7] << 16);
            *(u32x4*)(win + l * WIN_L + (size_t)(PQUP + nglob) * DM + k0) = o;
            atomicAdd(c12 + l * C12_L + 2 * NGU + PQUP + nglob, s1); atomicAdd(c12 + C2_OFF + l * C12_L + 2 * NGU + PQUP + nglob, s2);
        }
    }
    { u32x4* ag = (u32x4*)(p->ws + WS_AUG);
      for (int i = (vcu * NWAVES + wave) * 64 + lane; i < SEQ * 4; i += G * NWAVES * 64) { const int t = i >> 2, h = i & 3;
          const float sl = __builtin_amdgcn_exp2f(-(float)(5 + h));
          u32x4 w = {pkbf(sl * (float)(128 * (t >> 7)), sl * (float)(t & 127)), 0u, 0u, 0u}; ag[2 * i] = w; ag[2 * i + 1] = (u32x4){0u, 0u, 0u, 0u}; } }
    bf16_t* xb = (bf16_t*)(p->ws + WS_XB);
    for (int m = gw; m < T; m += NGW) {
        const f32x4* xr = (const f32x4*)(p->x + (size_t)m * DM) + lane; u32x2* o8 = (u32x2*)(xb + (size_t)m * DM) + lane;
#pragma unroll
        for (int j = 0; j < 4; ++j) { const f32x4 v = xr[64 * j]; u32x2 w; w.x = pkbf(v.x, v.y); w.y = pkbf(v.z, v.w); o8[64 * j] = w; }
    }
}

__device__ __forceinline__ void ln_phase(float* X, bf16_t* xb, const float* __restrict__ g, const float* __restrict__ b, int vcu, int G) {
    const int tid = tid_fresh(), lane = tid & 63, wave = __builtin_amdgcn_readfirstlane(tid >> 6);
    const int gw = vcu * NWAVES + wave, NGW = G * NWAVES;
    f32x4 gv[4], bv[4];
#pragma unroll
    for (int j = 0; j < 4; ++j) { gv[j] = ((const f32x4*)g)[64 * j + lane]; bv[j] = ((const f32x4*)b)[64 * j + lane]; }
    for (int m = gw; m < T; m += NGW) {
        f32x4* xr = (f32x4*)(X + (size_t)m * DM) + lane; u32x2* o8 = (u32x2*)(xb + (size_t)m * DM) + lane;
        f32x4 v[4]; float s = 0.f;
#pragma unroll
        for (int j = 0; j < 4; ++j) { v[j] = xr[64 * j]; s += (v[j].x + v[j].y) + (v[j].z + v[j].w); }
        const float mean = wave_sum(s) * (1.f / DM); float s2 = 0.f;
#pragma unroll
        for (int j = 0; j < 4; ++j) { v[j] = v[j] - mean; s2 += (v[j].x * v[j].x + v[j].y * v[j].y) + (v[j].z * v[j].z + v[j].w * v[j].w); }
        const float rstd = 1.f / sqrtf(wave_sum(s2) * (1.f / DM) + NORM_EPS);
#pragma unroll
        for (int j = 0; j < 4; ++j) { const f32x4 y = v[j] * rstd * gv[j] + bv[j]; xr[64 * j] = y; u32x2 w; w.x = pkbf(y.x, y.y); w.y = pkbf(y.z, y.w); o8[64 * j] = w; }
    }
}

__device__ __forceinline__ void sincos_rev(float ang, float& s, float& c) {
    double d = (double)ang * 0.15915494309189535; d -= __builtin_rint(d); const float f = (float)d;
    s = __builtin_amdgcn_sinf(f); c = __builtin_amdgcn_cosf(f);
}
__device__ __forceinline__ void rope8(float (&v)[8], bool first, float pos, int i0, KP p) {
#pragma unroll
    for (int e = 0; e < 8; ++e) {
        const float other = __shfl_xor(v[e], 2);
        const float inv = i0 ? p->inv32[8 + e] : p->inv32[e];
        float s, c; sincos_rev(pos * inv, s, c);
        v[e] = first ? (v[e] * c - other * s) : (other * s + v[e] * c);
    }
}
__device__ __forceinline__ void prep_phase(KP p, int l, int vcu, int G) {
    const int tid = tid_fresh(), lane = tid & 63, wave = __builtin_amdgcn_readfirstlane(tid >> 6);
    const int gw = vcu * NWAVES + wave, NGW = G * NWAVES;
    bf16_t* proj = (bf16_t*)(p->ws + WS_PROJ); bf16_t* qb = (bf16_t*)(p->ws + WS_QB); bf16_t* kb = (bf16_t*)(p->ws + WS_KB); bf16_t* vb = (bf16_t*)(p->ws + WS_VB);
    float cg[8];
    { const float* gsrc = (lane < 32 ? p->ax_q_norm : p->ax_k_norm) + l * 64 + 8 * (lane & 7);
#pragma unroll
      for (int e = 0; e < 8; ++e) cg[e] = gsrc[e]; }
    float km0 = 0.f, km1 = 0.f;
    for (int tok = gw; tok < T; tok += NGW) {
        const int t = tok & (SEQ - 1);
        bf16_t* pr = proj + (size_t)tok * NPROJ;
        const int l48 = lane < 48 ? lane : 0, l32 = lane < 32 ? lane : 0, l4 = lane < 4 ? lane : 0;
        const u32x4 in_cq = *(const u32x4*)(pr + PCQ + 8 * l48), in_qup = *(const u32x4*)(pr + PQUP + 8 * l48), in_kv = *(const u32x4*)(pr + PKVUP + 8 * lane);
        const u32x4 in_kr = *(const u32x4*)(pr + PKR + 8 * l4), in_c = *(const u32x4*)(pr + PC + 8 * l48), in_dk = *(const u32x4*)(pr + PD + 256 + 8 * l32);
        { float s = 0.f;
          if (lane < 32) { float v[8]; unpack8(in_dk, v);
#pragma unroll
              for (int e = 0; e < 8; ++e) s += v[e] * v[e]; }
          s += __shfl_xor(s, 1); s += __shfl_xor(s, 2);
          if (tok < SEQ) km0 = fmaxf(km0, s); else km1 = fmaxf(km1, s); }
        float ssq = 0.f;
        if (lane < 48) { float v[8]; unpack8(in_cq, v);
#pragma unroll
            for (int e = 0; e < 8; ++e) ssq += v[e] * v[e]; }
        const float ssq_q = wave_sum(lane < 32 ? ssq : 0.f), ssq_kv = wave_sum(lane >= 32 ? ssq : 0.f);
        const float rstd_q = 1.f / sqrtf(ssq_q * (1.f / 256.f) + NORM_EPS), rstd_kv = 1.f / sqrtf(ssq_kv * (1.f / 128.f) + NORM_EPS);
        {
            const int r = lane % 12; float v[8];
            unpack8(in_qup, v);
#pragma unroll
            for (int e = 0; e < 8; ++e) v[e] = (lane < 48) ? v[e] * rstd_q : 0.f;
            float w[8];
#pragma unroll
            for (int e = 0; e < 8; ++e) w[e] = v[e];
            rope8(w, r < 10, (float)t, 8 * (r & 1), p);
            const bool isr = (r >= 8); const float qs = 0.10206207261596575f;
#pragma unroll
            for (int e = 0; e < 8; ++e) v[e] = (isr ? w[e] : v[e]) * qs;
            if (lane < 48) *(u32x4*)(qb + (size_t)tok * 384 + 8 * lane) = pack8(v);
        }
        {
            float v[8]; unpack8(in_kv, v);
#pragma unroll
            for (int e = 0; e < 8; ++e) v[e] *= rstd_kv;
            const int hd = lane >> 4, r = lane & 15;
            if (r < 8) *(u32x4*)(kb + (size_t)tok * 384 + hd * 96 + 8 * r) = pack8(v);
            else *(u32x4*)(vb + (size_t)tok * 256 + hd * 64 + 8 * (r - 8)) = pack8(v);
        }
        {
            float v[8]; unpack8(in_kr, v);
            rope8(v, (lane & 3) < 2, (float)t, 8 * (lane & 1), p);
            if (lane < 4) { const u32x4 w = pack8(v);
#pragma unroll
                for (int hd = 0; hd < 4; ++hd) *(u32x4*)(kb + (size_t)tok * 384 + hd * 96 + 64 + 8 * lane) = w; }
        }
        {
            float v[8]; unpack8(in_c, v);
            float s = 0.f;
#pragma unroll
            for (int e = 0; e < 8; ++e) s += v[e] * v[e];
            s += __shfl_xor(s, 1); s += __shfl_xor(s, 2); s += __shfl_xor(s, 4);
            const float rs = 1.f / sqrtf(s * (1.f / 64.f) + NORM_EPS);
#pragma unroll
            for (int e = 0; e < 8; ++e) v[e] = v[e] * rs * cg[e];
            const int r = lane & 7; const float pos = (r < 4) ? (float)(t >> 6) : (float)(t & 63);
            rope8(v, (r & 3) < 2, pos, 8 * (r & 1), p);
            if (lane < 32) {
#pragma unroll
                for (int e = 0; e < 8; ++e) v[e] *= 0.125f; }
            if (lane < 48) *(u32x4*)(pr + PC + 8 * lane) = pack8(v);
        }
    }
    if (lane < 32 && (lane & 3) == 0) { unsigned* km = (unsigned*)(p->ws + WS_KMAX) + l * 16 + (lane >> 2);
        atomicMax(km, __builtin_bit_cast(unsigned, km0)); atomicMax(km + 8, __builtin_bit_cast(unsigned, km1)); }
}

#ifndef ATT_TYPES
#define ATT_TYPES 15
#endif
namespace att {
typedef float f32x2 __attribute__((ext_vector_type(2)));
constexpr int VPITCH = 144, KBUF = 64 * 208, VBUF = 64 * VPITCH;
constexpr int ATT_LDS = 2 * KBUF + 2 * VBUF;
constexpr float RESCALE_T = 5.0f;
__device__ __forceinline__ s16x4 vtr(const LAS char* p) { return __builtin_bit_cast(s16x4, __builtin_amdgcn_ds_read_tr16_b64_v4i16((LAS s16x4*)p)); }
__device__ __forceinline__ void xhalf_swap(float m, float& a, float& b) {
    a = m; b = m;
    asm volatile("s_nop 1\n\tv_permlane32_swap_b32 %0, %1\n\ts_nop 1" : "+v"(a), "+v"(b));
}
__device__ __forceinline__ float xhalf_max(float m) { float a, b; xhalf_swap(m, a, b); return fmaxf(a, b); }
__device__ __forceinline__ float xhalf_sum(float m) { float a, b; xhalf_swap(m, a, b); return a + b; }
__device__ __forceinline__ float max3f(float a, float b, float c) { return fmaxf(fmaxf(a, b), c); }
#define ATT_MFMA(a, b, c) __builtin_amdgcn_mfma_f32_32x32x16_bf16((a), (b), (c), 0, 0, 0)

template <int DK, int MODE, bool INIT = true>
__device__ __forceinline__ void flash_pass(LAS char* lds, const bf16_t* __restrict__ Qg, int qp, const bf16_t* __restrict__ Kg, int kp, const bf16_t* __restrict__ Vg, int vp,
                                           const bf16_t* __restrict__ AUGg, int q0, int a0, int nA, int b0, int nt, float slope, f32x16& O0, f32x16& O1, float& Mout, float& Lout) {
    constexpr int DKL = DK + (MODE == 1 ? 16 : 0);
    constexpr int KPITCH = DKL * 2 + 16, NKC = 8 * DKL, CPR = DKL / 8, NKS = DK / 16;
    constexpr bool HAS_K1 = NKC > 512;
    constexpr int DUMMY = 2 * KBUF + 2 * VBUF;
    const int tid = tid_fresh(), lane = tid & 63, r32 = lane & 31, hi = lane >> 5; const int wid = __builtin_amdgcn_readfirstlane(tid >> 6);
    const int qrow = q0 + wid * 32 + r32;
    bf16x8 qf[NKS];
#pragma unroll
    for (int ks = 0; ks < NKS; ++ks) qf[ks] = *(const bf16x8*)(Qg + (size_t)qrow * qp + 16 * ks + 8 * hi);
    const int kc1 = tid + 512;
    const bool k0v = tid < NKC, k1v = HAS_K1 && kc1 < NKC;
    const int kr0 = k0v ? tid / CPR : 0, kcc0 = k0v ? tid % CPR : 0, kr1 = k1v ? kc1 / CPR : 0, kcc1 = k1v ? kc1 % CPR : 0, vr = tid >> 3, vcc = tid & 7;
    const bf16_t* kg0; size_t kst0;
    if (MODE == 1 && kcc0 >= DK / 8) { kg0 = AUGg + (size_t)kr0 * 64 + 8 * (kcc0 - DK / 8); kst0 = (size_t)64 * 64; } else { kg0 = Kg + (size_t)kr0 * kp + 8 * kcc0; kst0 = (size_t)64 * kp; }
    const bf16_t* kg1 = Kg + (size_t)kr1 * kp + 8 * kcc1; const size_t kst1 = (size_t)64 * kp;
    const bf16_t* vg = Vg + (size_t)vr * vp + 8 * vcc; const size_t vst = (size_t)64 * vp;
    const int kl0 = k0v ? kr0 * KPITCH + 16 * kcc0 : -1, kl1 = k1v ? kr1 * KPITCH + 16 * kcc1 : -1, vl = 2 * KBUF + vr * VPITCH + 16 * vcc;
    u32x4 rk0 = {0u, 0u, 0u, 0u}, rk1 = {0u, 0u, 0u, 0u}, rv = {0u, 0u, 0u, 0u};
#define ATT_KT(i) ((i) < nA ? a0 + (i) : b0 + ((i) - nA))
#define ATT_LOADK(kt) do { const size_t t_ = (size_t)(kt); rk0 = *(const u32x4*)(kg0 + t_ * kst0); if (HAS_K1) rk1 = *(const u32x4*)(kg1 + t_ * kst1); } while (0)
#define ATT_LOADV(kt) do { rv = *(const u32x4*)(vg + (size_t)(kt) * vst); } while (0)
#define ATT_STOREK(buf) do { *(LAS u32x4*)(lds + (kl0 >= 0 ? (buf) * KBUF + kl0 : DUMMY + tid * 16)) = rk0; if (HAS_K1) *(LAS u32x4*)(lds + (kl1 >= 0 ? (buf) * KBUF + kl1 : DUMMY + tid * 16)) = rk1; } while (0)
#define ATT_STOREV(buf) do { *(LAS u32x4*)(lds + (buf) * VBUF + vl) = rv; } while (0)
    const int q4 = (lane & 15) >> 2, p4 = lane & 3, b16 = (lane >> 4) & 1;
    const int vbase = 2 * KBUF + (4 * hi + q4) * VPITCH + 32 * b16 + 8 * p4;
    const int kbase = r32 * KPITCH + 16 * hi;
    const int qw = q0 + wid * 32;
    const float stq = slope * (float)qrow;
    const bf16x8 qzero = {0, 0, 0, 0, 0, 0, 0, 0};
    bf16x8 qpos = qzero, qneg = qzero;
    if (MODE == 1 && hi == 0) { qpos[0] = (short)0x3F80; qpos[1] = (short)0x3F80; qneg[0] = (short)0xBF80; qneg[1] = (short)0xBF80; }
    constexpr int NKF = NKS + (MODE == 1 ? 1 : 0);
    constexpr int KPRE = NKF > 4 ? 4 : NKF;
    bf16x8 kfa[NKF], kfb[NKF];
#define ATT_KREAD(kbuf, f0, f1) do { const LAS char* Kb_ = lds + (kbuf) * KBUF + kbase; \
        _Pragma("unroll") for (int ks_ = (f0); ks_ < (f1); ++ks_) { kfa[ks_] = *(const LAS bf16x8*)(Kb_ + 32 * ks_); kfb[ks_] = *(const LAS bf16x8*)(Kb_ + 32 * KPITCH + 32 * ks_); } } while (0)
#define ATT_QKM(sa, sb, side) do { \
        _Pragma("unroll") for (int e_ = 0; e_ < 16; ++e_) { sa[e_] = 0.f; sb[e_] = 0.f; } \
        _Pragma("unroll") for (int ks_ = 0; ks_ < NKS; ++ks_) { sa = ATT_MFMA(kfa[ks_], qf[ks_], sa); sb = ATT_MFMA(kfb[ks_], qf[ks_], sb); } \
        if (MODE == 1) { const bf16x8 qa_ = (side) < 0 ? qpos : ((side) > 0 ? qneg : qzero); sa = ATT_MFMA(kfa[NKS], qa_, sa); sb = ATT_MFMA(kfb[NKS], qa_, sb); } } while (0)
#define ATT_QK(sa, sb, kbuf, side) do { ATT_KREAD(kbuf, 0, NKF); ATT_QKM(sa, sb, side); } while (0)
    bf16x8 vfa[4], vfb[4];
#define ATT_VREAD(vbuf) do { const LAS char* Vb_ = lds + (vbuf) * VBUF + vbase; \
        _Pragma("unroll") for (int j_ = 0; j_ < 4; ++j_) { const LAS char* vp0_ = Vb_ + (16 * j_) * VPITCH; \
            { const s16x4 lo_ = vtr(vp0_), hh_ = vtr(vp0_ + 8 * VPITCH); vfa[j_] = __builtin_shufflevector(lo_, hh_, 0, 1, 2, 3, 4, 5, 6, 7); } \
            { const s16x4 lo_ = vtr(vp0_ + 64), hh_ = vtr(vp0_ + 8 * VPITCH + 64); vfb[j_] = __builtin_shufflevector(lo_, hh_, 0, 1, 2, 3, 4, 5, 6, 7); } } } while (0)
#define ATT_PVM() do { _Pragma("unroll") for (int j_ = 0; j_ < 4; ++j_) { O0 = ATT_MFMA(vfa[j_], pf[j_ >> 1][j_ & 1], O0); O1 = ATT_MFMA(vfb[j_], pf[j_ >> 1][j_ & 1], O1); } } while (0)
#define ATT_PV(vbuf) do { ATT_VREAD(vbuf); ATT_PVM(); } while (0)
#define ATT_SIDE(kt) ((MODE != 1) ? 0 : (((kt) * 64 + 63 < qw) ? -1 : (((kt) * 64 > qw + 31) ? 1 : 0)))
    ATT_LOADK(ATT_KT(0)); ATT_STOREK(0);
    ATT_LOADK(ATT_KT(1)); ATT_STOREK(1);
    ATT_STOREV(1);
    __syncthreads();
    float M = INIT ? -1e20f : Mout, L = INIT ? 0.f : Lout;
    if (INIT) {
#pragma unroll
        for (int i = 0; i < 16; ++i) { O0[i] = 0.f; O1[i] = 0.f; } }
    bf16x8 pf[2][2];
#pragma unroll
    for (int kb = 0; kb < 2; ++kb)
#pragma unroll
        for (int st = 0; st < 2; ++st) pf[kb][st] = qzero;
    f32x16 s0, s1, n0, n1;
    int side_cur = ATT_SIDE(ATT_KT(0));
    ATT_QK(s0, s1, 0, side_cur);
#pragma unroll
    for (int e = 0; e < 16; ++e) { n0[e] = 0.f; n1[e] = 0.f; }
    __syncthreads();
    constexpr int NMF = 2 * NKS + (MODE == 1 ? 2 : 0) + 8;
#define ATT_ITER(i, C0, C1, N0, N1, HASN, HASK2) do { \
        const int kt = ATT_KT(i); \
        if (HASK2) ATT_LOADK(ATT_KT((i) + 2)); \
        ATT_LOADV(kt); \
        if (HASN) ATT_KREAD(((i) + 1) & 1, 0, KPRE); \
        const int k0 = kt * 64; \
          \
        float rc = 0.f; \
        if (MODE == 1) { \
            if (side_cur != 0) rc = side_cur < 0 ? -stq : stq; \
            else { const float dbase = (float)(k0 + 4 * hi - qrow); \
                _Pragma("unroll") for (int e = 0; e < 16; ++e) { const float c = (float)((e & 3) + 8 * (e >> 2)); \
                    C0[e] = fmaf(-slope, fabsf(dbase + c), C0[e]); C1[e] = fmaf(-slope, fabsf(dbase + (c + 32.f)), C1[e]); } } \
        } \
        if (MODE == 2) { const float dbase = (float)(k0 + 4 * hi - qrow); \
            _Pragma("unroll") for (int e = 0; e < 16; ++e) { const float c = (float)((e & 3) + 8 * (e >> 2)); \
                const float d0 = fabsf(dbase + c), d1 = fabsf(dbase + (c + 32.f)); \
                C0[e] = (d0 <= 128.f) ? fmaf(-slope, d0, C0[e]) : -1e30f; C1[e] = (d1 <= 128.f) ? fmaf(-slope, d1, C1[e]) : -1e30f; } } \
        float mx = max3f(C0[0], C1[0], C0[1]); \
        _Pragma("unroll") for (int e = 1; e < 15; e += 2) { mx = max3f(mx, C1[e], C0[e + 1]); mx = max3f(mx, C1[e + 1], C0[e + 2]); } \
        mx = fmaxf(mx, C1[15]); \
        const float mt = xhalf_max(mx) + rc;                     \
        if (__builtin_amdgcn_ballot_w64(mt > M + RESCALE_T) != 0ull) {         \
            ATT_PV(((i) + 1) & 1); \
            _Pragma("unroll") for (int kb = 0; kb < 2; ++kb) _Pragma("unroll") for (int st = 0; st < 2; ++st) pf[kb][st] = qzero; \
            const float Mn = fmaxf(M, mt); const float alpha = __builtin_amdgcn_exp2f((M - Mn) * LOG2E); M = Mn; \
            L *= alpha; \
            _Pragma("unroll") for (int e = 0; e < 16; ++e) { O0[e] *= alpha; O1[e] *= alpha; } \
        } \
          \
        const int side_next = HASN ? ATT_SIDE(ATT_KT((i) + 1)) : 0; \
        if (HASN) ATT_KREAD(((i) + 1) & 1, KPRE, NKF); \
        ATT_VREAD(((i) + 1) & 1); \
        if (HASN) ATT_QKM(N0, N1, side_next); \
        ATT_PVM();                                   \
        const float cc = (rc - M) * LOG2E; \
        const f32x2 k2 = {LOG2E, LOG2E}, c2 = {cc, cc}; \
        f32x2 ps2 = {0.f, 0.f}; \
        _Pragma("unroll") for (int e = 0; e < 16; e += 2) { \
            f32x2 a = {C0[e], C0[e + 1]}, b = {C1[e], C1[e + 1]}; \
            a = a * k2 + c2; b = b * k2 + c2; \
            a.x = __builtin_amdgcn_exp2f(a.x); a.y = __builtin_amdgcn_exp2f(a.y); b.x = __builtin_amdgcn_exp2f(b.x); b.y = __builtin_amdgcn_exp2f(b.y); \
            ps2 += a; ps2 += b; \
            C0[e] = a.x; C0[e + 1] = a.y; C1[e] = b.x; C1[e + 1] = b.y; } \
        L += ps2.x + ps2.y; \
        _Pragma("unroll") for (int st = 0; st < 2; ++st) { u32x4 w0, w1; \
            w0.x = pkbf(C0[8 * st + 0], C0[8 * st + 1]); w0.y = pkbf(C0[8 * st + 2], C0[8 * st + 3]); w0.z = pkbf(C0[8 * st + 4], C0[8 * st + 5]); w0.w = pkbf(C0[8 * st + 6], C0[8 * st + 7]); \
            w1.x = pkbf(C1[8 * st + 0], C1[8 * st + 1]); w1.y = pkbf(C1[8 * st + 2], C1[8 * st + 3]); w1.z = pkbf(C1[8 * st + 4], C1[8 * st + 5]); w1.w = pkbf(C1[8 * st + 6], C1[8 * st + 7]); \
            pf[0][st] = __builtin_bit_cast(bf16x8, w0); pf[1][st] = __builtin_bit_cast(bf16x8, w1); } \
        side_cur = side_next; \
        if (HASN) { __builtin_amdgcn_sched_group_barrier(0x100, 16 + 2 * (NKF - KPRE), 0); \
            _Pragma("unroll") for (int g_ = 0; g_ < NMF; ++g_) { __builtin_amdgcn_sched_group_barrier(0x008, 1, 0); __builtin_amdgcn_sched_group_barrier(0x002, 6, 0); } } \
        if (HASK2) ATT_STOREK((i) & 1); \
        ATT_STOREV((i) & 1); \
        __syncthreads(); } while (0)
    for (int i = 0; i + 2 < nt; i += 2) {
        ATT_ITER(i, s0, s1, n0, n1, true, true);
        ATT_ITER(i + 1, n0, n1, s0, s1, true, true);
    }
    ATT_ITER(nt - 2, s0, s1, n0, n1, true, false);
    ATT_ITER(nt - 1, n0, n1, s0, s1, false, false);
    ATT_PV((nt - 1) & 1);
    __syncthreads();
#undef ATT_ITER
#undef ATT_LOADK
#undef ATT_LOADV
#undef ATT_STOREK
#undef ATT_STOREV
#undef ATT_KT
#undef ATT_QK
#undef ATT_PV
#undef ATT_KREAD
#undef ATT_QKM
#undef ATT_VREAD
#undef ATT_PVM
#undef ATT_SIDE
    Mout = M; Lout = L;
}

__device__ __forceinline__ void store_o(bf16_t* orow, const f32x16& O0, const f32x16& O1, int hi) {
#pragma unroll
    for (int g = 0; g < 4; ++g) {
        u32x2 w0, w1; w0.x = pkbf(O0[4 * g], O0[4 * g + 1]); w0.y = pkbf(O0[4 * g + 2], O0[4 * g + 3]); w1.x = pkbf(O1[4 * g], O1[4 * g + 1]); w1.y = pkbf(O1[4 * g + 2], O1[4 * g + 3]);
        *(u32x2*)(orow + 8 * g + 4 * hi) = w0; *(u32x2*)(orow + 32 + 8 * g + 4 * hi) = w1;
    }
}

__device__ __forceinline__ void attn_phase(KP p, int l, LAS char* lds, int vcu, int G) {
    const int tid = tid_fresh(), lane = tid & 63, r32 = lane & 31, hi = lane >> 5; const int wid = __builtin_amdgcn_readfirstlane(tid >> 6);
    const bf16_t* proj = (const bf16_t*)(p->ws + WS_PROJ); const bf16_t* qb = (const bf16_t*)(p->ws + WS_QB); const bf16_t* kb = (const bf16_t*)(p->ws + WS_KB); const bf16_t* vb = (const bf16_t*)(p->ws + WS_VB);
    const bf16_t* aug = (const bf16_t*)(p->ws + WS_AUG);
    bf16_t* mix = (bf16_t*)(p->ws + WS_MIX);
    float lam;
    { const float* lp = p->diff_lambda + l * 128; const float a = (lane < 32) ? lp[lane] * lp[32 + lane] : 0.f, b2 = (lane < 32) ? lp[64 + lane] * lp[96 + lane] : 0.f;
      lam = expf(wave_sum(a)) - expf(wave_sum(b2)) + p->lam_init[l]; }
    const float one_m_li = 1.f - p->lam_init[l];
    for (int u = vcu; u < 2048; u += G) {
        if (!((ATT_TYPES >> (u >> 9)) & 1)) continue;
        const int type = u >> 9, idx = u & 511, bh = idx >> 6, qblk = idx & 63, b = bh >> 2, hd = bh & 3, q0 = qblk * 256;
        const int qrow = q0 + wid * 32 + r32;
        const size_t tok0 = (size_t)b * SEQ;
        bf16_t* orow = mix + (tok0 + qrow) * DM;
        f32x16 O0, O1; float M, L;
        if (type == 0) {
            const int bD = idx >> 8, hD = ((idx >> 6) & 3) ^ (bD ? 3 : 0);
            const size_t tokD = (size_t)bD * SEQ;
            bf16_t* orowD = mix + (tokD + qrow) * DM;
            const float slope = __builtin_amdgcn_exp2f(-(float)(5 + hD));
            const bf16_t* base = proj + tokD * NPROJ + PD;
            const int d0 = q0 / 64;
            LAS float* asave = (LAS float*)(lds + 65536) + tid;
#pragma unroll 1
            for (int mp = 0; mp < 2; ++mp) {
                const bf16_t* Qm = base + 64 * hD + 32 * mp; const bf16_t* Km = base + 256 + 64 * hD + 32 * mp; const bf16_t* Vm = base + 512 + 64 * hD;
                flash_pass<32, 1, true>(lds, Qm, NPROJ, Km, NPROJ, Vm, NPROJ, aug + 16 * hD, q0, d0, 4, 0, 4, slope, O0, O1, M, L);
                float qn2 = 0.f;
                { const u32x4* qr = (const u32x4*)(Qm + (size_t)qrow * NPROJ);
#pragma unroll
                  for (int c = 0; c < 4; ++c) { float v[8]; unpack8(qr[c], v);
#pragma unroll
                      for (int e = 0; e < 8; ++e) qn2 += v[e] * v[e]; } }
                const float kmax = sqrtf(__builtin_bit_cast(float, ((const unsigned*)(p->ws + WS_KMAX))[l * 16 + bD * 8 + hD * 2 + mp]));
                float dc = (sqrtf(qn2) * kmax * 1.001f + 40.f - M) / slope;
                dc = fminf(fmaxf(dc, 0.f), 1.0e8f);
#pragma unroll
                for (int o = 1; o < 64; o <<= 1) dc = fmaxf(dc, __shfl_xor(dc, o));
                LAS float* red = (LAS float*)(lds + ATT_LDS + 16384);
                if (lane == 0) red[wid] = dc;
                __syncthreads();
#pragma unroll
                for (int w = 0; w < 8; ++w) dc = fmaxf(dc, red[w]);
                __syncthreads();
                const int dci = (int)dc + 1;
                const int lo_key = q0 - dci - 63;
                int ktlo = lo_key <= 0 ? 0 : (lo_key + 63) / 64; int kthi = (q0 + 255 + dci) / 64; if (kthi > SEQ / 64 - 1) kthi = SEQ / 64 - 1;
                if (ktlo > d0) ktlo = d0; if (kthi < d0 + 3) kthi = d0 + 3;
                if (((kthi - ktlo + 1) & 1) != 0) { if (ktlo > 0) --ktlo; else ++kthi; }
                const int nR = kthi - (d0 + 3), nL = d0 - ktlo;
                if (nR + nL > 0) flash_pass<32, 1, false>(lds, Qm, NPROJ, Km, NPROJ, Vm, NPROJ, aug + 16 * hD, q0, d0 + 4, nR, ktlo, nR + nL, slope, O0, O1, M, L);
                if (mp == 0) { const float i1 = 1.f / xhalf_sum(L);
#pragma unroll
                    for (int i = 0; i < 16; ++i) { asave[(2 * i) * NTHREADS] = O0[i] * i1; asave[(2 * i + 1) * NTHREADS] = O1[i] * i1; } }
            }
            const float i2 = lam / xhalf_sum(L);
            float ss = 0.f;
            f32x16 A0, A1;
#pragma unroll
            for (int i = 0; i < 16; ++i) { A0[i] = asave[(2 * i) * NTHREADS] - O0[i] * i2; A1[i] = asave[(2 * i + 1) * NTHREADS] - O1[i] * i2; ss += A0[i] * A0[i] + A1[i] * A1[i]; }
            ss = xhalf_sum(ss);
            const float rs = one_m_li / sqrtf(ss * (1.f / 64.f) + NORM_EPS);
            const float* sg = p->diff_subln + l * 64;
#pragma unroll
            for (int i = 0; i < 16; ++i) { const int dv = (i & 3) + 8 * (i >> 2) + 4 * hi; A0[i] *= rs * sg[dv]; A1[i] *= rs * sg[32 + dv]; }
            store_o(orowD + 768 + 64 * hD, A0, A1, hi);
        } else if (type == 1) {
            flash_pass<96, 0>(lds, qb + tok0 * 384 + 96 * hd, 384, kb + tok0 * 384 + 96 * hd, 384, vb + tok0 * 256 + 64 * hd, 256, nullptr, q0, q0 / 64, SEQ / 64 - q0 / 64, 0, SEQ / 64, 0.f, O0, O1, M, L);
            const float il = 1.f / xhalf_sum(L);
#pragma unroll
            for (int i = 0; i < 16; ++i) { O0[i] *= il; O1[i] *= il; }
            store_o(orow + 256 + 64 * hd, O0, O1, hi);
        } else if (type == 2) {
            const bf16_t* base = proj + tok0 * NPROJ + PC; const int hk = hd >> 1;
            flash_pass<64, 0>(lds, base + 64 * hd, NPROJ, base + 256 + 64 * hk, NPROJ, base + 384 + 64 * hk, NPROJ, nullptr, q0, q0 / 64, SEQ / 64 - q0 / 64, 0, SEQ / 64, 0.f, O0, O1, M, L);
            const float il = 1.f / xhalf_sum(L);
#pragma unroll
            for (int i = 0; i < 16; ++i) { O0[i] *= il; O1[i] *= il; }
            store_o(orow + 512 + 64 * hd, O0, O1, hi);
        } else {
            const bf16_t* base = proj + tok0 * NPROJ + PA; const int hk = hd >> 1;
            const float slope = __builtin_amdgcn_exp2f(-(float)(1 + hd));
            const int kt0 = (q0 >= 128) ? (q0 - 128) / 64 : 0; int kt1 = (q0 + 256 + 128) / 64; if (kt1 > SEQ / 64) kt1 = SEQ / 64;
            flash_pass<64, 2>(lds, base + 64 * hd, NPROJ, base + 256 + 64 * hk, NPROJ, base + 384 + 64 * hk, NPROJ, nullptr, q0, kt0, kt1 - kt0, 0, kt1 - kt0, slope, O0, O1, M, L);
            const float sink = p->win_sink[l * 4 + hd];
            const float il = 1.f / (xhalf_sum(L) + __builtin_amdgcn_exp2f((sink - M) * LOG2E));
#pragma unroll
            for (int i = 0; i < 16; ++i) { O0[i] *= il; O1[i] *= il; }
            store_o(orow + 64 * hd, O0, O1, hi);
        }
    }
}
}

#define GRID_SYNC() do { asm volatile("s_waitcnt vmcnt(0) lgkmcnt(0)" ::: "memory"); grid.sync(); __builtin_amdgcn_fence(__ATOMIC_ACQUIRE, "agent"); } while (0)
#ifndef PH_MASK
#define PH_MASK 255
#endif
__global__ void __launch_bounds__(NTHREADS, 2) mega_fwd(Params p_by_value) {
    extern __shared__ __attribute__((aligned(16))) unsigned char lds_raw[];
    cg::grid_group grid = cg::this_grid();
    LAS unsigned char* lds = (LAS unsigned char*)lds_raw;
#define VCU(G_, bx_) (((G_) % 8 == 0) ? ((bx_) % 8) * ((G_) / 8) + (bx_) / 8 : (bx_))
    const float alpha = 1.681792830507429f;
#define STATS(s_) ((float*)(p->ws + WS_STATS) + (size_t)(s_) * T * 2)
#define C1(l_, off_) ((const float*)(p->ws + WS_C12) + (l_) * C12_L + (off_))
#define C2(l_, off_) ((const float*)(p->ws + WS_C12) + C2_OFF + (l_) * C12_L + (off_))

    if (PH_MASK & 1) { GETP(p); const int G = gridDim.x, bx = blockIdx.x; phase0(p, lds, VCU(G, bx), G); }
    GRID_SYNC();
#pragma unroll 1
    for (int li = 0; li < DEPTH; ++li) {
#pragma unroll 1
        for (int fi = 0; fi < 2; ++fi) {
            if (fi == 1) {
                if (PH_MASK & 2) { GETP(p); int l = li; asm volatile("" : "+s"(l)); const int G = gridDim.x, bx = blockIdx.x;
                  pg8::Gemm g{(const bf16_t*)(p->ws + WS_XB), (const bf16_t*)(p->ws + WS_WIN) + l * WIN_L, T, NPROJ, DM}; pg8::StaticOrder S; S.init(T, NPROJ, G, bx);
                  pg8::EpiStoreBf16LN E{(bf16_t*)(p->ws + WS_PROJ), NPROJ, STATS(3 * l), C1(l, 2 * NGU), C2(l, 2 * NGU)};
                  pg8::gemm_phase<pg8::EpiStoreBf16LN, pg8::StaticOrder, true, true>(lds, g, S, E); }
                GRID_SYNC();
                if (PH_MASK & 4) { GETP(p); int l = li; asm volatile("" : "+s"(l)); const int G = gridDim.x, bx = blockIdx.x; prep_phase(p, l, VCU(G, bx), G); }
                GRID_SYNC();
                if (PH_MASK & 8) { GETP(p); int l = li; asm volatile("" : "+s"(l)); const int G = gridDim.x, bx = blockIdx.x; att::attn_phase(p, l, (LAS char*)lds, VCU(G, bx), G); }
                GRID_SYNC();
                if (PH_MASK & 16) { GETP(p); int l = li; asm volatile("" : "+s"(l)); const int G = gridDim.x, bx = blockIdx.x;
                  pg8::Gemm g{(const bf16_t*)(p->ws + WS_MIX), (const bf16_t*)(p->ws + WS_WOUT) + l * WOUT_L, T, DM, DM}; pg8::StaticOrder S; S.init(T, DM, G, bx);
                  pg8::EpiResidLN<true> E{nullptr, p->out, p->ws, p->ln_g + (3 * l) * DM, p->ln_b + (3 * l) * DM, 3 * l, alpha, 1.0f};
                  pg8::gemm_phase<pg8::EpiResidLN<true>, pg8::StaticOrder, true, true>(lds, g, S, E); }
                GRID_SYNC();
            }
            if (PH_MASK & 64) { GETP(p); int l = li, f = fi; asm volatile("" : "+s"(l), "+s"(f)); const int G = gridDim.x, bx = blockIdx.x;
              const int s = 3 * l + 2 * f - 1;
              pg8::Gemm g{(const bf16_t*)(p->ws + WS_XB), (const bf16_t*)(p->ws + WS_WGU) + l * WGU_L + f * WGU_F, T, NGU, DM}; pg8::StaticOrder S; S.init(T, NGU, G, bx);
              if (s >= 0) { pg8::EpiSwiGLULN<true> E{(bf16_t*)(p->ws + WS_H), DFF, STATS(s), C1(l, f * NGU), C2(l, f * NGU)};
                            pg8::gemm_phase<pg8::EpiSwiGLULN<true>, pg8::StaticOrder, true, true>(lds, g, S, E); }
              else { pg8::EpiSwiGLULN<false> E{(bf16_t*)(p->ws + WS_H), DFF, nullptr, C1(l, f * NGU), C2(l, f * NGU)};
                     pg8::gemm_phase<pg8::EpiSwiGLULN<false>, pg8::StaticOrder, true, true>(lds, g, S, E); } }
            GRID_SYNC();
            if (PH_MASK & 128) { GETP(p); int l = li, f = fi; asm volatile("" : "+s"(l), "+s"(f)); const int G = gridDim.x, bx = blockIdx.x;
              const int s = 3 * l + 2 * f - 1;
              pg8::Gemm g{(const bf16_t*)(p->ws + WS_H), (const bf16_t*)(p->ws + WS_WD) + l * WD_L + f * WD_F, T, DM, DFF}; pg8::StaticOrder S; S.init(T, DM, G, bx);
              if (s >= 0) { pg8::EpiResidLN<true> E{nullptr, p->out, p->ws, p->ln_g + s * DM, p->ln_b + s * DM, s, alpha, 0.5f};
                            pg8::gemm_phase<pg8::EpiResidLN<true>, pg8::StaticOrder, true, true>(lds, g, S, E); }
              else { pg8::EpiResidLN<false> E{p->x, p->out, p->ws, nullptr, nullptr, -1, alpha, 0.5f};
                     pg8::gemm_phase<pg8::EpiResidLN<false>, pg8::StaticOrder, true, true>(lds, g, S, E); } }
            GRID_SYNC();
        }
    }
    if (PH_MASK & 32) { GETP(p); const int G = gridDim.x, bx = blockIdx.x;
      ln_phase(p->out, (bf16_t*)(p->ws + WS_XB), p->ln_g + (3 * DEPTH - 1) * DM, p->ln_b + (3 * DEPTH - 1) * DM, VCU(G, bx), G); }
}

extern "C" void kernel_launch(void* const* d_in, const int* in_sizes, int n_in, void* d_out, int out_size, void* d_ws, size_t ws_size, hipStream_t stream) {
    static int grid = 0;
    if (grid == 0) {
        if (n_in != 16 || in_sizes[0] != T * DM || out_size != T * DM || ws_size < WS_END) { fprintf(stderr, "kernel_launch: unexpected shapes (n_in %d, in0 %d, out %d, ws %zu); nothing launched\n", n_in, n_in > 0 ? in_sizes[0] : -1, out_size, ws_size); grid = -1; return; }
        int dev = 0, cus = 0, per_cu = 0;
        hipGetDevice(&dev); hipDeviceGetAttribute(&cus, hipDeviceAttributeMultiprocessorCount, dev);
        if (hipFuncSetAttribute((const void*)mega_fwd, hipFuncAttributeMaxDynamicSharedMemorySize, LDS_BYTES) != hipSuccess) { fprintf(stderr, "kernel_launch: hipFuncSetAttribute failed\n"); grid = -1; return; }
        if (hipOccupancyMaxActiveBlocksPerMultiprocessor(&per_cu, (const void*)mega_fwd, NTHREADS, LDS_BYTES) != hipSuccess || per_cu < 1) { fprintf(stderr, "kernel_launch: occupancy query gave %d\n", per_cu); per_cu = 1; }
        (void)hipGetLastError();
        grid = cus * 1;
    }
    if (grid < 0) return;
    Params p{};
    p.x = (const float*)d_in[0]; p.w_in = (const float*)d_in[1]; p.win_sink = (const float*)d_in[2]; p.mla_q_norm = (const float*)d_in[3]; p.mla_w_uq = (const float*)d_in[4];
    p.mla_kv_norm = (const float*)d_in[5]; p.mla_w_ukv = (const float*)d_in[6]; p.ax_q_norm = (const float*)d_in[7]; p.ax_k_norm = (const float*)d_in[8]; p.diff_lambda = (const float*)d_in[9];
    p.diff_subln = (const float*)d_in[10]; p.w_out = (const float*)d_in[11]; p.ffn_w_gu = (const float*)d_in[12]; p.ffn_w_down = (const float*)d_in[13]; p.ln_g = (const float*)d_in[14]; p.ln_b = (const float*)d_in[15];
    p.out = (float*)d_out; p.ws = (unsigned char*)d_ws;
    for (int l = 0; l < 4; ++l) p.lam_init[l] = (float)(0.8 - 0.6 * exp(-0.3 * (double)l));
    for (int i = 0; i < 16; ++i) p.inv32[i] = (float)pow(10000.0, -(double)i / 16.0);
    if (hipMemsetAsync((char*)d_ws + WS_CTL, 0, CTL_BYTES, stream) != hipSuccess) { fprintf(stderr, "kernel_launch: hipMemsetAsync of the control region failed\n"); return; }
    void* args[] = {&p};
    hipError_t e = hipLaunchCooperativeKernel((const void*)mega_fwd, dim3(grid), dim3(NTHREADS), args, LDS_BYTES, stream);
    if (e != hipSuccess) fprintf(stderr, "kernel_launch: cooperative launch failed: %s (grid %d)\n", hipGetErrorString(e), grid);
}
```

```cpp
#include <hip/hip_runtime.h>
#include <hip/hip_cooperative_groups.h>
#include <cstdio>
#include <cstdint>
#include <cmath>
namespace cg = cooperative_groups;
namespace pg8 {
#define PG8_LAS __attribute__((address_space(3)))
typedef unsigned short bf16_t;
typedef short bf16x8 __attribute__((ext_vector_type(8)));
typedef float f32x4 __attribute__((ext_vector_type(4)));
typedef unsigned u32x4 __attribute__((ext_vector_type(4)));
constexpr int BM = 256, BK = 64, HALF = 128, HTB = HALF * BK * 2  , STAGE_BYTES = 8 * HTB, NXCD = 8, WGM = 8;

__host__ __device__ __forceinline__ int lds_byte(int r, int c) { const int st = (r >> 4) * 2 + (c >> 5), rr = r & 15, cc = c & 31, ob = rr * 64 + cc * 2; return st * 1024 + (ob ^ (((ob >> 9) & 1) << 5)); }
__host__ __device__ __forceinline__ void stage_rc(int b, int& R, int& C) { const int st = b / 1024, sb = b % 1024, swz = sb ^ (((sb >> 9) & 1) << 5); R = (st >> 1) * 16 + swz / 64; C = (st & 1) * 32 + (swz % 64) / 2; }
__host__ __device__ __forceinline__ int perm32(int rho) { const int n = rho >> 4, i = rho & 15; return 8 * (i >> 2) + 4 * n + (i & 3); }

struct Unit { int pm, pn; };
struct Gemm { const bf16_t* A; const bf16_t* Bt; int M, N, K; };

struct StaticOrder {
    int nM, nN, nwg, G, c;
    __host__ __device__ void init(int M, int N, int G_, int c_) { nM = M / BM; nN = N / BM; nwg = nM * nN; G = G_; c = c_; }
    __host__ __device__ bool next(int i, Unit& u) const {
        const long L = (long)i * G + c; if (L >= nwg) return false;
        int wgid = (int)L; { const int q = nwg / NXCD, r = nwg % NXCD, xcd = wgid % NXCD, off = wgid / NXCD; wgid = (xcd < r ? xcd * (q + 1) : r * (q + 1) + (xcd - r) * q) + off; }
        const int nig = WGM * nN, gid = wgid / nig, fm = gid * WGM, gsz = (nM - fm) < WGM ? (nM - fm) : WGM;
        u.pm = fm + ((wgid % nig) % gsz); u.pn = (wgid % nig) / gsz; return true;
    }
    __device__ __forceinline__ void a_ready(const Unit&) const {}
    __device__ __forceinline__ void done(const Unit&) const {}
};

__device__ __forceinline__ unsigned cvt_pk_bf16(float lo, float hi) { unsigned r; asm volatile("v_cvt_pk_bf16_f32 %0, %1, %2" : "=v"(r) : "v"(lo), "v"(hi)); return r; }
typedef float f32x2 __attribute__((ext_vector_type(2)));
typedef float f32x2 __attribute__((ext_vector_type(2)));
typedef unsigned u32x2 __attribute__((ext_vector_type(2)));

struct EpiStoreBf16 {
    static constexpr bool PERM = true, AFTER_DRAIN = false;
    bf16_t* O; int ldc;
    __device__ __forceinline__ void operator()(const f32x4 (&acc)[2][2][4][2], const Unit& u, int wr, int wc, int fr, int fq) const {
        const int row0 = u.pm * BM + wr * 64 + fr; const int col0 = u.pn * BM + wc * 32 + 8 * fq;
#pragma unroll
        for (int ai = 0; ai < 2; ++ai)
#pragma unroll
            for (int m = 0; m < 4; ++m) { bf16_t* rowp = O + (size_t)(row0 + ai * HALF + m * 16) * ldc + col0;
#pragma unroll
                for (int bj = 0; bj < 2; ++bj) { const f32x4 v0 = acc[ai][bj][m][0], v1 = acc[ai][bj][m][1];
                    u32x4 w; w.x = cvt_pk_bf16(v0[0], v0[1]); w.y = cvt_pk_bf16(v0[2], v0[3]); w.z = cvt_pk_bf16(v1[0], v1[1]); w.w = cvt_pk_bf16(v1[2], v1[3]);
                    *(u32x4*)(rowp + bj * HALF) = w; } }
    }
};

__device__ __forceinline__ float silu_mul(float g, float u) {
    const float e = __builtin_amdgcn_exp2f(-1.4426950408889634f * g);
    return g * u * __builtin_amdgcn_rcpf(1.0f + e);
}
struct EpiSwiGLU {
    static constexpr bool PERM = true, AFTER_DRAIN = false;
    bf16_t* H; int ldh;
    __device__ __forceinline__ void operator()(const f32x4 (&acc)[2][2][4][2], const Unit& u, int wr, int wc, int fr, int fq) const {
        const int row0 = u.pm * BM + wr * 64 + fr; const int col0 = u.pn * HALF + wc * 32 + 8 * fq;
#pragma unroll
        for (int ai = 0; ai < 2; ++ai)
#pragma unroll
            for (int m = 0; m < 4; ++m) { bf16_t* rowp = H + (size_t)(row0 + ai * HALF + m * 16) * ldh + col0;
                const f32x4 g0 = acc[ai][0][m][0], g1 = acc[ai][0][m][1], u0 = acc[ai][1][m][0], u1 = acc[ai][1][m][1];
                u32x4 w;
                w.x = cvt_pk_bf16(silu_mul(g0[0], u0[0]), silu_mul(g0[1], u0[1])); w.y = cvt_pk_bf16(silu_mul(g0[2], u0[2]), silu_mul(g0[3], u0[3]));
                w.z = cvt_pk_bf16(silu_mul(g1[0], u1[0]), silu_mul(g1[1], u1[1])); w.w = cvt_pk_bf16(silu_mul(g1[2], u1[2]), silu_mul(g1[3], u1[3]));
                *(u32x4*)rowp = w; }
    }
};

struct EpiResid {
    static constexpr bool PERM = false, AFTER_DRAIN = false;
    const float* src; float* dst; int ld; float alpha, beta;
    __device__ __forceinline__ void operator()(const f32x4 (&acc)[2][2][4][2], const Unit& u, int wr, int wc, int fr, int fq) const {
        const int col0 = u.pn * BM + wc * 32 + 4 * fq;
#pragma unroll
        for (int ai = 0; ai < 2; ++ai)
#pragma unroll
            for (int m = 0; m < 4; ++m) { const size_t off = (size_t)(u.pm * BM + ai * HALF + wr * 64 + m * 16 + fr) * ld + col0;
#pragma unroll
                for (int bj = 0; bj < 2; ++bj)
#pragma unroll
                    for (int n = 0; n < 2; ++n) { const f32x4 s = *(const f32x4*)(src + off + bj * HALF + n * 16);
                        *(f32x4*)(dst + off + bj * HALF + n * 16) = s * alpha + acc[ai][bj][m][n] * beta; } }
    }
};

constexpr float LN_EPS_F = 1e-5f;
template <bool HAS> __device__ __forceinline__ void ln_row_stats(const float* st, int row, float& mu, float& rs) {
    if (!HAS) { mu = 0.f; rs = 1.f; return; }
    const f32x2 s = *(const f32x2*)(st + 2 * (size_t)row);
    mu = s.x * (1.0f / 1024.0f); const float var = fmaxf(s.y * (1.0f / 1024.0f) - mu * mu, 0.f); rs = 1.0f / sqrtf(var + LN_EPS_F);
}
struct EpiStoreBf16LN {
    static constexpr bool PERM = true, AFTER_DRAIN = false;
    bf16_t* O; int ldc; const float* st; const float* c1; const float* c2;
    __device__ __forceinline__ void operator()(const f32x4 (&acc)[2][2][4][2], const Unit& u, int wr, int wc, int fr, int fq) const {
        int row0 = u.pm * BM + wr * 64 + fr; int col0 = u.pn * BM + wc * 32 + 8 * fq;
        asm volatile("" : "+v"(row0), "+v"(col0));
        f32x4 c1v[2][2], c2v[2][2];
#pragma unroll
        for (int bj = 0; bj < 2; ++bj)
#pragma unroll
            for (int n = 0; n < 2; ++n) { c1v[bj][n] = *(const f32x4*)(c1 + col0 + bj * HALF + 4 * n); c2v[bj][n] = *(const f32x4*)(c2 + col0 + bj * HALF + 4 * n); }
#pragma unroll
        for (int ai = 0; ai < 2; ++ai)
#pragma unroll
            for (int m = 0; m < 4; ++m) { const int row = row0 + ai * HALF + m * 16; float mu, rs; ln_row_stats<true>(st, row, mu, rs);
                bf16_t* rowp = O + (size_t)row * ldc + col0;
#pragma unroll
                for (int bj = 0; bj < 2; ++bj) { const f32x4 v0 = (acc[ai][bj][m][0] - c1v[bj][0] * mu) * rs + c2v[bj][0], v1 = (acc[ai][bj][m][1] - c1v[bj][1] * mu) * rs + c2v[bj][1];
                    u32x4 w; w.x = cvt_pk_bf16(v0[0], v0[1]); w.y = cvt_pk_bf16(v0[2], v0[3]); w.z = cvt_pk_bf16(v1[0], v1[1]); w.w = cvt_pk_bf16(v1[2], v1[3]);
                    *(u32x4*)(rowp + bj * HALF) = w; } }
    }
};
template <bool HAS_LN> struct EpiSwiGLULN {
    static constexpr bool PERM = true, AFTER_DRAIN = false;
    bf16_t* H; int ldh; const float* st; const float* c1; const float* c2;
    __device__ __forceinline__ void operator()(const f32x4 (&acc)[2][2][4][2], const Unit& u, int wr, int wc, int fr, int fq) const {
        int row0 = u.pm * BM + wr * 64 + fr; const int col0 = u.pn * HALF + wc * 32 + 8 * fq; int wcol0 = u.pn * BM + wc * 32 + 8 * fq;
        asm volatile("" : "+v"(row0), "+v"(wcol0));
        f32x4 c1v[2][2], c2v[2][2];
#pragma unroll
        for (int bj = 0; bj < 2; ++bj)
#pragma unroll
            for (int n = 0; n < 2; ++n) { c1v[bj][n] = *(const f32x4*)(c1 + wcol0 + bj * HALF + 4 * n); c2v[bj][n] = *(const f32x4*)(c2 + wcol0 + bj * HALF + 4 * n); }
#pragma unroll
        for (int ai = 0; ai < 2; ++ai)
#pragma unroll
            for (int m = 0; m < 4; ++m) { const int row = row0 + ai * HALF + m * 16; float mu, rs; ln_row_stats<HAS_LN>(st, row, mu, rs);
                bf16_t* rowp = H + (size_t)row * ldh + col0;
                const f32x4 g0 = (acc[ai][0][m][0] - c1v[0][0] * mu) * rs + c2v[0][0], g1 = (acc[ai][0][m][1] - c1v[0][1] * mu) * rs + c2v[0][1];
                const f32x4 u0 = (acc[ai][1][m][0] - c1v[1][0] * mu) * rs + c2v[1][0], u1 = (acc[ai][1][m][1] - c1v[1][1] * mu) * rs + c2v[1][1];
                u32x4 w;
                w.x = cvt_pk_bf16(silu_mul(g0[0], u0[0]), silu_mul(g0[1], u0[1])); w.y = cvt_pk_bf16(silu_mul(g0[2], u0[2]), silu_mul(g0[3], u0[3]));
                w.z = cvt_pk_bf16(silu_mul(g1[0], u1[0]), silu_mul(g1[1], u1[1])); w.w = cvt_pk_bf16(silu_mul(g1[2], u1[2]), silu_mul(g1[3], u1[3]));
                *(u32x4*)rowp = w; }
    }
};
constexpr size_t EPI_WS_XB = (size_t)166 << 20, EPI_WS_STATS = ((size_t)568 << 20) + ((size_t)1 << 20); constexpr int EPI_T = 32768;
template <bool HAS_LN> struct EpiResidLN {
    static constexpr bool PERM = false, AFTER_DRAIN = false;
    static constexpr int ld = 1024;
    const float* src; float* dst; unsigned char* ws; const float* g_in; const float* b_in; int s_in; float alpha, beta;
    __device__ __forceinline__ void operator()(const f32x4 (&acc)[2][2][4][2], const Unit& u, int wr, int wc, int fr, int fq) const {
        int col0 = u.pn * BM + wc * 32 + 4 * fq; int rowb = u.pm * BM + wr * 64 + fr;
        asm volatile("" : "+v"(col0), "+v"(rowb));
        const float* rd = HAS_LN ? (const float*)dst : src;
        bf16_t* yb = (bf16_t*)(ws + EPI_WS_XB);
        const float* st_in = (const float*)(ws + EPI_WS_STATS) + (size_t)s_in * EPI_T * 2; float* st_out = (float*)(ws + EPI_WS_STATS) + (size_t)(s_in + 1) * EPI_T * 2;
        f32x4 gv[2][2], bv[2][2];
#pragma unroll
        for (int bj = 0; bj < 2; ++bj)
#pragma unroll
            for (int n = 0; n < 2; ++n) { if (HAS_LN) { gv[bj][n] = *(const f32x4*)(g_in + col0 + bj * HALF + n * 16); bv[bj][n] = *(const f32x4*)(b_in + col0 + bj * HALF + n * 16); }
                                          else { gv[bj][n] = (f32x4){1.f, 1.f, 1.f, 1.f}; bv[bj][n] = (f32x4){0.f, 0.f, 0.f, 0.f}; } }
#pragma unroll
        for (int ai = 0; ai < 2; ++ai)
#pragma unroll
            for (int m = 0; m < 4; ++m) { const int row = rowb + ai * HALF + m * 16; const size_t off = (size_t)row * ld + col0;
                float mu, rs; ln_row_stats<HAS_LN>(st_in, row, mu, rs);
                float ps = 0.f, pq = 0.f;
#pragma unroll
                for (int bj = 0; bj < 2; ++bj)
#pragma unroll
                    for (int n = 0; n < 2; ++n) { const f32x4 y = *(const f32x4*)(rd + off + bj * HALF + n * 16);
                        const f32x4 x = HAS_LN ? (y - mu) * rs * gv[bj][n] + bv[bj][n] : y;
                        const f32x4 yn = x * alpha + acc[ai][bj][m][n] * beta;
                        *(f32x4*)(dst + off + bj * HALF + n * 16) = yn;
                        u32x2 w; w.x = cvt_pk_bf16(yn[0], yn[1]); w.y = cvt_pk_bf16(yn[2], yn[3]); *(u32x2*)(yb + off + bj * HALF + n * 16) = w;
                        ps += (yn[0] + yn[1]) + (yn[2] + yn[3]); pq += (yn[0] * yn[0] + yn[1] * yn[1]) + (yn[2] * yn[2] + yn[3] * yn[3]); }
                ps += __shfl_xor(ps, 16); ps += __shfl_xor(ps, 32); pq += __shfl_xor(pq, 16); pq += __shfl_xor(pq, 32);
                if (fq == 0) { atomicAdd(st_out + 2 * (size_t)row, ps); atomicAdd(st_out + 2 * (size_t)row + 1, pq); } }
    }
};
template <class Epi, class Sched, bool ALIGN_EPI = false, bool SP2 = false>
__device__ __forceinline__ void gemm_phase(PG8_LAS unsigned char* lds, const Gemm g, const Sched S, const Epi E) {
    int tid_ = threadIdx.x; asm volatile("" : "+v"(tid_));
    const int tid = tid_, wid = __builtin_amdgcn_readfirstlane(tid >> 6), lane = tid & 63, wr = wid >> 2, wc = wid & 3, fr = lane & 15, fq = lane >> 4;
    const int K = g.K, nt = K / BK;
    unsigned voffA[2], voffB[2];
#pragma unroll
    for (int i = 0; i < 2; ++i) { int R, C; stage_rc(tid * 16 + i * 8192, R, C); const int Rb = Epi::PERM ? ((R & ~31) + perm32(R & 31)) : R;
        voffA[i] = (unsigned)(R * K + C) * 2u; voffB[i] = (unsigned)(Rb * K + C) * 2u; }
    const size_t kstep = (size_t)(BK * 2);
    const size_t hstep = (size_t)HALF * K * 2;
    const size_t tstep = 2 * hstep;
    const unsigned ldsw = (unsigned)wid * 1024u;
    const int aoff = lds_byte(wr * 64 + fr, fq * 8), boff = lds_byte(wc * 32 + fr, fq * 8);
#define PG8_SA(b, h) (((b) * 2 + (h)) * HTB)
#define PG8_SB(b, h) ((4 + (b) * 2 + (h)) * HTB)
#define PG8_STAGE(bufoff, gbase, voff) do { _Pragma("unroll") for (int _i = 0; _i < 2; ++_i) \
        __builtin_amdgcn_global_load_lds((const unsigned*)((const char*)(gbase) + (voff)[_i]), (PG8_LAS unsigned*)(lds + (bufoff) + ldsw + _i * 8192), 16, 0, 0); } while (0)
#define PG8_LDA(dst, b, h) do { _Pragma("unroll") for (int m = 0; m < 4; ++m) _Pragma("unroll") for (int k = 0; k < 2; ++k) dst[m][k] = *(const PG8_LAS bf16x8*)(lds + PG8_SA(b, h) + aoff + m * 2048 + k * 1024); } while (0)
#define PG8_LDB(dst, b, h) do { _Pragma("unroll") for (int n = 0; n < 2; ++n) _Pragma("unroll") for (int k = 0; k < 2; ++k) dst[n][k] = *(const PG8_LAS bf16x8*)(lds + PG8_SB(b, h) + boff + n * 2048 + k * 1024); } while (0)
#define PG8_MMA(ai, bj, At, Bt) do { __builtin_amdgcn_s_setprio(1); _Pragma("unroll") for (int m = 0; m < 4; ++m) _Pragma("unroll") for (int n = 0; n < 2; ++n) _Pragma("unroll") for (int k = 0; k < 2; ++k) \
        acc[ai][bj][m][n] = __builtin_amdgcn_mfma_f32_16x16x32_bf16(Bt[n][k], At[m][k], acc[ai][bj][m][n], 0, 0, 0); __builtin_amdgcn_s_setprio(0); } while (0)
#define PG8_WAIT_V(n) asm volatile("s_waitcnt vmcnt(" #n ")" ::: "memory")
#define PG8_WAIT_L(n) asm volatile("s_waitcnt lgkmcnt(" #n ")" ::: "memory")
#define PG8_BAR __builtin_amdgcn_s_barrier()
#define PG8_SCHED __builtin_amdgcn_sched_barrier(0)
    Unit cur, nxt; int ui = 0;
    if (!S.next(0, cur)) return;
    f32x4 acc[2][2][4][2];
#pragma unroll
    for (int a = 0; a < 2; ++a)
#pragma unroll
        for (int b = 0; b < 2; ++b)
#pragma unroll
            for (int m = 0; m < 4; ++m)
#pragma unroll
                for (int n = 0; n < 2; ++n) acc[a][b][m][n] = (f32x4){0.f, 0.f, 0.f, 0.f};
    bf16x8 At[4][2], B0[2][2], B1[2][2];
    const char* cA = (const char*)g.A + (size_t)cur.pm * tstep; const char* cB = (const char*)g.Bt + (size_t)cur.pn * tstep;
    S.a_ready(cur);
    if constexpr (SP2) {
        PG8_STAGE(PG8_SB(0, 0), cB, voffB); PG8_STAGE(PG8_SB(0, 1), cB + hstep, voffB); PG8_STAGE(PG8_SA(0, 0), cA, voffA); PG8_STAGE(PG8_SA(0, 1), cA + hstep, voffA);
        if (wr == 1) PG8_BAR;
        PG8_WAIT_V(2); PG8_BAR;
        PG8_STAGE(PG8_SB(1, 0), cB + kstep, voffB); PG8_STAGE(PG8_SA(1, 0), cA + kstep, voffA); PG8_STAGE(PG8_SB(1, 1), cB + hstep + kstep, voffB);
        PG8_WAIT_V(6); PG8_BAR;
    } else {
        PG8_STAGE(PG8_SB(0, 0), cB, voffB); PG8_STAGE(PG8_SA(0, 0), cA, voffA); PG8_STAGE(PG8_SB(0, 1), cB + hstep, voffB); PG8_STAGE(PG8_SA(0, 1), cA + hstep, voffA);
        if (wr == 1) PG8_BAR;
        PG8_WAIT_V(4); PG8_BAR;
        PG8_STAGE(PG8_SB(1, 0), cB + kstep, voffB); PG8_STAGE(PG8_SA(1, 0), cA + kstep, voffA); PG8_STAGE(PG8_SB(1, 1), cB + hstep + kstep, voffB);
        PG8_WAIT_V(6); PG8_BAR;
    }
    for (;;) {
        const bool has_next = S.next(ui + 1, nxt);
        const char* nA = has_next ? (const char*)g.A + (size_t)nxt.pm * tstep : cA; const char* nB = has_next ? (const char*)g.Bt + (size_t)nxt.pn * tstep : cB;
        for (int t = 0; t < nt; t += 2) {
            const bool last = (t == nt - 2);
            const char* a1 = cA + (size_t)(t + 1) * kstep;
            const char* a2 = last ? nA : cA + (size_t)(t + 2) * kstep; const char* b2 = last ? nB : cB + (size_t)(t + 2) * kstep;
            const char* a3 = a2 + kstep; const char* b3 = b2 + kstep;
            if (last && has_next) S.a_ready(nxt);
            if constexpr (SP2) {
            PG8_LDB(B0, 0, 0); PG8_LDB(B1, 0, 1); PG8_SCHED; PG8_LDA(At, 0, 0); PG8_STAGE(PG8_SA(1, 1), a1 + hstep, voffA);
            PG8_WAIT_V(8); PG8_WAIT_L(0); PG8_BAR; PG8_MMA(0, 0, At, B0); PG8_MMA(0, 1, At, B1); PG8_BAR; PG8_SCHED;
            PG8_LDA(At, 0, 1); PG8_STAGE(PG8_SB(0, 0), b2, voffB); PG8_STAGE(PG8_SB(0, 1), b2 + hstep, voffB); PG8_STAGE(PG8_SA(0, 0), a2, voffA);
            PG8_WAIT_V(8); PG8_WAIT_L(0); PG8_BAR; PG8_MMA(1, 0, At, B0); PG8_MMA(1, 1, At, B1); PG8_BAR; PG8_SCHED;
            PG8_LDB(B0, 1, 0); PG8_LDB(B1, 1, 1); PG8_SCHED; PG8_LDA(At, 1, 0); PG8_STAGE(PG8_SA(0, 1), a2 + hstep, voffA);
            PG8_WAIT_V(8); PG8_WAIT_L(0); PG8_BAR; PG8_MMA(0, 0, At, B0); PG8_MMA(0, 1, At, B1); PG8_BAR; PG8_SCHED;
            PG8_LDA(At, 1, 1); PG8_STAGE(PG8_SB(1, 0), b3, voffB); PG8_STAGE(PG8_SB(1, 1), b3 + hstep, voffB); PG8_STAGE(PG8_SA(1, 0), a3, voffA);
            PG8_WAIT_V(8); PG8_WAIT_L(0); PG8_BAR; PG8_MMA(1, 0, At, B0); PG8_MMA(1, 1, At, B1); PG8_BAR; PG8_SCHED;
            } else {
            PG8_LDB(B0, 0, 0); PG8_SCHED; PG8_LDA(At, 0, 0); PG8_STAGE(PG8_SA(1, 1), a1 + hstep, voffA);
            PG8_WAIT_L(8); PG8_BAR; PG8_WAIT_L(0); PG8_MMA(0, 0, At, B0); PG8_BAR; PG8_SCHED;
            PG8_LDB(B1, 0, 1); PG8_STAGE(PG8_SB(0, 0), b2, voffB);
            PG8_BAR; PG8_WAIT_L(0); PG8_MMA(0, 1, At, B1); PG8_BAR;
            PG8_LDA(At, 0, 1); PG8_STAGE(PG8_SA(0, 0), a2, voffA);
            PG8_BAR; PG8_WAIT_L(0); PG8_MMA(1, 0, At, B0); PG8_BAR; PG8_SCHED;
            PG8_STAGE(PG8_SB(0, 1), b2 + hstep, voffB);
            PG8_WAIT_V(6); PG8_BAR; PG8_MMA(1, 1, At, B1); PG8_BAR;
            PG8_LDB(B0, 1, 0); PG8_SCHED; PG8_LDA(At, 1, 0); PG8_STAGE(PG8_SA(0, 1), a2 + hstep, voffA);
            PG8_WAIT_L(8); PG8_BAR; PG8_WAIT_L(0); PG8_MMA(0, 0, At, B0); PG8_BAR; PG8_SCHED;
            PG8_LDB(B1, 1, 1); PG8_STAGE(PG8_SB(1, 0), b3, voffB);
            PG8_BAR; PG8_WAIT_L(0); PG8_MMA(0, 1, At, B1); PG8_BAR;
            PG8_LDA(At, 1, 1); PG8_STAGE(PG8_SA(1, 0), a3, voffA);
            PG8_BAR; PG8_WAIT_L(0); PG8_MMA(1, 0, At, B0); PG8_BAR; PG8_SCHED;
            PG8_STAGE(PG8_SB(1, 1), b3 + hstep, voffB);
            PG8_WAIT_V(6); PG8_BAR; PG8_MMA(1, 1, At, B1); PG8_BAR;
            }
        }
        if constexpr (ALIGN_EPI) { if (wr == 0) PG8_BAR; }
        if constexpr (!Epi::AFTER_DRAIN) { E(acc, cur, wr, wc, fr, fq); S.done(cur); }
        if (!has_next) break;
#pragma unroll
        for (int a = 0; a < 2; ++a)
#pragma unroll
            for (int b = 0; b < 2; ++b)
#pragma unroll
                for (int m = 0; m < 4; ++m)
#pragma unroll
                    for (int n = 0; n < 2; ++n) acc[a][b][m][n] = (f32x4){0.f, 0.f, 0.f, 0.f};
        cur = nxt; cA = nA; cB = nB; ++ui;
        if constexpr (ALIGN_EPI) { if (wr == 1) PG8_BAR; }
    }
    PG8_WAIT_V(0);
    if constexpr (!ALIGN_EPI) { if (wr == 0) PG8_BAR; }
    PG8_BAR;
    if constexpr (Epi::AFTER_DRAIN) { E.fused(acc, cur, wr, wc, fr, fq, lds, wid, lane); S.done(cur); }
#undef PG8_SA
#undef PG8_SB
#undef PG8_STAGE
#undef PG8_LDA
#undef PG8_LDB
#undef PG8_MMA
#undef PG8_WAIT_V
#undef PG8_WAIT_L
#undef PG8_BAR
#undef PG8_SCHED
}
}
#define LAS __attribute__((address_space(3)))
typedef unsigned short bf16_t;
typedef short bf16x8 __attribute__((ext_vector_type(8)));
typedef short s16x4 __attribute__((ext_vector_type(4)));
typedef float f32x4 __attribute__((ext_vector_type(4)));
typedef float f32x16 __attribute__((ext_vector_type(16)));
typedef unsigned u32x4 __attribute__((ext_vector_type(4)));
typedef unsigned u32x2 __attribute__((ext_vector_type(2)));
typedef float f32x2_t __attribute__((ext_vector_type(2)));
typedef __bf16 bf16x2_t __attribute__((ext_vector_type(2)));

constexpr int NB = 2, SEQ = 16384, T = NB * SEQ, DM = 1024, DEPTH = 4, DFF = 2816, NGU = 2 * DFF;
constexpr int NIN_SRC = 2208, NPROJ = 3328;
constexpr int PA = 0, PC = 512, PD = 1024, PCQ = 1792, PCKV = 2048, PKR = 2176, PQUP = 2208, PKVUP = 2592, PEND = 3104;
constexpr float LOG2E = 1.4426950408889634f;
constexpr float NORM_EPS = 1e-5f;
constexpr int NWAVES = 8, NTHREADS = 512;
constexpr int LDS_BYTES = 147456;

constexpr size_t MiB = 1u << 20;
constexpr size_t WS_WGU = 0, WS_WD = 88 * MiB, WS_WIN = 132 * MiB, WS_WOUT = 158 * MiB, WS_XB = 166 * MiB;
constexpr size_t WS_H = 230 * MiB, WS_PROJ = 230 * MiB, WS_QB = 438 * MiB, WS_KB = 462 * MiB, WS_VB = 486 * MiB, WS_MIX = 502 * MiB, WS_AUG = 566 * MiB, WS_CTL = 568 * MiB, WS_KMAX = WS_CTL, WS_C12 = WS_CTL + 4096, WS_STATS = WS_CTL + 1 * MiB, CTL_BYTES = 4 * MiB, WS_END = 572 * MiB;
constexpr int C12_L = 2 * NGU + NPROJ;
constexpr size_t C2_OFF = (size_t)DEPTH * C12_L;
static_assert(pg8::EPI_WS_XB == WS_XB && pg8::EPI_WS_STATS == WS_STATS && pg8::EPI_T == T, "part1's copies of the workspace map");
static_assert(WS_C12 + 2 * C2_OFF * 4 <= WS_STATS && WS_STATS + (size_t)12 * T * 8 <= WS_CTL + CTL_BYTES, "control region");
constexpr size_t WGU_L = (size_t)2 * NGU * DM, WGU_F = (size_t)NGU * DM;
constexpr size_t WD_L = (size_t)2 * DM * DFF, WD_F = (size_t)DM * DFF;
constexpr size_t WIN_L = (size_t)NPROJ * DM, WOUT_L = (size_t)DM * DM;

struct Params {
    const float* x; const float* w_in; const float* win_sink; const float* mla_q_norm; const float* mla_w_uq; const float* mla_kv_norm; const float* mla_w_ukv;
    const float* ax_q_norm; const float* ax_k_norm; const float* diff_lambda; const float* diff_subln; const float* w_out; const float* ffn_w_gu; const float* ffn_w_down;
    const float* ln_g; const float* ln_b;
    float* out; unsigned char* ws;
    float lam_init[4];
    float inv32[16];
};

typedef const __attribute__((address_space(4))) Params* KP;
#define GETP(name) KP name = (KP)__builtin_amdgcn_kernarg_segment_ptr(); asm volatile("" : "+s"(name))

__device__ __forceinline__ int tid_fresh() { int t = threadIdx.x; asm volatile("" : "+v"(t)); return t; }
__device__ __forceinline__ unsigned pkbf(float lo, float hi) { f32x2_t v = {lo, hi}; bf16x2_t b = __builtin_convertvector(v, bf16x2_t); return __builtin_bit_cast(unsigned, b); }
__device__ __forceinline__ float bflo(unsigned w) { return __builtin_bit_cast(float, w << 16); }
__device__ __forceinline__ float bfhi(unsigned w) { return __builtin_bit_cast(float, w & 0xffff0000u); }
__device__ __forceinline__ float wave_sum(float v) {
#pragma unroll
    for (int o = 1; o < 64; o <<= 1) v += __shfl_xor(v, o);
    return v;
}
__device__ __forceinline__ void unpack8(const u32x4 w, float (&v)[8]) {
    v[0] = bflo(w.x); v[1] = bfhi(w.x); v[2] = bflo(w.y); v[3] = bfhi(w.y); v[4] = bflo(w.z); v[5] = bfhi(w.z); v[6] = bflo(w.w); v[7] = bfhi(w.w);
}
__device__ __forceinline__ u32x4 pack8(const float (&v)[8]) { u32x4 w; w.x = pkbf(v[0], v[1]); w.y = pkbf(v[2], v[3]); w.z = pkbf(v[4], v[5]); w.w = pkbf(v[6], v[7]); return w; }

__device__ __forceinline__ void transpose_item(const float* __restrict__ W, int ldw, int src_col0, float scale, bf16_t* __restrict__ WT, int K, int dst_row0, int k0, LAS float* scr, int lane,
                                               const float* __restrict__ lng, const float* __restrict__ lnb, float* c1, float* c2) {
    if (src_col0 < 0) {
        const int c = lane & 7;
#pragma unroll
        for (int j = 0; j < 4; ++j) { const int n = (lane >> 3) + 8 * j; *(u32x4*)(WT + (size_t)(dst_row0 + n) * K + k0 + 8 * c) = (u32x4){0u, 0u, 0u, 0u}; }
        return;
    }
    float a1 = 0.f, a2 = 0.f;
#pragma unroll
    for (int i = 0; i < 32; ++i) { const int kk = 2 * i + (lane >> 5); float w = W[(size_t)(k0 + kk) * ldw + src_col0 + (lane & 31)] * scale;
        if (lng) { a2 = fmaf(lnb[k0 + kk], w, a2); w *= lng[k0 + kk]; a1 += bflo(pkbf(w, 0.f)); }
        scr[kk * 33 + (lane & 31)] = w; }
    asm volatile("s_waitcnt lgkmcnt(0)" ::: "memory");
    const int c = lane & 7;
#pragma unroll
    for (int j = 0; j < 4; ++j) { const int n = (lane >> 3) + 8 * j; const LAS float* s = scr + (8 * c) * 33 + n;
        u32x4 o; o.x = pkbf(s[0 * 33], s[1 * 33]); o.y = pkbf(s[2 * 33], s[3 * 33]); o.z = pkbf(s[4 * 33], s[5 * 33]); o.w = pkbf(s[6 * 33], s[7 * 33]);
        *(u32x4*)(WT + (size_t)(dst_row0 + n) * K + k0 + 8 * c) = o; }
    asm volatile("s_waitcnt lgkmcnt(0)" ::: "memory");
    if (lng) { a1 += __shfl_xor(a1, 32); a2 += __shfl_xor(a2, 32);
        if (lane < 32) { atomicAdd(c1 + dst_row0 + lane, a1); atomicAdd(c2 + dst_row0 + lane, a2); } }
}

__device__ __forceinline__ void phase0(KP p, LAS unsigned char* lds, int vcu, int G) {
    const int tid = tid_fresh(), lane = tid & 63, wave = __builtin_amdgcn_readfirstlane(tid >> 6);
    LAS float* scr = (LAS float*)(lds + wave * 16384);
    const int gw = vcu * NWAVES + wave, NGW = G * NWAVES;
    bf16_t* wgu = (bf16_t*)(p->ws + WS_WGU); bf16_t* wd = (bf16_t*)(p->ws + WS_WD); bf16_t* win = (bf16_t*)(p->ws + WS_WIN); bf16_t* wout = (bf16_t*)(p->ws + WS_WOUT);
    float* c12 = (float*)(p->ws + WS_C12);
    constexpr int I_GU = 176 * 16, I_WD = 32 * 44, I_IN = 104 * 16, I_OUT = 32 * 16, I_CMP = 128 * 14;
    constexpr int I_LAYER = 2 * I_GU + 2 * I_WD + I_IN + I_OUT + I_CMP;
    for (int it = gw; it < DEPTH * I_LAYER; it += NGW) {
        const int l = it / I_LAYER; int r = it % I_LAYER;
        if (r < 2 * I_GU) { const int f = r / I_GU; r %= I_GU; const int nb = r / 16, kb = r % 16; const int n0 = 32 * nb;
            const int pn = n0 >> 8, bj = (n0 >> 7) & 1, i0 = n0 & 127;
            const int s = 3 * l + 2 * f - 1;
            transpose_item(p->ffn_w_gu + ((size_t)l * 2 + f) * DM * NGU, NGU, bj * DFF + 128 * pn + i0, 1.f, wgu + l * WGU_L + f * WGU_F, DM, n0, 64 * kb, scr, lane,
                           s >= 0 ? p->ln_g + s * DM : nullptr, s >= 0 ? p->ln_b + s * DM : nullptr, c12 + l * C12_L + f * NGU, c12 + C2_OFF + l * C12_L + f * NGU); continue; }
        r -= 2 * I_GU;
        if (r < 2 * I_WD) { const int f = r / I_WD; r %= I_WD; const int nb = r / 44, kb = r % 44;
            transpose_item(p->ffn_w_down + ((size_t)l * 2 + f) * DFF * DM, DM, 32 * nb, 1.f, wd + l * WD_L + f * WD_F, DFF, 32 * nb, 64 * kb, scr, lane, nullptr, nullptr, nullptr, nullptr); continue; }
        r -= 2 * I_WD;
        if (r < I_IN) { const int nb = r / 16, kb = r % 16; const int n0 = 32 * nb; int src; float sc = 1.f;
            if (n0 < PC) { src = n0; if (n0 < 256) sc = 0.125f; }
            else if (n0 < PD) src = 928 + (n0 - PC);
            else if (n0 < PCQ) { src = 1440 + (n0 - PD); if (n0 - PD < 256) sc = 0.17677669529663687f; }
            else if (n0 < PCKV) src = 512 + (n0 - PCQ);
            else if (n0 < PKR) src = 768 + (n0 - PCKV);
            else if (n0 < PQUP) src = 896;
            else if (n0 < PEND) continue;
            else src = -1;
            transpose_item(p->w_in + (size_t)l * DM * NIN_SRC, NIN_SRC, src, sc, win + l * WIN_L, DM, n0, 64 * kb, scr, lane,
                           p->ln_g + (3 * l) * DM, p->ln_b + (3 * l) * DM, c12 + l * C12_L + 2 * NGU, c12 + C2_OFF + l * C12_L + 2 * NGU); continue; }
        r -= I_IN;
        if (r < I_OUT) { const int nb = r / 16, kb = r % 16;
            transpose_item(p->w_out + (size_t)l * DM * DM, DM, 32 * nb, 1.f, wout + l * WOUT_L, DM, 32 * nb, 64 * kb, scr, lane, nullptr, nullptr, nullptr, nullptr); continue; }
        r -= I_OUT;
        {
            const int kb8 = r / 14, ng = r % 14; const int k0 = 8 * kb8;
            int J, cA, ldu, nc; const float* g; const float* U;
            if (ng < 6) { J = 256; cA = 512; g = p->mla_q_norm + l * 256; U = p->mla_w_uq + (size_t)l * 256 * 384; ldu = 384; nc = 64 * ng; }
            else { J = 128; cA = 768; g = p->mla_kv_norm + l * 128; U = p->mla_w_ukv + (size_t)l * 128 * 512; ldu = 512; nc = 64 * (ng - 6); }
            const int nglob = (ng < 6 ? 0 : 384) + nc + lane;
            const float* a = p->w_in + (size_t)l * DM * NIN_SRC + (size_t)k0 * NIN_SRC + cA;
            const float* up = U + nc + lane;
            float acc[8];
#pragma unroll
            for (int e = 0; e < 8; ++e) acc[e] = 0.f;
#pragma unroll 4
            for (int j = 0; j < J; ++j) { const float u = up[(size_t)j * ldu] * g[j];
#pragma unroll
                for (int e = 0; e < 8; ++e) acc[e] = fmaf(a[(size_t)e * NIN_SRC + j], u, acc[e]); }
            const float* lg = p->ln_g + (3 * l) * DM + k0; const float* lb = p->ln_b + (3 * l) * DM + k0;
            float s1 = 0.f, s2 = 0.f; unsigned wb[8];
#pragma unroll
            for (int e = 0; e < 8; ++e) { wb[e] = pkbf(acc[e] * lg[e], 0.f) & 0xffffu; s1 += bflo(wb[e]); s2 = fmaf(acc[e], lb[e], s2); }
            u32x4 o; o.x = wb[0] | (wb[1] << 16); o.y = wb[2] | (wb[3] << 16); o.z = wb[4] | (wb[5] << 16); o.w = wb[6] | (wb[7] << 16);
            *(u32x4*)(win + l * WIN_L + (size_t)(PQUP + nglob) * DM + k0) = o;
            atomicAdd(c12 + l * C12_L + 2 * NGU + PQUP + nglob, s1); atomicAdd(c12 + C2_OFF + l * C12_L + 2 * NGU + PQUP + nglob, s2);
        }
    }
    { u32x4* ag = (u32x4*)(p->ws + WS_AUG);
      for (int i = (vcu * NWAVES + wave) * 64 + lane; i < SEQ * 4; i += G * NWAVES * 64) { const int t = i >> 2, h = i & 3;
          const float sl = __builtin_amdgcn_exp2f(-(float)(5 + h));
          u32x4 w = {pkbf(sl * (float)(128 * (t >> 7)), sl * (float)(t & 127)), 0u, 0u, 0u}; ag[2 * i] = w; ag[2 * i + 1] = (u32x4){0u, 0u, 0u, 0u}; } }
    bf16_t* xb = (bf16_t*)(p->ws + WS_XB);
    for (int m = gw; m < T; m += NGW) {
        const f32x4* xr = (const f32x4*)(p->x + (size_t)m * DM) + lane; u32x2* o8 = (u32x2*)(xb + (size_t)m * DM) + lane;
#pragma unroll
        for (int j = 0; j < 4; ++j) { const f32x4 v = xr[64 * j]; u32x2 w; w.x = pkbf(v.x, v.y); w.y = pkbf(v.z, v.w); o8[64 * j] = w; }
    }
}

__device__ __forceinline__ void ln_phase(float* X, bf16_t* xb, const float* __restrict__ g, const float* __restrict__ b, int vcu, int G) {
    const int tid = tid_fresh(), lane = tid & 63, wave = __builtin_amdgcn_readfirstlane(tid >> 6);
    const int gw = vcu * NWAVES + wave, NGW = G * NWAVES;
    f32x4 gv[4], bv[4];
#pragma unroll
    for (int j = 0; j < 4; ++j) { gv[j] = ((const f32x4*)g)[64 * j + lane]; bv[j] = ((const f32x4*)b)[64 * j + lane]; }
    for (int m = gw; m < T; m += NGW) {
        f32x4* xr = (f32x4*)(X + (size_t)m * DM) + lane; u32x2* o8 = (u32x2*)(xb + (size_t)m * DM) + lane;
        f32x4 v[4]; float s = 0.f;
#pragma unroll
        for (int j = 0; j < 4; ++j) { v[j] = xr[64 * j]; s += (v[j].x + v[j].y) + (v[j].z + v[j].w); }
        const float mean = wave_sum(s) * (1.f / DM); float s2 = 0.f;
#pragma unroll
        for (int j = 0; j < 4; ++j) { v[j] = v[j] - mean; s2 += (v[j].x * v[j].x + v[j].y * v[j].y) + (v[j].z * v[j].z + v[j].w * v[j].w); }
        const float rstd = 1.f / sqrtf(wave_sum(s2) * (1.f / DM) + NORM_EPS);
#pragma unroll
        for (int j = 0; j < 4; ++j) { const f32x4 y = v[j] * rstd * gv[j] + bv[j]; xr[64 * j] = y; u32x2 w; w.x = pkbf(y.x, y.y); w.y = pkbf(y.z, y.w); o8[64 * j] = w; }
    }
}

__device__ __forceinline__ void sincos_rev(float ang, float& s, float& c) {
    double d = (double)ang * 0.15915494309189535; d -= __builtin_rint(d); const float f = (float)d;
    s = __builtin_amdgcn_sinf(f); c = __builtin_amdgcn_cosf(f);
}
__device__ __forceinline__ void rope8(float (&v)[8], bool first, float pos, int i0, KP p) {
#pragma unroll
    for (int e = 0; e < 8; ++e) {
        const float other = __shfl_xor(v[e], 2);
        const float inv = i0 ? p->inv32[8 + e] : p->inv32[e];
        float s, c; sincos_rev(pos * inv, s, c);
        v[e] = first ? (v[e] * c - other * s) : (other * s + v[e] * c);
    }
}
__device__ __forceinline__ void prep_phase(KP p, int l, int vcu, int G) {
    const int tid = tid_fresh(), lane = tid & 63, wave = __builtin_amdgcn_readfirstlane(tid >> 6);
    const int gw = vcu * NWAVES + wave, NGW = G * NWAVES;
    bf16_t* proj = (bf16_t*)(p->ws + WS_PROJ); bf16_t* qb = (bf16_t*)(p->ws + WS_QB); bf16_t* kb = (bf16_t*)(p->ws + WS_KB); bf16_t* vb = (bf16_t*)(p->ws + WS_VB);
    float cg[8];
    { const float* gsrc = (lane < 32 ? p->ax_q_norm : p->ax_k_norm) + l * 64 + 8 * (lane & 7);
#pragma unroll
      for (int e = 0; e < 8; ++e) cg[e] = gsrc[e]; }
    float km0 = 0.f, km1 = 0.f;
    for (int tok = gw; tok < T; tok += NGW) {
        const int t = tok & (SEQ - 1);
        bf16_t* pr = proj + (size_t)tok * NPROJ;
        const int l48 = lane < 48 ? lane : 0, l32 = lane < 32 ? lane : 0, l4 = lane < 4 ? lane : 0;
        const u32x4 in_cq = *(const u32x4*)(pr + PCQ + 8 * l48), in_qup = *(const u32x4*)(pr + PQUP + 8 * l48), in_kv = *(const u32x4*)(pr + PKVUP + 8 * lane);
        const u32x4 in_kr = *(const u32x4*)(pr + PKR + 8 * l4), in_c = *(const u32x4*)(pr + PC + 8 * l48), in_dk = *(const u32x4*)(pr + PD + 256 + 8 * l32);
        { float s = 0.f;
          if (lane < 32) { float v[8]; unpack8(in_dk, v);
#pragma unroll
              for (int e = 0; e < 8; ++e) s += v[e] * v[e]; }
          s += __shfl_xor(s, 1); s += __shfl_xor(s, 2);
          if (tok < SEQ) km0 = fmaxf(km0, s); else km1 = fmaxf(km1, s); }
        float ssq = 0.f;
        if (lane < 48) { float v[8]; unpack8(in_cq, v);
#pragma unroll
            for (int e = 0; e < 8; ++e) ssq += v[e] * v[e]; }
        const float ssq_q = wave_sum(lane < 32 ? ssq : 0.f), ssq_kv = wave_sum(lane >= 32 ? ssq : 0.f);
        const float rstd_q = 1.f / sqrtf(ssq_q * (1.f / 256.f) + NORM_EPS), rstd_kv = 1.f / sqrtf(ssq_kv * (1.f / 128.f) + NORM_EPS);
        {
            const int r = lane % 12; float v[8];
            unpack8(in_qup, v);
#pragma unroll
            for (int e = 0; e < 8; ++e) v[e] = (lane < 48) ? v[e] * rstd_q : 0.f;
            float w[8];
#pragma unroll
            for (int e = 0; e < 8; ++e) w[e] = v[e];
            rope8(w, r < 10, (float)t, 8 * (r & 1), p);
            const bool isr = (r >= 8); const float qs = 0.10206207261596575f;
#pragma unroll
            for (int e = 0; e < 8; ++e) v[e] = (isr ? w[e] : v[e]) * qs;
            if (lane < 48) *(u32x4*)(qb + (size_t)tok * 384 + 8 * lane) = pack8(v);
        }
        {
            float v[8]; unpack8(in_kv, v);
#pragma unroll
            for (int e = 0; e < 8; ++e) v[e] *= rstd_kv;
            const int hd = lane >> 4, r = lane & 15;
            if (r < 8) *(u32x4*)(kb + (size_t)tok * 384 + hd * 96 + 8 * r) = pack8(v);
            else *(u32x4*)(vb + (size_t)tok * 256 + hd * 64 + 8 * (r - 8)) = pack8(v);
        }
        {
            float v[8]; unpack8(in_kr, v);
            rope8(v, (lane & 3) < 2, (float)t, 8 * (lane & 1), p);
            if (lane < 4) { const u32x4 w = pack8(v);
#pragma unroll
                for (int hd = 0; hd < 4; ++hd) *(u32x4*)(kb + (size_t)tok * 384 + hd * 96 + 64 + 8 * lane) = w; }
        }
        {
            float v[8]; unpack8(in_c, v);
            float s = 0.f;
#pragma unroll
            for (int e = 0; e < 8; ++e) s += v[e] * v[e];
            s += __shfl_xor(s, 1); s += __shfl_xor(s, 2); s += __shfl_xor(s, 4);
            const float rs = 1.f / sqrtf(s * (1.f / 64.f) + NORM_EPS);
#pragma unroll
            for (int e = 0; e < 8; ++e) v[e] = v[e] * rs * cg[e];
            const int r = lane & 7; const float pos = (r < 4) ? (float)(t >> 6) : (float)(t & 63);
            rope8(v, (r & 3) < 2, pos, 8 * (r & 1), p);
            if (lane < 32) {
#pragma unroll
                for (int e = 0; e < 8; ++e) v[e] *= 0.125f; }
            if (lane < 48) *(u32x4*)(pr + PC + 8 * lane) = pack8(v);
        }
    }
    if (lane < 32 && (lane & 3) == 0) { unsigned* km = (unsigned*)(p->ws + WS_KMAX) + l * 16 + (lane >> 2);
        atomicMax(km, __builtin_bit_cast(unsigned, km0)); atomicMax(km + 8, __builtin_bit_cast(unsigned, km1)); }
}

#ifndef ATT_TYPES
#define ATT_TYPES 15
#endif
namespace att {
typedef float f32x2 __attribute__((ext_vector_type(2)));
constexpr int VPITCH = 144, KBUF = 64 * 208, VBUF = 64 * VPITCH;
constexpr int ATT_LDS = 2 * KBUF + 2 * VBUF;
constexpr float RESCALE_T = 5.0f;
__device__ __forceinline__ s16x4 vtr(const LAS char* p) { return __builtin_bit_cast(s16x4, __builtin_amdgcn_ds_read_tr16_b64_v4i16((LAS s16x4*)p)); }
__device__ __forceinline__ void xhalf_swap(float m, float& a, float& b) {
    a = m; b = m;
    asm volatile("s_nop 1\n\tv_permlane32_swap_b32 %0, %1\n\ts_nop 1" : "+v"(a), "+v"(b));
}
__device__ __forceinline__ float xhalf_max(float m) { float a, b; xhalf_swap(m, a, b); return fmaxf(a, b); }
__device__ __forceinline__ float xhalf_sum(float m) { float a, b; xhalf_swap(m, a, b); return a + b; }
__device__ __forceinline__ float max3f(float a, float b, float c) { return fmaxf(fmaxf(a, b), c); }
__device__ __forceinline__ float fma_s(float a, float b, float c) { float r; asm("v_fma_f32 %0, %1, %2, %3" : "=v"(r) : "v"(a), "s"(b), "v"(c)); return r; }
__device__ __forceinline__ float add_s(float a, float b) { float r; asm("v_add_f32_e32 %0, %1, %2" : "=v"(r) : "v"(a), "v"(b)); return r; }
__device__ __forceinline__ float mul_s(float a, float b) { float r; asm("v_mul_f32_e32 %0, %1, %2" : "=v"(r) : "v"(a), "v"(b)); return r; }
#define ATT_MFMA(a, b, c) __builtin_amdgcn_mfma_f32_32x32x16_bf16((a), (b), (c), 0, 0, 0)

template <int DK, int MODE, bool INIT = true>
__device__ __forceinline__ void flash_pass(LAS char* lds, const bf16_t* __restrict__ Qg, int qp, const bf16_t* __restrict__ Kg, int kp, const bf16_t* __restrict__ Vg, int vp,
                                           const bf16_t* __restrict__ AUGg, int q0, int a0, int nA, int b0, int nt, float slope, f32x16& O0, f32x16& O1, float& Mout, float& Lout) {
    constexpr int DKL = DK + (MODE == 1 ? 16 : 0);
    constexpr int KPITCH = DKL * 2 + 16, NKC = 8 * DKL, CPR = DKL / 8, NKS = DK / 16;
    constexpr bool HAS_K1 = NKC > 512;
    constexpr int DUMMY = 2 * KBUF + 2 * VBUF;
    const int tid = tid_fresh(), lane = tid & 63, r32 = lane & 31, hi = lane >> 5; const int wid = __builtin_amdgcn_readfirstlane(tid >> 6);
    const int qrow = q0 + wid * 32 + r32;
    bf16x8 qf[NKS];
#pragma unroll
    for (int ks = 0; ks < NKS; ++ks) qf[ks] = *(const bf16x8*)(Qg + (size_t)qrow * qp + 16 * ks + 8 * hi);
    const int kc1 = tid + 512;
    const bool k0v = tid < NKC, k1v = HAS_K1 && kc1 < NKC;
    const int kr0 = k0v ? tid / CPR : 0, kcc0 = k0v ? tid % CPR : 0, kr1 = k1v ? kc1 / CPR : 0, kcc1 = k1v ? kc1 % CPR : 0, vr = tid >> 3, vcc = tid & 7;
    const bf16_t* kg0; size_t kst0;
    if (MODE == 1 && kcc0 >= DK / 8) { kg0 = AUGg + (size_t)kr0 * 64 + 8 * (kcc0 - DK / 8); kst0 = (size_t)64 * 64; } else { kg0 = Kg + (size_t)kr0 * kp + 8 * kcc0; kst0 = (size_t)64 * kp; }
    const bf16_t* kg1 = Kg + (size_t)kr1 * kp + 8 * kcc1; const size_t kst1 = (size_t)64 * kp;
    const bf16_t* vg = Vg + (size_t)vr * vp + 8 * vcc; const size_t vst = (size_t)64 * vp;
    const int kl0 = k0v ? kr0 * KPITCH + 16 * kcc0 : -1, kl1 = k1v ? kr1 * KPITCH + 16 * kcc1 : -1, vl = 2 * KBUF + vr * VPITCH + 16 * vcc;
    u32x4 rk0 = {0u, 0u, 0u, 0u}, rk1 = {0u, 0u, 0u, 0u}, rv = {0u, 0u, 0u, 0u};
#define ATT_KT(i) ((i) < nA ? a0 + (i) : b0 + ((i) - nA))
#define ATT_LOADK(kt) do { const size_t t_ = (size_t)(kt); rk0 = *(const u32x4*)(kg0 + t_ * kst0); if (HAS_K1) rk1 = *(const u32x4*)(kg1 + t_ * kst1); } while (0)
#define ATT_LOADV(kt) do { rv = *(const u32x4*)(vg + (size_t)(kt) * vst); } while (0)
#define ATT_STOREK(buf) do { *(LAS u32x4*)(lds + (kl0 >= 0 ? (buf) * KBUF + kl0 : DUMMY + tid * 16)) = rk0; if (HAS_K1) *(LAS u32x4*)(lds + (kl1 >= 0 ? (buf) * KBUF + kl1 : DUMMY + tid * 16)) = rk1; } while (0)
#define ATT_STOREV(buf) do { *(LAS u32x4*)(lds + (buf) * VBUF + vl) = rv; } while (0)
    const int q4 = (lane & 15) >> 2, p4 = lane & 3, b16 = (lane >> 4) & 1;
    const int vbase = 2 * KBUF + (4 * hi + q4) * VPITCH + 32 * b16 + 8 * p4;
    const int kbase = r32 * KPITCH + 16 * hi;
    const int qw = q0 + wid * 32;
    const float stq = slope * (float)qrow;
    const bf16x8 qzero = {0, 0, 0, 0, 0, 0, 0, 0};
    bf16x8 qpos = qzero, qneg = qzero;
    if (MODE == 1 && hi == 0) { qpos[0] = (short)0x3F80; qpos[1] = (short)0x3F80; qneg[0] = (short)0xBF80; qneg[1] = (short)0xBF80; }
    constexpr int NKF = NKS + (MODE == 1 ? 1 : 0);
    constexpr int KPRE = NKF > 4 ? 4 : NKF;
    bf16x8 kfa[NKF], kfb[NKF];
#define ATT_KREAD(kbuf, f0, f1) do { const LAS char* Kb_ = lds + (kbuf) * KBUF + kbase; \
        _Pragma("unroll") for (int ks_ = (f0); ks_ < (f1); ++ks_) { kfa[ks_] = *(const LAS bf16x8*)(Kb_ + 32 * ks_); kfb[ks_] = *(const LAS bf16x8*)(Kb_ + 32 * KPITCH + 32 * ks_); } } while (0)
#define ATT_QKM(sa, sb, side) do { \
        _Pragma("unroll") for (int e_ = 0; e_ < 16; ++e_) { sa[e_] = 0.f; sb[e_] = 0.f; } \
        _Pragma("unroll") for (int ks_ = 0; ks_ < NKS; ++ks_) { sa = ATT_MFMA(kfa[ks_], qf[ks_], sa); sb = ATT_MFMA(kfb[ks_], qf[ks_], sb); } \
        if (MODE == 1) { const bf16x8 qa_ = (side) < 0 ? qpos : ((side) > 0 ? qneg : qzero); sa = ATT_MFMA(kfa[NKS], qa_, sa); sb = ATT_MFMA(kfb[NKS], qa_, sb); } } while (0)
#define ATT_QK(sa, sb, kbuf, side) do { ATT_KREAD(kbuf, 0, NKF); ATT_QKM(sa, sb, side); } while (0)
    bf16x8 vfa[4], vfb[4];
#define ATT_VREAD(vbuf) do { const LAS char* Vb_ = lds + (vbuf) * VBUF + vbase; \
        _Pragma("unroll") for (int j_ = 0; j_ < 4; ++j_) { const LAS char* vp0_ = Vb_ + (16 * j_) * VPITCH; \
            { const s16x4 lo_ = vtr(vp0_), hh_ = vtr(vp0_ + 8 * VPITCH); vfa[j_] = __builtin_shufflevector(lo_, hh_, 0, 1, 2, 3, 4, 5, 6, 7); } \
            { const s16x4 lo_ = vtr(vp0_ + 64), hh_ = vtr(vp0_ + 8 * VPITCH + 64); vfb[j_] = __builtin_shufflevector(lo_, hh_, 0, 1, 2, 3, 4, 5, 6, 7); } } } while (0)
#define ATT_PVM() do { _Pragma("unroll") for (int j_ = 0; j_ < 4; ++j_) { O0 = ATT_MFMA(vfa[j_], pf[j_ >> 1][j_ & 1], O0); O1 = ATT_MFMA(vfb[j_], pf[j_ >> 1][j_ & 1], O1); } } while (0)
#define ATT_PV(vbuf) do { ATT_VREAD(vbuf); ATT_PVM(); } while (0)
#define ATT_SIDE(kt) ((MODE != 1) ? 0 : (((kt) * 64 + 63 < qw) ? -1 : (((kt) * 64 > qw + 31) ? 1 : 0)))
    ATT_LOADK(ATT_KT(0)); ATT_STOREK(0);
    ATT_LOADK(ATT_KT(1)); ATT_STOREK(1);
    ATT_STOREV(1);
    __syncthreads();
    float M = INIT ? -1e20f : Mout, L = INIT ? 0.f : Lout;
    if (INIT) {
#pragma unroll
        for (int i = 0; i < 16; ++i) { O0[i] = 0.f; O1[i] = 0.f; } }
    bf16x8 pf[2][2];
#pragma unroll
    for (int kb = 0; kb < 2; ++kb)
#pragma unroll
        for (int st = 0; st < 2; ++st) pf[kb][st] = qzero;
    f32x16 s0, s1, n0, n1;
    int side_cur = ATT_SIDE(ATT_KT(0));
    ATT_QK(s0, s1, 0, side_cur);
#pragma unroll
    for (int e = 0; e < 16; ++e) { n0[e] = 0.f; n1[e] = 0.f; }
    __syncthreads();
    constexpr int NMF = 2 * NKS + (MODE == 1 ? 2 : 0) + 8;
#define ATT_ITER(i, C0, C1, N0, N1, HASN, HASK2) do { \
        const int kt = ATT_KT(i); \
        if (HASK2) ATT_LOADK(ATT_KT((i) + 2)); \
        ATT_LOADV(kt); \
        if (HASN) ATT_KREAD(((i) + 1) & 1, 0, KPRE); \
        const int k0 = kt * 64; \
          \
        float rc = 0.f; \
        if (MODE == 1) { \
            if (side_cur != 0) rc = side_cur < 0 ? -stq : stq; \
            else { const float dbase = (float)(k0 + 4 * hi - qrow); \
                _Pragma("unroll") for (int e = 0; e < 16; ++e) { const float c = (float)((e & 3) + 8 * (e >> 2)); \
                    C0[e] = fmaf(-slope, fabsf(dbase + c), C0[e]); C1[e] = fmaf(-slope, fabsf(dbase + (c + 32.f)), C1[e]); } } \
        } \
        if (MODE == 2) { const float dbase = (float)(k0 + 4 * hi - qrow); \
            _Pragma("unroll") for (int e = 0; e < 16; ++e) { const float c = (float)((e & 3) + 8 * (e >> 2)); \
                const float d0 = fabsf(dbase + c), d1 = fabsf(dbase + (c + 32.f)); \
                C0[e] = (d0 <= 128.f) ? fmaf(-slope, d0, C0[e]) : -1e30f; C1[e] = (d1 <= 128.f) ? fmaf(-slope, d1, C1[e]) : -1e30f; } } \
        float mx = max3f(C0[0], C1[0], C0[1]); \
        _Pragma("unroll") for (int e = 1; e < 15; e += 2) { mx = max3f(mx, C1[e], C0[e + 1]); mx = max3f(mx, C1[e + 1], C0[e + 2]); } \
        mx = fmaxf(mx, C1[15]); \
        const float mt = xhalf_max(mx) + rc;                     \
        if (__builtin_amdgcn_ballot_w64(mt > M + RESCALE_T) != 0ull) {         \
            ATT_PV(((i) + 1) & 1); \
            _Pragma("unroll") for (int kb = 0; kb < 2; ++kb) _Pragma("unroll") for (int st = 0; st < 2; ++st) pf[kb][st] = qzero; \
            const float Mn = fmaxf(M, mt); const float alpha = __builtin_amdgcn_exp2f((M - Mn) * LOG2E); M = Mn; \
            L *= alpha; \
            _Pragma("unroll") for (int e = 0; e < 16; ++e) { O0[e] *= alpha; O1[e] *= alpha; }        \
        } \
          \
        const int side_next = HASN ? ATT_SIDE(ATT_KT((i) + 1)) : 0; \
        if (HASN) ATT_KREAD(((i) + 1) & 1, KPRE, NKF); \
        ATT_VREAD(((i) + 1) & 1); \
        if (HASN) ATT_QKM(N0, N1, side_next); \
        ATT_PVM();                                   \
        const float cc = (rc - M) * LOG2E; \
        float ps = 0.f;                                          \
        float ps1 = 0.f; \
        _Pragma("unroll") for (int e = 0; e < 16; ++e) { float t0 = __builtin_fmaf(C0[e], LOG2E, cc), t1 = __builtin_fmaf(C1[e], LOG2E, cc); \
            asm("" : "+v"(t0)); asm("" : "+v"(t1));                 \
            C0[e] = __builtin_amdgcn_exp2f(t0); C1[e] = __builtin_amdgcn_exp2f(t1); \
            float u0 = ps + C0[e], u1 = ps1 + C1[e]; asm("" : "+v"(u0)); asm("" : "+v"(u1)); ps = u0; ps1 = u1; } \
        L += ps + ps1; \
        _Pragma("unroll") for (int st = 0; st < 2; ++st) { u32x4 w0, w1; \
            w0.x = pkbf(C0[8 * st + 0], C0[8 * st + 1]); w0.y = pkbf(C0[8 * st + 2], C0[8 * st + 3]); w0.z = pkbf(C0[8 * st + 4], C0[8 * st + 5]); w0.w = pkbf(C0[8 * st + 6], C0[8 * st + 7]); \
            w1.x = pkbf(C1[8 * st + 0], C1[8 * st + 1]); w1.y = pkbf(C1[8 * st + 2], C1[8 * st + 3]); w1.z = pkbf(C1[8 * st + 4], C1[8 * st + 5]); w1.w = pkbf(C1[8 * st + 6], C1[8 * st + 7]); \
            pf[0][st] = __builtin_bit_cast(bf16x8, w0); pf[1][st] = __builtin_bit_cast(bf16x8, w1); } \
        side_cur = side_next; \
        if (HASN) { __builtin_amdgcn_sched_group_barrier(0x100, 16 + 2 * (NKF - KPRE), 0); \
            _Pragma("unroll") for (int g_ = 0; g_ < NMF; ++g_) { __builtin_amdgcn_sched_group_barrier(0x008, 1, 0); __builtin_amdgcn_sched_group_barrier(0x002, 6, 0); } } \
        if (HASK2) ATT_STOREK((i) & 1); \
        ATT_STOREV((i) & 1); \
        __syncthreads(); } while (0)
    for (int i = 0; i + 2 < nt; i += 2) {
        ATT_ITER(i, s0, s1, n0, n1, true, true);
        ATT_ITER(i + 1, n0, n1, s0, s1, true, true);
    }
    ATT_ITER(nt - 2, s0, s1, n0, n1, true, false);
    ATT_ITER(nt - 1, n0, n1, s0, s1, false, false);
    ATT_PV((nt - 1) & 1);
    __syncthreads();
#undef ATT_ITER
#undef ATT_LOADK
#undef ATT_LOADV
#undef ATT_STOREK
#undef ATT_STOREV
#undef ATT_KT
#undef ATT_QK
#undef ATT_PV
#undef ATT_KREAD
#undef ATT_QKM
#undef ATT_VREAD
#undef ATT_PVM
#undef ATT_SIDE
    Mout = M; Lout = L;
}

__device__ __forceinline__ void store_o(bf16_t* orow, const f32x16& O0, const f32x16& O1, int hi) {
#pragma unroll
    for (int g = 0; g < 4; ++g) {
        u32x2 w0, w1; w0.x = pkbf(O0[4 * g], O0[4 * g + 1]); w0.y = pkbf(O0[4 * g + 2], O0[4 * g + 3]); w1.x = pkbf(O1[4 * g], O1[4 * g + 1]); w1.y = pkbf(O1[4 * g + 2], O1[4 * g + 3]);
        *(u32x2*)(orow + 8 * g + 4 * hi) = w0; *(u32x2*)(orow + 32 + 8 * g + 4 * hi) = w1;
    }
}

__device__ __forceinline__ void attn_phase(KP p, int l, LAS char* lds, int vcu, int G) {
    const int tid = tid_fresh(), lane = tid & 63, r32 = lane & 31, hi = lane >> 5; const int wid = __builtin_amdgcn_readfirstlane(tid >> 6);
    const bf16_t* proj = (const bf16_t*)(p->ws + WS_PROJ); const bf16_t* qb = (const bf16_t*)(p->ws + WS_QB); const bf16_t* kb = (const bf16_t*)(p->ws + WS_KB); const bf16_t* vb = (const bf16_t*)(p->ws + WS_VB);
    const bf16_t* aug = (const bf16_t*)(p->ws + WS_AUG);
    bf16_t* mix = (bf16_t*)(p->ws + WS_MIX);
    float lam;
    { const float* lp = p->diff_lambda + l * 128; const float a = (lane < 32) ? lp[lane] * lp[32 + lane] : 0.f, b2 = (lane < 32) ? lp[64 + lane] * lp[96 + lane] : 0.f;
      lam = expf(wave_sum(a)) - expf(wave_sum(b2)) + p->lam_init[l]; }
    const float one_m_li = 1.f - p->lam_init[l];
    for (int u = vcu; u < 2048; u += G) {
        if (!((ATT_TYPES >> (u >> 9)) & 1)) continue;
        const int type = u >> 9, idx = u & 511, bh = idx >> 6, qblk = idx & 63, b = bh >> 2, hd = bh & 3, q0 = qblk * 256;
        const int qrow = q0 + wid * 32 + r32;
        const size_t tok0 = (size_t)b * SEQ;
        bf16_t* orow = mix + (tok0 + qrow) * DM;
        f32x16 O0, O1; float M, L;
        if (type == 0) {
            const int bD = idx >> 8, hD = ((idx >> 6) & 3) ^ (bD ? 3 : 0);
            const size_t tokD = (size_t)bD * SEQ;
            bf16_t* orowD = mix + (tokD + qrow) * DM;
            const float slope = __builtin_amdgcn_exp2f(-(float)(5 + hD));
            const bf16_t* base = proj + tokD * NPROJ + PD;
            const int d0 = q0 / 64;
            LAS float* asave = (LAS float*)(lds + 65536) + tid;
#pragma unroll 1
            for (int mp = 0; mp < 2; ++mp) {
                const bf16_t* Qm = base + 64 * hD + 32 * mp; const bf16_t* Km = base + 256 + 64 * hD + 32 * mp; const bf16_t* Vm = base + 512 + 64 * hD;
                flash_pass<32, 1, true>(lds, Qm, NPROJ, Km, NPROJ, Vm, NPROJ, aug + 16 * hD, q0, d0, 4, 0, 4, slope, O0, O1, M, L);
                float qn2 = 0.f;
                { const u32x4* qr = (const u32x4*)(Qm + (size_t)qrow * NPROJ);
#pragma unroll
                  for (int c = 0; c < 4; ++c) { float v[8]; unpack8(qr[c], v);
#pragma unroll
                      for (int e = 0; e < 8; ++e) qn2 += v[e] * v[e]; } }
                const float kmax = sqrtf(__builtin_bit_cast(float, ((const unsigned*)(p->ws + WS_KMAX))[l * 16 + bD * 8 + hD * 2 + mp]));
                float dc = (sqrtf(qn2) * kmax * 1.001f + 40.f - M) / slope;
                dc = fminf(fmaxf(dc, 0.f), 1.0e8f);
#pragma unroll
                for (int o = 1; o < 64; o <<= 1) dc = fmaxf(dc, __shfl_xor(dc, o));
                LAS float* red = (LAS float*)(lds + ATT_LDS + 16384);
                if (lane == 0) red[wid] = dc;
                __syncthreads();
#pragma unroll
                for (int w = 0; w < 8; ++w) dc = fmaxf(dc, red[w]);
                __syncthreads();
                const int dci = (int)dc + 1;
                const int lo_key = q0 - dci - 63;
                int ktlo = lo_key <= 0 ? 0 : (lo_key + 63) / 64; int kthi = (q0 + 255 + dci) / 64; if (kthi > SEQ / 64 - 1) kthi = SEQ / 64 - 1;
                if (ktlo > d0) ktlo = d0; if (kthi < d0 + 3) kthi = d0 + 3;
                if (((kthi - ktlo + 1) & 1) != 0) { if (ktlo > 0) --ktlo; else ++kthi; }
                const int nR = kthi - (d0 + 3), nL = d0 - ktlo;
                if (nR + nL > 0) flash_pass<32, 1, false>(lds, Qm, NPROJ, Km, NPROJ, Vm, NPROJ, aug + 16 * hD, q0, d0 + 4, nR, ktlo, nR + nL, slope, O0, O1, M, L);
                if (mp == 0) { const float i1 = 1.f / xhalf_sum(L);
#pragma unroll
                    for (int i = 0; i < 16; ++i) { asave[(2 * i) * NTHREADS] = O0[i] * i1; asave[(2 * i + 1) * NTHREADS] = O1[i] * i1; } }
            }
            const float i2 = lam / xhalf_sum(L);
            float ss = 0.f;
            f32x16 A0, A1;
#pragma unroll
            for (int i = 0; i < 16; ++i) { A0[i] = asave[(2 * i) * NTHREADS] - O0[i] * i2; A1[i] = asave[(2 * i + 1) * NTHREADS] - O1[i] * i2; ss += A0[i] * A0[i] + A1[i] * A1[i]; }
            ss = xhalf_sum(ss);
            const float rs = one_m_li / sqrtf(ss * (1.f / 64.f) + NORM_EPS);
            const float* sg = p->diff_subln + l * 64;
#pragma unroll
            for (int i = 0; i < 16; ++i) { const int dv = (i & 3) + 8 * (i >> 2) + 4 * hi; A0[i] *= rs * sg[dv]; A1[i] *= rs * sg[32 + dv]; }
            store_o(orowD + 768 + 64 * hD, A0, A1, hi);
        } else if (type == 1) {
            flash_pass<96, 0>(lds, qb + tok0 * 384 + 96 * hd, 384, kb + tok0 * 384 + 96 * hd, 384, vb + tok0 * 256 + 64 * hd, 256, nullptr, q0, q0 / 64, SEQ / 64 - q0 / 64, 0, SEQ / 64, 0.f, O0, O1, M, L);
            const float il = 1.f / xhalf_sum(L);
#pragma unroll
            for (int i = 0; i < 16; ++i) { O0[i] *= il; O1[i] *= il; }
            store_o(orow + 256 + 64 * hd, O0, O1, hi);
        } else if (type == 2) {
            const bf16_t* base = proj + tok0 * NPROJ + PC; const int hk = hd >> 1;
            flash_pass<64, 0>(lds, base + 64 * hd, NPROJ, base + 256 + 64 * hk, NPROJ, base + 384 + 64 * hk, NPROJ, nullptr, q0, q0 / 64, SEQ / 64 - q0 / 64, 0, SEQ / 64, 0.f, O0, O1, M, L);
            const float il = 1.f / xhalf_sum(L);
#pragma unroll
            for (int i = 0; i < 16; ++i) { O0[i] *= il; O1[i] *= il; }
            store_o(orow + 512 + 64 * hd, O0, O1, hi);
        } else {
            const bf16_t* base = proj + tok0 * NPROJ + PA; const int hk = hd >> 1;
            const float slope = __builtin_amdgcn_exp2f(-(float)(1 + hd));
            const int kt0 = (q0 >= 128) ? (q0 - 128) / 64 : 0; int kt1 = (q0 + 256 + 128) / 64; if (kt1 > SEQ / 64) kt1 = SEQ / 64;
            flash_pass<64, 2>(lds, base + 64 * hd, NPROJ, base + 256 + 64 * hk, NPROJ, base + 384 + 64 * hk, NPROJ, nullptr, q0, kt0, kt1 - kt0, 0, kt1 - kt0, slope, O0, O1, M, L);
            const float sink = p->win_sink[l * 4 + hd];
            const float il = 1.f / (xhalf_sum(L) + __builtin_amdgcn_exp2f((sink - M) * LOG2E));
#pragma unroll
            for (int i = 0; i < 16; ++i) { O0[i] *= il; O1[i] *= il; }
            store_o(orow + 64 * hd, O0, O1, hi);
        }
    }
}
}

#define GRID_SYNC() do { asm volatile("s_waitcnt vmcnt(0) lgkmcnt(0)" ::: "memory"); grid.sync(); __builtin_amdgcn_fence(__ATOMIC_ACQUIRE, "agent"); } while (0)
#ifndef PH_MASK
#define PH_MASK 255
#endif
__global__ void __launch_bounds__(NTHREADS, 2) mega_fwd(Params p_by_value) {
    extern __shared__ __attribute__((aligned(16))) unsigned char lds_raw[];
    cg::grid_group grid = cg::this_grid();
    LAS unsigned char* lds = (LAS unsigned char*)lds_raw;
#define VCU(G_, bx_) (((G_) % 8 == 0) ? ((bx_) % 8) * ((G_) / 8) + (bx_) / 8 : (bx_))
    const float alpha = 1.681792830507429f;
#define STATS(s_) ((float*)(p->ws + WS_STATS) + (size_t)(s_) * T * 2)
#define C1(l_, off_) ((const float*)(p->ws + WS_C12) + (l_) * C12_L + (off_))
#define C2(l_, off_) ((const float*)(p->ws + WS_C12) + C2_OFF + (l_) * C12_L + (off_))

    if (PH_MASK & 1) { GETP(p); const int G = gridDim.x, bx = blockIdx.x; phase0(p, lds, VCU(G, bx), G); }
    GRID_SYNC();
#pragma unroll 1
    for (int li = 0; li < DEPTH; ++li) {
#pragma unroll 1
        for (int fi = 0; fi < 2; ++fi) {
            if (fi == 1) {
                if (PH_MASK & 2) { GETP(p); int l = li; asm volatile("" : "+s"(l)); const int G = gridDim.x, bx = blockIdx.x;
                  pg8::Gemm g{(const bf16_t*)(p->ws + WS_XB), (const bf16_t*)(p->ws + WS_WIN) + l * WIN_L, T, NPROJ, DM}; pg8::StaticOrder S; S.init(T, NPROJ, G, bx);
                  pg8::EpiStoreBf16LN E{(bf16_t*)(p->ws + WS_PROJ), NPROJ, STATS(3 * l), C1(l, 2 * NGU), C2(l, 2 * NGU)};
                  pg8::gemm_phase<pg8::EpiStoreBf16LN, pg8::StaticOrder, true, true>(lds, g, S, E); }
                GRID_SYNC();
                if (PH_MASK & 4) { GETP(p); int l = li; asm volatile("" : "+s"(l)); const int G = gridDim.x, bx = blockIdx.x; prep_phase(p, l, VCU(G, bx), G); }
                GRID_SYNC();
                if (PH_MASK & 8) { GETP(p); int l = li; asm volatile("" : "+s"(l)); const int G = gridDim.x, bx = blockIdx.x; att::attn_phase(p, l, (LAS char*)lds, VCU(G, bx), G); }
                GRID_SYNC();
                if (PH_MASK & 16) { GETP(p); int l = li; asm volatile("" : "+s"(l)); const int G = gridDim.x, bx = blockIdx.x;
                  pg8::Gemm g{(const bf16_t*)(p->ws + WS_MIX), (const bf16_t*)(p->ws + WS_WOUT) + l * WOUT_L, T, DM, DM}; pg8::StaticOrder S; S.init(T, DM, G, bx);
                  pg8::EpiResidLN<true> E{nullptr, p->out, p->ws, p->ln_g + (3 * l) * DM, p->ln_b + (3 * l) * DM, 3 * l, alpha, 1.0f};
                  pg8::gemm_phase<pg8::EpiResidLN<true>, pg8::StaticOrder, true, true>(lds, g, S, E); }
                GRID_SYNC();
            }
            if (PH_MASK & 64) { GETP(p); int l = li, f = fi; asm volatile("" : "+s"(l), "+s"(f)); const int G = gridDim.x, bx = blockIdx.x;
              const int s = 3 * l + 2 * f - 1;
              pg8::Gemm g{(const bf16_t*)(p->ws + WS_XB), (const bf16_t*)(p->ws + WS_WGU) + l * WGU_L + f * WGU_F, T, NGU, DM}; pg8::StaticOrder S; S.init(T, NGU, G, bx);
              if (s >= 0) { pg8::EpiSwiGLULN<true> E{(bf16_t*)(p->ws + WS_H), DFF, STATS(s), C1(l, f * NGU), C2(l, f * NGU)};
                            pg8::gemm_phase<pg8::EpiSwiGLULN<true>, pg8::StaticOrder, true, true>(lds, g, S, E); }
              else { pg8::EpiSwiGLULN<false> E{(bf16_t*)(p->ws + WS_H), DFF, nullptr, C1(l, f * NGU), C2(l, f * NGU)};
                     pg8::gemm_phase<pg8::EpiSwiGLULN<false>, pg8::StaticOrder, true, true>(lds, g, S, E); } }
            GRID_SYNC();
            if (PH_MASK & 128) { GETP(p); int l = li, f = fi; asm volatile("" : "+s"(l), "+s"(f)); const int G = gridDim.x, bx = blockIdx.x;
              const int s = 3 * l + 2 * f - 1;
              pg8::Gemm g{(const bf16_t*)(p->ws + WS_H), (const bf16_t*)(p->ws + WS_WD) + l * WD_L + f * WD_F, T, DM, DFF}; pg8::StaticOrder S; S.init(T, DM, G, bx);
              if (s >= 0) { pg8::EpiResidLN<true> E{nullptr, p->out, p->ws, p->ln_g + s * DM, p->ln_b + s * DM, s, alpha, 0.5f};
                            pg8::gemm_phase<pg8::EpiResidLN<true>, pg8::StaticOrder, true, true>(lds, g, S, E); }
              else { pg8::EpiResidLN<false> E{p->x, p->out, p->ws, nullptr, nullptr, -1, alpha, 0.5f};
                     pg8::gemm_phase<pg8::EpiResidLN<false>, pg8::StaticOrder, true, true>(lds, g, S, E); } }
            GRID_SYNC();
        }
    }
    if (PH_MASK & 32) { GETP(p); const int G = gridDim.x, bx = blockIdx.x;
      ln_phase(p->out, (bf16_t*)(p->ws + WS_XB), p->ln_g + (3 * DEPTH - 1) * DM, p->ln_b + (3 * DEPTH - 1) * DM, VCU(G, bx), G); }
}

extern "C" void kernel_launch(void* const* d_in, const int* in_sizes, int n_in, void* d_out, int out_size, void* d_ws, size_t ws_size, hipStream_t stream) {
    static int grid = 0;
    if (grid == 0) {
        if (n_in != 16 || in_sizes[0] != T * DM || out_size != T * DM || ws_size < WS_END) { fprintf(stderr, "kernel_launch: unexpected shapes (n_in %d, in0 %d, out %d, ws %zu); nothing launched\n", n_in, n_in > 0 ? in_sizes[0] : -1, out_size, ws_size); grid = -1; return; }
        int dev = 0, cus = 0, per_cu = 0;
        hipGetDevice(&dev); hipDeviceGetAttribute(&cus, hipDeviceAttributeMultiprocessorCount, dev);
        if (hipFuncSetAttribute((const void*)mega_fwd, hipFuncAttributeMaxDynamicSharedMemorySize, LDS_BYTES) != hipSuccess) { fprintf(stderr, "kernel_launch: hipFuncSetAttribute failed\n"); grid = -1; return; }
        if (hipOccupancyMaxActiveBlocksPerMultiprocessor(&per_cu, (const void*)mega_fwd, NTHREADS, LDS_BYTES) != hipSuccess || per_cu < 1) { fprintf(stderr, "kernel_launch: occupancy query gave %d\n", per_cu); per_cu = 1; }
        (void)hipGetLastError();
        grid = cus * 1;
    }
    if (grid < 0) return;
    Params p{};
    p.x = (const float*)d_in[0]; p.w_in = (const float*)d_in[1]; p.win_sink = (const float*)d_in[2]; p.mla_q_norm = (const float*)d_in[3]; p.mla_w_uq = (const float*)d_in[4];
    p.mla_kv_norm = (const float*)d_in[5]; p.mla_w_ukv = (const float*)d_in[6]; p.ax_q_norm = (const float*)d_in[7]; p.ax_k_norm = (const float*)d_in[8]; p.diff_lambda = (const float*)d_in[9];
    p.diff_subln = (const float*)d_in[10]; p.w_out = (const float*)d_in[11]; p.ffn_w_gu = (const float*)d_in[12]; p.ffn_w_down = (const float*)d_in[13]; p.ln_g = (const float*)d_in[14]; p.ln_b = (const float*)d_in[15];
    p.out = (float*)d_out; p.ws = (unsigned char*)d_ws;
    for (int l = 0; l < 4; ++l) p.lam_init[l] = (float)(0.8 - 0.6 * exp(-0.3 * (double)l));
    for (int i = 0; i < 16; ++i) p.inv32[i] = (float)pow(10000.0, -(double)i / 16.0);
    if (hipMemsetAsync((char*)d_ws + WS_CTL, 0, CTL_BYTES, stream) != hipSuccess) { fprintf(stderr, "kernel_launch: hipMemsetAsync of the control region failed\n"); return; }
    void* args[] = {&p};
    hipError_t e = hipLaunchCooperativeKernel((const void*)mega_fwd, dim3(grid), dim3(NTHREADS), args, LDS_BYTES, stream);
    if (e != hipSuccess) fprintf(stderr, "kernel_launch: cooperative launch failed: %s (grid %d)\n", hipGetErrorString(e), grid);
}
```

```cpp
#include <hip/hip_runtime.h>
#include <hip/hip_cooperative_groups.h>
#include <cstdio>
#include <cstdint>
#include <cmath>
namespace cg = cooperative_groups;
namespace pg8 {
#define PG8_LAS __attribute__((address_space(3)))
typedef unsigned short bf16_t;
typedef short bf16x8 __attribute__((ext_vector_type(8)));
typedef float f32x4 __attribute__((ext_vector_type(4)));
typedef unsigned u32x4 __attribute__((ext_vector_type(4)));
constexpr int BM = 256, BK = 64, HALF = 128, HTB = HALF * BK * 2  , STAGE_BYTES = 8 * HTB, NXCD = 8, WGM = 8;

__host__ __device__ __forceinline__ int lds_byte(int r, int c) { const int st = (r >> 4) * 2 + (c >> 5), rr = r & 15, cc = c & 31, ob = rr * 64 + cc * 2; return st * 1024 + (ob ^ (((ob >> 9) & 1) << 5)); }
__host__ __device__ __forceinline__ void stage_rc(int b, int& R, int& C) { const int st = b / 1024, sb = b % 1024, swz = sb ^ (((sb >> 9) & 1) << 5); R = (st >> 1) * 16 + swz / 64; C = (st & 1) * 32 + (swz % 64) / 2; }
__host__ __device__ __forceinline__ int perm32(int rho) { const int n = rho >> 4, i = rho & 15; return 8 * (i >> 2) + 4 * n + (i & 3); }

struct Unit { int pm, pn; };
struct Gemm { const bf16_t* A; const bf16_t* Bt; int M, N, K; };

struct StaticOrder {
    int nM, nN, nwg, G, c;
    __host__ __device__ void init(int M, int N, int G_, int c_) { nM = M / BM; nN = N / BM; nwg = nM * nN; G = G_; c = c_; }
    __host__ __device__ bool next(int i, Unit& u) const {
        const long L = (long)i * G + c; if (L >= nwg) return false;
        int wgid = (int)L; { const int q = nwg / NXCD, r = nwg % NXCD, xcd = wgid % NXCD, off = wgid / NXCD; wgid = (xcd < r ? xcd * (q + 1) : r * (q + 1) + (xcd - r) * q) + off; }
        const int nig = WGM * nN, gid = wgid / nig, fm = gid * WGM, gsz = (nM - fm) < WGM ? (nM - fm) : WGM;
        u.pm = fm + ((wgid % nig) % gsz); u.pn = (wgid % nig) / gsz; return true;
    }
    __device__ __forceinline__ void a_ready(const Unit&) const {}
    __device__ __forceinline__ void done(const Unit&) const {}
};

__device__ __forceinline__ unsigned cvt_pk_bf16(float lo, float hi) { unsigned r; asm volatile("v_cvt_pk_bf16_f32 %0, %1, %2" : "=v"(r) : "v"(lo), "v"(hi)); return r; }
typedef float f32x2 __attribute__((ext_vector_type(2)));
typedef float f32x2 __attribute__((ext_vector_type(2)));
typedef unsigned u32x2 __attribute__((ext_vector_type(2)));

struct EpiStoreBf16 {
    static constexpr bool PERM = true, AFTER_DRAIN = false;
    bf16_t* O; int ldc;
    __device__ __forceinline__ void operator()(const f32x4 (&acc)[2][2][4][2], const Unit& u, int wr, int wc, int fr, int fq) const {
        const int row0 = u.pm * BM + wr * 64 + fr; const int col0 = u.pn * BM + wc * 32 + 8 * fq;
#pragma unroll
        for (int ai = 0; ai < 2; ++ai)
#pragma unroll
            for (int m = 0; m < 4; ++m) { bf16_t* rowp = O + (size_t)(row0 + ai * HALF + m * 16) * ldc + col0;
#pragma unroll
                for (int bj = 0; bj < 2; ++bj) { const f32x4 v0 = acc[ai][bj][m][0], v1 = acc[ai][bj][m][1];
                    u32x4 w; w.x = cvt_pk_bf16(v0[0], v0[1]); w.y = cvt_pk_bf16(v0[2], v0[3]); w.z = cvt_pk_bf16(v1[0], v1[1]); w.w = cvt_pk_bf16(v1[2], v1[3]);
                    *(u32x4*)(rowp + bj * HALF) = w; } }
    }
};

__device__ __forceinline__ float silu_mul(float g, float u) {
    const float e = __builtin_amdgcn_exp2f(-1.4426950408889634f * g);
    return g * u * __builtin_amdgcn_rcpf(1.0f + e);
}
struct EpiSwiGLU {
    static constexpr bool PERM = true, AFTER_DRAIN = false;
    bf16_t* H; int ldh;
    __device__ __forceinline__ void operator()(const f32x4 (&acc)[2][2][4][2], const Unit& u, int wr, int wc, int fr, int fq) const {
        const int row0 = u.pm * BM + wr * 64 + fr; const int col0 = u.pn * HALF + wc * 32 + 8 * fq;
#pragma unroll
        for (int ai = 0; ai < 2; ++ai)
#pragma unroll
            for (int m = 0; m < 4; ++m) { bf16_t* rowp = H + (size_t)(row0 + ai * HALF + m * 16) * ldh + col0;
                const f32x4 g0 = acc[ai][0][m][0], g1 = acc[ai][0][m][1], u0 = acc[ai][1][m][0], u1 = acc[ai][1][m][1];
                u32x4 w;
                w.x = cvt_pk_bf16(silu_mul(g0[0], u0[0]), silu_mul(g0[1], u0[1])); w.y = cvt_pk_bf16(silu_mul(g0[2], u0[2]), silu_mul(g0[3], u0[3]));
                w.z = cvt_pk_bf16(silu_mul(g1[0], u1[0]), silu_mul(g1[1], u1[1])); w.w = cvt_pk_bf16(silu_mul(g1[2], u1[2]), silu_mul(g1[3], u1[3]));
                *(u32x4*)rowp = w; }
    }
};

struct EpiResid {
    static constexpr bool PERM = false, AFTER_DRAIN = false;
    const float* src; float* dst; int ld; float alpha, beta;
    __device__ __forceinline__ void operator()(const f32x4 (&acc)[2][2][4][2], const Unit& u, int wr, int wc, int fr, int fq) const {
        const int col0 = u.pn * BM + wc * 32 + 4 * fq;
#pragma unroll
        for (int ai = 0; ai < 2; ++ai)
#pragma unroll
            for (int m = 0; m < 4; ++m) { const size_t off = (size_t)(u.pm * BM + ai * HALF + wr * 64 + m * 16 + fr) * ld + col0;
#pragma unroll
                for (int bj = 0; bj < 2; ++bj)
#pragma unroll
                    for (int n = 0; n < 2; ++n) { const f32x4 s = *(const f32x4*)(src + off + bj * HALF + n * 16);
                        *(f32x4*)(dst + off + bj * HALF + n * 16) = s * alpha + acc[ai][bj][m][n] * beta; } }
    }
};

constexpr float LN_EPS_F = 1e-5f;
template <bool HAS> __device__ __forceinline__ void ln_row_stats(const float* st, int row, float& mu, float& rs) {
    if (!HAS) { mu = 0.f; rs = 1.f; return; }
    const f32x2 s = *(const f32x2*)(st + 2 * (size_t)row);
    mu = s.x * (1.0f / 1024.0f); const float var = fmaxf(s.y * (1.0f / 1024.0f) - mu * mu, 0.f); rs = 1.0f / sqrtf(var + LN_EPS_F);
}
struct EpiStoreBf16LN {
    static constexpr bool PERM = true, AFTER_DRAIN = false;
    bf16_t* O; int ldc; const float* st; const float* c1; const float* c2;
    __device__ __forceinline__ void operator()(const f32x4 (&acc)[2][2][4][2], const Unit& u, int wr, int wc, int fr, int fq) const {
        int row0 = u.pm * BM + wr * 64 + fr; int col0 = u.pn * BM + wc * 32 + 8 * fq;
        asm volatile("" : "+v"(row0), "+v"(col0));
        f32x4 c1v[2][2], c2v[2][2];
#pragma unroll
        for (int bj = 0; bj < 2; ++bj)
#pragma unroll
            for (int n = 0; n < 2; ++n) { c1v[bj][n] = *(const f32x4*)(c1 + col0 + bj * HALF + 4 * n); c2v[bj][n] = *(const f32x4*)(c2 + col0 + bj * HALF + 4 * n); }
#pragma unroll
        for (int ai = 0; ai < 2; ++ai)
#pragma unroll
            for (int m = 0; m < 4; ++m) { const int row = row0 + ai * HALF + m * 16; float mu, rs; ln_row_stats<true>(st, row, mu, rs);
                bf16_t* rowp = O + (size_t)row * ldc + col0;
#pragma unroll
                for (int bj = 0; bj < 2; ++bj) { const f32x4 v0 = (acc[ai][bj][m][0] - c1v[bj][0] * mu) * rs + c2v[bj][0], v1 = (acc[ai][bj][m][1] - c1v[bj][1] * mu) * rs + c2v[bj][1];
                    u32x4 w; w.x = cvt_pk_bf16(v0[0], v0[1]); w.y = cvt_pk_bf16(v0[2], v0[3]); w.z = cvt_pk_bf16(v1[0], v1[1]); w.w = cvt_pk_bf16(v1[2], v1[3]);
                    *(u32x4*)(rowp + bj * HALF) = w; } }
    }
};
template <bool HAS_LN> struct EpiSwiGLULN {
    static constexpr bool PERM = true, AFTER_DRAIN = false;
    bf16_t* H; int ldh; const float* st; const float* c1; const float* c2;
    __device__ __forceinline__ void operator()(const f32x4 (&acc)[2][2][4][2], const Unit& u, int wr, int wc, int fr, int fq) const {
        int row0 = u.pm * BM + wr * 64 + fr; const int col0 = u.pn * HALF + wc * 32 + 8 * fq; int wcol0 = u.pn * BM + wc * 32 + 8 * fq;
        asm volatile("" : "+v"(row0), "+v"(wcol0));
        f32x4 c1v[2][2], c2v[2][2];
#pragma unroll
        for (int bj = 0; bj < 2; ++bj)
#pragma unroll
            for (int n = 0; n < 2; ++n) { c1v[bj][n] = *(const f32x4*)(c1 + wcol0 + bj * HALF + 4 * n); c2v[bj][n] = *(const f32x4*)(c2 + wcol0 + bj * HALF + 4 * n); }
#pragma unroll
        for (int ai = 0; ai < 2; ++ai)
#pragma unroll
            for (int m = 0; m < 4; ++m) { const int row = row0 + ai * HALF + m * 16; float mu, rs; ln_row_stats<HAS_LN>(st, row, mu, rs);
                bf16_t* rowp = H + (size_t)row * ldh + col0;
                const f32x4 g0 = (acc[ai][0][m][0] - c1v[0][0] * mu) * rs + c2v[0][0], g1 = (acc[ai][0][m][1] - c1v[0][1] * mu) * rs + c2v[0][1];
                const f32x4 u0 = (acc[ai][1][m][0] - c1v[1][0] * mu) * rs + c2v[1][0], u1 = (acc[ai][1][m][1] - c1v[1][1] * mu) * rs + c2v[1][1];
                u32x4 w;
                w.x = cvt_pk_bf16(silu_mul(g0[0], u0[0]), silu_mul(g0[1], u0[1])); w.y = cvt_pk_bf16(silu_mul(g0[2], u0[2]), silu_mul(g0[3], u0[3]));
                w.z = cvt_pk_bf16(silu_mul(g1[0], u1[0]), silu_mul(g1[1], u1[1])); w.w = cvt_pk_bf16(silu_mul(g1[2], u1[2]), silu_mul(g1[3], u1[3]));
                *(u32x4*)rowp = w; }
    }
};
constexpr size_t EPI_WS_XB = (size_t)166 << 20, EPI_WS_STATS = ((size_t)568 << 20) + ((size_t)1 << 20); constexpr int EPI_T = 32768;
template <bool HAS_LN> struct EpiResidLN {
    static constexpr bool PERM = false, AFTER_DRAIN = false;
    static constexpr int ld = 1024;
    const float* src; float* dst; unsigned char* ws; const float* g_in; const float* b_in; int s_in; float alpha, beta;
    __device__ __forceinline__ void operator()(const f32x4 (&acc)[2][2][4][2], const Unit& u, int wr, int wc, int fr, int fq) const {
        int col0 = u.pn * BM + wc * 32 + 4 * fq; int rowb = u.pm * BM + wr * 64 + fr;
        asm volatile("" : "+v"(col0), "+v"(rowb));
        const float* rd = HAS_LN ? (const float*)dst : src;
        bf16_t* yb = (bf16_t*)(ws + EPI_WS_XB);
        const float* st_in = (const float*)(ws + EPI_WS_STATS) + (size_t)s_in * EPI_T * 2; float* st_out = (float*)(ws + EPI_WS_STATS) + (size_t)(s_in + 1) * EPI_T * 2;
        f32x4 gv[2][2], bv[2][2];
#pragma unroll
        for (int bj = 0; bj < 2; ++bj)
#pragma unroll
            for (int n = 0; n < 2; ++n) { if (HAS_LN) { gv[bj][n] = *(const f32x4*)(g_in + col0 + bj * HALF + n * 16); bv[bj][n] = *(const f32x4*)(b_in + col0 + bj * HALF + n * 16); }
                                          else { gv[bj][n] = (f32x4){1.f, 1.f, 1.f, 1.f}; bv[bj][n] = (f32x4){0.f, 0.f, 0.f, 0.f}; } }
#pragma unroll
        for (int ai = 0; ai < 2; ++ai)
#pragma unroll
            for (int m = 0; m < 4; ++m) { const int row = rowb + ai * HALF + m * 16; const size_t off = (size_t)row * ld + col0;
                float mu, rs; ln_row_stats<HAS_LN>(st_in, row, mu, rs);
                float ps = 0.f, pq = 0.f;
#pragma unroll
                for (int bj = 0; bj < 2; ++bj)
#pragma unroll
                    for (int n = 0; n < 2; ++n) { const f32x4 y = *(const f32x4*)(rd + off + bj * HALF + n * 16);
                        const f32x4 x = HAS_LN ? (y - mu) * rs * gv[bj][n] + bv[bj][n] : y;
                        const f32x4 yn = x * alpha + acc[ai][bj][m][n] * beta;
                        *(f32x4*)(dst + off + bj * HALF + n * 16) = yn;
                        u32x2 w; w.x = cvt_pk_bf16(yn[0], yn[1]); w.y = cvt_pk_bf16(yn[2], yn[3]); *(u32x2*)(yb + off + bj * HALF + n * 16) = w;
                        ps += (yn[0] + yn[1]) + (yn[2] + yn[3]); pq += (yn[0] * yn[0] + yn[1] * yn[1]) + (yn[2] * yn[2] + yn[3] * yn[3]); }
                ps += __shfl_xor(ps, 16); ps += __shfl_xor(ps, 32); pq += __shfl_xor(pq, 16); pq += __shfl_xor(pq, 32);
                if (fq == 0) { atomicAdd(st_out + 2 * (size_t)row, ps); atomicAdd(st_out + 2 * (size_t)row + 1, pq); } }
    }
};
template <class Epi, class Sched, bool ALIGN_EPI = false, bool SP2 = false>
__device__ __forceinline__ void gemm_phase(PG8_LAS unsigned char* lds, const Gemm g, const Sched S, const Epi E) {
    int tid_ = threadIdx.x; asm volatile("" : "+v"(tid_));
    const int tid = tid_, wid = __builtin_amdgcn_readfirstlane(tid >> 6), lane = tid & 63, wr = wid >> 2, wc = wid & 3, fr = lane & 15, fq = lane >> 4;
    const int K = g.K, nt = K / BK;
    unsigned voffA[2], voffB[2];
#pragma unroll
    for (int i = 0; i < 2; ++i) { int R, C; stage_rc(tid * 16 + i * 8192, R, C); const int Rb = Epi::PERM ? ((R & ~31) + perm32(R & 31)) : R;
        voffA[i] = (unsigned)(R * K + C) * 2u; voffB[i] = (unsigned)(Rb * K + C) * 2u; }
    const size_t kstep = (size_t)(BK * 2);
    const size_t hstep = (size_t)HALF * K * 2;
    const size_t tstep = 2 * hstep;
    const unsigned ldsw = (unsigned)wid * 1024u;
    const int aoff = lds_byte(wr * 64 + fr, fq * 8), boff = lds_byte(wc * 32 + fr, fq * 8);
#define PG8_SA(b, h) (((b) * 2 + (h)) * HTB)
#define PG8_SB(b, h) ((4 + (b) * 2 + (h)) * HTB)
#define PG8_STAGE(bufoff, gbase, voff) do { _Pragma("unroll") for (int _i = 0; _i < 2; ++_i) \
        __builtin_amdgcn_global_load_lds((const unsigned*)((const char*)(gbase) + (voff)[_i]), (PG8_LAS unsigned*)(lds + (bufoff) + ldsw + _i * 8192), 16, 0, 0); } while (0)
#define PG8_LDA(dst, b, h) do { _Pragma("unroll") for (int m = 0; m < 4; ++m) _Pragma("unroll") for (int k = 0; k < 2; ++k) dst[m][k] = *(const PG8_LAS bf16x8*)(lds + PG8_SA(b, h) + aoff + m * 2048 + k * 1024); } while (0)
#define PG8_LDB(dst, b, h) do { _Pragma("unroll") for (int n = 0; n < 2; ++n) _Pragma("unroll") for (int k = 0; k < 2; ++k) dst[n][k] = *(const PG8_LAS bf16x8*)(lds + PG8_SB(b, h) + boff + n * 2048 + k * 1024); } while (0)
#define PG8_MMA(ai, bj, At, Bt) do { __builtin_amdgcn_s_setprio(1); _Pragma("unroll") for (int m = 0; m < 4; ++m) _Pragma("unroll") for (int n = 0; n < 2; ++n) _Pragma("unroll") for (int k = 0; k < 2; ++k) \
        acc[ai][bj][m][n] = __builtin_amdgcn_mfma_f32_16x16x32_bf16(Bt[n][k], At[m][k], acc[ai][bj][m][n], 0, 0, 0); __builtin_amdgcn_s_setprio(0); } while (0)
#define PG8_WAIT_V(n) asm volatile("s_waitcnt vmcnt(" #n ")" ::: "memory")
#define PG8_WAIT_L(n) asm volatile("s_waitcnt lgkmcnt(" #n ")" ::: "memory")
#define PG8_BAR __builtin_amdgcn_s_barrier()
#define PG8_SCHED __builtin_amdgcn_sched_barrier(0)
    Unit cur, nxt; int ui = 0;
    if (!S.next(0, cur)) return;
    f32x4 acc[2][2][4][2];
#pragma unroll
    for (int a = 0; a < 2; ++a)
#pragma unroll
        for (int b = 0; b < 2; ++b)
#pragma unroll
            for (int m = 0; m < 4; ++m)
#pragma unroll
                for (int n = 0; n < 2; ++n) acc[a][b][m][n] = (f32x4){0.f, 0.f, 0.f, 0.f};
    bf16x8 At[4][2], B0[2][2], B1[2][2];
    const char* cA = (const char*)g.A + (size_t)cur.pm * tstep; const char* cB = (const char*)g.Bt + (size_t)cur.pn * tstep;
    S.a_ready(cur);
    if constexpr (SP2) {
        PG8_STAGE(PG8_SB(0, 0), cB, voffB); PG8_STAGE(PG8_SB(0, 1), cB + hstep, voffB); PG8_STAGE(PG8_SA(0, 0), cA, voffA); PG8_STAGE(PG8_SA(0, 1), cA + hstep, voffA);
        if (wr == 1) PG8_BAR;
        PG8_WAIT_V(2); PG8_BAR;
        PG8_STAGE(PG8_SB(1, 0), cB + kstep, voffB); PG8_STAGE(PG8_SA(1, 0), cA + kstep, voffA); PG8_STAGE(PG8_SB(1, 1), cB + hstep + kstep, voffB);
        PG8_WAIT_V(6); PG8_BAR;
    } else {
        PG8_STAGE(PG8_SB(0, 0), cB, voffB); PG8_STAGE(PG8_SA(0, 0), cA, voffA); PG8_STAGE(PG8_SB(0, 1), cB + hstep, voffB); PG8_STAGE(PG8_SA(0, 1), cA + hstep, voffA);
        if (wr == 1) PG8_BAR;
        PG8_WAIT_V(4); PG8_BAR;
        PG8_STAGE(PG8_SB(1, 0), cB + kstep, voffB); PG8_STAGE(PG8_SA(1, 0), cA + kstep, voffA); PG8_STAGE(PG8_SB(1, 1), cB + hstep + kstep, voffB);
        PG8_WAIT_V(6); PG8_BAR;
    }
    for (;;) {
        const bool has_next = S.next(ui + 1, nxt);
        const char* nA = has_next ? (const char*)g.A + (size_t)nxt.pm * tstep : cA; const char* nB = has_next ? (const char*)g.Bt + (size_t)nxt.pn * tstep : cB;
        for (int t = 0; t < nt; t += 2) {
            const bool last = (t == nt - 2);
            const char* a1 = cA + (size_t)(t + 1) * kstep;
            const char* a2 = last ? nA : cA + (size_t)(t + 2) * kstep; const char* b2 = last ? nB : cB + (size_t)(t + 2) * kstep;
            const char* a3 = a2 + kstep; const char* b3 = b2 + kstep;
            if (last && has_next) S.a_ready(nxt);
            if constexpr (SP2) {
            PG8_LDB(B0, 0, 0); PG8_LDB(B1, 0, 1); PG8_SCHED; PG8_LDA(At, 0, 0); PG8_STAGE(PG8_SA(1, 1), a1 + hstep, voffA);
            PG8_WAIT_V(8); PG8_WAIT_L(0); PG8_BAR; PG8_MMA(0, 0, At, B0); PG8_MMA(0, 1, At, B1); PG8_BAR; PG8_SCHED;
            PG8_LDA(At, 0, 1); PG8_STAGE(PG8_SB(0, 0), b2, voffB); PG8_STAGE(PG8_SB(0, 1), b2 + hstep, voffB); PG8_STAGE(PG8_SA(0, 0), a2, voffA);
            PG8_WAIT_V(8); PG8_WAIT_L(0); PG8_BAR; PG8_MMA(1, 0, At, B0); PG8_MMA(1, 1, At, B1); PG8_BAR; PG8_SCHED;
            PG8_LDB(B0, 1, 0); PG8_LDB(B1, 1, 1); PG8_SCHED; PG8_LDA(At, 1, 0); PG8_STAGE(PG8_SA(0, 1), a2 + hstep, voffA);
            PG8_WAIT_V(8); PG8_WAIT_L(0); PG8_BAR; PG8_MMA(0, 0, At, B0); PG8_MMA(0, 1, At, B1); PG8_BAR; PG8_SCHED;
            PG8_LDA(At, 1, 1); PG8_STAGE(PG8_SB(1, 0), b3, voffB); PG8_STAGE(PG8_SB(1, 1), b3 + hstep, voffB); PG8_STAGE(PG8_SA(1, 0), a3, voffA);
            PG8_WAIT_V(8); PG8_WAIT_L(0); PG8_BAR; PG8_MMA(1, 0, At, B0); PG8_MMA(1, 1, At, B1); PG8_BAR; PG8_SCHED;
            } else {
            PG8_LDB(B0, 0, 0); PG8_SCHED; PG8_LDA(At, 0, 0); PG8_STAGE(PG8_SA(1, 1), a1 + hstep, voffA);
            PG8_WAIT_L(8); PG8_BAR; PG8_WAIT_L(0); PG8_MMA(0, 0, At, B0); PG8_BAR; PG8_SCHED;
            PG8_LDB(B1, 0, 1); PG8_STAGE(PG8_SB(0, 0), b2, voffB);
            PG8_BAR; PG8_WAIT_L(0); PG8_MMA(0, 1, At, B1); PG8_BAR;
            PG8_LDA(At, 0, 1); PG8_STAGE(PG8_SA(0, 0), a2, voffA);
            PG8_BAR; PG8_WAIT_L(0); PG8_MMA(1, 0, At, B0); PG8_BAR; PG8_SCHED;
            PG8_STAGE(PG8_SB(0, 1), b2 + hstep, voffB);
            PG8_WAIT_V(6); PG8_BAR; PG8_MMA(1, 1, At, B1); PG8_BAR;
            PG8_LDB(B0, 1, 0); PG8_SCHED; PG8_LDA(At, 1, 0); PG8_STAGE(PG8_SA(0, 1), a2 + hstep, voffA);
            PG8_WAIT_L(8); PG8_BAR; PG8_WAIT_L(0); PG8_MMA(0, 0, At, B0); PG8_BAR; PG8_SCHED;
            PG8_LDB(B1, 1, 1); PG8_STAGE(PG8_SB(1, 0), b3, voffB);
            PG8_BAR; PG8_WAIT_L(0); PG8_MMA(0, 1, At, B1); PG8_BAR;
            PG8_LDA(At, 1, 1); PG8_STAGE(PG8_SA(1, 0), a3, voffA);
            PG8_BAR; PG8_WAIT_L(0); PG8_MMA(1, 0, At, B0); PG8_BAR; PG8_SCHED;
            PG8_STAGE(PG8_SB(1, 1), b3 + hstep, voffB);
            PG8_WAIT_V(6); PG8_BAR; PG8_MMA(1, 1, At, B1); PG8_BAR;
            }
        }
        if constexpr (ALIGN_EPI) { if (wr == 0) PG8_BAR; }
        if constexpr (!Epi::AFTER_DRAIN) { E(acc, cur, wr, wc, fr, fq); S.done(cur); }
        if (!has_next) break;
#pragma unroll
        for (int a = 0; a < 2; ++a)
#pragma unroll
            for (int b = 0; b < 2; ++b)
#pragma unroll
                for (int m = 0; m < 4; ++m)
#pragma unroll
                    for (int n = 0; n < 2; ++n) acc[a][b][m][n] = (f32x4){0.f, 0.f, 0.f, 0.f};
        cur = nxt; cA = nA; cB = nB; ++ui;
        if constexpr (ALIGN_EPI) { if (wr == 1) PG8_BAR; }
    }
    PG8_WAIT_V(0);
    if constexpr (!ALIGN_EPI) { if (wr == 0) PG8_BAR; }
    PG8_BAR;
    if constexpr (Epi::AFTER_DRAIN) { E.fused(acc, cur, wr, wc, fr, fq, lds, wid, lane); S.done(cur); }
#undef PG8_SA
#undef PG8_SB
#undef PG8_STAGE
#undef PG8_LDA
#undef PG8_LDB
#undef PG8_MMA
#undef PG8_WAIT_V
#undef PG8_WAIT_L
#undef PG8_BAR
#undef PG8_SCHED
}
}
#define LAS __attribute__((address_space(3)))
typedef unsigned short bf16_t;
typedef short bf16x8 __attribute__((ext_vector_type(8)));
typedef short s16x4 __attribute__((ext_vector_type(4)));
typedef float f32x4 __attribute__((ext_vector_type(4)));
typedef float f32x16 __attribute__((ext_vector_type(16)));
typedef unsigned u32x4 __attribute__((ext_vector_type(4)));
typedef unsigned u32x2 __attribute__((ext_vector_type(2)));
typedef float f32x2_t __attribute__((ext_vector_type(2)));
typedef __bf16 bf16x2_t __attribute__((ext_vector_type(2)));

constexpr int NB = 2, SEQ = 16384, T = NB * SEQ, DM = 1024, DEPTH = 4, DFF = 2816, NGU = 2 * DFF;
constexpr int NIN_SRC = 2208, NPROJ = 3328;
constexpr int PA = 0, PC = 512, PD = 1024, PCQ = 1792, PCKV = 2048, PKR = 2176, PQUP = 2208, PKVUP = 2592, PEND = 3104;
constexpr float LOG2E = 1.4426950408889634f;
constexpr float NORM_EPS = 1e-5f;
constexpr int NWAVES = 8, NTHREADS = 512;
constexpr int LDS_BYTES = 147456;

constexpr size_t MiB = 1u << 20;
constexpr size_t WS_WGU = 0, WS_WD = 88 * MiB, WS_WIN = 132 * MiB, WS_WOUT = 158 * MiB, WS_XB = 166 * MiB;
constexpr size_t WS_H = 230 * MiB, WS_PROJ = 230 * MiB, WS_QB = 438 * MiB, WS_KB = 462 * MiB, WS_VB = 486 * MiB, WS_MIX = 502 * MiB, WS_AUG = 566 * MiB, WS_CTL = 568 * MiB, WS_KMAX = WS_CTL, WS_C12 = WS_CTL + 4096, WS_BAR = WS_CTL + 512 * 1024, WS_STATS = WS_CTL + 1 * MiB, CTL_BYTES = 4 * MiB, WS_END = 572 * MiB;
constexpr int C12_L = 2 * NGU + NPROJ;
constexpr size_t C2_OFF = (size_t)DEPTH * C12_L;
static_assert(pg8::EPI_WS_XB == WS_XB && pg8::EPI_WS_STATS == WS_STATS && pg8::EPI_T == T, "part1's copies of the workspace map");
static_assert(WS_C12 + 2 * C2_OFF * 4 <= WS_BAR && WS_BAR + 3456 * 4 <= WS_STATS, "control region");
static_assert(WS_C12 + 2 * C2_OFF * 4 <= WS_STATS && WS_STATS + (size_t)12 * T * 8 <= WS_CTL + CTL_BYTES, "control region");
constexpr size_t WGU_L = (size_t)2 * NGU * DM, WGU_F = (size_t)NGU * DM;
constexpr size_t WD_L = (size_t)2 * DM * DFF, WD_F = (size_t)DM * DFF;
constexpr size_t WIN_L = (size_t)NPROJ * DM, WOUT_L = (size_t)DM * DM;

struct Params {
    const float* x; const float* w_in; const float* win_sink; const float* mla_q_norm; const float* mla_w_uq; const float* mla_kv_norm; const float* mla_w_ukv;
    const float* ax_q_norm; const float* ax_k_norm; const float* diff_lambda; const float* diff_subln; const float* w_out; const float* ffn_w_gu; const float* ffn_w_down;
    const float* ln_g; const float* ln_b;
    float* out; unsigned char* ws;
    float lam_init[4];
    float inv32[16];
};

typedef const __attribute__((address_space(4))) Params* KP;
#define GETP(name) KP name = (KP)__builtin_amdgcn_kernarg_segment_ptr(); asm volatile("" : "+s"(name))

__device__ __forceinline__ int tid_fresh() { int t = threadIdx.x; asm volatile("" : "+v"(t)); return t; }
__device__ __forceinline__ unsigned pkbf(float lo, float hi) { f32x2_t v = {lo, hi}; bf16x2_t b = __builtin_convertvector(v, bf16x2_t); return __builtin_bit_cast(unsigned, b); }
__device__ __forceinline__ float bflo(unsigned w) { return __builtin_bit_cast(float, w << 16); }
__device__ __forceinline__ float bfhi(unsigned w) { return __builtin_bit_cast(float, w & 0xffff0000u); }
__device__ __forceinline__ float wave_sum(float v) {
#pragma unroll
    for (int o = 1; o < 64; o <<= 1) v += __shfl_xor(v, o);
    return v;
}
__device__ __forceinline__ void unpack8(const u32x4 w, float (&v)[8]) {
    v[0] = bflo(w.x); v[1] = bfhi(w.x); v[2] = bflo(w.y); v[3] = bfhi(w.y); v[4] = bflo(w.z); v[5] = bfhi(w.z); v[6] = bflo(w.w); v[7] = bfhi(w.w);
}
__device__ __forceinline__ u32x4 pack8(const float (&v)[8]) { u32x4 w; w.x = pkbf(v[0], v[1]); w.y = pkbf(v[2], v[3]); w.z = pkbf(v[4], v[5]); w.w = pkbf(v[6], v[7]); return w; }

__device__ __forceinline__ void transpose_item(const float* __restrict__ W, int ldw, int src_col0, float scale, bf16_t* __restrict__ WT, int K, int dst_row0, int k0, LAS float* scr, int lane,
                                               const float* __restrict__ lng, const float* __restrict__ lnb, float* c1, float* c2) {
    if (src_col0 < 0) {
        const int c = lane & 7;
#pragma unroll
        for (int j = 0; j < 4; ++j) { const int n = (lane >> 3) + 8 * j; *(u32x4*)(WT + (size_t)(dst_row0 + n) * K + k0 + 8 * c) = (u32x4){0u, 0u, 0u, 0u}; }
        return;
    }
    float a1 = 0.f, a2 = 0.f;
#pragma unroll
    for (int i = 0; i < 32; ++i) { const int kk = 2 * i + (lane >> 5); float w = W[(size_t)(k0 + kk) * ldw + src_col0 + (lane & 31)] * scale;
        if (lng) { a2 = fmaf(lnb[k0 + kk], w, a2); w *= lng[k0 + kk]; a1 += bflo(pkbf(w, 0.f)); }
        scr[kk * 33 + (lane & 31)] = w; }
    asm volatile("s_waitcnt lgkmcnt(0)" ::: "memory");
    const int c = lane & 7;
#pragma unroll
    for (int j = 0; j < 4; ++j) { const int n = (lane >> 3) + 8 * j; const LAS float* s = scr + (8 * c) * 33 + n;
        u32x4 o; o.x = pkbf(s[0 * 33], s[1 * 33]); o.y = pkbf(s[2 * 33], s[3 * 33]); o.z = pkbf(s[4 * 33], s[5 * 33]); o.w = pkbf(s[6 * 33], s[7 * 33]);
        *(u32x4*)(WT + (size_t)(dst_row0 + n) * K + k0 + 8 * c) = o; }
    asm volatile("s_waitcnt lgkmcnt(0)" ::: "memory");
    if (lng) { a1 += __shfl_xor(a1, 32); a2 += __shfl_xor(a2, 32);
        if (lane < 32) { atomicAdd(c1 + dst_row0 + lane, a1); atomicAdd(c2 + dst_row0 + lane, a2); } }
}

__device__ __forceinline__ void phase0(KP p, LAS unsigned char* lds, int vcu, int G) {
    const int tid = tid_fresh(), lane = tid & 63, wave = __builtin_amdgcn_readfirstlane(tid >> 6);
    LAS float* scr = (LAS float*)(lds + wave * 16384);
    const int gw = vcu * NWAVES + wave, NGW = G * NWAVES;
    bf16_t* wgu = (bf16_t*)(p->ws + WS_WGU); bf16_t* wd = (bf16_t*)(p->ws + WS_WD); bf16_t* win = (bf16_t*)(p->ws + WS_WIN); bf16_t* wout = (bf16_t*)(p->ws + WS_WOUT);
    float* c12 = (float*)(p->ws + WS_C12);
    constexpr int I_GU = 176 * 16, I_WD = 32 * 44, I_IN = 104 * 16, I_OUT = 32 * 16, I_CMP = 128 * 14;
    constexpr int I_LAYER = 2 * I_GU + 2 * I_WD + I_IN + I_OUT + I_CMP;
    for (int it = gw; it < DEPTH * I_LAYER; it += NGW) {
        const int l = it / I_LAYER; int r = it % I_LAYER;
        if (r < 2 * I_GU) { const int f = r / I_GU; r %= I_GU; const int nb = r / 16, kb = r % 16; const int n0 = 32 * nb;
            const int pn = n0 >> 8, bj = (n0 >> 7) & 1, i0 = n0 & 127;
            const int s = 3 * l + 2 * f - 1;
            transpose_item(p->ffn_w_gu + ((size_t)l * 2 + f) * DM * NGU, NGU, bj * DFF + 128 * pn + i0, 1.f, wgu + l * WGU_L + f * WGU_F, DM, n0, 64 * kb, scr, lane,
                           s >= 0 ? p->ln_g + s * DM : nullptr, s >= 0 ? p->ln_b + s * DM : nullptr, c12 + l * C12_L + f * NGU, c12 + C2_OFF + l * C12_L + f * NGU); continue; }
        r -= 2 * I_GU;
        if (r < 2 * I_WD) { const int f = r / I_WD; r %= I_WD; const int nb = r / 44, kb = r % 44;
            transpose_item(p->ffn_w_down + ((size_t)l * 2 + f) * DFF * DM, DM, 32 * nb, 1.f, wd + l * WD_L + f * WD_F, DFF, 32 * nb, 64 * kb, scr, lane, nullptr, nullptr, nullptr, nullptr); continue; }
        r -= 2 * I_WD;
        if (r < I_IN) { const int nb = r / 16, kb = r % 16; const int n0 = 32 * nb; int src; float sc = 1.f;
            if (n0 < PC) { src = n0; if (n0 < 256) sc = 0.125f; }
            else if (n0 < PD) src = 928 + (n0 - PC);
            else if (n0 < PCQ) { src = 1440 + (n0 - PD); if (n0 - PD < 256) sc = 0.17677669529663687f; }
            else if (n0 < PCKV) src = 512 + (n0 - PCQ);
            else if (n0 < PKR) src = 768 + (n0 - PCKV);
            else if (n0 < PQUP) src = 896;
            else if (n0 < PEND) continue;
            else src = -1;
            transpose_item(p->w_in + (size_t)l * DM * NIN_SRC, NIN_SRC, src, sc, win + l * WIN_L, DM, n0, 64 * kb, scr, lane,
                           p->ln_g + (3 * l) * DM, p->ln_b + (3 * l) * DM, c12 + l * C12_L + 2 * NGU, c12 + C2_OFF + l * C12_L + 2 * NGU); continue; }
        r -= I_IN;
        if (r < I_OUT) { const int nb = r / 16, kb = r % 16;
            transpose_item(p->w_out + (size_t)l * DM * DM, DM, 32 * nb, 1.f, wout + l * WOUT_L, DM, 32 * nb, 64 * kb, scr, lane, nullptr, nullptr, nullptr, nullptr); continue; }
        r -= I_OUT;
        {
            const int kb8 = r / 14, ng = r % 14; const int k0 = 8 * kb8;
            int J, cA, ldu, nc; const float* g; const float* U;
            if (ng < 6) { J = 256; cA = 512; g = p->mla_q_norm + l * 256; U = p->mla_w_uq + (size_t)l * 256 * 384; ldu = 384; nc = 64 * ng; }
            else { J = 128; cA = 768; g = p->mla_kv_norm + l * 128; U = p->mla_w_ukv + (size_t)l * 128 * 512; ldu = 512; nc = 64 * (ng - 6); }
            const int nglob = (ng < 6 ? 0 : 384) + nc + lane;
            const float* a = p->w_in + (size_t)l * DM * NIN_SRC + (size_t)k0 * NIN_SRC + cA;
            const float* up = U + nc + lane;
            float acc[8];
#pragma unroll
            for (int e = 0; e < 8; ++e) acc[e] = 0.f;
#pragma unroll 4
            for (int j = 0; j < J; ++j) { const float u = up[(size_t)j * ldu] * g[j];
#pragma unroll
                for (int e = 0; e < 8; ++e) acc[e] = fmaf(a[(size_t)e * NIN_SRC + j], u, acc[e]); }
            const float* lg = p->ln_g + (3 * l) * DM + k0; const float* lb = p->ln_b + (3 * l) * DM + k0;
            float s1 = 0.f, s2 = 0.f; unsigned wb[8];
#pragma unroll
            for (int e = 0; e < 8; ++e) { wb[e] = pkbf(acc[e] * lg[e], 0.f) & 0xffffu; s1 += bflo(wb[e]); s2 = fmaf(acc[e], lb[e], s2); }
            u32x4 o; o.x = wb[0] | (wb[1] << 16); o.y = wb[2] | (wb[3] << 16); o.z = wb[4] | (wb[5] << 16); o.w = wb[6] | (wb[7] << 16);
            *(u32x4*)(win + l * WIN_L + (size_t)(PQUP + nglob) * DM + k0) = o;
            atomicAdd(c12 + l * C12_L + 2 * NGU + PQUP + nglob, s1); atomicAdd(c12 + C2_OFF + l * C12_L + 2 * NGU + PQUP + nglob, s2);
        }
    }
    { u32x4* ag = (u32x4*)(p->ws + WS_AUG);
      for (int i = (vcu * NWAVES + wave) * 64 + lane; i < SEQ * 4; i += G * NWAVES * 64) { const int t = i >> 2, h = i & 3;
          const float sl = __builtin_amdgcn_exp2f(-(float)(5 + h));
          u32x4 w = {pkbf(sl * (float)(128 * (t >> 7)), sl * (float)(t & 127)), 0u, 0u, 0u}; ag[2 * i] = w; ag[2 * i + 1] = (u32x4){0u, 0u, 0u, 0u}; } }
    bf16_t* xb = (bf16_t*)(p->ws + WS_XB);
    for (int m = gw; m < T; m += NGW) {
        const f32x4* xr = (const f32x4*)(p->x + (size_t)m * DM) + lane; u32x2* o8 = (u32x2*)(xb + (size_t)m * DM) + lane;
#pragma unroll
        for (int j = 0; j < 4; ++j) { const f32x4 v = xr[64 * j]; u32x2 w; w.x = pkbf(v.x, v.y); w.y = pkbf(v.z, v.w); o8[64 * j] = w; }
    }
}

__device__ __forceinline__ void ln_phase(float* X, bf16_t* xb, const float* __restrict__ g, const float* __restrict__ b, int vcu, int G) {
    const int tid = tid_fresh(), lane = tid & 63, wave = __builtin_amdgcn_readfirstlane(tid >> 6);
    const int gw = vcu * NWAVES + wave, NGW = G * NWAVES;
    f32x4 gv[4], bv[4];
#pragma unroll
    for (int j = 0; j < 4; ++j) { gv[j] = ((const f32x4*)g)[64 * j + lane]; bv[j] = ((const f32x4*)b)[64 * j + lane]; }
    for (int m = gw; m < T; m += NGW) {
        f32x4* xr = (f32x4*)(X + (size_t)m * DM) + lane; u32x2* o8 = (u32x2*)(xb + (size_t)m * DM) + lane;
        f32x4 v[4]; float s = 0.f;
#pragma unroll
        for (int j = 0; j < 4; ++j) { v[j] = xr[64 * j]; s += (v[j].x + v[j].y) + (v[j].z + v[j].w); }
        const float mean = wave_sum(s) * (1.f / DM); float s2 = 0.f;
#pragma unroll
        for (int j = 0; j < 4; ++j) { v[j] = v[j] - mean; s2 += (v[j].x * v[j].x + v[j].y * v[j].y) + (v[j].z * v[j].z + v[j].w * v[j].w); }
        const float rstd = 1.f / sqrtf(wave_sum(s2) * (1.f / DM) + NORM_EPS);
#pragma unroll
        for (int j = 0; j < 4; ++j) { const f32x4 y = v[j] * rstd * gv[j] + bv[j]; xr[64 * j] = y; u32x2 w; w.x = pkbf(y.x, y.y); w.y = pkbf(y.z, y.w); o8[64 * j] = w; }
    }
}

__device__ __forceinline__ void sincos_rev(float ang, float& s, float& c) {
    double d = (double)ang * 0.15915494309189535; d -= __builtin_rint(d); const float f = (float)d;
    s = __builtin_amdgcn_sinf(f); c = __builtin_amdgcn_cosf(f);
}
__device__ __forceinline__ void rope8(float (&v)[8], bool first, float pos, int i0, KP p) {
#pragma unroll
    for (int e = 0; e < 8; ++e) {
        const float other = __shfl_xor(v[e], 2);
        const float inv = i0 ? p->inv32[8 + e] : p->inv32[e];
        float s, c; sincos_rev(pos * inv, s, c);
        v[e] = first ? (v[e] * c - other * s) : (other * s + v[e] * c);
    }
}
__device__ __forceinline__ void prep_phase(KP p, int l, int vcu, int G) {
    const int tid = tid_fresh(), lane = tid & 63, wave = __builtin_amdgcn_readfirstlane(tid >> 6);
    const int gw = vcu * NWAVES + wave, NGW = G * NWAVES;
    bf16_t* proj = (bf16_t*)(p->ws + WS_PROJ); bf16_t* qb = (bf16_t*)(p->ws + WS_QB); bf16_t* kb = (bf16_t*)(p->ws + WS_KB); bf16_t* vb = (bf16_t*)(p->ws + WS_VB);
    float cg[8];
    { const float* gsrc = (lane < 32 ? p->ax_q_norm : p->ax_k_norm) + l * 64 + 8 * (lane & 7);
#pragma unroll
      for (int e = 0; e < 8; ++e) cg[e] = gsrc[e]; }
    float km0 = 0.f, km1 = 0.f;
    for (int tok = gw; tok < T; tok += NGW) {
        const int t = tok & (SEQ - 1);
        bf16_t* pr = proj + (size_t)tok * NPROJ;
        const int l48 = lane < 48 ? lane : 0, l32 = lane < 32 ? lane : 0, l4 = lane < 4 ? lane : 0;
        const u32x4 in_cq = *(const u32x4*)(pr + PCQ + 8 * l48), in_qup = *(const u32x4*)(pr + PQUP + 8 * l48), in_kv = *(const u32x4*)(pr + PKVUP + 8 * lane);
        const u32x4 in_kr = *(const u32x4*)(pr + PKR + 8 * l4), in_c = *(const u32x4*)(pr + PC + 8 * l48), in_dk = *(const u32x4*)(pr + PD + 256 + 8 * l32);
        { float s = 0.f;
          if (lane < 32) { float v[8]; unpack8(in_dk, v);
#pragma unroll
              for (int e = 0; e < 8; ++e) s += v[e] * v[e]; }
          s += __shfl_xor(s, 1); s += __shfl_xor(s, 2);
          if (tok < SEQ) km0 = fmaxf(km0, s); else km1 = fmaxf(km1, s); }
        float ssq = 0.f;
        if (lane < 48) { float v[8]; unpack8(in_cq, v);
#pragma unroll
            for (int e = 0; e < 8; ++e) ssq += v[e] * v[e]; }
        const float ssq_q = wave_sum(lane < 32 ? ssq : 0.f), ssq_kv = wave_sum(lane >= 32 ? ssq : 0.f);
        const float rstd_q = 1.f / sqrtf(ssq_q * (1.f / 256.f) + NORM_EPS), rstd_kv = 1.f / sqrtf(ssq_kv * (1.f / 128.f) + NORM_EPS);
        {
            const int r = lane % 12; float v[8];
            unpack8(in_qup, v);
#pragma unroll
            for (int e = 0; e < 8; ++e) v[e] = (lane < 48) ? v[e] * rstd_q : 0.f;
            float w[8];
#pragma unroll
            for (int e = 0; e < 8; ++e) w[e] = v[e];
            rope8(w, r < 10, (float)t, 8 * (r & 1), p);
            const bool isr = (r >= 8); const float qs = 0.10206207261596575f;
#pragma unroll
            for (int e = 0; e < 8; ++e) v[e] = (isr ? w[e] : v[e]) * qs;
            if (lane < 48) *(u32x4*)(qb + (size_t)tok * 384 + 8 * lane) = pack8(v);
        }
        {
            float v[8]; unpack8(in_kv, v);
#pragma unroll
            for (int e = 0; e < 8; ++e) v[e] *= rstd_kv;
            const int hd = lane >> 4, r = lane & 15;
            if (r < 8) *(u32x4*)(kb + (size_t)tok * 384 + hd * 96 + 8 * r) = pack8(v);
            else *(u32x4*)(vb + (size_t)tok * 256 + hd * 64 + 8 * (r - 8)) = pack8(v);
        }
        {
            float v[8]; unpack8(in_kr, v);
            rope8(v, (lane & 3) < 2, (float)t, 8 * (lane & 1), p);
            if (lane < 4) { const u32x4 w = pack8(v);
#pragma unroll
                for (int hd = 0; hd < 4; ++hd) *(u32x4*)(kb + (size_t)tok * 384 + hd * 96 + 64 + 8 * lane) = w; }
        }
        {
            float v[8]; unpack8(in_c, v);
            float s = 0.f;
#pragma unroll
            for (int e = 0; e < 8; ++e) s += v[e] * v[e];
            s += __shfl_xor(s, 1); s += __shfl_xor(s, 2); s += __shfl_xor(s, 4);
            const float rs = 1.f / sqrtf(s * (1.f / 64.f) + NORM_EPS);
#pragma unroll
            for (int e = 0; e < 8; ++e) v[e] = v[e] * rs * cg[e];
            const int r = lane & 7; const float pos = (r < 4) ? (float)(t >> 6) : (float)(t & 63);
            rope8(v, (r & 3) < 2, pos, 8 * (r & 1), p);
            if (lane < 32) {
#pragma unroll
                for (int e = 0; e < 8; ++e) v[e] *= 0.125f; }
            if (lane < 48) *(u32x4*)(pr + PC + 8 * lane) = pack8(v);
        }
    }
    if (lane < 32 && (lane & 3) == 0) { unsigned* km = (unsigned*)(p->ws + WS_KMAX) + l * 16 + (lane >> 2);
        atomicMax(km, __builtin_bit_cast(unsigned, km0)); atomicMax(km + 8, __builtin_bit_cast(unsigned, km1)); }
}

#ifndef ATT_TYPES
#define ATT_TYPES 15
#endif
namespace att {
typedef float f32x2 __attribute__((ext_vector_type(2)));
constexpr int VPITCH = 144, KBUF = 64 * 208, VBUF = 64 * VPITCH;
constexpr int ATT_LDS = 2 * KBUF + 2 * VBUF;
constexpr float RESCALE_T = 5.0f;
__device__ __forceinline__ s16x4 vtr(const LAS char* p) { return __builtin_bit_cast(s16x4, __builtin_amdgcn_ds_read_tr16_b64_v4i16((LAS s16x4*)p)); }
__device__ __forceinline__ void xhalf_swap(float m, float& a, float& b) {
    a = m; b = m;
    asm volatile("s_nop 1\n\tv_permlane32_swap_b32 %0, %1\n\ts_nop 1" : "+v"(a), "+v"(b));
}
__device__ __forceinline__ float xhalf_max(float m) { float a, b; xhalf_swap(m, a, b); return fmaxf(a, b); }
__device__ __forceinline__ float xhalf_sum(float m) { float a, b; xhalf_swap(m, a, b); return a + b; }
__device__ __forceinline__ float max3f(float a, float b, float c) { return fmaxf(fmaxf(a, b), c); }
__device__ __forceinline__ float fma_s(float a, float b, float c) { float r; asm("v_fma_f32 %0, %1, %2, %3" : "=v"(r) : "v"(a), "s"(b), "v"(c)); return r; }
__device__ __forceinline__ float add_s(float a, float b) { float r; asm("v_add_f32_e32 %0, %1, %2" : "=v"(r) : "v"(a), "v"(b)); return r; }
__device__ __forceinline__ float mul_s(float a, float b) { float r; asm("v_mul_f32_e32 %0, %1, %2" : "=v"(r) : "v"(a), "v"(b)); return r; }
#define ATT_MFMA(a, b, c) __builtin_amdgcn_mfma_f32_32x32x16_bf16((a), (b), (c), 0, 0, 0)

template <int DK, int MODE, bool INIT = true>
__device__ __forceinline__ void flash_pass(LAS char* lds, const bf16_t* __restrict__ Qg, int qp, const bf16_t* __restrict__ Kg, int kp, const bf16_t* __restrict__ Vg, int vp,
                                           const bf16_t* __restrict__ AUGg, int q0, int a0, int nA, int b0, int nt, float slope, f32x16& O0, f32x16& O1, float& Mout, float& Lout) {
    constexpr int DKL = DK + (MODE == 1 ? 16 : 0);
    constexpr int KPITCH = DKL * 2 + 16, NKC = 8 * DKL, CPR = DKL / 8, NKS = DK / 16;
    constexpr bool HAS_K1 = NKC > 512;
    constexpr int DUMMY = 2 * KBUF + 2 * VBUF;
    const int tid = tid_fresh(), lane = tid & 63, r32 = lane & 31, hi = lane >> 5; const int wid = __builtin_amdgcn_readfirstlane(tid >> 6);
    const int qrow = q0 + wid * 32 + r32;
    bf16x8 qf[NKS];
#pragma unroll
    for (int ks = 0; ks < NKS; ++ks) qf[ks] = *(const bf16x8*)(Qg + (size_t)qrow * qp + 16 * ks + 8 * hi);
    const int kc1 = tid + 512;
    const bool k0v = tid < NKC, k1v = HAS_K1 && kc1 < NKC;
    const int kr0 = k0v ? tid / CPR : 0, kcc0 = k0v ? tid % CPR : 0, kr1 = k1v ? kc1 / CPR : 0, kcc1 = k1v ? kc1 % CPR : 0, vr = tid >> 3, vcc = tid & 7;
    const bf16_t* kg0; size_t kst0;
    if (MODE == 1 && kcc0 >= DK / 8) { kg0 = AUGg + (size_t)kr0 * 64 + 8 * (kcc0 - DK / 8); kst0 = (size_t)64 * 64; } else { kg0 = Kg + (size_t)kr0 * kp + 8 * kcc0; kst0 = (size_t)64 * kp; }
    const bf16_t* kg1 = Kg + (size_t)kr1 * kp + 8 * kcc1; const size_t kst1 = (size_t)64 * kp;
    const bf16_t* vg = Vg + (size_t)vr * vp + 8 * vcc; const size_t vst = (size_t)64 * vp;
    const int kl0 = k0v ? kr0 * KPITCH + 16 * kcc0 : -1, kl1 = k1v ? kr1 * KPITCH + 16 * kcc1 : -1, vl = 2 * KBUF + vr * VPITCH + 16 * vcc;
    u32x4 rk0 = {0u, 0u, 0u, 0u}, rk1 = {0u, 0u, 0u, 0u}, rv = {0u, 0u, 0u, 0u};
#define ATT_KT(i) ((i) < nA ? a0 + (i) : b0 + ((i) - nA))
#define ATT_LOADK(kt) do { const size_t t_ = (size_t)(kt); rk0 = *(const u32x4*)(kg0 + t_ * kst0); if (HAS_K1) rk1 = *(const u32x4*)(kg1 + t_ * kst1); } while (0)
#define ATT_LOADV(kt) do { rv = *(const u32x4*)(vg + (size_t)(kt) * vst); } while (0)
#define ATT_STOREK(buf) do { *(LAS u32x4*)(lds + (kl0 >= 0 ? (buf) * KBUF + kl0 : DUMMY + tid * 16)) = rk0; if (HAS_K1) *(LAS u32x4*)(lds + (kl1 >= 0 ? (buf) * KBUF + kl1 : DUMMY + tid * 16)) = rk1; } while (0)
#define ATT_STOREV(buf) do { *(LAS u32x4*)(lds + (buf) * VBUF + vl) = rv; } while (0)
    const int q4 = (lane & 15) >> 2, p4 = lane & 3, b16 = (lane >> 4) & 1;
    const int vbase = 2 * KBUF + (4 * hi + q4) * VPITCH + 32 * b16 + 8 * p4;
    const int kbase = r32 * KPITCH + 16 * hi;
    const int qw = q0 + wid * 32;
    const float stq = slope * (float)qrow;
    const bf16x8 qzero = {0, 0, 0, 0, 0, 0, 0, 0};
    bf16x8 qpos = qzero, qneg = qzero;
    if (MODE == 1 && hi == 0) { qpos[0] = (short)0x3F80; qpos[1] = (short)0x3F80; qneg[0] = (short)0xBF80; qneg[1] = (short)0xBF80; }
    constexpr int NKF = NKS + (MODE == 1 ? 1 : 0);
    constexpr int KPRE = NKF > 4 ? 4 : NKF;
    bf16x8 kfa[NKF], kfb[NKF];
#define ATT_KREAD(kbuf, f0, f1) do { const LAS char* Kb_ = lds + (kbuf) * KBUF + kbase; \
        _Pragma("unroll") for (int ks_ = (f0); ks_ < (f1); ++ks_) { kfa[ks_] = *(const LAS bf16x8*)(Kb_ + 32 * ks_); kfb[ks_] = *(const LAS bf16x8*)(Kb_ + 32 * KPITCH + 32 * ks_); } } while (0)
#define ATT_QKM(sa, sb, side) do { \
        _Pragma("unroll") for (int e_ = 0; e_ < 16; ++e_) { sa[e_] = 0.f; sb[e_] = 0.f; } \
        _Pragma("unroll") for (int ks_ = 0; ks_ < NKS; ++ks_) { sa = ATT_MFMA(kfa[ks_], qf[ks_], sa); sb = ATT_MFMA(kfb[ks_], qf[ks_], sb); } \
        if (MODE == 1) { const bf16x8 qa_ = (side) < 0 ? qpos : ((side) > 0 ? qneg : qzero); sa = ATT_MFMA(kfa[NKS], qa_, sa); sb = ATT_MFMA(kfb[NKS], qa_, sb); } } while (0)
#define ATT_QK(sa, sb, kbuf, side) do { ATT_KREAD(kbuf, 0, NKF); ATT_QKM(sa, sb, side); } while (0)
    bf16x8 vfa[4], vfb[4];
#define ATT_VREAD(vbuf) do { const LAS char* Vb_ = lds + (vbuf) * VBUF + vbase; \
        _Pragma("unroll") for (int j_ = 0; j_ < 4; ++j_) { const LAS char* vp0_ = Vb_ + (16 * j_) * VPITCH; \
            { const s16x4 lo_ = vtr(vp0_), hh_ = vtr(vp0_ + 8 * VPITCH); vfa[j_] = __builtin_shufflevector(lo_, hh_, 0, 1, 2, 3, 4, 5, 6, 7); } \
            { const s16x4 lo_ = vtr(vp0_ + 64), hh_ = vtr(vp0_ + 8 * VPITCH + 64); vfb[j_] = __builtin_shufflevector(lo_, hh_, 0, 1, 2, 3, 4, 5, 6, 7); } } } while (0)
#define ATT_PVM() do { _Pragma("unroll") for (int j_ = 0; j_ < 4; ++j_) { O0 = ATT_MFMA(vfa[j_], pf[j_ >> 1][j_ & 1], O0); O1 = ATT_MFMA(vfb[j_], pf[j_ >> 1][j_ & 1], O1); } } while (0)
#define ATT_PV(vbuf) do { ATT_VREAD(vbuf); ATT_PVM(); } while (0)
#define ATT_SIDE(kt) ((MODE != 1) ? 0 : (((kt) * 64 + 63 < qw) ? -1 : (((kt) * 64 > qw + 31) ? 1 : 0)))
    ATT_LOADK(ATT_KT(0)); ATT_STOREK(0);
    ATT_LOADK(ATT_KT(1)); ATT_STOREK(1);
    ATT_STOREV(1);
    __syncthreads();
    float M = INIT ? -1e20f : Mout, L = INIT ? 0.f : Lout;
    if (INIT) {
#pragma unroll
        for (int i = 0; i < 16; ++i) { O0[i] = 0.f; O1[i] = 0.f; } }
    bf16x8 pf[2][2];
#pragma unroll
    for (int kb = 0; kb < 2; ++kb)
#pragma unroll
        for (int st = 0; st < 2; ++st) pf[kb][st] = qzero;
    f32x16 s0, s1, n0, n1;
    int side_cur = ATT_SIDE(ATT_KT(0));
    ATT_QK(s0, s1, 0, side_cur);
#pragma unroll
    for (int e = 0; e < 16; ++e) { n0[e] = 0.f; n1[e] = 0.f; }
    __syncthreads();
    constexpr int NMF = 2 * NKS + (MODE == 1 ? 2 : 0) + 8;
#define ATT_ITER(i, C0, C1, N0, N1, HASN, HASK2) do { \
        const int kt = ATT_KT(i); \
        if (HASK2) ATT_LOADK(ATT_KT((i) + 2)); \
        ATT_LOADV(kt); \
        if (HASN) ATT_KREAD(((i) + 1) & 1, 0, KPRE); \
        const int k0 = kt * 64; \
          \
        float rc = 0.f; \
        if (MODE == 1) { \
            if (side_cur != 0) rc = side_cur < 0 ? -stq : stq; \
            else { const float dbase = (float)(k0 + 4 * hi - qrow); \
                _Pragma("unroll") for (int e = 0; e < 16; ++e) { const float c = (float)((e & 3) + 8 * (e >> 2)); \
                    C0[e] = fmaf(-slope, fabsf(dbase + c), C0[e]); C1[e] = fmaf(-slope, fabsf(dbase + (c + 32.f)), C1[e]); } } \
        } \
        if (MODE == 2) { const float dbase = (float)(k0 + 4 * hi - qrow); \
            _Pragma("unroll") for (int e = 0; e < 16; ++e) { const float c = (float)((e & 3) + 8 * (e >> 2)); \
                const float d0 = fabsf(dbase + c), d1 = fabsf(dbase + (c + 32.f)); \
                C0[e] = (d0 <= 128.f) ? fmaf(-slope, d0, C0[e]) : -1e30f; C1[e] = (d1 <= 128.f) ? fmaf(-slope, d1, C1[e]) : -1e30f; } } \
        float mx = max3f(C0[0], C1[0], C0[1]); \
        _Pragma("unroll") for (int e = 1; e < 15; e += 2) { mx = max3f(mx, C1[e], C0[e + 1]); mx = max3f(mx, C1[e + 1], C0[e + 2]); } \
        mx = fmaxf(mx, C1[15]); \
        const float mt = xhalf_max(mx) + rc;                     \
        if (__builtin_amdgcn_ballot_w64(mt > M + RESCALE_T) != 0ull) {         \
            ATT_PV(((i) + 1) & 1); \
            _Pragma("unroll") for (int kb = 0; kb < 2; ++kb) _Pragma("unroll") for (int st = 0; st < 2; ++st) pf[kb][st] = qzero; \
            const float Mn = fmaxf(M, mt); const float alpha = __builtin_amdgcn_exp2f((M - Mn) * LOG2E); M = Mn; \
            L *= alpha; \
            _Pragma("unroll") for (int e = 0; e < 16; ++e) { O0[e] *= alpha; O1[e] *= alpha; }        \
        } \
          \
        const int side_next = HASN ? ATT_SIDE(ATT_KT((i) + 1)) : 0; \
        if (HASN) ATT_KREAD(((i) + 1) & 1, KPRE, NKF); \
        ATT_VREAD(((i) + 1) & 1); \
        if (HASN) ATT_QKM(N0, N1, side_next); \
        ATT_PVM();                                   \
        const float cc = (rc - M) * LOG2E; \
        float ps = 0.f;                                          \
        float ps1 = 0.f; \
        _Pragma("unroll") for (int e = 0; e < 16; ++e) { float t0 = __builtin_fmaf(C0[e], LOG2E, cc), t1 = __builtin_fmaf(C1[e], LOG2E, cc); \
            asm("" : "+v"(t0)); asm("" : "+v"(t1));                 \
            C0[e] = __builtin_amdgcn_exp2f(t0); C1[e] = __builtin_amdgcn_exp2f(t1); \
            float u0 = ps + C0[e], u1 = ps1 + C1[e]; asm("" : "+v"(u0)); asm("" : "+v"(u1)); ps = u0; ps1 = u1; } \
        L += ps + ps1; \
        _Pragma("unroll") for (int st = 0; st < 2; ++st) { u32x4 w0, w1; \
            w0.x = pkbf(C0[8 * st + 0], C0[8 * st + 1]); w0.y = pkbf(C0[8 * st + 2], C0[8 * st + 3]); w0.z = pkbf(C0[8 * st + 4], C0[8 * st + 5]); w0.w = pkbf(C0[8 * st + 6], C0[8 * st + 7]); \
            w1.x = pkbf(C1[8 * st + 0], C1[8 * st + 1]); w1.y = pkbf(C1[8 * st + 2], C1[8 * st + 3]); w1.z = pkbf(C1[8 * st + 4], C1[8 * st + 5]); w1.w = pkbf(C1[8 * st + 6], C1[8 * st + 7]); \
            pf[0][st] = __builtin_bit_cast(bf16x8, w0); pf[1][st] = __builtin_bit_cast(bf16x8, w1); } \
        side_cur = side_next; \
        if (HASN) { __builtin_amdgcn_sched_group_barrier(0x100, 16 + 2 * (NKF - KPRE), 0); \
            _Pragma("unroll") for (int g_ = 0; g_ < NMF; ++g_) { __builtin_amdgcn_sched_group_barrier(0x008, 1, 0); __builtin_amdgcn_sched_group_barrier(0x002, 6, 0); } } \
        if (HASK2) ATT_STOREK((i) & 1); \
        ATT_STOREV((i) & 1); \
        __syncthreads(); } while (0)
    for (int i = 0; i + 2 < nt; i += 2) {
        ATT_ITER(i, s0, s1, n0, n1, true, true);
        ATT_ITER(i + 1, n0, n1, s0, s1, true, true);
    }
    ATT_ITER(nt - 2, s0, s1, n0, n1, true, false);
    ATT_ITER(nt - 1, n0, n1, s0, s1, false, false);
    ATT_PV((nt - 1) & 1);
    __syncthreads();
#undef ATT_ITER
#undef ATT_LOADK
#undef ATT_LOADV
#undef ATT_STOREK
#undef ATT_STOREV
#undef ATT_KT
#undef ATT_QK
#undef ATT_PV
#undef ATT_KREAD
#undef ATT_QKM
#undef ATT_VREAD
#undef ATT_PVM
#undef ATT_SIDE
    Mout = M; Lout = L;
}

__device__ __forceinline__ void store_o(bf16_t* orow, const f32x16& O0, const f32x16& O1, int hi) {
#pragma unroll
    for (int g = 0; g < 4; ++g) {
        u32x2 w0, w1; w0.x = pkbf(O0[4 * g], O0[4 * g + 1]); w0.y = pkbf(O0[4 * g + 2], O0[4 * g + 3]); w1.x = pkbf(O1[4 * g], O1[4 * g + 1]); w1.y = pkbf(O1[4 * g + 2], O1[4 * g + 3]);
        *(u32x2*)(orow + 8 * g + 4 * hi) = w0; *(u32x2*)(orow + 32 + 8 * g + 4 * hi) = w1;
    }
}

__device__ __forceinline__ void attn_phase(KP p, int l, LAS char* lds, int vcu, int G) {
    const int tid = tid_fresh(), lane = tid & 63, r32 = lane & 31, hi = lane >> 5; const int wid = __builtin_amdgcn_readfirstlane(tid >> 6);
    const bf16_t* proj = (const bf16_t*)(p->ws + WS_PROJ); const bf16_t* qb = (const bf16_t*)(p->ws + WS_QB); const bf16_t* kb = (const bf16_t*)(p->ws + WS_KB); const bf16_t* vb = (const bf16_t*)(p->ws + WS_VB);
    const bf16_t* aug = (const bf16_t*)(p->ws + WS_AUG);
    bf16_t* mix = (bf16_t*)(p->ws + WS_MIX);
    float lam;
    { const float* lp = p->diff_lambda + l * 128; const float a = (lane < 32) ? lp[lane] * lp[32 + lane] : 0.f, b2 = (lane < 32) ? lp[64 + lane] * lp[96 + lane] : 0.f;
      lam = expf(wave_sum(a)) - expf(wave_sum(b2)) + p->lam_init[l]; }
    const float one_m_li = 1.f - p->lam_init[l];
    for (int u = vcu; u < 2048; u += G) {
        if (!((ATT_TYPES >> (u >> 9)) & 1)) continue;
        const int type = u >> 9, idx = u & 511, bh = idx >> 6, qblk = idx & 63, b = bh >> 2, hd = bh & 3, q0 = qblk * 256;
        const int qrow = q0 + wid * 32 + r32;
        const size_t tok0 = (size_t)b * SEQ;
        bf16_t* orow = mix + (tok0 + qrow) * DM;
        f32x16 O0, O1; float M, L;
        if (type == 0) {
            const int bD = idx >> 8, hD = ((idx >> 6) & 3) ^ (bD ? 3 : 0);
            const size_t tokD = (size_t)bD * SEQ;
            bf16_t* orowD = mix + (tokD + qrow) * DM;
            const float slope = __builtin_amdgcn_exp2f(-(float)(5 + hD));
            const bf16_t* base = proj + tokD * NPROJ + PD;
            const int d0 = q0 / 64;
            LAS float* asave = (LAS float*)(lds + 65536) + tid;
#pragma unroll 1
            for (int mp = 0; mp < 2; ++mp) {
                const bf16_t* Qm = base + 64 * hD + 32 * mp; const bf16_t* Km = base + 256 + 64 * hD + 32 * mp; const bf16_t* Vm = base + 512 + 64 * hD;
                flash_pass<32, 1, true>(lds, Qm, NPROJ, Km, NPROJ, Vm, NPROJ, aug + 16 * hD, q0, d0, 4, 0, 4, slope, O0, O1, M, L);
                float qn2 = 0.f;
                { const u32x4* qr = (const u32x4*)(Qm + (size_t)qrow * NPROJ);
#pragma unroll
                  for (int c = 0; c < 4; ++c) { float v[8]; unpack8(qr[c], v);
#pragma unroll
                      for (int e = 0; e < 8; ++e) qn2 += v[e] * v[e]; } }
                const float kmax = sqrtf(__builtin_bit_cast(float, ((const unsigned*)(p->ws + WS_KMAX))[l * 16 + bD * 8 + hD * 2 + mp]));
                float dc = (sqrtf(qn2) * kmax * 1.001f + 40.f - M) / slope;
                dc = fminf(fmaxf(dc, 0.f), 1.0e8f);
#pragma unroll
                for (int o = 1; o < 64; o <<= 1) dc = fmaxf(dc, __shfl_xor(dc, o));
                LAS float* red = (LAS float*)(lds + ATT_LDS + 16384);
                if (lane == 0) red[wid] = dc;
                __syncthreads();
#pragma unroll
                for (int w = 0; w < 8; ++w) dc = fmaxf(dc, red[w]);
                __syncthreads();
                const int dci = (int)dc + 1;
                const int lo_key = q0 - dci - 63;
                int ktlo = lo_key <= 0 ? 0 : (lo_key + 63) / 64; int kthi = (q0 + 255 + dci) / 64; if (kthi > SEQ / 64 - 1) kthi = SEQ / 64 - 1;
                if (ktlo > d0) ktlo = d0; if (kthi < d0 + 3) kthi = d0 + 3;
                if (((kthi - ktlo + 1) & 1) != 0) { if (ktlo > 0) --ktlo; else ++kthi; }
                const int nR = kthi - (d0 + 3), nL = d0 - ktlo;
                if (nR + nL > 0) flash_pass<32, 1, false>(lds, Qm, NPROJ, Km, NPROJ, Vm, NPROJ, aug + 16 * hD, q0, d0 + 4, nR, ktlo, nR + nL, slope, O0, O1, M, L);
                if (mp == 0) { const float i1 = 1.f / xhalf_sum(L);
#pragma unroll
                    for (int i = 0; i < 16; ++i) { asave[(2 * i) * NTHREADS] = O0[i] * i1; asave[(2 * i + 1) * NTHREADS] = O1[i] * i1; } }
            }
            const float i2 = lam / xhalf_sum(L);
            float ss = 0.f;
            f32x16 A0, A1;
#pragma unroll
            for (int i = 0; i < 16; ++i) { A0[i] = asave[(2 * i) * NTHREADS] - O0[i] * i2; A1[i] = asave[(2 * i + 1) * NTHREADS] - O1[i] * i2; ss += A0[i] * A0[i] + A1[i] * A1[i]; }
            ss = xhalf_sum(ss);
            const float rs = one_m_li / sqrtf(ss * (1.f / 64.f) + NORM_EPS);
            const float* sg = p->diff_subln + l * 64;
#pragma unroll
            for (int i = 0; i < 16; ++i) { const int dv = (i & 3) + 8 * (i >> 2) + 4 * hi; A0[i] *= rs * sg[dv]; A1[i] *= rs * sg[32 + dv]; }
            store_o(orowD + 768 + 64 * hD, A0, A1, hi);
        } else if (type == 1) {
            flash_pass<96, 0>(lds, qb + tok0 * 384 + 96 * hd, 384, kb + tok0 * 384 + 96 * hd, 384, vb + tok0 * 256 + 64 * hd, 256, nullptr, q0, q0 / 64, SEQ / 64 - q0 / 64, 0, SEQ / 64, 0.f, O0, O1, M, L);
            const float il = 1.f / xhalf_sum(L);
#pragma unroll
            for (int i = 0; i < 16; ++i) { O0[i] *= il; O1[i] *= il; }
            store_o(orow + 256 + 64 * hd, O0, O1, hi);
        } else if (type == 2) {
            const bf16_t* base = proj + tok0 * NPROJ + PC; const int hk = hd >> 1;
            flash_pass<64, 0>(lds, base + 64 * hd, NPROJ, base + 256 + 64 * hk, NPROJ, base + 384 + 64 * hk, NPROJ, nullptr, q0, q0 / 64, SEQ / 64 - q0 / 64, 0, SEQ / 64, 0.f, O0, O1, M, L);
            const float il = 1.f / xhalf_sum(L);
#pragma unroll
            for (int i = 0; i < 16; ++i) { O0[i] *= il; O1[i] *= il; }
            store_o(orow + 512 + 64 * hd, O0, O1, hi);
        } else {
            const bf16_t* base = proj + tok0 * NPROJ + PA; const int hk = hd >> 1;
            const float slope = __builtin_amdgcn_exp2f(-(float)(1 + hd));
            const int kt0 = (q0 >= 128) ? (q0 - 128) / 64 : 0; int kt1 = (q0 + 256 + 128) / 64; if (kt1 > SEQ / 64) kt1 = SEQ / 64;
            flash_pass<64, 2>(lds, base + 64 * hd, NPROJ, base + 256 + 64 * hk, NPROJ, base + 384 + 64 * hk, NPROJ, nullptr, q0, kt0, kt1 - kt0, 0, kt1 - kt0, slope, O0, O1, M, L);
            const float sink = p->win_sink[l * 4 + hd];
            const float il = 1.f / (xhalf_sum(L) + __builtin_amdgcn_exp2f((sink - M) * LOG2E));
#pragma unroll
            for (int i = 0; i < 16; ++i) { O0[i] *= il; O1[i] *= il; }
            store_o(orow + 64 * hd, O0, O1, hi);
        }
    }
}
}

#define XB_TMO      128
#define XB_XCNT(j)  (256  + 64 * (j))
#define XB_XSUB(j)  (1280 + 64 * (j))
#define XB_XGEN(j)  (2304 + 64 * (j))
#define XB_TOP      3328
#define XB_TOPGEN   3392
#define XCD_BAR_WORDS 3456
#define XB_SPIN_CAP (1u << 18)

__device__ __forceinline__ unsigned xb_ld(unsigned* p)              { return __hip_atomic_load(p, __ATOMIC_RELAXED, __HIP_MEMORY_SCOPE_AGENT); }
__device__ __forceinline__ unsigned xb_add(unsigned* p, unsigned v) { return __hip_atomic_fetch_add(p, v, __ATOMIC_RELAXED, __HIP_MEMORY_SCOPE_AGENT); }
__device__ __forceinline__ unsigned xb_xcc_id() { return (unsigned)__builtin_amdgcn_s_getreg((3 << 11) | 20) & 0xFu; }
#define XB_SPIN(cond, bar) do { unsigned _sp = 0; while (cond) { __builtin_amdgcn_s_sleep(1); \
    if ((++_sp & 255u) == 0u) { if (xb_ld(&(bar)[XB_TMO])) break; if (_sp > XB_SPIN_CAP) { atomicAdd(&(bar)[XB_TMO], 1u); break; } } } } while (0)

struct XcdBarrier {
    unsigned* bar; unsigned x;
    volatile LAS unsigned* st;
};

__device__ __forceinline__ XcdBarrier xcd_barrier_post(unsigned* bar, volatile LAS unsigned* st) {
    XcdBarrier b; b.bar = bar; b.x = xb_xcc_id(); b.st = st;
    if (threadIdx.x == 0) (void)xb_add(&bar[XB_XCNT(b.x)], 1u);
    return b;
}
__device__ __forceinline__ void xcd_barrier_complete(unsigned* bar, unsigned x, unsigned& nloc, unsigned& nx) {
    const unsigned G = gridDim.x * gridDim.y * gridDim.z;
    unsigned sum, cnt, mine, sp = 0u;
    for (;;) {
        sum = 0u; cnt = 0u; mine = 0u;
#pragma unroll
        for (unsigned j = 0; j < 16; ++j) { const unsigned c = xb_ld(&bar[XB_XCNT(j)]); sum += c; cnt += (c > 0u) ? 1u : 0u; mine = (j == x) ? c : mine; }
        if (sum == G) break;
        __builtin_amdgcn_s_sleep(1);
        if ((++sp & 255u) == 0u) { if (xb_ld(&bar[XB_TMO])) break; if (sp > XB_SPIN_CAP) { atomicAdd(&bar[XB_TMO], 1u); break; } }
    }
    nloc = mine > 0u ? mine : 1u; nx = cnt > 0u ? cnt : 1u;
}

__device__ __forceinline__ void xcd_barrier(const XcdBarrier& b) {
    asm volatile("s_waitcnt vmcnt(0)" ::: "memory");
    __syncthreads();
    if (threadIdx.x == 0) {
        unsigned* bar = b.bar;
        __builtin_amdgcn_s_waitcnt(0);
        unsigned nloc = b.st[0], nx = b.st[1];
        if (nloc == 0u) { xcd_barrier_complete(bar, b.x, nloc, nx); b.st[0] = nloc; b.st[1] = nx; }
        const unsigned old = xb_add(&bar[XB_XSUB(b.x)], 1u);
        const unsigned gen = old / nloc;
        if (old + 1u == (gen + 1u) * nloc) {
            __builtin_amdgcn_fence(__ATOMIC_RELEASE, "agent");
            asm volatile("s_waitcnt vmcnt(0)" ::: "memory");
            const unsigned og = xb_add(&bar[XB_TOP], 1u);
            const unsigned tg = og / nx;
            if (og + 1u == (tg + 1u) * nx) xb_add(&bar[XB_TOPGEN], 1u);
            else XB_SPIN(xb_ld(&bar[XB_TOPGEN]) == tg, bar);
            __builtin_amdgcn_fence(__ATOMIC_ACQUIRE, "agent");
            xb_add(&bar[XB_XGEN(b.x)], 1u);
            asm volatile("s_waitcnt vmcnt(0)" ::: "memory");
        } else {
            XB_SPIN(xb_ld(&bar[XB_XGEN(b.x)]) == gen, bar);
            __builtin_amdgcn_fence(__ATOMIC_ACQUIRE, "agent");
            asm volatile("s_waitcnt vmcnt(0)" ::: "memory");
        }
    }
    __syncthreads();
}

#define GRID_SYNC_CG() do { asm volatile("s_waitcnt vmcnt(0) lgkmcnt(0)" ::: "memory"); grid.sync(); __builtin_amdgcn_fence(__ATOMIC_ACQUIRE, "agent"); } while (0)
#define XB_ST ((volatile LAS unsigned*)(lds + LDS_BYTES - 64))
#define GRID_SYNC() do { GETP(pb_); XcdBarrier xb_; xb_.bar = (unsigned*)(pb_->ws + WS_BAR); xb_.x = xb_xcc_id(); xb_.st = XB_ST; xcd_barrier(xb_); } while (0)
#ifndef PH_MASK
#define PH_MASK 255
#endif
__global__ void __launch_bounds__(NTHREADS, 2) mega_fwd(Params p_by_value) {
    extern __shared__ __attribute__((aligned(16))) unsigned char lds_raw[];
    cg::grid_group grid = cg::this_grid();
    LAS unsigned char* lds = (LAS unsigned char*)lds_raw;
#define VCU(G_, bx_) (((G_) % 8 == 0) ? ((bx_) % 8) * ((G_) / 8) + (bx_) / 8 : (bx_))
    const float alpha = 1.681792830507429f;
#define STATS(s_) ((float*)(p->ws + WS_STATS) + (size_t)(s_) * T * 2)
#define C1(l_, off_) ((const float*)(p->ws + WS_C12) + (l_) * C12_L + (off_))
#define C2(l_, off_) ((const float*)(p->ws + WS_C12) + C2_OFF + (l_) * C12_L + (off_))

    if (threadIdx.x < 16) ((LAS unsigned*)(lds + LDS_BYTES - 64))[threadIdx.x] = 0u;
    __syncthreads();
    { GETP(p); (void)xcd_barrier_post((unsigned*)(p->ws + WS_BAR), XB_ST); }
    if (PH_MASK & 1) { GETP(p); const int G = gridDim.x, bx = blockIdx.x; phase0(p, lds, VCU(G, bx), G); }
    GRID_SYNC_CG();
#pragma unroll 1
    for (int li = 0; li < DEPTH; ++li) {
#pragma unroll 1
        for (int fi = 0; fi < 2; ++fi) {
            if (fi == 1) {
                if (PH_MASK & 2) { GETP(p); int l = li; asm volatile("" : "+s"(l)); const int G = gridDim.x, bx = blockIdx.x;
                  pg8::Gemm g{(const bf16_t*)(p->ws + WS_XB), (const bf16_t*)(p->ws + WS_WIN) + l * WIN_L, T, NPROJ, DM}; pg8::StaticOrder S; S.init(T, NPROJ, G, bx);
                  pg8::EpiStoreBf16LN E{(bf16_t*)(p->ws + WS_PROJ), NPROJ, STATS(3 * l), C1(l, 2 * NGU), C2(l, 2 * NGU)};
                  pg8::gemm_phase<pg8::EpiStoreBf16LN, pg8::StaticOrder, true, true>(lds, g, S, E); }
                GRID_SYNC();
                if (PH_MASK & 4) { GETP(p); int l = li; asm volatile("" : "+s"(l)); const int G = gridDim.x, bx = blockIdx.x; prep_phase(p, l, VCU(G, bx), G); }
                GRID_SYNC();
                if (PH_MASK & 8) { GETP(p); int l = li; asm volatile("" : "+s"(l)); const int G = gridDim.x, bx = blockIdx.x; att::attn_phase(p, l, (LAS char*)lds, VCU(G, bx), G); }
                GRID_SYNC();
                if (PH_MASK & 16) { GETP(p); int l = li; asm volatile("" : "+s"(l)); const int G = gridDim.x, bx = blockIdx.x;
                  pg8::Gemm g{(const bf16_t*)(p->ws + WS_MIX), (const bf16_t*)(p->ws + WS_WOUT) + l * WOUT_L, T, DM, DM}; pg8::StaticOrder S; S.init(T, DM, G, bx);
                  pg8::EpiResidLN<true> E{nullptr, p->out, p->ws, p->ln_g + (3 * l) * DM, p->ln_b + (3 * l) * DM, 3 * l, alpha, 1.0f};
                  pg8::gemm_phase<pg8::EpiResidLN<true>, pg8::StaticOrder, true, true>(lds, g, S, E); }
                GRID_SYNC();
            }
            if (PH_MASK & 64) { GETP(p); int l = li, f = fi; asm volatile("" : "+s"(l), "+s"(f)); const int G = gridDim.x, bx = blockIdx.x;
              const int s = 3 * l + 2 * f - 1;
              pg8::Gemm g{(const bf16_t*)(p->ws + WS_XB), (const bf16_t*)(p->ws + WS_WGU) + l * WGU_L + f * WGU_F, T, NGU, DM}; pg8::StaticOrder S; S.init(T, NGU, G, bx);
              if (s >= 0) { pg8::EpiSwiGLULN<true> E{(bf16_t*)(p->ws + WS_H), DFF, STATS(s), C1(l, f * NGU), C2(l, f * NGU)};
                            pg8::gemm_phase<pg8::EpiSwiGLULN<true>, pg8::StaticOrder, true, true>(lds, g, S, E); }
              else { pg8::EpiSwiGLULN<false> E{(bf16_t*)(p->ws + WS_H), DFF, nullptr, C1(l, f * NGU), C2(l, f * NGU)};
                     pg8::gemm_phase<pg8::EpiSwiGLULN<false>, pg8::StaticOrder, true, true>(lds, g, S, E); } }
            GRID_SYNC();
            if (PH_MASK & 128) { GETP(p); int l = li, f = fi; asm volatile("" : "+s"(l), "+s"(f)); const int G = gridDim.x, bx = blockIdx.x;
              const int s = 3 * l + 2 * f - 1;
              pg8::Gemm g{(const bf16_t*)(p->ws + WS_H), (const bf16_t*)(p->ws + WS_WD) + l * WD_L + f * WD_F, T, DM, DFF}; pg8::StaticOrder S; S.init(T, DM, G, bx);
              if (s >= 0) { pg8::EpiResidLN<true> E{nullptr, p->out, p->ws, p->ln_g + s * DM, p->ln_b + s * DM, s, alpha, 0.5f};
                            pg8::gemm_phase<pg8::EpiResidLN<true>, pg8::StaticOrder, true, true>(lds, g, S, E); }
              else { pg8::EpiResidLN<false> E{p->x, p->out, p->ws, nullptr, nullptr, -1, alpha, 0.5f};
                     pg8::gemm_phase<pg8::EpiResidLN<false>, pg8::StaticOrder, true, true>(lds, g, S, E); } }
            GRID_SYNC();
        }
    }
    if (PH_MASK & 32) { GETP(p); const int G = gridDim.x, bx = blockIdx.x;
      ln_phase(p->out, (bf16_t*)(p->ws + WS_XB), p->ln_g + (3 * DEPTH - 1) * DM, p->ln_b + (3 * DEPTH - 1) * DM, VCU(G, bx), G); }
}

extern "C" void kernel_launch(void* const* d_in, const int* in_sizes, int n_in, void* d_out, int out_size, void* d_ws, size_t ws_size, hipStream_t stream) {
    static int grid = 0;
    if (grid == 0) {
        if (n_in != 16 || in_sizes[0] != T * DM || out_size != T * DM || ws_size < WS_END) { fprintf(stderr, "kernel_launch: unexpected shapes (n_in %d, in0 %d, out %d, ws %zu); nothing launched\n", n_in, n_in > 0 ? in_sizes[0] : -1, out_size, ws_size); grid = -1; return; }
        int dev = 0, cus = 0, per_cu = 0;
        hipGetDevice(&dev); hipDeviceGetAttribute(&cus, hipDeviceAttributeMultiprocessorCount, dev);
        if (hipFuncSetAttribute((const void*)mega_fwd, hipFuncAttributeMaxDynamicSharedMemorySize, LDS_BYTES) != hipSuccess) { fprintf(stderr, "kernel_launch: hipFuncSetAttribute failed\n"); grid = -1; return; }
        if (hipOccupancyMaxActiveBlocksPerMultiprocessor(&per_cu, (const void*)mega_fwd, NTHREADS, LDS_BYTES) != hipSuccess || per_cu < 1) { fprintf(stderr, "kernel_launch: occupancy query gave %d\n", per_cu); per_cu = 1; }
        (void)hipGetLastError();
        grid = cus * 1;
    }
    if (grid < 0) return;
    Params p{};
    p.x = (const float*)d_in[0]; p.w_in = (const float*)d_in[1]; p.win_sink = (const float*)d_in[2]; p.mla_q_norm = (const float*)d_in[3]; p.mla_w_uq = (const float*)d_in[4];
    p.mla_kv_norm = (const float*)d_in[5]; p.mla_w_ukv = (const float*)d_in[6]; p.ax_q_norm = (const float*)d_in[7]; p.ax_k_norm = (const float*)d_in[8]; p.diff_lambda = (const float*)d_in[9];
    p.diff_subln = (const float*)d_in[10]; p.w_out = (const float*)d_in[11]; p.ffn_w_gu = (const float*)d_in[12]; p.ffn_w_down = (const float*)d_in[13]; p.ln_g = (const float*)d_in[14]; p.ln_b = (const float*)d_in[15];
    p.out = (float*)d_out; p.ws = (unsigned char*)d_ws;
    for (int l = 0; l < 4; ++l) p.lam_init[l] = (float)(0.8 - 0.6 * exp(-0.3 * (double)l));
    for (int i = 0; i < 16; ++i) p.inv32[i] = (float)pow(10000.0, -(double)i / 16.0);
    if (hipMemsetAsync((char*)d_ws + WS_CTL, 0, CTL_BYTES, stream) != hipSuccess) { fprintf(stderr, "kernel_launch: hipMemsetAsync of the control region failed\n"); return; }
    void* args[] = {&p};
    hipError_t e = hipLaunchCooperativeKernel((const void*)mega_fwd, dim3(grid), dim3(NTHREADS), args, LDS_BYTES, stream);
    if (e != hipSuccess) fprintf(stderr, "kernel_launch: cooperative launch failed: %s (grid %d)\n", hipGetErrorString(e), grid);
}
```

```cpp
#include <hip/hip_runtime.h>
#include <hip/hip_cooperative_groups.h>
#include <cstdio>
#include <cstdint>
#include <cmath>
namespace cg = cooperative_groups;
namespace pg8 {
#define PG8_LAS __attribute__((address_space(3)))
typedef unsigned short bf16_t;
typedef short bf16x8 __attribute__((ext_vector_type(8)));
typedef float f32x4 __attribute__((ext_vector_type(4)));
typedef unsigned u32x4 __attribute__((ext_vector_type(4)));
constexpr int BM = 256, BK = 64, HALF = 128, HTB = HALF * BK * 2  , STAGE_BYTES = 8 * HTB, NXCD = 8, WGM = 8;

__host__ __device__ __forceinline__ int lds_byte(int r, int c) { const int st = (r >> 4) * 2 + (c >> 5), rr = r & 15, cc = c & 31, ob = rr * 64 + cc * 2; return st * 1024 + (ob ^ (((ob >> 9) & 1) << 5)); }
__host__ __device__ __forceinline__ void stage_rc(int b, int& R, int& C) { const int st = b / 1024, sb = b % 1024, swz = sb ^ (((sb >> 9) & 1) << 5); R = (st >> 1) * 16 + swz / 64; C = (st & 1) * 32 + (swz % 64) / 2; }
__host__ __device__ __forceinline__ int perm32(int rho) { const int n = rho >> 4, i = rho & 15; return 8 * (i >> 2) + 4 * n + (i & 3); }

struct Unit { int pm, pn; };
struct Gemm { const bf16_t* A; const bf16_t* Bt; int M, N, K; };

struct StaticOrder {
    int nM, nN, nwg, G, c;
    __host__ __device__ void init(int M, int N, int G_, int c_) { nM = M / BM; nN = N / BM; nwg = nM * nN; G = G_; c = c_; }
    __host__ __device__ bool next(int i, Unit& u) const {
        const long L = (long)i * G + c; if (L >= nwg) return false;
        int wgid = (int)L; { const int q = nwg / NXCD, r = nwg % NXCD, xcd = wgid % NXCD, off = wgid / NXCD; wgid = (xcd < r ? xcd * (q + 1) : r * (q + 1) + (xcd - r) * q) + off; }
        const int nig = WGM * nN, gid = wgid / nig, fm = gid * WGM, gsz = (nM - fm) < WGM ? (nM - fm) : WGM;
        u.pm = fm + ((wgid % nig) % gsz); u.pn = (wgid % nig) / gsz; return true;
    }
    __device__ __forceinline__ void a_ready(const Unit&) const {}
    __device__ __forceinline__ void done(const Unit&) const {}
};

__device__ __forceinline__ unsigned cvt_pk_bf16(float lo, float hi) { unsigned r; asm volatile("v_cvt_pk_bf16_f32 %0, %1, %2" : "=v"(r) : "v"(lo), "v"(hi)); return r; }
typedef float f32x2 __attribute__((ext_vector_type(2)));
typedef float f32x2 __attribute__((ext_vector_type(2)));
typedef unsigned u32x2 __attribute__((ext_vector_type(2)));

struct EpiStoreBf16 {
    static constexpr bool PERM = true, AFTER_DRAIN = false;
    bf16_t* O; int ldc;
    __device__ __forceinline__ void operator()(const f32x4 (&acc)[2][2][4][2], const Unit& u, int wr, int wc, int fr, int fq) const {
        const int row0 = u.pm * BM + wr * 64 + fr; const int col0 = u.pn * BM + wc * 32 + 8 * fq;
#pragma unroll
        for (int ai = 0; ai < 2; ++ai)
#pragma unroll
            for (int m = 0; m < 4; ++m) { bf16_t* rowp = O + (size_t)(row0 + ai * HALF + m * 16) * ldc + col0;
#pragma unroll
                for (int bj = 0; bj < 2; ++bj) { const f32x4 v0 = acc[ai][bj][m][0], v1 = acc[ai][bj][m][1];
                    u32x4 w; w.x = cvt_pk_bf16(v0[0], v0[1]); w.y = cvt_pk_bf16(v0[2], v0[3]); w.z = cvt_pk_bf16(v1[0], v1[1]); w.w = cvt_pk_bf16(v1[2], v1[3]);
                    *(u32x4*)(rowp + bj * HALF) = w; } }
    }
};

__device__ __forceinline__ float silu_mul(float g, float u) {
    const float e = __builtin_amdgcn_exp2f(-1.4426950408889634f * g);
    return g * u * __builtin_amdgcn_rcpf(1.0f + e);
}
struct EpiSwiGLU {
    static constexpr bool PERM = true, AFTER_DRAIN = false;
    bf16_t* H; int ldh;
    __device__ __forceinline__ void operator()(const f32x4 (&acc)[2][2][4][2], const Unit& u, int wr, int wc, int fr, int fq) const {
        const int row0 = u.pm * BM + wr * 64 + fr; const int col0 = u.pn * HALF + wc * 32 + 8 * fq;
#pragma unroll
        for (int ai = 0; ai < 2; ++ai)
#pragma unroll
            for (int m = 0; m < 4; ++m) { bf16_t* rowp = H + (size_t)(row0 + ai * HALF + m * 16) * ldh + col0;
                const f32x4 g0 = acc[ai][0][m][0], g1 = acc[ai][0][m][1], u0 = acc[ai][1][m][0], u1 = acc[ai][1][m][1];
                u32x4 w;
                w.x = cvt_pk_bf16(silu_mul(g0[0], u0[0]), silu_mul(g0[1], u0[1])); w.y = cvt_pk_bf16(silu_mul(g0[2], u0[2]), silu_mul(g0[3], u0[3]));
                w.z = cvt_pk_bf16(silu_mul(g1[0], u1[0]), silu_mul(g1[1], u1[1])); w.w = cvt_pk_bf16(silu_mul(g1[2], u1[2]), silu_mul(g1[3], u1[3]));
                *(u32x4*)rowp = w; }
    }
};

struct EpiResid {
    static constexpr bool PERM = false, AFTER_DRAIN = false;
    const float* src; float* dst; int ld; float alpha, beta;
    __device__ __forceinline__ void operator()(const f32x4 (&acc)[2][2][4][2], const Unit& u, int wr, int wc, int fr, int fq) const {
        const int col0 = u.pn * BM + wc * 32 + 4 * fq;
#pragma unroll
        for (int ai = 0; ai < 2; ++ai)
#pragma unroll
            for (int m = 0; m < 4; ++m) { const size_t off = (size_t)(u.pm * BM + ai * HALF + wr * 64 + m * 16 + fr) * ld + col0;
#pragma unroll
                for (int bj = 0; bj < 2; ++bj)
#pragma unroll
                    for (int n = 0; n < 2; ++n) { const f32x4 s = *(const f32x4*)(src + off + bj * HALF + n * 16);
                        *(f32x4*)(dst + off + bj * HALF + n * 16) = s * alpha + acc[ai][bj][m][n] * beta; } }
    }
};

constexpr float LN_EPS_F = 1e-5f;
template <bool HAS> __device__ __forceinline__ void ln_row_stats(const float* st, int row, float& mu, float& rs) {
    if (!HAS) { mu = 0.f; rs = 1.f; return; }
    const f32x2 s = *(const f32x2*)(st + 2 * (size_t)row);
    mu = s.x * (1.0f / 1024.0f); const float var = fmaxf(s.y * (1.0f / 1024.0f) - mu * mu, 0.f); rs = 1.0f / sqrtf(var + LN_EPS_F);
}
struct EpiStoreBf16LN {
    static constexpr bool PERM = true, AFTER_DRAIN = false;
    bf16_t* O; int ldc; const float* st; const float* c1; const float* c2;
    __device__ __forceinline__ void operator()(const f32x4 (&acc)[2][2][4][2], const Unit& u, int wr, int wc, int fr, int fq) const {
        int row0 = u.pm * BM + wr * 64 + fr; int col0 = u.pn * BM + wc * 32 + 8 * fq;
        asm volatile("" : "+v"(row0), "+v"(col0));
        f32x4 c1v[2][2], c2v[2][2];
#pragma unroll
        for (int bj = 0; bj < 2; ++bj)
#pragma unroll
            for (int n = 0; n < 2; ++n) { c1v[bj][n] = *(const f32x4*)(c1 + col0 + bj * HALF + 4 * n); c2v[bj][n] = *(const f32x4*)(c2 + col0 + bj * HALF + 4 * n); }
#pragma unroll
        for (int ai = 0; ai < 2; ++ai)
#pragma unroll
            for (int m = 0; m < 4; ++m) { const int row = row0 + ai * HALF + m * 16; float mu, rs; ln_row_stats<true>(st, row, mu, rs);
                bf16_t* rowp = O + (size_t)row * ldc + col0;
#pragma unroll
                for (int bj = 0; bj < 2; ++bj) { const f32x4 v0 = (acc[ai][bj][m][0] - c1v[bj][0] * mu) * rs + c2v[bj][0], v1 = (acc[ai][bj][m][1] - c1v[bj][1] * mu) * rs + c2v[bj][1];
                    u32x4 w; w.x = cvt_pk_bf16(v0[0], v0[1]); w.y = cvt_pk_bf16(v0[2], v0[3]); w.z = cvt_pk_bf16(v1[0], v1[1]); w.w = cvt_pk_bf16(v1[2], v1[3]);
                    *(u32x4*)(rowp + bj * HALF) = w; } }
    }
};
template <bool HAS_LN> struct EpiSwiGLULN {
    static constexpr bool PERM = true, AFTER_DRAIN = false;
    bf16_t* H; int ldh; const float* st; const float* c1; const float* c2;
    __device__ __forceinline__ void operator()(const f32x4 (&acc)[2][2][4][2], const Unit& u, int wr, int wc, int fr, int fq) const {
        int row0 = u.pm * BM + wr * 64 + fr; const int col0 = u.pn * HALF + wc * 32 + 8 * fq; int wcol0 = u.pn * BM + wc * 32 + 8 * fq;
        asm volatile("" : "+v"(row0), "+v"(wcol0));
        f32x4 c1v[2][2], c2v[2][2];
#pragma unroll
        for (int bj = 0; bj < 2; ++bj)
#pragma unroll
            for (int n = 0; n < 2; ++n) { c1v[bj][n] = *(const f32x4*)(c1 + wcol0 + bj * HALF + 4 * n); c2v[bj][n] = *(const f32x4*)(c2 + wcol0 + bj * HALF + 4 * n); }
#pragma unroll
        for (int ai = 0; ai < 2; ++ai)
#pragma unroll
            for (int m = 0; m < 4; ++m) { const int row = row0 + ai * HALF + m * 16; float mu, rs; ln_row_stats<HAS_LN>(st, row, mu, rs);
                bf16_t* rowp = H + (size_t)row * ldh + col0;
                const f32x4 g0 = (acc[ai][0][m][0] - c1v[0][0] * mu) * rs + c2v[0][0], g1 = (acc[ai][0][m][1] - c1v[0][1] * mu) * rs + c2v[0][1];
                const f32x4 u0 = (acc[ai][1][m][0] - c1v[1][0] * mu) * rs + c2v[1][0], u1 = (acc[ai][1][m][1] - c1v[1][1] * mu) * rs + c2v[1][1];
                u32x4 w;
                w.x = cvt_pk_bf16(silu_mul(g0[0], u0[0]), silu_mul(g0[1], u0[1])); w.y = cvt_pk_bf16(silu_mul(g0[2], u0[2]), silu_mul(g0[3], u0[3]));
                w.z = cvt_pk_bf16(silu_mul(g1[0], u1[0]), silu_mul(g1[1], u1[1])); w.w = cvt_pk_bf16(silu_mul(g1[2], u1[2]), silu_mul(g1[3], u1[3]));
                *(u32x4*)rowp = w; }
    }
};
constexpr size_t EPI_WS_XB = (size_t)166 << 20, EPI_WS_STATS = ((size_t)568 << 20) + ((size_t)1 << 20); constexpr int EPI_T = 32768;
template <bool HAS_LN> struct EpiResidLN {
    static constexpr bool PERM = false, AFTER_DRAIN = false;
    static constexpr int ld = 1024;
    const float* src; float* dst; unsigned char* ws; const float* g_in; const float* b_in; int s_in; float alpha, beta;
    __device__ __forceinline__ void operator()(const f32x4 (&acc)[2][2][4][2], const Unit& u, int wr, int wc, int fr, int fq) const {
        int col0 = u.pn * BM + wc * 32 + 4 * fq; int rowb = u.pm * BM + wr * 64 + fr;
        asm volatile("" : "+v"(col0), "+v"(rowb));
        const float* rd = HAS_LN ? (const float*)dst : src;
        bf16_t* yb = (bf16_t*)(ws + EPI_WS_XB);
        const float* st_in = (const float*)(ws + EPI_WS_STATS) + (size_t)s_in * EPI_T * 2; float* st_out = (float*)(ws + EPI_WS_STATS) + (size_t)(s_in + 1) * EPI_T * 2;
        f32x4 gv[2][2], bv[2][2];
#pragma unroll
        for (int bj = 0; bj < 2; ++bj)
#pragma unroll
            for (int n = 0; n < 2; ++n) { if (HAS_LN) { gv[bj][n] = *(const f32x4*)(g_in + col0 + bj * HALF + n * 16); bv[bj][n] = *(const f32x4*)(b_in + col0 + bj * HALF + n * 16); }
                                          else { gv[bj][n] = (f32x4){1.f, 1.f, 1.f, 1.f}; bv[bj][n] = (f32x4){0.f, 0.f, 0.f, 0.f}; } }
#pragma unroll
        for (int ai = 0; ai < 2; ++ai)
#pragma unroll
            for (int m = 0; m < 4; ++m) { const int row = rowb + ai * HALF + m * 16; const size_t off = (size_t)row * ld + col0;
                float mu, rs; ln_row_stats<HAS_LN>(st_in, row, mu, rs);
                float ps = 0.f, pq = 0.f;
#pragma unroll
                for (int bj = 0; bj < 2; ++bj)
#pragma unroll
                    for (int n = 0; n < 2; ++n) { const f32x4 y = *(const f32x4*)(rd + off + bj * HALF + n * 16);
                        const f32x4 x = HAS_LN ? (y - mu) * rs * gv[bj][n] + bv[bj][n] : y;
                        const f32x4 yn = x * alpha + acc[ai][bj][m][n] * beta;
                        *(f32x4*)(dst + off + bj * HALF + n * 16) = yn;
                        u32x2 w; w.x = cvt_pk_bf16(yn[0], yn[1]); w.y = cvt_pk_bf16(yn[2], yn[3]); *(u32x2*)(yb + off + bj * HALF + n * 16) = w;
                        ps += (yn[0] + yn[1]) + (yn[2] + yn[3]); pq += (yn[0] * yn[0] + yn[1] * yn[1]) + (yn[2] * yn[2] + yn[3] * yn[3]); }
                ps += __shfl_xor(ps, 16); ps += __shfl_xor(ps, 32); pq += __shfl_xor(pq, 16); pq += __shfl_xor(pq, 32);
                if (fq == 0) { atomicAdd(st_out + 2 * (size_t)row, ps); atomicAdd(st_out + 2 * (size_t)row + 1, pq); } }
    }
};
template <class Epi, class Sched, bool ALIGN_EPI = false, bool SP2 = false>
__device__ __forceinline__ void gemm_phase(PG8_LAS unsigned char* lds, const Gemm g, const Sched S, const Epi E) {
    int tid_ = threadIdx.x; asm volatile("" : "+v"(tid_));
    const int tid = tid_, wid = __builtin_amdgcn_readfirstlane(tid >> 6), lane = tid & 63, wr = wid >> 2, wc = wid & 3, fr = lane & 15, fq = lane >> 4;
    const int K = g.K, nt = K / BK;
    unsigned voffA[2], voffB[2];
#pragma unroll
    for (int i = 0; i < 2; ++i) { int R, C; stage_rc(tid * 16 + i * 8192, R, C); const int Rb = Epi::PERM ? ((R & ~31) + perm32(R & 31)) : R;
        voffA[i] = (unsigned)(R * K + C) * 2u; voffB[i] = (unsigned)(Rb * K + C) * 2u; }
    const size_t kstep = (size_t)(BK * 2);
    const size_t hstep = (size_t)HALF * K * 2;
    const size_t tstep = 2 * hstep;
    const unsigned ldsw = (unsigned)wid * 1024u;
    const int aoff = lds_byte(wr * 64 + fr, fq * 8), boff = lds_byte(wc * 32 + fr, fq * 8);
#define PG8_SA(b, h) (((b) * 2 + (h)) * HTB)
#define PG8_SB(b, h) ((4 + (b) * 2 + (h)) * HTB)
#define PG8_STAGE(bufoff, gbase, voff) do { _Pragma("unroll") for (int _i = 0; _i < 2; ++_i) \
        __builtin_amdgcn_global_load_lds((const unsigned*)((const char*)(gbase) + (voff)[_i]), (PG8_LAS unsigned*)(lds + (bufoff) + ldsw + _i * 8192), 16, 0, 0); } while (0)
#define PG8_LDA(dst, b, h) do { _Pragma("unroll") for (int m = 0; m < 4; ++m) _Pragma("unroll") for (int k = 0; k < 2; ++k) dst[m][k] = *(const PG8_LAS bf16x8*)(lds + PG8_SA(b, h) + aoff + m * 2048 + k * 1024); } while (0)
#define PG8_LDB(dst, b, h) do { _Pragma("unroll") for (int n = 0; n < 2; ++n) _Pragma("unroll") for (int k = 0; k < 2; ++k) dst[n][k] = *(const PG8_LAS bf16x8*)(lds + PG8_SB(b, h) + boff + n * 2048 + k * 1024); } while (0)
#define PG8_MMA(ai, bj, At, Bt) do { __builtin_amdgcn_s_setprio(1); _Pragma("unroll") for (int m = 0; m < 4; ++m) _Pragma("unroll") for (int n = 0; n < 2; ++n) _Pragma("unroll") for (int k = 0; k < 2; ++k) \
        acc[ai][bj][m][n] = __builtin_amdgcn_mfma_f32_16x16x32_bf16(Bt[n][k], At[m][k], acc[ai][bj][m][n], 0, 0, 0); __builtin_amdgcn_s_setprio(0); } while (0)
#define PG8_WAIT_V(n) asm volatile("s_waitcnt vmcnt(" #n ")" ::: "memory")
#define PG8_WAIT_L(n) asm volatile("s_waitcnt lgkmcnt(" #n ")" ::: "memory")
#define PG8_BAR __builtin_amdgcn_s_barrier()
#define PG8_SCHED __builtin_amdgcn_sched_barrier(0)
    Unit cur, nxt; int ui = 0;
    if (!S.next(0, cur)) return;
    f32x4 acc[2][2][4][2];
#pragma unroll
    for (int a = 0; a < 2; ++a)
#pragma unroll
        for (int b = 0; b < 2; ++b)
#pragma unroll
            for (int m = 0; m < 4; ++m)
#pragma unroll
                for (int n = 0; n < 2; ++n) acc[a][b][m][n] = (f32x4){0.f, 0.f, 0.f, 0.f};
    bf16x8 At[4][2], B0[2][2], B1[2][2];
    const char* cA = (const char*)g.A + (size_t)cur.pm * tstep; const char* cB = (const char*)g.Bt + (size_t)cur.pn * tstep;
    S.a_ready(cur);
    if constexpr (SP2) {
        PG8_STAGE(PG8_SB(0, 0), cB, voffB); PG8_STAGE(PG8_SB(0, 1), cB + hstep, voffB); PG8_STAGE(PG8_SA(0, 0), cA, voffA); PG8_STAGE(PG8_SA(0, 1), cA + hstep, voffA);
        if (wr == 1) PG8_BAR;
        PG8_WAIT_V(2); PG8_BAR;
        PG8_STAGE(PG8_SB(1, 0), cB + kstep, voffB); PG8_STAGE(PG8_SA(1, 0), cA + kstep, voffA); PG8_STAGE(PG8_SB(1, 1), cB + hstep + kstep, voffB);
        PG8_WAIT_V(6); PG8_BAR;
    } else {
        PG8_STAGE(PG8_SB(0, 0), cB, voffB); PG8_STAGE(PG8_SA(0, 0), cA, voffA); PG8_STAGE(PG8_SB(0, 1), cB + hstep, voffB); PG8_STAGE(PG8_SA(0, 1), cA + hstep, voffA);
        if (wr == 1) PG8_BAR;
        PG8_WAIT_V(4); PG8_BAR;
        PG8_STAGE(PG8_SB(1, 0), cB + kstep, voffB); PG8_STAGE(PG8_SA(1, 0), cA + kstep, voffA); PG8_STAGE(PG8_SB(1, 1), cB + hstep + kstep, voffB);
        PG8_WAIT_V(6); PG8_BAR;
    }
    for (;;) {
        const bool has_next = S.next(ui + 1, nxt);
        const char* nA = has_next ? (const char*)g.A + (size_t)nxt.pm * tstep : cA; const char* nB = has_next ? (const char*)g.Bt + (size_t)nxt.pn * tstep : cB;
        for (int t = 0; t < nt; t += 2) {
            const bool last = (t == nt - 2);
            const char* a1 = cA + (size_t)(t + 1) * kstep;
            const char* a2 = last ? nA : cA + (size_t)(t + 2) * kstep; const char* b2 = last ? nB : cB + (size_t)(t + 2) * kstep;
            const char* a3 = a2 + kstep; const char* b3 = b2 + kstep;
            if (last && has_next) S.a_ready(nxt);
            if constexpr (SP2) {
            PG8_LDB(B0, 0, 0); PG8_LDB(B1, 0, 1); PG8_SCHED; PG8_LDA(At, 0, 0); PG8_STAGE(PG8_SA(1, 1), a1 + hstep, voffA);
            PG8_WAIT_V(8); PG8_WAIT_L(0); PG8_BAR; PG8_MMA(0, 0, At, B0); PG8_MMA(0, 1, At, B1); PG8_BAR; PG8_SCHED;
            PG8_LDA(At, 0, 1); PG8_STAGE(PG8_SB(0, 0), b2, voffB); PG8_STAGE(PG8_SB(0, 1), b2 + hstep, voffB); PG8_STAGE(PG8_SA(0, 0), a2, voffA);
            PG8_WAIT_V(8); PG8_WAIT_L(0); PG8_BAR; PG8_MMA(1, 0, At, B0); PG8_MMA(1, 1, At, B1); PG8_BAR; PG8_SCHED;
            PG8_LDB(B0, 1, 0); PG8_LDB(B1, 1, 1); PG8_SCHED; PG8_LDA(At, 1, 0); PG8_STAGE(PG8_SA(0, 1), a2 + hstep, voffA);
            PG8_WAIT_V(8); PG8_WAIT_L(0); PG8_BAR; PG8_MMA(0, 0, At, B0); PG8_MMA(0, 1, At, B1); PG8_BAR; PG8_SCHED;
            PG8_LDA(At, 1, 1); PG8_STAGE(PG8_SB(1, 0), b3, voffB); PG8_STAGE(PG8_SB(1, 1), b3 + hstep, voffB); PG8_STAGE(PG8_SA(1, 0), a3, voffA);
            PG8_WAIT_V(8); PG8_WAIT_L(0); PG8_BAR; PG8_MMA(1, 0, At, B0); PG8_MMA(1, 1, At, B1); PG8_BAR; PG8_SCHED;
            } else {
            PG8_LDB(B0, 0, 0); PG8_SCHED; PG8_LDA(At, 0, 0); PG8_STAGE(PG8_SA(1, 1), a1 + hstep, voffA);
            PG8_WAIT_L(8); PG8_BAR; PG8_WAIT_L(0); PG8_MMA(0, 0, At, B0); PG8_BAR; PG8_SCHED;
            PG8_LDB(B1, 0, 1); PG8_STAGE(PG8_SB(0, 0), b2, voffB);
            PG8_BAR; PG8_WAIT_L(0); PG8_MMA(0, 1, At, B1); PG8_BAR;
            PG8_LDA(At, 0, 1); PG8_STAGE(PG8_SA(0, 0), a2, voffA);
            PG8_BAR; PG8_WAIT_L(0); PG8_MMA(1, 0, At, B0); PG8_BAR; PG8_SCHED;
            PG8_STAGE(PG8_SB(0, 1), b2 + hstep, voffB);
            PG8_WAIT_V(6); PG8_BAR; PG8_MMA(1, 1, At, B1); PG8_BAR;
            PG8_LDB(B0, 1, 0); PG8_SCHED; PG8_LDA(At, 1, 0); PG8_STAGE(PG8_SA(0, 1), a2 + hstep, voffA);
            PG8_WAIT_L(8); PG8_BAR; PG8_WAIT_L(0); PG8_MMA(0, 0, At, B0); PG8_BAR; PG8_SCHED;
            PG8_LDB(B1, 1, 1); PG8_STAGE(PG8_SB(1, 0), b3, voffB);
            PG8_BAR; PG8_WAIT_L(0); PG8_MMA(0, 1, At, B1); PG8_BAR;
            PG8_LDA(At, 1, 1); PG8_STAGE(PG8_SA(1, 0), a3, voffA);
            PG8_BAR; PG8_WAIT_L(0); PG8_MMA(1, 0, At, B0); PG8_BAR; PG8_SCHED;
            PG8_STAGE(PG8_SB(1, 1), b3 + hstep, voffB);
            PG8_WAIT_V(6); PG8_BAR; PG8_MMA(1, 1, At, B1); PG8_BAR;
            }
        }
        if constexpr (ALIGN_EPI) { if (wr == 0) PG8_BAR; }
        if constexpr (!Epi::AFTER_DRAIN) { E(acc, cur, wr, wc, fr, fq); S.done(cur); }
        if (!has_next) break;
#pragma unroll
        for (int a = 0; a < 2; ++a)
#pragma unroll
            for (int b = 0; b < 2; ++b)
#pragma unroll
                for (int m = 0; m < 4; ++m)
#pragma unroll
                    for (int n = 0; n < 2; ++n) acc[a][b][m][n] = (f32x4){0.f, 0.f, 0.f, 0.f};
        cur = nxt; cA = nA; cB = nB; ++ui;
        if constexpr (ALIGN_EPI) { if (wr == 1) PG8_BAR; }
    }
    PG8_WAIT_V(0);
    if constexpr (!ALIGN_EPI) { if (wr == 0) PG8_BAR; }
    PG8_BAR;
    if constexpr (Epi::AFTER_DRAIN) { E.fused(acc, cur, wr, wc, fr, fq, lds, wid, lane); S.done(cur); }
#undef PG8_SA
#undef PG8_SB
#undef PG8_STAGE
#undef PG8_LDA
#undef PG8_LDB
#undef PG8_MMA
#undef PG8_WAIT_V
#undef PG8_WAIT_L
#undef PG8_BAR
#undef PG8_SCHED
}
}
#define LAS __attribute__((address_space(3)))
typedef unsigned short bf16_t;
typedef short bf16x8 __attribute__((ext_vector_type(8)));
typedef short s16x4 __attribute__((ext_vector_type(4)));
typedef float f32x4 __attribute__((ext_vector_type(4)));
typedef float f32x16 __attribute__((ext_vector_type(16)));
typedef unsigned u32x4 __attribute__((ext_vector_type(4)));
typedef unsigned u32x2 __attribute__((ext_vector_type(2)));
typedef float f32x2_t __attribute__((ext_vector_type(2)));
typedef __bf16 bf16x2_t __attribute__((ext_vector_type(2)));

constexpr int NB = 2, SEQ = 16384, T = NB * SEQ, DM = 1024, DEPTH = 4, DFF = 2816, NGU = 2 * DFF;
constexpr int NIN_SRC = 2208, NPROJ = 3328;
constexpr int PA = 0, PC = 512, PD = 1024, PCQ = 1792, PCKV = 2048, PKR = 2176, PQUP = 2208, PKVUP = 2592, PEND = 3104;
constexpr float LOG2E = 1.4426950408889634f;
constexpr float NORM_EPS = 1e-5f;
constexpr int NWAVES = 8, NTHREADS = 512;
constexpr int LDS_BYTES = 147456;

constexpr size_t MiB = 1u << 20;
constexpr size_t WS_WGU = 0, WS_WD = 88 * MiB, WS_WIN = 132 * MiB, WS_WOUT = 158 * MiB, WS_XB = 166 * MiB;
constexpr size_t WS_H = 230 * MiB, WS_PROJ = 230 * MiB, WS_QB = 438 * MiB, WS_KB = 462 * MiB, WS_VB = 486 * MiB, WS_MIX = 502 * MiB, WS_AUG = 566 * MiB, WS_CTL = 568 * MiB, WS_KMAX = WS_CTL, WS_C12 = WS_CTL + 4096, WS_BAR = WS_CTL + 512 * 1024, WS_STATS = WS_CTL + 1 * MiB, CTL_BYTES = 4 * MiB, WS_END = 572 * MiB;
constexpr int C12_L = 2 * NGU + NPROJ;
constexpr size_t C2_OFF = (size_t)DEPTH * C12_L;
static_assert(pg8::EPI_WS_XB == WS_XB && pg8::EPI_WS_STATS == WS_STATS && pg8::EPI_T == T, "part1's copies of the workspace map");
static_assert(WS_C12 + 2 * C2_OFF * 4 <= WS_BAR && WS_BAR + 3456 * 4 <= WS_STATS, "control region");
static_assert(WS_C12 + 2 * C2_OFF * 4 <= WS_STATS && WS_STATS + (size_t)12 * T * 8 <= WS_CTL + CTL_BYTES, "control region");
constexpr size_t WGU_L = (size_t)2 * NGU * DM, WGU_F = (size_t)NGU * DM;
constexpr size_t WD_L = (size_t)2 * DM * DFF, WD_F = (size_t)DM * DFF;
constexpr size_t WIN_L = (size_t)NPROJ * DM, WOUT_L = (size_t)DM * DM;

struct Params {
    const float* x; const float* w_in; const float* win_sink; const float* mla_q_norm; const float* mla_w_uq; const float* mla_kv_norm; const float* mla_w_ukv;
    const float* ax_q_norm; const float* ax_k_norm; const float* diff_lambda; const float* diff_subln; const float* w_out; const float* ffn_w_gu; const float* ffn_w_down;
    const float* ln_g; const float* ln_b;
    float* out; unsigned char* ws;
    float lam_init[4];
    float inv32[16];
};

typedef const __attribute__((address_space(4))) Params* KP;
#define GETP(name) KP name = (KP)__builtin_amdgcn_kernarg_segment_ptr(); asm volatile("" : "+s"(name))

__device__ __forceinline__ int tid_fresh() { int t = threadIdx.x; asm volatile("" : "+v"(t)); return t; }
__device__ __forceinline__ unsigned pkbf(float lo, float hi) { f32x2_t v = {lo, hi}; bf16x2_t b = __builtin_convertvector(v, bf16x2_t); return __builtin_bit_cast(unsigned, b); }
__device__ __forceinline__ float bflo(unsigned w) { return __builtin_bit_cast(float, w << 16); }
__device__ __forceinline__ float bfhi(unsigned w) { return __builtin_bit_cast(float, w & 0xffff0000u); }
__device__ __forceinline__ float wave_sum(float v) {
#pragma unroll
    for (int o = 1; o < 64; o <<= 1) v += __shfl_xor(v, o);
    return v;
}
__device__ __forceinline__ void unpack8(const u32x4 w, float (&v)[8]) {
    v[0] = bflo(w.x); v[1] = bfhi(w.x); v[2] = bflo(w.y); v[3] = bfhi(w.y); v[4] = bflo(w.z); v[5] = bfhi(w.z); v[6] = bflo(w.w); v[7] = bfhi(w.w);
}
__device__ __forceinline__ u32x4 pack8(const float (&v)[8]) { u32x4 w; w.x = pkbf(v[0], v[1]); w.y = pkbf(v[2], v[3]); w.z = pkbf(v[4], v[5]); w.w = pkbf(v[6], v[7]); return w; }

__device__ __forceinline__ void transpose_item(const float* __restrict__ W, int ldw, int src_col0, float scale, bf16_t* __restrict__ WT, int K, int dst_row0, int k0, LAS float* scr, int lane,
                                               const float* __restrict__ lng, const float* __restrict__ lnb, float* c1, float* c2) {
    if (src_col0 < 0) {
        const int c = lane & 7;
#pragma unroll
        for (int j = 0; j < 4; ++j) { const int n = (lane >> 3) + 8 * j; *(u32x4*)(WT + (size_t)(dst_row0 + n) * K + k0 + 8 * c) = (u32x4){0u, 0u, 0u, 0u}; }
        return;
    }
    float a1 = 0.f, a2 = 0.f;
#pragma unroll
    for (int i = 0; i < 32; ++i) { const int kk = 2 * i + (lane >> 5); float w = W[(size_t)(k0 + kk) * ldw + src_col0 + (lane & 31)] * scale;
        if (lng) { a2 = fmaf(lnb[k0 + kk], w, a2); w *= lng[k0 + kk]; a1 += bflo(pkbf(w, 0.f)); }
        scr[kk * 33 + (lane & 31)] = w; }
    asm volatile("s_waitcnt lgkmcnt(0)" ::: "memory");
    const int c = lane & 7;
#pragma unroll
    for (int j = 0; j < 4; ++j) { const int n = (lane >> 3) + 8 * j; const LAS float* s = scr + (8 * c) * 33 + n;
        u32x4 o; o.x = pkbf(s[0 * 33], s[1 * 33]); o.y = pkbf(s[2 * 33], s[3 * 33]); o.z = pkbf(s[4 * 33], s[5 * 33]); o.w = pkbf(s[6 * 33], s[7 * 33]);
        *(u32x4*)(WT + (size_t)(dst_row0 + n) * K + k0 + 8 * c) = o; }
    asm volatile("s_waitcnt lgkmcnt(0)" ::: "memory");
    if (lng) { a1 += __shfl_xor(a1, 32); a2 += __shfl_xor(a2, 32);
        if (lane < 32) { atomicAdd(c1 + dst_row0 + lane, a1); atomicAdd(c2 + dst_row0 + lane, a2); } }
}

__device__ __forceinline__ void phase0(KP p, LAS unsigned char* lds, int vcu, int G) {
    const int tid = tid_fresh(), lane = tid & 63, wave = __builtin_amdgcn_readfirstlane(tid >> 6);
    LAS float* scr = (LAS float*)(lds + wave * 16384);
    const int gw = vcu * NWAVES + wave, NGW = G * NWAVES;
    bf16_t* wgu = (bf16_t*)(p->ws + WS_WGU); bf16_t* wd = (bf16_t*)(p->ws + WS_WD); bf16_t* win = (bf16_t*)(p->ws + WS_WIN); bf16_t* wout = (bf16_t*)(p->ws + WS_WOUT);
    float* c12 = (float*)(p->ws + WS_C12);
    constexpr int I_GU = 176 * 16, I_WD = 32 * 44, I_IN = 104 * 16, I_OUT = 32 * 16, I_CMP = 128 * 14;
    constexpr int I_LAYER = 2 * I_GU + 2 * I_WD + I_IN + I_OUT + I_CMP;
    for (int it = gw; it < DEPTH * I_LAYER; it += NGW) {
        const int l = it / I_LAYER; int r = it % I_LAYER;
        if (r < 2 * I_GU) { const int f = r / I_GU; r %= I_GU; const int nb = r / 16, kb = r % 16; const int n0 = 32 * nb;
            const int pn = n0 >> 8, bj = (n0 >> 7) & 1, i0 = n0 & 127;
            const int s = 3 * l + 2 * f - 1;
            transpose_item(p->ffn_w_gu + ((size_t)l * 2 + f) * DM * NGU, NGU, bj * DFF + 128 * pn + i0, 1.f, wgu + l * WGU_L + f * WGU_F, DM, n0, 64 * kb, scr, lane,
                           s >= 0 ? p->ln_g + s * DM : nullptr, s >= 0 ? p->ln_b + s * DM : nullptr, c12 + l * C12_L + f * NGU, c12 + C2_OFF + l * C12_L + f * NGU); continue; }
        r -= 2 * I_GU;
        if (r < 2 * I_WD) { const int f = r / I_WD; r %= I_WD; const int nb = r / 44, kb = r % 44;
            transpose_item(p->ffn_w_down + ((size_t)l * 2 + f) * DFF * DM, DM, 32 * nb, 1.f, wd + l * WD_L + f * WD_F, DFF, 32 * nb, 64 * kb, scr, lane, nullptr, nullptr, nullptr, nullptr); continue; }
        r -= 2 * I_WD;
        if (r < I_IN) { const int nb = r / 16, kb = r % 16; const int n0 = 32 * nb; int src; float sc = 1.f;
            if (n0 < PC) { src = n0; if (n0 < 256) sc = 0.125f; }
            else if (n0 < PD) src = 928 + (n0 - PC);
            else if (n0 < PCQ) { src = 1440 + (n0 - PD); if (n0 - PD < 256) sc = 0.17677669529663687f; }
            else if (n0 < PCKV) src = 512 + (n0 - PCQ);
            else if (n0 < PKR) src = 768 + (n0 - PCKV);
            else if (n0 < PQUP) src = 896;
            else if (n0 < PEND) continue;
            else src = -1;
            transpose_item(p->w_in + (size_t)l * DM * NIN_SRC, NIN_SRC, src, sc, win + l * WIN_L, DM, n0, 64 * kb, scr, lane,
                           p->ln_g + (3 * l) * DM, p->ln_b + (3 * l) * DM, c12 + l * C12_L + 2 * NGU, c12 + C2_OFF + l * C12_L + 2 * NGU); continue; }
        r -= I_IN;
        if (r < I_OUT) { const int nb = r / 16, kb = r % 16;
            transpose_item(p->w_out + (size_t)l * DM * DM, DM, 32 * nb, 1.f, wout + l * WOUT_L, DM, 32 * nb, 64 * kb, scr, lane, nullptr, nullptr, nullptr, nullptr); continue; }
        r -= I_OUT;
        {
            const int kb8 = r / 14, ng = r % 14; const int k0 = 8 * kb8;
            int J, cA, ldu, nc; const float* g; const float* U;
            if (ng < 6) { J = 256; cA = 512; g = p->mla_q_norm + l * 256; U = p->mla_w_uq + (size_t)l * 256 * 384; ldu = 384; nc = 64 * ng; }
            else { J = 128; cA = 768; g = p->mla_kv_norm + l * 128; U = p->mla_w_ukv + (size_t)l * 128 * 512; ldu = 512; nc = 64 * (ng - 6); }
            const int nglob = (ng < 6 ? 0 : 384) + nc + lane;
            const float* a = p->w_in + (size_t)l * DM * NIN_SRC + (size_t)k0 * NIN_SRC + cA;
            const float* up = U + nc + lane;
            float acc[8];
#pragma unroll
            for (int e = 0; e < 8; ++e) acc[e] = 0.f;
#pragma unroll 4
            for (int j = 0; j < J; ++j) { const float u = up[(size_t)j * ldu] * g[j];
#pragma unroll
                for (int e = 0; e < 8; ++e) acc[e] = fmaf(a[(size_t)e * NIN_SRC + j], u, acc[e]); }
            const float* lg = p->ln_g + (3 * l) * DM + k0; const float* lb = p->ln_b + (3 * l) * DM + k0;
            float s1 = 0.f, s2 = 0.f; unsigned wb[8];
#pragma unroll
            for (int e = 0; e < 8; ++e) { wb[e] = pkbf(acc[e] * lg[e], 0.f) & 0xffffu; s1 += bflo(wb[e]); s2 = fmaf(acc[e], lb[e], s2); }
            u32x4 o; o.x = wb[0] | (wb[1] << 16); o.y = wb[2] | (wb[3] << 16); o.z = wb[4] | (wb[5] << 16); o.w = wb[6] | (wb[7] << 16);
            *(u32x4*)(win + l * WIN_L + (size_t)(PQUP + nglob) * DM + k0) = o;
            atomicAdd(c12 + l * C12_L + 2 * NGU + PQUP + nglob, s1); atomicAdd(c12 + C2_OFF + l * C12_L + 2 * NGU + PQUP + nglob, s2);
        }
    }
    { u32x4* ag = (u32x4*)(p->ws + WS_AUG);
      for (int i = (vcu * NWAVES + wave) * 64 + lane; i < SEQ * 4; i += G * NWAVES * 64) { const int t = i >> 2, h = i & 3;
          const float sl = __builtin_amdgcn_exp2f(-(float)(5 + h));
          u32x4 w = {pkbf(sl * (float)(128 * (t >> 7)), sl * (float)(t & 127)), 0u, 0u, 0u}; ag[2 * i] = w; ag[2 * i + 1] = (u32x4){0u, 0u, 0u, 0u}; } }
    bf16_t* xb = (bf16_t*)(p->ws + WS_XB);
    for (int m = gw; m < T; m += NGW) {
        const f32x4* xr = (const f32x4*)(p->x + (size_t)m * DM) + lane; u32x2* o8 = (u32x2*)(xb + (size_t)m * DM) + lane;
#pragma unroll
        for (int j = 0; j < 4; ++j) { const f32x4 v = xr[64 * j]; u32x2 w; w.x = pkbf(v.x, v.y); w.y = pkbf(v.z, v.w); o8[64 * j] = w; }
    }
}

__device__ __forceinline__ void ln_phase(float* X, bf16_t* xb, const float* __restrict__ g, const float* __restrict__ b, int vcu, int G) {
    const int tid = tid_fresh(), lane = tid & 63, wave = __builtin_amdgcn_readfirstlane(tid >> 6);
    const int gw = vcu * NWAVES + wave, NGW = G * NWAVES;
    f32x4 gv[4], bv[4];
#pragma unroll
    for (int j = 0; j < 4; ++j) { gv[j] = ((const f32x4*)g)[64 * j + lane]; bv[j] = ((const f32x4*)b)[64 * j + lane]; }
    for (int m = gw; m < T; m += NGW) {
        f32x4* xr = (f32x4*)(X + (size_t)m * DM) + lane; u32x2* o8 = (u32x2*)(xb + (size_t)m * DM) + lane;
        f32x4 v[4]; float s = 0.f;
#pragma unroll
        for (int j = 0; j < 4; ++j) { v[j] = xr[64 * j]; s += (v[j].x + v[j].y) + (v[j].z + v[j].w); }
        const float mean = wave_sum(s) * (1.f / DM); float s2 = 0.f;
#pragma unroll
        for (int j = 0; j < 4; ++j) { v[j] = v[j] - mean; s2 += (v[j].x * v[j].x + v[j].y * v[j].y) + (v[j].z * v[j].z + v[j].w * v[j].w); }
        const float rstd = 1.f / sqrtf(wave_sum(s2) * (1.f / DM) + NORM_EPS);
#pragma unroll
        for (int j = 0; j < 4; ++j) { const f32x4 y = v[j] * rstd * gv[j] + bv[j]; xr[64 * j] = y; u32x2 w; w.x = pkbf(y.x, y.y); w.y = pkbf(y.z, y.w); o8[64 * j] = w; }
    }
}

__device__ __forceinline__ void sincos_rev(float ang, float& s, float& c) {
    double d = (double)ang * 0.15915494309189535; d -= __builtin_rint(d); const float f = (float)d;
    s = __builtin_amdgcn_sinf(f); c = __builtin_amdgcn_cosf(f);
}
__device__ __forceinline__ void rope8(float (&v)[8], bool first, float pos, int i0, KP p) {
#pragma unroll
    for (int e = 0; e < 8; ++e) {
        const float other = __shfl_xor(v[e], 2);
        const float inv = i0 ? p->inv32[8 + e] : p->inv32[e];
        float s, c; sincos_rev(pos * inv, s, c);
        v[e] = first ? (v[e] * c - other * s) : (other * s + v[e] * c);
    }
}
__device__ __forceinline__ void prep_phase(KP p, int l, int vcu, int G) {
    const int tid = tid_fresh(), lane = tid & 63, wave = __builtin_amdgcn_readfirstlane(tid >> 6);
    const int gw = vcu * NWAVES + wave, NGW = G * NWAVES;
    bf16_t* proj = (bf16_t*)(p->ws + WS_PROJ); bf16_t* qb = (bf16_t*)(p->ws + WS_QB); bf16_t* kb = (bf16_t*)(p->ws + WS_KB); bf16_t* vb = (bf16_t*)(p->ws + WS_VB);
    float cg[8];
    { const float* gsrc = (lane < 32 ? p->ax_q_norm : p->ax_k_norm) + l * 64 + 8 * (lane & 7);
#pragma unroll
      for (int e = 0; e < 8; ++e) cg[e] = gsrc[e]; }
    float km0 = 0.f, km1 = 0.f;
    float kb0 = 0.f, kb1 = 0.f, kc0 = 0.f, kc1 = 0.f;
    for (int tok = gw; tok < T; tok += NGW) {
        const int t = tok & (SEQ - 1);
        bf16_t* pr = proj + (size_t)tok * NPROJ;
        const int l48 = lane < 48 ? lane : 0, l32 = lane < 32 ? lane : 0, l4 = lane < 4 ? lane : 0;
        const u32x4 in_cq = *(const u32x4*)(pr + PCQ + 8 * l48), in_qup = *(const u32x4*)(pr + PQUP + 8 * l48), in_kv = *(const u32x4*)(pr + PKVUP + 8 * lane);
        const u32x4 in_kr = *(const u32x4*)(pr + PKR + 8 * l4), in_c = *(const u32x4*)(pr + PC + 8 * l48), in_dk = *(const u32x4*)(pr + PD + 256 + 8 * l32);
        { float s = 0.f;
          if (lane < 32) { float v[8]; unpack8(in_dk, v);
#pragma unroll
              for (int e = 0; e < 8; ++e) s += v[e] * v[e]; }
          s += __shfl_xor(s, 1); s += __shfl_xor(s, 2);
          if (tok < SEQ) km0 = fmaxf(km0, s); else km1 = fmaxf(km1, s); }
        float ssq = 0.f;
        if (lane < 48) { float v[8]; unpack8(in_cq, v);
#pragma unroll
            for (int e = 0; e < 8; ++e) ssq += v[e] * v[e]; }
        const float ssq_q = wave_sum(lane < 32 ? ssq : 0.f), ssq_kv = wave_sum(lane >= 32 ? ssq : 0.f);
        const float rstd_q = 1.f / sqrtf(ssq_q * (1.f / 256.f) + NORM_EPS), rstd_kv = 1.f / sqrtf(ssq_kv * (1.f / 128.f) + NORM_EPS);
        {
            const int r = lane % 12; float v[8];
            unpack8(in_qup, v);
#pragma unroll
            for (int e = 0; e < 8; ++e) v[e] = (lane < 48) ? v[e] * rstd_q : 0.f;
            float w[8];
#pragma unroll
            for (int e = 0; e < 8; ++e) w[e] = v[e];
            rope8(w, r < 10, (float)t, 8 * (r & 1), p);
            const bool isr = (r >= 8); const float qs = 0.10206207261596575f;
#pragma unroll
            for (int e = 0; e < 8; ++e) v[e] = (isr ? w[e] : v[e]) * qs;
            if (lane < 48) *(u32x4*)(qb + (size_t)tok * 384 + 8 * lane) = pack8(v);
        }
        float nope2;
        {
            float v[8]; unpack8(in_kv, v);
#pragma unroll
            for (int e = 0; e < 8; ++e) v[e] *= rstd_kv;
            const int hd = lane >> 4, r = lane & 15;
            { float s = 0.f;
#pragma unroll
              for (int e = 0; e < 8; ++e) s += v[e] * v[e];
              s = (r < 8) ? s : 0.f; s += __shfl_xor(s, 1); s += __shfl_xor(s, 2); s += __shfl_xor(s, 4); nope2 = s; }
            if (r < 8) *(u32x4*)(kb + (size_t)tok * 384 + hd * 96 + 8 * r) = pack8(v);
            else *(u32x4*)(vb + (size_t)tok * 256 + hd * 64 + 8 * (r - 8)) = pack8(v);
        }
        {
            float v[8]; unpack8(in_kr, v);
            rope8(v, (lane & 3) < 2, (float)t, 8 * (lane & 1), p);
            { float s = 0.f;
#pragma unroll
              for (int e = 0; e < 8; ++e) s += v[e] * v[e];
              s = (lane < 4) ? s : 0.f; s += __shfl_xor(s, 1); s += __shfl_xor(s, 2);
              const float kk = nope2 + __shfl(s, 0);
              if (tok < SEQ) kb0 = fmaxf(kb0, kk); else kb1 = fmaxf(kb1, kk); }
            if (lane < 4) { const u32x4 w = pack8(v);
#pragma unroll
                for (int hd = 0; hd < 4; ++hd) *(u32x4*)(kb + (size_t)tok * 384 + hd * 96 + 64 + 8 * lane) = w; }
        }
        {
            float v[8]; unpack8(in_c, v);
            float s = 0.f;
#pragma unroll
            for (int e = 0; e < 8; ++e) s += v[e] * v[e];
            s += __shfl_xor(s, 1); s += __shfl_xor(s, 2); s += __shfl_xor(s, 4);
            const float rs = 1.f / sqrtf(s * (1.f / 64.f) + NORM_EPS);
#pragma unroll
            for (int e = 0; e < 8; ++e) v[e] = v[e] * rs * cg[e];
            const int r = lane & 7; const float pos = (r < 4) ? (float)(t >> 6) : (float)(t & 63);
            rope8(v, (r & 3) < 2, pos, 8 * (r & 1), p);
            { float s2 = 0.f;
#pragma unroll
              for (int e = 0; e < 8; ++e) s2 += v[e] * v[e];
              s2 += __shfl_xor(s2, 1); s2 += __shfl_xor(s2, 2); s2 += __shfl_xor(s2, 4);
              if (tok < SEQ) kc0 = fmaxf(kc0, s2); else kc1 = fmaxf(kc1, s2); }
            if (lane < 32) {
#pragma unroll
                for (int e = 0; e < 8; ++e) v[e] *= 0.125f; }
            if (lane < 48) *(u32x4*)(pr + PC + 8 * lane) = pack8(v);
        }
    }
    unsigned* kmw = (unsigned*)(p->ws + WS_KMAX) + l * 32;
    if (lane < 32 && (lane & 3) == 0) { atomicMax(kmw + (lane >> 2), __builtin_bit_cast(unsigned, km0)); atomicMax(kmw + 8 + (lane >> 2), __builtin_bit_cast(unsigned, km1)); }
    if ((lane & 15) == 0) { atomicMax(kmw + 16 + (lane >> 4), __builtin_bit_cast(unsigned, kb0)); atomicMax(kmw + 20 + (lane >> 4), __builtin_bit_cast(unsigned, kb1)); }
    if (lane == 32 || lane == 40) { atomicMax(kmw + 24 + ((lane - 32) >> 3), __builtin_bit_cast(unsigned, kc0)); atomicMax(kmw + 26 + ((lane - 32) >> 3), __builtin_bit_cast(unsigned, kc1)); }
}

#ifndef ATT_TYPES
#define ATT_TYPES 15
#endif
namespace att {
typedef float f32x2 __attribute__((ext_vector_type(2)));
constexpr int VPITCH = 144, KBUF = 64 * 208, VBUF = 64 * VPITCH;
constexpr int ATT_LDS = 2 * KBUF + 2 * VBUF;
constexpr float RESCALE_T = 5.0f;
__device__ __forceinline__ s16x4 vtr(const LAS char* p) { return __builtin_bit_cast(s16x4, __builtin_amdgcn_ds_read_tr16_b64_v4i16((LAS s16x4*)p)); }
__device__ __forceinline__ void xhalf_swap(float m, float& a, float& b) {
    a = m; b = m;
    asm volatile("s_nop 1\n\tv_permlane32_swap_b32 %0, %1\n\ts_nop 1" : "+v"(a), "+v"(b));
}
__device__ __forceinline__ float xhalf_max(float m) { float a, b; xhalf_swap(m, a, b); return fmaxf(a, b); }
__device__ __forceinline__ float xhalf_sum(float m) { float a, b; xhalf_swap(m, a, b); return a + b; }
__device__ __forceinline__ float max3f(float a, float b, float c) { return fmaxf(fmaxf(a, b), c); }
__device__ __forceinline__ float fma_s(float a, float b, float c) { float r; asm("v_fma_f32 %0, %1, %2, %3" : "=v"(r) : "v"(a), "s"(b), "v"(c)); return r; }
__device__ __forceinline__ float add_s(float a, float b) { float r; asm("v_add_f32_e32 %0, %1, %2" : "=v"(r) : "v"(a), "v"(b)); return r; }
__device__ __forceinline__ float mul_s(float a, float b) { float r; asm("v_mul_f32_e32 %0, %1, %2" : "=v"(r) : "v"(a), "v"(b)); return r; }
#define ATT_MFMA(a, b, c) __builtin_amdgcn_mfma_f32_32x32x16_bf16((a), (b), (c), 0, 0, 0)

template <int DK, int MODE, bool INIT = true, bool TRACK = (MODE == 2)>
__device__ __forceinline__ void flash_pass(LAS char* lds, const bf16_t* __restrict__ Qg, int qp, const bf16_t* __restrict__ Kg, int kp, const bf16_t* __restrict__ Vg, int vp,
                                           const bf16_t* __restrict__ AUGg, int q0, int a0, int nA, int b0, int nt, float slope, f32x16& O0, f32x16& O1, float& Mout, float& Lout) {
    constexpr int DKL = DK + (MODE == 1 ? 16 : 0);
    constexpr int KPITCH = DKL * 2 + 16, NKC = 8 * DKL, CPR = DKL / 8, NKS = DK / 16;
    constexpr bool HAS_K1 = NKC > 512;
    constexpr int DUMMY = 2 * KBUF + 2 * VBUF;
    const int tid = tid_fresh(), lane = tid & 63, r32 = lane & 31, hi = lane >> 5; const int wid = __builtin_amdgcn_readfirstlane(tid >> 6);
    const int qrow = q0 + wid * 32 + r32;
    bf16x8 qf[NKS];
#pragma unroll
    for (int ks = 0; ks < NKS; ++ks) qf[ks] = *(const bf16x8*)(Qg + (size_t)qrow * qp + 16 * ks + 8 * hi);
    const int kc1 = tid + 512;
    const bool k0v = tid < NKC, k1v = HAS_K1 && kc1 < NKC;
    const int kr0 = k0v ? tid / CPR : 0, kcc0 = k0v ? tid % CPR : 0, kr1 = k1v ? kc1 / CPR : 0, kcc1 = k1v ? kc1 % CPR : 0, vr = tid >> 3, vcc = tid & 7;
    const bf16_t* kg0; size_t kst0;
    if (MODE == 1 && kcc0 >= DK / 8) { kg0 = AUGg + (size_t)kr0 * 64 + 8 * (kcc0 - DK / 8); kst0 = (size_t)64 * 64; } else { kg0 = Kg + (size_t)kr0 * kp + 8 * kcc0; kst0 = (size_t)64 * kp; }
    const bf16_t* kg1 = Kg + (size_t)kr1 * kp + 8 * kcc1; const size_t kst1 = (size_t)64 * kp;
    const bf16_t* vg = Vg + (size_t)vr * vp + 8 * vcc; const size_t vst = (size_t)64 * vp;
    const int kl0 = k0v ? kr0 * KPITCH + 16 * kcc0 : -1, kl1 = k1v ? kr1 * KPITCH + 16 * kcc1 : -1, vl = 2 * KBUF + vr * VPITCH + 16 * vcc;
    u32x4 rk0 = {0u, 0u, 0u, 0u}, rk1 = {0u, 0u, 0u, 0u}, rv = {0u, 0u, 0u, 0u};
#define ATT_KT(i) ((i) < nA ? a0 + (i) : b0 + ((i) - nA))
#define ATT_LOADK(kt) do { const size_t t_ = (size_t)(kt); rk0 = *(const u32x4*)(kg0 + t_ * kst0); if (HAS_K1) rk1 = *(const u32x4*)(kg1 + t_ * kst1); } while (0)
#define ATT_LOADV(kt) do { rv = *(const u32x4*)(vg + (size_t)(kt) * vst); } while (0)
#define ATT_STOREK(buf) do { *(LAS u32x4*)(lds + (kl0 >= 0 ? (buf) * KBUF + kl0 : DUMMY + tid * 16)) = rk0; if (HAS_K1) *(LAS u32x4*)(lds + (kl1 >= 0 ? (buf) * KBUF + kl1 : DUMMY + tid * 16)) = rk1; } while (0)
#define ATT_STOREV(buf) do { *(LAS u32x4*)(lds + (buf) * VBUF + vl) = rv; } while (0)
    const int q4 = (lane & 15) >> 2, p4 = lane & 3, b16 = (lane >> 4) & 1;
    const int vbase = 2 * KBUF + (4 * hi + q4) * VPITCH + 32 * b16 + 8 * p4;
    const int kbase = r32 * KPITCH + 16 * hi;
    const int qw = q0 + wid * 32;
    const float stq = slope * (float)qrow;
    const bf16x8 qzero = {0, 0, 0, 0, 0, 0, 0, 0};
    bf16x8 qpos = qzero, qneg = qzero;
    if (MODE == 1 && hi == 0) { qpos[0] = (short)0x3F80; qpos[1] = (short)0x3F80; qneg[0] = (short)0xBF80; qneg[1] = (short)0xBF80; }
    constexpr int NKF = NKS + (MODE == 1 ? 1 : 0);
    constexpr int KPRE = NKF > 4 ? 4 : NKF;
    bf16x8 kfa[NKF], kfb[NKF];
#define ATT_KREAD(kbuf, f0, f1) do { const LAS char* Kb_ = lds + (kbuf) * KBUF + kbase; \
        _Pragma("unroll") for (int ks_ = (f0); ks_ < (f1); ++ks_) { kfa[ks_] = *(const LAS bf16x8*)(Kb_ + 32 * ks_); kfb[ks_] = *(const LAS bf16x8*)(Kb_ + 32 * KPITCH + 32 * ks_); } } while (0)
#define ATT_QKM(sa, sb, side) do { \
        _Pragma("unroll") for (int e_ = 0; e_ < 16; ++e_) { sa[e_] = 0.f; sb[e_] = 0.f; } \
        _Pragma("unroll") for (int ks_ = 0; ks_ < NKS; ++ks_) { sa = ATT_MFMA(kfa[ks_], qf[ks_], sa); sb = ATT_MFMA(kfb[ks_], qf[ks_], sb); } \
        if (MODE == 1) { const bf16x8 qa_ = (side) < 0 ? qpos : ((side) > 0 ? qneg : qzero); sa = ATT_MFMA(kfa[NKS], qa_, sa); sb = ATT_MFMA(kfb[NKS], qa_, sb); } } while (0)
#define ATT_QK(sa, sb, kbuf, side) do { ATT_KREAD(kbuf, 0, NKF); ATT_QKM(sa, sb, side); } while (0)
    bf16x8 vfa[4], vfb[4];
#define ATT_VREAD(vbuf) do { const LAS char* Vb_ = lds + (vbuf) * VBUF + vbase; \
        _Pragma("unroll") for (int j_ = 0; j_ < 4; ++j_) { const LAS char* vp0_ = Vb_ + (16 * j_) * VPITCH; \
            { const s16x4 lo_ = vtr(vp0_), hh_ = vtr(vp0_ + 8 * VPITCH); vfa[j_] = __builtin_shufflevector(lo_, hh_, 0, 1, 2, 3, 4, 5, 6, 7); } \
            { const s16x4 lo_ = vtr(vp0_ + 64), hh_ = vtr(vp0_ + 8 * VPITCH + 64); vfb[j_] = __builtin_shufflevector(lo_, hh_, 0, 1, 2, 3, 4, 5, 6, 7); } } } while (0)
#define ATT_PVM() do { _Pragma("unroll") for (int j_ = 0; j_ < 4; ++j_) { O0 = ATT_MFMA(vfa[j_], pf[j_ >> 1][j_ & 1], O0); O1 = ATT_MFMA(vfb[j_], pf[j_ >> 1][j_ & 1], O1); } } while (0)
#define ATT_PV(vbuf) do { ATT_VREAD(vbuf); ATT_PVM(); } while (0)
#define ATT_SIDE(kt) ((MODE != 1) ? 0 : (((kt) * 64 + 63 < qw) ? -1 : (((kt) * 64 > qw + 31) ? 1 : 0)))
    ATT_LOADK(ATT_KT(0)); ATT_STOREK(0);
    ATT_LOADK(ATT_KT(1)); ATT_STOREK(1);
    ATT_STOREV(1);
    __syncthreads();
    float M = (INIT && TRACK) ? -1e20f : Mout, L = INIT ? 0.f : Lout;
    if (INIT) {
#pragma unroll
        for (int i = 0; i < 16; ++i) { O0[i] = 0.f; O1[i] = 0.f; } }
    bf16x8 pf[2][2];
#pragma unroll
    for (int kb = 0; kb < 2; ++kb)
#pragma unroll
        for (int st = 0; st < 2; ++st) pf[kb][st] = qzero;
    f32x16 s0, s1, n0, n1;
    int side_cur = ATT_SIDE(ATT_KT(0));
    ATT_QK(s0, s1, 0, side_cur);
#pragma unroll
    for (int e = 0; e < 16; ++e) { n0[e] = 0.f; n1[e] = 0.f; }
    __syncthreads();
    constexpr int NMF = 2 * NKS + (MODE == 1 ? 2 : 0) + 8;
#define ATT_ITER(i, C0, C1, N0, N1, HASN, HASK2) do { \
        const int kt = ATT_KT(i); \
        if (HASK2) ATT_LOADK(ATT_KT((i) + 2)); \
        ATT_LOADV(kt); \
        if (HASN) ATT_KREAD(((i) + 1) & 1, 0, KPRE); \
        const int k0 = kt * 64; \
          \
        float rc = 0.f; \
        if (MODE == 1) { \
            if (side_cur != 0) rc = side_cur < 0 ? -stq : stq; \
            else { const float dbase = (float)(k0 + 4 * hi - qrow); \
                _Pragma("unroll") for (int e = 0; e < 16; ++e) { const float c = (float)((e & 3) + 8 * (e >> 2)); \
                    C0[e] = fmaf(-slope, fabsf(dbase + c), C0[e]); C1[e] = fmaf(-slope, fabsf(dbase + (c + 32.f)), C1[e]); } } \
        } \
        if (MODE == 2) { const float dbase = (float)(k0 + 4 * hi - qrow); \
            _Pragma("unroll") for (int e = 0; e < 16; ++e) { const float c = (float)((e & 3) + 8 * (e >> 2)); \
                const float d0 = fabsf(dbase + c), d1 = fabsf(dbase + (c + 32.f)); \
                C0[e] = (d0 <= 128.f) ? fmaf(-slope, d0, C0[e]) : -1e30f; C1[e] = (d1 <= 128.f) ? fmaf(-slope, d1, C1[e]) : -1e30f; } } \
        if (TRACK) { \
        float mx = max3f(C0[0], C1[0], C0[1]); \
        _Pragma("unroll") for (int e = 1; e < 15; e += 2) { mx = max3f(mx, C1[e], C0[e + 1]); mx = max3f(mx, C1[e + 1], C0[e + 2]); } \
        mx = fmaxf(mx, C1[15]); \
        const float mt = xhalf_max(mx) + rc;                     \
        if (__builtin_amdgcn_ballot_w64(mt > M + RESCALE_T) != 0ull) {         \
            ATT_PV(((i) + 1) & 1); \
            _Pragma("unroll") for (int kb = 0; kb < 2; ++kb) _Pragma("unroll") for (int st = 0; st < 2; ++st) pf[kb][st] = qzero; \
            const float Mn = fmaxf(M, mt); const float alpha = __builtin_amdgcn_exp2f((M - Mn) * LOG2E); M = Mn; \
            L *= alpha; \
            _Pragma("unroll") for (int e = 0; e < 16; ++e) { O0[e] *= alpha; O1[e] *= alpha; }        \
        } } \
          \
        const int side_next = HASN ? ATT_SIDE(ATT_KT((i) + 1)) : 0; \
        if (HASN) ATT_KREAD(((i) + 1) & 1, KPRE, NKF); \
        ATT_VREAD(((i) + 1) & 1); \
        if (HASN) ATT_QKM(N0, N1, side_next); \
        ATT_PVM();                                   \
        const float cc = (rc - M) * LOG2E; \
        float ps = 0.f;                                          \
        float ps1 = 0.f; \
        _Pragma("unroll") for (int e = 0; e < 16; ++e) { float t0 = __builtin_fmaf(C0[e], LOG2E, cc), t1 = __builtin_fmaf(C1[e], LOG2E, cc); \
            asm("" : "+v"(t0)); asm("" : "+v"(t1));                 \
            C0[e] = __builtin_amdgcn_exp2f(t0); C1[e] = __builtin_amdgcn_exp2f(t1); \
            float u0 = ps + C0[e], u1 = ps1 + C1[e]; asm("" : "+v"(u0)); asm("" : "+v"(u1)); ps = u0; ps1 = u1; } \
        L += ps + ps1; \
        _Pragma("unroll") for (int st = 0; st < 2; ++st) { u32x4 w0, w1; \
            w0.x = pkbf(C0[8 * st + 0], C0[8 * st + 1]); w0.y = pkbf(C0[8 * st + 2], C0[8 * st + 3]); w0.z = pkbf(C0[8 * st + 4], C0[8 * st + 5]); w0.w = pkbf(C0[8 * st + 6], C0[8 * st + 7]); \
            w1.x = pkbf(C1[8 * st + 0], C1[8 * st + 1]); w1.y = pkbf(C1[8 * st + 2], C1[8 * st + 3]); w1.z = pkbf(C1[8 * st + 4], C1[8 * st + 5]); w1.w = pkbf(C1[8 * st + 6], C1[8 * st + 7]); \
            pf[0][st] = __builtin_bit_cast(bf16x8, w0); pf[1][st] = __builtin_bit_cast(bf16x8, w1); } \
        side_cur = side_next; \
        if (HASN) { __builtin_amdgcn_sched_group_barrier(0x100, 8, 0);        \
            _Pragma("unroll") for (int g_ = 0; g_ < NMF; ++g_) { __builtin_amdgcn_sched_group_barrier(0x008, 1, 0); __builtin_amdgcn_sched_group_barrier(0x100, 2, 0); __builtin_amdgcn_sched_group_barrier(0x002, 6, 0); } } \
        if (HASK2) ATT_STOREK((i) & 1); \
        ATT_STOREV((i) & 1); \
        __syncthreads(); } while (0)
    for (int i = 0; i + 2 < nt; i += 2) {
        ATT_ITER(i, s0, s1, n0, n1, true, true);
        ATT_ITER(i + 1, n0, n1, s0, s1, true, true);
    }
    ATT_ITER(nt - 2, s0, s1, n0, n1, true, false);
    ATT_ITER(nt - 1, n0, n1, s0, s1, false, false);
    ATT_PV((nt - 1) & 1);
    __syncthreads();
#undef ATT_ITER
#undef ATT_LOADK
#undef ATT_LOADV
#undef ATT_STOREK
#undef ATT_STOREV
#undef ATT_KT
#undef ATT_QK
#undef ATT_PV
#undef ATT_KREAD
#undef ATT_QKM
#undef ATT_VREAD
#undef ATT_PVM
#undef ATT_SIDE
    Mout = M; Lout = L;
}

template <int NE> __device__ __forceinline__ float row_norm2(const bf16_t* qrow_ptr) {
    float s = 0.f;
#pragma unroll
    for (int c = 0; c < NE / 8; ++c) { float v[8]; unpack8(((const u32x4*)qrow_ptr)[c], v);
#pragma unroll
        for (int e = 0; e < 8; ++e) s += v[e] * v[e]; }
    return s;
}
__device__ __forceinline__ void store_o(bf16_t* orow, const f32x16& O0, const f32x16& O1, int hi) {
#pragma unroll
    for (int g = 0; g < 4; ++g) {
        u32x2 w0, w1; w0.x = pkbf(O0[4 * g], O0[4 * g + 1]); w0.y = pkbf(O0[4 * g + 2], O0[4 * g + 3]); w1.x = pkbf(O1[4 * g], O1[4 * g + 1]); w1.y = pkbf(O1[4 * g + 2], O1[4 * g + 3]);
        *(u32x2*)(orow + 8 * g + 4 * hi) = w0; *(u32x2*)(orow + 32 + 8 * g + 4 * hi) = w1;
    }
}

__device__ __forceinline__ void attn_phase(KP p, int l, LAS char* lds, int vcu, int G) {
    const int tid = tid_fresh(), lane = tid & 63, r32 = lane & 31, hi = lane >> 5; const int wid = __builtin_amdgcn_readfirstlane(tid >> 6);
    const bf16_t* proj = (const bf16_t*)(p->ws + WS_PROJ); const bf16_t* qb = (const bf16_t*)(p->ws + WS_QB); const bf16_t* kb = (const bf16_t*)(p->ws + WS_KB); const bf16_t* vb = (const bf16_t*)(p->ws + WS_VB);
    const bf16_t* aug = (const bf16_t*)(p->ws + WS_AUG);
    bf16_t* mix = (bf16_t*)(p->ws + WS_MIX);
    float lam;
    { const float* lp = p->diff_lambda + l * 128; const float a = (lane < 32) ? lp[lane] * lp[32 + lane] : 0.f, b2 = (lane < 32) ? lp[64 + lane] * lp[96 + lane] : 0.f;
      lam = expf(wave_sum(a)) - expf(wave_sum(b2)) + p->lam_init[l]; }
    const float one_m_li = 1.f - p->lam_init[l];
    for (int u = vcu; u < 2048; u += G) {
        if (!((ATT_TYPES >> (u >> 9)) & 1)) continue;
        const int type = u >> 9, idx = u & 511, bh = idx >> 6, qblk = idx & 63, b = bh >> 2, hd = bh & 3, q0 = qblk * 256;
        const int qrow = q0 + wid * 32 + r32;
        const size_t tok0 = (size_t)b * SEQ;
        bf16_t* orow = mix + (tok0 + qrow) * DM;
        f32x16 O0, O1; float M, L;
        if (type == 0) {
            const int bD = idx >> 8, hD = ((idx >> 6) & 3) ^ (bD ? 3 : 0);
            const size_t tokD = (size_t)bD * SEQ;
            bf16_t* orowD = mix + (tokD + qrow) * DM;
            const float slope = __builtin_amdgcn_exp2f(-(float)(5 + hD));
            const bf16_t* base = proj + tokD * NPROJ + PD;
            const int d0 = q0 / 64;
            LAS float* asave = (LAS float*)(lds + 65536) + tid;
#pragma unroll 1
            for (int mp = 0; mp < 2; ++mp) {
                const bf16_t* Qm = base + 64 * hD + 32 * mp; const bf16_t* Km = base + 256 + 64 * hD + 32 * mp; const bf16_t* Vm = base + 512 + 64 * hD;
                const float kmax = sqrtf(__builtin_bit_cast(float, ((const unsigned*)(p->ws + WS_KMAX))[l * 32 + bD * 8 + hD * 2 + mp]));
                const float bound = sqrtf(row_norm2<32>(Qm + (size_t)qrow * NPROJ)) * kmax * 1.01f;
                M = bound;
                flash_pass<32, 1, true>(lds, Qm, NPROJ, Km, NPROJ, Vm, NPROJ, aug + 16 * hD, q0, d0, 4, 0, 4, slope, O0, O1, M, L);
                float dc = (bound + 32.f - (M + __logf(fmaxf(xhalf_sum(L), 1e-37f)))) / slope;
                dc = fminf(fmaxf(dc, 0.f), 1.0e8f);
#pragma unroll
                for (int o = 1; o < 64; o <<= 1) dc = fmaxf(dc, __shfl_xor(dc, o));
                LAS float* red = (LAS float*)(lds + ATT_LDS + 16384);
                if (lane == 0) red[wid] = dc;
                __syncthreads();
#pragma unroll
                for (int w = 0; w < 8; ++w) dc = fmaxf(dc, red[w]);
                __syncthreads();
                const int dci = (int)dc + 1;
                const int lo_key = q0 - dci - 63;
                int ktlo = lo_key <= 0 ? 0 : (lo_key + 63) / 64; int kthi = (q0 + 255 + dci) / 64; if (kthi > SEQ / 64 - 1) kthi = SEQ / 64 - 1;
                if (ktlo > d0) ktlo = d0; if (kthi < d0 + 3) kthi = d0 + 3;
                if (((kthi - ktlo + 1) & 1) != 0) { if (ktlo > 0) --ktlo; else ++kthi; }
                const int nR = kthi - (d0 + 3), nL = d0 - ktlo;
                if (nR + nL > 0) flash_pass<32, 1, false>(lds, Qm, NPROJ, Km, NPROJ, Vm, NPROJ, aug + 16 * hD, q0, d0 + 4, nR, ktlo, nR + nL, slope, O0, O1, M, L);
                if (mp == 0) { const float i1 = 1.f / xhalf_sum(L);
#pragma unroll
                    for (int i = 0; i < 16; ++i) { asave[(2 * i) * NTHREADS] = O0[i] * i1; asave[(2 * i + 1) * NTHREADS] = O1[i] * i1; } }
            }
            const float i2 = lam / xhalf_sum(L);
            float ss = 0.f;
            f32x16 A0, A1;
#pragma unroll
            for (int i = 0; i < 16; ++i) { A0[i] = asave[(2 * i) * NTHREADS] - O0[i] * i2; A1[i] = asave[(2 * i + 1) * NTHREADS] - O1[i] * i2; ss += A0[i] * A0[i] + A1[i] * A1[i]; }
            ss = xhalf_sum(ss);
            const float rs = one_m_li / sqrtf(ss * (1.f / 64.f) + NORM_EPS);
            const float* sg = p->diff_subln + l * 64;
#pragma unroll
            for (int i = 0; i < 16; ++i) { const int dv = (i & 3) + 8 * (i >> 2) + 4 * hi; A0[i] *= rs * sg[dv]; A1[i] *= rs * sg[32 + dv]; }
            store_o(orowD + 768 + 64 * hD, A0, A1, hi);
        } else if (type == 1) {
            M = sqrtf(row_norm2<96>(qb + (tok0 + qrow) * 384 + 96 * hd) * __builtin_bit_cast(float, ((const unsigned*)(p->ws + WS_KMAX))[l * 32 + 16 + b * 4 + hd])) * 1.01f;
            flash_pass<96, 0>(lds, qb + tok0 * 384 + 96 * hd, 384, kb + tok0 * 384 + 96 * hd, 384, vb + tok0 * 256 + 64 * hd, 256, nullptr, q0, q0 / 64, SEQ / 64 - q0 / 64, 0, SEQ / 64, 0.f, O0, O1, M, L);
            const float il = 1.f / xhalf_sum(L);
#pragma unroll
            for (int i = 0; i < 16; ++i) { O0[i] *= il; O1[i] *= il; }
            store_o(orow + 256 + 64 * hd, O0, O1, hi);
        } else if (type == 2) {
            const bf16_t* base = proj + tok0 * NPROJ + PC; const int hk = hd >> 1;
            M = sqrtf(row_norm2<64>(base + (size_t)qrow * NPROJ + 64 * hd) * __builtin_bit_cast(float, ((const unsigned*)(p->ws + WS_KMAX))[l * 32 + 24 + b * 2 + hk])) * 1.01f;
            flash_pass<64, 0>(lds, base + 64 * hd, NPROJ, base + 256 + 64 * hk, NPROJ, base + 384 + 64 * hk, NPROJ, nullptr, q0, q0 / 64, SEQ / 64 - q0 / 64, 0, SEQ / 64, 0.f, O0, O1, M, L);
            const float il = 1.f / xhalf_sum(L);
#pragma unroll
            for (int i = 0; i < 16; ++i) { O0[i] *= il; O1[i] *= il; }
            store_o(orow + 512 + 64 * hd, O0, O1, hi);
        } else {
            const bf16_t* base = proj + tok0 * NPROJ + PA; const int hk = hd >> 1;
            const float slope = __builtin_amdgcn_exp2f(-(float)(1 + hd));
            const int kt0 = (q0 >= 128) ? (q0 - 128) / 64 : 0; int kt1 = (q0 + 256 + 128) / 64; if (kt1 > SEQ / 64) kt1 = SEQ / 64;
            flash_pass<64, 2>(lds, base + 64 * hd, NPROJ, base + 256 + 64 * hk, NPROJ, base + 384 + 64 * hk, NPROJ, nullptr, q0, kt0, kt1 - kt0, 0, kt1 - kt0, slope, O0, O1, M, L);
            const float sink = p->win_sink[l * 4 + hd];
            const float il = 1.f / (xhalf_sum(L) + __builtin_amdgcn_exp2f((sink - M) * LOG2E));
#pragma unroll
            for (int i = 0; i < 16; ++i) { O0[i] *= il; O1[i] *= il; }
            store_o(orow + 64 * hd, O0, O1, hi);
        }
    }
}
}

#define XB_TMO      128
#define XB_XCNT(j)  (256  + 64 * (j))
#define XB_XSUB(j)  (1280 + 64 * (j))
#define XB_XGEN(j)  (2304 + 64 * (j))
#define XB_TOP      3328
#define XB_TOPGEN   3392
#define XCD_BAR_WORDS 3456
#define XB_SPIN_CAP (1u << 18)

__device__ __forceinline__ unsigned xb_ld(unsigned* p)              { return __hip_atomic_load(p, __ATOMIC_RELAXED, __HIP_MEMORY_SCOPE_AGENT); }
__device__ __forceinline__ unsigned xb_add(unsigned* p, unsigned v) { return __hip_atomic_fetch_add(p, v, __ATOMIC_RELAXED, __HIP_MEMORY_SCOPE_AGENT); }
__device__ __forceinline__ unsigned xb_xcc_id() { return (unsigned)__builtin_amdgcn_s_getreg((3 << 11) | 20) & 0xFu; }
#define XB_SPIN(cond, bar) do { unsigned _sp = 0; while (cond) { __builtin_amdgcn_s_sleep(1); \
    if ((++_sp & 255u) == 0u) { if (xb_ld(&(bar)[XB_TMO])) break; if (_sp > XB_SPIN_CAP) { atomicAdd(&(bar)[XB_TMO], 1u); break; } } } } while (0)

struct XcdBarrier {
    unsigned* bar; unsigned x;
    volatile LAS unsigned* st;
};

__device__ __forceinline__ XcdBarrier xcd_barrier_post(unsigned* bar, volatile LAS unsigned* st) {
    XcdBarrier b; b.bar = bar; b.x = xb_xcc_id(); b.st = st;
    if (threadIdx.x == 0) (void)xb_add(&bar[XB_XCNT(b.x)], 1u);
    return b;
}
__device__ __forceinline__ void xcd_barrier_complete(unsigned* bar, unsigned x, unsigned& nloc, unsigned& nx) {
    const unsigned G = gridDim.x * gridDim.y * gridDim.z;
    unsigned sum, cnt, mine, sp = 0u;
    for (;;) {
        sum = 0u; cnt = 0u; mine = 0u;
#pragma unroll
        for (unsigned j = 0; j < 16; ++j) { const unsigned c = xb_ld(&bar[XB_XCNT(j)]); sum += c; cnt += (c > 0u) ? 1u : 0u; mine = (j == x) ? c : mine; }
        if (sum == G) break;
        __builtin_amdgcn_s_sleep(1);
        if ((++sp & 255u) == 0u) { if (xb_ld(&bar[XB_TMO])) break; if (sp > XB_SPIN_CAP) { atomicAdd(&bar[XB_TMO], 1u); break; } }
    }
    nloc = mine > 0u ? mine : 1u; nx = cnt > 0u ? cnt : 1u;
}

__device__ __forceinline__ void xcd_barrier(const XcdBarrier& b) {
    asm volatile("s_waitcnt vmcnt(0)" ::: "memory");
    __syncthreads();
    if (threadIdx.x == 0) {
        unsigned* bar = b.bar;
        __builtin_amdgcn_s_waitcnt(0);
        unsigned nloc = b.st[0], nx = b.st[1];
        if (nloc == 0u) { xcd_barrier_complete(bar, b.x, nloc, nx); b.st[0] = nloc; b.st[1] = nx; }
        const unsigned old = xb_add(&bar[XB_XSUB(b.x)], 1u);
        const unsigned gen = old / nloc;
        if (old + 1u == (gen + 1u) * nloc) {
            __builtin_amdgcn_fence(__ATOMIC_RELEASE, "agent");
            asm volatile("s_waitcnt vmcnt(0)" ::: "memory");
            const unsigned og = xb_add(&bar[XB_TOP], 1u);
            const unsigned tg = og / nx;
            if (og + 1u == (tg + 1u) * nx) xb_add(&bar[XB_TOPGEN], 1u);
            else XB_SPIN(xb_ld(&bar[XB_TOPGEN]) == tg, bar);
            __builtin_amdgcn_fence(__ATOMIC_ACQUIRE, "agent");
            xb_add(&bar[XB_XGEN(b.x)], 1u);
            asm volatile("s_waitcnt vmcnt(0)" ::: "memory");
        } else {
            XB_SPIN(xb_ld(&bar[XB_XGEN(b.x)]) == gen, bar);
            __builtin_amdgcn_fence(__ATOMIC_ACQUIRE, "agent");
            asm volatile("s_waitcnt vmcnt(0)" ::: "memory");
        }
    }
    __syncthreads();
}

#define GRID_SYNC_CG() do { asm volatile("s_waitcnt vmcnt(0) lgkmcnt(0)" ::: "memory"); grid.sync(); __builtin_amdgcn_fence(__ATOMIC_ACQUIRE, "agent"); } while (0)
#define XB_ST ((volatile LAS unsigned*)(lds + LDS_BYTES - 64))
#define GRID_SYNC() do { GETP(pb_); XcdBarrier xb_; xb_.bar = (unsigned*)(pb_->ws + WS_BAR); xb_.x = xb_xcc_id(); xb_.st = XB_ST; xcd_barrier(xb_); } while (0)
#ifndef PH_MASK
#define PH_MASK 255
#endif
__global__ void __launch_bounds__(NTHREADS, 2) mega_fwd(Params p_by_value) {
    extern __shared__ __attribute__((aligned(16))) unsigned char lds_raw[];
    cg::grid_group grid = cg::this_grid();
    LAS unsigned char* lds = (LAS unsigned char*)lds_raw;
#define VCU(G_, bx_) (((G_) % 8 == 0) ? ((bx_) % 8) * ((G_) / 8) + (bx_) / 8 : (bx_))
    const float alpha = 1.681792830507429f;
#define STATS(s_) ((float*)(p->ws + WS_STATS) + (size_t)(s_) * T * 2)
#define C1(l_, off_) ((const float*)(p->ws + WS_C12) + (l_) * C12_L + (off_))
#define C2(l_, off_) ((const float*)(p->ws + WS_C12) + C2_OFF + (l_) * C12_L + (off_))

    if (threadIdx.x < 16) ((LAS unsigned*)(lds + LDS_BYTES - 64))[threadIdx.x] = 0u;
    __syncthreads();
    { GETP(p); (void)xcd_barrier_post((unsigned*)(p->ws + WS_BAR), XB_ST); }
    if (PH_MASK & 1) { GETP(p); const int G = gridDim.x, bx = blockIdx.x; phase0(p, lds, VCU(G, bx), G); }
    GRID_SYNC_CG();
#pragma unroll 1
    for (int li = 0; li < DEPTH; ++li) {
#pragma unroll 1
        for (int fi = 0; fi < 2; ++fi) {
            if (fi == 1) {
                if (PH_MASK & 2) { GETP(p); int l = li; asm volatile("" : "+s"(l)); const int G = gridDim.x, bx = blockIdx.x;
                  pg8::Gemm g{(const bf16_t*)(p->ws + WS_XB), (const bf16_t*)(p->ws + WS_WIN) + l * WIN_L, T, NPROJ, DM}; pg8::StaticOrder S; S.init(T, NPROJ, G, bx);
                  pg8::EpiStoreBf16LN E{(bf16_t*)(p->ws + WS_PROJ), NPROJ, STATS(3 * l), C1(l, 2 * NGU), C2(l, 2 * NGU)};
                  pg8::gemm_phase<pg8::EpiStoreBf16LN, pg8::StaticOrder, true, true>(lds, g, S, E); }
                GRID_SYNC();
                if (PH_MASK & 4) { GETP(p); int l = li; asm volatile("" : "+s"(l)); const int G = gridDim.x, bx = blockIdx.x; prep_phase(p, l, VCU(G, bx), G); }
                GRID_SYNC();
                if (PH_MASK & 8) { GETP(p); int l = li; asm volatile("" : "+s"(l)); const int G = gridDim.x, bx = blockIdx.x; att::attn_phase(p, l, (LAS char*)lds, VCU(G, bx), G); }
                GRID_SYNC();
                if (PH_MASK & 16) { GETP(p); int l = li; asm volatile("" : "+s"(l)); const int G = gridDim.x, bx = blockIdx.x;
                  pg8::Gemm g{(const bf16_t*)(p->ws + WS_MIX), (const bf16_t*)(p->ws + WS_WOUT) + l * WOUT_L, T, DM, DM}; pg8::StaticOrder S; S.init(T, DM, G, bx);
                  pg8::EpiResidLN<true> E{nullptr, p->out, p->ws, p->ln_g + (3 * l) * DM, p->ln_b + (3 * l) * DM, 3 * l, alpha, 1.0f};
                  pg8::gemm_phase<pg8::EpiResidLN<true>, pg8::StaticOrder, true, true>(lds, g, S, E); }
                GRID_SYNC();
            }
            if (PH_MASK & 64) { GETP(p); int l = li, f = fi; asm volatile("" : "+s"(l), "+s"(f)); const int G = gridDim.x, bx = blockIdx.x;
              const int s = 3 * l + 2 * f - 1;
              pg8::Gemm g{(const bf16_t*)(p->ws + WS_XB), (const bf16_t*)(p->ws + WS_WGU) + l * WGU_L + f * WGU_F, T, NGU, DM}; pg8::StaticOrder S; S.init(T, NGU, G, bx);
              if (s >= 0) { pg8::EpiSwiGLULN<true> E{(bf16_t*)(p->ws + WS_H), DFF, STATS(s), C1(l, f * NGU), C2(l, f * NGU)};
                            pg8::gemm_phase<pg8::EpiSwiGLULN<true>, pg8::StaticOrder, true, true>(lds, g, S, E); }
              else { pg8::EpiSwiGLULN<false> E{(bf16_t*)(p->ws + WS_H), DFF, nullptr, C1(l, f * NGU), C2(l, f * NGU)};
                     pg8::gemm_phase<pg8::EpiSwiGLULN<false>, pg8::StaticOrder, true, true>(lds, g, S, E); } }
            GRID_SYNC();
            if (PH_MASK & 128) { GETP(p); int l = li, f = fi; asm volatile("" : "+s"(l), "+s"(f)); const int G = gridDim.x, bx = blockIdx.x;
              const int s = 3 * l + 2 * f - 1;
              pg8::Gemm g{(const bf16_t*)(p->ws + WS_H), (const bf16_t*)(p->ws + WS_WD) + l * WD_L + f * WD_F, T, DM, DFF}; pg8::StaticOrder S; S.init(T, DM, G, bx);
              if (s >= 0) { pg8::EpiResidLN<true> E{nullptr, p->out, p->ws, p->ln_g + s * DM, p->ln_b + s * DM, s, alpha, 0.5f};
                            pg8::gemm_phase<pg8::EpiResidLN<true>, pg8::StaticOrder, true, true>(lds, g, S, E); }
              else { pg8::EpiResidLN<false> E{p->x, p->out, p->ws, nullptr, nullptr, -1, alpha, 0.5f};
                     pg8::gemm_phase<pg8::EpiResidLN<false>, pg8::StaticOrder, true, true>(lds, g, S, E); } }
            GRID_SYNC();
        }
    }
    if (PH_MASK & 32) { GETP(p); const int G = gridDim.x, bx = blockIdx.x;
      ln_phase(p->out, (bf16_t*)(p->ws + WS_XB), p->ln_g + (3 * DEPTH - 1) * DM, p->ln_b + (3 * DEPTH - 1) * DM, VCU(G, bx), G); }
}

extern "C" void kernel_launch(void* const* d_in, const int* in_sizes, int n_in, void* d_out, int out_size, void* d_ws, size_t ws_size, hipStream_t stream) {
    static int grid = 0;
    if (grid == 0) {
        if (n_in != 16 || in_sizes[0] != T * DM || out_size != T * DM || ws_size < WS_END) { fprintf(stderr, "kernel_launch: unexpected shapes (n_in %d, in0 %d, out %d, ws %zu); nothing launched\n", n_in, n_in > 0 ? in_sizes[0] : -1, out_size, ws_size); grid = -1; return; }
        int dev = 0, cus = 0, per_cu = 0;
        hipGetDevice(&dev); hipDeviceGetAttribute(&cus, hipDeviceAttributeMultiprocessorCount, dev);
        if (hipFuncSetAttribute((const void*)mega_fwd, hipFuncAttributeMaxDynamicSharedMemorySize, LDS_BYTES) != hipSuccess) { fprintf(stderr, "kernel_launch: hipFuncSetAttribute failed\n"); grid = -1; return; }
        if (hipOccupancyMaxActiveBlocksPerMultiprocessor(&per_cu, (const void*)mega_fwd, NTHREADS, LDS_BYTES) != hipSuccess || per_cu < 1) { fprintf(stderr, "kernel_launch: occupancy query gave %d\n", per_cu); per_cu = 1; }
        (void)hipGetLastError();
        grid = cus * 1;
    }
    if (grid < 0) return;
    Params p{};
    p.x = (const float*)d_in[0]; p.w_in = (const float*)d_in[1]; p.win_sink = (const float*)d_in[2]; p.mla_q_norm = (const float*)d_in[3]; p.mla_w_uq = (const float*)d_in[4];
    p.mla_kv_norm = (const float*)d_in[5]; p.mla_w_ukv = (const float*)d_in[6]; p.ax_q_norm = (const float*)d_in[7]; p.ax_k_norm = (const float*)d_in[8]; p.diff_lambda = (const float*)d_in[9];
    p.diff_subln = (const float*)d_in[10]; p.w_out = (const float*)d_in[11]; p.ffn_w_gu = (const float*)d_in[12]; p.ffn_w_down = (const float*)d_in[13]; p.ln_g = (const float*)d_in[14]; p.ln_b = (const float*)d_in[15];
    p.out = (float*)d_out; p.ws = (unsigned char*)d_ws;
    for (int l = 0; l < 4; ++l) p.lam_init[l] = (float)(0.8 - 0.6 * exp(-0.3 * (double)l));
    for (int i = 0; i < 16; ++i) p.inv32[i] = (float)pow(10000.0, -(double)i / 16.0);
    if (hipMemsetAsync((char*)d_ws + WS_CTL, 0, CTL_BYTES, stream) != hipSuccess) { fprintf(stderr, "kernel_launch: hipMemsetAsync of the control region failed\n"); return; }
    void* args[] = {&p};
    hipError_t e = hipLaunchCooperativeKernel((const void*)mega_fwd, dim3(grid), dim3(NTHREADS), args, LDS_BYTES, stream);
    if (e != hipSuccess) fprintf(stderr, "kernel_launch: cooperative launch failed: %s (grid %d)\n", hipGetErrorString(e), grid);
}
```

```cpp
#include <hip/hip_runtime.h>
#include <hip/hip_cooperative_groups.h>
#include <cstdio>
#include <cstdint>
#include <cmath>
namespace cg = cooperative_groups;
namespace pg8 {
#define PG8_LAS __attribute__((address_space(3)))
typedef unsigned short bf16_t;
typedef short bf16x8 __attribute__((ext_vector_type(8)));
typedef float f32x4 __attribute__((ext_vector_type(4)));
typedef unsigned u32x4 __attribute__((ext_vector_type(4)));
constexpr int BM = 256, BK = 64, HALF = 128, HTB = HALF * BK * 2  , STAGE_BYTES = 8 * HTB, NXCD = 8, WGM = 8;

__host__ __device__ __forceinline__ int lds_byte(int r, int c) { const int st = (r >> 4) * 2 + (c >> 5), rr = r & 15, cc = c & 31, ob = rr * 64 + cc * 2; return st * 1024 + (ob ^ (((ob >> 9) & 1) << 5)); }
__host__ __device__ __forceinline__ void stage_rc(int b, int& R, int& C) { const int st = b / 1024, sb = b % 1024, swz = sb ^ (((sb >> 9) & 1) << 5); R = (st >> 1) * 16 + swz / 64; C = (st & 1) * 32 + (swz % 64) / 2; }
__host__ __device__ __forceinline__ int perm32(int rho) { const int n = rho >> 4, i = rho & 15; return 8 * (i >> 2) + 4 * n + (i & 3); }

struct Unit { int pm, pn; };
struct Gemm { const bf16_t* A; const bf16_t* Bt; int M, N, K; };

struct StaticOrder {
    int nM, nN, nwg, G, c;
    __host__ __device__ void init(int M, int N, int G_, int c_) { nM = M / BM; nN = N / BM; nwg = nM * nN; G = G_; c = c_; }
    __host__ __device__ bool next(int i, Unit& u) const {
        const long L = (long)i * G + c; if (L >= nwg) return false;
        int wgid = (int)L; { const int q = nwg / NXCD, r = nwg % NXCD, xcd = wgid % NXCD, off = wgid / NXCD; wgid = (xcd < r ? xcd * (q + 1) : r * (q + 1) + (xcd - r) * q) + off; }
        const int nig = WGM * nN, gid = wgid / nig, fm = gid * WGM, gsz = (nM - fm) < WGM ? (nM - fm) : WGM;
        u.pm = fm + ((wgid % nig) % gsz); u.pn = (wgid % nig) / gsz; return true;
    }
    __device__ __forceinline__ void a_ready(const Unit&) const {}
    __device__ __forceinline__ void done(const Unit&) const {}
};

__device__ __forceinline__ unsigned cvt_pk_bf16(float lo, float hi) { unsigned r; asm volatile("v_cvt_pk_bf16_f32 %0, %1, %2" : "=v"(r) : "v"(lo), "v"(hi)); return r; }
typedef float f32x2 __attribute__((ext_vector_type(2)));
typedef float f32x2 __attribute__((ext_vector_type(2)));
typedef unsigned u32x2 __attribute__((ext_vector_type(2)));

struct EpiStoreBf16 {
    static constexpr bool PERM = true, AFTER_DRAIN = false;
    bf16_t* O; int ldc;
    __device__ __forceinline__ void operator()(const f32x4 (&acc)[2][2][4][2], const Unit& u, int wr, int wc, int fr, int fq) const {
        const int row0 = u.pm * BM + wr * 64 + fr; const int col0 = u.pn * BM + wc * 32 + 8 * fq;
#pragma unroll
        for (int ai = 0; ai < 2; ++ai)
#pragma unroll
            for (int m = 0; m < 4; ++m) { bf16_t* rowp = O + (size_t)(row0 + ai * HALF + m * 16) * ldc + col0;
#pragma unroll
                for (int bj = 0; bj < 2; ++bj) { const f32x4 v0 = acc[ai][bj][m][0], v1 = acc[ai][bj][m][1];
                    u32x4 w; w.x = cvt_pk_bf16(v0[0], v0[1]); w.y = cvt_pk_bf16(v0[2], v0[3]); w.z = cvt_pk_bf16(v1[0], v1[1]); w.w = cvt_pk_bf16(v1[2], v1[3]);
                    *(u32x4*)(rowp + bj * HALF) = w; } }
    }
};

__device__ __forceinline__ float silu_mul(float g, float u) {
    const float e = __builtin_amdgcn_exp2f(-1.4426950408889634f * g);
    return g * u * __builtin_amdgcn_rcpf(1.0f + e);
}
struct EpiSwiGLU {
    static constexpr bool PERM = true, AFTER_DRAIN = false;
    bf16_t* H; int ldh;
    __device__ __forceinline__ void operator()(const f32x4 (&acc)[2][2][4][2], const Unit& u, int wr, int wc, int fr, int fq) const {
        const int row0 = u.pm * BM + wr * 64 + fr; const int col0 = u.pn * HALF + wc * 32 + 8 * fq;
#pragma unroll
        for (int ai = 0; ai < 2; ++ai)
#pragma unroll
            for (int m = 0; m < 4; ++m) { bf16_t* rowp = H + (size_t)(row0 + ai * HALF + m * 16) * ldh + col0;
                const f32x4 g0 = acc[ai][0][m][0], g1 = acc[ai][0][m][1], u0 = acc[ai][1][m][0], u1 = acc[ai][1][m][1];
                u32x4 w;
                w.x = cvt_pk_bf16(silu_mul(g0[0], u0[0]), silu_mul(g0[1], u0[1])); w.y = cvt_pk_bf16(silu_mul(g0[2], u0[2]), silu_mul(g0[3], u0[3]));
                w.z = cvt_pk_bf16(silu_mul(g1[0], u1[0]), silu_mul(g1[1], u1[1])); w.w = cvt_pk_bf16(silu_mul(g1[2], u1[2]), silu_mul(g1[3], u1[3]));
                *(u32x4*)rowp = w; }
    }
};

struct EpiResid {
    static constexpr bool PERM = false, AFTER_DRAIN = false;
    const float* src; float* dst; int ld; float alpha, beta;
    __device__ __forceinline__ void operator()(const f32x4 (&acc)[2][2][4][2], const Unit& u, int wr, int wc, int fr, int fq) const {
        const int col0 = u.pn * BM + wc * 32 + 4 * fq;
#pragma unroll
        for (int ai = 0; ai < 2; ++ai)
#pragma unroll
            for (int m = 0; m < 4; ++m) { const size_t off = (size_t)(u.pm * BM + ai * HALF + wr * 64 + m * 16 + fr) * ld + col0;
#pragma unroll
                for (int bj = 0; bj < 2; ++bj)
#pragma unroll
                    for (int n = 0; n < 2; ++n) { const f32x4 s = *(const f32x4*)(src + off + bj * HALF + n * 16);
                        *(f32x4*)(dst + off + bj * HALF + n * 16) = s * alpha + acc[ai][bj][m][n] * beta; } }
    }
};

constexpr float LN_EPS_F = 1e-5f;
template <bool HAS> __device__ __forceinline__ void ln_row_stats(const float* st, int row, float& mu, float& rs) {
    if (!HAS) { mu = 0.f; rs = 1.f; return; }
    const f32x2 s = *(const f32x2*)(st + 2 * (size_t)row);
    mu = s.x * (1.0f / 1024.0f); const float var = fmaxf(s.y * (1.0f / 1024.0f) - mu * mu, 0.f); rs = 1.0f / sqrtf(var + LN_EPS_F);
}
struct EpiStoreBf16LN {
    static constexpr bool PERM = true, AFTER_DRAIN = false;
    bf16_t* O; int ldc; const float* st; const float* c1; const float* c2;
    __device__ __forceinline__ void operator()(const f32x4 (&acc)[2][2][4][2], const Unit& u, int wr, int wc, int fr, int fq) const {
        int row0 = u.pm * BM + wr * 64 + fr; int col0 = u.pn * BM + wc * 32 + 8 * fq;
        asm volatile("" : "+v"(row0), "+v"(col0));
        f32x4 c1v[2][2], c2v[2][2];
#pragma unroll
        for (int bj = 0; bj < 2; ++bj)
#pragma unroll
            for (int n = 0; n < 2; ++n) { c1v[bj][n] = *(const f32x4*)(c1 + col0 + bj * HALF + 4 * n); c2v[bj][n] = *(const f32x4*)(c2 + col0 + bj * HALF + 4 * n); }
#pragma unroll
        for (int ai = 0; ai < 2; ++ai)
#pragma unroll
            for (int m = 0; m < 4; ++m) { const int row = row0 + ai * HALF + m * 16; float mu, rs; ln_row_stats<true>(st, row, mu, rs);
                bf16_t* rowp = O + (size_t)row * ldc + col0;
#pragma unroll
                for (int bj = 0; bj < 2; ++bj) { const f32x4 v0 = (acc[ai][bj][m][0] - c1v[bj][0] * mu) * rs + c2v[bj][0], v1 = (acc[ai][bj][m][1] - c1v[bj][1] * mu) * rs + c2v[bj][1];
                    u32x4 w; w.x = cvt_pk_bf16(v0[0], v0[1]); w.y = cvt_pk_bf16(v0[2], v0[3]); w.z = cvt_pk_bf16(v1[0], v1[1]); w.w = cvt_pk_bf16(v1[2], v1[3]);
                    *(u32x4*)(rowp + bj * HALF) = w; } }
    }
};
template <bool HAS_LN> struct EpiSwiGLULN {
    static constexpr bool PERM = true, AFTER_DRAIN = false;
    bf16_t* H; int ldh; const float* st; const float* c1; const float* c2;
    __device__ __forceinline__ void operator()(const f32x4 (&acc)[2][2][4][2], const Unit& u, int wr, int wc, int fr, int fq) const {
        int row0 = u.pm * BM + wr * 64 + fr; const int col0 = u.pn * HALF + wc * 32 + 8 * fq; int wcol0 = u.pn * BM + wc * 32 + 8 * fq;
        asm volatile("" : "+v"(row0), "+v"(wcol0));
        f32x4 c1v[2][2], c2v[2][2];
#pragma unroll
        for (int bj = 0; bj < 2; ++bj)
#pragma unroll
            for (int n = 0; n < 2; ++n) { c1v[bj][n] = *(const f32x4*)(c1 + wcol0 + bj * HALF + 4 * n); c2v[bj][n] = *(const f32x4*)(c2 + wcol0 + bj * HALF + 4 * n); }
#pragma unroll
        for (int ai = 0; ai < 2; ++ai)
#pragma unroll
            for (int m = 0; m < 4; ++m) { const int row = row0 + ai * HALF + m * 16; float mu, rs; ln_row_stats<HAS_LN>(st, row, mu, rs);
                bf16_t* rowp = H + (size_t)row * ldh + col0;
                const f32x4 g0 = (acc[ai][0][m][0] - c1v[0][0] * mu) * rs + c2v[0][0], g1 = (acc[ai][0][m][1] - c1v[0][1] * mu) * rs + c2v[0][1];
                const f32x4 u0 = (acc[ai][1][m][0] - c1v[1][0] * mu) * rs + c2v[1][0], u1 = (acc[ai][1][m][1] - c1v[1][1] * mu) * rs + c2v[1][1];
                u32x4 w;
                w.x = cvt_pk_bf16(silu_mul(g0[0], u0[0]), silu_mul(g0[1], u0[1])); w.y = cvt_pk_bf16(silu_mul(g0[2], u0[2]), silu_mul(g0[3], u0[3]));
                w.z = cvt_pk_bf16(silu_mul(g1[0], u1[0]), silu_mul(g1[1], u1[1])); w.w = cvt_pk_bf16(silu_mul(g1[2], u1[2]), silu_mul(g1[3], u1[3]));
                *(u32x4*)rowp = w; }
    }
};
constexpr size_t EPI_WS_XB = (size_t)166 << 20, EPI_WS_STATS = ((size_t)568 << 20) + ((size_t)1 << 20); constexpr int EPI_T = 32768;
template <bool HAS_LN> struct EpiResidLN {
    static constexpr bool PERM = false, AFTER_DRAIN = false;
    static constexpr int ld = 1024;
    const float* src; float* dst; unsigned char* ws; const float* g_in; const float* b_in; int s_in; float alpha, beta;
    __device__ __forceinline__ void operator()(const f32x4 (&acc)[2][2][4][2], const Unit& u, int wr, int wc, int fr, int fq) const {
        int col0 = u.pn * BM + wc * 32 + 4 * fq; int rowb = u.pm * BM + wr * 64 + fr;
        asm volatile("" : "+v"(col0), "+v"(rowb));
        const float* rd = HAS_LN ? (const float*)dst : src;
        bf16_t* yb = (bf16_t*)(ws + EPI_WS_XB);
        const float* st_in = (const float*)(ws + EPI_WS_STATS) + (size_t)s_in * EPI_T * 2; float* st_out = (float*)(ws + EPI_WS_STATS) + (size_t)(s_in + 1) * EPI_T * 2;
        f32x4 gv[2][2], bv[2][2];
#pragma unroll
        for (int bj = 0; bj < 2; ++bj)
#pragma unroll
            for (int n = 0; n < 2; ++n) { if (HAS_LN) { gv[bj][n] = *(const f32x4*)(g_in + col0 + bj * HALF + n * 16); bv[bj][n] = *(const f32x4*)(b_in + col0 + bj * HALF + n * 16); }
                                          else { gv[bj][n] = (f32x4){1.f, 1.f, 1.f, 1.f}; bv[bj][n] = (f32x4){0.f, 0.f, 0.f, 0.f}; } }
#pragma unroll
        for (int ai = 0; ai < 2; ++ai)
#pragma unroll
            for (int m = 0; m < 4; ++m) { const int row = rowb + ai * HALF + m * 16; const size_t off = (size_t)row * ld + col0;
                float mu, rs; ln_row_stats<HAS_LN>(st_in, row, mu, rs);
                float ps = 0.f, pq = 0.f;
#pragma unroll
                for (int bj = 0; bj < 2; ++bj)
#pragma unroll
                    for (int n = 0; n < 2; ++n) { const f32x4 y = *(const f32x4*)(rd + off + bj * HALF + n * 16);
                        const f32x4 x = HAS_LN ? (y - mu) * rs * gv[bj][n] + bv[bj][n] : y;
                        const f32x4 yn = x * alpha + acc[ai][bj][m][n] * beta;
                        *(f32x4*)(dst + off + bj * HALF + n * 16) = yn;
                        u32x2 w; w.x = cvt_pk_bf16(yn[0], yn[1]); w.y = cvt_pk_bf16(yn[2], yn[3]); *(u32x2*)(yb + off + bj * HALF + n * 16) = w;
                        ps += (yn[0] + yn[1]) + (yn[2] + yn[3]); pq += (yn[0] * yn[0] + yn[1] * yn[1]) + (yn[2] * yn[2] + yn[3] * yn[3]); }
                ps += __shfl_xor(ps, 16); ps += __shfl_xor(ps, 32); pq += __shfl_xor(pq, 16); pq += __shfl_xor(pq, 32);
                if (fq == 0) { atomicAdd(st_out + 2 * (size_t)row, ps); atomicAdd(st_out + 2 * (size_t)row + 1, pq); } }
    }
};
template <class Epi, class Sched, bool ALIGN_EPI = false, bool SP2 = false>
__device__ __forceinline__ void gemm_phase(PG8_LAS unsigned char* lds, const Gemm g, const Sched S, const Epi E) {
    int tid_ = threadIdx.x; asm volatile("" : "+v"(tid_));
    const int tid = tid_, wid = __builtin_amdgcn_readfirstlane(tid >> 6), lane = tid & 63, wr = wid >> 2, wc = wid & 3, fr = lane & 15, fq = lane >> 4;
    const int K = g.K, nt = K / BK;
    unsigned voffA[2], voffB[2];
#pragma unroll
    for (int i = 0; i < 2; ++i) { int R, C; stage_rc(tid * 16 + i * 8192, R, C); const int Rb = Epi::PERM ? ((R & ~31) + perm32(R & 31)) : R;
        voffA[i] = (unsigned)(R * K + C) * 2u; voffB[i] = (unsigned)(Rb * K + C) * 2u; }
    const size_t kstep = (size_t)(BK * 2);
    const size_t hstep = (size_t)HALF * K * 2;
    const size_t tstep = 2 * hstep;
    const unsigned ldsw = (unsigned)wid * 1024u;
    const int aoff = lds_byte(wr * 64 + fr, fq * 8), boff = lds_byte(wc * 32 + fr, fq * 8);
#define PG8_SA(b, h) (((b) * 2 + (h)) * HTB)
#define PG8_SB(b, h) ((4 + (b) * 2 + (h)) * HTB)
#define PG8_STAGE(bufoff, gbase, voff) do { _Pragma("unroll") for (int _i = 0; _i < 2; ++_i) \
        __builtin_amdgcn_global_load_lds((const unsigned*)((const char*)(gbase) + (voff)[_i]), (PG8_LAS unsigned*)(lds + (bufoff) + ldsw + _i * 8192), 16, 0, 0); } while (0)
#define PG8_LDA(dst, b, h) do { _Pragma("unroll") for (int m = 0; m < 4; ++m) _Pragma("unroll") for (int k = 0; k < 2; ++k) dst[m][k] = *(const PG8_LAS bf16x8*)(lds + PG8_SA(b, h) + aoff + m * 2048 + k * 1024); } while (0)
#define PG8_LDB(dst, b, h) do { _Pragma("unroll") for (int n = 0; n < 2; ++n) _Pragma("unroll") for (int k = 0; k < 2; ++k) dst[n][k] = *(const PG8_LAS bf16x8*)(lds + PG8_SB(b, h) + boff + n * 2048 + k * 1024); } while (0)
#define PG8_MMA(ai, bj, At, Bt) do { __builtin_amdgcn_s_setprio(1); _Pragma("unroll") for (int m = 0; m < 4; ++m) _Pragma("unroll") for (int n = 0; n < 2; ++n) _Pragma("unroll") for (int k = 0; k < 2; ++k) \
        acc[ai][bj][m][n] = __builtin_amdgcn_mfma_f32_16x16x32_bf16(Bt[n][k], At[m][k], acc[ai][bj][m][n], 0, 0, 0); __builtin_amdgcn_s_setprio(0); } while (0)
#define PG8_WAIT_V(n) asm volatile("s_waitcnt vmcnt(" #n ")" ::: "memory")
#define PG8_WAIT_L(n) asm volatile("s_waitcnt lgkmcnt(" #n ")" ::: "memory")
#define PG8_BAR __builtin_amdgcn_s_barrier()
#define PG8_SCHED __builtin_amdgcn_sched_barrier(0)
    Unit cur, nxt; int ui = 0;
    if (!S.next(0, cur)) return;
    f32x4 acc[2][2][4][2];
#pragma unroll
    for (int a = 0; a < 2; ++a)
#pragma unroll
        for (int b = 0; b < 2; ++b)
#pragma unroll
            for (int m = 0; m < 4; ++m)
#pragma unroll
                for (int n = 0; n < 2; ++n) acc[a][b][m][n] = (f32x4){0.f, 0.f, 0.f, 0.f};
    bf16x8 At[4][2], B0[2][2], B1[2][2];
    const char* cA = (const char*)g.A + (size_t)cur.pm * tstep; const char* cB = (const char*)g.Bt + (size_t)cur.pn * tstep;
    S.a_ready(cur);
    if constexpr (SP2) {
        PG8_STAGE(PG8_SB(0, 0), cB, voffB); PG8_STAGE(PG8_SB(0, 1), cB + hstep, voffB); PG8_STAGE(PG8_SA(0, 0), cA, voffA); PG8_STAGE(PG8_SA(0, 1), cA + hstep, voffA);
        if (wr == 1) PG8_BAR;
        PG8_WAIT_V(2); PG8_BAR;
        PG8_STAGE(PG8_SB(1, 0), cB + kstep, voffB); PG8_STAGE(PG8_SA(1, 0), cA + kstep, voffA); PG8_STAGE(PG8_SB(1, 1), cB + hstep + kstep, voffB);
        PG8_WAIT_V(6); PG8_BAR;
    } else {
        PG8_STAGE(PG8_SB(0, 0), cB, voffB); PG8_STAGE(PG8_SA(0, 0), cA, voffA); PG8_STAGE(PG8_SB(0, 1), cB + hstep, voffB); PG8_STAGE(PG8_SA(0, 1), cA + hstep, voffA);
        if (wr == 1) PG8_BAR;
        PG8_WAIT_V(4); PG8_BAR;
        PG8_STAGE(PG8_SB(1, 0), cB + kstep, voffB); PG8_STAGE(PG8_SA(1, 0), cA + kstep, voffA); PG8_STAGE(PG8_SB(1, 1), cB + hstep + kstep, voffB);
        PG8_WAIT_V(6); PG8_BAR;
    }
    for (;;) {
        const bool has_next = S.next(ui + 1, nxt);
        const char* nA = has_next ? (const char*)g.A + (size_t)nxt.pm * tstep : cA; const char* nB = has_next ? (const char*)g.Bt + (size_t)nxt.pn * tstep : cB;
        for (int t = 0; t < nt; t += 2) {
            const bool last = (t == nt - 2);
            const char* a1 = cA + (size_t)(t + 1) * kstep;
            const char* a2 = last ? nA : cA + (size_t)(t + 2) * kstep; const char* b2 = last ? nB : cB + (size_t)(t + 2) * kstep;
            const char* a3 = a2 + kstep; const char* b3 = b2 + kstep;
            if (last && has_next) S.a_ready(nxt);
            if constexpr (SP2) {
            PG8_LDB(B0, 0, 0); PG8_LDB(B1, 0, 1); PG8_SCHED; PG8_LDA(At, 0, 0); PG8_STAGE(PG8_SA(1, 1), a1 + hstep, voffA);
            PG8_WAIT_V(8); PG8_WAIT_L(0); PG8_BAR; PG8_MMA(0, 0, At, B0); PG8_MMA(0, 1, At, B1); PG8_BAR; PG8_SCHED;
            PG8_LDA(At, 0, 1); PG8_STAGE(PG8_SB(0, 0), b2, voffB); PG8_STAGE(PG8_SB(0, 1), b2 + hstep, voffB); PG8_STAGE(PG8_SA(0, 0), a2, voffA);
            PG8_WAIT_V(8); PG8_WAIT_L(0); PG8_BAR; PG8_MMA(1, 0, At, B0); PG8_MMA(1, 1, At, B1); PG8_BAR; PG8_SCHED;
            PG8_LDB(B0, 1, 0); PG8_LDB(B1, 1, 1); PG8_SCHED; PG8_LDA(At, 1, 0); PG8_STAGE(PG8_SA(0, 1), a2 + hstep, voffA);
            PG8_WAIT_V(8); PG8_WAIT_L(0); PG8_BAR; PG8_MMA(0, 0, At, B0); PG8_MMA(0, 1, At, B1); PG8_BAR; PG8_SCHED;
            PG8_LDA(At, 1, 1); PG8_STAGE(PG8_SB(1, 0), b3, voffB); PG8_STAGE(PG8_SB(1, 1), b3 + hstep, voffB); PG8_STAGE(PG8_SA(1, 0), a3, voffA);
            PG8_WAIT_V(8); PG8_WAIT_L(0); PG8_BAR; PG8_MMA(1, 0, At, B0); PG8_MMA(1, 1, At, B1); PG8_BAR; PG8_SCHED;
            } else {
            PG8_LDB(B0, 0, 0); PG8_SCHED; PG8_LDA(At, 0, 0); PG8_STAGE(PG8_SA(1, 1), a1 + hstep, voffA);
            PG8_WAIT_L(8); PG8_BAR; PG8_WAIT_L(0); PG8_MMA(0, 0, At, B0); PG8_BAR; PG8_SCHED;
            PG8_LDB(B1, 0, 1); PG8_STAGE(PG8_SB(0, 0), b2, voffB);
            PG8_BAR; PG8_WAIT_L(0); PG8_MMA(0, 1, At, B1); PG8_BAR;
            PG8_LDA(At, 0, 1); PG8_STAGE(PG8_SA(0, 0), a2, voffA);
            PG8_BAR; PG8_WAIT_L(0); PG8_MMA(1, 0, At, B0); PG8_BAR; PG8_SCHED;
            PG8_STAGE(PG8_SB(0, 1), b2 + hstep, voffB);
            PG8_WAIT_V(6); PG8_BAR; PG8_MMA(1, 1, At, B1); PG8_BAR;
            PG8_LDB(B0, 1, 0); PG8_SCHED; PG8_LDA(At, 1, 0); PG8_STAGE(PG8_SA(0, 1), a2 + hstep, voffA);
            PG8_WAIT_L(8); PG8_BAR; PG8_WAIT_L(0); PG8_MMA(0, 0, At, B0); PG8_BAR; PG8_SCHED;
            PG8_LDB(B1, 1, 1); PG8_STAGE(PG8_SB(1, 0), b3, voffB);
            PG8_BAR; PG8_WAIT_L(0); PG8_MMA(0, 1, At, B1); PG8_BAR;
            PG8_LDA(At, 1, 1); PG8_STAGE(PG8_SA(1, 0), a3, voffA);
            PG8_BAR; PG8_WAIT_L(0); PG8_MMA(1, 0, At, B0); PG8_BAR; PG8_SCHED;
            PG8_STAGE(PG8_SB(1, 1), b3 + hstep, voffB);
            PG8_WAIT_V(6); PG8_BAR; PG8_MMA(1, 1, At, B1); PG8_BAR;
            }
        }
        if constexpr (ALIGN_EPI) { if (wr == 0) PG8_BAR; }
        if constexpr (!Epi::AFTER_DRAIN) { E(acc, cur, wr, wc, fr, fq); S.done(cur); }
        if (!has_next) break;
#pragma unroll
        for (int a = 0; a < 2; ++a)
#pragma unroll
            for (int b = 0; b < 2; ++b)
#pragma unroll
                for (int m = 0; m < 4; ++m)
#pragma unroll
                    for (int n = 0; n < 2; ++n) acc[a][b][m][n] = (f32x4){0.f, 0.f, 0.f, 0.f};
        cur = nxt; cA = nA; cB = nB; ++ui;
        if constexpr (ALIGN_EPI) { if (wr == 1) PG8_BAR; }
    }
    PG8_WAIT_V(0);
    if constexpr (!ALIGN_EPI) { if (wr == 0) PG8_BAR; }
    PG8_BAR;
    if constexpr (Epi::AFTER_DRAIN) { E.fused(acc, cur, wr, wc, fr, fq, lds, wid, lane); S.done(cur); }
#undef PG8_SA
#undef PG8_SB
#undef PG8_STAGE
#undef PG8_LDA
#undef PG8_LDB
#undef PG8_MMA
#undef PG8_WAIT_V
#undef PG8_WAIT_L
#undef PG8_BAR
#undef PG8_SCHED
}
}
#define LAS __attribute__((address_space(3)))
typedef unsigned short bf16_t;
typedef short bf16x8 __attribute__((ext_vector_type(8)));
typedef short s16x4 __attribute__((ext_vector_type(4)));
typedef float f32x4 __attribute__((ext_vector_type(4)));
typedef float f32x16 __attribute__((ext_vector_type(16)));
typedef unsigned u32x4 __attribute__((ext_vector_type(4)));
typedef unsigned u32x2 __attribute__((ext_vector_type(2)));
typedef float f32x2_t __attribute__((ext_vector_type(2)));
typedef __bf16 bf16x2_t __attribute__((ext_vector_type(2)));

constexpr int NB = 2, SEQ = 16384, T = NB * SEQ, DM = 1024, DEPTH = 4, DFF = 2816, NGU = 2 * DFF;
constexpr int NIN_SRC = 2208, NPROJ = 3328;
constexpr int PA = 0, PC = 512, PD = 1024, PCQ = 1792, PCKV = 2048, PKR = 2176, PQUP = 2208, PKVUP = 2592, PEND = 3104;
constexpr float LOG2E = 1.4426950408889634f;
constexpr float NORM_EPS = 1e-5f;
constexpr int NWAVES = 8, NTHREADS = 512;
constexpr int LDS_BYTES = 147456;

constexpr size_t MiB = 1u << 20;
constexpr size_t WS_WGU = 0, WS_WD = 88 * MiB, WS_WIN = 132 * MiB, WS_WOUT = 158 * MiB, WS_XB = 166 * MiB;
constexpr size_t WS_H = 230 * MiB, WS_PROJ = 230 * MiB, WS_QB = 438 * MiB, WS_KB = 462 * MiB, WS_VB = 486 * MiB, WS_MIX = 502 * MiB, WS_AUG = 566 * MiB, WS_CTL = 568 * MiB, WS_KMAX = WS_CTL, WS_C12 = WS_CTL + 4096, WS_BAR = WS_CTL + 512 * 1024, WS_STATS = WS_CTL + 1 * MiB, CTL_BYTES = 4 * MiB, WS_END = 572 * MiB;
constexpr int C12_L = 2 * NGU + NPROJ;
constexpr size_t C2_OFF = (size_t)DEPTH * C12_L;
static_assert(pg8::EPI_WS_XB == WS_XB && pg8::EPI_WS_STATS == WS_STATS && pg8::EPI_T == T, "part1's copies of the workspace map");
static_assert(WS_C12 + 2 * C2_OFF * 4 <= WS_BAR && WS_BAR + 3456 * 4 <= WS_STATS, "control region");
static_assert(WS_C12 + 2 * C2_OFF * 4 <= WS_STATS && WS_STATS + (size_t)12 * T * 8 <= WS_CTL + CTL_BYTES, "control region");
constexpr size_t WGU_L = (size_t)2 * NGU * DM, WGU_F = (size_t)NGU * DM;
constexpr size_t WD_L = (size_t)2 * DM * DFF, WD_F = (size_t)DM * DFF;
constexpr size_t WIN_L = (size_t)NPROJ * DM, WOUT_L = (size_t)DM * DM;

struct Params {
    const float* x; const float* w_in; const float* win_sink; const float* mla_q_norm; const float* mla_w_uq; const float* mla_kv_norm; const float* mla_w_ukv;
    const float* ax_q_norm; const float* ax_k_norm; const float* diff_lambda; const float* diff_subln; const float* w_out; const float* ffn_w_gu; const float* ffn_w_down;
    const float* ln_g; const float* ln_b;
    float* out; unsigned char* ws;
    float lam_init[4];
    float inv32[16];
};

typedef const __attribute__((address_space(4))) Params* KP;
#define GETP(name) KP name = (KP)__builtin_amdgcn_kernarg_segment_ptr(); asm volatile("" : "+s"(name))

__device__ __forceinline__ int tid_fresh() { int t = threadIdx.x; asm volatile("" : "+v"(t)); return t; }
__device__ __forceinline__ unsigned pkbf(float lo, float hi) { f32x2_t v = {lo, hi}; bf16x2_t b = __builtin_convertvector(v, bf16x2_t); return __builtin_bit_cast(unsigned, b); }
__device__ __forceinline__ float bflo(unsigned w) { return __builtin_bit_cast(float, w << 16); }
__device__ __forceinline__ float bfhi(unsigned w) { return __builtin_bit_cast(float, w & 0xffff0000u); }
__device__ __forceinline__ float wave_sum(float v) {
#pragma unroll
    for (int o = 1; o < 64; o <<= 1) v += __shfl_xor(v, o);
    return v;
}
__device__ __forceinline__ void unpack8(const u32x4 w, float (&v)[8]) {
    v[0] = bflo(w.x); v[1] = bfhi(w.x); v[2] = bflo(w.y); v[3] = bfhi(w.y); v[4] = bflo(w.z); v[5] = bfhi(w.z); v[6] = bflo(w.w); v[7] = bfhi(w.w);
}
__device__ __forceinline__ u32x4 pack8(const float (&v)[8]) { u32x4 w; w.x = pkbf(v[0], v[1]); w.y = pkbf(v[2], v[3]); w.z = pkbf(v[4], v[5]); w.w = pkbf(v[6], v[7]); return w; }

__device__ __forceinline__ void transpose_item(const float* __restrict__ W, int ldw, int src_col0, float scale, bf16_t* __restrict__ WT, int K, int dst_row0, int k0, LAS float* scr, int lane,
                                               const float* __restrict__ lng, const float* __restrict__ lnb, float* c1, float* c2) {
    if (src_col0 < 0) {
        const int c = lane & 7;
#pragma unroll
        for (int j = 0; j < 4; ++j) { const int n = (lane >> 3) + 8 * j; *(u32x4*)(WT + (size_t)(dst_row0 + n) * K + k0 + 8 * c) = (u32x4){0u, 0u, 0u, 0u}; }
        return;
    }
    float a1 = 0.f, a2 = 0.f;
#pragma unroll
    for (int i = 0; i < 32; ++i) { const int kk = 2 * i + (lane >> 5); float w = W[(size_t)(k0 + kk) * ldw + src_col0 + (lane & 31)] * scale;
        if (lng) { a2 = fmaf(lnb[k0 + kk], w, a2); w *= lng[k0 + kk]; a1 += bflo(pkbf(w, 0.f)); }
        scr[kk * 33 + (lane & 31)] = w; }
    asm volatile("s_waitcnt lgkmcnt(0)" ::: "memory");
    const int c = lane & 7;
#pragma unroll
    for (int j = 0; j < 4; ++j) { const int n = (lane >> 3) + 8 * j; const LAS float* s = scr + (8 * c) * 33 + n;
        u32x4 o; o.x = pkbf(s[0 * 33], s[1 * 33]); o.y = pkbf(s[2 * 33], s[3 * 33]); o.z = pkbf(s[4 * 33], s[5 * 33]); o.w = pkbf(s[6 * 33], s[7 * 33]);
        *(u32x4*)(WT + (size_t)(dst_row0 + n) * K + k0 + 8 * c) = o; }
    asm volatile("s_waitcnt lgkmcnt(0)" ::: "memory");
    if (lng) { a1 += __shfl_xor(a1, 32); a2 += __shfl_xor(a2, 32);
        if (lane < 32) { atomicAdd(c1 + dst_row0 + lane, a1); atomicAdd(c2 + dst_row0 + lane, a2); } }
}

__device__ __forceinline__ void phase0(KP p, LAS unsigned char* lds, int vcu, int G) {
    const int tid = tid_fresh(), lane = tid & 63, wave = __builtin_amdgcn_readfirstlane(tid >> 6);
    LAS float* scr = (LAS float*)(lds + wave * 16384);
    const int gw = vcu * NWAVES + wave, NGW = G * NWAVES;
    bf16_t* wgu = (bf16_t*)(p->ws + WS_WGU); bf16_t* wd = (bf16_t*)(p->ws + WS_WD); bf16_t* win = (bf16_t*)(p->ws + WS_WIN); bf16_t* wout = (bf16_t*)(p->ws + WS_WOUT);
    float* c12 = (float*)(p->ws + WS_C12);
    constexpr int I_GU = 176 * 16, I_WD = 32 * 44, I_IN = 104 * 16, I_OUT = 32 * 16, I_CMP = 128 * 14;
    constexpr int I_LAYER = 2 * I_GU + 2 * I_WD + I_IN + I_OUT + I_CMP;
    for (int it = gw; it < DEPTH * I_LAYER; it += NGW) {
        const int l = it / I_LAYER; int r = it % I_LAYER;
        if (r < 2 * I_GU) { const int f = r / I_GU; r %= I_GU; const int nb = r / 16, kb = r % 16; const int n0 = 32 * nb;
            const int pn = n0 >> 8, bj = (n0 >> 7) & 1, i0 = n0 & 127;
            const int s = 3 * l + 2 * f - 1;
            transpose_item(p->ffn_w_gu + ((size_t)l * 2 + f) * DM * NGU, NGU, bj * DFF + 128 * pn + i0, 1.f, wgu + l * WGU_L + f * WGU_F, DM, n0, 64 * kb, scr, lane,
                           s >= 0 ? p->ln_g + s * DM : nullptr, s >= 0 ? p->ln_b + s * DM : nullptr, c12 + l * C12_L + f * NGU, c12 + C2_OFF + l * C12_L + f * NGU); continue; }
        r -= 2 * I_GU;
        if (r < 2 * I_WD) { const int f = r / I_WD; r %= I_WD; const int nb = r / 44, kb = r % 44;
            transpose_item(p->ffn_w_down + ((size_t)l * 2 + f) * DFF * DM, DM, 32 * nb, 1.f, wd + l * WD_L + f * WD_F, DFF, 32 * nb, 64 * kb, scr, lane, nullptr, nullptr, nullptr, nullptr); continue; }
        r -= 2 * I_WD;
        if (r < I_IN) { const int nb = r / 16, kb = r % 16; const int n0 = 32 * nb; int src; float sc = 1.f;
            if (n0 < PC) { src = n0; if (n0 < 256) sc = 0.125f; }
            else if (n0 < PD) src = 928 + (n0 - PC);
            else if (n0 < PCQ) { src = 1440 + (n0 - PD); if (n0 - PD < 256) sc = 0.17677669529663687f; }
            else if (n0 < PCKV) src = 512 + (n0 - PCQ);
            else if (n0 < PKR) src = 768 + (n0 - PCKV);
            else if (n0 < PQUP) src = 896;
            else if (n0 < PEND) continue;
            else src = -1;
            transpose_item(p->w_in + (size_t)l * DM * NIN_SRC, NIN_SRC, src, sc, win + l * WIN_L, DM, n0, 64 * kb, scr, lane,
                           p->ln_g + (3 * l) * DM, p->ln_b + (3 * l) * DM, c12 + l * C12_L + 2 * NGU, c12 + C2_OFF + l * C12_L + 2 * NGU); continue; }
        r -= I_IN;
        if (r < I_OUT) { const int nb = r / 16, kb = r % 16;
            transpose_item(p->w_out + (size_t)l * DM * DM, DM, 32 * nb, 1.f, wout + l * WOUT_L, DM, 32 * nb, 64 * kb, scr, lane, nullptr, nullptr, nullptr, nullptr); continue; }
        r -= I_OUT;
        {
            const int kb8 = r / 14, ng = r % 14; const int k0 = 8 * kb8;
            int J, cA, ldu, nc; const float* g; const float* U;
            if (ng < 6) { J = 256; cA = 512; g = p->mla_q_norm + l * 256; U = p->mla_w_uq + (size_t)l * 256 * 384; ldu = 384; nc = 64 * ng; }
            else { J = 128; cA = 768; g = p->mla_kv_norm + l * 128; U = p->mla_w_ukv + (size_t)l * 128 * 512; ldu = 512; nc = 64 * (ng - 6); }
            const int nglob = (ng < 6 ? 0 : 384) + nc + lane;
            const float* a = p->w_in + (size_t)l * DM * NIN_SRC + (size_t)k0 * NIN_SRC + cA;
            const float* up = U + nc + lane;
            float acc[8];
#pragma unroll
            for (int e = 0; e < 8; ++e) acc[e] = 0.f;
#pragma unroll 4
            for (int j = 0; j < J; ++j) { const float u = up[(size_t)j * ldu] * g[j];
#pragma unroll
                for (int e = 0; e < 8; ++e) acc[e] = fmaf(a[(size_t)e * NIN_SRC + j], u, acc[e]); }
            const float* lg = p->ln_g + (3 * l) * DM + k0; const float* lb = p->ln_b + (3 * l) * DM + k0;
            float s1 = 0.f, s2 = 0.f; unsigned wb[8];
#pragma unroll
            for (int e = 0; e < 8; ++e) { wb[e] = pkbf(acc[e] * lg[e], 0.f) & 0xffffu; s1 += bflo(wb[e]); s2 = fmaf(acc[e], lb[e], s2); }
            u32x4 o; o.x = wb[0] | (wb[1] << 16); o.y = wb[2] | (wb[3] << 16); o.z = wb[4] | (wb[5] << 16); o.w = wb[6] | (wb[7] << 16);
            *(u32x4*)(win + l * WIN_L + (size_t)(PQUP + nglob) * DM + k0) = o;
            atomicAdd(c12 + l * C12_L + 2 * NGU + PQUP + nglob, s1); atomicAdd(c12 + C2_OFF + l * C12_L + 2 * NGU + PQUP + nglob, s2);
        }
    }
    { u32x4* ag = (u32x4*)(p->ws + WS_AUG);
      for (int i = (vcu * NWAVES + wave) * 64 + lane; i < SEQ * 4; i += G * NWAVES * 64) { const int t = i >> 2, h = i & 3;
          const float sl = __builtin_amdgcn_exp2f(-(float)(5 + h));
          u32x4 w = {pkbf(sl * (float)(128 * (t >> 7)), sl * (float)(t & 127)), 0u, 0u, 0u}; ag[2 * i] = w; ag[2 * i + 1] = (u32x4){0u, 0u, 0u, 0u}; } }
    bf16_t* xb = (bf16_t*)(p->ws + WS_XB);
    for (int m = gw; m < T; m += NGW) {
        const f32x4* xr = (const f32x4*)(p->x + (size_t)m * DM) + lane; u32x2* o8 = (u32x2*)(xb + (size_t)m * DM) + lane;
#pragma unroll
        for (int j = 0; j < 4; ++j) { const f32x4 v = xr[64 * j]; u32x2 w; w.x = pkbf(v.x, v.y); w.y = pkbf(v.z, v.w); o8[64 * j] = w; }
    }
}

__device__ __forceinline__ void ln_phase(float* X, bf16_t* xb, const float* __restrict__ g, const float* __restrict__ b, int vcu, int G) {
    const int tid = tid_fresh(), lane = tid & 63, wave = __builtin_amdgcn_readfirstlane(tid >> 6);
    const int gw = vcu * NWAVES + wave, NGW = G * NWAVES;
    f32x4 gv[4], bv[4];
#pragma unroll
    for (int j = 0; j < 4; ++j) { gv[j] = ((const f32x4*)g)[64 * j + lane]; bv[j] = ((const f32x4*)b)[64 * j + lane]; }
    for (int m = gw; m < T; m += NGW) {
        f32x4* xr = (f32x4*)(X + (size_t)m * DM) + lane; u32x2* o8 = (u32x2*)(xb + (size_t)m * DM) + lane;
        f32x4 v[4]; float s = 0.f;
#pragma unroll
        for (int j = 0; j < 4; ++j) { v[j] = xr[64 * j]; s += (v[j].x + v[j].y) + (v[j].z + v[j].w); }
        const float mean = wave_sum(s) * (1.f / DM); float s2 = 0.f;
#pragma unroll
        for (int j = 0; j < 4; ++j) { v[j] = v[j] - mean; s2 += (v[j].x * v[j].x + v[j].y * v[j].y) + (v[j].z * v[j].z + v[j].w * v[j].w); }
        const float rstd = 1.f / sqrtf(wave_sum(s2) * (1.f / DM) + NORM_EPS);
#pragma unroll
        for (int j = 0; j < 4; ++j) { const f32x4 y = v[j] * rstd * gv[j] + bv[j]; xr[64 * j] = y; u32x2 w; w.x = pkbf(y.x, y.y); w.y = pkbf(y.z, y.w); o8[64 * j] = w; }
    }
}

__device__ __forceinline__ void sincos_rev(float ang, float& s, float& c) {
    double d = (double)ang * 0.15915494309189535; d -= __builtin_rint(d); const float f = (float)d;
    s = __builtin_amdgcn_sinf(f); c = __builtin_amdgcn_cosf(f);
}
__device__ __forceinline__ void rope8(float (&v)[8], bool first, float pos, int i0, KP p) {
#pragma unroll
    for (int e = 0; e < 8; ++e) {
        const float other = __shfl_xor(v[e], 2);
        const float inv = i0 ? p->inv32[8 + e] : p->inv32[e];
        float s, c; sincos_rev(pos * inv, s, c);
        v[e] = first ? (v[e] * c - other * s) : (other * s + v[e] * c);
    }
}
__device__ __forceinline__ void prep_phase(KP p, int l, int vcu, int G) {
    const int tid = tid_fresh(), lane = tid & 63, wave = __builtin_amdgcn_readfirstlane(tid >> 6);
    const int gw = vcu * NWAVES + wave, NGW = G * NWAVES;
    bf16_t* proj = (bf16_t*)(p->ws + WS_PROJ); bf16_t* qb = (bf16_t*)(p->ws + WS_QB); bf16_t* kb = (bf16_t*)(p->ws + WS_KB); bf16_t* vb = (bf16_t*)(p->ws + WS_VB);
    float cg[8];
    { const float* gsrc = (lane < 32 ? p->ax_q_norm : p->ax_k_norm) + l * 64 + 8 * (lane & 7);
#pragma unroll
      for (int e = 0; e < 8; ++e) cg[e] = gsrc[e]; }
    float km0 = 0.f, km1 = 0.f;
    float kb0 = 0.f, kb1 = 0.f, kc0 = 0.f, kc1 = 0.f;
    for (int tok = gw; tok < T; tok += NGW) {
        const int t = tok & (SEQ - 1);
        bf16_t* pr = proj + (size_t)tok * NPROJ;
        const int l48 = lane < 48 ? lane : 0, l32 = lane < 32 ? lane : 0, l4 = lane < 4 ? lane : 0;
        const u32x4 in_cq = *(const u32x4*)(pr + PCQ + 8 * l48), in_qup = *(const u32x4*)(pr + PQUP + 8 * l48), in_kv = *(const u32x4*)(pr + PKVUP + 8 * lane);
        const u32x4 in_kr = *(const u32x4*)(pr + PKR + 8 * l4), in_c = *(const u32x4*)(pr + PC + 8 * l48), in_dk = *(const u32x4*)(pr + PD + 256 + 8 * l32);
        { float s = 0.f;
          if (lane < 32) { float v[8]; unpack8(in_dk, v);
#pragma unroll
              for (int e = 0; e < 8; ++e) s += v[e] * v[e]; }
          s += __shfl_xor(s, 1); s += __shfl_xor(s, 2);
          if (tok < SEQ) km0 = fmaxf(km0, s); else km1 = fmaxf(km1, s); }
        float ssq = 0.f;
        if (lane < 48) { float v[8]; unpack8(in_cq, v);
#pragma unroll
            for (int e = 0; e < 8; ++e) ssq += v[e] * v[e]; }
        const float ssq_q = wave_sum(lane < 32 ? ssq : 0.f), ssq_kv = wave_sum(lane >= 32 ? ssq : 0.f);
        const float rstd_q = 1.f / sqrtf(ssq_q * (1.f / 256.f) + NORM_EPS), rstd_kv = 1.f / sqrtf(ssq_kv * (1.f / 128.f) + NORM_EPS);
        {
            const int r = lane % 12; float v[8];
            unpack8(in_qup, v);
#pragma unroll
            for (int e = 0; e < 8; ++e) v[e] = (lane < 48) ? v[e] * rstd_q : 0.f;
            float w[8];
#pragma unroll
            for (int e = 0; e < 8; ++e) w[e] = v[e];
            rope8(w, r < 10, (float)t, 8 * (r & 1), p);
            const bool isr = (r >= 8); const float qs = 0.10206207261596575f;
#pragma unroll
            for (int e = 0; e < 8; ++e) v[e] = (isr ? w[e] : v[e]) * qs;
            if (lane < 48) *(u32x4*)(qb + (size_t)tok * 384 + 8 * lane) = pack8(v);
        }
        float nope2;
        {
            float v[8]; unpack8(in_kv, v);
#pragma unroll
            for (int e = 0; e < 8; ++e) v[e] *= rstd_kv;
            const int hd = lane >> 4, r = lane & 15;
            { float s = 0.f;
#pragma unroll
              for (int e = 0; e < 8; ++e) s += v[e] * v[e];
              s = (r < 8) ? s : 0.f; s += __shfl_xor(s, 1); s += __shfl_xor(s, 2); s += __shfl_xor(s, 4); nope2 = s; }
            if (r < 8) *(u32x4*)(kb + (size_t)tok * 384 + hd * 96 + 8 * r) = pack8(v);
            else *(u32x4*)(vb + (size_t)tok * 256 + hd * 64 + 8 * (r - 8)) = pack8(v);
        }
        {
            float v[8]; unpack8(in_kr, v);
            rope8(v, (lane & 3) < 2, (float)t, 8 * (lane & 1), p);
            { float s = 0.f;
#pragma unroll
              for (int e = 0; e < 8; ++e) s += v[e] * v[e];
              s = (lane < 4) ? s : 0.f; s += __shfl_xor(s, 1); s += __shfl_xor(s, 2);
              const float kk = nope2 + __shfl(s, 0);
              if (tok < SEQ) kb0 = fmaxf(kb0, kk); else kb1 = fmaxf(kb1, kk); }
            if (lane < 4) { const u32x4 w = pack8(v);
#pragma unroll
                for (int hd = 0; hd < 4; ++hd) *(u32x4*)(kb + (size_t)tok * 384 + hd * 96 + 64 + 8 * lane) = w; }
        }
        {
            float v[8]; unpack8(in_c, v);
            float s = 0.f;
#pragma unroll
            for (int e = 0; e < 8; ++e) s += v[e] * v[e];
            s += __shfl_xor(s, 1); s += __shfl_xor(s, 2); s += __shfl_xor(s, 4);
            const float rs = 1.f / sqrtf(s * (1.f / 64.f) + NORM_EPS);
#pragma unroll
            for (int e = 0; e < 8; ++e) v[e] = v[e] * rs * cg[e];
            const int r = lane & 7; const float pos = (r < 4) ? (float)(t >> 6) : (float)(t & 63);
            rope8(v, (r & 3) < 2, pos, 8 * (r & 1), p);
            { float s2 = 0.f;
#pragma unroll
              for (int e = 0; e < 8; ++e) s2 += v[e] * v[e];
              s2 += __shfl_xor(s2, 1); s2 += __shfl_xor(s2, 2); s2 += __shfl_xor(s2, 4);
              if (tok < SEQ) kc0 = fmaxf(kc0, s2); else kc1 = fmaxf(kc1, s2); }
            if (lane < 32) {
#pragma unroll
                for (int e = 0; e < 8; ++e) v[e] *= 0.125f; }
            if (lane < 48) *(u32x4*)(pr + PC + 8 * lane) = pack8(v);
        }
    }
    unsigned* kmw = (unsigned*)(p->ws + WS_KMAX) + l * 32;
    if (lane < 32 && (lane & 3) == 0) { atomicMax(kmw + (lane >> 2), __builtin_bit_cast(unsigned, km0)); atomicMax(kmw + 8 + (lane >> 2), __builtin_bit_cast(unsigned, km1)); }
    if ((lane & 15) == 0) { atomicMax(kmw + 16 + (lane >> 4), __builtin_bit_cast(unsigned, kb0)); atomicMax(kmw + 20 + (lane >> 4), __builtin_bit_cast(unsigned, kb1)); }
    if (lane == 32 || lane == 40) { atomicMax(kmw + 24 + ((lane - 32) >> 3), __builtin_bit_cast(unsigned, kc0)); atomicMax(kmw + 26 + ((lane - 32) >> 3), __builtin_bit_cast(unsigned, kc1)); }
}

#ifndef ATT_TYPES
#define ATT_TYPES 15
#endif
namespace att {
typedef float f32x2 __attribute__((ext_vector_type(2)));
constexpr int VPITCH = 144, KBUF = 64 * 208, VBUF = 64 * VPITCH;
constexpr int ATT_LDS = 2 * KBUF + 2 * VBUF;
constexpr float RESCALE_T = 5.0f;
__device__ __forceinline__ s16x4 vtr(const LAS char* p) { return __builtin_bit_cast(s16x4, __builtin_amdgcn_ds_read_tr16_b64_v4i16((LAS s16x4*)p)); }
__device__ __forceinline__ void xhalf_swap(float m, float& a, float& b) {
    a = m; b = m;
    asm volatile("s_nop 1\n\tv_permlane32_swap_b32 %0, %1\n\ts_nop 1" : "+v"(a), "+v"(b));
}
__device__ __forceinline__ float xhalf_max(float m) { float a, b; xhalf_swap(m, a, b); return fmaxf(a, b); }
__device__ __forceinline__ float xhalf_sum(float m) { float a, b; xhalf_swap(m, a, b); return a + b; }
__device__ __forceinline__ float max3f(float a, float b, float c) { return fmaxf(fmaxf(a, b), c); }
__device__ __forceinline__ float fma_s(float a, float b, float c) { float r; asm("v_fma_f32 %0, %1, %2, %3" : "=v"(r) : "v"(a), "s"(b), "v"(c)); return r; }
__device__ __forceinline__ float add_s(float a, float b) { float r; asm("v_add_f32_e32 %0, %1, %2" : "=v"(r) : "v"(a), "v"(b)); return r; }
__device__ __forceinline__ float mul_s(float a, float b) { float r; asm("v_mul_f32_e32 %0, %1, %2" : "=v"(r) : "v"(a), "v"(b)); return r; }
#define ATT_MFMA(a, b, c) __builtin_amdgcn_mfma_f32_32x32x16_bf16((a), (b), (c), 0, 0, 0)

template <int DK, int MODE, bool INIT = true, bool TRACK = (MODE == 2)>
__device__ __forceinline__ void flash_pass(LAS char* lds, const bf16_t* __restrict__ Qg, int qp, const bf16_t* __restrict__ Kg, int kp, const bf16_t* __restrict__ Vg, int vp,
                                           const bf16_t* __restrict__ AUGg, int q0, int a0, int nA, int b0, int nt, float slope, f32x16& O0, f32x16& O1, float& Mout, float& Lout) {
    constexpr int DKL = DK + (MODE == 1 ? 16 : 0);
    constexpr int KPITCH = DKL * 2 + 16, NKC = 8 * DKL, CPR = DKL / 8, NKS = DK / 16;
    constexpr bool HAS_K1 = NKC > 512;
    constexpr int DUMMY = 2 * KBUF + 2 * VBUF;
    const int tid = tid_fresh(), lane = tid & 63, r32 = lane & 31, hi = lane >> 5; const int wid = __builtin_amdgcn_readfirstlane(tid >> 6);
    const int qrow = q0 + wid * 32 + r32;
    bf16x8 qf[NKS];
#pragma unroll
    for (int ks = 0; ks < NKS; ++ks) qf[ks] = *(const bf16x8*)(Qg + (size_t)qrow * qp + 16 * ks + 8 * hi);
    const int kc1 = tid + 512;
    const bool k0v = tid < NKC, k1v = HAS_K1 && kc1 < NKC;
    const int kr0 = k0v ? tid / CPR : 0, kcc0 = k0v ? tid % CPR : 0, kr1 = k1v ? kc1 / CPR : 0, kcc1 = k1v ? kc1 % CPR : 0, vr = tid >> 3, vcc = tid & 7;
    const bf16_t* kg0; size_t kst0;
    if (MODE == 1 && kcc0 >= DK / 8) { kg0 = AUGg + (size_t)kr0 * 64 + 8 * (kcc0 - DK / 8); kst0 = (size_t)64 * 64; } else { kg0 = Kg + (size_t)kr0 * kp + 8 * kcc0; kst0 = (size_t)64 * kp; }
    const bf16_t* kg1 = Kg + (size_t)kr1 * kp + 8 * kcc1; const size_t kst1 = (size_t)64 * kp;
    const bf16_t* vg = Vg + (size_t)vr * vp + 8 * vcc; const size_t vst = (size_t)64 * vp;
    const int kl0 = k0v ? kr0 * KPITCH + 16 * kcc0 : -1, kl1 = k1v ? kr1 * KPITCH + 16 * kcc1 : -1, vl = 2 * KBUF + vr * VPITCH + 16 * vcc;
    u32x4 rk0A = {0u, 0u, 0u, 0u}, rk1A = {0u, 0u, 0u, 0u}, rvA = {0u, 0u, 0u, 0u}, rk0B = {0u, 0u, 0u, 0u}, rk1B = {0u, 0u, 0u, 0u}, rvB = {0u, 0u, 0u, 0u};
#define ATT_KT(i) ((i) < nA ? a0 + (i) : b0 + ((i) - nA))
#define ATT_LOADK(X, kt) do { const size_t t_ = (size_t)(kt); rk0##X = *(const u32x4*)(kg0 + t_ * kst0); if (HAS_K1) rk1##X = *(const u32x4*)(kg1 + t_ * kst1); } while (0)
#define ATT_LOADV(X, kt) do { rv##X = *(const u32x4*)(vg + (size_t)(kt) * vst); } while (0)
#define ATT_STOREK(X, buf) do { *(LAS u32x4*)(lds + (kl0 >= 0 ? (buf) * KBUF + kl0 : DUMMY + tid * 16)) = rk0##X; if (HAS_K1) *(LAS u32x4*)(lds + (kl1 >= 0 ? (buf) * KBUF + kl1 : DUMMY + tid * 16)) = rk1##X; } while (0)
#define ATT_STOREV(X, buf) do { *(LAS u32x4*)(lds + (buf) * VBUF + vl) = rv##X; } while (0)
    const int q4 = (lane & 15) >> 2, p4 = lane & 3, b16 = (lane >> 4) & 1;
    const int vbase = 2 * KBUF + (4 * hi + q4) * VPITCH + 32 * b16 + 8 * p4;
    const int kbase = r32 * KPITCH + 16 * hi;
    const int qw = q0 + wid * 32;
    const float stq = slope * (float)qrow;
    const bf16x8 qzero = {0, 0, 0, 0, 0, 0, 0, 0};
    bf16x8 qpos = qzero, qneg = qzero;
    if (MODE == 1 && hi == 0) { qpos[0] = (short)0x3F80; qpos[1] = (short)0x3F80; qneg[0] = (short)0xBF80; qneg[1] = (short)0xBF80; }
    constexpr int NKF = NKS + (MODE == 1 ? 1 : 0);
    constexpr int KPRE = NKF > 4 ? 4 : NKF;
    bf16x8 kfa[NKF], kfb[NKF];
#define ATT_KREAD(kbuf, f0, f1) do { const LAS char* Kb_ = lds + (kbuf) * KBUF + kbase; \
        _Pragma("unroll") for (int ks_ = (f0); ks_ < (f1); ++ks_) { kfa[ks_] = *(const LAS bf16x8*)(Kb_ + 32 * ks_); kfb[ks_] = *(const LAS bf16x8*)(Kb_ + 32 * KPITCH + 32 * ks_); } } while (0)
#define ATT_QKM(sa, sb, side) do { \
        _Pragma("unroll") for (int e_ = 0; e_ < 16; ++e_) { sa[e_] = 0.f; sb[e_] = 0.f; } \
        _Pragma("unroll") for (int ks_ = 0; ks_ < NKS; ++ks_) { sa = ATT_MFMA(kfa[ks_], qf[ks_], sa); sb = ATT_MFMA(kfb[ks_], qf[ks_], sb); } \
        if (MODE == 1) { const bf16x8 qa_ = (side) < 0 ? qpos : ((side) > 0 ? qneg : qzero); sa = ATT_MFMA(kfa[NKS], qa_, sa); sb = ATT_MFMA(kfb[NKS], qa_, sb); } } while (0)
#define ATT_QK(sa, sb, kbuf, side) do { ATT_KREAD(kbuf, 0, NKF); ATT_QKM(sa, sb, side); } while (0)
    bf16x8 vfa[4], vfb[4];
#define ATT_VREAD(vbuf) do { const LAS char* Vb_ = lds + (vbuf) * VBUF + vbase; \
        _Pragma("unroll") for (int j_ = 0; j_ < 4; ++j_) { const LAS char* vp0_ = Vb_ + (16 * j_) * VPITCH; \
            { const s16x4 lo_ = vtr(vp0_), hh_ = vtr(vp0_ + 8 * VPITCH); vfa[j_] = __builtin_shufflevector(lo_, hh_, 0, 1, 2, 3, 4, 5, 6, 7); } \
            { const s16x4 lo_ = vtr(vp0_ + 64), hh_ = vtr(vp0_ + 8 * VPITCH + 64); vfb[j_] = __builtin_shufflevector(lo_, hh_, 0, 1, 2, 3, 4, 5, 6, 7); } } } while (0)
#define ATT_PVM() do { _Pragma("unroll") for (int j_ = 0; j_ < 4; ++j_) { O0 = ATT_MFMA(vfa[j_], pf[j_ >> 1][j_ & 1], O0); O1 = ATT_MFMA(vfb[j_], pf[j_ >> 1][j_ & 1], O1); } } while (0)
#define ATT_PV(vbuf) do { ATT_VREAD(vbuf); ATT_PVM(); } while (0)
#define ATT_SIDE(kt) ((MODE != 1) ? 0 : (((kt) * 64 + 63 < qw) ? -1 : (((kt) * 64 > qw + 31) ? 1 : 0)))
    ATT_LOADK(A, ATT_KT(0)); ATT_LOADK(B, ATT_KT(1)); ATT_STOREV(B, 1);
    ATT_STOREK(A, 0); ATT_STOREK(B, 1);
    ATT_LOADK(A, ATT_KT(2)); ATT_LOADV(A, ATT_KT(0));
    __syncthreads();
    float M = (INIT && TRACK) ? -1e20f : Mout, L = INIT ? 0.f : Lout;
    if (INIT) {
#pragma unroll
        for (int i = 0; i < 16; ++i) { O0[i] = 0.f; O1[i] = 0.f; } }
    bf16x8 pf[2][2];
#pragma unroll
    for (int kb = 0; kb < 2; ++kb)
#pragma unroll
        for (int st = 0; st < 2; ++st) pf[kb][st] = qzero;
    f32x16 s0, s1, n0, n1;
    int side_cur = ATT_SIDE(ATT_KT(0));
    ATT_QK(s0, s1, 0, side_cur);
#pragma unroll
    for (int e = 0; e < 16; ++e) { n0[e] = 0.f; n1[e] = 0.f; }
    __syncthreads();
    constexpr int NMF = 2 * NKS + (MODE == 1 ? 2 : 0) + 8;
#define ATT_ITER(i, C0, C1, N0, N1, LS, SS, HASN, HASK2, HASK3) do { \
        const int kt = ATT_KT(i); \
        if (HASK3) ATT_LOADK(LS, ATT_KT((i) + 3)); \
        if (HASN) ATT_LOADV(LS, ATT_KT((i) + 1)); \
        if (HASN) ATT_KREAD(((i) + 1) & 1, 0, KPRE); \
        const int k0 = kt * 64; \
          \
        float rc = 0.f; \
        if (MODE == 1) { \
            if (side_cur != 0) rc = side_cur < 0 ? -stq : stq; \
            else { const float dbase = (float)(k0 + 4 * hi - qrow); \
                _Pragma("unroll") for (int e = 0; e < 16; ++e) { const float c = (float)((e & 3) + 8 * (e >> 2)); \
                    C0[e] = fmaf(-slope, fabsf(dbase + c), C0[e]); C1[e] = fmaf(-slope, fabsf(dbase + (c + 32.f)), C1[e]); } } \
        } \
        if (MODE == 2) { const float dbase = (float)(k0 + 4 * hi - qrow); \
            _Pragma("unroll") for (int e = 0; e < 16; ++e) { const float c = (float)((e & 3) + 8 * (e >> 2)); \
                const float d0 = fabsf(dbase + c), d1 = fabsf(dbase + (c + 32.f)); \
                C0[e] = (d0 <= 128.f) ? fmaf(-slope, d0, C0[e]) : -1e30f; C1[e] = (d1 <= 128.f) ? fmaf(-slope, d1, C1[e]) : -1e30f; } } \
        if (TRACK) { \
        float mx = max3f(C0[0], C1[0], C0[1]); \
        _Pragma("unroll") for (int e = 1; e < 15; e += 2) { mx = max3f(mx, C1[e], C0[e + 1]); mx = max3f(mx, C1[e + 1], C0[e + 2]); } \
        mx = fmaxf(mx, C1[15]); \
        const float mt = xhalf_max(mx) + rc;                     \
        if (__builtin_amdgcn_ballot_w64(mt > M + RESCALE_T) != 0ull) {         \
            ATT_PV(((i) + 1) & 1); \
            _Pragma("unroll") for (int kb = 0; kb < 2; ++kb) _Pragma("unroll") for (int st = 0; st < 2; ++st) pf[kb][st] = qzero; \
            const float Mn = fmaxf(M, mt); const float alpha = __builtin_amdgcn_exp2f((M - Mn) * LOG2E); M = Mn; \
            L *= alpha; \
            _Pragma("unroll") for (int e = 0; e < 16; ++e) { O0[e] *= alpha; O1[e] *= alpha; }        \
        } } \
          \
        const int side_next = HASN ? ATT_SIDE(ATT_KT((i) + 1)) : 0; \
        if (HASN) ATT_KREAD(((i) + 1) & 1, KPRE, NKF); \
        ATT_VREAD(((i) + 1) & 1); \
        if (HASN) ATT_QKM(N0, N1, side_next); \
        ATT_PVM();                                   \
        const float cc = (rc - M) * LOG2E; \
        float ps = 0.f;                                          \
        float ps1 = 0.f; \
        _Pragma("unroll") for (int e = 0; e < 16; ++e) { float t0 = __builtin_fmaf(C0[e], LOG2E, cc), t1 = __builtin_fmaf(C1[e], LOG2E, cc); \
            asm("" : "+v"(t0)); asm("" : "+v"(t1));                 \
            C0[e] = __builtin_amdgcn_exp2f(t0); C1[e] = __builtin_amdgcn_exp2f(t1); \
            float u0 = ps + C0[e], u1 = ps1 + C1[e]; asm("" : "+v"(u0)); asm("" : "+v"(u1)); ps = u0; ps1 = u1; } \
        L += ps + ps1; \
        _Pragma("unroll") for (int st = 0; st < 2; ++st) { u32x4 w0, w1; \
            w0.x = pkbf(C0[8 * st + 0], C0[8 * st + 1]); w0.y = pkbf(C0[8 * st + 2], C0[8 * st + 3]); w0.z = pkbf(C0[8 * st + 4], C0[8 * st + 5]); w0.w = pkbf(C0[8 * st + 6], C0[8 * st + 7]); \
            w1.x = pkbf(C1[8 * st + 0], C1[8 * st + 1]); w1.y = pkbf(C1[8 * st + 2], C1[8 * st + 3]); w1.z = pkbf(C1[8 * st + 4], C1[8 * st + 5]); w1.w = pkbf(C1[8 * st + 6], C1[8 * st + 7]); \
            pf[0][st] = __builtin_bit_cast(bf16x8, w0); pf[1][st] = __builtin_bit_cast(bf16x8, w1); } \
        side_cur = side_next; \
        if (HASN) { __builtin_amdgcn_sched_group_barrier(0x100, 8, 0);        \
            _Pragma("unroll") for (int g_ = 0; g_ < NMF; ++g_) { __builtin_amdgcn_sched_group_barrier(0x008, 1, 0); __builtin_amdgcn_sched_group_barrier(0x100, 2, 0); __builtin_amdgcn_sched_group_barrier(0x002, 6, 0); } } \
        if (HASK2) ATT_STOREK(SS, (i) & 1); \
        ATT_STOREV(SS, (i) & 1); \
        __syncthreads(); } while (0)
    for (int i = 0; i + 4 < nt; i += 2) {
        ATT_ITER(i, s0, s1, n0, n1, B, A, true, true, true);
        ATT_ITER(i + 1, n0, n1, s0, s1, A, B, true, true, true);
    }
    ATT_ITER(nt - 4, s0, s1, n0, n1, B, A, true, true, true);
    ATT_ITER(nt - 3, n0, n1, s0, s1, A, B, true, true, false);
    ATT_ITER(nt - 2, s0, s1, n0, n1, B, A, true, false, false);
    ATT_ITER(nt - 1, n0, n1, s0, s1, A, B, false, false, false);
    ATT_PV((nt - 1) & 1);
    __syncthreads();
#undef ATT_ITER
#undef ATT_LOADK
#undef ATT_LOADV
#undef ATT_STOREK
#undef ATT_STOREV
#undef ATT_KT
#undef ATT_QK
#undef ATT_PV
#undef ATT_KREAD
#undef ATT_QKM
#undef ATT_VREAD
#undef ATT_PVM
#undef ATT_SIDE
    Mout = M; Lout = L;
}

template <int NE> __device__ __forceinline__ float row_norm2(const bf16_t* qrow_ptr) {
    float s = 0.f;
#pragma unroll
    for (int c = 0; c < NE / 8; ++c) { float v[8]; unpack8(((const u32x4*)qrow_ptr)[c], v);
#pragma unroll
        for (int e = 0; e < 8; ++e) s += v[e] * v[e]; }
    return s;
}
__device__ __forceinline__ void store_o(bf16_t* orow, const f32x16& O0, const f32x16& O1, int hi) {
#pragma unroll
    for (int g = 0; g < 4; ++g) {
        u32x2 w0, w1; w0.x = pkbf(O0[4 * g], O0[4 * g + 1]); w0.y = pkbf(O0[4 * g + 2], O0[4 * g + 3]); w1.x = pkbf(O1[4 * g], O1[4 * g + 1]); w1.y = pkbf(O1[4 * g + 2], O1[4 * g + 3]);
        *(u32x2*)(orow + 8 * g + 4 * hi) = w0; *(u32x2*)(orow + 32 + 8 * g + 4 * hi) = w1;
    }
}

__device__ __forceinline__ void attn_phase(KP p, int l, LAS char* lds, int vcu, int G) {
    const bf16_t* proj = (const bf16_t*)(p->ws + WS_PROJ); const bf16_t* qb = (const bf16_t*)(p->ws + WS_QB); const bf16_t* kb = (const bf16_t*)(p->ws + WS_KB); const bf16_t* vb = (const bf16_t*)(p->ws + WS_VB);
    const bf16_t* aug = (const bf16_t*)(p->ws + WS_AUG);
    bf16_t* mix = (bf16_t*)(p->ws + WS_MIX);
    for (int u = vcu; u < 2048; u += G) {
        if (!((ATT_TYPES >> (u >> 9)) & 1)) continue;
        const int tid = tid_fresh(), lane = tid & 63, r32 = lane & 31, hi = lane >> 5; const int wid = __builtin_amdgcn_readfirstlane(tid >> 6);
        const int type = u >> 9, idx = u & 511, bh = idx >> 6, qblk = idx & 63, b = bh >> 2, hd = bh & 3, q0 = qblk * 256;
        const int qrow = q0 + wid * 32 + r32;
        const size_t tok0 = (size_t)b * SEQ;
        bf16_t* orow = mix + (tok0 + qrow) * DM;
        f32x16 O0, O1; float M, L;
        if (type == 0) {
            const int bD = idx >> 8, hD = ((idx >> 6) & 3) ^ (bD ? 3 : 0);
            const size_t tokD = (size_t)bD * SEQ;
            bf16_t* orowD = mix + (tokD + qrow) * DM;
            const float slope = __builtin_amdgcn_exp2f(-(float)(5 + hD));
            const bf16_t* base = proj + tokD * NPROJ + PD;
            const int d0 = q0 / 64;
            LAS float* asave = (LAS float*)(lds + 65536) + tid;
#pragma unroll 1
            for (int mp = 0; mp < 2; ++mp) {
                const bf16_t* Qm = base + 64 * hD + 32 * mp; const bf16_t* Km = base + 256 + 64 * hD + 32 * mp; const bf16_t* Vm = base + 512 + 64 * hD;
                const float kmax = sqrtf(__builtin_bit_cast(float, ((const unsigned*)(p->ws + WS_KMAX))[l * 32 + bD * 8 + hD * 2 + mp]));
                const float bound = sqrtf(row_norm2<32>(Qm + (size_t)qrow * NPROJ)) * kmax * 1.01f;
                M = bound;
                flash_pass<32, 1, true>(lds, Qm, NPROJ, Km, NPROJ, Vm, NPROJ, aug + 16 * hD, q0, d0, 4, 0, 4, slope, O0, O1, M, L);
                float dc = (bound + 32.f - (M + __logf(fmaxf(xhalf_sum(L), 1e-37f)))) / slope;
                dc = fminf(fmaxf(dc, 0.f), 1.0e8f);
#pragma unroll
                for (int o = 1; o < 64; o <<= 1) dc = fmaxf(dc, __shfl_xor(dc, o));
                LAS float* red = (LAS float*)(lds + ATT_LDS + 16384);
                if (lane == 0) red[wid] = dc;
                __syncthreads();
#pragma unroll
                for (int w = 0; w < 8; ++w) dc = fmaxf(dc, red[w]);
                __syncthreads();
                const int dci = (int)dc + 1;
                const int lo_key = q0 - dci - 63;
                int ktlo = lo_key <= 0 ? 0 : (lo_key + 63) / 64; int kthi = (q0 + 255 + dci) / 64; if (kthi > SEQ / 64 - 1) kthi = SEQ / 64 - 1;
                if (ktlo > d0) ktlo = d0; if (kthi < d0 + 3) kthi = d0 + 3;
                if (((kthi - ktlo + 1) & 1) != 0) { if (ktlo > 0) --ktlo; else ++kthi; }
                if (kthi - ktlo + 1 == 6) { if (ktlo >= 2) ktlo -= 2; else kthi += 2; }
                const int nR = kthi - (d0 + 3), nL = d0 - ktlo;
                if (nR + nL > 0) flash_pass<32, 1, false>(lds, Qm, NPROJ, Km, NPROJ, Vm, NPROJ, aug + 16 * hD, q0, d0 + 4, nR, ktlo, nR + nL, slope, O0, O1, M, L);
                if (mp == 0) { const float i1 = 1.f / xhalf_sum(L);
#pragma unroll
                    for (int i = 0; i < 16; ++i) { asave[(2 * i) * NTHREADS] = O0[i] * i1; asave[(2 * i + 1) * NTHREADS] = O1[i] * i1; } }
            }
            float lam;
            { const float* lp = p->diff_lambda + l * 128; const float a = (lane < 32) ? lp[lane] * lp[32 + lane] : 0.f, b2 = (lane < 32) ? lp[64 + lane] * lp[96 + lane] : 0.f;
              lam = expf(wave_sum(a)) - expf(wave_sum(b2)) + p->lam_init[l]; }
            const float one_m_li = 1.f - p->lam_init[l];
            const float i2 = lam / xhalf_sum(L);
            float ss = 0.f;
            f32x16 A0, A1;
#pragma unroll
            for (int i = 0; i < 16; ++i) { A0[i] = asave[(2 * i) * NTHREADS] - O0[i] * i2; A1[i] = asave[(2 * i + 1) * NTHREADS] - O1[i] * i2; ss += A0[i] * A0[i] + A1[i] * A1[i]; }
            ss = xhalf_sum(ss);
            const float rs = one_m_li / sqrtf(ss * (1.f / 64.f) + NORM_EPS);
            const float* sg = p->diff_subln + l * 64;
#pragma unroll
            for (int i = 0; i < 16; ++i) { const int dv = (i & 3) + 8 * (i >> 2) + 4 * hi; A0[i] *= rs * sg[dv]; A1[i] *= rs * sg[32 + dv]; }
            store_o(orowD + 768 + 64 * hD, A0, A1, hi);
        } else if (type == 1) {
            M = sqrtf(row_norm2<96>(qb + (tok0 + qrow) * 384 + 96 * hd) * __builtin_bit_cast(float, ((const unsigned*)(p->ws + WS_KMAX))[l * 32 + 16 + b * 4 + hd])) * 1.01f;
            flash_pass<96, 0>(lds, qb + tok0 * 384 + 96 * hd, 384, kb + tok0 * 384 + 96 * hd, 384, vb + tok0 * 256 + 64 * hd, 256, nullptr, q0, q0 / 64, SEQ / 64 - q0 / 64, 0, SEQ / 64, 0.f, O0, O1, M, L);
            const float il = 1.f / xhalf_sum(L);
#pragma unroll
            for (int i = 0; i < 16; ++i) { O0[i] *= il; O1[i] *= il; }
            store_o(orow + 256 + 64 * hd, O0, O1, hi);
        } else if (type == 2) {
            const bf16_t* base = proj + tok0 * NPROJ + PC; const int hk = hd >> 1;
            M = sqrtf(row_norm2<64>(base + (size_t)qrow * NPROJ + 64 * hd) * __builtin_bit_cast(float, ((const unsigned*)(p->ws + WS_KMAX))[l * 32 + 24 + b * 2 + hk])) * 1.01f;
            flash_pass<64, 0>(lds, base + 64 * hd, NPROJ, base + 256 + 64 * hk, NPROJ, base + 384 + 64 * hk, NPROJ, nullptr, q0, q0 / 64, SEQ / 64 - q0 / 64, 0, SEQ / 64, 0.f, O0, O1, M, L);
            const float il = 1.f / xhalf_sum(L);
#pragma unroll
            for (int i = 0; i < 16; ++i) { O0[i] *= il; O1[i] *= il; }
            store_o(orow + 512 + 64 * hd, O0, O1, hi);
        } else {
            const bf16_t* base = proj + tok0 * NPROJ + PA; const int hk = hd >> 1;
            const float slope = __builtin_amdgcn_exp2f(-(float)(1 + hd));
            const int kt0 = (q0 >= 128) ? (q0 - 128) / 64 : 0; int kt1 = (q0 + 256 + 128) / 64; if (kt1 > SEQ / 64) kt1 = SEQ / 64;
            flash_pass<64, 2>(lds, base + 64 * hd, NPROJ, base + 256 + 64 * hk, NPROJ, base + 384 + 64 * hk, NPROJ, nullptr, q0, kt0, kt1 - kt0, 0, kt1 - kt0, slope, O0, O1, M, L);
            const float sink = p->win_sink[l * 4 + hd];
            const float il = 1.f / (xhalf_sum(L) + __builtin_amdgcn_exp2f((sink - M) * LOG2E));
#pragma unroll
            for (int i = 0; i < 16; ++i) { O0[i] *= il; O1[i] *= il; }
            store_o(orow + 64 * hd, O0, O1, hi);
        }
    }
}
}

#define XB_TMO      128
#define XB_XCNT(j)  (256  + 64 * (j))
#define XB_XSUB(j)  (1280 + 64 * (j))
#define XB_XGEN(j)  (2304 + 64 * (j))
#define XB_TOP      3328
#define XB_TOPGEN   3392
#define XCD_BAR_WORDS 3456
#define XB_SPIN_CAP (1u << 18)

__device__ __forceinline__ unsigned xb_ld(unsigned* p)              { return __hip_atomic_load(p, __ATOMIC_RELAXED, __HIP_MEMORY_SCOPE_AGENT); }
__device__ __forceinline__ unsigned xb_add(unsigned* p, unsigned v) { return __hip_atomic_fetch_add(p, v, __ATOMIC_RELAXED, __HIP_MEMORY_SCOPE_AGENT); }
__device__ __forceinline__ unsigned xb_xcc_id() { return (unsigned)__builtin_amdgcn_s_getreg((3 << 11) | 20) & 0xFu; }
#define XB_SPIN(cond, bar) do { unsigned _sp = 0; while (cond) { __builtin_amdgcn_s_sleep(1); \
    if ((++_sp & 255u) == 0u) { if (xb_ld(&(bar)[XB_TMO])) break; if (_sp > XB_SPIN_CAP) { atomicAdd(&(bar)[XB_TMO], 1u); break; } } } } while (0)

struct XcdBarrier {
    unsigned* bar; unsigned x;
    volatile LAS unsigned* st;
};

__device__ __forceinline__ XcdBarrier xcd_barrier_post(unsigned* bar, volatile LAS unsigned* st) {
    XcdBarrier b; b.bar = bar; b.x = xb_xcc_id(); b.st = st;
    if (threadIdx.x == 0) (void)xb_add(&bar[XB_XCNT(b.x)], 1u);
    return b;
}
__device__ __forceinline__ void xcd_barrier_complete(unsigned* bar, unsigned x, unsigned& nloc, unsigned& nx) {
    const unsigned G = gridDim.x * gridDim.y * gridDim.z;
    unsigned sum, cnt, mine, sp = 0u;
    for (;;) {
        sum = 0u; cnt = 0u; mine = 0u;
#pragma unroll
        for (unsigned j = 0; j < 16; ++j) { const unsigned c = xb_ld(&bar[XB_XCNT(j)]); sum += c; cnt += (c > 0u) ? 1u : 0u; mine = (j == x) ? c : mine; }
        if (sum == G) break;
        __builtin_amdgcn_s_sleep(1);
        if ((++sp & 255u) == 0u) { if (xb_ld(&bar[XB_TMO])) break; if (sp > XB_SPIN_CAP) { atomicAdd(&bar[XB_TMO], 1u); break; } }
    }
    nloc = mine > 0u ? mine : 1u; nx = cnt > 0u ? cnt : 1u;
}

__device__ __forceinline__ void xcd_barrier(const XcdBarrier& b) {
    asm volatile("s_waitcnt vmcnt(0)" ::: "memory");
    __syncthreads();
    if (threadIdx.x == 0) {
        unsigned* bar = b.bar;
        __builtin_amdgcn_s_waitcnt(0);
        unsigned nloc = b.st[0], nx = b.st[1];
        if (nloc == 0u) { xcd_barrier_complete(bar, b.x, nloc, nx); b.st[0] = nloc; b.st[1] = nx; }
        const unsigned old = xb_add(&bar[XB_XSUB(b.x)], 1u);
        const unsigned gen = old / nloc;
        if (old + 1u == (gen + 1u) * nloc) {
            __builtin_amdgcn_fence(__ATOMIC_RELEASE, "agent");
            asm volatile("s_waitcnt vmcnt(0)" ::: "memory");
            const unsigned og = xb_add(&bar[XB_TOP], 1u);
            const unsigned tg = og / nx;
            if (og + 1u == (tg + 1u) * nx) xb_add(&bar[XB_TOPGEN], 1u);
            else XB_SPIN(xb_ld(&bar[XB_TOPGEN]) == tg, bar);
            __builtin_amdgcn_fence(__ATOMIC_ACQUIRE, "agent");
            xb_add(&bar[XB_XGEN(b.x)], 1u);
            asm volatile("s_waitcnt vmcnt(0)" ::: "memory");
        } else {
            XB_SPIN(xb_ld(&bar[XB_XGEN(b.x)]) == gen, bar);
            __builtin_amdgcn_fence(__ATOMIC_ACQUIRE, "agent");
            asm volatile("s_waitcnt vmcnt(0)" ::: "memory");
        }
    }
    __syncthreads();
}

#define GRID_SYNC_CG() do { asm volatile("s_waitcnt vmcnt(0) lgkmcnt(0)" ::: "memory"); grid.sync(); __builtin_amdgcn_fence(__ATOMIC_ACQUIRE, "agent"); } while (0)
#define XB_ST ((volatile LAS unsigned*)(lds + LDS_BYTES - 64))
#define GRID_SYNC() do { GETP(pb_); XcdBarrier xb_; xb_.bar = (unsigned*)(pb_->ws + WS_BAR); xb_.x = xb_xcc_id(); xb_.st = XB_ST; xcd_barrier(xb_); } while (0)
#ifndef PH_MASK
#define PH_MASK 255
#endif
__global__ void __launch_bounds__(NTHREADS, 2) mega_fwd(Params p_by_value) {
    extern __shared__ __attribute__((aligned(16))) unsigned char lds_raw[];
    cg::grid_group grid = cg::this_grid();
    LAS unsigned char* lds = (LAS unsigned char*)lds_raw;
#define VCU(G_, bx_) (((G_) % 8 == 0) ? ((bx_) % 8) * ((G_) / 8) + (bx_) / 8 : (bx_))
    const float alpha = 1.681792830507429f;
#define STATS(s_) ((float*)(p->ws + WS_STATS) + (size_t)(s_) * T * 2)
#define C1(l_, off_) ((const float*)(p->ws + WS_C12) + (l_) * C12_L + (off_))
#define C2(l_, off_) ((const float*)(p->ws + WS_C12) + C2_OFF + (l_) * C12_L + (off_))

    if (threadIdx.x < 16) ((LAS unsigned*)(lds + LDS_BYTES - 64))[threadIdx.x] = 0u;
    __syncthreads();
    { GETP(p); (void)xcd_barrier_post((unsigned*)(p->ws + WS_BAR), XB_ST); }
    if (PH_MASK & 1) { GETP(p); const int G = gridDim.x, bx = blockIdx.x; phase0(p, lds, VCU(G, bx), G); }
    GRID_SYNC_CG();
#pragma unroll 1
    for (int li = 0; li < DEPTH; ++li) {
#pragma unroll 1
        for (int fi = 0; fi < 2; ++fi) {
            if (fi == 1) {
                if (PH_MASK & 2) { GETP(p); int l = li; asm volatile("" : "+s"(l)); const int G = gridDim.x, bx = blockIdx.x;
                  pg8::Gemm g{(const bf16_t*)(p->ws + WS_XB), (const bf16_t*)(p->ws + WS_WIN) + l * WIN_L, T, NPROJ, DM}; pg8::StaticOrder S; S.init(T, NPROJ, G, bx);
                  pg8::EpiStoreBf16LN E{(bf16_t*)(p->ws + WS_PROJ), NPROJ, STATS(3 * l), C1(l, 2 * NGU), C2(l, 2 * NGU)};
                  pg8::gemm_phase<pg8::EpiStoreBf16LN, pg8::StaticOrder, true, true>(lds, g, S, E); }
                GRID_SYNC();
                if (PH_MASK & 4) { GETP(p); int l = li; asm volatile("" : "+s"(l)); const int G = gridDim.x, bx = blockIdx.x; prep_phase(p, l, VCU(G, bx), G); }
                GRID_SYNC();
                if (PH_MASK & 8) { GETP(p); int l = li; asm volatile("" : "+s"(l)); const int G = gridDim.x, bx = blockIdx.x; att::attn_phase(p, l, (LAS char*)lds, VCU(G, bx), G); }
                GRID_SYNC();
                if (PH_MASK & 16) { GETP(p); int l = li; asm volatile("" : "+s"(l)); const int G = gridDim.x, bx = blockIdx.x;
                  pg8::Gemm g{(const bf16_t*)(p->ws + WS_MIX), (const bf16_t*)(p->ws + WS_WOUT) + l * WOUT_L, T, DM, DM}; pg8::StaticOrder S; S.init(T, DM, G, bx);
                  pg8::EpiResidLN<true> E{nullptr, p->out, p->ws, p->ln_g + (3 * l) * DM, p->ln_b + (3 * l) * DM, 3 * l, alpha, 1.0f};
                  pg8::gemm_phase<pg8::EpiResidLN<true>, pg8::StaticOrder, true, true>(lds, g, S, E); }
                GRID_SYNC();
            }
            if (PH_MASK & 64) { GETP(p); int l = li, f = fi; asm volatile("" : "+s"(l), "+s"(f)); const int G = gridDim.x, bx = blockIdx.x;
              const int s = 3 * l + 2 * f - 1;
              pg8::Gemm g{(const bf16_t*)(p->ws + WS_XB), (const bf16_t*)(p->ws + WS_WGU) + l * WGU_L + f * WGU_F, T, NGU, DM}; pg8::StaticOrder S; S.init(T, NGU, G, bx);
              if (s >= 0) { pg8::EpiSwiGLULN<true> E{(bf16_t*)(p->ws + WS_H), DFF, STATS(s), C1(l, f * NGU), C2(l, f * NGU)};
                            pg8::gemm_phase<pg8::EpiSwiGLULN<true>, pg8::StaticOrder, true, true>(lds, g, S, E); }
              else { pg8::EpiSwiGLULN<false> E{(bf16_t*)(p->ws + WS_H), DFF, nullptr, C1(l, f * NGU), C2(l, f * NGU)};
                     pg8::gemm_phase<pg8::EpiSwiGLULN<false>, pg8::StaticOrder, true, true>(lds, g, S, E); } }
            GRID_SYNC();
            if (PH_MASK & 128) { GETP(p); int l = li, f = fi; asm volatile("" : "+s"(l), "+s"(f)); const int G = gridDim.x, bx = blockIdx.x;
              const int s = 3 * l + 2 * f - 1;
              pg8::Gemm g{(const bf16_t*)(p->ws + WS_H), (const bf16_t*)(p->ws + WS_WD) + l * WD_L + f * WD_F, T, DM, DFF}; pg8::StaticOrder S; S.init(T, DM, G, bx);
              if (s >= 0) { pg8::EpiResidLN<true> E{nullptr, p->out, p->ws, p->ln_g + s * DM, p->ln_b + s * DM, s, alpha, 0.5f};
                            pg8::gemm_phase<pg8::EpiResidLN<true>, pg8::StaticOrder, true, true>(lds, g, S, E); }
              else { pg8::EpiResidLN<false> E{p->x, p->out, p->ws, nullptr, nullptr, -1, alpha, 0.5f};
                     pg8::gemm_phase<pg8::EpiResidLN<false>, pg8::StaticOrder, true, true>(lds, g, S, E); } }
            GRID_SYNC();
        }
    }
    if (PH_MASK & 32) { GETP(p); const int G = gridDim.x, bx = blockIdx.x;
      ln_phase(p->out, (bf16_t*)(p->ws + WS_XB), p->ln_g + (3 * DEPTH - 1) * DM, p->ln_b + (3 * DEPTH - 1) * DM, VCU(G, bx), G); }
}

extern "C" void kernel_launch(void* const* d_in, const int* in_sizes, int n_in, void* d_out, int out_size, void* d_ws, size_t ws_size, hipStream_t stream) {
    static int grid = 0;
    if (grid == 0) {
        if (n_in != 16 || in_sizes[0] != T * DM || out_size != T * DM || ws_size < WS_END) { fprintf(stderr, "kernel_launch: unexpected shapes (n_in %d, in0 %d, out %d, ws %zu); nothing launched\n", n_in, n_in > 0 ? in_sizes[0] : -1, out_size, ws_size); grid = -1; return; }
        int dev = 0, cus = 0, per_cu = 0;
        hipGetDevice(&dev); hipDeviceGetAttribute(&cus, hipDeviceAttributeMultiprocessorCount, dev);
        if (hipFuncSetAttribute((const void*)mega_fwd, hipFuncAttributeMaxDynamicSharedMemorySize, LDS_BYTES) != hipSuccess) { fprintf(stderr, "kernel_launch: hipFuncSetAttribute failed\n"); grid = -1; return; }
        if (hipOccupancyMaxActiveBlocksPerMultiprocessor(&per_cu, (const void*)mega_fwd, NTHREADS, LDS_BYTES) != hipSuccess || per_cu < 1) { fprintf(stderr, "kernel_launch: occupancy query gave %d\n", per_cu); per_cu = 1; }
        (void)hipGetLastError();
        grid = cus * 1;
    }
    if (grid < 0) return;
    Params p{};
    p.x = (const float*)d_in[0]; p.w_in = (const float*)d_in[1]; p.win_sink = (const float*)d_in[2]; p.mla_q_norm = (const float*)d_in[3]; p.mla_w_uq = (const float*)d_in[4];
    p.mla_kv_norm = (const float*)d_in[5]; p.mla_w_ukv = (const float*)d_in[6]; p.ax_q_norm = (const float*)d_in[7]; p.ax_k_norm = (const float*)d_in[8]; p.diff_lambda = (const float*)d_in[9];
    p.diff_subln = (const float*)d_in[10]; p.w_out = (const float*)d_in[11]; p.ffn_w_gu = (const float*)d_in[12]; p.ffn_w_down = (const float*)d_in[13]; p.ln_g = (const float*)d_in[14]; p.ln_b = (const float*)d_in[15];
    p.out = (float*)d_out; p.ws = (unsigned char*)d_ws;
    for (int l = 0; l < 4; ++l) p.lam_init[l] = (float)(0.8 - 0.6 * exp(-0.3 * (double)l));
    for (int i = 0; i < 16; ++i) p.inv32[i] = (float)pow(10000.0, -(double)i / 16.0);
    if (hipMemsetAsync((char*)d_ws + WS_CTL, 0, CTL_BYTES, stream) != hipSuccess) { fprintf(stderr, "kernel_launch: hipMemsetAsync of the control region failed\n"); return; }
    void* args[] = {&p};
    hipError_t e = hipLaunchCooperativeKernel((const void*)mega_fwd, dim3(grid), dim3(NTHREADS), args, LDS_BYTES, stream);
    if (e != hipSuccess) fprintf(stderr, "kernel_launch: cooperative launch failed: %s (grid %d)\n", hipGetErrorString(e), grid);
}
```

```cpp
#include <hip/hip_runtime.h>
#include <hip/hip_cooperative_groups.h>
#include <cstdio>
#include <cstdint>
#include <cmath>
namespace cg = cooperative_groups;
namespace pg8 {
#define PG8_LAS __attribute__((address_space(3)))
typedef unsigned short bf16_t;
typedef short bf16x8 __attribute__((ext_vector_type(8)));
typedef float f32x4 __attribute__((ext_vector_type(4)));
typedef unsigned u32x4 __attribute__((ext_vector_type(4)));
constexpr int BM = 256, BK = 64, HALF = 128, HTB = HALF * BK * 2  , STAGE_BYTES = 8 * HTB, NXCD = 8, WGM = 8;

__host__ __device__ __forceinline__ int lds_byte(int r, int c) { const int st = (r >> 4) * 2 + (c >> 5), rr = r & 15, cc = c & 31, ob = rr * 64 + cc * 2; return st * 1024 + (ob ^ (((ob >> 9) & 1) << 5)); }
__host__ __device__ __forceinline__ void stage_rc(int b, int& R, int& C) { const int st = b / 1024, sb = b % 1024, swz = sb ^ (((sb >> 9) & 1) << 5); R = (st >> 1) * 16 + swz / 64; C = (st & 1) * 32 + (swz % 64) / 2; }
__host__ __device__ __forceinline__ int perm32(int rho) { const int n = rho >> 4, i = rho & 15; return 8 * (i >> 2) + 4 * n + (i & 3); }

struct Unit { int pm, pn; };
struct Gemm { const bf16_t* A; const bf16_t* Bt; int M, N, K; };

struct StaticOrder {
    int nM, nN, nwg, G, c;
    __host__ __device__ void init(int M, int N, int G_, int c_) { nM = M / BM; nN = N / BM; nwg = nM * nN; G = G_; c = c_; }
    __host__ __device__ bool next(int i, Unit& u) const {
        const long L = (long)i * G + c; if (L >= nwg) return false;
        int wgid = (int)L; { const int q = nwg / NXCD, r = nwg % NXCD, xcd = wgid % NXCD, off = wgid / NXCD; wgid = (xcd < r ? xcd * (q + 1) : r * (q + 1) + (xcd - r) * q) + off; }
        const int nig = WGM * nN, gid = wgid / nig, fm = gid * WGM, gsz = (nM - fm) < WGM ? (nM - fm) : WGM;
        u.pm = fm + ((wgid % nig) % gsz); u.pn = (wgid % nig) / gsz; return true;
    }
    __device__ __forceinline__ void a_ready(const Unit&) const {}
    __device__ __forceinline__ void done(const Unit&) const {}
};

__device__ __forceinline__ unsigned cvt_pk_bf16(float lo, float hi) { unsigned r; asm volatile("v_cvt_pk_bf16_f32 %0, %1, %2" : "=v"(r) : "v"(lo), "v"(hi)); return r; }
typedef float f32x2 __attribute__((ext_vector_type(2)));
typedef float f32x2 __attribute__((ext_vector_type(2)));
typedef unsigned u32x2 __attribute__((ext_vector_type(2)));

struct EpiStoreBf16 {
    static constexpr bool PERM = true, AFTER_DRAIN = false;
    bf16_t* O; int ldc;
    __device__ __forceinline__ void operator()(const f32x4 (&acc)[2][2][4][2], const Unit& u, int wr, int wc, int fr, int fq) const {
        const int row0 = u.pm * BM + wr * 64 + fr; const int col0 = u.pn * BM + wc * 32 + 8 * fq;
#pragma unroll
        for (int ai = 0; ai < 2; ++ai)
#pragma unroll
            for (int m = 0; m < 4; ++m) { bf16_t* rowp = O + (size_t)(row0 + ai * HALF + m * 16) * ldc + col0;
#pragma unroll
                for (int bj = 0; bj < 2; ++bj) { const f32x4 v0 = acc[ai][bj][m][0], v1 = acc[ai][bj][m][1];
                    u32x4 w; w.x = cvt_pk_bf16(v0[0], v0[1]); w.y = cvt_pk_bf16(v0[2], v0[3]); w.z = cvt_pk_bf16(v1[0], v1[1]); w.w = cvt_pk_bf16(v1[2], v1[3]);
                    *(u32x4*)(rowp + bj * HALF) = w; } }
    }
};

__device__ __forceinline__ float silu_mul(float g, float u) {
    const float e = __builtin_amdgcn_exp2f(-1.4426950408889634f * g);
    return g * u * __builtin_amdgcn_rcpf(1.0f + e);
}
struct EpiSwiGLU {
    static constexpr bool PERM = true, AFTER_DRAIN = false;
    bf16_t* H; int ldh;
    __device__ __forceinline__ void operator()(const f32x4 (&acc)[2][2][4][2], const Unit& u, int wr, int wc, int fr, int fq) const {
        const int row0 = u.pm * BM + wr * 64 + fr; const int col0 = u.pn * HALF + wc * 32 + 8 * fq;
#pragma unroll
        for (int ai = 0; ai < 2; ++ai)
#pragma unroll
            for (int m = 0; m < 4; ++m) { bf16_t* rowp = H + (size_t)(row0 + ai * HALF + m * 16) * ldh + col0;
                const f32x4 g0 = acc[ai][0][m][0], g1 = acc[ai][0][m][1], u0 = acc[ai][1][m][0], u1 = acc[ai][1][m][1];
                u32x4 w;
                w.x = cvt_pk_bf16(silu_mul(g0[0], u0[0]), silu_mul(g0[1], u0[1])); w.y = cvt_pk_bf16(silu_mul(g0[2], u0[2]), silu_mul(g0[3], u0[3]));
                w.z = cvt_pk_bf16(silu_mul(g1[0], u1[0]), silu_mul(g1[1], u1[1])); w.w = cvt_pk_bf16(silu_mul(g1[2], u1[2]), silu_mul(g1[3], u1[3]));
                *(u32x4*)rowp = w; }
    }
};

struct EpiResid {
    static constexpr bool PERM = false, AFTER_DRAIN = false;
    const float* src; float* dst; int ld; float alpha, beta;
    __device__ __forceinline__ void operator()(const f32x4 (&acc)[2][2][4][2], const Unit& u, int wr, int wc, int fr, int fq) const {
        const int col0 = u.pn * BM + wc * 32 + 4 * fq;
#pragma unroll
        for (int ai = 0; ai < 2; ++ai)
#pragma unroll
            for (int m = 0; m < 4; ++m) { const size_t off = (size_t)(u.pm * BM + ai * HALF + wr * 64 + m * 16 + fr) * ld + col0;
#pragma unroll
                for (int bj = 0; bj < 2; ++bj)
#pragma unroll
                    for (int n = 0; n < 2; ++n) { const f32x4 s = *(const f32x4*)(src + off + bj * HALF + n * 16);
                        *(f32x4*)(dst + off + bj * HALF + n * 16) = s * alpha + acc[ai][bj][m][n] * beta; } }
    }
};

constexpr float LN_EPS_F = 1e-5f;
template <bool HAS> __device__ __forceinline__ void ln_row_stats(const float* st, int row, float& mu, float& rs) {
    if (!HAS) { mu = 0.f; rs = 1.f; return; }
    const f32x2 s = *(const f32x2*)(st + 2 * (size_t)row);
    mu = s.x * (1.0f / 1024.0f); const float var = fmaxf(s.y * (1.0f / 1024.0f) - mu * mu, 0.f); rs = 1.0f / sqrtf(var + LN_EPS_F);
}
struct EpiStoreBf16LN {
    static constexpr bool PERM = true, AFTER_DRAIN = false;
    bf16_t* O; int ldc; const float* st; const float* c1; const float* c2;
    __device__ __forceinline__ void operator()(const f32x4 (&acc)[2][2][4][2], const Unit& u, int wr, int wc, int fr, int fq) const {
        int row0 = u.pm * BM + wr * 64 + fr; int col0 = u.pn * BM + wc * 32 + 8 * fq;
        asm volatile("" : "+v"(row0), "+v"(col0));
        f32x4 c1v[2][2], c2v[2][2];
#pragma unroll
        for (int bj = 0; bj < 2; ++bj)
#pragma unroll
            for (int n = 0; n < 2; ++n) { c1v[bj][n] = *(const f32x4*)(c1 + col0 + bj * HALF + 4 * n); c2v[bj][n] = *(const f32x4*)(c2 + col0 + bj * HALF + 4 * n); }
#pragma unroll
        for (int ai = 0; ai < 2; ++ai)
#pragma unroll
            for (int m = 0; m < 4; ++m) { const int row = row0 + ai * HALF + m * 16; float mu, rs; ln_row_stats<true>(st, row, mu, rs);
                bf16_t* rowp = O + (size_t)row * ldc + col0;
#pragma unroll
                for (int bj = 0; bj < 2; ++bj) { const f32x4 v0 = (acc[ai][bj][m][0] - c1v[bj][0] * mu) * rs + c2v[bj][0], v1 = (acc[ai][bj][m][1] - c1v[bj][1] * mu) * rs + c2v[bj][1];
                    u32x4 w; w.x = cvt_pk_bf16(v0[0], v0[1]); w.y = cvt_pk_bf16(v0[2], v0[3]); w.z = cvt_pk_bf16(v1[0], v1[1]); w.w = cvt_pk_bf16(v1[2], v1[3]);
                    *(u32x4*)(rowp + bj * HALF) = w; } }
    }
};
template <bool HAS_LN> struct EpiSwiGLULN {
    static constexpr bool PERM = true, AFTER_DRAIN = false;
    bf16_t* H; int ldh; const float* st; const float* c1; const float* c2;
    __device__ __forceinline__ void operator()(const f32x4 (&acc)[2][2][4][2], const Unit& u, int wr, int wc, int fr, int fq) const {
        int row0 = u.pm * BM + wr * 64 + fr; const int col0 = u.pn * HALF + wc * 32 + 8 * fq; int wcol0 = u.pn * BM + wc * 32 + 8 * fq;
        asm volatile("" : "+v"(row0), "+v"(wcol0));
        f32x4 c1v[2][2], c2v[2][2];
#pragma unroll
        for (int bj = 0; bj < 2; ++bj)
#pragma unroll
            for (int n = 0; n < 2; ++n) { c1v[bj][n] = *(const f32x4*)(c1 + wcol0 + bj * HALF + 4 * n); c2v[bj][n] = *(const f32x4*)(c2 + wcol0 + bj * HALF + 4 * n); }
#pragma unroll
        for (int ai = 0; ai < 2; ++ai)
#pragma unroll
            for (int m = 0; m < 4; ++m) { const int row = row0 + ai * HALF + m * 16; float mu, rs; ln_row_stats<HAS_LN>(st, row, mu, rs);
                bf16_t* rowp = H + (size_t)row * ldh + col0;
                const f32x4 g0 = (acc[ai][0][m][0] - c1v[0][0] * mu) * rs + c2v[0][0], g1 = (acc[ai][0][m][1] - c1v[0][1] * mu) * rs + c2v[0][1];
                const f32x4 u0 = (acc[ai][1][m][0] - c1v[1][0] * mu) * rs + c2v[1][0], u1 = (acc[ai][1][m][1] - c1v[1][1] * mu) * rs + c2v[1][1];
                u32x4 w;
                w.x = cvt_pk_bf16(silu_mul(g0[0], u0[0]), silu_mul(g0[1], u0[1])); w.y = cvt_pk_bf16(silu_mul(g0[2], u0[2]), silu_mul(g0[3], u0[3]));
                w.z = cvt_pk_bf16(silu_mul(g1[0], u1[0]), silu_mul(g1[1], u1[1])); w.w = cvt_pk_bf16(silu_mul(g1[2], u1[2]), silu_mul(g1[3], u1[3]));
                *(u32x4*)rowp = w; }
    }
};
constexpr size_t EPI_WS_XB = (size_t)166 << 20, EPI_WS_STATS = ((size_t)568 << 20) + ((size_t)1 << 20); constexpr int EPI_T = 32768;
template <bool HAS_LN> struct EpiResidLN {
    static constexpr bool PERM = false, AFTER_DRAIN = false;
    static constexpr int ld = 1024;
    const float* src; float* dst; unsigned char* ws; const float* g_in; const float* b_in; int s_in; float alpha, beta;
    __device__ __forceinline__ void operator()(const f32x4 (&acc)[2][2][4][2], const Unit& u, int wr, int wc, int fr, int fq) const {
        int col0 = u.pn * BM + wc * 32 + 4 * fq; int rowb = u.pm * BM + wr * 64 + fr;
        asm volatile("" : "+v"(col0), "+v"(rowb));
        const float* rd = HAS_LN ? (const float*)dst : src;
        bf16_t* yb = (bf16_t*)(ws + EPI_WS_XB);
        const float* st_in = (const float*)(ws + EPI_WS_STATS) + (size_t)s_in * EPI_T * 2; float* st_out = (float*)(ws + EPI_WS_STATS) + (size_t)(s_in + 1) * EPI_T * 2;
        f32x4 gv[2][2], bv[2][2];
#pragma unroll
        for (int bj = 0; bj < 2; ++bj)
#pragma unroll
            for (int n = 0; n < 2; ++n) { if (HAS_LN) { gv[bj][n] = *(const f32x4*)(g_in + col0 + bj * HALF + n * 16); bv[bj][n] = *(const f32x4*)(b_in + col0 + bj * HALF + n * 16); }
                                          else { gv[bj][n] = (f32x4){1.f, 1.f, 1.f, 1.f}; bv[bj][n] = (f32x4){0.f, 0.f, 0.f, 0.f}; } }
#pragma unroll
        for (int ai = 0; ai < 2; ++ai)
#pragma unroll
            for (int m = 0; m < 4; ++m) { const int row = rowb + ai * HALF + m * 16; const size_t off = (size_t)row * ld + col0;
                float mu, rs; ln_row_stats<HAS_LN>(st_in, row, mu, rs);
                float ps = 0.f, pq = 0.f;
#pragma unroll
                for (int bj = 0; bj < 2; ++bj)
#pragma unroll
                    for (int n = 0; n < 2; ++n) { const f32x4 y = *(const f32x4*)(rd + off + bj * HALF + n * 16);
                        const f32x4 x = HAS_LN ? (y - mu) * rs * gv[bj][n] + bv[bj][n] : y;
                        const f32x4 yn = x * alpha + acc[ai][bj][m][n] * beta;
                        *(f32x4*)(dst + off + bj * HALF + n * 16) = yn;
                        u32x2 w; w.x = cvt_pk_bf16(yn[0], yn[1]); w.y = cvt_pk_bf16(yn[2], yn[3]); *(u32x2*)(yb + off + bj * HALF + n * 16) = w;
                        ps += (yn[0] + yn[1]) + (yn[2] + yn[3]); pq += (yn[0] * yn[0] + yn[1] * yn[1]) + (yn[2] * yn[2] + yn[3] * yn[3]); }
                ps += __shfl_xor(ps, 16); ps += __shfl_xor(ps, 32); pq += __shfl_xor(pq, 16); pq += __shfl_xor(pq, 32);
                if (fq == 0) { atomicAdd(st_out + 2 * (size_t)row, ps); atomicAdd(st_out + 2 * (size_t)row + 1, pq); } }
    }
};
template <class Epi, class Sched, bool ALIGN_EPI = false, bool SP2 = false>
__device__ __forceinline__ void gemm_phase(PG8_LAS unsigned char* lds, const Gemm g, const Sched S, const Epi E) {
    int tid_ = threadIdx.x; asm volatile("" : "+v"(tid_));
    const int tid = tid_, wid = __builtin_amdgcn_readfirstlane(tid >> 6), lane = tid & 63, wr = wid >> 2, wc = wid & 3, fr = lane & 15, fq = lane >> 4;
    const int K = g.K, nt = K / BK;
    unsigned voffA[2], voffB[2];
#pragma unroll
    for (int i = 0; i < 2; ++i) { int R, C; stage_rc(tid * 16 + i * 8192, R, C); const int Rb = Epi::PERM ? ((R & ~31) + perm32(R & 31)) : R;
        voffA[i] = (unsigned)(R * K + C) * 2u; voffB[i] = (unsigned)(Rb * K + C) * 2u; }
    const size_t kstep = (size_t)(BK * 2);
    const size_t hstep = (size_t)HALF * K * 2;
    const size_t tstep = 2 * hstep;
    const unsigned ldsw = (unsigned)wid * 1024u;
    const int aoff = lds_byte(wr * 64 + fr, fq * 8), boff = lds_byte(wc * 32 + fr, fq * 8);
#define PG8_SA(b, h) (((b) * 2 + (h)) * HTB)
#define PG8_SB(b, h) ((4 + (b) * 2 + (h)) * HTB)
#define PG8_STAGE(bufoff, gbase, voff) do { _Pragma("unroll") for (int _i = 0; _i < 2; ++_i) \
        __builtin_amdgcn_global_load_lds((const unsigned*)((const char*)(gbase) + (voff)[_i]), (PG8_LAS unsigned*)(lds + (bufoff) + ldsw + _i * 8192), 16, 0, 0); } while (0)
#define PG8_LDA(dst, b, h) do { _Pragma("unroll") for (int m = 0; m < 4; ++m) _Pragma("unroll") for (int k = 0; k < 2; ++k) dst[m][k] = *(const PG8_LAS bf16x8*)(lds + PG8_SA(b, h) + aoff + m * 2048 + k * 1024); } while (0)
#define PG8_LDB(dst, b, h) do { _Pragma("unroll") for (int n = 0; n < 2; ++n) _Pragma("unroll") for (int k = 0; k < 2; ++k) dst[n][k] = *(const PG8_LAS bf16x8*)(lds + PG8_SB(b, h) + boff + n * 2048 + k * 1024); } while (0)
#define PG8_MMA(ai, bj, At, Bt) do { __builtin_amdgcn_s_setprio(1); _Pragma("unroll") for (int m = 0; m < 4; ++m) _Pragma("unroll") for (int n = 0; n < 2; ++n) _Pragma("unroll") for (int k = 0; k < 2; ++k) \
        acc[ai][bj][m][n] = __builtin_amdgcn_mfma_f32_16x16x32_bf16(Bt[n][k], At[m][k], acc[ai][bj][m][n], 0, 0, 0); __builtin_amdgcn_s_setprio(0); } while (0)
#define PG8_WAIT_V(n) asm volatile("s_waitcnt vmcnt(" #n ")" ::: "memory")
#define PG8_WAIT_L(n) asm volatile("s_waitcnt lgkmcnt(" #n ")" ::: "memory")
#define PG8_BAR __builtin_amdgcn_s_barrier()
#define PG8_SCHED __builtin_amdgcn_sched_barrier(0)
    Unit cur, nxt; int ui = 0;
    if (!S.next(0, cur)) return;
    f32x4 acc[2][2][4][2];
#pragma unroll
    for (int a = 0; a < 2; ++a)
#pragma unroll
        for (int b = 0; b < 2; ++b)
#pragma unroll
            for (int m = 0; m < 4; ++m)
#pragma unroll
                for (int n = 0; n < 2; ++n) acc[a][b][m][n] = (f32x4){0.f, 0.f, 0.f, 0.f};
    bf16x8 At[4][2], B0[2][2], B1[2][2];
    const char* cA = (const char*)g.A + (size_t)cur.pm * tstep; const char* cB = (const char*)g.Bt + (size_t)cur.pn * tstep;
    S.a_ready(cur);
    if constexpr (SP2) {
        PG8_STAGE(PG8_SB(0, 0), cB, voffB); PG8_STAGE(PG8_SB(0, 1), cB + hstep, voffB); PG8_STAGE(PG8_SA(0, 0), cA, voffA); PG8_STAGE(PG8_SA(0, 1), cA + hstep, voffA);
        if (wr == 1) PG8_BAR;
        PG8_WAIT_V(2); PG8_BAR;
        PG8_STAGE(PG8_SB(1, 0), cB + kstep, voffB); PG8_STAGE(PG8_SA(1, 0), cA + kstep, voffA); PG8_STAGE(PG8_SB(1, 1), cB + hstep + kstep, voffB);
        PG8_WAIT_V(6); PG8_BAR;
    } else {
        PG8_STAGE(PG8_SB(0, 0), cB, voffB); PG8_STAGE(PG8_SA(0, 0), cA, voffA); PG8_STAGE(PG8_SB(0, 1), cB + hstep, voffB); PG8_STAGE(PG8_SA(0, 1), cA + hstep, voffA);
        if (wr == 1) PG8_BAR;
        PG8_WAIT_V(4); PG8_BAR;
        PG8_STAGE(PG8_SB(1, 0), cB + kstep, voffB); PG8_STAGE(PG8_SA(1, 0), cA + kstep, voffA); PG8_STAGE(PG8_SB(1, 1), cB + hstep + kstep, voffB);
        PG8_WAIT_V(6); PG8_BAR;
    }
    for (;;) {
        const bool has_next = S.next(ui + 1, nxt);
        const char* nA = has_next ? (const char*)g.A + (size_t)nxt.pm * tstep : cA; const char* nB = has_next ? (const char*)g.Bt + (size_t)nxt.pn * tstep : cB;
        for (int t = 0; t < nt; t += 2) {
            const bool last = (t == nt - 2);
            const char* a1 = cA + (size_t)(t + 1) * kstep;
            const char* a2 = last ? nA : cA + (size_t)(t + 2) * kstep; const char* b2 = last ? nB : cB + (size_t)(t + 2) * kstep;
            const char* a3 = a2 + kstep; const char* b3 = b2 + kstep;
            if (last && has_next) S.a_ready(nxt);
            if constexpr (SP2) {
            PG8_LDB(B0, 0, 0); PG8_LDB(B1, 0, 1); PG8_SCHED; PG8_LDA(At, 0, 0); PG8_STAGE(PG8_SA(1, 1), a1 + hstep, voffA);
            PG8_WAIT_V(8); PG8_WAIT_L(0); PG8_BAR; PG8_MMA(0, 0, At, B0); PG8_MMA(0, 1, At, B1); PG8_BAR; PG8_SCHED;
            PG8_LDA(At, 0, 1); PG8_STAGE(PG8_SB(0, 0), b2, voffB); PG8_STAGE(PG8_SB(0, 1), b2 + hstep, voffB); PG8_STAGE(PG8_SA(0, 0), a2, voffA);
            PG8_WAIT_V(8); PG8_WAIT_L(0); PG8_BAR; PG8_MMA(1, 0, At, B0); PG8_MMA(1, 1, At, B1); PG8_BAR; PG8_SCHED;
            PG8_LDB(B0, 1, 0); PG8_LDB(B1, 1, 1); PG8_SCHED; PG8_LDA(At, 1, 0); PG8_STAGE(PG8_SA(0, 1), a2 + hstep, voffA);
            PG8_WAIT_V(8); PG8_WAIT_L(0); PG8_BAR; PG8_MMA(0, 0, At, B0); PG8_MMA(0, 1, At, B1); PG8_BAR; PG8_SCHED;
            PG8_LDA(At, 1, 1); PG8_STAGE(PG8_SB(1, 0), b3, voffB); PG8_STAGE(PG8_SB(1, 1), b3 + hstep, voffB); PG8_STAGE(PG8_SA(1, 0), a3, voffA);
            PG8_WAIT_V(8); PG8_WAIT_L(0); PG8_BAR; PG8_MMA(1, 0, At, B0); PG8_MMA(1, 1, At, B1); PG8_BAR; PG8_SCHED;
            } else {
            PG8_LDB(B0, 0, 0); PG8_SCHED; PG8_LDA(At, 0, 0); PG8_STAGE(PG8_SA(1, 1), a1 + hstep, voffA);
            PG8_WAIT_L(8); PG8_BAR; PG8_WAIT_L(0); PG8_MMA(0, 0, At, B0); PG8_BAR; PG8_SCHED;
            PG8_LDB(B1, 0, 1); PG8_STAGE(PG8_SB(0, 0), b2, voffB);
            PG8_BAR; PG8_WAIT_L(0); PG8_MMA(0, 1, At, B1); PG8_BAR;
            PG8_LDA(At, 0, 1); PG8_STAGE(PG8_SA(0, 0), a2, voffA);
            PG8_BAR; PG8_WAIT_L(0); PG8_MMA(1, 0, At, B0); PG8_BAR; PG8_SCHED;
            PG8_STAGE(PG8_SB(0, 1), b2 + hstep, voffB);
            PG8_WAIT_V(6); PG8_BAR; PG8_MMA(1, 1, At, B1); PG8_BAR;
            PG8_LDB(B0, 1, 0); PG8_SCHED; PG8_LDA(At, 1, 0); PG8_STAGE(PG8_SA(0, 1), a2 + hstep, voffA);
            PG8_WAIT_L(8); PG8_BAR; PG8_WAIT_L(0); PG8_MMA(0, 0, At, B0); PG8_BAR; PG8_SCHED;
            PG8_LDB(B1, 1, 1); PG8_STAGE(PG8_SB(1, 0), b3, voffB);
            PG8_BAR; PG8_WAIT_L(0); PG8_MMA(0, 1, At, B1); PG8_BAR;
            PG8_LDA(At, 1, 1); PG8_STAGE(PG8_SA(1, 0), a3, voffA);
            PG8_BAR; PG8_WAIT_L(0); PG8_MMA(1, 0, At, B0); PG8_BAR; PG8_SCHED;
            PG8_STAGE(PG8_SB(1, 1), b3 + hstep, voffB);
            PG8_WAIT_V(6); PG8_BAR; PG8_MMA(1, 1, At, B1); PG8_BAR;
            }
        }
        if constexpr (ALIGN_EPI) { if (wr == 0) PG8_BAR; }
        if constexpr (!Epi::AFTER_DRAIN) { E(acc, cur, wr, wc, fr, fq); S.done(cur); }
        if (!has_next) break;
#pragma unroll
        for (int a = 0; a < 2; ++a)
#pragma unroll
            for (int b = 0; b < 2; ++b)
#pragma unroll
                for (int m = 0; m < 4; ++m)
#pragma unroll
                    for (int n = 0; n < 2; ++n) acc[a][b][m][n] = (f32x4){0.f, 0.f, 0.f, 0.f};
        cur = nxt; cA = nA; cB = nB; ++ui;
        if constexpr (ALIGN_EPI) { if (wr == 1) PG8_BAR; }
    }
    PG8_WAIT_V(0);
    if constexpr (!ALIGN_EPI) { if (wr == 0) PG8_BAR; }
    PG8_BAR;
    if constexpr (Epi::AFTER_DRAIN) { E.fused(acc, cur, wr, wc, fr, fq, lds, wid, lane); S.done(cur); }
#undef PG8_SA
#undef PG8_SB
#undef PG8_STAGE
#undef PG8_LDA
#undef PG8_LDB
#undef PG8_MMA
#undef PG8_WAIT_V
#undef PG8_WAIT_L
#undef PG8_BAR
#undef PG8_SCHED
}
}
#define LAS __attribute__((address_space(3)))
typedef unsigned short bf16_t;
typedef short bf16x8 __attribute__((ext_vector_type(8)));
typedef short s16x4 __attribute__((ext_vector_type(4)));
typedef float f32x4 __attribute__((ext_vector_type(4)));
typedef float f32x16 __attribute__((ext_vector_type(16)));
typedef unsigned u32x4 __attribute__((ext_vector_type(4)));
typedef unsigned u32x2 __attribute__((ext_vector_type(2)));
typedef float f32x2_t __attribute__((ext_vector_type(2)));
typedef __bf16 bf16x2_t __attribute__((ext_vector_type(2)));

constexpr int NB = 2, SEQ = 16384, T = NB * SEQ, DM = 1024, DEPTH = 4, DFF = 2816, NGU = 2 * DFF;
constexpr int NIN_SRC = 2208, NPROJ = 3328;
constexpr int PA = 0, PC = 512, PD = 1024, PCQ = 1792, PCKV = 2048, PKR = 2176, PQUP = 2208, PKVUP = 2592, PEND = 3104;
constexpr float LOG2E = 1.4426950408889634f;
constexpr float NORM_EPS = 1e-5f;
constexpr int NWAVES = 8, NTHREADS = 512;
constexpr int LDS_BYTES = 147456;

constexpr size_t MiB = 1u << 20;
constexpr size_t WS_WGU = 0, WS_WD = 88 * MiB, WS_WIN = 132 * MiB, WS_WOUT = 158 * MiB, WS_XB = 166 * MiB;
constexpr size_t WS_H = 230 * MiB, WS_PROJ = 230 * MiB, WS_QB = 438 * MiB, WS_KB = 462 * MiB, WS_VB = 486 * MiB, WS_MIX = 502 * MiB, WS_AUG = 566 * MiB, WS_CTL = 568 * MiB, WS_KMAX = WS_CTL, WS_C12 = WS_CTL + 4096, WS_BAR = WS_CTL + 512 * 1024, WS_STATS = WS_CTL + 1 * MiB, CTL_BYTES = 4 * MiB, WS_END = 572 * MiB;
constexpr int C12_L = 2 * NGU + NPROJ;
constexpr size_t C2_OFF = (size_t)DEPTH * C12_L;
static_assert(pg8::EPI_WS_XB == WS_XB && pg8::EPI_WS_STATS == WS_STATS && pg8::EPI_T == T, "part1's copies of the workspace map");
static_assert(WS_C12 + 2 * C2_OFF * 4 <= WS_BAR && WS_BAR + 3456 * 4 <= WS_STATS, "control region");
static_assert(WS_C12 + 2 * C2_OFF * 4 <= WS_STATS && WS_STATS + (size_t)12 * T * 8 <= WS_CTL + CTL_BYTES, "control region");
constexpr size_t WGU_L = (size_t)2 * NGU * DM, WGU_F = (size_t)NGU * DM;
constexpr size_t WD_L = (size_t)2 * DM * DFF, WD_F = (size_t)DM * DFF;
constexpr size_t WIN_L = (size_t)NPROJ * DM, WOUT_L = (size_t)DM * DM;

struct Params {
    const float* x; const float* w_in; const float* win_sink; const float* mla_q_norm; const float* mla_w_uq; const float* mla_kv_norm; const float* mla_w_ukv;
    const float* ax_q_norm; const float* ax_k_norm; const float* diff_lambda; const float* diff_subln; const float* w_out; const float* ffn_w_gu; const float* ffn_w_down;
    const float* ln_g; const float* ln_b;
    float* out; unsigned char* ws;
    float lam_init[4];
    float inv32[16];
};

typedef const __attribute__((address_space(4))) Params* KP;
#define GETP(name) KP name = (KP)__builtin_amdgcn_kernarg_segment_ptr(); asm volatile("" : "+s"(name))

__device__ __forceinline__ int tid_fresh() { int t = threadIdx.x; asm volatile("" : "+v"(t)); return t; }
__device__ __forceinline__ unsigned pkbf(float lo, float hi) { f32x2_t v = {lo, hi}; bf16x2_t b = __builtin_convertvector(v, bf16x2_t); return __builtin_bit_cast(unsigned, b); }
__device__ __forceinline__ float bflo(unsigned w) { return __builtin_bit_cast(float, w << 16); }
__device__ __forceinline__ float bfhi(unsigned w) { return __builtin_bit_cast(float, w & 0xffff0000u); }
__device__ __forceinline__ float wave_sum(float v) {
#pragma unroll
    for (int o = 1; o < 64; o <<= 1) v += __shfl_xor(v, o);
    return v;
}
__device__ __forceinline__ void unpack8(const u32x4 w, float (&v)[8]) {
    v[0] = bflo(w.x); v[1] = bfhi(w.x); v[2] = bflo(w.y); v[3] = bfhi(w.y); v[4] = bflo(w.z); v[5] = bfhi(w.z); v[6] = bflo(w.w); v[7] = bfhi(w.w);
}
__device__ __forceinline__ u32x4 pack8(const float (&v)[8]) { u32x4 w; w.x = pkbf(v[0], v[1]); w.y = pkbf(v[2], v[3]); w.z = pkbf(v[4], v[5]); w.w = pkbf(v[6], v[7]); return w; }

__device__ __forceinline__ void transpose_item(const float* __restrict__ W, int ldw, int src_col0, float scale, bf16_t* __restrict__ WT, int K, int dst_row0, int k0, LAS float* scr, int lane,
                                               const float* __restrict__ lng, const float* __restrict__ lnb, float* c1, float* c2) {
    if (src_col0 < 0) {
        const int c = lane & 7;
#pragma unroll
        for (int j = 0; j < 4; ++j) { const int n = (lane >> 3) + 8 * j; *(u32x4*)(WT + (size_t)(dst_row0 + n) * K + k0 + 8 * c) = (u32x4){0u, 0u, 0u, 0u}; }
        return;
    }
    float a1 = 0.f, a2 = 0.f;
#pragma unroll
    for (int i = 0; i < 32; ++i) { const int kk = 2 * i + (lane >> 5); float w = W[(size_t)(k0 + kk) * ldw + src_col0 + (lane & 31)] * scale;
        if (lng) { a2 = fmaf(lnb[k0 + kk], w, a2); w *= lng[k0 + kk]; a1 += bflo(pkbf(w, 0.f)); }
        scr[kk * 33 + (lane & 31)] = w; }
    asm volatile("s_waitcnt lgkmcnt(0)" ::: "memory");
    const int c = lane & 7;
#pragma unroll
    for (int j = 0; j < 4; ++j) { const int n = (lane >> 3) + 8 * j; const LAS float* s = scr + (8 * c) * 33 + n;
        u32x4 o; o.x = pkbf(s[0 * 33], s[1 * 33]); o.y = pkbf(s[2 * 33], s[3 * 33]); o.z = pkbf(s[4 * 33], s[5 * 33]); o.w = pkbf(s[6 * 33], s[7 * 33]);
        *(u32x4*)(WT + (size_t)(dst_row0 + n) * K + k0 + 8 * c) = o; }
    asm volatile("s_waitcnt lgkmcnt(0)" ::: "memory");
    if (lng) { a1 += __shfl_xor(a1, 32); a2 += __shfl_xor(a2, 32);
        if (lane < 32) { atomicAdd(c1 + dst_row0 + lane, a1); atomicAdd(c2 + dst_row0 + lane, a2); } }
}

__device__ __forceinline__ void phase0(KP p, LAS unsigned char* lds, int vcu, int G) {
    const int tid = tid_fresh(), lane = tid & 63, wave = __builtin_amdgcn_readfirstlane(tid >> 6);
    LAS float* scr = (LAS float*)(lds + wave * 16384);
    const int gw = vcu * NWAVES + wave, NGW = G * NWAVES;
    bf16_t* wgu = (bf16_t*)(p->ws + WS_WGU); bf16_t* wd = (bf16_t*)(p->ws + WS_WD); bf16_t* win = (bf16_t*)(p->ws + WS_WIN); bf16_t* wout = (bf16_t*)(p->ws + WS_WOUT);
    float* c12 = (float*)(p->ws + WS_C12);
    constexpr int I_GU = 176 * 16, I_WD = 32 * 44, I_IN = 104 * 16, I_OUT = 32 * 16, I_CMP = 128 * 14;
    constexpr int I_LAYER = 2 * I_GU + 2 * I_WD + I_IN + I_OUT + I_CMP;
    for (int it = gw; it < DEPTH * I_LAYER; it += NGW) {
        const int l = it / I_LAYER; int r = it % I_LAYER;
        if (r < 2 * I_GU) { const int f = r / I_GU; r %= I_GU; const int nb = r / 16, kb = r % 16; const int n0 = 32 * nb;
            const int pn = n0 >> 8, bj = (n0 >> 7) & 1, i0 = n0 & 127;
            const int s = 3 * l + 2 * f - 1;
            transpose_item(p->ffn_w_gu + ((size_t)l * 2 + f) * DM * NGU, NGU, bj * DFF + 128 * pn + i0, 1.f, wgu + l * WGU_L + f * WGU_F, DM, n0, 64 * kb, scr, lane,
                           s >= 0 ? p->ln_g + s * DM : nullptr, s >= 0 ? p->ln_b + s * DM : nullptr, c12 + l * C12_L + f * NGU, c12 + C2_OFF + l * C12_L + f * NGU); continue; }
        r -= 2 * I_GU;
        if (r < 2 * I_WD) { const int f = r / I_WD; r %= I_WD; const int nb = r / 44, kb = r % 44;
            transpose_item(p->ffn_w_down + ((size_t)l * 2 + f) * DFF * DM, DM, 32 * nb, 1.f, wd + l * WD_L + f * WD_F, DFF, 32 * nb, 64 * kb, scr, lane, nullptr, nullptr, nullptr, nullptr); continue; }
        r -= 2 * I_WD;
        if (r < I_IN) { const int nb = r / 16, kb = r % 16; const int n0 = 32 * nb; int src; float sc = 1.f;
            if (n0 < PC) { src = n0; if (n0 < 256) sc = 0.125f; }
            else if (n0 < PD) src = 928 + (n0 - PC);
            else if (n0 < PCQ) { src = 1440 + (n0 - PD); if (n0 - PD < 256) sc = 0.17677669529663687f; }
            else if (n0 < PCKV) src = 512 + (n0 - PCQ);
            else if (n0 < PKR) src = 768 + (n0 - PCKV);
            else if (n0 < PQUP) src = 896;
            else if (n0 < PEND) continue;
            else src = -1;
            transpose_item(p->w_in + (size_t)l * DM * NIN_SRC, NIN_SRC, src, sc, win + l * WIN_L, DM, n0, 64 * kb, scr, lane,
                           p->ln_g + (3 * l) * DM, p->ln_b + (3 * l) * DM, c12 + l * C12_L + 2 * NGU, c12 + C2_OFF + l * C12_L + 2 * NGU); continue; }
        r -= I_IN;
        if (r < I_OUT) { const int nb = r / 16, kb = r % 16;
            transpose_item(p->w_out + (size_t)l * DM * DM, DM, 32 * nb, 1.f, wout + l * WOUT_L, DM, 32 * nb, 64 * kb, scr, lane, nullptr, nullptr, nullptr, nullptr); continue; }
        r -= I_OUT;
        {
            const int kb8 = r / 14, ng = r % 14; const int k0 = 8 * kb8;
            int J, cA, ldu, nc; const float* g; const float* U;
            if (ng < 6) { J = 256; cA = 512; g = p->mla_q_norm + l * 256; U = p->mla_w_uq + (size_t)l * 256 * 384; ldu = 384; nc = 64 * ng; }
            else { J = 128; cA = 768; g = p->mla_kv_norm + l * 128; U = p->mla_w_ukv + (size_t)l * 128 * 512; ldu = 512; nc = 64 * (ng - 6); }
            const int nglob = (ng < 6 ? 0 : 384) + nc + lane;
            const float* a = p->w_in + (size_t)l * DM * NIN_SRC + (size_t)k0 * NIN_SRC + cA;
            const float* up = U + nc + lane;
            float acc[8];
#pragma unroll
            for (int e = 0; e < 8; ++e) acc[e] = 0.f;
#pragma unroll 4
            for (int j = 0; j < J; ++j) { const float u = up[(size_t)j * ldu] * g[j];
#pragma unroll
                for (int e = 0; e < 8; ++e) acc[e] = fmaf(a[(size_t)e * NIN_SRC + j], u, acc[e]); }
            const float* lg = p->ln_g + (3 * l) * DM + k0; const float* lb = p->ln_b + (3 * l) * DM + k0;
            float s1 = 0.f, s2 = 0.f; unsigned wb[8];
#pragma unroll
            for (int e = 0; e < 8; ++e) { wb[e] = pkbf(acc[e] * lg[e], 0.f) & 0xffffu; s1 += bflo(wb[e]); s2 = fmaf(acc[e], lb[e], s2); }
            u32x4 o; o.x = wb[0] | (wb[1] << 16); o.y = wb[2] | (wb[3] << 16); o.z = wb[4] | (wb[5] << 16); o.w = wb[6] | (wb[7] << 16);
            *(u32x4*)(win + l * WIN_L + (size_t)(PQUP + nglob) * DM + k0) = o;
            atomicAdd(c12 + l * C12_L + 2 * NGU + PQUP + nglob, s1); atomicAdd(c12 + C2_OFF + l * C12_L + 2 * NGU + PQUP + nglob, s2);
        }
    }
    { u32x4* ag = (u32x4*)(p->ws + WS_AUG);
      for (int i = (vcu * NWAVES + wave) * 64 + lane; i < SEQ * 4; i += G * NWAVES * 64) { const int t = i >> 2, h = i & 3;
          const float sl = __builtin_amdgcn_exp2f(-(float)(5 + h));
          u32x4 w = {pkbf(sl * (float)(128 * (t >> 7)), sl * (float)(t & 127)), 0u, 0u, 0u}; ag[2 * i] = w; ag[2 * i + 1] = (u32x4){0u, 0u, 0u, 0u}; } }
    bf16_t* xb = (bf16_t*)(p->ws + WS_XB);
    for (int m = gw; m < T; m += NGW) {
        const f32x4* xr = (const f32x4*)(p->x + (size_t)m * DM) + lane; u32x2* o8 = (u32x2*)(xb + (size_t)m * DM) + lane;
#pragma unroll
        for (int j = 0; j < 4; ++j) { const f32x4 v = xr[64 * j]; u32x2 w; w.x = pkbf(v.x, v.y); w.y = pkbf(v.z, v.w); o8[64 * j] = w; }
    }
}

__device__ __forceinline__ void ln_phase(float* X, bf16_t* xb, const float* __restrict__ g, const float* __restrict__ b, int vcu, int G) {
    const int tid = tid_fresh(), lane = tid & 63, wave = __builtin_amdgcn_readfirstlane(tid >> 6);
    const int gw = vcu * NWAVES + wave, NGW = G * NWAVES;
    f32x4 gv[4], bv[4];
#pragma unroll
    for (int j = 0; j < 4; ++j) { gv[j] = ((const f32x4*)g)[64 * j + lane]; bv[j] = ((const f32x4*)b)[64 * j + lane]; }
    for (int m = gw; m < T; m += NGW) {
        f32x4* xr = (f32x4*)(X + (size_t)m * DM) + lane; u32x2* o8 = (u32x2*)(xb + (size_t)m * DM) + lane;
        f32x4 v[4]; float s = 0.f;
#pragma unroll
        for (int j = 0; j < 4; ++j) { v[j] = xr[64 * j]; s += (v[j].x + v[j].y) + (v[j].z + v[j].w); }
        const float mean = wave_sum(s) * (1.f / DM); float s2 = 0.f;
#pragma unroll
        for (int j = 0; j < 4; ++j) { v[j] = v[j] - mean; s2 += (v[j].x * v[j].x + v[j].y * v[j].y) + (v[j].z * v[j].z + v[j].w * v[j].w); }
        const float rstd = 1.f / sqrtf(wave_sum(s2) * (1.f / DM) + NORM_EPS);
#pragma unroll
        for (int j = 0; j < 4; ++j) { const f32x4 y = v[j] * rstd * gv[j] + bv[j]; xr[64 * j] = y; u32x2 w; w.x = pkbf(y.x, y.y); w.y = pkbf(y.z, y.w); o8[64 * j] = w; }
    }
}

__device__ __forceinline__ void sincos_rev(float ang, float& s, float& c) {
    double d = (double)ang * 0.15915494309189535; d -= __builtin_rint(d); const float f = (float)d;
    s = __builtin_amdgcn_sinf(f); c = __builtin_amdgcn_cosf(f);
}
__device__ __forceinline__ void rope8(float (&v)[8], bool first, float pos, int i0, KP p) {
#pragma unroll
    for (int e = 0; e < 8; ++e) {
        const float other = __shfl_xor(v[e], 2);
        const float inv = i0 ? p->inv32[8 + e] : p->inv32[e];
        float s, c; sincos_rev(pos * inv, s, c);
        v[e] = first ? (v[e] * c - other * s) : (other * s + v[e] * c);
    }
}
__device__ __forceinline__ void prep_phase(KP p, int l, int vcu, int G) {
    const int tid = tid_fresh(), lane = tid & 63, wave = __builtin_amdgcn_readfirstlane(tid >> 6);
    const int gw = vcu * NWAVES + wave, NGW = G * NWAVES;
    bf16_t* proj = (bf16_t*)(p->ws + WS_PROJ); bf16_t* qb = (bf16_t*)(p->ws + WS_QB); bf16_t* kb = (bf16_t*)(p->ws + WS_KB); bf16_t* vb = (bf16_t*)(p->ws + WS_VB);
    float cg[8];
    { const float* gsrc = (lane < 32 ? p->ax_q_norm : p->ax_k_norm) + l * 64 + 8 * (lane & 7);
#pragma unroll
      for (int e = 0; e < 8; ++e) cg[e] = gsrc[e]; }
    float km0 = 0.f, km1 = 0.f;
    float kb0 = 0.f, kb1 = 0.f, kc0 = 0.f, kc1 = 0.f;
    for (int tok = gw; tok < T; tok += NGW) {
        const int t = tok & (SEQ - 1);
        bf16_t* pr = proj + (size_t)tok * NPROJ;
        const int l48 = lane < 48 ? lane : 0, l32 = lane < 32 ? lane : 0, l4 = lane < 4 ? lane : 0;
        const u32x4 in_cq = *(const u32x4*)(pr + PCQ + 8 * l48), in_qup = *(const u32x4*)(pr + PQUP + 8 * l48), in_kv = *(const u32x4*)(pr + PKVUP + 8 * lane);
        const u32x4 in_kr = *(const u32x4*)(pr + PKR + 8 * l4), in_c = *(const u32x4*)(pr + PC + 8 * l48), in_dk = *(const u32x4*)(pr + PD + 256 + 8 * l32);
        { float s = 0.f;
          if (lane < 32) { float v[8]; unpack8(in_dk, v);
#pragma unroll
              for (int e = 0; e < 8; ++e) s += v[e] * v[e]; }
          s += __shfl_xor(s, 1); s += __shfl_xor(s, 2);
          if (tok < SEQ) km0 = fmaxf(km0, s); else km1 = fmaxf(km1, s); }
        float ssq = 0.f;
        if (lane < 48) { float v[8]; unpack8(in_cq, v);
#pragma unroll
            for (int e = 0; e < 8; ++e) ssq += v[e] * v[e]; }
        const float ssq_q = wave_sum(lane < 32 ? ssq : 0.f), ssq_kv = wave_sum(lane >= 32 ? ssq : 0.f);
        const float rstd_q = 1.f / sqrtf(ssq_q * (1.f / 256.f) + NORM_EPS), rstd_kv = 1.f / sqrtf(ssq_kv * (1.f / 128.f) + NORM_EPS);
        {
            const int r = lane % 12; float v[8];
            unpack8(in_qup, v);
#pragma unroll
            for (int e = 0; e < 8; ++e) v[e] = (lane < 48) ? v[e] * rstd_q : 0.f;
            float w[8];
#pragma unroll
            for (int e = 0; e < 8; ++e) w[e] = v[e];
            rope8(w, r < 10, (float)t, 8 * (r & 1), p);
            const bool isr = (r >= 8); const float qs = 0.10206207261596575f;
#pragma unroll
            for (int e = 0; e < 8; ++e) v[e] = (isr ? w[e] : v[e]) * qs;
            if (lane < 48) *(u32x4*)(qb + (size_t)tok * 384 + 8 * lane) = pack8(v);
        }
        float nope2;
        {
            float v[8]; unpack8(in_kv, v);
#pragma unroll
            for (int e = 0; e < 8; ++e) v[e] *= rstd_kv;
            const int hd = lane >> 4, r = lane & 15;
            { float s = 0.f;
#pragma unroll
              for (int e = 0; e < 8; ++e) s += v[e] * v[e];
              s = (r < 8) ? s : 0.f; s += __shfl_xor(s, 1); s += __shfl_xor(s, 2); s += __shfl_xor(s, 4); nope2 = s; }
            if (r < 8) *(u32x4*)(kb + (size_t)tok * 384 + hd * 96 + 8 * r) = pack8(v);
            else *(u32x4*)(vb + (size_t)tok * 256 + hd * 64 + 8 * (r - 8)) = pack8(v);
        }
        {
            float v[8]; unpack8(in_kr, v);
            rope8(v, (lane & 3) < 2, (float)t, 8 * (lane & 1), p);
            { float s = 0.f;
#pragma unroll
              for (int e = 0; e < 8; ++e) s += v[e] * v[e];
              s = (lane < 4) ? s : 0.f; s += __shfl_xor(s, 1); s += __shfl_xor(s, 2);
              const float kk = nope2 + __shfl(s, 0);
              if (tok < SEQ) kb0 = fmaxf(kb0, kk); else kb1 = fmaxf(kb1, kk); }
            if (lane < 4) { const u32x4 w = pack8(v);
#pragma unroll
                for (int hd = 0; hd < 4; ++hd) *(u32x4*)(kb + (size_t)tok * 384 + hd * 96 + 64 + 8 * lane) = w; }
        }
        {
            float v[8]; unpack8(in_c, v);
            float s = 0.f;
#pragma unroll
            for (int e = 0; e < 8; ++e) s += v[e] * v[e];
            s += __shfl_xor(s, 1); s += __shfl_xor(s, 2); s += __shfl_xor(s, 4);
            const float rs = 1.f / sqrtf(s * (1.f / 64.f) + NORM_EPS);
#pragma unroll
            for (int e = 0; e < 8; ++e) v[e] = v[e] * rs * cg[e];
            const int r = lane & 7; const float pos = (r < 4) ? (float)(t >> 6) : (float)(t & 63);
            rope8(v, (r & 3) < 2, pos, 8 * (r & 1), p);
            { float s2 = 0.f;
#pragma unroll
              for (int e = 0; e < 8; ++e) s2 += v[e] * v[e];
              s2 += __shfl_xor(s2, 1); s2 += __shfl_xor(s2, 2); s2 += __shfl_xor(s2, 4);
              if (tok < SEQ) kc0 = fmaxf(kc0, s2); else kc1 = fmaxf(kc1, s2); }
            if (lane < 32) {
#pragma unroll
                for (int e = 0; e < 8; ++e) v[e] *= 0.125f; }
            if (lane < 48) *(u32x4*)(pr + PC + 8 * lane) = pack8(v);
        }
    }
    unsigned* kmw = (unsigned*)(p->ws + WS_KMAX) + l * 32;
    if (lane < 32 && (lane & 3) == 0) { atomicMax(kmw + (lane >> 2), __builtin_bit_cast(unsigned, km0)); atomicMax(kmw + 8 + (lane >> 2), __builtin_bit_cast(unsigned, km1)); }
    if ((lane & 15) == 0) { atomicMax(kmw + 16 + (lane >> 4), __builtin_bit_cast(unsigned, kb0)); atomicMax(kmw + 20 + (lane >> 4), __builtin_bit_cast(unsigned, kb1)); }
    if (lane == 32 || lane == 40) { atomicMax(kmw + 24 + ((lane - 32) >> 3), __builtin_bit_cast(unsigned, kc0)); atomicMax(kmw + 26 + ((lane - 32) >> 3), __builtin_bit_cast(unsigned, kc1)); }
}

#ifndef ATT_TYPES
#define ATT_TYPES 15
#endif
namespace att {
typedef float f32x2 __attribute__((ext_vector_type(2)));
constexpr int VPITCH = 144, KBUF = 64 * 208, VBUF = 64 * VPITCH;
constexpr int ATT_LDS = 2 * KBUF + 2 * VBUF;
constexpr float RESCALE_T = 5.0f;
__device__ __forceinline__ s16x4 vtr(const LAS char* p) { return __builtin_bit_cast(s16x4, __builtin_amdgcn_ds_read_tr16_b64_v4i16((LAS s16x4*)p)); }
__device__ __forceinline__ void xhalf_swap(float m, float& a, float& b) {
    a = m; b = m;
    asm volatile("s_nop 1\n\tv_permlane32_swap_b32 %0, %1\n\ts_nop 1" : "+v"(a), "+v"(b));
}
__device__ __forceinline__ float xhalf_max(float m) { float a, b; xhalf_swap(m, a, b); return fmaxf(a, b); }
__device__ __forceinline__ float xhalf_sum(float m) { float a, b; xhalf_swap(m, a, b); return a + b; }
__device__ __forceinline__ float max3f(float a, float b, float c) { return fmaxf(fmaxf(a, b), c); }
__device__ __forceinline__ float fma_s(float a, float b, float c) { float r; asm("v_fma_f32 %0, %1, %2, %3" : "=v"(r) : "v"(a), "s"(b), "v"(c)); return r; }
__device__ __forceinline__ float add_s(float a, float b) { float r; asm("v_add_f32_e32 %0, %1, %2" : "=v"(r) : "v"(a), "v"(b)); return r; }
__device__ __forceinline__ float mul_s(float a, float b) { float r; asm("v_mul_f32_e32 %0, %1, %2" : "=v"(r) : "v"(a), "v"(b)); return r; }
#define ATT_MFMA(a, b, c) __builtin_amdgcn_mfma_f32_32x32x16_bf16((a), (b), (c), 0, 0, 0)

template <int DK, int MODE, bool INIT = true, bool TRACK = (MODE == 2)>
__device__ __forceinline__ void flash_pass(LAS char* lds, const bf16_t* __restrict__ Qg, int qp, const bf16_t* __restrict__ Kg, int kp, const bf16_t* __restrict__ Vg, int vp,
                                           const bf16_t* __restrict__ AUGg, int q0, int a0, int nA, int b0, int nt, float slope, f32x16& O0, f32x16& O1, float& Mout, float& Lout) {
    constexpr int DKL = DK + (MODE == 1 ? 16 : 0);
    constexpr int KPITCH = DKL * 2 + 16, NKC = 8 * DKL, CPR = DKL / 8, NKS = DK / 16;
    constexpr bool HAS_K1 = NKC > 512;
    constexpr int DUMMY = 2 * KBUF + 2 * VBUF;
    const int tid = tid_fresh(), lane = tid & 63, r32 = lane & 31, hi = lane >> 5; const int wid = __builtin_amdgcn_readfirstlane(tid >> 6);
    const int qrow = q0 + wid * 32 + r32;
    bf16x8 qf[NKS];
#pragma unroll
    for (int ks = 0; ks < NKS; ++ks) qf[ks] = *(const bf16x8*)(Qg + (size_t)qrow * qp + 16 * ks + 8 * hi);
    const int kc1 = tid + 512;
    const bool k0v = tid < NKC, k1v = HAS_K1 && kc1 < NKC;
    const int kr0 = k0v ? tid / CPR : 0, kcc0 = k0v ? tid % CPR : 0, kr1 = k1v ? kc1 / CPR : 0, kcc1 = k1v ? kc1 % CPR : 0, vr = tid >> 3, vcc = tid & 7;
    const bf16_t* kg0; size_t kst0;
    if (MODE == 1 && kcc0 >= DK / 8) { kg0 = AUGg + (size_t)kr0 * 64 + 8 * (kcc0 - DK / 8); kst0 = (size_t)64 * 64; } else { kg0 = Kg + (size_t)kr0 * kp + 8 * kcc0; kst0 = (size_t)64 * kp; }
    const bf16_t* kg1 = Kg + (size_t)kr1 * kp + 8 * kcc1; const size_t kst1 = (size_t)64 * kp;
    const bf16_t* vg = Vg + (size_t)vr * vp + 8 * vcc; const size_t vst = (size_t)64 * vp;
    const int kl0 = k0v ? kr0 * KPITCH + 16 * kcc0 : -1, kl1 = k1v ? kr1 * KPITCH + 16 * kcc1 : -1, vl = 2 * KBUF + vr * VPITCH + 16 * vcc;
    u32x4 rk0A = {0u, 0u, 0u, 0u}, rk1A = {0u, 0u, 0u, 0u}, rvA = {0u, 0u, 0u, 0u}, rk0B = {0u, 0u, 0u, 0u}, rk1B = {0u, 0u, 0u, 0u}, rvB = {0u, 0u, 0u, 0u};
#define ATT_KT(i) ((i) < nA ? a0 + (i) : b0 + ((i) - nA))
#define ATT_LOADK(X, kt) do { const size_t t_ = (size_t)(kt); rk0##X = *(const u32x4*)(kg0 + t_ * kst0); if (HAS_K1) rk1##X = *(const u32x4*)(kg1 + t_ * kst1); } while (0)
#define ATT_LOADV(X, kt) do { rv##X = *(const u32x4*)(vg + (size_t)(kt) * vst); } while (0)
#define ATT_STOREK(X, buf) do { *(LAS u32x4*)(lds + (kl0 >= 0 ? (buf) * KBUF + kl0 : DUMMY + tid * 16)) = rk0##X; if (HAS_K1) *(LAS u32x4*)(lds + (kl1 >= 0 ? (buf) * KBUF + kl1 : DUMMY + tid * 16)) = rk1##X; } while (0)
#define ATT_STOREV(X, buf) do { *(LAS u32x4*)(lds + (buf) * VBUF + vl) = rv##X; } while (0)
    const int q4 = (lane & 15) >> 2, p4 = lane & 3, b16 = (lane >> 4) & 1;
    const int vbase = 2 * KBUF + (4 * hi + q4) * VPITCH + 32 * b16 + 8 * p4;
    const int kbase = r32 * KPITCH + 16 * hi;
    const int qw = q0 + wid * 32;
    const float stq = slope * (float)qrow;
    const bf16x8 qzero = {0, 0, 0, 0, 0, 0, 0, 0};
    bf16x8 qpos = qzero, qneg = qzero;
    if (MODE == 1 && hi == 0) { qpos[0] = (short)0x3F80; qpos[1] = (short)0x3F80; qneg[0] = (short)0xBF80; qneg[1] = (short)0xBF80; }
    constexpr int NKF = NKS + (MODE == 1 ? 1 : 0);
    constexpr int KPRE = NKF > 4 ? 4 : NKF;
    bf16x8 kfa[NKF], kfb[NKF];
#define ATT_KREAD(kbuf, f0, f1) do { const LAS char* Kb_ = lds + (kbuf) * KBUF + kbase; \
        _Pragma("unroll") for (int ks_ = (f0); ks_ < (f1); ++ks_) { kfa[ks_] = *(const LAS bf16x8*)(Kb_ + 32 * ks_); kfb[ks_] = *(const LAS bf16x8*)(Kb_ + 32 * KPITCH + 32 * ks_); } } while (0)
#define ATT_QKM(sa, sb, side) do { \
        _Pragma("unroll") for (int e_ = 0; e_ < 16; ++e_) { sa[e_] = 0.f; sb[e_] = 0.f; } \
        _Pragma("unroll") for (int ks_ = 0; ks_ < NKS; ++ks_) { sa = ATT_MFMA(kfa[ks_], qf[ks_], sa); sb = ATT_MFMA(kfb[ks_], qf[ks_], sb); } \
        if (MODE == 1) { const bf16x8 qa_ = (side) < 0 ? qpos : ((side) > 0 ? qneg : qzero); sa = ATT_MFMA(kfa[NKS], qa_, sa); sb = ATT_MFMA(kfb[NKS], qa_, sb); } } while (0)
#define ATT_QK(sa, sb, kbuf, side) do { ATT_KREAD(kbuf, 0, NKF); ATT_QKM(sa, sb, side); } while (0)
    bf16x8 vfa[4], vfb[4];
#define ATT_VREAD(vbuf) do { const LAS char* Vb_ = lds + (vbuf) * VBUF + vbase; \
        _Pragma("unroll") for (int j_ = 0; j_ < 4; ++j_) { const LAS char* vp0_ = Vb_ + (16 * j_) * VPITCH; \
            { const s16x4 lo_ = vtr(vp0_), hh_ = vtr(vp0_ + 8 * VPITCH); vfa[j_] = __builtin_shufflevector(lo_, hh_, 0, 1, 2, 3, 4, 5, 6, 7); } \
            { const s16x4 lo_ = vtr(vp0_ + 64), hh_ = vtr(vp0_ + 8 * VPITCH + 64); vfb[j_] = __builtin_shufflevector(lo_, hh_, 0, 1, 2, 3, 4, 5, 6, 7); } } } while (0)
#define ATT_PVM() do { _Pragma("unroll") for (int j_ = 0; j_ < 4; ++j_) { O0 = ATT_MFMA(vfa[j_], pf[j_ >> 1][j_ & 1], O0); O1 = ATT_MFMA(vfb[j_], pf[j_ >> 1][j_ & 1], O1); } } while (0)
#define ATT_PV(vbuf) do { ATT_VREAD(vbuf); ATT_PVM(); } while (0)
#define ATT_SIDE(kt) ((MODE != 1) ? 0 : (((kt) * 64 + 63 < qw) ? -1 : (((kt) * 64 > qw + 31) ? 1 : 0)))
    ATT_LOADK(A, ATT_KT(0)); ATT_LOADK(B, ATT_KT(1)); ATT_STOREV(B, 1);
    ATT_STOREK(A, 0); ATT_STOREK(B, 1);
    ATT_LOADK(A, ATT_KT(2)); ATT_LOADV(A, ATT_KT(0));
    __syncthreads();
    float M = (INIT && TRACK) ? -1e20f : Mout, L = INIT ? 0.f : Lout;
    if (INIT) {
#pragma unroll
        for (int i = 0; i < 16; ++i) { O0[i] = 0.f; O1[i] = 0.f; } }
    bf16x8 pf[2][2];
#pragma unroll
    for (int kb = 0; kb < 2; ++kb)
#pragma unroll
        for (int st = 0; st < 2; ++st) pf[kb][st] = qzero;
    f32x16 s0, s1, n0, n1;
    int side_cur = ATT_SIDE(ATT_KT(0));
    ATT_QK(s0, s1, 0, side_cur);
#pragma unroll
    for (int e = 0; e < 16; ++e) { n0[e] = 0.f; n1[e] = 0.f; }
    __syncthreads();
    constexpr int NMF = 2 * NKS + (MODE == 1 ? 2 : 0) + 8;
#define ATT_ITER(i, C0, C1, N0, N1, LS, SS, HASN, HASK2, HASK3) do { \
        const int kt = ATT_KT(i); \
        if (HASK3) ATT_LOADK(LS, ATT_KT((i) + 3)); \
        if (HASN) ATT_LOADV(LS, ATT_KT((i) + 1)); \
        if (HASN) ATT_KREAD(((i) + 1) & 1, 0, KPRE); \
        const int k0 = kt * 64; \
          \
        float rc = 0.f; \
        if (MODE == 1) { \
            if (side_cur != 0) rc = side_cur < 0 ? -stq : stq; \
            else { const float dbase = (float)(k0 + 4 * hi - qrow); \
                _Pragma("unroll") for (int e = 0; e < 16; ++e) { const float c = (float)((e & 3) + 8 * (e >> 2)); \
                    C0[e] = fmaf(-slope, fabsf(dbase + c), C0[e]); C1[e] = fmaf(-slope, fabsf(dbase + (c + 32.f)), C1[e]); } } \
        } \
        if (MODE == 2) { const float dbase = (float)(k0 + 4 * hi - qrow); \
            _Pragma("unroll") for (int e = 0; e < 16; ++e) { const float c = (float)((e & 3) + 8 * (e >> 2)); \
                const float d0 = fabsf(dbase + c), d1 = fabsf(dbase + (c + 32.f)); \
                C0[e] = (d0 <= 128.f) ? fmaf(-slope, d0, C0[e]) : -1e30f; C1[e] = (d1 <= 128.f) ? fmaf(-slope, d1, C1[e]) : -1e30f; } } \
        if (TRACK) { \
        float mx = max3f(C0[0], C1[0], C0[1]); \
        _Pragma("unroll") for (int e = 1; e < 15; e += 2) { mx = max3f(mx, C1[e], C0[e + 1]); mx = max3f(mx, C1[e + 1], C0[e + 2]); } \
        mx = fmaxf(mx, C1[15]); \
        const float mt = xhalf_max(mx) + rc;                     \
        if (__builtin_amdgcn_ballot_w64(mt > M + RESCALE_T) != 0ull) {         \
            ATT_PV(((i) + 1) & 1); \
            _Pragma("unroll") for (int kb = 0; kb < 2; ++kb) _Pragma("unroll") for (int st = 0; st < 2; ++st) pf[kb][st] = qzero; \
            const float Mn = fmaxf(M, mt); const float alpha = __builtin_amdgcn_exp2f((M - Mn) * LOG2E); M = Mn; \
            L *= alpha; \
            _Pragma("unroll") for (int e = 0; e < 16; ++e) { O0[e] *= alpha; O1[e] *= alpha; }        \
        } } \
          \
        const int side_next = HASN ? ATT_SIDE(ATT_KT((i) + 1)) : 0; \
        if (HASN) ATT_KREAD(((i) + 1) & 1, KPRE, NKF); \
        ATT_VREAD(((i) + 1) & 1); \
        if (HASN) ATT_QKM(N0, N1, side_next); \
        ATT_PVM();                                   \
        const float cc = (rc - M) * LOG2E; \
        float ps = 0.f;                                          \
        float ps1 = 0.f; \
        _Pragma("unroll") for (int e = 0; e < 16; ++e) { float t0 = __builtin_fmaf(C0[e], LOG2E, cc), t1 = __builtin_fmaf(C1[e], LOG2E, cc); \
            asm("" : "+v"(t0)); asm("" : "+v"(t1));                 \
            C0[e] = __builtin_amdgcn_exp2f(t0); C1[e] = __builtin_amdgcn_exp2f(t1); \
            float u0 = ps + C0[e], u1 = ps1 + C1[e]; asm("" : "+v"(u0)); asm("" : "+v"(u1)); ps = u0; ps1 = u1; } \
        L += ps + ps1; \
        _Pragma("unroll") for (int st = 0; st < 2; ++st) { u32x4 w0, w1; \
            w0.x = pkbf(C0[8 * st + 0], C0[8 * st + 1]); w0.y = pkbf(C0[8 * st + 2], C0[8 * st + 3]); w0.z = pkbf(C0[8 * st + 4], C0[8 * st + 5]); w0.w = pkbf(C0[8 * st + 6], C0[8 * st + 7]); \
            w1.x = pkbf(C1[8 * st + 0], C1[8 * st + 1]); w1.y = pkbf(C1[8 * st + 2], C1[8 * st + 3]); w1.z = pkbf(C1[8 * st + 4], C1[8 * st + 5]); w1.w = pkbf(C1[8 * st + 6], C1[8 * st + 7]); \
            pf[0][st] = __builtin_bit_cast(bf16x8, w0); pf[1][st] = __builtin_bit_cast(bf16x8, w1); } \
        side_cur = side_next; \
        if (HASN) { __builtin_amdgcn_sched_group_barrier(0x100, 8, 0);        \
            _Pragma("unroll") for (int g_ = 0; g_ < NMF; ++g_) { __builtin_amdgcn_sched_group_barrier(0x008, 1, 0); __builtin_amdgcn_sched_group_barrier(0x100, 2, 0); __builtin_amdgcn_sched_group_barrier(0x002, 6, 0); } } \
        if (HASK2) ATT_STOREK(SS, (i) & 1); \
        ATT_STOREV(SS, (i) & 1); \
        __syncthreads(); } while (0)
    for (int i = 0; i + 4 < nt; i += 2) {
        ATT_ITER(i, s0, s1, n0, n1, B, A, true, true, true);
        ATT_ITER(i + 1, n0, n1, s0, s1, A, B, true, true, true);
    }
    ATT_ITER(nt - 4, s0, s1, n0, n1, B, A, true, true, true);
    ATT_ITER(nt - 3, n0, n1, s0, s1, A, B, true, true, false);
    ATT_ITER(nt - 2, s0, s1, n0, n1, B, A, true, false, false);
    ATT_ITER(nt - 1, n0, n1, s0, s1, A, B, false, false, false);
    ATT_PV((nt - 1) & 1);
    __syncthreads();
#undef ATT_ITER
#undef ATT_LOADK
#undef ATT_LOADV
#undef ATT_STOREK
#undef ATT_STOREV
#undef ATT_KT
#undef ATT_QK
#undef ATT_PV
#undef ATT_KREAD
#undef ATT_QKM
#undef ATT_VREAD
#undef ATT_PVM
#undef ATT_SIDE
    Mout = M; Lout = L;
}

template <int NE> __device__ __forceinline__ float row_norm2(const bf16_t* qrow_ptr) {
    float s = 0.f;
#pragma unroll
    for (int c = 0; c < NE / 8; ++c) { float v[8]; unpack8(((const u32x4*)qrow_ptr)[c], v);
#pragma unroll
        for (int e = 0; e < 8; ++e) s += v[e] * v[e]; }
    return s;
}
__device__ __forceinline__ void store_o(bf16_t* orow, const f32x16& O0, const f32x16& O1, int hi) {
#pragma unroll
    for (int g = 0; g < 4; ++g) {
        u32x2 w0, w1; w0.x = pkbf(O0[4 * g], O0[4 * g + 1]); w0.y = pkbf(O0[4 * g + 2], O0[4 * g + 3]); w1.x = pkbf(O1[4 * g], O1[4 * g + 1]); w1.y = pkbf(O1[4 * g + 2], O1[4 * g + 3]);
        *(u32x2*)(orow + 8 * g + 4 * hi) = w0; *(u32x2*)(orow + 32 + 8 * g + 4 * hi) = w1;
    }
}

__device__ __forceinline__ void attn_phase(KP p, int l, LAS char* lds, int vcu, int G) {
    const bf16_t* proj = (const bf16_t*)(p->ws + WS_PROJ); const bf16_t* qb = (const bf16_t*)(p->ws + WS_QB); const bf16_t* kb = (const bf16_t*)(p->ws + WS_KB); const bf16_t* vb = (const bf16_t*)(p->ws + WS_VB);
    const bf16_t* aug = (const bf16_t*)(p->ws + WS_AUG);
    bf16_t* mix = (bf16_t*)(p->ws + WS_MIX);
    for (int u = vcu; u < 2048; u += G) {
        if (!((ATT_TYPES >> (u >> 9)) & 1)) continue;
        const int tid = tid_fresh(), lane = tid & 63, r32 = lane & 31, hi = lane >> 5; const int wid = __builtin_amdgcn_readfirstlane(tid >> 6);
        const int type = u >> 9, idx = u & 511, bh = idx >> 6, qblk = idx & 63, b = bh >> 2, hd = bh & 3, q0 = qblk * 256;
        const int qrow = q0 + wid * 32 + r32;
        const size_t tok0 = (size_t)b * SEQ;
        bf16_t* orow = mix + (tok0 + qrow) * DM;
        f32x16 O0, O1; float M, L;
        if (type == 0) {
            const int bD = idx >> 8, hD = ((idx >> 6) & 3) ^ (bD ? 3 : 0);
            const size_t tokD = (size_t)bD * SEQ;
            bf16_t* orowD = mix + (tokD + qrow) * DM;
            const float slope = __builtin_amdgcn_exp2f(-(float)(5 + hD));
            const bf16_t* base = proj + tokD * NPROJ + PD;
            const int d0 = q0 / 64;
            LAS float* asave = (LAS float*)(lds + 65536) + tid;
#pragma unroll 1
            for (int mp = 0; mp < 2; ++mp) {
                const bf16_t* Qm = base + 64 * hD + 32 * mp; const bf16_t* Km = base + 256 + 64 * hD + 32 * mp; const bf16_t* Vm = base + 512 + 64 * hD;
                const float kmax = sqrtf(__builtin_bit_cast(float, ((const unsigned*)(p->ws + WS_KMAX))[l * 32 + bD * 8 + hD * 2 + mp]));
                const float bound = sqrtf(row_norm2<32>(Qm + (size_t)qrow * NPROJ)) * kmax * 1.01f;
                M = bound;
                flash_pass<32, 1, true>(lds, Qm, NPROJ, Km, NPROJ, Vm, NPROJ, aug + 16 * hD, q0, d0, 4, 0, 4, slope, O0, O1, M, L);
                float dc = (bound + (20.8f + __logf(2.f / slope)) - (M + __logf(fmaxf(xhalf_sum(L), 1e-37f)))) / slope;
                dc = fminf(fmaxf(dc, 0.f), 1.0e8f);
#pragma unroll
                for (int o = 1; o < 64; o <<= 1) dc = fmaxf(dc, __shfl_xor(dc, o));
                LAS float* red = (LAS float*)(lds + ATT_LDS + 16384);
                if (lane == 0) red[wid] = dc;
                __syncthreads();
#pragma unroll
                for (int w = 0; w < 8; ++w) dc = fmaxf(dc, red[w]);
                __syncthreads();
                const int dci = (int)dc + 1;
                const int lo_key = q0 - dci - 63;
                int ktlo = lo_key <= 0 ? 0 : (lo_key + 63) / 64; int kthi = (q0 + 255 + dci) / 64; if (kthi > SEQ / 64 - 1) kthi = SEQ / 64 - 1;
                if (ktlo > d0) ktlo = d0; if (kthi < d0 + 3) kthi = d0 + 3;
                if (((kthi - ktlo + 1) & 1) != 0) { if (ktlo > 0) --ktlo; else ++kthi; }
                if (kthi - ktlo + 1 == 6) { if (ktlo >= 2) ktlo -= 2; else kthi += 2; }
                const int nR = kthi - (d0 + 3), nL = d0 - ktlo;
                if (nR + nL > 0) flash_pass<32, 1, false>(lds, Qm, NPROJ, Km, NPROJ, Vm, NPROJ, aug + 16 * hD, q0, d0 + 4, nR, ktlo, nR + nL, slope, O0, O1, M, L);
                if (mp == 0) { const float i1 = 1.f / xhalf_sum(L);
#pragma unroll
                    for (int i = 0; i < 16; ++i) { asave[(2 * i) * NTHREADS] = O0[i] * i1; asave[(2 * i + 1) * NTHREADS] = O1[i] * i1; } }
            }
            float lam;
            { const float* lp = p->diff_lambda + l * 128; const float a = (lane < 32) ? lp[lane] * lp[32 + lane] : 0.f, b2 = (lane < 32) ? lp[64 + lane] * lp[96 + lane] : 0.f;
              lam = expf(wave_sum(a)) - expf(wave_sum(b2)) + p->lam_init[l]; }
            const float one_m_li = 1.f - p->lam_init[l];
            const float i2 = lam / xhalf_sum(L);
            float ss = 0.f;
            f32x16 A0, A1;
#pragma unroll
            for (int i = 0; i < 16; ++i) { A0[i] = asave[(2 * i) * NTHREADS] - O0[i] * i2; A1[i] = asave[(2 * i + 1) * NTHREADS] - O1[i] * i2; ss += A0[i] * A0[i] + A1[i] * A1[i]; }
            ss = xhalf_sum(ss);
            const float rs = one_m_li / sqrtf(ss * (1.f / 64.f) + NORM_EPS);
            const float* sg = p->diff_subln + l * 64;
#pragma unroll
            for (int i = 0; i < 16; ++i) { const int dv = (i & 3) + 8 * (i >> 2) + 4 * hi; A0[i] *= rs * sg[dv]; A1[i] *= rs * sg[32 + dv]; }
            store_o(orowD + 768 + 64 * hD, A0, A1, hi);
        } else if (type == 1) {
            M = sqrtf(row_norm2<96>(qb + (tok0 + qrow) * 384 + 96 * hd) * __builtin_bit_cast(float, ((const unsigned*)(p->ws + WS_KMAX))[l * 32 + 16 + b * 4 + hd])) * 1.01f;
            flash_pass<96, 0>(lds, qb + tok0 * 384 + 96 * hd, 384, kb + tok0 * 384 + 96 * hd, 384, vb + tok0 * 256 + 64 * hd, 256, nullptr, q0, q0 / 64, SEQ / 64 - q0 / 64, 0, SEQ / 64, 0.f, O0, O1, M, L);
            const float il = 1.f / xhalf_sum(L);
#pragma unroll
            for (int i = 0; i < 16; ++i) { O0[i] *= il; O1[i] *= il; }
            store_o(orow + 256 + 64 * hd, O0, O1, hi);
        } else if (type == 2) {
            const bf16_t* base = proj + tok0 * NPROJ + PC; const int hk = hd >> 1;
            M = sqrtf(row_norm2<64>(base + (size_t)qrow * NPROJ + 64 * hd) * __builtin_bit_cast(float, ((const unsigned*)(p->ws + WS_KMAX))[l * 32 + 24 + b * 2 + hk])) * 1.01f;
            flash_pass<64, 0>(lds, base + 64 * hd, NPROJ, base + 256 + 64 * hk, NPROJ, base + 384 + 64 * hk, NPROJ, nullptr, q0, q0 / 64, SEQ / 64 - q0 / 64, 0, SEQ / 64, 0.f, O0, O1, M, L);
            const float il = 1.f / xhalf_sum(L);
#pragma unroll
            for (int i = 0; i < 16; ++i) { O0[i] *= il; O1[i] *= il; }
            store_o(orow + 512 + 64 * hd, O0, O1, hi);
        } else {
            const bf16_t* base = proj + tok0 * NPROJ + PA; const int hk = hd >> 1;
            const float slope = __builtin_amdgcn_exp2f(-(float)(1 + hd));
            const int kt0 = (q0 >= 128) ? (q0 - 128) / 64 : 0; int kt1 = (q0 + 256 + 128) / 64; if (kt1 > SEQ / 64) kt1 = SEQ / 64;
            flash_pass<64, 2>(lds, base + 64 * hd, NPROJ, base + 256 + 64 * hk, NPROJ, base + 384 + 64 * hk, NPROJ, nullptr, q0, kt0, kt1 - kt0, 0, kt1 - kt0, slope, O0, O1, M, L);
            const float sink = p->win_sink[l * 4 + hd];
            const float il = 1.f / (xhalf_sum(L) + __builtin_amdgcn_exp2f((sink - M) * LOG2E));
#pragma unroll
            for (int i = 0; i < 16; ++i) { O0[i] *= il; O1[i] *= il; }
            store_o(orow + 64 * hd, O0, O1, hi);
        }
    }
}
}

#define XB_TMO      128
#define XB_XCNT(j)  (256  + 64 * (j))
#define XB_XSUB(j)  (1280 + 64 * (j))
#define XB_XGEN(j)  (2304 + 64 * (j))
#define XB_TOP      3328
#define XB_TOPGEN   3392
#define XCD_BAR_WORDS 3456
#define XB_SPIN_CAP (1u << 18)

__device__ __forceinline__ unsigned xb_ld(unsigned* p)              { return __hip_atomic_load(p, __ATOMIC_RELAXED, __HIP_MEMORY_SCOPE_AGENT); }
__device__ __forceinline__ unsigned xb_add(unsigned* p, unsigned v) { return __hip_atomic_fetch_add(p, v, __ATOMIC_RELAXED, __HIP_MEMORY_SCOPE_AGENT); }
__device__ __forceinline__ unsigned xb_xcc_id() { return (unsigned)__builtin_amdgcn_s_getreg((3 << 11) | 20) & 0xFu; }
#define XB_SPIN(cond, bar) do { unsigned _sp = 0; while (cond) { __builtin_amdgcn_s_sleep(1); \
    if ((++_sp & 255u) == 0u) { if (xb_ld(&(bar)[XB_TMO])) break; if (_sp > XB_SPIN_CAP) { atomicAdd(&(bar)[XB_TMO], 1u); break; } } } } while (0)

struct XcdBarrier {
    unsigned* bar; unsigned x;
    volatile LAS unsigned* st;
};

__device__ __forceinline__ XcdBarrier xcd_barrier_post(unsigned* bar, volatile LAS unsigned* st) {
    XcdBarrier b; b.bar = bar; b.x = xb_xcc_id(); b.st = st;
    if (threadIdx.x == 0) (void)xb_add(&bar[XB_XCNT(b.x)], 1u);
    return b;
}
__device__ __forceinline__ void xcd_barrier_complete(unsigned* bar, unsigned x, unsigned& nloc, unsigned& nx) {
    const unsigned G = gridDim.x * gridDim.y * gridDim.z;
    unsigned sum, cnt, mine, sp = 0u;
    for (;;) {
        sum = 0u; cnt = 0u; mine = 0u;
#pragma unroll
        for (unsigned j = 0; j < 16; ++j) { const unsigned c = xb_ld(&bar[XB_XCNT(j)]); sum += c; cnt += (c > 0u) ? 1u : 0u; mine = (j == x) ? c : mine; }
        if (sum == G) break;
        __builtin_amdgcn_s_sleep(1);
        if ((++sp & 255u) == 0u) { if (xb_ld(&bar[XB_TMO])) break; if (sp > XB_SPIN_CAP) { atomicAdd(&bar[XB_TMO], 1u); break; } }
    }
    nloc = mine > 0u ? mine : 1u; nx = cnt > 0u ? cnt : 1u;
}

__device__ __forceinline__ void xcd_barrier(const XcdBarrier& b) {
    asm volatile("s_waitcnt vmcnt(0)" ::: "memory");
    __syncthreads();
    if (threadIdx.x == 0) {
        unsigned* bar = b.bar;
        __builtin_amdgcn_s_waitcnt(0);
        unsigned nloc = b.st[0], nx = b.st[1];
        if (nloc == 0u) { xcd_barrier_complete(bar, b.x, nloc, nx); b.st[0] = nloc; b.st[1] = nx; }
        const unsigned old = xb_add(&bar[XB_XSUB(b.x)], 1u);
        const unsigned gen = old / nloc;
        if (old + 1u == (gen + 1u) * nloc) {
            __builtin_amdgcn_fence(__ATOMIC_RELEASE, "agent");
            asm volatile("s_waitcnt vmcnt(0)" ::: "memory");
            const unsigned og = xb_add(&bar[XB_TOP], 1u);
            const unsigned tg = og / nx;
            if (og + 1u == (tg + 1u) * nx) xb_add(&bar[XB_TOPGEN], 1u);
            else XB_SPIN(xb_ld(&bar[XB_TOPGEN]) == tg, bar);
            __builtin_amdgcn_fence(__ATOMIC_ACQUIRE, "agent");
            xb_add(&bar[XB_XGEN(b.x)], 1u);
            asm volatile("s_waitcnt vmcnt(0)" ::: "memory");
        } else {
            XB_SPIN(xb_ld(&bar[XB_XGEN(b.x)]) == gen, bar);
            __builtin_amdgcn_fence(__ATOMIC_ACQUIRE, "agent");
            asm volatile("s_waitcnt vmcnt(0)" ::: "memory");
        }
    }
    __syncthreads();
}

#define GRID_SYNC_CG() do { asm volatile("s_waitcnt vmcnt(0) lgkmcnt(0)" ::: "memory"); grid.sync(); __builtin_amdgcn_fence(__ATOMIC_ACQUIRE, "agent"); } while (0)
#define XB_ST ((volatile LAS unsigned*)(lds + LDS_BYTES - 64))
#define GRID_SYNC() do { GETP(pb_); XcdBarrier xb_; xb_.bar = (unsigned*)(pb_->ws + WS_BAR); xb_.x = xb_xcc_id(); xb_.st = XB_ST; xcd_barrier(xb_); } while (0)
#ifndef PH_MASK
#define PH_MASK 255
#endif
__global__ void __launch_bounds__(NTHREADS, 2) mega_fwd(Params p_by_value) {
    extern __shared__ __attribute__((aligned(16))) unsigned char lds_raw[];
    cg::grid_group grid = cg::this_grid();
    LAS unsigned char* lds = (LAS unsigned char*)lds_raw;
#define VCU(G_, bx_) (((G_) % 8 == 0) ? ((bx_) % 8) * ((G_) / 8) + (bx_) / 8 : (bx_))
    const float alpha = 1.681792830507429f;
#define STATS(s_) ((float*)(p->ws + WS_STATS) + (size_t)(s_) * T * 2)
#define C1(l_, off_) ((const float*)(p->ws + WS_C12) + (l_) * C12_L + (off_))
#define C2(l_, off_) ((const float*)(p->ws + WS_C12) + C2_OFF + (l_) * C12_L + (off_))

    if (threadIdx.x < 16) ((LAS unsigned*)(lds + LDS_BYTES - 64))[threadIdx.x] = 0u;
    __syncthreads();
    { GETP(p); (void)xcd_barrier_post((unsigned*)(p->ws + WS_BAR), XB_ST); }
    if (PH_MASK & 1) { GETP(p); const int G = gridDim.x, bx = blockIdx.x; phase0(p, lds, VCU(G, bx), G); }
    GRID_SYNC_CG();
#pragma unroll 1
    for (int li = 0; li < DEPTH; ++li) {
#pragma unroll 1
        for (int fi = 0; fi < 2; ++fi) {
            if (fi == 1) {
                if (PH_MASK & 2) { GETP(p); int l = li; asm volatile("" : "+s"(l)); const int G = gridDim.x, bx = blockIdx.x;
                  pg8::Gemm g{(const bf16_t*)(p->ws + WS_XB), (const bf16_t*)(p->ws + WS_WIN) + l * WIN_L, T, NPROJ, DM}; pg8::StaticOrder S; S.init(T, NPROJ, G, bx);
                  pg8::EpiStoreBf16LN E{(bf16_t*)(p->ws + WS_PROJ), NPROJ, STATS(3 * l), C1(l, 2 * NGU), C2(l, 2 * NGU)};
                  pg8::gemm_phase<pg8::EpiStoreBf16LN, pg8::StaticOrder, true, true>(lds, g, S, E); }
                GRID_SYNC();
                if (PH_MASK & 4) { GETP(p); int l = li; asm volatile("" : "+s"(l)); const int G = gridDim.x, bx = blockIdx.x; prep_phase(p, l, VCU(G, bx), G); }
                GRID_SYNC();
                if (PH_MASK & 8) { GETP(p); int l = li; asm volatile("" : "+s"(l)); const int G = gridDim.x, bx = blockIdx.x; att::attn_phase(p, l, (LAS char*)lds, VCU(G, bx), G); }
                GRID_SYNC();
                if (PH_MASK & 16) { GETP(p); int l = li; asm volatile("" : "+s"(l)); const int G = gridDim.x, bx = blockIdx.x;
                  pg8::Gemm g{(const bf16_t*)(p->ws + WS_MIX), (const bf16_t*)(p->ws + WS_WOUT) + l * WOUT_L, T, DM, DM}; pg8::StaticOrder S; S.init(T, DM, G, bx);
                  pg8::EpiResidLN<true> E{nullptr, p->out, p->ws, p->ln_g + (3 * l) * DM, p->ln_b + (3 * l) * DM, 3 * l, alpha, 1.0f};
                  pg8::gemm_phase<pg8::EpiResidLN<true>, pg8::StaticOrder, true, true>(lds, g, S, E); }
                GRID_SYNC();
            }
            if (PH_MASK & 64) { GETP(p); int l = li, f = fi; asm volatile("" : "+s"(l), "+s"(f)); const int G = gridDim.x, bx = blockIdx.x;
              const int s = 3 * l + 2 * f - 1;
              pg8::Gemm g{(const bf16_t*)(p->ws + WS_XB), (const bf16_t*)(p->ws + WS_WGU) + l * WGU_L + f * WGU_F, T, NGU, DM}; pg8::StaticOrder S; S.init(T, NGU, G, bx);
              if (s >= 0) { pg8::EpiSwiGLULN<true> E{(bf16_t*)(p->ws + WS_H), DFF, STATS(s), C1(l, f * NGU), C2(l, f * NGU)};
                            pg8::gemm_phase<pg8::EpiSwiGLULN<true>, pg8::StaticOrder, true, true>(lds, g, S, E); }
              else { pg8::EpiSwiGLULN<false> E{(bf16_t*)(p->ws + WS_H), DFF, nullptr, C1(l, f * NGU), C2(l, f * NGU)};
                     pg8::gemm_phase<pg8::EpiSwiGLULN<false>, pg8::StaticOrder, true, true>(lds, g, S, E); } }
            GRID_SYNC();
            if (PH_MASK & 128) { GETP(p); int l = li, f = fi; asm volatile("" : "+s"(l), "+s"(f)); const int G = gridDim.x, bx = blockIdx.x;
              const int s = 3 * l + 2 * f - 1;
              pg8::Gemm g{(const bf16_t*)(p->ws + WS_H), (const bf16_t*)(p->ws + WS_WD) + l * WD_L + f * WD_F, T, DM, DFF}; pg8::StaticOrder S; S.init(T, DM, G, bx);
              if (s >= 0) { pg8::EpiResidLN<true> E{nullptr, p->out, p->ws, p->ln_g + s * DM, p->ln_b + s * DM, s, alpha, 0.5f};
                            pg8::gemm_phase<pg8::EpiResidLN<true>, pg8::StaticOrder, true, true>(lds, g, S, E); }
              else { pg8::EpiResidLN<false> E{p->x, p->out, p->ws, nullptr, nullptr, -1, alpha, 0.5f};
                     pg8::gemm_phase<pg8::EpiResidLN<false>, pg8::StaticOrder, true, true>(lds, g, S, E); } }
            GRID_SYNC();
        }
    }
    if (PH_MASK & 32) { GETP(p); const int G = gridDim.x, bx = blockIdx.x;
      ln_phase(p->out, (bf16_t*)(p->ws + WS_XB), p->ln_g + (3 * DEPTH - 1) * DM, p->ln_b + (3 * DEPTH - 1) * DM, VCU(G, bx), G); }
}

extern "C" void kernel_launch(void* const* d_in, const int* in_sizes, int n_in, void* d_out, int out_size, void* d_ws, size_t ws_size, hipStream_t stream) {
    static int grid = 0;
    if (grid == 0) {
        if (n_in != 16 || in_sizes[0] != T * DM || out_size != T * DM || ws_size < WS_END) { fprintf(stderr, "kernel_launch: unexpected shapes (n_in %d, in0 %d, out %d, ws %zu); nothing launched\n", n_in, n_in > 0 ? in_sizes[0] : -1, out_size, ws_size); grid = -1; return; }
        int dev = 0, cus = 0, per_cu = 0;
        hipGetDevice(&dev); hipDeviceGetAttribute(&cus, hipDeviceAttributeMultiprocessorCount, dev);
        if (hipFuncSetAttribute((const void*)mega_fwd, hipFuncAttributeMaxDynamicSharedMemorySize, LDS_BYTES) != hipSuccess) { fprintf(stderr, "kernel_launch: hipFuncSetAttribute failed\n"); grid = -1; return; }
        if (hipOccupancyMaxActiveBlocksPerMultiprocessor(&per_cu, (const void*)mega_fwd, NTHREADS, LDS_BYTES) != hipSuccess || per_cu < 1) { fprintf(stderr, "kernel_launch: occupancy query gave %d\n", per_cu); per_cu = 1; }
        (void)hipGetLastError();
        grid = cus * 1;
    }
    if (grid < 0) return;
    Params p{};
    p.x = (const float*)d_in[0]; p.w_in = (const float*)d_in[1]; p.win_sink = (const float*)d_in[2]; p.mla_q_norm = (const float*)d_in[3]; p.mla_w_uq = (const float*)d_in[4];
    p.mla_kv_norm = (const float*)d_in[5]; p.mla_w_ukv = (const float*)d_in[6]; p.ax_q_norm = (const float*)d_in[7]; p.ax_k_norm = (const float*)d_in[8]; p.diff_lambda = (const float*)d_in[9];
    p.diff_subln = (const float*)d_in[10]; p.w_out = (const float*)d_in[11]; p.ffn_w_gu = (const float*)d_in[12]; p.ffn_w_down = (const float*)d_in[13]; p.ln_g = (const float*)d_in[14]; p.ln_b = (const float*)d_in[15];
    p.out = (float*)d_out; p.ws = (unsigned char*)d_ws;
    for (int l = 0; l < 4; ++l) p.lam_init[l] = (float)(0.8 - 0.6 * exp(-0.3 * (double)l));
    for (int i = 0; i < 16; ++i) p.inv32[i] = (float)pow(10000.0, -(double)i / 16.0);
    if (hipMemsetAsync((char*)d_ws + WS_CTL, 0, CTL_BYTES, stream) != hipSuccess) { fprintf(stderr, "kernel_launch: hipMemsetAsync of the control region failed\n"); return; }
    void* args[] = {&p};
    hipError_t e = hipLaunchCooperativeKernel((const void*)mega_fwd, dim3(grid), dim3(NTHREADS), args, LDS_BYTES, stream);
    if (e != hipSuccess) fprintf(stderr, "kernel_launch: cooperative launch failed: %s (grid %d)\n", hipGetErrorString(e), grid);
}
```

```cpp
#include <hip/hip_runtime.h>
#include <hip/hip_cooperative_groups.h>
#include <cstdio>
#include <cstdint>
#include <cmath>
namespace cg = cooperative_groups;
namespace pg8 {
#define PG8_LAS __attribute__((address_space(3)))
typedef unsigned short bf16_t;
typedef short bf16x8 __attribute__((ext_vector_type(8)));
typedef float f32x4 __attribute__((ext_vector_type(4)));
typedef unsigned u32x4 __attribute__((ext_vector_type(4)));
constexpr int BM = 256, BK = 64, HALF = 128, HTB = HALF * BK * 2  , STAGE_BYTES = 8 * HTB, NXCD = 8, WGM = 8;

__host__ __device__ __forceinline__ int lds_byte(int r, int c) { const int st = (r >> 4) * 2 + (c >> 5), rr = r & 15, cc = c & 31, ob = rr * 64 + cc * 2; return st * 1024 + (ob ^ (((ob >> 9) & 1) << 5)); }
__host__ __device__ __forceinline__ void stage_rc(int b, int& R, int& C) { const int st = b / 1024, sb = b % 1024, swz = sb ^ (((sb >> 9) & 1) << 5); R = (st >> 1) * 16 + swz / 64; C = (st & 1) * 32 + (swz % 64) / 2; }
__host__ __device__ __forceinline__ int perm32(int rho) { const int n = rho >> 4, i = rho & 15; return 8 * (i >> 2) + 4 * n + (i & 3); }

struct Unit { int pm, pn; };
struct Gemm { const bf16_t* A; const bf16_t* Bt; int M, N, K; };

struct StaticOrder {
    int nM, nN, nwg, G, c;
    __host__ __device__ void init(int M, int N, int G_, int c_) { nM = M / BM; nN = N / BM; nwg = nM * nN; G = G_; c = c_; }
    __host__ __device__ bool next(int i, Unit& u) const {
        const long L = (long)i * G + c; if (L >= nwg) return false;
        int wgid = (int)L; { const int q = nwg / NXCD, r = nwg % NXCD, xcd = wgid % NXCD, off = wgid / NXCD; wgid = (xcd < r ? xcd * (q + 1) : r * (q + 1) + (xcd - r) * q) + off; }
        const int nig = WGM * nN, gid = wgid / nig, fm = gid * WGM, gsz = (nM - fm) < WGM ? (nM - fm) : WGM;
        u.pm = fm + ((wgid % nig) % gsz); u.pn = (wgid % nig) / gsz; return true;
    }
    __device__ __forceinline__ void a_ready(const Unit&) const {}
    __device__ __forceinline__ void done(const Unit&) const {}
};

__device__ __forceinline__ unsigned cvt_pk_bf16(float lo, float hi) { unsigned r; asm volatile("v_cvt_pk_bf16_f32 %0, %1, %2" : "=v"(r) : "v"(lo), "v"(hi)); return r; }
typedef float f32x2 __attribute__((ext_vector_type(2)));
typedef float f32x2 __attribute__((ext_vector_type(2)));
typedef unsigned u32x2 __attribute__((ext_vector_type(2)));

struct EpiStoreBf16 {
    static constexpr bool PERM = true, AFTER_DRAIN = false;
    bf16_t* O; int ldc;
    __device__ __forceinline__ void operator()(const f32x4 (&acc)[2][2][4][2], const Unit& u, int wr, int wc, int fr, int fq) const {
        const int row0 = u.pm * BM + wr * 64 + fr; const int col0 = u.pn * BM + wc * 32 + 8 * fq;
#pragma unroll
        for (int ai = 0; ai < 2; ++ai)
#pragma unroll
            for (int m = 0; m < 4; ++m) { bf16_t* rowp = O + (size_t)(row0 + ai * HALF + m * 16) * ldc + col0;
#pragma unroll
                for (int bj = 0; bj < 2; ++bj) { const f32x4 v0 = acc[ai][bj][m][0], v1 = acc[ai][bj][m][1];
                    u32x4 w; w.x = cvt_pk_bf16(v0[0], v0[1]); w.y = cvt_pk_bf16(v0[2], v0[3]); w.z = cvt_pk_bf16(v1[0], v1[1]); w.w = cvt_pk_bf16(v1[2], v1[3]);
                    *(u32x4*)(rowp + bj * HALF) = w; } }
    }
};

__device__ __forceinline__ float silu_mul(float g, float u) {
    const float e = __builtin_amdgcn_exp2f(-1.4426950408889634f * g);
    return g * u * __builtin_amdgcn_rcpf(1.0f + e);
}
struct EpiSwiGLU {
    static constexpr bool PERM = true, AFTER_DRAIN = false;
    bf16_t* H; int ldh;
    __device__ __forceinline__ void operator()(const f32x4 (&acc)[2][2][4][2], const Unit& u, int wr, int wc, int fr, int fq) const {
        const int row0 = u.pm * BM + wr * 64 + fr; const int col0 = u.pn * HALF + wc * 32 + 8 * fq;
#pragma unroll
        for (int ai = 0; ai < 2; ++ai)
#pragma unroll
            for (int m = 0; m < 4; ++m) { bf16_t* rowp = H + (size_t)(row0 + ai * HALF + m * 16) * ldh + col0;
                const f32x4 g0 = acc[ai][0][m][0], g1 = acc[ai][0][m][1], u0 = acc[ai][1][m][0], u1 = acc[ai][1][m][1];
                u32x4 w;
                w.x = cvt_pk_bf16(silu_mul(g0[0], u0[0]), silu_mul(g0[1], u0[1])); w.y = cvt_pk_bf16(silu_mul(g0[2], u0[2]), silu_mul(g0[3], u0[3]));
                w.z = cvt_pk_bf16(silu_mul(g1[0], u1[0]), silu_mul(g1[1], u1[1])); w.w = cvt_pk_bf16(silu_mul(g1[2], u1[2]), silu_mul(g1[3], u1[3]));
                *(u32x4*)rowp = w; }
    }
};

struct EpiResid {
    static constexpr bool PERM = false, AFTER_DRAIN = false;
    const float* src; float* dst; int ld; float alpha, beta;
    __device__ __forceinline__ void operator()(const f32x4 (&acc)[2][2][4][2], const Unit& u, int wr, int wc, int fr, int fq) const {
        const int col0 = u.pn * BM + wc * 32 + 4 * fq;
#pragma unroll
        for (int ai = 0; ai < 2; ++ai)
#pragma unroll
            for (int m = 0; m < 4; ++m) { const size_t off = (size_t)(u.pm * BM + ai * HALF + wr * 64 + m * 16 + fr) * ld + col0;
#pragma unroll
                for (int bj = 0; bj < 2; ++bj)
#pragma unroll
                    for (int n = 0; n < 2; ++n) { const f32x4 s = *(const f32x4*)(src + off + bj * HALF + n * 16);
                        *(f32x4*)(dst + off + bj * HALF + n * 16) = s * alpha + acc[ai][bj][m][n] * beta; } }
    }
};

constexpr float LN_EPS_F = 1e-5f;
template <bool HAS> __device__ __forceinline__ void ln_row_stats(const float* st, int row, float& mu, float& rs) {
    if (!HAS) { mu = 0.f; rs = 1.f; return; }
    const f32x2 s = *(const f32x2*)(st + 2 * (size_t)row);
    mu = s.x * (1.0f / 1024.0f); const float var = fmaxf(s.y * (1.0f / 1024.0f) - mu * mu, 0.f); rs = 1.0f / sqrtf(var + LN_EPS_F);
}
struct EpiStoreBf16LN {
    static constexpr bool PERM = true, AFTER_DRAIN = false;
    bf16_t* O; int ldc; const float* st; const float* c1; const float* c2;
    __device__ __forceinline__ void operator()(const f32x4 (&acc)[2][2][4][2], const Unit& u, int wr, int wc, int fr, int fq) const {
        int row0 = u.pm * BM + wr * 64 + fr; int col0 = u.pn * BM + wc * 32 + 8 * fq;
        asm volatile("" : "+v"(row0), "+v"(col0));
        f32x4 c1v[2][2], c2v[2][2];
#pragma unroll
        for (int bj = 0; bj < 2; ++bj)
#pragma unroll
            for (int n = 0; n < 2; ++n) { c1v[bj][n] = *(const f32x4*)(c1 + col0 + bj * HALF + 4 * n); c2v[bj][n] = *(const f32x4*)(c2 + col0 + bj * HALF + 4 * n); }
#pragma unroll
        for (int ai = 0; ai < 2; ++ai)
#pragma unroll
            for (int m = 0; m < 4; ++m) { const int row = row0 + ai * HALF + m * 16; float mu, rs; ln_row_stats<true>(st, row, mu, rs);
                bf16_t* rowp = O + (size_t)row * ldc + col0;
#pragma unroll
                for (int bj = 0; bj < 2; ++bj) { const f32x4 v0 = (acc[ai][bj][m][0] - c1v[bj][0] * mu) * rs + c2v[bj][0], v1 = (acc[ai][bj][m][1] - c1v[bj][1] * mu) * rs + c2v[bj][1];
                    u32x4 w; w.x = cvt_pk_bf16(v0[0], v0[1]); w.y = cvt_pk_bf16(v0[2], v0[3]); w.z = cvt_pk_bf16(v1[0], v1[1]); w.w = cvt_pk_bf16(v1[2], v1[3]);
                    *(u32x4*)(rowp + bj * HALF) = w; } }
    }
};
template <bool HAS_LN> struct EpiSwiGLULN {
    static constexpr bool PERM = true, AFTER_DRAIN = false;
    bf16_t* H; int ldh; const float* st; const float* c1; const float* c2;
    __device__ __forceinline__ void operator()(const f32x4 (&acc)[2][2][4][2], const Unit& u, int wr, int wc, int fr, int fq) const {
        int row0 = u.pm * BM + wr * 64 + fr; const int col0 = u.pn * HALF + wc * 32 + 8 * fq; int wcol0 = u.pn * BM + wc * 32 + 8 * fq;
        asm volatile("" : "+v"(row0), "+v"(wcol0));
        f32x4 c1v[2][2], c2v[2][2];
#pragma unroll
        for (int bj = 0; bj < 2; ++bj)
#pragma unroll
            for (int n = 0; n < 2; ++n) { c1v[bj][n] = *(const f32x4*)(c1 + wcol0 + bj * HALF + 4 * n); c2v[bj][n] = *(const f32x4*)(c2 + wcol0 + bj * HALF + 4 * n); }
#pragma unroll
        for (int ai = 0; ai < 2; ++ai)
#pragma unroll
            for (int m = 0; m < 4; ++m) { const int row = row0 + ai * HALF + m * 16; float mu, rs; ln_row_stats<HAS_LN>(st, row, mu, rs);
                bf16_t* rowp = H + (size_t)row * ldh + col0;
                const f32x4 g0 = (acc[ai][0][m][0] - c1v[0][0] * mu) * rs + c2v[0][0], g1 = (acc[ai][0][m][1] - c1v[0][1] * mu) * rs + c2v[0][1];
                const f32x4 u0 = (acc[ai][1][m][0] - c1v[1][0] * mu) * rs + c2v[1][0], u1 = (acc[ai][1][m][1] - c1v[1][1] * mu) * rs + c2v[1][1];
                u32x4 w;
                w.x = cvt_pk_bf16(silu_mul(g0[0], u0[0]), silu_mul(g0[1], u0[1])); w.y = cvt_pk_bf16(silu_mul(g0[2], u0[2]), silu_mul(g0[3], u0[3]));
                w.z = cvt_pk_bf16(silu_mul(g1[0], u1[0]), silu_mul(g1[1], u1[1])); w.w = cvt_pk_bf16(silu_mul(g1[2], u1[2]), silu_mul(g1[3], u1[3]));
                *(u32x4*)rowp = w; }
    }
};
constexpr size_t EPI_WS_XB = (size_t)166 << 20, EPI_WS_STATS = ((size_t)568 << 20) + ((size_t)1 << 20); constexpr int EPI_T = 32768;
template <bool HAS_LN> struct EpiResidLN {
    static constexpr bool PERM = true, AFTER_DRAIN = false;
    static constexpr int ld = 1024;
    const float* src; float* dst; unsigned char* ws; const float* g_in; const float* b_in; int s_in; float alpha, beta;
    __device__ __forceinline__ void operator()(const f32x4 (&acc)[2][2][4][2], const Unit& u, int wr, int wc, int fr, int fq) const {
        int col0 = u.pn * BM + wc * 32 + 8 * fq; int rowb = u.pm * BM + wr * 64 + fr;
        asm volatile("" : "+v"(col0), "+v"(rowb));
        const float* rd = HAS_LN ? (const float*)dst : src;
        bf16_t* yb = (bf16_t*)(ws + EPI_WS_XB);
        const float* st_in = (const float*)(ws + EPI_WS_STATS) + (size_t)s_in * EPI_T * 2; float* st_out = (float*)(ws + EPI_WS_STATS) + (size_t)(s_in + 1) * EPI_T * 2;
        f32x4 gv[2][2], bv[2][2];
#pragma unroll
        for (int bj = 0; bj < 2; ++bj)
#pragma unroll
            for (int n = 0; n < 2; ++n) { if (HAS_LN) { gv[bj][n] = *(const f32x4*)(g_in + col0 + bj * HALF + 4 * n); bv[bj][n] = *(const f32x4*)(b_in + col0 + bj * HALF + 4 * n); }
                                          else { gv[bj][n] = (f32x4){1.f, 1.f, 1.f, 1.f}; bv[bj][n] = (f32x4){0.f, 0.f, 0.f, 0.f}; } }
#pragma unroll
        for (int ai = 0; ai < 2; ++ai)
#pragma unroll
            for (int m = 0; m < 4; ++m) { const int row = rowb + ai * HALF + m * 16; const size_t off = (size_t)row * ld + col0;
                float mu, rs; ln_row_stats<HAS_LN>(st_in, row, mu, rs);
                float ps = 0.f, pq = 0.f;
#pragma unroll
                for (int bj = 0; bj < 2; ++bj) { f32x4 yn[2];
#pragma unroll
                    for (int n = 0; n < 2; ++n) { const f32x4 y = *(const f32x4*)(rd + off + bj * HALF + 4 * n);
                        const f32x4 x = HAS_LN ? (y - mu) * rs * gv[bj][n] + bv[bj][n] : y;
                        yn[n] = x * alpha + acc[ai][bj][m][n] * beta;
                        *(f32x4*)(dst + off + bj * HALF + 4 * n) = yn[n];
                        ps += (yn[n][0] + yn[n][1]) + (yn[n][2] + yn[n][3]); pq += (yn[n][0] * yn[n][0] + yn[n][1] * yn[n][1]) + (yn[n][2] * yn[n][2] + yn[n][3] * yn[n][3]); }
                    u32x4 w; w.x = cvt_pk_bf16(yn[0][0], yn[0][1]); w.y = cvt_pk_bf16(yn[0][2], yn[0][3]); w.z = cvt_pk_bf16(yn[1][0], yn[1][1]); w.w = cvt_pk_bf16(yn[1][2], yn[1][3]);
                    *(u32x4*)(yb + off + bj * HALF) = w; }
                ps += __shfl_xor(ps, 16); ps += __shfl_xor(ps, 32); pq += __shfl_xor(pq, 16); pq += __shfl_xor(pq, 32);
                if (fq == 0) { atomicAdd(st_out + 2 * (size_t)row, ps); atomicAdd(st_out + 2 * (size_t)row + 1, pq); } }
    }
};
template <class Epi, class Sched, bool ALIGN_EPI = false, bool SP2 = false>
__device__ __forceinline__ void gemm_phase(PG8_LAS unsigned char* lds, const Gemm g, const Sched S, const Epi E) {
    int tid_ = threadIdx.x; asm volatile("" : "+v"(tid_));
    const int tid = tid_, wid = __builtin_amdgcn_readfirstlane(tid >> 6), lane = tid & 63, wr = wid >> 2, wc = wid & 3, fr = lane & 15, fq = lane >> 4;
    const int K = g.K, nt = K / BK;
    unsigned voffA[2], voffB[2];
#pragma unroll
    for (int i = 0; i < 2; ++i) { int R, C; stage_rc(tid * 16 + i * 8192, R, C); const int Rb = Epi::PERM ? ((R & ~31) + perm32(R & 31)) : R;
        voffA[i] = (unsigned)(R * K + C) * 2u; voffB[i] = (unsigned)(Rb * K + C) * 2u; }
    const size_t kstep = (size_t)(BK * 2);
    const size_t hstep = (size_t)HALF * K * 2;
    const size_t tstep = 2 * hstep;
    const unsigned ldsw = (unsigned)wid * 1024u;
    const int aoff = lds_byte(wr * 64 + fr, fq * 8), boff = lds_byte(wc * 32 + fr, fq * 8);
#define PG8_SA(b, h) (((b) * 2 + (h)) * HTB)
#define PG8_SB(b, h) ((4 + (b) * 2 + (h)) * HTB)
#define PG8_STAGE(bufoff, gbase, voff) do { _Pragma("unroll") for (int _i = 0; _i < 2; ++_i) \
        __builtin_amdgcn_global_load_lds((const unsigned*)((const char*)(gbase) + (voff)[_i]), (PG8_LAS unsigned*)(lds + (bufoff) + ldsw + _i * 8192), 16, 0, 0); } while (0)
#define PG8_LDA(dst, b, h) do { _Pragma("unroll") for (int m = 0; m < 4; ++m) _Pragma("unroll") for (int k = 0; k < 2; ++k) dst[m][k] = *(const PG8_LAS bf16x8*)(lds + PG8_SA(b, h) + aoff + m * 2048 + k * 1024); } while (0)
#define PG8_LDB(dst, b, h) do { _Pragma("unroll") for (int n = 0; n < 2; ++n) _Pragma("unroll") for (int k = 0; k < 2; ++k) dst[n][k] = *(const PG8_LAS bf16x8*)(lds + PG8_SB(b, h) + boff + n * 2048 + k * 1024); } while (0)
#define PG8_MMA(ai, bj, At, Bt) do { __builtin_amdgcn_s_setprio(1); _Pragma("unroll") for (int m = 0; m < 4; ++m) _Pragma("unroll") for (int n = 0; n < 2; ++n) _Pragma("unroll") for (int k = 0; k < 2; ++k) \
        acc[ai][bj][m][n] = __builtin_amdgcn_mfma_f32_16x16x32_bf16(Bt[n][k], At[m][k], acc[ai][bj][m][n], 0, 0, 0); __builtin_amdgcn_s_setprio(0); } while (0)
#define PG8_WAIT_V(n) asm volatile("s_waitcnt vmcnt(" #n ")" ::: "memory")
#define PG8_WAIT_L(n) asm volatile("s_waitcnt lgkmcnt(" #n ")" ::: "memory")
#define PG8_BAR __builtin_amdgcn_s_barrier()
#define PG8_SCHED __builtin_amdgcn_sched_barrier(0)
    Unit cur, nxt; int ui = 0;
    if (!S.next(0, cur)) return;
    f32x4 acc[2][2][4][2];
#pragma unroll
    for (int a = 0; a < 2; ++a)
#pragma unroll
        for (int b = 0; b < 2; ++b)
#pragma unroll
            for (int m = 0; m < 4; ++m)
#pragma unroll
                for (int n = 0; n < 2; ++n) acc[a][b][m][n] = (f32x4){0.f, 0.f, 0.f, 0.f};
    bf16x8 At[4][2], B0[2][2], B1[2][2];
    const char* cA = (const char*)g.A + (size_t)cur.pm * tstep; const char* cB = (const char*)g.Bt + (size_t)cur.pn * tstep;
    S.a_ready(cur);
    if constexpr (SP2) {
        PG8_STAGE(PG8_SB(0, 0), cB, voffB); PG8_STAGE(PG8_SB(0, 1), cB + hstep, voffB); PG8_STAGE(PG8_SA(0, 0), cA, voffA); PG8_STAGE(PG8_SA(0, 1), cA + hstep, voffA);
        if (wr == 1) PG8_BAR;
        PG8_WAIT_V(2); PG8_BAR;
        PG8_STAGE(PG8_SB(1, 0), cB + kstep, voffB); PG8_STAGE(PG8_SA(1, 0), cA + kstep, voffA); PG8_STAGE(PG8_SB(1, 1), cB + hstep + kstep, voffB);
        PG8_WAIT_V(6); PG8_BAR;
    } else {
        PG8_STAGE(PG8_SB(0, 0), cB, voffB); PG8_STAGE(PG8_SA(0, 0), cA, voffA); PG8_STAGE(PG8_SB(0, 1), cB + hstep, voffB); PG8_STAGE(PG8_SA(0, 1), cA + hstep, voffA);
        if (wr == 1) PG8_BAR;
        PG8_WAIT_V(4); PG8_BAR;
        PG8_STAGE(PG8_SB(1, 0), cB + kstep, voffB); PG8_STAGE(PG8_SA(1, 0), cA + kstep, voffA); PG8_STAGE(PG8_SB(1, 1), cB + hstep + kstep, voffB);
        PG8_WAIT_V(6); PG8_BAR;
    }
    for (;;) {
        const bool has_next = S.next(ui + 1, nxt);
        const char* nA = has_next ? (const char*)g.A + (size_t)nxt.pm * tstep : cA; const char* nB = has_next ? (const char*)g.Bt + (size_t)nxt.pn * tstep : cB;
        for (int t = 0; t < nt; t += 2) {
            const bool last = (t == nt - 2);
            const char* a1 = cA + (size_t)(t + 1) * kstep;
            const char* a2 = last ? nA : cA + (size_t)(t + 2) * kstep; const char* b2 = last ? nB : cB + (size_t)(t + 2) * kstep;
            const char* a3 = a2 + kstep; const char* b3 = b2 + kstep;
            if (last && has_next) S.a_ready(nxt);
            if constexpr (SP2) {
            PG8_LDB(B0, 0, 0); PG8_LDB(B1, 0, 1); PG8_SCHED; PG8_LDA(At, 0, 0); PG8_STAGE(PG8_SA(1, 1), a1 + hstep, voffA);
            PG8_WAIT_V(8); PG8_WAIT_L(0); PG8_BAR; PG8_MMA(0, 0, At, B0); PG8_MMA(0, 1, At, B1); PG8_BAR; PG8_SCHED;
            PG8_LDA(At, 0, 1); PG8_STAGE(PG8_SB(0, 0), b2, voffB); PG8_STAGE(PG8_SB(0, 1), b2 + hstep, voffB); PG8_STAGE(PG8_SA(0, 0), a2, voffA);
            PG8_WAIT_V(8); PG8_WAIT_L(0); PG8_BAR; PG8_MMA(1, 0, At, B0); PG8_MMA(1, 1, At, B1); PG8_BAR; PG8_SCHED;
            PG8_LDB(B0, 1, 0); PG8_LDB(B1, 1, 1); PG8_SCHED; PG8_LDA(At, 1, 0); PG8_STAGE(PG8_SA(0, 1), a2 + hstep, voffA);
            PG8_WAIT_V(8); PG8_WAIT_L(0); PG8_BAR; PG8_MMA(0, 0, At, B0); PG8_MMA(0, 1, At, B1); PG8_BAR; PG8_SCHED;
            PG8_LDA(At, 1, 1); PG8_STAGE(PG8_SB(1, 0), b3, voffB); PG8_STAGE(PG8_SB(1, 1), b3 + hstep, voffB); PG8_STAGE(PG8_SA(1, 0), a3, voffA);
            PG8_WAIT_V(8); PG8_WAIT_L(0); PG8_BAR; PG8_MMA(1, 0, At, B0); PG8_MMA(1, 1, At, B1); PG8_BAR; PG8_SCHED;
            } else {
            PG8_LDB(B0, 0, 0); PG8_SCHED; PG8_LDA(At, 0, 0); PG8_STAGE(PG8_SA(1, 1), a1 + hstep, voffA);
            PG8_WAIT_L(8); PG8_BAR; PG8_WAIT_L(0); PG8_MMA(0, 0, At, B0); PG8_BAR; PG8_SCHED;
            PG8_LDB(B1, 0, 1); PG8_STAGE(PG8_SB(0, 0), b2, voffB);
            PG8_BAR; PG8_WAIT_L(0); PG8_MMA(0, 1, At, B1); PG8_BAR;
            PG8_LDA(At, 0, 1); PG8_STAGE(PG8_SA(0, 0), a2, voffA);
            PG8_BAR; PG8_WAIT_L(0); PG8_MMA(1, 0, At, B0); PG8_BAR; PG8_SCHED;
            PG8_STAGE(PG8_SB(0, 1), b2 + hstep, voffB);
            PG8_WAIT_V(6); PG8_BAR; PG8_MMA(1, 1, At, B1); PG8_BAR;
            PG8_LDB(B0, 1, 0); PG8_SCHED; PG8_LDA(At, 1, 0); PG8_STAGE(PG8_SA(0, 1), a2 + hstep, voffA);
            PG8_WAIT_L(8); PG8_BAR; PG8_WAIT_L(0); PG8_MMA(0, 0, At, B0); PG8_BAR; PG8_SCHED;
            PG8_LDB(B1, 1, 1); PG8_STAGE(PG8_SB(1, 0), b3, voffB);
            PG8_BAR; PG8_WAIT_L(0); PG8_MMA(0, 1, At, B1); PG8_BAR;
            PG8_LDA(At, 1, 1); PG8_STAGE(PG8_SA(1, 0), a3, voffA);
            PG8_BAR; PG8_WAIT_L(0); PG8_MMA(1, 0, At, B0); PG8_BAR; PG8_SCHED;
            PG8_STAGE(PG8_SB(1, 1), b3 + hstep, voffB);
            PG8_WAIT_V(6); PG8_BAR; PG8_MMA(1, 1, At, B1); PG8_BAR;
            }
        }
        if constexpr (ALIGN_EPI) { if (wr == 0) PG8_BAR; }
        if constexpr (!Epi::AFTER_DRAIN) { E(acc, cur, wr, wc, fr, fq); S.done(cur); }
        if (!has_next) break;
#pragma unroll
        for (int a = 0; a < 2; ++a)
#pragma unroll
            for (int b = 0; b < 2; ++b)
#pragma unroll
                for (int m = 0; m < 4; ++m)
#pragma unroll
                    for (int n = 0; n < 2; ++n) acc[a][b][m][n] = (f32x4){0.f, 0.f, 0.f, 0.f};
        cur = nxt; cA = nA; cB = nB; ++ui;
        if constexpr (ALIGN_EPI) { if (wr == 1) PG8_BAR; }
    }
    PG8_WAIT_V(0);
    if constexpr (!ALIGN_EPI) { if (wr == 0) PG8_BAR; }
    PG8_BAR;
    if constexpr (Epi::AFTER_DRAIN) { E.fused(acc, cur, wr, wc, fr, fq, lds, wid, lane); S.done(cur); }
#undef PG8_SA
#undef PG8_SB
#undef PG8_STAGE
#undef PG8_LDA
#undef PG8_LDB
#undef PG8_MMA
#undef PG8_WAIT_V
#undef PG8_WAIT_L
#undef PG8_BAR
#undef PG8_SCHED
}
}
#define LAS __attribute__((address_space(3)))
typedef unsigned short bf16_t;
typedef short bf16x8 __attribute__((ext_vector_type(8)));
typedef short s16x4 __attribute__((ext_vector_type(4)));
typedef float f32x4 __attribute__((ext_vector_type(4)));
typedef float f32x16 __attribute__((ext_vector_type(16)));
typedef unsigned u32x4 __attribute__((ext_vector_type(4)));
typedef unsigned u32x2 __attribute__((ext_vector_type(2)));
typedef float f32x2_t __attribute__((ext_vector_type(2)));
typedef __bf16 bf16x2_t __attribute__((ext_vector_type(2)));

constexpr int NB = 2, SEQ = 16384, T = NB * SEQ, DM = 1024, DEPTH = 4, DFF = 2816, NGU = 2 * DFF;
constexpr int NIN_SRC = 2208, NPROJ = 3328;
constexpr int PA = 0, PC = 512, PD = 1024, PCQ = 1792, PCKV = 2048, PKR = 2176, PQUP = 2208, PKVUP = 2592, PEND = 3104;
constexpr float LOG2E = 1.4426950408889634f;
constexpr float NORM_EPS = 1e-5f;
constexpr int NWAVES = 8, NTHREADS = 512;
constexpr int LDS_BYTES = 147456;

constexpr size_t MiB = 1u << 20;
constexpr size_t WS_WGU = 0, WS_WD = 88 * MiB, WS_WIN = 132 * MiB, WS_WOUT = 158 * MiB, WS_XB = 166 * MiB;
constexpr size_t WS_H = 230 * MiB, WS_PROJ = 230 * MiB, WS_QB = 438 * MiB, WS_KB = 462 * MiB, WS_VB = 486 * MiB, WS_MIX = 502 * MiB, WS_AUG = 566 * MiB, WS_CTL = 568 * MiB, WS_KMAX = WS_CTL, WS_C12 = WS_CTL + 4096, WS_BAR = WS_CTL + 512 * 1024, WS_STATS = WS_CTL + 1 * MiB, CTL_BYTES = 4 * MiB, WS_END = 572 * MiB;
constexpr int C12_L = 2 * NGU + NPROJ;
constexpr size_t C2_OFF = (size_t)DEPTH * C12_L;
static_assert(pg8::EPI_WS_XB == WS_XB && pg8::EPI_WS_STATS == WS_STATS && pg8::EPI_T == T, "part1's copies of the workspace map");
static_assert(WS_C12 + 2 * C2_OFF * 4 <= WS_BAR && WS_BAR + 3456 * 4 <= WS_STATS, "control region");
static_assert(WS_C12 + 2 * C2_OFF * 4 <= WS_STATS && WS_STATS + (size_t)12 * T * 8 <= WS_CTL + CTL_BYTES, "control region");
constexpr size_t WGU_L = (size_t)2 * NGU * DM, WGU_F = (size_t)NGU * DM;
constexpr size_t WD_L = (size_t)2 * DM * DFF, WD_F = (size_t)DM * DFF;
constexpr size_t WIN_L = (size_t)NPROJ * DM, WOUT_L = (size_t)DM * DM;

struct Params {
    const float* x; const float* w_in; const float* win_sink; const float* mla_q_norm; const float* mla_w_uq; const float* mla_kv_norm; const float* mla_w_ukv;
    const float* ax_q_norm; const float* ax_k_norm; const float* diff_lambda; const float* diff_subln; const float* w_out; const float* ffn_w_gu; const float* ffn_w_down;
    const float* ln_g; const float* ln_b;
    float* out; unsigned char* ws;
    float lam_init[4];
    float inv32[16];
};

typedef const __attribute__((address_space(4))) Params* KP;
#define GETP(name) KP name = (KP)__builtin_amdgcn_kernarg_segment_ptr(); asm volatile("" : "+s"(name))

__device__ __forceinline__ int tid_fresh() { int t = threadIdx.x; asm volatile("" : "+v"(t)); return t; }
__device__ __forceinline__ unsigned pkbf(float lo, float hi) { f32x2_t v = {lo, hi}; bf16x2_t b = __builtin_convertvector(v, bf16x2_t); return __builtin_bit_cast(unsigned, b); }
__device__ __forceinline__ float bflo(unsigned w) { return __builtin_bit_cast(float, w << 16); }
__device__ __forceinline__ float bfhi(unsigned w) { return __builtin_bit_cast(float, w & 0xffff0000u); }
__device__ __forceinline__ float wave_sum(float v) {
#pragma unroll
    for (int o = 1; o < 64; o <<= 1) v += __shfl_xor(v, o);
    return v;
}
__device__ __forceinline__ void unpack8(const u32x4 w, float (&v)[8]) {
    v[0] = bflo(w.x); v[1] = bfhi(w.x); v[2] = bflo(w.y); v[3] = bfhi(w.y); v[4] = bflo(w.z); v[5] = bfhi(w.z); v[6] = bflo(w.w); v[7] = bfhi(w.w);
}
__device__ __forceinline__ u32x4 pack8(const float (&v)[8]) { u32x4 w; w.x = pkbf(v[0], v[1]); w.y = pkbf(v[2], v[3]); w.z = pkbf(v[4], v[5]); w.w = pkbf(v[6], v[7]); return w; }

__device__ __forceinline__ void transpose_item(const float* __restrict__ W, int ldw, int src_col0, float scale, bf16_t* __restrict__ WT, int K, int dst_row0, int k0, LAS float* scr, int lane,
                                               const float* __restrict__ lng, const float* __restrict__ lnb, float* c1, float* c2) {
    if (src_col0 < 0) {
        const int c = lane & 7;
#pragma unroll
        for (int j = 0; j < 4; ++j) { const int n = (lane >> 3) + 8 * j; *(u32x4*)(WT + (size_t)(dst_row0 + n) * K + k0 + 8 * c) = (u32x4){0u, 0u, 0u, 0u}; }
        return;
    }
    float a1 = 0.f, a2 = 0.f;
#pragma unroll
    for (int i = 0; i < 32; ++i) { const int kk = 2 * i + (lane >> 5); float w = W[(size_t)(k0 + kk) * ldw + src_col0 + (lane & 31)] * scale;
        if (lng) { a2 = fmaf(lnb[k0 + kk], w, a2); w *= lng[k0 + kk]; a1 += bflo(pkbf(w, 0.f)); }
        scr[kk * 33 + (lane & 31)] = w; }
    asm volatile("s_waitcnt lgkmcnt(0)" ::: "memory");
    const int c = lane & 7;
#pragma unroll
    for (int j = 0; j < 4; ++j) { const int n = (lane >> 3) + 8 * j; const LAS float* s = scr + (8 * c) * 33 + n;
        u32x4 o; o.x = pkbf(s[0 * 33], s[1 * 33]); o.y = pkbf(s[2 * 33], s[3 * 33]); o.z = pkbf(s[4 * 33], s[5 * 33]); o.w = pkbf(s[6 * 33], s[7 * 33]);
        *(u32x4*)(WT + (size_t)(dst_row0 + n) * K + k0 + 8 * c) = o; }
    asm volatile("s_waitcnt lgkmcnt(0)" ::: "memory");
    if (lng) { a1 += __shfl_xor(a1, 32); a2 += __shfl_xor(a2, 32);
        if (lane < 32) { atomicAdd(c1 + dst_row0 + lane, a1); atomicAdd(c2 + dst_row0 + lane, a2); } }
}

__device__ __forceinline__ void phase0(KP p, LAS unsigned char* lds, int vcu, int G) {
    const int tid = tid_fresh(), lane = tid & 63, wave = __builtin_amdgcn_readfirstlane(tid >> 6);
    LAS float* scr = (LAS float*)(lds + wave * 16384);
    const int gw = vcu * NWAVES + wave, NGW = G * NWAVES;
    bf16_t* wgu = (bf16_t*)(p->ws + WS_WGU); bf16_t* wd = (bf16_t*)(p->ws + WS_WD); bf16_t* win = (bf16_t*)(p->ws + WS_WIN); bf16_t* wout = (bf16_t*)(p->ws + WS_WOUT);
    float* c12 = (float*)(p->ws + WS_C12);
    constexpr int I_GU = 176 * 16, I_WD = 32 * 44, I_IN = 104 * 16, I_OUT = 32 * 16, I_CMP = 128 * 14;
    constexpr int I_LAYER = 2 * I_GU + 2 * I_WD + I_IN + I_OUT + I_CMP;
    for (int it = gw; it < DEPTH * I_LAYER; it += NGW) {
        const int l = it / I_LAYER; int r = it % I_LAYER;
        if (r < 2 * I_GU) { const int f = r / I_GU; r %= I_GU; const int nb = r / 16, kb = r % 16; const int n0 = 32 * nb;
            const int pn = n0 >> 8, bj = (n0 >> 7) & 1, i0 = n0 & 127;
            const int s = 3 * l + 2 * f - 1;
            transpose_item(p->ffn_w_gu + ((size_t)l * 2 + f) * DM * NGU, NGU, bj * DFF + 128 * pn + i0, 1.f, wgu + l * WGU_L + f * WGU_F, DM, n0, 64 * kb, scr, lane,
                           s >= 0 ? p->ln_g + s * DM : nullptr, s >= 0 ? p->ln_b + s * DM : nullptr, c12 + l * C12_L + f * NGU, c12 + C2_OFF + l * C12_L + f * NGU); continue; }
        r -= 2 * I_GU;
        if (r < 2 * I_WD) { const int f = r / I_WD; r %= I_WD; const int nb = r / 44, kb = r % 44;
            transpose_item(p->ffn_w_down + ((size_t)l * 2 + f) * DFF * DM, DM, 32 * nb, 1.f, wd + l * WD_L + f * WD_F, DFF, 32 * nb, 64 * kb, scr, lane, nullptr, nullptr, nullptr, nullptr); continue; }
        r -= 2 * I_WD;
        if (r < I_IN) { const int nb = r / 16, kb = r % 16; const int n0 = 32 * nb; int src; float sc = 1.f;
            if (n0 < PC) { src = n0; if (n0 < 256) sc = 0.125f; }
            else if (n0 < PD) src = 928 + (n0 - PC);
            else if (n0 < PCQ) { src = 1440 + (n0 - PD); if (n0 - PD < 256) sc = 0.17677669529663687f; }
            else if (n0 < PCKV) src = 512 + (n0 - PCQ);
            else if (n0 < PKR) src = 768 + (n0 - PCKV);
            else if (n0 < PQUP) src = 896;
            else if (n0 < PEND) continue;
            else src = -1;
            transpose_item(p->w_in + (size_t)l * DM * NIN_SRC, NIN_SRC, src, sc, win + l * WIN_L, DM, n0, 64 * kb, scr, lane,
                           p->ln_g + (3 * l) * DM, p->ln_b + (3 * l) * DM, c12 + l * C12_L + 2 * NGU, c12 + C2_OFF + l * C12_L + 2 * NGU); continue; }
        r -= I_IN;
        if (r < I_OUT) { const int nb = r / 16, kb = r % 16;
            transpose_item(p->w_out + (size_t)l * DM * DM, DM, 32 * nb, 1.f, wout + l * WOUT_L, DM, 32 * nb, 64 * kb, scr, lane, nullptr, nullptr, nullptr, nullptr); continue; }
        r -= I_OUT;
        {
            const int kb8 = r / 14, ng = r % 14; const int k0 = 8 * kb8;
            int J, cA, ldu, nc; const float* g; const float* U;
            if (ng < 6) { J = 256; cA = 512; g = p->mla_q_norm + l * 256; U = p->mla_w_uq + (size_t)l * 256 * 384; ldu = 384; nc = 64 * ng; }
            else { J = 128; cA = 768; g = p->mla_kv_norm + l * 128; U = p->mla_w_ukv + (size_t)l * 128 * 512; ldu = 512; nc = 64 * (ng - 6); }
            const int nglob = (ng < 6 ? 0 : 384) + nc + lane;
            const float* a = p->w_in + (size_t)l * DM * NIN_SRC + (size_t)k0 * NIN_SRC + cA;
            const float* up = U + nc + lane;
            float acc[8];
#pragma unroll
            for (int e = 0; e < 8; ++e) acc[e] = 0.f;
#pragma unroll 4
            for (int j = 0; j < J; ++j) { const float u = up[(size_t)j * ldu] * g[j];
#pragma unroll
                for (int e = 0; e < 8; ++e) acc[e] = fmaf(a[(size_t)e * NIN_SRC + j], u, acc[e]); }
            const float* lg = p->ln_g + (3 * l) * DM + k0; const float* lb = p->ln_b + (3 * l) * DM + k0;
            float s1 = 0.f, s2 = 0.f; unsigned wb[8];
#pragma unroll
            for (int e = 0; e < 8; ++e) { wb[e] = pkbf(acc[e] * lg[e], 0.f) & 0xffffu; s1 += bflo(wb[e]); s2 = fmaf(acc[e], lb[e], s2); }
            u32x4 o; o.x = wb[0] | (wb[1] << 16); o.y = wb[2] | (wb[3] << 16); o.z = wb[4] | (wb[5] << 16); o.w = wb[6] | (wb[7] << 16);
            *(u32x4*)(win + l * WIN_L + (size_t)(PQUP + nglob) * DM + k0) = o;
            atomicAdd(c12 + l * C12_L + 2 * NGU + PQUP + nglob, s1); atomicAdd(c12 + C2_OFF + l * C12_L + 2 * NGU + PQUP + nglob, s2);
        }
    }
    { u32x4* ag = (u32x4*)(p->ws + WS_AUG);
      for (int i = (vcu * NWAVES + wave) * 64 + lane; i < SEQ * 4; i += G * NWAVES * 64) { const int t = i >> 2, h = i & 3;
          const float sl = __builtin_amdgcn_exp2f(-(float)(5 + h));
          u32x4 w = {pkbf(sl * (float)(128 * (t >> 7)), sl * (float)(t & 127)), 0u, 0u, 0u}; ag[2 * i] = w; ag[2 * i + 1] = (u32x4){0u, 0u, 0u, 0u}; } }
    bf16_t* xb = (bf16_t*)(p->ws + WS_XB);
    for (int m = gw; m < T; m += NGW) {
        const f32x4* xr = (const f32x4*)(p->x + (size_t)m * DM) + lane; u32x2* o8 = (u32x2*)(xb + (size_t)m * DM) + lane;
#pragma unroll
        for (int j = 0; j < 4; ++j) { const f32x4 v = xr[64 * j]; u32x2 w; w.x = pkbf(v.x, v.y); w.y = pkbf(v.z, v.w); o8[64 * j] = w; }
    }
}

template <bool WRITE_XB> __device__ __forceinline__ void ln_phase(float* X, bf16_t* xb, const float* __restrict__ g, const float* __restrict__ b, int vcu, int G) {
    const int tid = tid_fresh(), lane = tid & 63, wave = __builtin_amdgcn_readfirstlane(tid >> 6);
    const int gw = vcu * NWAVES + wave, NGW = G * NWAVES;
    f32x4 gv[4], bv[4];
#pragma unroll
    for (int j = 0; j < 4; ++j) { gv[j] = ((const f32x4*)g)[64 * j + lane]; bv[j] = ((const f32x4*)b)[64 * j + lane]; }
    for (int m = gw; m < T; m += NGW) {
        f32x4* xr = (f32x4*)(X + (size_t)m * DM) + lane; u32x2* o8 = (u32x2*)(xb + (size_t)m * DM) + lane;
        f32x4 v[4]; float s = 0.f;
#pragma unroll
        for (int j = 0; j < 4; ++j) { v[j] = xr[64 * j]; s += (v[j].x + v[j].y) + (v[j].z + v[j].w); }
        const float mean = wave_sum(s) * (1.f / DM); float s2 = 0.f;
#pragma unroll
        for (int j = 0; j < 4; ++j) { v[j] = v[j] - mean; s2 += (v[j].x * v[j].x + v[j].y * v[j].y) + (v[j].z * v[j].z + v[j].w * v[j].w); }
        const float rstd = 1.f / sqrtf(wave_sum(s2) * (1.f / DM) + NORM_EPS);
#pragma unroll
        for (int j = 0; j < 4; ++j) { const f32x4 y = v[j] * rstd * gv[j] + bv[j]; xr[64 * j] = y; if (WRITE_XB) { u32x2 w; w.x = pkbf(y.x, y.y); w.y = pkbf(y.z, y.w); o8[64 * j] = w; } }
    }
}

__device__ __forceinline__ void sincos_rev(float ang, float& s, float& c) {
    double d = (double)ang * 0.15915494309189535; d -= __builtin_rint(d); const float f = (float)d;
    s = __builtin_amdgcn_sinf(f); c = __builtin_amdgcn_cosf(f);
}
__device__ __forceinline__ void rope8(float (&v)[8], bool first, float pos, int i0, KP p) {
#pragma unroll
    for (int e = 0; e < 8; ++e) {
        const float other = __shfl_xor(v[e], 2);
        const float inv = i0 ? p->inv32[8 + e] : p->inv32[e];
        float s, c; sincos_rev(pos * inv, s, c);
        v[e] = first ? (v[e] * c - other * s) : (other * s + v[e] * c);
    }
}
__device__ __forceinline__ void prep_phase(KP p, int l, int vcu, int G) {
    const int tid = tid_fresh(), lane = tid & 63, wave = __builtin_amdgcn_readfirstlane(tid >> 6);
    const int gw = vcu * NWAVES + wave, NGW = G * NWAVES;
    bf16_t* proj = (bf16_t*)(p->ws + WS_PROJ); bf16_t* qb = (bf16_t*)(p->ws + WS_QB); bf16_t* kb = (bf16_t*)(p->ws + WS_KB); bf16_t* vb = (bf16_t*)(p->ws + WS_VB);
    float cg[8];
    { const float* gsrc = (lane < 32 ? p->ax_q_norm : p->ax_k_norm) + l * 64 + 8 * (lane & 7);
#pragma unroll
      for (int e = 0; e < 8; ++e) cg[e] = gsrc[e]; }
    float km0 = 0.f, km1 = 0.f;
    float kb0 = 0.f, kb1 = 0.f, kc0 = 0.f, kc1 = 0.f;
    for (int tok = gw; tok < T; tok += NGW) {
        const int t = tok & (SEQ - 1);
        bf16_t* pr = proj + (size_t)tok * NPROJ;
        const int l48 = lane < 48 ? lane : 0, l32 = lane < 32 ? lane : 0, l4 = lane < 4 ? lane : 0;
        const u32x4 in_cq = *(const u32x4*)(pr + PCQ + 8 * l48), in_qup = *(const u32x4*)(pr + PQUP + 8 * l48), in_kv = *(const u32x4*)(pr + PKVUP + 8 * lane);
        const u32x4 in_kr = *(const u32x4*)(pr + PKR + 8 * l4), in_c = *(const u32x4*)(pr + PC + 8 * l48), in_dk = *(const u32x4*)(pr + PD + 256 + 8 * l32);
        { float s = 0.f;
          if (lane < 32) { float v[8]; unpack8(in_dk, v);
#pragma unroll
              for (int e = 0; e < 8; ++e) s += v[e] * v[e]; }
          s += __shfl_xor(s, 1); s += __shfl_xor(s, 2);
          if (tok < SEQ) km0 = fmaxf(km0, s); else km1 = fmaxf(km1, s); }
        float ssq = 0.f;
        if (lane < 48) { float v[8]; unpack8(in_cq, v);
#pragma unroll
            for (int e = 0; e < 8; ++e) ssq += v[e] * v[e]; }
        const float ssq_q = wave_sum(lane < 32 ? ssq : 0.f), ssq_kv = wave_sum(lane >= 32 ? ssq : 0.f);
        const float rstd_q = 1.f / sqrtf(ssq_q * (1.f / 256.f) + NORM_EPS), rstd_kv = 1.f / sqrtf(ssq_kv * (1.f / 128.f) + NORM_EPS);
        {
            const int r = lane % 12; float v[8];
            unpack8(in_qup, v);
#pragma unroll
            for (int e = 0; e < 8; ++e) v[e] = (lane < 48) ? v[e] * rstd_q : 0.f;
            float w[8];
#pragma unroll
            for (int e = 0; e < 8; ++e) w[e] = v[e];
            rope8(w, r < 10, (float)t, 8 * (r & 1), p);
            const bool isr = (r >= 8); const float qs = 0.10206207261596575f;
#pragma unroll
            for (int e = 0; e < 8; ++e) v[e] = (isr ? w[e] : v[e]) * qs;
            if (lane < 48) *(u32x4*)(qb + (size_t)tok * 384 + 8 * lane) = pack8(v);
        }
        float nope2;
        {
            float v[8]; unpack8(in_kv, v);
#pragma unroll
            for (int e = 0; e < 8; ++e) v[e] *= rstd_kv;
            const int hd = lane >> 4, r = lane & 15;
            { float s = 0.f;
#pragma unroll
              for (int e = 0; e < 8; ++e) s += v[e] * v[e];
              s = (r < 8) ? s : 0.f; s += __shfl_xor(s, 1); s += __shfl_xor(s, 2); s += __shfl_xor(s, 4); nope2 = s; }
            if (r < 8) *(u32x4*)(kb + (size_t)tok * 384 + hd * 96 + 8 * r) = pack8(v);
            else *(u32x4*)(vb + (size_t)tok * 256 + hd * 64 + 8 * (r - 8)) = pack8(v);
        }
        {
            float v[8]; unpack8(in_kr, v);
            rope8(v, (lane & 3) < 2, (float)t, 8 * (lane & 1), p);
            { float s = 0.f;
#pragma unroll
              for (int e = 0; e < 8; ++e) s += v[e] * v[e];
              s = (lane < 4) ? s : 0.f; s += __shfl_xor(s, 1); s += __shfl_xor(s, 2);
              const float kk = nope2 + __shfl(s, 0);
              if (tok < SEQ) kb0 = fmaxf(kb0, kk); else kb1 = fmaxf(kb1, kk); }
            if (lane < 4) { const u32x4 w = pack8(v);
#pragma unroll
                for (int hd = 0; hd < 4; ++hd) *(u32x4*)(kb + (size_t)tok * 384 + hd * 96 + 64 + 8 * lane) = w; }
        }
        {
            float v[8]; unpack8(in_c, v);
            float s = 0.f;
#pragma unroll
            for (int e = 0; e < 8; ++e) s += v[e] * v[e];
            s += __shfl_xor(s, 1); s += __shfl_xor(s, 2); s += __shfl_xor(s, 4);
            const float rs = 1.f / sqrtf(s * (1.f / 64.f) + NORM_EPS);
#pragma unroll
            for (int e = 0; e < 8; ++e) v[e] = v[e] * rs * cg[e];
            const int r = lane & 7; const float pos = (r < 4) ? (float)(t >> 6) : (float)(t & 63);
            rope8(v, (r & 3) < 2, pos, 8 * (r & 1), p);
            { float s2 = 0.f;
#pragma unroll
              for (int e = 0; e < 8; ++e) s2 += v[e] * v[e];
              s2 += __shfl_xor(s2, 1); s2 += __shfl_xor(s2, 2); s2 += __shfl_xor(s2, 4);
              if (tok < SEQ) kc0 = fmaxf(kc0, s2); else kc1 = fmaxf(kc1, s2); }
            if (lane < 32) {
#pragma unroll
                for (int e = 0; e < 8; ++e) v[e] *= 0.125f; }
            if (lane < 48) *(u32x4*)(pr + PC + 8 * lane) = pack8(v);
        }
    }
    unsigned* kmw = (unsigned*)(p->ws + WS_KMAX) + l * 32;
    if (lane < 32 && (lane & 3) == 0) { atomicMax(kmw + (lane >> 2), __builtin_bit_cast(unsigned, km0)); atomicMax(kmw + 8 + (lane >> 2), __builtin_bit_cast(unsigned, km1)); }
    if ((lane & 15) == 0) { atomicMax(kmw + 16 + (lane >> 4), __builtin_bit_cast(unsigned, kb0)); atomicMax(kmw + 20 + (lane >> 4), __builtin_bit_cast(unsigned, kb1)); }
    if (lane == 32 || lane == 40) { atomicMax(kmw + 24 + ((lane - 32) >> 3), __builtin_bit_cast(unsigned, kc0)); atomicMax(kmw + 26 + ((lane - 32) >> 3), __builtin_bit_cast(unsigned, kc1)); }
}

#ifndef ATT_TYPES
#define ATT_TYPES 15
#endif
namespace att {
typedef float f32x2 __attribute__((ext_vector_type(2)));
constexpr int VPITCH = 144, KBUF = 64 * 208, VBUF = 64 * VPITCH;
constexpr int ATT_LDS = 2 * KBUF + 2 * VBUF;
constexpr float RESCALE_T = 5.0f;
__device__ __forceinline__ s16x4 vtr(const LAS char* p) { return __builtin_bit_cast(s16x4, __builtin_amdgcn_ds_read_tr16_b64_v4i16((LAS s16x4*)p)); }
__device__ __forceinline__ void xhalf_swap(float m, float& a, float& b) {
    a = m; b = m;
    asm volatile("s_nop 1\n\tv_permlane32_swap_b32 %0, %1\n\ts_nop 1" : "+v"(a), "+v"(b));
}
__device__ __forceinline__ float xhalf_max(float m) { float a, b; xhalf_swap(m, a, b); return fmaxf(a, b); }
__device__ __forceinline__ float xhalf_sum(float m) { float a, b; xhalf_swap(m, a, b); return a + b; }
__device__ __forceinline__ float max3f(float a, float b, float c) { return fmaxf(fmaxf(a, b), c); }
__device__ __forceinline__ float fma_s(float a, float b, float c) { float r; asm("v_fma_f32 %0, %1, %2, %3" : "=v"(r) : "v"(a), "s"(b), "v"(c)); return r; }
__device__ __forceinline__ float add_s(float a, float b) { float r; asm("v_add_f32_e32 %0, %1, %2" : "=v"(r) : "v"(a), "v"(b)); return r; }
__device__ __forceinline__ float mul_s(float a, float b) { float r; asm("v_mul_f32_e32 %0, %1, %2" : "=v"(r) : "v"(a), "v"(b)); return r; }
#define ATT_MFMA(a, b, c) __builtin_amdgcn_mfma_f32_32x32x16_bf16((a), (b), (c), 0, 0, 0)

template <int DK, int MODE, bool INIT = true, bool TRACK = (MODE == 2)>
__device__ __forceinline__ void flash_pass(LAS char* lds, const bf16_t* __restrict__ Qg, int qp, const bf16_t* __restrict__ Kg, int kp, const bf16_t* __restrict__ Vg, int vp,
                                           const bf16_t* __restrict__ AUGg, int q0, int a0, int nA, int b0, int nt, float slope, f32x16& O0, f32x16& O1, float& Mout, float& Lout) {
    constexpr int DKL = DK + (MODE == 1 ? 16 : 0);
    constexpr int KPITCH = DKL * 2 + 16, NKC = 8 * DKL, CPR = DKL / 8, NKS = DK / 16;
    constexpr bool HAS_K1 = NKC > 512;
    constexpr int DUMMY = 2 * KBUF + 2 * VBUF;
    const int tid = tid_fresh(), lane = tid & 63, r32 = lane & 31, hi = lane >> 5; const int wid = __builtin_amdgcn_readfirstlane(tid >> 6);
    const int qrow = q0 + wid * 32 + r32;
    bf16x8 qf[NKS];
#pragma unroll
    for (int ks = 0; ks < NKS; ++ks) qf[ks] = *(const bf16x8*)(Qg + (size_t)qrow * qp + 16 * ks + 8 * hi);
    const int kc1 = tid + 512;
    const bool k0v = tid < NKC, k1v = HAS_K1 && kc1 < NKC;
    const int kr0 = k0v ? tid / CPR : 0, kcc0 = k0v ? tid % CPR : 0, kr1 = k1v ? kc1 / CPR : 0, kcc1 = k1v ? kc1 % CPR : 0, vr = tid >> 3, vcc = tid & 7;
    const bf16_t* kg0; size_t kst0;
    if (MODE == 1 && kcc0 >= DK / 8) { kg0 = AUGg + (size_t)kr0 * 64 + 8 * (kcc0 - DK / 8); kst0 = (size_t)64 * 64; } else { kg0 = Kg + (size_t)kr0 * kp + 8 * kcc0; kst0 = (size_t)64 * kp; }
    const bf16_t* kg1 = Kg + (size_t)kr1 * kp + 8 * kcc1; const size_t kst1 = (size_t)64 * kp;
    const bf16_t* vg = Vg + (size_t)vr * vp + 8 * vcc; const size_t vst = (size_t)64 * vp;
    const int kl0 = k0v ? kr0 * KPITCH + 16 * kcc0 : -1, kl1 = k1v ? kr1 * KPITCH + 16 * kcc1 : -1, vl = 2 * KBUF + vr * VPITCH + 16 * vcc;
    u32x4 rk0A = {0u, 0u, 0u, 0u}, rk1A = {0u, 0u, 0u, 0u}, rvA = {0u, 0u, 0u, 0u}, rk0B = {0u, 0u, 0u, 0u}, rk1B = {0u, 0u, 0u, 0u}, rvB = {0u, 0u, 0u, 0u};
#define ATT_KT(i) ((i) < nA ? a0 + (i) : b0 + ((i) - nA))
#define ATT_LOADK(X, kt) do { const size_t t_ = (size_t)(kt); rk0##X = *(const u32x4*)(kg0 + t_ * kst0); if (HAS_K1) rk1##X = *(const u32x4*)(kg1 + t_ * kst1); } while (0)
#define ATT_LOADV(X, kt) do { rv##X = *(const u32x4*)(vg + (size_t)(kt) * vst); } while (0)
#define ATT_STOREK(X, buf) do { *(LAS u32x4*)(lds + (kl0 >= 0 ? (buf) * KBUF + kl0 : DUMMY + tid * 16)) = rk0##X; if (HAS_K1) *(LAS u32x4*)(lds + (kl1 >= 0 ? (buf) * KBUF + kl1 : DUMMY + tid * 16)) = rk1##X; } while (0)
#define ATT_STOREV(X, buf) do { *(LAS u32x4*)(lds + (buf) * VBUF + vl) = rv##X; } while (0)
    const int q4 = (lane & 15) >> 2, p4 = lane & 3, b16 = (lane >> 4) & 1;
    const int vbase = 2 * KBUF + (4 * hi + q4) * VPITCH + 32 * b16 + 8 * p4;
    const int kbase = r32 * KPITCH + 16 * hi;
    const int qw = q0 + wid * 32;
    const float stq = slope * (float)qrow;
    const bf16x8 qzero = {0, 0, 0, 0, 0, 0, 0, 0};
    bf16x8 qpos = qzero, qneg = qzero;
    if (MODE == 1 && hi == 0) { qpos[0] = (short)0x3F80; qpos[1] = (short)0x3F80; qneg[0] = (short)0xBF80; qneg[1] = (short)0xBF80; }
    constexpr int NKF = NKS + (MODE == 1 ? 1 : 0);
    constexpr int KPRE = NKF > 4 ? 4 : NKF;
    bf16x8 kfa[NKF], kfb[NKF];
#define ATT_KREAD(kbuf, f0, f1) do { const LAS char* Kb_ = lds + (kbuf) * KBUF + kbase; \
        _Pragma("unroll") for (int ks_ = (f0); ks_ < (f1); ++ks_) { kfa[ks_] = *(const LAS bf16x8*)(Kb_ + 32 * ks_); kfb[ks_] = *(const LAS bf16x8*)(Kb_ + 32 * KPITCH + 32 * ks_); } } while (0)
#define ATT_QKM(sa, sb, side) do { \
        _Pragma("unroll") for (int e_ = 0; e_ < 16; ++e_) { sa[e_] = 0.f; sb[e_] = 0.f; } \
        _Pragma("unroll") for (int ks_ = 0; ks_ < NKS; ++ks_) { sa = ATT_MFMA(kfa[ks_], qf[ks_], sa); sb = ATT_MFMA(kfb[ks_], qf[ks_], sb); } \
        if (MODE == 1) { const bf16x8 qa_ = (side) < 0 ? qpos : ((side) > 0 ? qneg : qzero); sa = ATT_MFMA(kfa[NKS], qa_, sa); sb = ATT_MFMA(kfb[NKS], qa_, sb); } } while (0)
#define ATT_QK(sa, sb, kbuf, side) do { ATT_KREAD(kbuf, 0, NKF); ATT_QKM(sa, sb, side); } while (0)
    bf16x8 vfa[4], vfb[4];
#define ATT_VREAD(vbuf) do { const LAS char* Vb_ = lds + (vbuf) * VBUF + vbase; \
        _Pragma("unroll") for (int j_ = 0; j_ < 4; ++j_) { const LAS char* vp0_ = Vb_ + (16 * j_) * VPITCH; \
            { const s16x4 lo_ = vtr(vp0_), hh_ = vtr(vp0_ + 8 * VPITCH); vfa[j_] = __builtin_shufflevector(lo_, hh_, 0, 1, 2, 3, 4, 5, 6, 7); } \
            { const s16x4 lo_ = vtr(vp0_ + 64), hh_ = vtr(vp0_ + 8 * VPITCH + 64); vfb[j_] = __builtin_shufflevector(lo_, hh_, 0, 1, 2, 3, 4, 5, 6, 7); } } } while (0)
#define ATT_PVM() do { _Pragma("unroll") for (int j_ = 0; j_ < 4; ++j_) { O0 = ATT_MFMA(vfa[j_], pf[j_ >> 1][j_ & 1], O0); O1 = ATT_MFMA(vfb[j_], pf[j_ >> 1][j_ & 1], O1); } } while (0)
#define ATT_PV(vbuf) do { ATT_VREAD(vbuf); ATT_PVM(); } while (0)
#define ATT_SIDE(kt) ((MODE != 1) ? 0 : (((kt) * 64 + 63 < qw) ? -1 : (((kt) * 64 > qw + 31) ? 1 : 0)))
    ATT_LOADK(A, ATT_KT(0)); ATT_LOADK(B, ATT_KT(1)); ATT_STOREV(B, 1);
    ATT_STOREK(A, 0); ATT_STOREK(B, 1);
    ATT_LOADK(A, ATT_KT(2)); ATT_LOADV(A, ATT_KT(0));
    __syncthreads();
    float M = (INIT && TRACK) ? -1e20f : Mout, L = INIT ? 0.f : Lout;
    if (INIT) {
#pragma unroll
        for (int i = 0; i < 16; ++i) { O0[i] = 0.f; O1[i] = 0.f; } }
    bf16x8 pf[2][2];
#pragma unroll
    for (int kb = 0; kb < 2; ++kb)
#pragma unroll
        for (int st = 0; st < 2; ++st) pf[kb][st] = qzero;
    f32x16 s0, s1, n0, n1;
    int side_cur = ATT_SIDE(ATT_KT(0));
    ATT_QK(s0, s1, 0, side_cur);
#pragma unroll
    for (int e = 0; e < 16; ++e) { n0[e] = 0.f; n1[e] = 0.f; }
    __syncthreads();
    constexpr int NMF = 2 * NKS + (MODE == 1 ? 2 : 0) + 8;
#define ATT_ITER(i, C0, C1, N0, N1, LS, SS, HASN, HASK2, HASK3) do { \
        const int kt = ATT_KT(i); \
        if (HASK3) ATT_LOADK(LS, ATT_KT((i) + 3)); \
        if (HASN) ATT_LOADV(LS, ATT_KT((i) + 1)); \
        if (HASN) ATT_KREAD(((i) + 1) & 1, 0, KPRE); \
        const int k0 = kt * 64; \
          \
        float rc = 0.f; \
        if (MODE == 1) { \
            if (side_cur != 0) rc = side_cur < 0 ? -stq : stq; \
            else { const float dbase = (float)(k0 + 4 * hi - qrow); \
                _Pragma("unroll") for (int e = 0; e < 16; ++e) { const float c = (float)((e & 3) + 8 * (e >> 2)); \
                    C0[e] = fmaf(-slope, fabsf(dbase + c), C0[e]); C1[e] = fmaf(-slope, fabsf(dbase + (c + 32.f)), C1[e]); } } \
        } \
        if (MODE == 2) { const float dbase = (float)(k0 + 4 * hi - qrow); \
            _Pragma("unroll") for (int e = 0; e < 16; ++e) { const float c = (float)((e & 3) + 8 * (e >> 2)); \
                const float d0 = fabsf(dbase + c), d1 = fabsf(dbase + (c + 32.f)); \
                C0[e] = (d0 <= 128.f) ? fmaf(-slope, d0, C0[e]) : -1e30f; C1[e] = (d1 <= 128.f) ? fmaf(-slope, d1, C1[e]) : -1e30f; } } \
        if (TRACK) { \
        float mx = max3f(C0[0], C1[0], C0[1]); \
        _Pragma("unroll") for (int e = 1; e < 15; e += 2) { mx = max3f(mx, C1[e], C0[e + 1]); mx = max3f(mx, C1[e + 1], C0[e + 2]); } \
        mx = fmaxf(mx, C1[15]); \
        const float mt = xhalf_max(mx) + rc;                     \
        if (__builtin_amdgcn_ballot_w64(mt > M + RESCALE_T) != 0ull) {         \
            ATT_PV(((i) + 1) & 1); \
            _Pragma("unroll") for (int kb = 0; kb < 2; ++kb) _Pragma("unroll") for (int st = 0; st < 2; ++st) pf[kb][st] = qzero; \
            const float Mn = fmaxf(M, mt); const float alpha = __builtin_amdgcn_exp2f((M - Mn) * LOG2E); M = Mn; \
            L *= alpha; \
            _Pragma("unroll") for (int e = 0; e < 16; ++e) { O0[e] *= alpha; O1[e] *= alpha; }        \
        } } \
          \
        const int side_next = HASN ? ATT_SIDE(ATT_KT((i) + 1)) : 0; \
        if (HASN) ATT_KREAD(((i) + 1) & 1, KPRE, NKF); \
        ATT_VREAD(((i) + 1) & 1); \
        if (HASN) ATT_QKM(N0, N1, side_next); \
        ATT_PVM();                                   \
        const float cc = (rc - M) * LOG2E; \
        float ps = 0.f;                                          \
        float ps1 = 0.f; \
        _Pragma("unroll") for (int e = 0; e < 16; ++e) { float t0 = __builtin_fmaf(C0[e], LOG2E, cc), t1 = __builtin_fmaf(C1[e], LOG2E, cc); \
            asm("" : "+v"(t0)); asm("" : "+v"(t1));                 \
            C0[e] = __builtin_amdgcn_exp2f(t0); C1[e] = __builtin_amdgcn_exp2f(t1); \
            float u0 = ps + C0[e], u1 = ps1 + C1[e]; asm("" : "+v"(u0)); asm("" : "+v"(u1)); ps = u0; ps1 = u1; } \
        L += ps + ps1; \
        _Pragma("unroll") for (int st = 0; st < 2; ++st) { u32x4 w0, w1; \
            w0.x = pkbf(C0[8 * st + 0], C0[8 * st + 1]); w0.y = pkbf(C0[8 * st + 2], C0[8 * st + 3]); w0.z = pkbf(C0[8 * st + 4], C0[8 * st + 5]); w0.w = pkbf(C0[8 * st + 6], C0[8 * st + 7]); \
            w1.x = pkbf(C1[8 * st + 0], C1[8 * st + 1]); w1.y = pkbf(C1[8 * st + 2], C1[8 * st + 3]); w1.z = pkbf(C1[8 * st + 4], C1[8 * st + 5]); w1.w = pkbf(C1[8 * st + 6], C1[8 * st + 7]); \
            pf[0][st] = __builtin_bit_cast(bf16x8, w0); pf[1][st] = __builtin_bit_cast(bf16x8, w1); } \
        side_cur = side_next; \
        if (HASN) { __builtin_amdgcn_sched_group_barrier(0x100, 8, 0);        \
            _Pragma("unroll") for (int g_ = 0; g_ < NMF; ++g_) { __builtin_amdgcn_sched_group_barrier(0x008, 1, 0); __builtin_amdgcn_sched_group_barrier(0x100, 2, 0); __builtin_amdgcn_sched_group_barrier(0x002, 6, 0); } } \
        if (HASK2) ATT_STOREK(SS, (i) & 1); \
        ATT_STOREV(SS, (i) & 1); \
        __syncthreads(); } while (0)
    for (int i = 0; i + 4 < nt; i += 2) {
        ATT_ITER(i, s0, s1, n0, n1, B, A, true, true, true);
        ATT_ITER(i + 1, n0, n1, s0, s1, A, B, true, true, true);
    }
    ATT_ITER(nt - 4, s0, s1, n0, n1, B, A, true, true, true);
    ATT_ITER(nt - 3, n0, n1, s0, s1, A, B, true, true, false);
    ATT_ITER(nt - 2, s0, s1, n0, n1, B, A, true, false, false);
    ATT_ITER(nt - 1, n0, n1, s0, s1, A, B, false, false, false);
    ATT_PV((nt - 1) & 1);
    __syncthreads();
#undef ATT_ITER
#undef ATT_LOADK
#undef ATT_LOADV
#undef ATT_STOREK
#undef ATT_STOREV
#undef ATT_KT
#undef ATT_QK
#undef ATT_PV
#undef ATT_KREAD
#undef ATT_QKM
#undef ATT_VREAD
#undef ATT_PVM
#undef ATT_SIDE
    Mout = M; Lout = L;
}

template <int NE> __device__ __forceinline__ float row_norm2(const bf16_t* qrow_ptr) {
    float s = 0.f;
#pragma unroll
    for (int c = 0; c < NE / 8; ++c) { float v[8]; unpack8(((const u32x4*)qrow_ptr)[c], v);
#pragma unroll
        for (int e = 0; e < 8; ++e) s += v[e] * v[e]; }
    return s;
}
__device__ __forceinline__ void store_o(bf16_t* orow, const f32x16& O0, const f32x16& O1, int hi) {
#pragma unroll
    for (int g = 0; g < 4; ++g) {
        u32x2 w0, w1; w0.x = pkbf(O0[4 * g], O0[4 * g + 1]); w0.y = pkbf(O0[4 * g + 2], O0[4 * g + 3]); w1.x = pkbf(O1[4 * g], O1[4 * g + 1]); w1.y = pkbf(O1[4 * g + 2], O1[4 * g + 3]);
        *(u32x2*)(orow + 8 * g + 4 * hi) = w0; *(u32x2*)(orow + 32 + 8 * g + 4 * hi) = w1;
    }
}

__device__ __forceinline__ void attn_phase(KP p, int l, LAS char* lds, int vcu, int G) {
    const bf16_t* proj = (const bf16_t*)(p->ws + WS_PROJ); const bf16_t* qb = (const bf16_t*)(p->ws + WS_QB); const bf16_t* kb = (const bf16_t*)(p->ws + WS_KB); const bf16_t* vb = (const bf16_t*)(p->ws + WS_VB);
    const bf16_t* aug = (const bf16_t*)(p->ws + WS_AUG);
    bf16_t* mix = (bf16_t*)(p->ws + WS_MIX);
    for (int u = vcu; u < 2048; u += G) {
        if (!((ATT_TYPES >> (u >> 9)) & 1)) continue;
        const int tid = tid_fresh(), lane = tid & 63, r32 = lane & 31, hi = lane >> 5; const int wid = __builtin_amdgcn_readfirstlane(tid >> 6);
        const int type = u >> 9, idx = u & 511, bh = idx >> 6, qblk = idx & 63, b = bh >> 2, hd = bh & 3, q0 = qblk * 256;
        const int qrow = q0 + wid * 32 + r32;
        const size_t tok0 = (size_t)b * SEQ;
        bf16_t* orow = mix + (tok0 + qrow) * DM;
        f32x16 O0, O1; float M, L;
        if (type == 0) {
            const int bD = idx >> 8, hD = ((idx >> 6) & 3) ^ (bD ? 3 : 0);
            const size_t tokD = (size_t)bD * SEQ;
            bf16_t* orowD = mix + (tokD + qrow) * DM;
            const float slope = __builtin_amdgcn_exp2f(-(float)(5 + hD));
            const bf16_t* base = proj + tokD * NPROJ + PD;
            const int d0 = q0 / 64;
            LAS float* asave = (LAS float*)(lds + 65536) + tid;
#pragma unroll 1
            for (int mp = 0; mp < 2; ++mp) {
                const bf16_t* Qm = base + 64 * hD + 32 * mp; const bf16_t* Km = base + 256 + 64 * hD + 32 * mp; const bf16_t* Vm = base + 512 + 64 * hD;
                const float kmax = sqrtf(__builtin_bit_cast(float, ((const unsigned*)(p->ws + WS_KMAX))[l * 32 + bD * 8 + hD * 2 + mp]));
                const float bound = sqrtf(row_norm2<32>(Qm + (size_t)qrow * NPROJ)) * kmax * 1.01f;
                M = bound;
                flash_pass<32, 1, true>(lds, Qm, NPROJ, Km, NPROJ, Vm, NPROJ, aug + 16 * hD, q0, d0, 4, 0, 4, slope, O0, O1, M, L);
                float dc = (bound + (20.8f + __logf(2.f / slope)) - (M + __logf(fmaxf(xhalf_sum(L), 1e-37f)))) / slope;
                dc = fminf(fmaxf(dc, 0.f), 1.0e8f);
#pragma unroll
                for (int o = 1; o < 64; o <<= 1) dc = fmaxf(dc, __shfl_xor(dc, o));
                LAS float* red = (LAS float*)(lds + ATT_LDS + 16384);
                if (lane == 0) red[wid] = dc;
                __syncthreads();
#pragma unroll
                for (int w = 0; w < 8; ++w) dc = fmaxf(dc, red[w]);
                __syncthreads();
                const int dci = (int)dc + 1;
                const int lo_key = q0 - dci - 63;
                int ktlo = lo_key <= 0 ? 0 : (lo_key + 63) / 64; int kthi = (q0 + 255 + dci) / 64; if (kthi > SEQ / 64 - 1) kthi = SEQ / 64 - 1;
                if (ktlo > d0) ktlo = d0; if (kthi < d0 + 3) kthi = d0 + 3;
                if (((kthi - ktlo + 1) & 1) != 0) { if (ktlo > 0) --ktlo; else ++kthi; }
                if (kthi - ktlo + 1 == 6) { if (ktlo >= 2) ktlo -= 2; else kthi += 2; }
                const int nR = kthi - (d0 + 3), nL = d0 - ktlo;
                if (nR + nL > 0) flash_pass<32, 1, false>(lds, Qm, NPROJ, Km, NPROJ, Vm, NPROJ, aug + 16 * hD, q0, d0 + 4, nR, ktlo, nR + nL, slope, O0, O1, M, L);
                if (mp == 0) { const float i1 = 1.f / xhalf_sum(L);
#pragma unroll
                    for (int i = 0; i < 16; ++i) { asave[(2 * i) * NTHREADS] = O0[i] * i1; asave[(2 * i + 1) * NTHREADS] = O1[i] * i1; } }
            }
            float lam;
            { const float* lp = p->diff_lambda + l * 128; const float a = (lane < 32) ? lp[lane] * lp[32 + lane] : 0.f, b2 = (lane < 32) ? lp[64 + lane] * lp[96 + lane] : 0.f;
              lam = expf(wave_sum(a)) - expf(wave_sum(b2)) + p->lam_init[l]; }
            const float one_m_li = 1.f - p->lam_init[l];
            const float i2 = lam / xhalf_sum(L);
            float ss = 0.f;
            f32x16 A0, A1;
#pragma unroll
            for (int i = 0; i < 16; ++i) { A0[i] = asave[(2 * i) * NTHREADS] - O0[i] * i2; A1[i] = asave[(2 * i + 1) * NTHREADS] - O1[i] * i2; ss += A0[i] * A0[i] + A1[i] * A1[i]; }
            ss = xhalf_sum(ss);
            const float rs = one_m_li / sqrtf(ss * (1.f / 64.f) + NORM_EPS);
            const float* sg = p->diff_subln + l * 64;
#pragma unroll
            for (int i = 0; i < 16; ++i) { const int dv = (i & 3) + 8 * (i >> 2) + 4 * hi; A0[i] *= rs * sg[dv]; A1[i] *= rs * sg[32 + dv]; }
            store_o(orowD + 768 + 64 * hD, A0, A1, hi);
        } else if (type == 1) {
            M = sqrtf(row_norm2<96>(qb + (tok0 + qrow) * 384 + 96 * hd) * __builtin_bit_cast(float, ((const unsigned*)(p->ws + WS_KMAX))[l * 32 + 16 + b * 4 + hd])) * 1.01f;
            flash_pass<96, 0>(lds, qb + tok0 * 384 + 96 * hd, 384, kb + tok0 * 384 + 96 * hd, 384, vb + tok0 * 256 + 64 * hd, 256, nullptr, q0, q0 / 64, SEQ / 64 - q0 / 64, 0, SEQ / 64, 0.f, O0, O1, M, L);
            const float il = 1.f / xhalf_sum(L);
#pragma unroll
            for (int i = 0; i < 16; ++i) { O0[i] *= il; O1[i] *= il; }
            store_o(orow + 256 + 64 * hd, O0, O1, hi);
        } else if (type == 2) {
            const bf16_t* base = proj + tok0 * NPROJ + PC; const int hk = hd >> 1;
            M = sqrtf(row_norm2<64>(base + (size_t)qrow * NPROJ + 64 * hd) * __builtin_bit_cast(float, ((const unsigned*)(p->ws + WS_KMAX))[l * 32 + 24 + b * 2 + hk])) * 1.01f;
            flash_pass<64, 0>(lds, base + 64 * hd, NPROJ, base + 256 + 64 * hk, NPROJ, base + 384 + 64 * hk, NPROJ, nullptr, q0, q0 / 64, SEQ / 64 - q0 / 64, 0, SEQ / 64, 0.f, O0, O1, M, L);
            const float il = 1.f / xhalf_sum(L);
#pragma unroll
            for (int i = 0; i < 16; ++i) { O0[i] *= il; O1[i] *= il; }
            store_o(orow + 512 + 64 * hd, O0, O1, hi);
        } else {
            const bf16_t* base = proj + tok0 * NPROJ + PA; const int hk = hd >> 1;
            const float slope = __builtin_amdgcn_exp2f(-(float)(1 + hd));
            const int kt0 = (q0 >= 128) ? (q0 - 128) / 64 : 0; int kt1 = (q0 + 256 + 128) / 64; if (kt1 > SEQ / 64) kt1 = SEQ / 64;
            flash_pass<64, 2>(lds, base + 64 * hd, NPROJ, base + 256 + 64 * hk, NPROJ, base + 384 + 64 * hk, NPROJ, nullptr, q0, kt0, kt1 - kt0, 0, kt1 - kt0, slope, O0, O1, M, L);
            const float sink = p->win_sink[l * 4 + hd];
            const float il = 1.f / (xhalf_sum(L) + __builtin_amdgcn_exp2f((sink - M) * LOG2E));
#pragma unroll
            for (int i = 0; i < 16; ++i) { O0[i] *= il; O1[i] *= il; }
            store_o(orow + 64 * hd, O0, O1, hi);
        }
    }
}
}

#define XB_TMO      128
#define XB_XCNT(j)  (256  + 64 * (j))
#define XB_XSUB(j)  (1280 + 64 * (j))
#define XB_XGEN(j)  (2304 + 64 * (j))
#define XB_TOP      3328
#define XB_TOPGEN   3392
#define XCD_BAR_WORDS 3456
#define XB_SPIN_CAP (1u << 22)

__device__ __forceinline__ unsigned xb_ld(unsigned* p)              { return __hip_atomic_load(p, __ATOMIC_RELAXED, __HIP_MEMORY_SCOPE_AGENT); }
__device__ __forceinline__ unsigned xb_add(unsigned* p, unsigned v) { return __hip_atomic_fetch_add(p, v, __ATOMIC_RELAXED, __HIP_MEMORY_SCOPE_AGENT); }
__device__ __forceinline__ unsigned xb_xcc_id() { return (unsigned)__builtin_amdgcn_s_getreg((3 << 11) | 20) & 0xFu; }
#define XB_SPIN(cond, bar) do { unsigned _sp = 0; while (cond) { __builtin_amdgcn_s_sleep(1); \
    if ((++_sp & 255u) == 0u) { if (xb_ld(&(bar)[XB_TMO])) break; if (_sp > XB_SPIN_CAP) { atomicAdd(&(bar)[XB_TMO], 1u); break; } } } } while (0)

struct XcdBarrier {
    unsigned* bar; unsigned x;
    volatile LAS unsigned* st;
};

__device__ __forceinline__ XcdBarrier xcd_barrier_post(unsigned* bar, volatile LAS unsigned* st) {
    XcdBarrier b; b.bar = bar; b.x = xb_xcc_id(); b.st = st;
    if (threadIdx.x == 0) (void)xb_add(&bar[XB_XCNT(b.x)], 1u);
    return b;
}
__device__ __forceinline__ void xcd_barrier_complete(unsigned* bar, unsigned x, unsigned& nloc, unsigned& nx) {
    const unsigned G = gridDim.x * gridDim.y * gridDim.z;
    unsigned sum, cnt, mine, sp = 0u;
    for (;;) {
        sum = 0u; cnt = 0u; mine = 0u;
#pragma unroll
        for (unsigned j = 0; j < 16; ++j) { const unsigned c = xb_ld(&bar[XB_XCNT(j)]); sum += c; cnt += (c > 0u) ? 1u : 0u; mine = (j == x) ? c : mine; }
        if (sum == G) break;
        __builtin_amdgcn_s_sleep(1);
        if ((++sp & 255u) == 0u) { if (xb_ld(&bar[XB_TMO])) break; if (sp > XB_SPIN_CAP) { atomicAdd(&bar[XB_TMO], 1u); break; } }
    }
    nloc = mine > 0u ? mine : 1u; nx = cnt > 0u ? cnt : 1u;
}

__device__ __forceinline__ void xcd_barrier(const XcdBarrier& b) {
    asm volatile("s_waitcnt vmcnt(0)" ::: "memory");
    __syncthreads();
    if (threadIdx.x == 0) {
        unsigned* bar = b.bar;
        __builtin_amdgcn_s_waitcnt(0);
        unsigned nloc = b.st[0], nx = b.st[1];
        if (nloc == 0u) { xcd_barrier_complete(bar, b.x, nloc, nx); b.st[0] = nloc; b.st[1] = nx; }
        const unsigned old = xb_add(&bar[XB_XSUB(b.x)], 1u);
        const unsigned gen = old / nloc;
        if (old + 1u == (gen + 1u) * nloc) {
            __builtin_amdgcn_fence(__ATOMIC_RELEASE, "agent");
            asm volatile("s_waitcnt vmcnt(0)" ::: "memory");
            const unsigned og = xb_add(&bar[XB_TOP], 1u);
            const unsigned tg = og / nx;
            if (og + 1u == (tg + 1u) * nx) xb_add(&bar[XB_TOPGEN], 1u);
            else XB_SPIN(xb_ld(&bar[XB_TOPGEN]) == tg, bar);
            __builtin_amdgcn_fence(__ATOMIC_ACQUIRE, "agent");
            xb_add(&bar[XB_XGEN(b.x)], 1u);
            asm volatile("s_waitcnt vmcnt(0)" ::: "memory");
        } else {
            XB_SPIN(xb_ld(&bar[XB_XGEN(b.x)]) == gen, bar);
            __builtin_amdgcn_fence(__ATOMIC_ACQUIRE, "agent");
            asm volatile("s_waitcnt vmcnt(0)" ::: "memory");
        }
    }
    __syncthreads();
}

#define GRID_SYNC_CG() do { asm volatile("s_waitcnt vmcnt(0) lgkmcnt(0)" ::: "memory"); grid.sync(); __builtin_amdgcn_fence(__ATOMIC_ACQUIRE, "agent"); } while (0)
#define XB_ST ((volatile LAS unsigned*)(lds + LDS_BYTES - 64))
#define GRID_SYNC() do { GETP(pb_); XcdBarrier xb_; xb_.bar = (unsigned*)(pb_->ws + WS_BAR); xb_.x = xb_xcc_id(); xb_.st = XB_ST; xcd_barrier(xb_); } while (0)
#ifndef PH_MASK
#define PH_MASK 255
#endif
__global__ void __launch_bounds__(NTHREADS, 2) mega_fwd(Params p_by_value) {
    extern __shared__ __attribute__((aligned(16))) unsigned char lds_raw[];
    cg::grid_group grid = cg::this_grid();
    LAS unsigned char* lds = (LAS unsigned char*)lds_raw;
#define VCU(G_, bx_) (((G_) % 8 == 0) ? ((bx_) % 8) * ((G_) / 8) + (bx_) / 8 : (bx_))
    const float alpha = 1.681792830507429f;
#define STATS(s_) ((float*)(p->ws + WS_STATS) + (size_t)(s_) * T * 2)
#define C1(l_, off_) ((const float*)(p->ws + WS_C12) + (l_) * C12_L + (off_))
#define C2(l_, off_) ((const float*)(p->ws + WS_C12) + C2_OFF + (l_) * C12_L + (off_))

    if (threadIdx.x < 16) ((LAS unsigned*)(lds + LDS_BYTES - 64))[threadIdx.x] = 0u;
    __syncthreads();
    { GETP(p); (void)xcd_barrier_post((unsigned*)(p->ws + WS_BAR), XB_ST); }
    if (PH_MASK & 1) { GETP(p); const int G = gridDim.x, bx = blockIdx.x; phase0(p, lds, VCU(G, bx), G); }
    GRID_SYNC_CG();
#pragma unroll 1
    for (int li = 0; li < DEPTH; ++li) {
#pragma unroll 1
        for (int fi = 0; fi < 2; ++fi) {
            if (fi == 1) {
                if (PH_MASK & 2) { GETP(p); int l = li; asm volatile("" : "+s"(l)); const int G = gridDim.x, bx = blockIdx.x;
                  pg8::Gemm g{(const bf16_t*)(p->ws + WS_XB), (const bf16_t*)(p->ws + WS_WIN) + l * WIN_L, T, NPROJ, DM}; pg8::StaticOrder S; S.init(T, NPROJ, G, bx);
                  pg8::EpiStoreBf16LN E{(bf16_t*)(p->ws + WS_PROJ), NPROJ, STATS(3 * l), C1(l, 2 * NGU), C2(l, 2 * NGU)};
                  pg8::gemm_phase<pg8::EpiStoreBf16LN, pg8::StaticOrder, true, true>(lds, g, S, E); }
                GRID_SYNC();
                if (PH_MASK & 4) { GETP(p); int l = li; asm volatile("" : "+s"(l)); const int G = gridDim.x, bx = blockIdx.x; prep_phase(p, l, VCU(G, bx), G); }
                GRID_SYNC();
                if (PH_MASK & 8) { GETP(p); int l = li; asm volatile("" : "+s"(l)); const int G = gridDim.x, bx = blockIdx.x; att::attn_phase(p, l, (LAS char*)lds, VCU(G, bx), G); }
                GRID_SYNC();
                if (PH_MASK & 16) { GETP(p); int l = li; asm volatile("" : "+s"(l)); const int G = gridDim.x, bx = blockIdx.x;
                  pg8::Gemm g{(const bf16_t*)(p->ws + WS_MIX), (const bf16_t*)(p->ws + WS_WOUT) + l * WOUT_L, T, DM, DM}; pg8::StaticOrder S; S.init(T, DM, G, bx);
                  pg8::EpiResidLN<true> E{nullptr, p->out, p->ws, p->ln_g + (3 * l) * DM, p->ln_b + (3 * l) * DM, 3 * l, alpha, 1.0f};
                  pg8::gemm_phase<pg8::EpiResidLN<true>, pg8::StaticOrder, true, true>(lds, g, S, E); }
                GRID_SYNC();
            }
            if (PH_MASK & 64) { GETP(p); int l = li, f = fi; asm volatile("" : "+s"(l), "+s"(f)); const int G = gridDim.x, bx = blockIdx.x;
              const int s = 3 * l + 2 * f - 1;
              pg8::Gemm g{(const bf16_t*)(p->ws + WS_XB), (const bf16_t*)(p->ws + WS_WGU) + l * WGU_L + f * WGU_F, T, NGU, DM}; pg8::StaticOrder S; S.init(T, NGU, G, bx);
              if (s >= 0) { pg8::EpiSwiGLULN<true> E{(bf16_t*)(p->ws + WS_H), DFF, STATS(s), C1(l, f * NGU), C2(l, f * NGU)};
                            pg8::gemm_phase<pg8::EpiSwiGLULN<true>, pg8::StaticOrder, true, true>(lds, g, S, E); }
              else { pg8::EpiSwiGLULN<false> E{(bf16_t*)(p->ws + WS_H), DFF, nullptr, C1(l, f * NGU), C2(l, f * NGU)};
                     pg8::gemm_phase<pg8::EpiSwiGLULN<false>, pg8::StaticOrder, true, true>(lds, g, S, E); } }
            GRID_SYNC();
            if (PH_MASK & 128) { GETP(p); int l = li, f = fi; asm volatile("" : "+s"(l), "+s"(f)); const int G = gridDim.x, bx = blockIdx.x;
              const int s = 3 * l + 2 * f - 1;
              pg8::Gemm g{(const bf16_t*)(p->ws + WS_H), (const bf16_t*)(p->ws + WS_WD) + l * WD_L + f * WD_F, T, DM, DFF}; pg8::StaticOrder S; S.init(T, DM, G, bx);
              if (s >= 0) { pg8::EpiResidLN<true> E{nullptr, p->out, p->ws, p->ln_g + s * DM, p->ln_b + s * DM, s, alpha, 0.5f};
                            pg8::gemm_phase<pg8::EpiResidLN<true>, pg8::StaticOrder, true, true>(lds, g, S, E); }
              else { pg8::EpiResidLN<false> E{p->x, p->out, p->ws, nullptr, nullptr, -1, alpha, 0.5f};
                     pg8::gemm_phase<pg8::EpiResidLN<false>, pg8::StaticOrder, true, true>(lds, g, S, E); } }
            GRID_SYNC();
        }
    }
    if (PH_MASK & 32) { GETP(p); const int G = gridDim.x, bx = blockIdx.x;
      ln_phase<false>(p->out, (bf16_t*)(p->ws + WS_XB), p->ln_g + (3 * DEPTH - 1) * DM, p->ln_b + (3 * DEPTH - 1) * DM, VCU(G, bx), G); }
}

extern "C" void kernel_launch(void* const* d_in, const int* in_sizes, int n_in, void* d_out, int out_size, void* d_ws, size_t ws_size, hipStream_t stream) {
    static int grid = 0;
    if (grid == 0) {
        if (n_in != 16 || in_sizes[0] != T * DM || out_size != T * DM || ws_size < WS_END) { fprintf(stderr, "kernel_launch: unexpected shapes (n_in %d, in0 %d, out %d, ws %zu); nothing launched\n", n_in, n_in > 0 ? in_sizes[0] : -1, out_size, ws_size); grid = -1; return; }
        int dev = 0, cus = 0, per_cu = 0;
        hipGetDevice(&dev); hipDeviceGetAttribute(&cus, hipDeviceAttributeMultiprocessorCount, dev);
        if (hipFuncSetAttribute((const void*)mega_fwd, hipFuncAttributeMaxDynamicSharedMemorySize, LDS_BYTES) != hipSuccess) { fprintf(stderr, "kernel_launch: hipFuncSetAttribute failed\n"); grid = -1; return; }
        if (hipOccupancyMaxActiveBlocksPerMultiprocessor(&per_cu, (const void*)mega_fwd, NTHREADS, LDS_BYTES) != hipSuccess || per_cu < 1) { fprintf(stderr, "kernel_launch: occupancy query gave %d\n", per_cu); per_cu = 1; }
        (void)hipGetLastError();
        grid = cus * 1;
    }
    if (grid < 0) return;
    Params p{};
    p.x = (const float*)d_in[0]; p.w_in = (const float*)d_in[1]; p.win_sink = (const float*)d_in[2]; p.mla_q_norm = (const float*)d_in[3]; p.mla_w_uq = (const float*)d_in[4];
    p.mla_kv_norm = (const float*)d_in[5]; p.mla_w_ukv = (const float*)d_in[6]; p.ax_q_norm = (const float*)d_in[7]; p.ax_k_norm = (const float*)d_in[8]; p.diff_lambda = (const float*)d_in[9];
    p.diff_subln = (const float*)d_in[10]; p.w_out = (const float*)d_in[11]; p.ffn_w_gu = (const float*)d_in[12]; p.ffn_w_down = (const float*)d_in[13]; p.ln_g = (const float*)d_in[14]; p.ln_b = (const float*)d_in[15];
    p.out = (float*)d_out; p.ws = (unsigned char*)d_ws;
    for (int l = 0; l < 4; ++l) p.lam_init[l] = (float)(0.8 - 0.6 * exp(-0.3 * (double)l));
    for (int i = 0; i < 16; ++i) p.inv32[i] = (float)pow(10000.0, -(double)i / 16.0);
    if (hipMemsetAsync((char*)d_ws + WS_CTL, 0, CTL_BYTES, stream) != hipSuccess) { fprintf(stderr, "kernel_launch: hipMemsetAsync of the control region failed\n"); return; }
    void* args[] = {&p};
    hipError_t e = hipLaunchCooperativeKernel((const void*)mega_fwd, dim3(grid), dim3(NTHREADS), args, LDS_BYTES, stream);
    if (e != hipSuccess) fprintf(stderr, "kernel_launch: cooperative launch failed: %s (grid %d)\n", hipGetErrorString(e), grid);
}
```

```cpp
#include <hip/hip_runtime.h>
#include <hip/hip_cooperative_groups.h>
#include <cstdio>
#include <cstdint>
#include <cmath>
namespace cg = cooperative_groups;
namespace pg8 {
#define PG8_LAS __attribute__((address_space(3)))
typedef unsigned short bf16_t;
typedef short bf16x8 __attribute__((ext_vector_type(8)));
typedef float f32x4 __attribute__((ext_vector_type(4)));
typedef unsigned u32x4 __attribute__((ext_vector_type(4)));
constexpr int BM = 256, BK = 64, HALF = 128, HTB = HALF * BK * 2  , STAGE_BYTES = 8 * HTB, NXCD = 8, WGM = 4;

__host__ __device__ __forceinline__ int lds_byte(int r, int c) { const int st = (r >> 4) * 2 + (c >> 5), rr = r & 15, cc = c & 31, ob = rr * 64 + cc * 2; return st * 1024 + (ob ^ (((ob >> 9) & 1) << 5)); }
__host__ __device__ __forceinline__ void stage_rc(int b, int& R, int& C) { const int st = b / 1024, sb = b % 1024, swz = sb ^ (((sb >> 9) & 1) << 5); R = (st >> 1) * 16 + swz / 64; C = (st & 1) * 32 + (swz % 64) / 2; }
__host__ __device__ __forceinline__ int perm32(int rho) { const int n = rho >> 4, i = rho & 15; return 8 * (i >> 2) + 4 * n + (i & 3); }

struct Unit { int pm, pn; };
struct Gemm { const bf16_t* A; const bf16_t* Bt; int M, N, K; };

struct StaticOrder {
    int nM, nN, nwg, G, c;
    __host__ __device__ void init(int M, int N, int G_, int c_) { nM = M / BM; nN = N / BM; nwg = nM * nN; G = G_; c = c_; }
    __host__ __device__ bool next(int i, Unit& u) const {
        const long L = (long)i * G + c; if (L >= nwg) return false;
        int wgid = (int)L; { const int q = nwg / NXCD, r = nwg % NXCD, xcd = wgid % NXCD, off = wgid / NXCD; wgid = (xcd < r ? xcd * (q + 1) : r * (q + 1) + (xcd - r) * q) + off; }
        const int nig = WGM * nN, gid = wgid / nig, fm = gid * WGM, gsz = (nM - fm) < WGM ? (nM - fm) : WGM;
        u.pm = fm + ((wgid % nig) % gsz); u.pn = (wgid % nig) / gsz; return true;
    }
    __device__ __forceinline__ void a_ready(const Unit&) const {}
    __device__ __forceinline__ void done(const Unit&) const {}
};

__device__ __forceinline__ unsigned cvt_pk_bf16(float lo, float hi) { unsigned r; asm volatile("v_cvt_pk_bf16_f32 %0, %1, %2" : "=v"(r) : "v"(lo), "v"(hi)); return r; }
typedef float f32x2 __attribute__((ext_vector_type(2)));
typedef float f32x2 __attribute__((ext_vector_type(2)));
typedef unsigned u32x2 __attribute__((ext_vector_type(2)));

struct EpiStoreBf16 {
    static constexpr bool PERM = true, AFTER_DRAIN = false;
    bf16_t* O; int ldc;
    __device__ __forceinline__ void operator()(const f32x4 (&acc)[2][2][4][2], const Unit& u, int wr, int wc, int fr, int fq) const {
        const int row0 = u.pm * BM + wr * 64 + fr; const int col0 = u.pn * BM + wc * 32 + 8 * fq;
#pragma unroll
        for (int ai = 0; ai < 2; ++ai)
#pragma unroll
            for (int m = 0; m < 4; ++m) { bf16_t* rowp = O + (size_t)(row0 + ai * HALF + m * 16) * ldc + col0;
#pragma unroll
                for (int bj = 0; bj < 2; ++bj) { const f32x4 v0 = acc[ai][bj][m][0], v1 = acc[ai][bj][m][1];
                    u32x4 w; w.x = cvt_pk_bf16(v0[0], v0[1]); w.y = cvt_pk_bf16(v0[2], v0[3]); w.z = cvt_pk_bf16(v1[0], v1[1]); w.w = cvt_pk_bf16(v1[2], v1[3]);
                    *(u32x4*)(rowp + bj * HALF) = w; } }
    }
};

__device__ __forceinline__ float silu_mul(float g, float u) {
    const float e = __builtin_amdgcn_exp2f(-1.4426950408889634f * g);
    return g * u * __builtin_amdgcn_rcpf(1.0f + e);
}
struct EpiSwiGLU {
    static constexpr bool PERM = true, AFTER_DRAIN = false;
    bf16_t* H; int ldh;
    __device__ __forceinline__ void operator()(const f32x4 (&acc)[2][2][4][2], const Unit& u, int wr, int wc, int fr, int fq) const {
        const int row0 = u.pm * BM + wr * 64 + fr; const int col0 = u.pn * HALF + wc * 32 + 8 * fq;
#pragma unroll
        for (int ai = 0; ai < 2; ++ai)
#pragma unroll
            for (int m = 0; m < 4; ++m) { bf16_t* rowp = H + (size_t)(row0 + ai * HALF + m * 16) * ldh + col0;
                const f32x4 g0 = acc[ai][0][m][0], g1 = acc[ai][0][m][1], u0 = acc[ai][1][m][0], u1 = acc[ai][1][m][1];
                u32x4 w;
                w.x = cvt_pk_bf16(silu_mul(g0[0], u0[0]), silu_mul(g0[1], u0[1])); w.y = cvt_pk_bf16(silu_mul(g0[2], u0[2]), silu_mul(g0[3], u0[3]));
                w.z = cvt_pk_bf16(silu_mul(g1[0], u1[0]), silu_mul(g1[1], u1[1])); w.w = cvt_pk_bf16(silu_mul(g1[2], u1[2]), silu_mul(g1[3], u1[3]));
                *(u32x4*)rowp = w; }
    }
};

struct EpiResid {
    static constexpr bool PERM = false, AFTER_DRAIN = false;
    const float* src; float* dst; int ld; float alpha, beta;
    __device__ __forceinline__ void operator()(const f32x4 (&acc)[2][2][4][2], const Unit& u, int wr, int wc, int fr, int fq) const {
        const int col0 = u.pn * BM + wc * 32 + 4 * fq;
#pragma unroll
        for (int ai = 0; ai < 2; ++ai)
#pragma unroll
            for (int m = 0; m < 4; ++m) { const size_t off = (size_t)(u.pm * BM + ai * HALF + wr * 64 + m * 16 + fr) * ld + col0;
#pragma unroll
                for (int bj = 0; bj < 2; ++bj)
#pragma unroll
                    for (int n = 0; n < 2; ++n) { const f32x4 s = *(const f32x4*)(src + off + bj * HALF + n * 16);
                        *(f32x4*)(dst + off + bj * HALF + n * 16) = s * alpha + acc[ai][bj][m][n] * beta; } }
    }
};

constexpr float LN_EPS_F = 1e-5f;
template <bool HAS> __device__ __forceinline__ void ln_row_stats(const float* st, int row, float& mu, float& rs) {
    if (!HAS) { mu = 0.f; rs = 1.f; return; }
    const f32x2 s = *(const f32x2*)(st + 2 * (size_t)row);
    mu = s.x * (1.0f / 1024.0f); const float var = fmaxf(s.y * (1.0f / 1024.0f) - mu * mu, 0.f); rs = 1.0f / sqrtf(var + LN_EPS_F);
}
struct EpiStoreBf16LN {
    static constexpr bool PERM = true, AFTER_DRAIN = false;
    bf16_t* O; int ldc; const float* st; const float* c1; const float* c2;
    __device__ __forceinline__ void operator()(const f32x4 (&acc)[2][2][4][2], const Unit& u, int wr, int wc, int fr, int fq) const {
        int row0 = u.pm * BM + wr * 64 + fr; int col0 = u.pn * BM + wc * 32 + 8 * fq;
        asm volatile("" : "+v"(row0), "+v"(col0));
        f32x4 c1v[2][2], c2v[2][2];
#pragma unroll
        for (int bj = 0; bj < 2; ++bj)
#pragma unroll
            for (int n = 0; n < 2; ++n) { c1v[bj][n] = *(const f32x4*)(c1 + col0 + bj * HALF + 4 * n); c2v[bj][n] = *(const f32x4*)(c2 + col0 + bj * HALF + 4 * n); }
#pragma unroll
        for (int ai = 0; ai < 2; ++ai)
#pragma unroll
            for (int m = 0; m < 4; ++m) { const int row = row0 + ai * HALF + m * 16; float mu, rs; ln_row_stats<true>(st, row, mu, rs);
                bf16_t* rowp = O + (size_t)row * ldc + col0;
#pragma unroll
                for (int bj = 0; bj < 2; ++bj) { const f32x4 v0 = (acc[ai][bj][m][0] - c1v[bj][0] * mu) * rs + c2v[bj][0], v1 = (acc[ai][bj][m][1] - c1v[bj][1] * mu) * rs + c2v[bj][1];
                    u32x4 w; w.x = cvt_pk_bf16(v0[0], v0[1]); w.y = cvt_pk_bf16(v0[2], v0[3]); w.z = cvt_pk_bf16(v1[0], v1[1]); w.w = cvt_pk_bf16(v1[2], v1[3]);
                    *(u32x4*)(rowp + bj * HALF) = w; } }
    }
};
template <bool HAS_LN> struct EpiSwiGLULN {
    static constexpr bool PERM = true, AFTER_DRAIN = false;
    bf16_t* H; int ldh; const float* st; const float* c1; const float* c2;
    __device__ __forceinline__ void operator()(const f32x4 (&acc)[2][2][4][2], const Unit& u, int wr, int wc, int fr, int fq) const {
        int row0 = u.pm * BM + wr * 64 + fr; const int col0 = u.pn * HALF + wc * 32 + 8 * fq; int wcol0 = u.pn * BM + wc * 32 + 8 * fq;
        asm volatile("" : "+v"(row0), "+v"(wcol0));
        f32x4 c1v[2][2], c2v[2][2];
#pragma unroll
        for (int bj = 0; bj < 2; ++bj)
#pragma unroll
            for (int n = 0; n < 2; ++n) { c1v[bj][n] = *(const f32x4*)(c1 + wcol0 + bj * HALF + 4 * n); c2v[bj][n] = *(const f32x4*)(c2 + wcol0 + bj * HALF + 4 * n); }
#pragma unroll
        for (int ai = 0; ai < 2; ++ai)
#pragma unroll
            for (int m = 0; m < 4; ++m) { const int row = row0 + ai * HALF + m * 16; float mu, rs; ln_row_stats<HAS_LN>(st, row, mu, rs);
                bf16_t* rowp = H + (size_t)row * ldh + col0;
                const f32x4 g0 = (acc[ai][0][m][0] - c1v[0][0] * mu) * rs + c2v[0][0], g1 = (acc[ai][0][m][1] - c1v[0][1] * mu) * rs + c2v[0][1];
                const f32x4 u0 = (acc[ai][1][m][0] - c1v[1][0] * mu) * rs + c2v[1][0], u1 = (acc[ai][1][m][1] - c1v[1][1] * mu) * rs + c2v[1][1];
                u32x4 w;
                w.x = cvt_pk_bf16(silu_mul(g0[0], u0[0]), silu_mul(g0[1], u0[1])); w.y = cvt_pk_bf16(silu_mul(g0[2], u0[2]), silu_mul(g0[3], u0[3]));
                w.z = cvt_pk_bf16(silu_mul(g1[0], u1[0]), silu_mul(g1[1], u1[1])); w.w = cvt_pk_bf16(silu_mul(g1[2], u1[2]), silu_mul(g1[3], u1[3]));
                *(u32x4*)rowp = w; }
    }
};
constexpr size_t EPI_WS_XB = (size_t)166 << 20, EPI_WS_STATS = ((size_t)568 << 20) + ((size_t)1 << 20); constexpr int EPI_T = 32768;
template <bool HAS_LN> struct EpiResidLN {
    static constexpr bool PERM = true, AFTER_DRAIN = false;
    static constexpr int ld = 1024;
    const float* src; float* dst; unsigned char* ws; const float* g_in; const float* b_in; int s_in; float alpha, beta;
    __device__ __forceinline__ void operator()(const f32x4 (&acc)[2][2][4][2], const Unit& u, int wr, int wc, int fr, int fq) const {
        int col0 = u.pn * BM + wc * 32 + 8 * fq; int rowb = u.pm * BM + wr * 64 + fr;
        asm volatile("" : "+v"(col0), "+v"(rowb));
        const float* rd = HAS_LN ? (const float*)dst : src;
        bf16_t* yb = (bf16_t*)(ws + EPI_WS_XB);
        const float* st_in = (const float*)(ws + EPI_WS_STATS) + (size_t)s_in * EPI_T * 2; float* st_out = (float*)(ws + EPI_WS_STATS) + (size_t)(s_in + 1) * EPI_T * 2;
        f32x4 gv[2][2], bv[2][2];
#pragma unroll
        for (int bj = 0; bj < 2; ++bj)
#pragma unroll
            for (int n = 0; n < 2; ++n) { if (HAS_LN) { gv[bj][n] = *(const f32x4*)(g_in + col0 + bj * HALF + 4 * n); bv[bj][n] = *(const f32x4*)(b_in + col0 + bj * HALF + 4 * n); }
                                          else { gv[bj][n] = (f32x4){1.f, 1.f, 1.f, 1.f}; bv[bj][n] = (f32x4){0.f, 0.f, 0.f, 0.f}; } }
#pragma unroll
        for (int ai = 0; ai < 2; ++ai)
#pragma unroll
            for (int m = 0; m < 4; ++m) { const int row = rowb + ai * HALF + m * 16; const size_t off = (size_t)row * ld + col0;
                float mu, rs; ln_row_stats<HAS_LN>(st_in, row, mu, rs);
                float ps = 0.f, pq = 0.f;
#pragma unroll
                for (int bj = 0; bj < 2; ++bj) { f32x4 yn[2];
#pragma unroll
                    for (int n = 0; n < 2; ++n) { const f32x4 y = *(const f32x4*)(rd + off + bj * HALF + 4 * n);
                        const f32x4 x = HAS_LN ? (y - mu) * rs * gv[bj][n] + bv[bj][n] : y;
                        yn[n] = x * alpha + acc[ai][bj][m][n] * beta;
                        *(f32x4*)(dst + off + bj * HALF + 4 * n) = yn[n];
                        ps += (yn[n][0] + yn[n][1]) + (yn[n][2] + yn[n][3]); pq += (yn[n][0] * yn[n][0] + yn[n][1] * yn[n][1]) + (yn[n][2] * yn[n][2] + yn[n][3] * yn[n][3]); }
                    u32x4 w; w.x = cvt_pk_bf16(yn[0][0], yn[0][1]); w.y = cvt_pk_bf16(yn[0][2], yn[0][3]); w.z = cvt_pk_bf16(yn[1][0], yn[1][1]); w.w = cvt_pk_bf16(yn[1][2], yn[1][3]);
                    *(u32x4*)(yb + off + bj * HALF) = w; }
                ps += __shfl_xor(ps, 16); ps += __shfl_xor(ps, 32); pq += __shfl_xor(pq, 16); pq += __shfl_xor(pq, 32);
                if (fq == 0) { atomicAdd(st_out + 2 * (size_t)row, ps); atomicAdd(st_out + 2 * (size_t)row + 1, pq); } }
    }
};
template <class Epi, class Sched, bool ALIGN_EPI = false, bool SP2 = false>
__device__ __forceinline__ void gemm_phase(PG8_LAS unsigned char* lds, const Gemm g, const Sched S, const Epi E) {
    int tid_ = threadIdx.x; asm volatile("" : "+v"(tid_));
    const int tid = tid_, wid = __builtin_amdgcn_readfirstlane(tid >> 6), lane = tid & 63, wr = wid >> 2, wc = wid & 3, fr = lane & 15, fq = lane >> 4;
    const int K = g.K, nt = K / BK;
    unsigned voffA[2], voffB[2];
#pragma unroll
    for (int i = 0; i < 2; ++i) { int R, C; stage_rc(tid * 16 + i * 8192, R, C); const int Rb = Epi::PERM ? ((R & ~31) + perm32(R & 31)) : R;
        voffA[i] = (unsigned)(R * K + C) * 2u; voffB[i] = (unsigned)(Rb * K + C) * 2u; }
    const size_t kstep = (size_t)(BK * 2);
    const size_t hstep = (size_t)HALF * K * 2;
    const size_t tstep = 2 * hstep;
    const unsigned ldsw = (unsigned)wid * 1024u;
    const int aoff = lds_byte(wr * 64 + fr, fq * 8), boff = lds_byte(wc * 32 + fr, fq * 8);
#define PG8_SA(b, h) (((b) * 2 + (h)) * HTB)
#define PG8_SB(b, h) ((4 + (b) * 2 + (h)) * HTB)
#define PG8_STAGE(bufoff, gbase, voff) do { _Pragma("unroll") for (int _i = 0; _i < 2; ++_i) \
        __builtin_amdgcn_global_load_lds((const unsigned*)((const char*)(gbase) + (voff)[_i]), (PG8_LAS unsigned*)(lds + (bufoff) + ldsw + _i * 8192), 16, 0, 0); } while (0)
#define PG8_LDA(dst, b, h) do { _Pragma("unroll") for (int m = 0; m < 4; ++m) _Pragma("unroll") for (int k = 0; k < 2; ++k) dst[m][k] = *(const PG8_LAS bf16x8*)(lds + PG8_SA(b, h) + aoff + m * 2048 + k * 1024); } while (0)
#define PG8_LDB(dst, b, h) do { _Pragma("unroll") for (int n = 0; n < 2; ++n) _Pragma("unroll") for (int k = 0; k < 2; ++k) dst[n][k] = *(const PG8_LAS bf16x8*)(lds + PG8_SB(b, h) + boff + n * 2048 + k * 1024); } while (0)
#define PG8_MMA(ai, bj, At, Bt) do { __builtin_amdgcn_s_setprio(1); _Pragma("unroll") for (int m = 0; m < 4; ++m) _Pragma("unroll") for (int n = 0; n < 2; ++n) _Pragma("unroll") for (int k = 0; k < 2; ++k) \
        acc[ai][bj][m][n] = __builtin_amdgcn_mfma_f32_16x16x32_bf16(Bt[n][k], At[m][k], acc[ai][bj][m][n], 0, 0, 0); __builtin_amdgcn_s_setprio(0); } while (0)
#define PG8_WAIT_V(n) asm volatile("s_waitcnt vmcnt(" #n ")" ::: "memory")
#define PG8_WAIT_L(n) asm volatile("s_waitcnt lgkmcnt(" #n ")" ::: "memory")
#define PG8_BAR __builtin_amdgcn_s_barrier()
#define PG8_SCHED __builtin_amdgcn_sched_barrier(0)
    Unit cur, nxt; int ui = 0;
    if (!S.next(0, cur)) return;
    f32x4 acc[2][2][4][2];
#pragma unroll
    for (int a = 0; a < 2; ++a)
#pragma unroll
        for (int b = 0; b < 2; ++b)
#pragma unroll
            for (int m = 0; m < 4; ++m)
#pragma unroll
                for (int n = 0; n < 2; ++n) acc[a][b][m][n] = (f32x4){0.f, 0.f, 0.f, 0.f};
    bf16x8 At[4][2], B0[2][2], B1[2][2];
    const char* cA = (const char*)g.A + (size_t)cur.pm * tstep; const char* cB = (const char*)g.Bt + (size_t)cur.pn * tstep;
    S.a_ready(cur);
    if constexpr (SP2) {
        PG8_STAGE(PG8_SB(0, 0), cB, voffB); PG8_STAGE(PG8_SB(0, 1), cB + hstep, voffB); PG8_STAGE(PG8_SA(0, 0), cA, voffA); PG8_STAGE(PG8_SA(0, 1), cA + hstep, voffA);
        if (wr == 1) PG8_BAR;
        PG8_WAIT_V(2); PG8_BAR;
        PG8_STAGE(PG8_SB(1, 0), cB + kstep, voffB); PG8_STAGE(PG8_SA(1, 0), cA + kstep, voffA); PG8_STAGE(PG8_SB(1, 1), cB + hstep + kstep, voffB);
        PG8_WAIT_V(6); PG8_BAR;
    } else {
        PG8_STAGE(PG8_SB(0, 0), cB, voffB); PG8_STAGE(PG8_SA(0, 0), cA, voffA); PG8_STAGE(PG8_SB(0, 1), cB + hstep, voffB); PG8_STAGE(PG8_SA(0, 1), cA + hstep, voffA);
        if (wr == 1) PG8_BAR;
        PG8_WAIT_V(4); PG8_BAR;
        PG8_STAGE(PG8_SB(1, 0), cB + kstep, voffB); PG8_STAGE(PG8_SA(1, 0), cA + kstep, voffA); PG8_STAGE(PG8_SB(1, 1), cB + hstep + kstep, voffB);
        PG8_WAIT_V(6); PG8_BAR;
    }
    for (;;) {
        const bool has_next = S.next(ui + 1, nxt);
        const char* nA = has_next ? (const char*)g.A + (size_t)nxt.pm * tstep : cA; const char* nB = has_next ? (const char*)g.Bt + (size_t)nxt.pn * tstep : cB;
        for (int t = 0; t < nt; t += 2) {
            const bool last = (t == nt - 2);
            const char* a1 = cA + (size_t)(t + 1) * kstep;
            const char* a2 = last ? nA : cA + (size_t)(t + 2) * kstep; const char* b2 = last ? nB : cB + (size_t)(t + 2) * kstep;
            const char* a3 = a2 + kstep; const char* b3 = b2 + kstep;
            if (last && has_next) S.a_ready(nxt);
            if constexpr (SP2) {
            PG8_LDB(B0, 0, 0); PG8_LDB(B1, 0, 1); PG8_SCHED; PG8_LDA(At, 0, 0); PG8_STAGE(PG8_SA(1, 1), a1 + hstep, voffA);
            PG8_WAIT_V(8); PG8_WAIT_L(0); PG8_BAR; PG8_MMA(0, 0, At, B0); PG8_MMA(0, 1, At, B1); PG8_BAR; PG8_SCHED;
            PG8_LDA(At, 0, 1); PG8_STAGE(PG8_SB(0, 0), b2, voffB); PG8_STAGE(PG8_SB(0, 1), b2 + hstep, voffB); PG8_STAGE(PG8_SA(0, 0), a2, voffA);
            PG8_WAIT_V(8); PG8_WAIT_L(0); PG8_BAR; PG8_MMA(1, 0, At, B0); PG8_MMA(1, 1, At, B1); PG8_BAR; PG8_SCHED;
            PG8_LDB(B0, 1, 0); PG8_LDB(B1, 1, 1); PG8_SCHED; PG8_LDA(At, 1, 0); PG8_STAGE(PG8_SA(0, 1), a2 + hstep, voffA);
            PG8_WAIT_V(8); PG8_WAIT_L(0); PG8_BAR; PG8_MMA(0, 0, At, B0); PG8_MMA(0, 1, At, B1); PG8_BAR; PG8_SCHED;
            PG8_LDA(At, 1, 1); PG8_STAGE(PG8_SB(1, 0), b3, voffB); PG8_STAGE(PG8_SB(1, 1), b3 + hstep, voffB); PG8_STAGE(PG8_SA(1, 0), a3, voffA);
            PG8_WAIT_V(8); PG8_WAIT_L(0); PG8_BAR; PG8_MMA(1, 0, At, B0); PG8_MMA(1, 1, At, B1); PG8_BAR; PG8_SCHED;
            } else {
            PG8_LDB(B0, 0, 0); PG8_SCHED; PG8_LDA(At, 0, 0); PG8_STAGE(PG8_SA(1, 1), a1 + hstep, voffA);
            PG8_WAIT_L(8); PG8_BAR; PG8_WAIT_L(0); PG8_MMA(0, 0, At, B0); PG8_BAR; PG8_SCHED;
            PG8_LDB(B1, 0, 1); PG8_STAGE(PG8_SB(0, 0), b2, voffB);
            PG8_BAR; PG8_WAIT_L(0); PG8_MMA(0, 1, At, B1); PG8_BAR;
            PG8_LDA(At, 0, 1); PG8_STAGE(PG8_SA(0, 0), a2, voffA);
            PG8_BAR; PG8_WAIT_L(0); PG8_MMA(1, 0, At, B0); PG8_BAR; PG8_SCHED;
            PG8_STAGE(PG8_SB(0, 1), b2 + hstep, voffB);
            PG8_WAIT_V(6); PG8_BAR; PG8_MMA(1, 1, At, B1); PG8_BAR;
            PG8_LDB(B0, 1, 0); PG8_SCHED; PG8_LDA(At, 1, 0); PG8_STAGE(PG8_SA(0, 1), a2 + hstep, voffA);
            PG8_WAIT_L(8); PG8_BAR; PG8_WAIT_L(0); PG8_MMA(0, 0, At, B0); PG8_BAR; PG8_SCHED;
            PG8_LDB(B1, 1, 1); PG8_STAGE(PG8_SB(1, 0), b3, voffB);
            PG8_BAR; PG8_WAIT_L(0); PG8_MMA(0, 1, At, B1); PG8_BAR;
            PG8_LDA(At, 1, 1); PG8_STAGE(PG8_SA(1, 0), a3, voffA);
            PG8_BAR; PG8_WAIT_L(0); PG8_MMA(1, 0, At, B0); PG8_BAR; PG8_SCHED;
            PG8_STAGE(PG8_SB(1, 1), b3 + hstep, voffB);
            PG8_WAIT_V(6); PG8_BAR; PG8_MMA(1, 1, At, B1); PG8_BAR;
            }
        }
        if constexpr (ALIGN_EPI) { if (wr == 0) PG8_BAR; }
        if constexpr (!Epi::AFTER_DRAIN) { E(acc, cur, wr, wc, fr, fq); S.done(cur); }
        if (!has_next) break;
#pragma unroll
        for (int a = 0; a < 2; ++a)
#pragma unroll
            for (int b = 0; b < 2; ++b)
#pragma unroll
                for (int m = 0; m < 4; ++m)
#pragma unroll
                    for (int n = 0; n < 2; ++n) acc[a][b][m][n] = (f32x4){0.f, 0.f, 0.f, 0.f};
        cur = nxt; cA = nA; cB = nB; ++ui;
        if constexpr (ALIGN_EPI) { if (wr == 1) PG8_BAR; }
    }
    PG8_WAIT_V(0);
    if constexpr (!ALIGN_EPI) { if (wr == 0) PG8_BAR; }
    PG8_BAR;
    if constexpr (Epi::AFTER_DRAIN) { E.fused(acc, cur, wr, wc, fr, fq, lds, wid, lane); S.done(cur); }
#undef PG8_SA
#undef PG8_SB
#undef PG8_STAGE
#undef PG8_LDA
#undef PG8_LDB
#undef PG8_MMA
#undef PG8_WAIT_V
#undef PG8_WAIT_L
#undef PG8_BAR
#undef PG8_SCHED
}
}
#define LAS __attribute__((address_space(3)))
typedef unsigned short bf16_t;
typedef short bf16x8 __attribute__((ext_vector_type(8)));
typedef short s16x4 __attribute__((ext_vector_type(4)));
typedef float f32x4 __attribute__((ext_vector_type(4)));
typedef float f32x16 __attribute__((ext_vector_type(16)));
typedef unsigned u32x4 __attribute__((ext_vector_type(4)));
typedef unsigned u32x2 __attribute__((ext_vector_type(2)));
typedef float f32x2_t __attribute__((ext_vector_type(2)));
typedef __bf16 bf16x2_t __attribute__((ext_vector_type(2)));

constexpr int NB = 2, SEQ = 16384, T = NB * SEQ, DM = 1024, DEPTH = 4, DFF = 2816, NGU = 2 * DFF;
constexpr int NIN_SRC = 2208, NPROJ = 3328;
constexpr int PA = 0, PC = 512, PD = 1024, PCQ = 1792, PCKV = 2048, PKR = 2176, PQUP = 2208, PKVUP = 2592, PEND = 3104;
constexpr float LOG2E = 1.4426950408889634f;
constexpr float NORM_EPS = 1e-5f;
constexpr int NWAVES = 8, NTHREADS = 512;
constexpr int LDS_BYTES = 147456;

constexpr size_t MiB = 1u << 20;
constexpr size_t WS_WGU = 0, WS_WD = 88 * MiB, WS_WIN = 132 * MiB, WS_WOUT = 158 * MiB, WS_XB = 166 * MiB;
constexpr size_t WS_H = 230 * MiB, WS_PROJ = 230 * MiB, WS_QB = 438 * MiB, WS_KB = 462 * MiB, WS_VB = 486 * MiB, WS_MIX = 502 * MiB, WS_AUG = 566 * MiB, WS_CTL = 568 * MiB, WS_KMAX = WS_CTL, WS_C12 = WS_CTL + 4096, WS_BAR = WS_CTL + 512 * 1024, WS_STATS = WS_CTL + 1 * MiB, CTL_BYTES = 4 * MiB, WS_END = 572 * MiB;
constexpr int C12_L = 2 * NGU + NPROJ;
constexpr size_t C2_OFF = (size_t)DEPTH * C12_L;
static_assert(pg8::EPI_WS_XB == WS_XB && pg8::EPI_WS_STATS == WS_STATS && pg8::EPI_T == T, "part1's copies of the workspace map");
static_assert(WS_C12 + 2 * C2_OFF * 4 <= WS_BAR && WS_BAR + 3456 * 4 <= WS_STATS, "control region");
static_assert(WS_C12 + 2 * C2_OFF * 4 <= WS_STATS && WS_STATS + (size_t)12 * T * 8 <= WS_CTL + CTL_BYTES, "control region");
constexpr size_t WGU_L = (size_t)2 * NGU * DM, WGU_F = (size_t)NGU * DM;
constexpr size_t WD_L = (size_t)2 * DM * DFF, WD_F = (size_t)DM * DFF;
constexpr size_t WIN_L = (size_t)NPROJ * DM, WOUT_L = (size_t)DM * DM;

struct Params {
    const float* x; const float* w_in; const float* win_sink; const float* mla_q_norm; const float* mla_w_uq; const float* mla_kv_norm; const float* mla_w_ukv;
    const float* ax_q_norm; const float* ax_k_norm; const float* diff_lambda; const float* diff_subln; const float* w_out; const float* ffn_w_gu; const float* ffn_w_down;
    const float* ln_g; const float* ln_b;
    float* out; unsigned char* ws;
    float lam_init[4];
    float inv32[16];
};

typedef const __attribute__((address_space(4))) Params* KP;
#define GETP(name) KP name = (KP)__builtin_amdgcn_kernarg_segment_ptr(); asm volatile("" : "+s"(name))

__device__ __forceinline__ int tid_fresh() { int t = threadIdx.x; asm volatile("" : "+v"(t)); return t; }
__device__ __forceinline__ unsigned pkbf(float lo, float hi) { f32x2_t v = {lo, hi}; bf16x2_t b = __builtin_convertvector(v, bf16x2_t); return __builtin_bit_cast(unsigned, b); }
__device__ __forceinline__ float bflo(unsigned w) { return __builtin_bit_cast(float, w << 16); }
__device__ __forceinline__ float bfhi(unsigned w) { return __builtin_bit_cast(float, w & 0xffff0000u); }
__device__ __forceinline__ float wave_sum(float v) {
#pragma unroll
    for (int o = 1; o < 64; o <<= 1) v += __shfl_xor(v, o);
    return v;
}
__device__ __forceinline__ void unpack8(const u32x4 w, float (&v)[8]) {
    v[0] = bflo(w.x); v[1] = bfhi(w.x); v[2] = bflo(w.y); v[3] = bfhi(w.y); v[4] = bflo(w.z); v[5] = bfhi(w.z); v[6] = bflo(w.w); v[7] = bfhi(w.w);
}
__device__ __forceinline__ u32x4 pack8(const float (&v)[8]) { u32x4 w; w.x = pkbf(v[0], v[1]); w.y = pkbf(v[2], v[3]); w.z = pkbf(v[4], v[5]); w.w = pkbf(v[6], v[7]); return w; }

__device__ __forceinline__ void transpose_item(const float* __restrict__ W, int ldw, int src_col0, float scale, bf16_t* __restrict__ WT, int K, int dst_row0, int k0, LAS float* scr, int lane,
                                               const float* __restrict__ lng, const float* __restrict__ lnb, float* c1, float* c2) {
    if (src_col0 < 0) {
        const int c = lane & 7;
#pragma unroll
        for (int j = 0; j < 4; ++j) { const int n = (lane >> 3) + 8 * j; *(u32x4*)(WT + (size_t)(dst_row0 + n) * K + k0 + 8 * c) = (u32x4){0u, 0u, 0u, 0u}; }
        return;
    }
    float a1 = 0.f, a2 = 0.f;
#pragma unroll
    for (int i = 0; i < 32; ++i) { const int kk = 2 * i + (lane >> 5); float w = W[(size_t)(k0 + kk) * ldw + src_col0 + (lane & 31)] * scale;
        if (lng) { a2 = fmaf(lnb[k0 + kk], w, a2); w *= lng[k0 + kk]; a1 += bflo(pkbf(w, 0.f)); }
        scr[kk * 33 + (lane & 31)] = w; }
    asm volatile("s_waitcnt lgkmcnt(0)" ::: "memory");
    const int c = lane & 7;
#pragma unroll
    for (int j = 0; j < 4; ++j) { const int n = (lane >> 3) + 8 * j; const LAS float* s = scr + (8 * c) * 33 + n;
        u32x4 o; o.x = pkbf(s[0 * 33], s[1 * 33]); o.y = pkbf(s[2 * 33], s[3 * 33]); o.z = pkbf(s[4 * 33], s[5 * 33]); o.w = pkbf(s[6 * 33], s[7 * 33]);
        *(u32x4*)(WT + (size_t)(dst_row0 + n) * K + k0 + 8 * c) = o; }
    asm volatile("s_waitcnt lgkmcnt(0)" ::: "memory");
    if (lng) { a1 += __shfl_xor(a1, 32); a2 += __shfl_xor(a2, 32);
        if (lane < 32) { atomicAdd(c1 + dst_row0 + lane, a1); atomicAdd(c2 + dst_row0 + lane, a2); } }
}

__device__ __forceinline__ void phase0(KP p, LAS unsigned char* lds, int vcu, int G) {
    const int tid = tid_fresh(), lane = tid & 63, wave = __builtin_amdgcn_readfirstlane(tid >> 6);
    LAS float* scr = (LAS float*)(lds + wave * 16384);
    const int gw = vcu * NWAVES + wave, NGW = G * NWAVES;
    bf16_t* wgu = (bf16_t*)(p->ws + WS_WGU); bf16_t* wd = (bf16_t*)(p->ws + WS_WD); bf16_t* win = (bf16_t*)(p->ws + WS_WIN); bf16_t* wout = (bf16_t*)(p->ws + WS_WOUT);
    float* c12 = (float*)(p->ws + WS_C12);
    constexpr int I_GU = 176 * 16, I_WD = 32 * 44, I_IN = 104 * 16, I_OUT = 32 * 16, I_CMP = 128 * 14;
    constexpr int I_LAYER = 2 * I_GU + 2 * I_WD + I_IN + I_OUT + I_CMP;
    for (int it = gw; it < DEPTH * I_LAYER; it += NGW) {
        const int l = it / I_LAYER; int r = it % I_LAYER;
        if (r < 2 * I_GU) { const int f = r / I_GU; r %= I_GU; const int nb = r / 16, kb = r % 16; const int n0 = 32 * nb;
            const int pn = n0 >> 8, bj = (n0 >> 7) & 1, i0 = n0 & 127;
            const int s = 3 * l + 2 * f - 1;
            transpose_item(p->ffn_w_gu + ((size_t)l * 2 + f) * DM * NGU, NGU, bj * DFF + 128 * pn + i0, 1.f, wgu + l * WGU_L + f * WGU_F, DM, n0, 64 * kb, scr, lane,
                           s >= 0 ? p->ln_g + s * DM : nullptr, s >= 0 ? p->ln_b + s * DM : nullptr, c12 + l * C12_L + f * NGU, c12 + C2_OFF + l * C12_L + f * NGU); continue; }
        r -= 2 * I_GU;
        if (r < 2 * I_WD) { const int f = r / I_WD; r %= I_WD; const int nb = r / 44, kb = r % 44;
            transpose_item(p->ffn_w_down + ((size_t)l * 2 + f) * DFF * DM, DM, 32 * nb, 1.f, wd + l * WD_L + f * WD_F, DFF, 32 * nb, 64 * kb, scr, lane, nullptr, nullptr, nullptr, nullptr); continue; }
        r -= 2 * I_WD;
        if (r < I_IN) { const int nb = r / 16, kb = r % 16; const int n0 = 32 * nb; int src; float sc = 1.f;
            if (n0 < PC) { src = n0; if (n0 < 256) sc = 0.125f; }
            else if (n0 < PD) src = 928 + (n0 - PC);
            else if (n0 < PCQ) { src = 1440 + (n0 - PD); if (n0 - PD < 256) sc = 0.17677669529663687f; }
            else if (n0 < PCKV) src = 512 + (n0 - PCQ);
            else if (n0 < PKR) src = 768 + (n0 - PCKV);
            else if (n0 < PQUP) src = 896;
            else if (n0 < PEND) continue;
            else src = -1;
            transpose_item(p->w_in + (size_t)l * DM * NIN_SRC, NIN_SRC, src, sc, win + l * WIN_L, DM, n0, 64 * kb, scr, lane,
                           p->ln_g + (3 * l) * DM, p->ln_b + (3 * l) * DM, c12 + l * C12_L + 2 * NGU, c12 + C2_OFF + l * C12_L + 2 * NGU); continue; }
        r -= I_IN;
        if (r < I_OUT) { const int nb = r / 16, kb = r % 16;
            transpose_item(p->w_out + (size_t)l * DM * DM, DM, 32 * nb, 1.f, wout + l * WOUT_L, DM, 32 * nb, 64 * kb, scr, lane, nullptr, nullptr, nullptr, nullptr); continue; }
        r -= I_OUT;
        {
            const int kb8 = r / 14, ng = r % 14; const int k0 = 8 * kb8;
            int J, cA, ldu, nc; const float* g; const float* U;
            if (ng < 6) { J = 256; cA = 512; g = p->mla_q_norm + l * 256; U = p->mla_w_uq + (size_t)l * 256 * 384; ldu = 384; nc = 64 * ng; }
            else { J = 128; cA = 768; g = p->mla_kv_norm + l * 128; U = p->mla_w_ukv + (size_t)l * 128 * 512; ldu = 512; nc = 64 * (ng - 6); }
            const int nglob = (ng < 6 ? 0 : 384) + nc + lane;
            const float* a = p->w_in + (size_t)l * DM * NIN_SRC + (size_t)k0 * NIN_SRC + cA;
            const float* up = U + nc + lane;
            float acc[8];
#pragma unroll
            for (int e = 0; e < 8; ++e) acc[e] = 0.f;
#pragma unroll 4
            for (int j = 0; j < J; ++j) { const float u = up[(size_t)j * ldu] * g[j];
#pragma unroll
                for (int e = 0; e < 8; ++e) acc[e] = fmaf(a[(size_t)e * NIN_SRC + j], u, acc[e]); }
            const float* lg = p->ln_g + (3 * l) * DM + k0; const float* lb = p->ln_b + (3 * l) * DM + k0;
            float s1 = 0.f, s2 = 0.f; unsigned wb[8];
#pragma unroll
            for (int e = 0; e < 8; ++e) { wb[e] = pkbf(acc[e] * lg[e], 0.f) & 0xffffu; s1 += bflo(wb[e]); s2 = fmaf(acc[e], lb[e], s2); }
            u32x4 o; o.x = wb[0] | (wb[1] << 16); o.y = wb[2] | (wb[3] << 16); o.z = wb[4] | (wb[5] << 16); o.w = wb[6] | (wb[7] << 16);
            *(u32x4*)(win + l * WIN_L + (size_t)(PQUP + nglob) * DM + k0) = o;
            atomicAdd(c12 + l * C12_L + 2 * NGU + PQUP + nglob, s1); atomicAdd(c12 + C2_OFF + l * C12_L + 2 * NGU + PQUP + nglob, s2);
        }
    }
    { u32x4* ag = (u32x4*)(p->ws + WS_AUG);
      for (int i = (vcu * NWAVES + wave) * 64 + lane; i < SEQ * 4; i += G * NWAVES * 64) { const int t = i >> 2, h = i & 3;
          const float sl = __builtin_amdgcn_exp2f(-(float)(5 + h));
          u32x4 w = {pkbf(sl * (float)(128 * (t >> 7)), sl * (float)(t & 127)), 0u, 0u, 0u}; ag[2 * i] = w; ag[2 * i + 1] = (u32x4){0u, 0u, 0u, 0u}; } }
    bf16_t* xb = (bf16_t*)(p->ws + WS_XB);
    for (int m = gw; m < T; m += NGW) {
        const f32x4* xr = (const f32x4*)(p->x + (size_t)m * DM) + lane; u32x2* o8 = (u32x2*)(xb + (size_t)m * DM) + lane;
#pragma unroll
        for (int j = 0; j < 4; ++j) { const f32x4 v = xr[64 * j]; u32x2 w; w.x = pkbf(v.x, v.y); w.y = pkbf(v.z, v.w); o8[64 * j] = w; }
    }
}

template <bool WRITE_XB> __device__ __forceinline__ void ln_phase(float* X, bf16_t* xb, const float* __restrict__ g, const float* __restrict__ b, int vcu, int G) {
    const int tid = tid_fresh(), lane = tid & 63, wave = __builtin_amdgcn_readfirstlane(tid >> 6);
    const int gw = vcu * NWAVES + wave, NGW = G * NWAVES;
    f32x4 gv[4], bv[4];
#pragma unroll
    for (int j = 0; j < 4; ++j) { gv[j] = ((const f32x4*)g)[64 * j + lane]; bv[j] = ((const f32x4*)b)[64 * j + lane]; }
    for (int m = gw; m < T; m += NGW) {
        f32x4* xr = (f32x4*)(X + (size_t)m * DM) + lane; u32x2* o8 = (u32x2*)(xb + (size_t)m * DM) + lane;
        f32x4 v[4]; float s = 0.f;
#pragma unroll
        for (int j = 0; j < 4; ++j) { v[j] = xr[64 * j]; s += (v[j].x + v[j].y) + (v[j].z + v[j].w); }
        const float mean = wave_sum(s) * (1.f / DM); float s2 = 0.f;
#pragma unroll
        for (int j = 0; j < 4; ++j) { v[j] = v[j] - mean; s2 += (v[j].x * v[j].x + v[j].y * v[j].y) + (v[j].z * v[j].z + v[j].w * v[j].w); }
        const float rstd = 1.f / sqrtf(wave_sum(s2) * (1.f / DM) + NORM_EPS);
#pragma unroll
        for (int j = 0; j < 4; ++j) { const f32x4 y = v[j] * rstd * gv[j] + bv[j]; xr[64 * j] = y; if (WRITE_XB) { u32x2 w; w.x = pkbf(y.x, y.y); w.y = pkbf(y.z, y.w); o8[64 * j] = w; } }
    }
}

__device__ __forceinline__ void sincos_rev(float ang, float& s, float& c) {
    double d = (double)ang * 0.15915494309189535; d -= __builtin_rint(d); const float f = (float)d;
    s = __builtin_amdgcn_sinf(f); c = __builtin_amdgcn_cosf(f);
}
__device__ __forceinline__ void rope8(float (&v)[8], bool first, float pos, int i0, KP p) {
#pragma unroll
    for (int e = 0; e < 8; ++e) {
        const float other = __shfl_xor(v[e], 2);
        const float inv = i0 ? p->inv32[8 + e] : p->inv32[e];
        float s, c; sincos_rev(pos * inv, s, c);
        v[e] = first ? (v[e] * c - other * s) : (other * s + v[e] * c);
    }
}
__device__ __forceinline__ void prep_phase(KP p, int l, int vcu, int G) {
    const int tid = tid_fresh(), lane = tid & 63, wave = __builtin_amdgcn_readfirstlane(tid >> 6);
    const int gw = vcu * NWAVES + wave, NGW = G * NWAVES;
    bf16_t* proj = (bf16_t*)(p->ws + WS_PROJ); bf16_t* qb = (bf16_t*)(p->ws + WS_QB); bf16_t* kb = (bf16_t*)(p->ws + WS_KB); bf16_t* vb = (bf16_t*)(p->ws + WS_VB);
    float cg[8];
    { const float* gsrc = (lane < 32 ? p->ax_q_norm : p->ax_k_norm) + l * 64 + 8 * (lane & 7);
#pragma unroll
      for (int e = 0; e < 8; ++e) cg[e] = gsrc[e]; }
    float km0 = 0.f, km1 = 0.f;
    float kb0 = 0.f, kb1 = 0.f, kc0 = 0.f, kc1 = 0.f;
    for (int tok = gw; tok < T; tok += NGW) {
        const int t = tok & (SEQ - 1);
        bf16_t* pr = proj + (size_t)tok * NPROJ;
        const int l48 = lane < 48 ? lane : 0, l32 = lane < 32 ? lane : 0, l4 = lane < 4 ? lane : 0;
        const u32x4 in_cq = *(const u32x4*)(pr + PCQ + 8 * l48), in_qup = *(const u32x4*)(pr + PQUP + 8 * l48), in_kv = *(const u32x4*)(pr + PKVUP + 8 * lane);
        const u32x4 in_kr = *(const u32x4*)(pr + PKR + 8 * l4), in_c = *(const u32x4*)(pr + PC + 8 * l48), in_dk = *(const u32x4*)(pr + PD + 256 + 8 * l32);
        { float s = 0.f;
          if (lane < 32) { float v[8]; unpack8(in_dk, v);
#pragma unroll
              for (int e = 0; e < 8; ++e) s += v[e] * v[e]; }
          s += __shfl_xor(s, 1); s += __shfl_xor(s, 2);
          if (tok < SEQ) km0 = fmaxf(km0, s); else km1 = fmaxf(km1, s); }
        float ssq = 0.f;
        if (lane < 48) { float v[8]; unpack8(in_cq, v);
#pragma unroll
            for (int e = 0; e < 8; ++e) ssq += v[e] * v[e]; }
        const float ssq_q = wave_sum(lane < 32 ? ssq : 0.f), ssq_kv = wave_sum(lane >= 32 ? ssq : 0.f);
        const float rstd_q = 1.f / sqrtf(ssq_q * (1.f / 256.f) + NORM_EPS), rstd_kv = 1.f / sqrtf(ssq_kv * (1.f / 128.f) + NORM_EPS);
        {
            const int r = lane % 12; float v[8];
            unpack8(in_qup, v);
#pragma unroll
            for (int e = 0; e < 8; ++e) v[e] = (lane < 48) ? v[e] * rstd_q : 0.f;
            float w[8];
#pragma unroll
            for (int e = 0; e < 8; ++e) w[e] = v[e];
            rope8(w, r < 10, (float)t, 8 * (r & 1), p);
            const bool isr = (r >= 8); const float qs = 0.10206207261596575f;
#pragma unroll
            for (int e = 0; e < 8; ++e) v[e] = (isr ? w[e] : v[e]) * qs;
            if (lane < 48) *(u32x4*)(qb + (size_t)tok * 384 + 8 * lane) = pack8(v);
        }
        float nope2;
        {
            float v[8]; unpack8(in_kv, v);
#pragma unroll
            for (int e = 0; e < 8; ++e) v[e] *= rstd_kv;
            const int hd = lane >> 4, r = lane & 15;
            { float s = 0.f;
#pragma unroll
              for (int e = 0; e < 8; ++e) s += v[e] * v[e];
              s = (r < 8) ? s : 0.f; s += __shfl_xor(s, 1); s += __shfl_xor(s, 2); s += __shfl_xor(s, 4); nope2 = s; }
            if (r < 8) *(u32x4*)(kb + (size_t)tok * 384 + hd * 96 + 8 * r) = pack8(v);
            else *(u32x4*)(vb + (size_t)tok * 256 + hd * 64 + 8 * (r - 8)) = pack8(v);
        }
        {
            float v[8]; unpack8(in_kr, v);
            rope8(v, (lane & 3) < 2, (float)t, 8 * (lane & 1), p);
            { float s = 0.f;
#pragma unroll
              for (int e = 0; e < 8; ++e) s += v[e] * v[e];
              s = (lane < 4) ? s : 0.f; s += __shfl_xor(s, 1); s += __shfl_xor(s, 2);
              const float kk = nope2 + __shfl(s, 0);
              if (tok < SEQ) kb0 = fmaxf(kb0, kk); else kb1 = fmaxf(kb1, kk); }
            if (lane < 4) { const u32x4 w = pack8(v);
#pragma unroll
                for (int hd = 0; hd < 4; ++hd) *(u32x4*)(kb + (size_t)tok * 384 + hd * 96 + 64 + 8 * lane) = w; }
        }
        {
            float v[8]; unpack8(in_c, v);
            float s = 0.f;
#pragma unroll
            for (int e = 0; e < 8; ++e) s += v[e] * v[e];
            s += __shfl_xor(s, 1); s += __shfl_xor(s, 2); s += __shfl_xor(s, 4);
            const float rs = 1.f / sqrtf(s * (1.f / 64.f) + NORM_EPS);
#pragma unroll
            for (int e = 0; e < 8; ++e) v[e] = v[e] * rs * cg[e];
            const int r = lane & 7; const float pos = (r < 4) ? (float)(t >> 6) : (float)(t & 63);
            rope8(v, (r & 3) < 2, pos, 8 * (r & 1), p);
            { float s2 = 0.f;
#pragma unroll
              for (int e = 0; e < 8; ++e) s2 += v[e] * v[e];
              s2 += __shfl_xor(s2, 1); s2 += __shfl_xor(s2, 2); s2 += __shfl_xor(s2, 4);
              if (tok < SEQ) kc0 = fmaxf(kc0, s2); else kc1 = fmaxf(kc1, s2); }
            if (lane < 32) {
#pragma unroll
                for (int e = 0; e < 8; ++e) v[e] *= 0.125f; }
            if (lane < 48) *(u32x4*)(pr + PC + 8 * lane) = pack8(v);
        }
    }
    unsigned* kmw = (unsigned*)(p->ws + WS_KMAX) + l * 32;
    if (lane < 32 && (lane & 3) == 0) { atomicMax(kmw + (lane >> 2), __builtin_bit_cast(unsigned, km0)); atomicMax(kmw + 8 + (lane >> 2), __builtin_bit_cast(unsigned, km1)); }
    if ((lane & 15) == 0) { atomicMax(kmw + 16 + (lane >> 4), __builtin_bit_cast(unsigned, kb0)); atomicMax(kmw + 20 + (lane >> 4), __builtin_bit_cast(unsigned, kb1)); }
    if (lane == 32 || lane == 40) { atomicMax(kmw + 24 + ((lane - 32) >> 3), __builtin_bit_cast(unsigned, kc0)); atomicMax(kmw + 26 + ((lane - 32) >> 3), __builtin_bit_cast(unsigned, kc1)); }
}

#ifndef ATT_TYPES
#define ATT_TYPES 15
#endif
namespace att {
typedef float f32x2 __attribute__((ext_vector_type(2)));
constexpr int VPITCH = 144, KBUF = 64 * 208, VBUF = 64 * VPITCH;
constexpr int ATT_LDS = 2 * KBUF + 2 * VBUF;
constexpr float RESCALE_T = 5.0f;
__device__ __forceinline__ s16x4 vtr(const LAS char* p) { return __builtin_bit_cast(s16x4, __builtin_amdgcn_ds_read_tr16_b64_v4i16((LAS s16x4*)p)); }
__device__ __forceinline__ void xhalf_swap(float m, float& a, float& b) {
    a = m; b = m;
    asm volatile("s_nop 1\n\tv_permlane32_swap_b32 %0, %1\n\ts_nop 1" : "+v"(a), "+v"(b));
}
__device__ __forceinline__ float xhalf_max(float m) { float a, b; xhalf_swap(m, a, b); return fmaxf(a, b); }
__device__ __forceinline__ float xhalf_sum(float m) { float a, b; xhalf_swap(m, a, b); return a + b; }
__device__ __forceinline__ float max3f(float a, float b, float c) { return fmaxf(fmaxf(a, b), c); }
__device__ __forceinline__ float fma_s(float a, float b, float c) { float r; asm("v_fma_f32 %0, %1, %2, %3" : "=v"(r) : "v"(a), "s"(b), "v"(c)); return r; }
__device__ __forceinline__ float add_s(float a, float b) { float r; asm("v_add_f32_e32 %0, %1, %2" : "=v"(r) : "v"(a), "v"(b)); return r; }
__device__ __forceinline__ float mul_s(float a, float b) { float r; asm("v_mul_f32_e32 %0, %1, %2" : "=v"(r) : "v"(a), "v"(b)); return r; }
#define ATT_MFMA(a, b, c) __builtin_amdgcn_mfma_f32_32x32x16_bf16((a), (b), (c), 0, 0, 0)

template <int DK, int MODE, bool INIT = true, bool TRACK = (MODE == 2)>
__device__ __forceinline__ void flash_pass(LAS char* lds, const bf16_t* __restrict__ Qg, int qp, const bf16_t* __restrict__ Kg, int kp, const bf16_t* __restrict__ Vg, int vp,
                                           const bf16_t* __restrict__ AUGg, int q0, int a0, int nA, int b0, int nt, float slope, f32x16& O0, f32x16& O1, float& Mout, float& Lout) {
    constexpr int DKL = DK + (MODE == 1 ? 16 : 0);
    constexpr int KPITCH = DKL * 2 + 16, NKC = 8 * DKL, CPR = DKL / 8, NKS = DK / 16;
    constexpr bool HAS_K1 = NKC > 512;
    constexpr int DUMMY = 2 * KBUF + 2 * VBUF;
    const int tid = tid_fresh(), lane = tid & 63, r32 = lane & 31, hi = lane >> 5; const int wid = __builtin_amdgcn_readfirstlane(tid >> 6);
    const int qrow = q0 + wid * 32 + r32;
    bf16x8 qf[NKS];
#pragma unroll
    for (int ks = 0; ks < NKS; ++ks) qf[ks] = *(const bf16x8*)(Qg + (size_t)qrow * qp + 16 * ks + 8 * hi);
    const int kc1 = tid + 512;
    const bool k0v = tid < NKC, k1v = HAS_K1 && kc1 < NKC;
    const int kr0 = k0v ? tid / CPR : 0, kcc0 = k0v ? tid % CPR : 0, kr1 = k1v ? kc1 / CPR : 0, kcc1 = k1v ? kc1 % CPR : 0, vr = tid >> 3, vcc = tid & 7;
    const bf16_t* kg0; size_t kst0;
    if (MODE == 1 && kcc0 >= DK / 8) { kg0 = AUGg + (size_t)kr0 * 64 + 8 * (kcc0 - DK / 8); kst0 = (size_t)64 * 64; } else { kg0 = Kg + (size_t)kr0 * kp + 8 * kcc0; kst0 = (size_t)64 * kp; }
    const bf16_t* kg1 = Kg + (size_t)kr1 * kp + 8 * kcc1; const size_t kst1 = (size_t)64 * kp;
    const bf16_t* vg = Vg + (size_t)vr * vp + 8 * vcc; const size_t vst = (size_t)64 * vp;
    const int kl0 = k0v ? kr0 * KPITCH + 16 * kcc0 : -1, kl1 = k1v ? kr1 * KPITCH + 16 * kcc1 : -1, vl = 2 * KBUF + vr * VPITCH + 16 * vcc;
    u32x4 rk0A = {0u, 0u, 0u, 0u}, rk1A = {0u, 0u, 0u, 0u}, rvA = {0u, 0u, 0u, 0u}, rk0B = {0u, 0u, 0u, 0u}, rk1B = {0u, 0u, 0u, 0u}, rvB = {0u, 0u, 0u, 0u};
#define ATT_KT(i) ((i) < nA ? a0 + (i) : b0 + ((i) - nA))
#define ATT_LOADK(X, kt) do { const size_t t_ = (size_t)(kt); rk0##X = *(const u32x4*)(kg0 + t_ * kst0); if (HAS_K1) rk1##X = *(const u32x4*)(kg1 + t_ * kst1); } while (0)
#define ATT_LOADV(X, kt) do { rv##X = *(const u32x4*)(vg + (size_t)(kt) * vst); } while (0)
#define ATT_STOREK(X, buf) do { *(LAS u32x4*)(lds + (kl0 >= 0 ? (buf) * KBUF + kl0 : DUMMY + tid * 16)) = rk0##X; if (HAS_K1) *(LAS u32x4*)(lds + (kl1 >= 0 ? (buf) * KBUF + kl1 : DUMMY + tid * 16)) = rk1##X; } while (0)
#define ATT_STOREV(X, buf) do { *(LAS u32x4*)(lds + (buf) * VBUF + vl) = rv##X; } while (0)
    const int q4 = (lane & 15) >> 2, p4 = lane & 3, b16 = (lane >> 4) & 1;
    const int vbase = 2 * KBUF + (4 * hi + q4) * VPITCH + 32 * b16 + 8 * p4;
    const int kbase = r32 * KPITCH + 16 * hi;
    const int qw = q0 + wid * 32;
    const float stq = slope * (float)qrow;
    const bf16x8 qzero = {0, 0, 0, 0, 0, 0, 0, 0};
    bf16x8 qpos = qzero, qneg = qzero;
    if (MODE == 1 && hi == 0) { qpos[0] = (short)0x3F80; qpos[1] = (short)0x3F80; qneg[0] = (short)0xBF80; qneg[1] = (short)0xBF80; }
    constexpr int NKF = NKS + (MODE == 1 ? 1 : 0);
    constexpr int KPRE = NKF > 4 ? 4 : NKF;
    bf16x8 kfa[NKF], kfb[NKF];
#define ATT_KREAD(kbuf, f0, f1) do { const LAS char* Kb_ = lds + (kbuf) * KBUF + kbase; \
        _Pragma("unroll") for (int ks_ = (f0); ks_ < (f1); ++ks_) { kfa[ks_] = *(const LAS bf16x8*)(Kb_ + 32 * ks_); kfb[ks_] = *(const LAS bf16x8*)(Kb_ + 32 * KPITCH + 32 * ks_); } } while (0)
#define ATT_QKM(sa, sb, side) do { \
        _Pragma("unroll") for (int e_ = 0; e_ < 16; ++e_) { sa[e_] = 0.f; sb[e_] = 0.f; } \
        _Pragma("unroll") for (int ks_ = 0; ks_ < NKS; ++ks_) { sa = ATT_MFMA(kfa[ks_], qf[ks_], sa); sb = ATT_MFMA(kfb[ks_], qf[ks_], sb); } \
        if (MODE == 1) { const bf16x8 qa_ = (side) < 0 ? qpos : ((side) > 0 ? qneg : qzero); sa = ATT_MFMA(kfa[NKS], qa_, sa); sb = ATT_MFMA(kfb[NKS], qa_, sb); } } while (0)
#define ATT_QK(sa, sb, kbuf, side) do { ATT_KREAD(kbuf, 0, NKF); ATT_QKM(sa, sb, side); } while (0)
    bf16x8 vfa[4], vfb[4];
#define ATT_VREAD(vbuf) do { const LAS char* Vb_ = lds + (vbuf) * VBUF + vbase; \
        _Pragma("unroll") for (int j_ = 0; j_ < 4; ++j_) { const LAS char* vp0_ = Vb_ + (16 * j_) * VPITCH; \
            { const s16x4 lo_ = vtr(vp0_), hh_ = vtr(vp0_ + 8 * VPITCH); vfa[j_] = __builtin_shufflevector(lo_, hh_, 0, 1, 2, 3, 4, 5, 6, 7); } \
            { const s16x4 lo_ = vtr(vp0_ + 64), hh_ = vtr(vp0_ + 8 * VPITCH + 64); vfb[j_] = __builtin_shufflevector(lo_, hh_, 0, 1, 2, 3, 4, 5, 6, 7); } } } while (0)
#define ATT_PVM() do { _Pragma("unroll") for (int j_ = 0; j_ < 4; ++j_) { O0 = ATT_MFMA(vfa[j_], pf[j_ >> 1][j_ & 1], O0); O1 = ATT_MFMA(vfb[j_], pf[j_ >> 1][j_ & 1], O1); } } while (0)
#define ATT_PV(vbuf) do { ATT_VREAD(vbuf); ATT_PVM(); } while (0)
#define ATT_SIDE(kt) ((MODE != 1) ? 0 : (((kt) * 64 + 63 < qw) ? -1 : (((kt) * 64 > qw + 31) ? 1 : 0)))
    ATT_LOADK(A, ATT_KT(0)); ATT_LOADK(B, ATT_KT(1)); ATT_STOREV(B, 1);
    ATT_STOREK(A, 0); ATT_STOREK(B, 1);
    ATT_LOADK(A, ATT_KT(2)); ATT_LOADV(A, ATT_KT(0));
    __syncthreads();
    float M = (INIT && TRACK) ? -1e20f : Mout, L = INIT ? 0.f : Lout;
    if (INIT) {
#pragma unroll
        for (int i = 0; i < 16; ++i) { O0[i] = 0.f; O1[i] = 0.f; } }
    bf16x8 pf[2][2];
#pragma unroll
    for (int kb = 0; kb < 2; ++kb)
#pragma unroll
        for (int st = 0; st < 2; ++st) pf[kb][st] = qzero;
    f32x16 s0, s1, n0, n1;
    int side_cur = ATT_SIDE(ATT_KT(0));
    ATT_QK(s0, s1, 0, side_cur);
#pragma unroll
    for (int e = 0; e < 16; ++e) { n0[e] = 0.f; n1[e] = 0.f; }
    __syncthreads();
    constexpr int NMF = 2 * NKS + (MODE == 1 ? 2 : 0) + 8;
#define ATT_ITER(i, C0, C1, N0, N1, LS, SS, HASN, HASK2, HASK3) do { \
        const int kt = ATT_KT(i); \
        if (HASK3) ATT_LOADK(LS, ATT_KT((i) + 3)); \
        if (HASN) ATT_LOADV(LS, ATT_KT((i) + 1)); \
        if (HASN) ATT_KREAD(((i) + 1) & 1, 0, KPRE); \
        const int k0 = kt * 64; \
          \
        float rc = 0.f; \
        if (MODE == 1) { \
            if (side_cur != 0) rc = side_cur < 0 ? -stq : stq; \
            else { const float dbase = (float)(k0 + 4 * hi - qrow); \
                _Pragma("unroll") for (int e = 0; e < 16; ++e) { const float c = (float)((e & 3) + 8 * (e >> 2)); \
                    C0[e] = fmaf(-slope, fabsf(dbase + c), C0[e]); C1[e] = fmaf(-slope, fabsf(dbase + (c + 32.f)), C1[e]); } } \
        } \
        if (MODE == 2) { const float dbase = (float)(k0 + 4 * hi - qrow); \
            _Pragma("unroll") for (int e = 0; e < 16; ++e) { const float c = (float)((e & 3) + 8 * (e >> 2)); \
                const float d0 = fabsf(dbase + c), d1 = fabsf(dbase + (c + 32.f)); \
                C0[e] = (d0 <= 128.f) ? fmaf(-slope, d0, C0[e]) : -1e30f; C1[e] = (d1 <= 128.f) ? fmaf(-slope, d1, C1[e]) : -1e30f; } } \
        if (TRACK) { \
        float mx = max3f(C0[0], C1[0], C0[1]); \
        _Pragma("unroll") for (int e = 1; e < 15; e += 2) { mx = max3f(mx, C1[e], C0[e + 1]); mx = max3f(mx, C1[e + 1], C0[e + 2]); } \
        mx = fmaxf(mx, C1[15]); \
        const float mt = xhalf_max(mx) + rc;                     \
        if (__builtin_amdgcn_ballot_w64(mt > M + RESCALE_T) != 0ull) {         \
            ATT_PV(((i) + 1) & 1); \
            _Pragma("unroll") for (int kb = 0; kb < 2; ++kb) _Pragma("unroll") for (int st = 0; st < 2; ++st) pf[kb][st] = qzero; \
            const float Mn = fmaxf(M, mt); const float alpha = __builtin_amdgcn_exp2f((M - Mn) * LOG2E); M = Mn; \
            L *= alpha; \
            _Pragma("unroll") for (int e = 0; e < 16; ++e) { O0[e] *= alpha; O1[e] *= alpha; }        \
        } } \
          \
        const int side_next = HASN ? ATT_SIDE(ATT_KT((i) + 1)) : 0; \
        if (HASN) ATT_KREAD(((i) + 1) & 1, KPRE, NKF); \
        ATT_VREAD(((i) + 1) & 1); \
        if (HASN) ATT_QKM(N0, N1, side_next); \
        ATT_PVM();                                   \
        const float cc = (rc - M) * LOG2E; \
        float ps = 0.f;                                          \
        float ps1 = 0.f; \
        _Pragma("unroll") for (int e = 0; e < 16; ++e) { float t0 = __builtin_fmaf(C0[e], LOG2E, cc), t1 = __builtin_fmaf(C1[e], LOG2E, cc); \
            asm("" : "+v"(t0)); asm("" : "+v"(t1));                 \
            C0[e] = __builtin_amdgcn_exp2f(t0); C1[e] = __builtin_amdgcn_exp2f(t1); \
            float u0 = ps + C0[e], u1 = ps1 + C1[e]; asm("" : "+v"(u0)); asm("" : "+v"(u1)); ps = u0; ps1 = u1; } \
        L += ps + ps1; \
        _Pragma("unroll") for (int st = 0; st < 2; ++st) { u32x4 w0, w1; \
            w0.x = pkbf(C0[8 * st + 0], C0[8 * st + 1]); w0.y = pkbf(C0[8 * st + 2], C0[8 * st + 3]); w0.z = pkbf(C0[8 * st + 4], C0[8 * st + 5]); w0.w = pkbf(C0[8 * st + 6], C0[8 * st + 7]); \
            w1.x = pkbf(C1[8 * st + 0], C1[8 * st + 1]); w1.y = pkbf(C1[8 * st + 2], C1[8 * st + 3]); w1.z = pkbf(C1[8 * st + 4], C1[8 * st + 5]); w1.w = pkbf(C1[8 * st + 6], C1[8 * st + 7]); \
            pf[0][st] = __builtin_bit_cast(bf16x8, w0); pf[1][st] = __builtin_bit_cast(bf16x8, w1); } \
        side_cur = side_next; \
        if (HASN) { __builtin_amdgcn_sched_group_barrier(0x100, 8, 0);        \
            _Pragma("unroll") for (int g_ = 0; g_ < NMF; ++g_) { __builtin_amdgcn_sched_group_barrier(0x008, 1, 0); __builtin_amdgcn_sched_group_barrier(0x100, 2, 0); __builtin_amdgcn_sched_group_barrier(0x002, 6, 0); } } \
        if (HASK2) ATT_STOREK(SS, (i) & 1); \
        ATT_STOREV(SS, (i) & 1); \
        __syncthreads(); } while (0)
    for (int i = 0; i + 4 < nt; i += 2) {
        ATT_ITER(i, s0, s1, n0, n1, B, A, true, true, true);
        ATT_ITER(i + 1, n0, n1, s0, s1, A, B, true, true, true);
    }
    ATT_ITER(nt - 4, s0, s1, n0, n1, B, A, true, true, true);
    ATT_ITER(nt - 3, n0, n1, s0, s1, A, B, true, true, false);
    ATT_ITER(nt - 2, s0, s1, n0, n1, B, A, true, false, false);
    ATT_ITER(nt - 1, n0, n1, s0, s1, A, B, false, false, false);
    ATT_PV((nt - 1) & 1);
    __syncthreads();
#undef ATT_ITER
#undef ATT_LOADK
#undef ATT_LOADV
#undef ATT_STOREK
#undef ATT_STOREV
#undef ATT_KT
#undef ATT_QK
#undef ATT_PV
#undef ATT_KREAD
#undef ATT_QKM
#undef ATT_VREAD
#undef ATT_PVM
#undef ATT_SIDE
    Mout = M; Lout = L;
}

template <int NE> __device__ __forceinline__ float row_norm2(const bf16_t* qrow_ptr) {
    float s = 0.f;
#pragma unroll
    for (int c = 0; c < NE / 8; ++c) { float v[8]; unpack8(((const u32x4*)qrow_ptr)[c], v);
#pragma unroll
        for (int e = 0; e < 8; ++e) s += v[e] * v[e]; }
    return s;
}
__device__ __forceinline__ void store_o(bf16_t* orow, const f32x16& O0, const f32x16& O1, int hi) {
#pragma unroll
    for (int g = 0; g < 4; ++g) {
        u32x2 w0, w1; w0.x = pkbf(O0[4 * g], O0[4 * g + 1]); w0.y = pkbf(O0[4 * g + 2], O0[4 * g + 3]); w1.x = pkbf(O1[4 * g], O1[4 * g + 1]); w1.y = pkbf(O1[4 * g + 2], O1[4 * g + 3]);
        *(u32x2*)(orow + 8 * g + 4 * hi) = w0; *(u32x2*)(orow + 32 + 8 * g + 4 * hi) = w1;
    }
}

__device__ __forceinline__ void attn_phase(KP p, int l, LAS char* lds, int vcu, int G) {
    const bf16_t* proj = (const bf16_t*)(p->ws + WS_PROJ); const bf16_t* qb = (const bf16_t*)(p->ws + WS_QB); const bf16_t* kb = (const bf16_t*)(p->ws + WS_KB); const bf16_t* vb = (const bf16_t*)(p->ws + WS_VB);
    const bf16_t* aug = (const bf16_t*)(p->ws + WS_AUG);
    bf16_t* mix = (bf16_t*)(p->ws + WS_MIX);
    for (int u = vcu; u < 2048; u += G) {
        if (!((ATT_TYPES >> (u >> 9)) & 1)) continue;
        const int tid = tid_fresh(), lane = tid & 63, r32 = lane & 31, hi = lane >> 5; const int wid = __builtin_amdgcn_readfirstlane(tid >> 6);
        const int type = u >> 9, idx = u & 511, bh = idx >> 6, qblk = idx & 63, b = bh >> 2, hd = bh & 3, q0 = qblk * 256;
        const int qrow = q0 + wid * 32 + r32;
        const size_t tok0 = (size_t)b * SEQ;
        bf16_t* orow = mix + (tok0 + qrow) * DM;
        f32x16 O0, O1; float M, L;
        if (type == 0) {
            const int bD = idx >> 8, hD = ((idx >> 6) & 3) ^ (bD ? 3 : 0);
            const size_t tokD = (size_t)bD * SEQ;
            bf16_t* orowD = mix + (tokD + qrow) * DM;
            const float slope = __builtin_amdgcn_exp2f(-(float)(5 + hD));
            const bf16_t* base = proj + tokD * NPROJ + PD;
            const int d0 = q0 / 64;
            LAS float* asave = (LAS float*)(lds + 65536) + tid;
#pragma unroll 1
            for (int mp = 0; mp < 2; ++mp) {
                const bf16_t* Qm = base + 64 * hD + 32 * mp; const bf16_t* Km = base + 256 + 64 * hD + 32 * mp; const bf16_t* Vm = base + 512 + 64 * hD;
                const float kmax = sqrtf(__builtin_bit_cast(float, ((const unsigned*)(p->ws + WS_KMAX))[l * 32 + bD * 8 + hD * 2 + mp]));
                const float bound = sqrtf(row_norm2<32>(Qm + (size_t)qrow * NPROJ)) * kmax * 1.01f;
                M = bound;
                flash_pass<32, 1, true>(lds, Qm, NPROJ, Km, NPROJ, Vm, NPROJ, aug + 16 * hD, q0, d0, 4, 0, 4, slope, O0, O1, M, L);
                float dc = (bound + (20.8f + __logf(2.f / slope)) - (M + __logf(fmaxf(xhalf_sum(L), 1e-37f)))) / slope;
                dc = fminf(fmaxf(dc, 0.f), 1.0e8f);
#pragma unroll
                for (int o = 1; o < 64; o <<= 1) dc = fmaxf(dc, __shfl_xor(dc, o));
                LAS float* red = (LAS float*)(lds + ATT_LDS + 16384);
                if (lane == 0) red[wid] = dc;
                __syncthreads();
#pragma unroll
                for (int w = 0; w < 8; ++w) dc = fmaxf(dc, red[w]);
                __syncthreads();
                const int dci = (int)dc + 1;
                const int lo_key = q0 - dci - 63;
                int ktlo = lo_key <= 0 ? 0 : (lo_key + 63) / 64; int kthi = (q0 + 255 + dci) / 64; if (kthi > SEQ / 64 - 1) kthi = SEQ / 64 - 1;
                if (ktlo > d0) ktlo = d0; if (kthi < d0 + 3) kthi = d0 + 3;
                if (((kthi - ktlo + 1) & 1) != 0) { if (ktlo > 0) --ktlo; else ++kthi; }
                if (kthi - ktlo + 1 == 6) { if (ktlo >= 2) ktlo -= 2; else kthi += 2; }
                const int nR = kthi - (d0 + 3), nL = d0 - ktlo;
                if (nR + nL > 0) flash_pass<32, 1, false>(lds, Qm, NPROJ, Km, NPROJ, Vm, NPROJ, aug + 16 * hD, q0, d0 + 4, nR, ktlo, nR + nL, slope, O0, O1, M, L);
                if (mp == 0) { const float i1 = 1.f / xhalf_sum(L);
#pragma unroll
                    for (int i = 0; i < 16; ++i) { asave[(2 * i) * NTHREADS] = O0[i] * i1; asave[(2 * i + 1) * NTHREADS] = O1[i] * i1; } }
            }
            float lam;
            { const float* lp = p->diff_lambda + l * 128; const float a = (lane < 32) ? lp[lane] * lp[32 + lane] : 0.f, b2 = (lane < 32) ? lp[64 + lane] * lp[96 + lane] : 0.f;
              lam = expf(wave_sum(a)) - expf(wave_sum(b2)) + p->lam_init[l]; }
            const float one_m_li = 1.f - p->lam_init[l];
            const float i2 = lam / xhalf_sum(L);
            float ss = 0.f;
            f32x16 A0, A1;
#pragma unroll
            for (int i = 0; i < 16; ++i) { A0[i] = asave[(2 * i) * NTHREADS] - O0[i] * i2; A1[i] = asave[(2 * i + 1) * NTHREADS] - O1[i] * i2; ss += A0[i] * A0[i] + A1[i] * A1[i]; }
            ss = xhalf_sum(ss);
            const float rs = one_m_li / sqrtf(ss * (1.f / 64.f) + NORM_EPS);
            const float* sg = p->diff_subln + l * 64;
#pragma unroll
            for (int i = 0; i < 16; ++i) { const int dv = (i & 3) + 8 * (i >> 2) + 4 * hi; A0[i] *= rs * sg[dv]; A1[i] *= rs * sg[32 + dv]; }
            store_o(orowD + 768 + 64 * hD, A0, A1, hi);
        } else if (type == 1) {
            M = sqrtf(row_norm2<96>(qb + (tok0 + qrow) * 384 + 96 * hd) * __builtin_bit_cast(float, ((const unsigned*)(p->ws + WS_KMAX))[l * 32 + 16 + b * 4 + hd])) * 1.01f;
            flash_pass<96, 0>(lds, qb + tok0 * 384 + 96 * hd, 384, kb + tok0 * 384 + 96 * hd, 384, vb + tok0 * 256 + 64 * hd, 256, nullptr, q0, q0 / 64, SEQ / 64 - q0 / 64, 0, SEQ / 64, 0.f, O0, O1, M, L);
            const float il = 1.f / xhalf_sum(L);
#pragma unroll
            for (int i = 0; i < 16; ++i) { O0[i] *= il; O1[i] *= il; }
            store_o(orow + 256 + 64 * hd, O0, O1, hi);
        } else if (type == 2) {
            const bf16_t* base = proj + tok0 * NPROJ + PC; const int hk = hd >> 1;
            M = sqrtf(row_norm2<64>(base + (size_t)qrow * NPROJ + 64 * hd) * __builtin_bit_cast(float, ((const unsigned*)(p->ws + WS_KMAX))[l * 32 + 24 + b * 2 + hk])) * 1.01f;
            flash_pass<64, 0>(lds, base + 64 * hd, NPROJ, base + 256 + 64 * hk, NPROJ, base + 384 + 64 * hk, NPROJ, nullptr, q0, q0 / 64, SEQ / 64 - q0 / 64, 0, SEQ / 64, 0.f, O0, O1, M, L);
            const float il = 1.f / xhalf_sum(L);
#pragma unroll
            for (int i = 0; i < 16; ++i) { O0[i] *= il; O1[i] *= il; }
            store_o(orow + 512 + 64 * hd, O0, O1, hi);
        } else {
            const bf16_t* base = proj + tok0 * NPROJ + PA; const int hk = hd >> 1;
            const float slope = __builtin_amdgcn_exp2f(-(float)(1 + hd));
            const int kt0 = (q0 >= 128) ? (q0 - 128) / 64 : 0; int kt1 = (q0 + 256 + 128) / 64; if (kt1 > SEQ / 64) kt1 = SEQ / 64;
            flash_pass<64, 2>(lds, base + 64 * hd, NPROJ, base + 256 + 64 * hk, NPROJ, base + 384 + 64 * hk, NPROJ, nullptr, q0, kt0, kt1 - kt0, 0, kt1 - kt0, slope, O0, O1, M, L);
            const float sink = p->win_sink[l * 4 + hd];
            const float il = 1.f / (xhalf_sum(L) + __builtin_amdgcn_exp2f((sink - M) * LOG2E));
#pragma unroll
            for (int i = 0; i < 16; ++i) { O0[i] *= il; O1[i] *= il; }
            store_o(orow + 64 * hd, O0, O1, hi);
        }
    }
}
}

#define XB_TMO      128
#define XB_XCNT(j)  (256  + 64 * (j))
#define XB_XSUB(j)  (1280 + 64 * (j))
#define XB_XGEN(j)  (2304 + 64 * (j))
#define XB_TOP      3328
#define XB_TOPGEN   3392
#define XCD_BAR_WORDS 3456
#define XB_SPIN_CAP (1u << 22)

__device__ __forceinline__ unsigned xb_ld(unsigned* p)              { return __hip_atomic_load(p, __ATOMIC_RELAXED, __HIP_MEMORY_SCOPE_AGENT); }
__device__ __forceinline__ unsigned xb_add(unsigned* p, unsigned v) { return __hip_atomic_fetch_add(p, v, __ATOMIC_RELAXED, __HIP_MEMORY_SCOPE_AGENT); }
__device__ __forceinline__ unsigned xb_xcc_id() { return (unsigned)__builtin_amdgcn_s_getreg((3 << 11) | 20) & 0xFu; }
#define XB_SPIN(cond, bar) do { unsigned _sp = 0; while (cond) { __builtin_amdgcn_s_sleep(1); \
    if ((++_sp & 255u) == 0u) { if (xb_ld(&(bar)[XB_TMO])) break; if (_sp > XB_SPIN_CAP) { atomicAdd(&(bar)[XB_TMO], 1u); break; } } } } while (0)

struct XcdBarrier {
    unsigned* bar; unsigned x;
    volatile LAS unsigned* st;
};

__device__ __forceinline__ XcdBarrier xcd_barrier_post(unsigned* bar, volatile LAS unsigned* st) {
    XcdBarrier b; b.bar = bar; b.x = xb_xcc_id(); b.st = st;
    if (threadIdx.x == 0) (void)xb_add(&bar[XB_XCNT(b.x)], 1u);
    return b;
}
__device__ __forceinline__ void xcd_barrier_complete(unsigned* bar, unsigned x, unsigned& nloc, unsigned& nx) {
    const unsigned G = gridDim.x * gridDim.y * gridDim.z;
    unsigned sum, cnt, mine, sp = 0u;
    for (;;) {
        sum = 0u; cnt = 0u; mine = 0u;
#pragma unroll
        for (unsigned j = 0; j < 16; ++j) { const unsigned c = xb_ld(&bar[XB_XCNT(j)]); sum += c; cnt += (c > 0u) ? 1u : 0u; mine = (j == x) ? c : mine; }
        if (sum == G) break;
        __builtin_amdgcn_s_sleep(1);
        if ((++sp & 255u) == 0u) { if (xb_ld(&bar[XB_TMO])) break; if (sp > XB_SPIN_CAP) { atomicAdd(&bar[XB_TMO], 1u); break; } }
    }
    nloc = mine > 0u ? mine : 1u; nx = cnt > 0u ? cnt : 1u;
}

__device__ __forceinline__ void xcd_barrier(const XcdBarrier& b) {
    asm volatile("s_waitcnt vmcnt(0)" ::: "memory");
    __syncthreads();
    if (threadIdx.x == 0) {
        unsigned* bar = b.bar;
        __builtin_amdgcn_s_waitcnt(0);
        unsigned nloc = b.st[0], nx = b.st[1];
        if (nloc == 0u) { xcd_barrier_complete(bar, b.x, nloc, nx); b.st[0] = nloc; b.st[1] = nx; }
        const unsigned old = xb_add(&bar[XB_XSUB(b.x)], 1u);
        const unsigned gen = old / nloc;
        if (old + 1u == (gen + 1u) * nloc) {
            __builtin_amdgcn_fence(__ATOMIC_RELEASE, "agent");
            asm volatile("s_waitcnt vmcnt(0)" ::: "memory");
            const unsigned og = xb_add(&bar[XB_TOP], 1u);
            const unsigned tg = og / nx;
            if (og + 1u == (tg + 1u) * nx) xb_add(&bar[XB_TOPGEN], 1u);
            else XB_SPIN(xb_ld(&bar[XB_TOPGEN]) == tg, bar);
            __builtin_amdgcn_fence(__ATOMIC_ACQUIRE, "agent");
            xb_add(&bar[XB_XGEN(b.x)], 1u);
            asm volatile("s_waitcnt vmcnt(0)" ::: "memory");
        } else {
            XB_SPIN(xb_ld(&bar[XB_XGEN(b.x)]) == gen, bar);
            __builtin_amdgcn_fence(__ATOMIC_ACQUIRE, "agent");
            asm volatile("s_waitcnt vmcnt(0)" ::: "memory");
        }
    }
    __syncthreads();
}

#define GRID_SYNC_CG() do { asm volatile("s_waitcnt vmcnt(0) lgkmcnt(0)" ::: "memory"); grid.sync(); __builtin_amdgcn_fence(__ATOMIC_ACQUIRE, "agent"); } while (0)
#define XB_ST ((volatile LAS unsigned*)(lds + LDS_BYTES - 64))
#define GRID_SYNC() do { GETP(pb_); XcdBarrier xb_; xb_.bar = (unsigned*)(pb_->ws + WS_BAR); xb_.x = xb_xcc_id(); xb_.st = XB_ST; xcd_barrier(xb_); } while (0)
#ifndef PH_MASK
#define PH_MASK 255
#endif
__global__ void __launch_bounds__(NTHREADS, 2) mega_fwd(Params p_by_value) {
    extern __shared__ __attribute__((aligned(16))) unsigned char lds_raw[];
    cg::grid_group grid = cg::this_grid();
    LAS unsigned char* lds = (LAS unsigned char*)lds_raw;
#define VCU(G_, bx_) (((G_) % 8 == 0) ? ((bx_) % 8) * ((G_) / 8) + (bx_) / 8 : (bx_))
    const float alpha = 1.681792830507429f;
#define STATS(s_) ((float*)(p->ws + WS_STATS) + (size_t)(s_) * T * 2)
#define C1(l_, off_) ((const float*)(p->ws + WS_C12) + (l_) * C12_L + (off_))
#define C2(l_, off_) ((const float*)(p->ws + WS_C12) + C2_OFF + (l_) * C12_L + (off_))

    if (threadIdx.x < 16) ((LAS unsigned*)(lds + LDS_BYTES - 64))[threadIdx.x] = 0u;
    __syncthreads();
    { GETP(p); (void)xcd_barrier_post((unsigned*)(p->ws + WS_BAR), XB_ST); }
    if (PH_MASK & 1) { GETP(p); const int G = gridDim.x, bx = blockIdx.x; phase0(p, lds, VCU(G, bx), G); }
    GRID_SYNC_CG();
#pragma unroll 1
    for (int li = 0; li < DEPTH; ++li) {
#pragma unroll 1
        for (int fi = 0; fi < 2; ++fi) {
            if (fi == 1) {
                if (PH_MASK & 2) { GETP(p); int l = li; asm volatile("" : "+s"(l)); const int G = gridDim.x, bx = blockIdx.x;
                  pg8::Gemm g{(const bf16_t*)(p->ws + WS_XB), (const bf16_t*)(p->ws + WS_WIN) + l * WIN_L, T, NPROJ, DM}; pg8::StaticOrder S; S.init(T, NPROJ, G, bx);
                  pg8::EpiStoreBf16LN E{(bf16_t*)(p->ws + WS_PROJ), NPROJ, STATS(3 * l), C1(l, 2 * NGU), C2(l, 2 * NGU)};
                  pg8::gemm_phase<pg8::EpiStoreBf16LN, pg8::StaticOrder, true, true>(lds, g, S, E); }
                GRID_SYNC();
                if (PH_MASK & 4) { GETP(p); int l = li; asm volatile("" : "+s"(l)); const int G = gridDim.x, bx = blockIdx.x; prep_phase(p, l, VCU(G, bx), G); }
                GRID_SYNC();
                if (PH_MASK & 8) { GETP(p); int l = li; asm volatile("" : "+s"(l)); const int G = gridDim.x, bx = blockIdx.x; att::attn_phase(p, l, (LAS char*)lds, VCU(G, bx), G); }
                GRID_SYNC();
                if (PH_MASK & 16) { GETP(p); int l = li; asm volatile("" : "+s"(l)); const int G = gridDim.x, bx = blockIdx.x;
                  pg8::Gemm g{(const bf16_t*)(p->ws + WS_MIX), (const bf16_t*)(p->ws + WS_WOUT) + l * WOUT_L, T, DM, DM}; pg8::StaticOrder S; S.init(T, DM, G, bx);
                  pg8::EpiResidLN<true> E{nullptr, p->out, p->ws, p->ln_g + (3 * l) * DM, p->ln_b + (3 * l) * DM, 3 * l, alpha, 1.0f};
                  pg8::gemm_phase<pg8::EpiResidLN<true>, pg8::StaticOrder, true, true>(lds, g, S, E); }
                GRID_SYNC();
            }
            if (PH_MASK & 64) { GETP(p); int l = li, f = fi; asm volatile("" : "+s"(l), "+s"(f)); const int G = gridDim.x, bx = blockIdx.x;
              const int s = 3 * l + 2 * f - 1;
              pg8::Gemm g{(const bf16_t*)(p->ws + WS_XB), (const bf16_t*)(p->ws + WS_WGU) + l * WGU_L + f * WGU_F, T, NGU, DM}; pg8::StaticOrder S; S.init(T, NGU, G, bx);
              if (s >= 0) { pg8::EpiSwiGLULN<true> E{(bf16_t*)(p->ws + WS_H), DFF, STATS(s), C1(l, f * NGU), C2(l, f * NGU)};
                            pg8::gemm_phase<pg8::EpiSwiGLULN<true>, pg8::StaticOrder, true, true>(lds, g, S, E); }
              else { pg8::EpiSwiGLULN<false> E{(bf16_t*)(p->ws + WS_H), DFF, nullptr, C1(l, f * NGU), C2(l, f * NGU)};
                     pg8::gemm_phase<pg8::EpiSwiGLULN<false>, pg8::StaticOrder, true, true>(lds, g, S, E); } }
            GRID_SYNC();
            if (PH_MASK & 128) { GETP(p); int l = li, f = fi; asm volatile("" : "+s"(l), "+s"(f)); const int G = gridDim.x, bx = blockIdx.x;
              const int s = 3 * l + 2 * f - 1;
              pg8::Gemm g{(const bf16_t*)(p->ws + WS_H), (const bf16_t*)(p->ws + WS_WD) + l * WD_L + f * WD_F, T, DM, DFF}; pg8::StaticOrder S; S.init(T, DM, G, bx);
              if (s >= 0) { pg8::EpiResidLN<true> E{nullptr, p->out, p->ws, p->ln_g + s * DM, p->ln_b + s * DM, s, alpha, 0.5f};
                            pg8::gemm_phase<pg8::EpiResidLN<true>, pg8::StaticOrder, true, true>(lds, g, S, E); }
              else { pg8::EpiResidLN<false> E{p->x, p->out, p->ws, nullptr, nullptr, -1, alpha, 0.5f};
                     pg8::gemm_phase<pg8::EpiResidLN<false>, pg8::StaticOrder, true, true>(lds, g, S, E); } }
            GRID_SYNC();
        }
    }
    if (PH_MASK & 32) { GETP(p); const int G = gridDim.x, bx = blockIdx.x;
      ln_phase<false>(p->out, (bf16_t*)(p->ws + WS_XB), p->ln_g + (3 * DEPTH - 1) * DM, p->ln_b + (3 * DEPTH - 1) * DM, VCU(G, bx), G); }
}

extern "C" void kernel_launch(void* const* d_in, const int* in_sizes, int n_in, void* d_out, int out_size, void* d_ws, size_t ws_size, hipStream_t stream) {
    static int grid = 0;
    if (grid == 0) {
        if (n_in != 16 || in_sizes[0] != T * DM || out_size != T * DM || ws_size < WS_END) { fprintf(stderr, "kernel_launch: unexpected shapes (n_in %d, in0 %d, out %d, ws %zu); nothing launched\n", n_in, n_in > 0 ? in_sizes[0] : -1, out_size, ws_size); grid = -1; return; }
        int dev = 0, cus = 0, per_cu = 0;
        hipGetDevice(&dev); hipDeviceGetAttribute(&cus, hipDeviceAttributeMultiprocessorCount, dev);
        if (hipFuncSetAttribute((const void*)mega_fwd, hipFuncAttributeMaxDynamicSharedMemorySize, LDS_BYTES) != hipSuccess) { fprintf(stderr, "kernel_launch: hipFuncSetAttribute failed\n"); grid = -1; return; }
        if (hipOccupancyMaxActiveBlocksPerMultiprocessor(&per_cu, (const void*)mega_fwd, NTHREADS, LDS_BYTES) != hipSuccess || per_cu < 1) { fprintf(stderr, "kernel_launch: occupancy query gave %d\n", per_cu); per_cu = 1; }
        (void)hipGetLastError();
        grid = cus * 1;
    }
    if (grid < 0) return;
    Params p{};
    p.x = (const float*)d_in[0]; p.w_in = (const float*)d_in[1]; p.win_sink = (const float*)d_in[2]; p.mla_q_norm = (const float*)d_in[3]; p.mla_w_uq = (const float*)d_in[4];
    p.mla_kv_norm = (const float*)d_in[5]; p.mla_w_ukv = (const float*)d_in[6]; p.ax_q_norm = (const float*)d_in[7]; p.ax_k_norm = (const float*)d_in[8]; p.diff_lambda = (const float*)d_in[9];
    p.diff_subln = (const float*)d_in[10]; p.w_out = (const float*)d_in[11]; p.ffn_w_gu = (const float*)d_in[12]; p.ffn_w_down = (const float*)d_in[13]; p.ln_g = (const float*)d_in[14]; p.ln_b = (const float*)d_in[15];
    p.out = (float*)d_out; p.ws = (unsigned char*)d_ws;
    for (int l = 0; l < 4; ++l) p.lam_init[l] = (float)(0.8 - 0.6 * exp(-0.3 * (double)l));
    for (int i = 0; i < 16; ++i) p.inv32[i] = (float)pow(10000.0, -(double)i / 16.0);
    if (hipMemsetAsync((char*)d_ws + WS_CTL, 0, CTL_BYTES, stream) != hipSuccess) { fprintf(stderr, "kernel_launch: hipMemsetAsync of the control region failed\n"); return; }
    void* args[] = {&p};
    hipError_t e = hipLaunchCooperativeKernel((const void*)mega_fwd, dim3(grid), dim3(NTHREADS), args, LDS_BYTES, stream);
    if (e != hipSuccess) fprintf(stderr, "kernel_launch: cooperative launch failed: %s (grid %d)\n", hipGetErrorString(e), grid);
}
```

```cpp
#include <hip/hip_runtime.h>
#include <hip/hip_cooperative_groups.h>
#include <cstdio>
#include <cstdint>
#include <cmath>
namespace cg = cooperative_groups;
namespace pg8 {
#define PG8_LAS __attribute__((address_space(3)))
typedef unsigned short bf16_t;
typedef short bf16x8 __attribute__((ext_vector_type(8)));
typedef float f32x4 __attribute__((ext_vector_type(4)));
typedef unsigned u32x4 __attribute__((ext_vector_type(4)));
constexpr int BM = 256, BK = 64, HALF = 128, HTB = HALF * BK * 2  , STAGE_BYTES = 8 * HTB, NXCD = 8, WGM = 4;

__host__ __device__ __forceinline__ int lds_byte(int r, int c) { const int st = (r >> 4) * 2 + (c >> 5), rr = r & 15, cc = c & 31, ob = rr * 64 + cc * 2; return st * 1024 + (ob ^ (((ob >> 9) & 1) << 5)); }
__host__ __device__ __forceinline__ void stage_rc(int b, int& R, int& C) { const int st = b / 1024, sb = b % 1024, swz = sb ^ (((sb >> 9) & 1) << 5); R = (st >> 1) * 16 + swz / 64; C = (st & 1) * 32 + (swz % 64) / 2; }
__host__ __device__ __forceinline__ int perm32(int rho) { const int n = rho >> 4, i = rho & 15; return 8 * (i >> 2) + 4 * n + (i & 3); }

struct Unit { int pm, pn; };
struct Gemm { const bf16_t* A; const bf16_t* Bt; int M, N, K; };

struct StaticOrder {
    int nM, nN, nwg, G, c;
    __host__ __device__ void init(int M, int N, int G_, int c_) { nM = M / BM; nN = N / BM; nwg = nM * nN; G = G_; c = c_; }
    __host__ __device__ bool next(int i, Unit& u) const {
        const long L = (long)i * G + c; if (L >= nwg) return false;
        int wgid = (int)L; { const int q = nwg / NXCD, r = nwg % NXCD, xcd = wgid % NXCD, off = wgid / NXCD; wgid = (xcd < r ? xcd * (q + 1) : r * (q + 1) + (xcd - r) * q) + off; }
        const int nig = WGM * nN, gid = wgid / nig, fm = gid * WGM, gsz = (nM - fm) < WGM ? (nM - fm) : WGM;
        u.pm = fm + ((wgid % nig) % gsz); u.pn = (wgid % nig) / gsz; return true;
    }
    __device__ __forceinline__ void a_ready(const Unit&) const {}
    __device__ __forceinline__ void done(const Unit&) const {}
};

__device__ __forceinline__ unsigned cvt_pk_bf16(float lo, float hi) { unsigned r; asm volatile("v_cvt_pk_bf16_f32 %0, %1, %2" : "=v"(r) : "v"(lo), "v"(hi)); return r; }
typedef float f32x2 __attribute__((ext_vector_type(2)));
typedef float f32x2 __attribute__((ext_vector_type(2)));
typedef unsigned u32x2 __attribute__((ext_vector_type(2)));

struct EpiStoreBf16 {
    static constexpr bool PERM = true, AFTER_DRAIN = false;
    bf16_t* O; int ldc;
    __device__ __forceinline__ void operator()(const f32x4 (&acc)[2][2][4][2], const Unit& u, int wr, int wc, int fr, int fq) const {
        const int row0 = u.pm * BM + wr * 64 + fr; const int col0 = u.pn * BM + wc * 32 + 8 * fq;
#pragma unroll
        for (int ai = 0; ai < 2; ++ai)
#pragma unroll
            for (int m = 0; m < 4; ++m) { bf16_t* rowp = O + (size_t)(row0 + ai * HALF + m * 16) * ldc + col0;
#pragma unroll
                for (int bj = 0; bj < 2; ++bj) { const f32x4 v0 = acc[ai][bj][m][0], v1 = acc[ai][bj][m][1];
                    u32x4 w; w.x = cvt_pk_bf16(v0[0], v0[1]); w.y = cvt_pk_bf16(v0[2], v0[3]); w.z = cvt_pk_bf16(v1[0], v1[1]); w.w = cvt_pk_bf16(v1[2], v1[3]);
                    *(u32x4*)(rowp + bj * HALF) = w; } }
    }
};

__device__ __forceinline__ float silu_mul(float g, float u) {
    const float e = __builtin_amdgcn_exp2f(-1.4426950408889634f * g);
    return g * u * __builtin_amdgcn_rcpf(1.0f + e);
}
struct EpiSwiGLU {
    static constexpr bool PERM = true, AFTER_DRAIN = false;
    bf16_t* H; int ldh;
    __device__ __forceinline__ void operator()(const f32x4 (&acc)[2][2][4][2], const Unit& u, int wr, int wc, int fr, int fq) const {
        const int row0 = u.pm * BM + wr * 64 + fr; const int col0 = u.pn * HALF + wc * 32 + 8 * fq;
#pragma unroll
        for (int ai = 0; ai < 2; ++ai)
#pragma unroll
            for (int m = 0; m < 4; ++m) { bf16_t* rowp = H + (size_t)(row0 + ai * HALF + m * 16) * ldh + col0;
                const f32x4 g0 = acc[ai][0][m][0], g1 = acc[ai][0][m][1], u0 = acc[ai][1][m][0], u1 = acc[ai][1][m][1];
                u32x4 w;
                w.x = cvt_pk_bf16(silu_mul(g0[0], u0[0]), silu_mul(g0[1], u0[1])); w.y = cvt_pk_bf16(silu_mul(g0[2], u0[2]), silu_mul(g0[3], u0[3]));
                w.z = cvt_pk_bf16(silu_mul(g1[0], u1[0]), silu_mul(g1[1], u1[1])); w.w = cvt_pk_bf16(silu_mul(g1[2], u1[2]), silu_mul(g1[3], u1[3]));
                *(u32x4*)rowp = w; }
    }
};

struct EpiResid {
    static constexpr bool PERM = false, AFTER_DRAIN = false;
    const float* src; float* dst; int ld; float alpha, beta;
    __device__ __forceinline__ void operator()(const f32x4 (&acc)[2][2][4][2], const Unit& u, int wr, int wc, int fr, int fq) const {
        const int col0 = u.pn * BM + wc * 32 + 4 * fq;
#pragma unroll
        for (int ai = 0; ai < 2; ++ai)
#pragma unroll
            for (int m = 0; m < 4; ++m) { const size_t off = (size_t)(u.pm * BM + ai * HALF + wr * 64 + m * 16 + fr) * ld + col0;
#pragma unroll
                for (int bj = 0; bj < 2; ++bj)
#pragma unroll
                    for (int n = 0; n < 2; ++n) { const f32x4 s = *(const f32x4*)(src + off + bj * HALF + n * 16);
                        *(f32x4*)(dst + off + bj * HALF + n * 16) = s * alpha + acc[ai][bj][m][n] * beta; } }
    }
};

constexpr float LN_EPS_F = 1e-5f;
template <bool HAS> __device__ __forceinline__ void ln_row_stats(const float* st, int row, float& mu, float& rs) {
    if (!HAS) { mu = 0.f; rs = 1.f; return; }
    const f32x2 s = *(const f32x2*)(st + 2 * (size_t)row);
    mu = s.x * (1.0f / 1024.0f); const float var = fmaxf(s.y * (1.0f / 1024.0f) - mu * mu, 0.f); rs = 1.0f / sqrtf(var + LN_EPS_F);
}
struct EpiStoreBf16LN {
    static constexpr bool PERM = true, AFTER_DRAIN = false;
    bf16_t* O; int ldc; const float* st; const float* c1; const float* c2;
    __device__ __forceinline__ void operator()(const f32x4 (&acc)[2][2][4][2], const Unit& u, int wr, int wc, int fr, int fq) const {
        int row0 = u.pm * BM + wr * 64 + fr; int col0 = u.pn * BM + wc * 32 + 8 * fq;
        asm volatile("" : "+v"(row0), "+v"(col0));
        f32x4 c1v[2][2], c2v[2][2];
#pragma unroll
        for (int bj = 0; bj < 2; ++bj)
#pragma unroll
            for (int n = 0; n < 2; ++n) { c1v[bj][n] = *(const f32x4*)(c1 + col0 + bj * HALF + 4 * n); c2v[bj][n] = *(const f32x4*)(c2 + col0 + bj * HALF + 4 * n); }
#pragma unroll
        for (int ai = 0; ai < 2; ++ai)
#pragma unroll
            for (int m = 0; m < 4; ++m) { const int row = row0 + ai * HALF + m * 16; float mu, rs; ln_row_stats<true>(st, row, mu, rs);
                bf16_t* rowp = O + (size_t)row * ldc + col0;
#pragma unroll
                for (int bj = 0; bj < 2; ++bj) { const f32x4 v0 = (acc[ai][bj][m][0] - c1v[bj][0] * mu) * rs + c2v[bj][0], v1 = (acc[ai][bj][m][1] - c1v[bj][1] * mu) * rs + c2v[bj][1];
                    u32x4 w; w.x = cvt_pk_bf16(v0[0], v0[1]); w.y = cvt_pk_bf16(v0[2], v0[3]); w.z = cvt_pk_bf16(v1[0], v1[1]); w.w = cvt_pk_bf16(v1[2], v1[3]);
                    *(u32x4*)(rowp + bj * HALF) = w; } }
    }
};
template <bool HAS_LN> struct EpiSwiGLULN {
    static constexpr bool PERM = true, AFTER_DRAIN = false;
    bf16_t* H; int ldh; const float* st; const float* c1; const float* c2;
    __device__ __forceinline__ void operator()(const f32x4 (&acc)[2][2][4][2], const Unit& u, int wr, int wc, int fr, int fq) const {
        int row0 = u.pm * BM + wr * 64 + fr; const int col0 = u.pn * HALF + wc * 32 + 8 * fq; int wcol0 = u.pn * BM + wc * 32 + 8 * fq;
        asm volatile("" : "+v"(row0), "+v"(wcol0));
        f32x4 c1v[2][2], c2v[2][2];
#pragma unroll
        for (int bj = 0; bj < 2; ++bj)
#pragma unroll
            for (int n = 0; n < 2; ++n) { c1v[bj][n] = *(const f32x4*)(c1 + wcol0 + bj * HALF + 4 * n); c2v[bj][n] = *(const f32x4*)(c2 + wcol0 + bj * HALF + 4 * n); }
#pragma unroll
        for (int ai = 0; ai < 2; ++ai)
#pragma unroll
            for (int m = 0; m < 4; ++m) { const int row = row0 + ai * HALF + m * 16; float mu, rs; ln_row_stats<HAS_LN>(st, row, mu, rs);
                bf16_t* rowp = H + (size_t)row * ldh + col0;
                const f32x4 g0 = (acc[ai][0][m][0] - c1v[0][0] * mu) * rs + c2v[0][0], g1 = (acc[ai][0][m][1] - c1v[0][1] * mu) * rs + c2v[0][1];
                const f32x4 u0 = (acc[ai][1][m][0] - c1v[1][0] * mu) * rs + c2v[1][0], u1 = (acc[ai][1][m][1] - c1v[1][1] * mu) * rs + c2v[1][1];
                u32x4 w;
                w.x = cvt_pk_bf16(silu_mul(g0[0], u0[0]), silu_mul(g0[1], u0[1])); w.y = cvt_pk_bf16(silu_mul(g0[2], u0[2]), silu_mul(g0[3], u0[3]));
                w.z = cvt_pk_bf16(silu_mul(g1[0], u1[0]), silu_mul(g1[1], u1[1])); w.w = cvt_pk_bf16(silu_mul(g1[2], u1[2]), silu_mul(g1[3], u1[3]));
                *(u32x4*)rowp = w; }
    }
};
constexpr size_t EPI_WS_XB = (size_t)166 << 20, EPI_WS_STATS = ((size_t)568 << 20) + ((size_t)1 << 20); constexpr int EPI_T = 32768;
template <bool HAS_LN> struct EpiResidLN {
    static constexpr bool PERM = true, AFTER_DRAIN = false;
    static constexpr int ld = 1024;
    const float* src; float* dst; unsigned char* ws; const float* g_in; const float* b_in; int s_in; float alpha, beta;
    __device__ __forceinline__ void operator()(const f32x4 (&acc)[2][2][4][2], const Unit& u, int wr, int wc, int fr, int fq) const {
        int col0 = u.pn * BM + wc * 32 + 8 * fq; int rowb = u.pm * BM + wr * 64 + fr;
        asm volatile("" : "+v"(col0), "+v"(rowb));
        const float* rd = HAS_LN ? (const float*)dst : src;
        bf16_t* yb = (bf16_t*)(ws + EPI_WS_XB);
        const float* st_in = (const float*)(ws + EPI_WS_STATS) + (size_t)s_in * EPI_T * 2; float* st_out = (float*)(ws + EPI_WS_STATS) + (size_t)(s_in + 1) * EPI_T * 2;
        f32x4 gv[2][2], bv[2][2];
#pragma unroll
        for (int bj = 0; bj < 2; ++bj)
#pragma unroll
            for (int n = 0; n < 2; ++n) { if (HAS_LN) { gv[bj][n] = *(const f32x4*)(g_in + col0 + bj * HALF + 4 * n); bv[bj][n] = *(const f32x4*)(b_in + col0 + bj * HALF + 4 * n); }
                                          else { gv[bj][n] = (f32x4){1.f, 1.f, 1.f, 1.f}; bv[bj][n] = (f32x4){0.f, 0.f, 0.f, 0.f}; } }
#pragma unroll
        for (int ai = 0; ai < 2; ++ai)
#pragma unroll
            for (int m = 0; m < 4; ++m) { const int row = rowb + ai * HALF + m * 16; const size_t off = (size_t)row * ld + col0;
                float mu, rs; ln_row_stats<HAS_LN>(st_in, row, mu, rs);
                float ps = 0.f, pq = 0.f;
#pragma unroll
                for (int bj = 0; bj < 2; ++bj) { f32x4 yn[2];
#pragma unroll
                    for (int n = 0; n < 2; ++n) { const f32x4 y = *(const f32x4*)(rd + off + bj * HALF + 4 * n);
                        const f32x4 x = HAS_LN ? (y - mu) * rs * gv[bj][n] + bv[bj][n] : y;
                        yn[n] = x * alpha + acc[ai][bj][m][n] * beta;
                        *(f32x4*)(dst + off + bj * HALF + 4 * n) = yn[n];
                        ps += (yn[n][0] + yn[n][1]) + (yn[n][2] + yn[n][3]); pq += (yn[n][0] * yn[n][0] + yn[n][1] * yn[n][1]) + (yn[n][2] * yn[n][2] + yn[n][3] * yn[n][3]); }
                    u32x4 w; w.x = cvt_pk_bf16(yn[0][0], yn[0][1]); w.y = cvt_pk_bf16(yn[0][2], yn[0][3]); w.z = cvt_pk_bf16(yn[1][0], yn[1][1]); w.w = cvt_pk_bf16(yn[1][2], yn[1][3]);
                    *(u32x4*)(yb + off + bj * HALF) = w; }
                ps += __shfl_xor(ps, 16); ps += __shfl_xor(ps, 32); pq += __shfl_xor(pq, 16); pq += __shfl_xor(pq, 32);
                if (fq == 0) { atomicAdd(st_out + 2 * (size_t)row, ps); atomicAdd(st_out + 2 * (size_t)row + 1, pq); } }
    }
};
template <class Epi, class Sched, bool ALIGN_EPI = false, bool SP2 = false>
__device__ __forceinline__ void gemm_phase(PG8_LAS unsigned char* lds, const Gemm g, const Sched S, const Epi E) {
    int tid_ = threadIdx.x; asm volatile("" : "+v"(tid_));
    const int tid = tid_, wid = __builtin_amdgcn_readfirstlane(tid >> 6), lane = tid & 63, wr = wid >> 2, wc = wid & 3, fr = lane & 15, fq = lane >> 4;
    const int K = g.K, nt = K / BK;
    unsigned voffA[2], voffB[2];
#pragma unroll
    for (int i = 0; i < 2; ++i) { int R, C; stage_rc(tid * 16 + i * 8192, R, C); const int Rb = Epi::PERM ? ((R & ~31) + perm32(R & 31)) : R;
        voffA[i] = (unsigned)(R * K + C) * 2u; voffB[i] = (unsigned)(Rb * K + C) * 2u; }
    const size_t kstep = (size_t)(BK * 2);
    const size_t hstep = (size_t)HALF * K * 2;
    const size_t tstep = 2 * hstep;
    const unsigned ldsw = (unsigned)wid * 1024u;
    const int aoff = lds_byte(wr * 64 + fr, fq * 8), boff = lds_byte(wc * 32 + fr, fq * 8);
#define PG8_SA(b, h) (((b) * 2 + (h)) * HTB)
#define PG8_SB(b, h) ((4 + (b) * 2 + (h)) * HTB)
#define PG8_STAGE(bufoff, gbase, voff) do { _Pragma("unroll") for (int _i = 0; _i < 2; ++_i) \
        __builtin_amdgcn_global_load_lds((const unsigned*)((const char*)(gbase) + (voff)[_i]), (PG8_LAS unsigned*)(lds + (bufoff) + ldsw + _i * 8192), 16, 0, 0); } while (0)
#define PG8_LDA(dst, b, h) do { _Pragma("unroll") for (int m = 0; m < 4; ++m) _Pragma("unroll") for (int k = 0; k < 2; ++k) dst[m][k] = *(const PG8_LAS bf16x8*)(lds + PG8_SA(b, h) + aoff + m * 2048 + k * 1024); } while (0)
#define PG8_LDB(dst, b, h) do { _Pragma("unroll") for (int n = 0; n < 2; ++n) _Pragma("unroll") for (int k = 0; k < 2; ++k) dst[n][k] = *(const PG8_LAS bf16x8*)(lds + PG8_SB(b, h) + boff + n * 2048 + k * 1024); } while (0)
#define PG8_MMA(ai, bj, At, Bt) do { __builtin_amdgcn_s_setprio(1); _Pragma("unroll") for (int m = 0; m < 4; ++m) _Pragma("unroll") for (int n = 0; n < 2; ++n) _Pragma("unroll") for (int k = 0; k < 2; ++k) \
        acc[ai][bj][m][n] = __builtin_amdgcn_mfma_f32_16x16x32_bf16(Bt[n][k], At[m][k], acc[ai][bj][m][n], 0, 0, 0); __builtin_amdgcn_s_setprio(0); } while (0)
#define PG8_WAIT_V(n) asm volatile("s_waitcnt vmcnt(" #n ")" ::: "memory")
#define PG8_WAIT_L(n) asm volatile("s_waitcnt lgkmcnt(" #n ")" ::: "memory")
#define PG8_BAR __builtin_amdgcn_s_barrier()
#define PG8_SCHED __builtin_amdgcn_sched_barrier(0)
    Unit cur, nxt; int ui = 0;
    if (!S.next(0, cur)) return;
    f32x4 acc[2][2][4][2];
#pragma unroll
    for (int a = 0; a < 2; ++a)
#pragma unroll
        for (int b = 0; b < 2; ++b)
#pragma unroll
            for (int m = 0; m < 4; ++m)
#pragma unroll
                for (int n = 0; n < 2; ++n) acc[a][b][m][n] = (f32x4){0.f, 0.f, 0.f, 0.f};
    bf16x8 At[4][2], B0[2][2], B1[2][2];
    const char* cA = (const char*)g.A + (size_t)cur.pm * tstep; const char* cB = (const char*)g.Bt + (size_t)cur.pn * tstep;
    S.a_ready(cur);
    if constexpr (SP2) {
        PG8_STAGE(PG8_SB(0, 0), cB, voffB); PG8_STAGE(PG8_SB(0, 1), cB + hstep, voffB); PG8_STAGE(PG8_SA(0, 0), cA, voffA); PG8_STAGE(PG8_SA(0, 1), cA + hstep, voffA);
        if (wr == 1) PG8_BAR;
        PG8_WAIT_V(2); PG8_BAR;
        PG8_STAGE(PG8_SB(1, 0), cB + kstep, voffB); PG8_STAGE(PG8_SA(1, 0), cA + kstep, voffA); PG8_STAGE(PG8_SB(1, 1), cB + hstep + kstep, voffB);
        PG8_WAIT_V(6); PG8_BAR;
    } else {
        PG8_STAGE(PG8_SB(0, 0), cB, voffB); PG8_STAGE(PG8_SA(0, 0), cA, voffA); PG8_STAGE(PG8_SB(0, 1), cB + hstep, voffB); PG8_STAGE(PG8_SA(0, 1), cA + hstep, voffA);
        if (wr == 1) PG8_BAR;
        PG8_WAIT_V(4); PG8_BAR;
        PG8_STAGE(PG8_SB(1, 0), cB + kstep, voffB); PG8_STAGE(PG8_SA(1, 0), cA + kstep, voffA); PG8_STAGE(PG8_SB(1, 1), cB + hstep + kstep, voffB);
        PG8_WAIT_V(6); PG8_BAR;
    }
    for (;;) {
        const bool has_next = S.next(ui + 1, nxt);
        const char* nA = has_next ? (const char*)g.A + (size_t)nxt.pm * tstep : cA; const char* nB = has_next ? (const char*)g.Bt + (size_t)nxt.pn * tstep : cB;
        for (int t = 0; t < nt; t += 2) {
            const bool last = (t == nt - 2);
            const char* a1 = cA + (size_t)(t + 1) * kstep;
            const char* a2 = last ? nA : cA + (size_t)(t + 2) * kstep; const char* b2 = last ? nB : cB + (size_t)(t + 2) * kstep;
            const char* a3 = a2 + kstep; const char* b3 = b2 + kstep;
            if (last && has_next) S.a_ready(nxt);
            if constexpr (SP2) {
            PG8_LDB(B0, 0, 0); PG8_LDB(B1, 0, 1); PG8_SCHED; PG8_LDA(At, 0, 0); PG8_STAGE(PG8_SA(1, 1), a1 + hstep, voffA);
            PG8_WAIT_V(8); PG8_WAIT_L(0); PG8_BAR; PG8_MMA(0, 0, At, B0); PG8_MMA(0, 1, At, B1); PG8_BAR; PG8_SCHED;
            PG8_LDA(At, 0, 1); PG8_STAGE(PG8_SB(0, 0), b2, voffB); PG8_STAGE(PG8_SB(0, 1), b2 + hstep, voffB); PG8_STAGE(PG8_SA(0, 0), a2, voffA);
            PG8_WAIT_V(8); PG8_WAIT_L(0); PG8_BAR; PG8_MMA(1, 0, At, B0); PG8_MMA(1, 1, At, B1); PG8_BAR; PG8_SCHED;
            PG8_LDB(B0, 1, 0); PG8_LDB(B1, 1, 1); PG8_SCHED; PG8_LDA(At, 1, 0); PG8_STAGE(PG8_SA(0, 1), a2 + hstep, voffA);
            PG8_WAIT_V(8); PG8_WAIT_L(0); PG8_BAR; PG8_MMA(0, 0, At, B0); PG8_MMA(0, 1, At, B1); PG8_BAR; PG8_SCHED;
            PG8_LDA(At, 1, 1); PG8_STAGE(PG8_SB(1, 0), b3, voffB); PG8_STAGE(PG8_SB(1, 1), b3 + hstep, voffB); PG8_STAGE(PG8_SA(1, 0), a3, voffA);
            PG8_WAIT_V(8); PG8_WAIT_L(0); PG8_BAR; PG8_MMA(1, 0, At, B0); PG8_MMA(1, 1, At, B1); PG8_BAR; PG8_SCHED;
            } else {
            PG8_LDB(B0, 0, 0); PG8_SCHED; PG8_LDA(At, 0, 0); PG8_STAGE(PG8_SA(1, 1), a1 + hstep, voffA);
            PG8_WAIT_L(8); PG8_BAR; PG8_WAIT_L(0); PG8_MMA(0, 0, At, B0); PG8_BAR; PG8_SCHED;
            PG8_LDB(B1, 0, 1); PG8_STAGE(PG8_SB(0, 0), b2, voffB);
            PG8_BAR; PG8_WAIT_L(0); PG8_MMA(0, 1, At, B1); PG8_BAR;
            PG8_LDA(At, 0, 1); PG8_STAGE(PG8_SA(0, 0), a2, voffA);
            PG8_BAR; PG8_WAIT_L(0); PG8_MMA(1, 0, At, B0); PG8_BAR; PG8_SCHED;
            PG8_STAGE(PG8_SB(0, 1), b2 + hstep, voffB);
            PG8_WAIT_V(6); PG8_BAR; PG8_MMA(1, 1, At, B1); PG8_BAR;
            PG8_LDB(B0, 1, 0); PG8_SCHED; PG8_LDA(At, 1, 0); PG8_STAGE(PG8_SA(0, 1), a2 + hstep, voffA);
            PG8_WAIT_L(8); PG8_BAR; PG8_WAIT_L(0); PG8_MMA(0, 0, At, B0); PG8_BAR; PG8_SCHED;
            PG8_LDB(B1, 1, 1); PG8_STAGE(PG8_SB(1, 0), b3, voffB);
            PG8_BAR; PG8_WAIT_L(0); PG8_MMA(0, 1, At, B1); PG8_BAR;
            PG8_LDA(At, 1, 1); PG8_STAGE(PG8_SA(1, 0), a3, voffA);
            PG8_BAR; PG8_WAIT_L(0); PG8_MMA(1, 0, At, B0); PG8_BAR; PG8_SCHED;
            PG8_STAGE(PG8_SB(1, 1), b3 + hstep, voffB);
            PG8_WAIT_V(6); PG8_BAR; PG8_MMA(1, 1, At, B1); PG8_BAR;
            }
        }
        if constexpr (ALIGN_EPI) { if (wr == 0) PG8_BAR; }
        if constexpr (!Epi::AFTER_DRAIN) { E(acc, cur, wr, wc, fr, fq); S.done(cur); }
        if (!has_next) break;
#pragma unroll
        for (int a = 0; a < 2; ++a)
#pragma unroll
            for (int b = 0; b < 2; ++b)
#pragma unroll
                for (int m = 0; m < 4; ++m)
#pragma unroll
                    for (int n = 0; n < 2; ++n) acc[a][b][m][n] = (f32x4){0.f, 0.f, 0.f, 0.f};
        cur = nxt; cA = nA; cB = nB; ++ui;
        if constexpr (ALIGN_EPI) { if (wr == 1) PG8_BAR; }
    }
    PG8_WAIT_V(0);
    if constexpr (!ALIGN_EPI) { if (wr == 0) PG8_BAR; }
    PG8_BAR;
    if constexpr (Epi::AFTER_DRAIN) { E.fused(acc, cur, wr, wc, fr, fq, lds, wid, lane); S.done(cur); }
#undef PG8_SA
#undef PG8_SB
#undef PG8_STAGE
#undef PG8_LDA
#undef PG8_LDB
#undef PG8_MMA
#undef PG8_WAIT_V
#undef PG8_WAIT_L
#undef PG8_BAR
#undef PG8_SCHED
}
}
#define LAS __attribute__((address_space(3)))
typedef unsigned short bf16_t;
typedef short bf16x8 __attribute__((ext_vector_type(8)));
typedef short s16x4 __attribute__((ext_vector_type(4)));
typedef float f32x4 __attribute__((ext_vector_type(4)));
typedef float f32x16 __attribute__((ext_vector_type(16)));
typedef unsigned u32x4 __attribute__((ext_vector_type(4)));
typedef unsigned u32x2 __attribute__((ext_vector_type(2)));
typedef float f32x2_t __attribute__((ext_vector_type(2)));
typedef __bf16 bf16x2_t __attribute__((ext_vector_type(2)));

constexpr int NB = 2, SEQ = 16384, T = NB * SEQ, DM = 1024, DEPTH = 4, DFF = 2816, NGU = 2 * DFF;
constexpr int NIN_SRC = 2208, NPROJ = 3328;
constexpr int PA = 0, PC = 512, PD = 1024, PCQ = 1792, PCKV = 2048, PKR = 2176, PQUP = 2208, PKVUP = 2592, PEND = 3104;
constexpr float LOG2E = 1.4426950408889634f;
constexpr float NORM_EPS = 1e-5f;
constexpr int NWAVES = 8, NTHREADS = 512;
constexpr int LDS_BYTES = 147456;

constexpr size_t MiB = 1u << 20;
constexpr size_t WS_WGU = 0, WS_WD = 88 * MiB, WS_WIN = 132 * MiB, WS_WOUT = 158 * MiB, WS_XB = 166 * MiB;
constexpr size_t WS_H = 230 * MiB, WS_PROJ = 230 * MiB, WS_QB = 438 * MiB, WS_KB = 462 * MiB, WS_VB = 486 * MiB, WS_MIX = 502 * MiB, WS_AUG = 566 * MiB, WS_CTL = 568 * MiB, WS_KMAX = WS_CTL, WS_QCTR = WS_CTL + 1024, WS_C12 = WS_CTL + 4096, WS_BAR = WS_CTL + 512 * 1024, WS_STATS = WS_CTL + 1 * MiB, CTL_BYTES = 4 * MiB, WS_END = 572 * MiB;
constexpr int C12_L = 2 * NGU + NPROJ;
constexpr size_t C2_OFF = (size_t)DEPTH * C12_L;
static_assert(pg8::EPI_WS_XB == WS_XB && pg8::EPI_WS_STATS == WS_STATS && pg8::EPI_T == T, "part1's copies of the workspace map");
static_assert(WS_C12 + 2 * C2_OFF * 4 <= WS_BAR && WS_BAR + 3456 * 4 <= WS_STATS, "control region");
static_assert(WS_C12 + 2 * C2_OFF * 4 <= WS_STATS && WS_STATS + (size_t)12 * T * 8 <= WS_CTL + CTL_BYTES, "control region");
constexpr size_t WGU_L = (size_t)2 * NGU * DM, WGU_F = (size_t)NGU * DM;
constexpr size_t WD_L = (size_t)2 * DM * DFF, WD_F = (size_t)DM * DFF;
constexpr size_t WIN_L = (size_t)NPROJ * DM, WOUT_L = (size_t)DM * DM;

struct Params {
    const float* x; const float* w_in; const float* win_sink; const float* mla_q_norm; const float* mla_w_uq; const float* mla_kv_norm; const float* mla_w_ukv;
    const float* ax_q_norm; const float* ax_k_norm; const float* diff_lambda; const float* diff_subln; const float* w_out; const float* ffn_w_gu; const float* ffn_w_down;
    const float* ln_g; const float* ln_b;
    float* out; unsigned char* ws;
    float lam_init[4];
    float inv32[16];
};

typedef const __attribute__((address_space(4))) Params* KP;
#define GETP(name) KP name = (KP)__builtin_amdgcn_kernarg_segment_ptr(); asm volatile("" : "+s"(name))

__device__ __forceinline__ int tid_fresh() { int t = threadIdx.x; asm volatile("" : "+v"(t)); return t; }
__device__ __forceinline__ unsigned pkbf(float lo, float hi) { f32x2_t v = {lo, hi}; bf16x2_t b = __builtin_convertvector(v, bf16x2_t); return __builtin_bit_cast(unsigned, b); }
__device__ __forceinline__ float bflo(unsigned w) { return __builtin_bit_cast(float, w << 16); }
__device__ __forceinline__ float bfhi(unsigned w) { return __builtin_bit_cast(float, w & 0xffff0000u); }
__device__ __forceinline__ float wave_sum(float v) {
#pragma unroll
    for (int o = 1; o < 64; o <<= 1) v += __shfl_xor(v, o);
    return v;
}
__device__ __forceinline__ void unpack8(const u32x4 w, float (&v)[8]) {
    v[0] = bflo(w.x); v[1] = bfhi(w.x); v[2] = bflo(w.y); v[3] = bfhi(w.y); v[4] = bflo(w.z); v[5] = bfhi(w.z); v[6] = bflo(w.w); v[7] = bfhi(w.w);
}
__device__ __forceinline__ u32x4 pack8(const float (&v)[8]) { u32x4 w; w.x = pkbf(v[0], v[1]); w.y = pkbf(v[2], v[3]); w.z = pkbf(v[4], v[5]); w.w = pkbf(v[6], v[7]); return w; }

__device__ __forceinline__ void transpose_item(const float* __restrict__ W, int ldw, int src_col0, float scale, bf16_t* __restrict__ WT, int K, int dst_row0, int k0, LAS float* scr, int lane,
                                               const float* __restrict__ lng, const float* __restrict__ lnb, float* c1, float* c2) {
    if (src_col0 < 0) {
        const int c = lane & 7;
#pragma unroll
        for (int j = 0; j < 4; ++j) { const int n = (lane >> 3) + 8 * j; *(u32x4*)(WT + (size_t)(dst_row0 + n) * K + k0 + 8 * c) = (u32x4){0u, 0u, 0u, 0u}; }
        return;
    }
    float a1 = 0.f, a2 = 0.f;
#pragma unroll
    for (int i = 0; i < 32; ++i) { const int kk = 2 * i + (lane >> 5); float w = W[(size_t)(k0 + kk) * ldw + src_col0 + (lane & 31)] * scale;
        if (lng) { a2 = fmaf(lnb[k0 + kk], w, a2); w *= lng[k0 + kk]; a1 += bflo(pkbf(w, 0.f)); }
        scr[kk * 33 + (lane & 31)] = w; }
    asm volatile("s_waitcnt lgkmcnt(0)" ::: "memory");
    const int c = lane & 7;
#pragma unroll
    for (int j = 0; j < 4; ++j) { const int n = (lane >> 3) + 8 * j; const LAS float* s = scr + (8 * c) * 33 + n;
        u32x4 o; o.x = pkbf(s[0 * 33], s[1 * 33]); o.y = pkbf(s[2 * 33], s[3 * 33]); o.z = pkbf(s[4 * 33], s[5 * 33]); o.w = pkbf(s[6 * 33], s[7 * 33]);
        *(u32x4*)(WT + (size_t)(dst_row0 + n) * K + k0 + 8 * c) = o; }
    asm volatile("s_waitcnt lgkmcnt(0)" ::: "memory");
    if (lng) { a1 += __shfl_xor(a1, 32); a2 += __shfl_xor(a2, 32);
        if (lane < 32) { atomicAdd(c1 + dst_row0 + lane, a1); atomicAdd(c2 + dst_row0 + lane, a2); } }
}

__device__ __forceinline__ void phase0(KP p, LAS unsigned char* lds, int vcu, int G) {
    const int tid = tid_fresh(), lane = tid & 63, wave = __builtin_amdgcn_readfirstlane(tid >> 6);
    LAS float* scr = (LAS float*)(lds + wave * 16384);
    const int gw = vcu * NWAVES + wave, NGW = G * NWAVES;
    bf16_t* wgu = (bf16_t*)(p->ws + WS_WGU); bf16_t* wd = (bf16_t*)(p->ws + WS_WD); bf16_t* win = (bf16_t*)(p->ws + WS_WIN); bf16_t* wout = (bf16_t*)(p->ws + WS_WOUT);
    float* c12 = (float*)(p->ws + WS_C12);
    constexpr int I_GU = 176 * 16, I_WD = 32 * 44, I_IN = 104 * 16, I_OUT = 32 * 16, I_CMP = 128 * 14;
    constexpr int I_LAYER = 2 * I_GU + 2 * I_WD + I_IN + I_OUT + I_CMP;
    for (int it = gw; it < DEPTH * I_LAYER; it += NGW) {
        const int l = it / I_LAYER; int r = it % I_LAYER;
        if (r < 2 * I_GU) { const int f = r / I_GU; r %= I_GU; const int nb = r / 16, kb = r % 16; const int n0 = 32 * nb;
            const int pn = n0 >> 8, bj = (n0 >> 7) & 1, i0 = n0 & 127;
            const int s = 3 * l + 2 * f - 1;
            transpose_item(p->ffn_w_gu + ((size_t)l * 2 + f) * DM * NGU, NGU, bj * DFF + 128 * pn + i0, 1.f, wgu + l * WGU_L + f * WGU_F, DM, n0, 64 * kb, scr, lane,
                           s >= 0 ? p->ln_g + s * DM : nullptr, s >= 0 ? p->ln_b + s * DM : nullptr, c12 + l * C12_L + f * NGU, c12 + C2_OFF + l * C12_L + f * NGU); continue; }
        r -= 2 * I_GU;
        if (r < 2 * I_WD) { const int f = r / I_WD; r %= I_WD; const int nb = r / 44, kb = r % 44;
            transpose_item(p->ffn_w_down + ((size_t)l * 2 + f) * DFF * DM, DM, 32 * nb, 1.f, wd + l * WD_L + f * WD_F, DFF, 32 * nb, 64 * kb, scr, lane, nullptr, nullptr, nullptr, nullptr); continue; }
        r -= 2 * I_WD;
        if (r < I_IN) { const int nb = r / 16, kb = r % 16; const int n0 = 32 * nb; int src; float sc = 1.f;
            if (n0 < PC) { src = n0; if (n0 < 256) sc = 0.125f; }
            else if (n0 < PD) src = 928 + (n0 - PC);
            else if (n0 < PCQ) { src = 1440 + (n0 - PD); if (n0 - PD < 256) sc = 0.17677669529663687f; }
            else if (n0 < PCKV) src = 512 + (n0 - PCQ);
            else if (n0 < PKR) src = 768 + (n0 - PCKV);
            else if (n0 < PQUP) src = 896;
            else if (n0 < PEND) continue;
            else src = -1;
            transpose_item(p->w_in + (size_t)l * DM * NIN_SRC, NIN_SRC, src, sc, win + l * WIN_L, DM, n0, 64 * kb, scr, lane,
                           p->ln_g + (3 * l) * DM, p->ln_b + (3 * l) * DM, c12 + l * C12_L + 2 * NGU, c12 + C2_OFF + l * C12_L + 2 * NGU); continue; }
        r -= I_IN;
        if (r < I_OUT) { const int nb = r / 16, kb = r % 16;
            transpose_item(p->w_out + (size_t)l * DM * DM, DM, 32 * nb, 1.f, wout + l * WOUT_L, DM, 32 * nb, 64 * kb, scr, lane, nullptr, nullptr, nullptr, nullptr); continue; }
        r -= I_OUT;
        {
            const int kb8 = r / 14, ng = r % 14; const int k0 = 8 * kb8;
            int J, cA, ldu, nc; const float* g; const float* U;
            if (ng < 6) { J = 256; cA = 512; g = p->mla_q_norm + l * 256; U = p->mla_w_uq + (size_t)l * 256 * 384; ldu = 384; nc = 64 * ng; }
            else { J = 128; cA = 768; g = p->mla_kv_norm + l * 128; U = p->mla_w_ukv + (size_t)l * 128 * 512; ldu = 512; nc = 64 * (ng - 6); }
            const int nglob = (ng < 6 ? 0 : 384) + nc + lane;
            const float* a = p->w_in + (size_t)l * DM * NIN_SRC + (size_t)k0 * NIN_SRC + cA;
            const float* up = U + nc + lane;
            float acc[8];
#pragma unroll
            for (int e = 0; e < 8; ++e) acc[e] = 0.f;
#pragma unroll 4
            for (int j = 0; j < J; ++j) { const float u = up[(size_t)j * ldu] * g[j];
#pragma unroll
                for (int e = 0; e < 8; ++e) acc[e] = fmaf(a[(size_t)e * NIN_SRC + j], u, acc[e]); }
            const float* lg = p->ln_g + (3 * l) * DM + k0; const float* lb = p->ln_b + (3 * l) * DM + k0;
            float s1 = 0.f, s2 = 0.f; unsigned wb[8];
#pragma unroll
            for (int e = 0; e < 8; ++e) { wb[e] = pkbf(acc[e] * lg[e], 0.f) & 0xffffu; s1 += bflo(wb[e]); s2 = fmaf(acc[e], lb[e], s2); }
            u32x4 o; o.x = wb[0] | (wb[1] << 16); o.y = wb[2] | (wb[3] << 16); o.z = wb[4] | (wb[5] << 16); o.w = wb[6] | (wb[7] << 16);
            *(u32x4*)(win + l * WIN_L + (size_t)(PQUP + nglob) * DM + k0) = o;
            atomicAdd(c12 + l * C12_L + 2 * NGU + PQUP + nglob, s1); atomicAdd(c12 + C2_OFF + l * C12_L + 2 * NGU + PQUP + nglob, s2);
        }
    }
    { u32x4* ag = (u32x4*)(p->ws + WS_AUG);
      for (int i = (vcu * NWAVES + wave) * 64 + lane; i < SEQ * 4; i += G * NWAVES * 64) { const int t = i >> 2, h = i & 3;
          const float sl = __builtin_amdgcn_exp2f(-(float)(5 + h));
          u32x4 w = {pkbf(sl * (float)(128 * (t >> 7)), sl * (float)(t & 127)), 0u, 0u, 0u}; ag[2 * i] = w; ag[2 * i + 1] = (u32x4){0u, 0u, 0u, 0u}; } }
    bf16_t* xb = (bf16_t*)(p->ws + WS_XB);
    for (int m = gw; m < T; m += NGW) {
        const f32x4* xr = (const f32x4*)(p->x + (size_t)m * DM) + lane; u32x2* o8 = (u32x2*)(xb + (size_t)m * DM) + lane;
#pragma unroll
        for (int j = 0; j < 4; ++j) { const f32x4 v = xr[64 * j]; u32x2 w; w.x = pkbf(v.x, v.y); w.y = pkbf(v.z, v.w); o8[64 * j] = w; }
    }
}

template <bool WRITE_XB> __device__ __forceinline__ void ln_phase(float* X, bf16_t* xb, const float* __restrict__ g, const float* __restrict__ b, int vcu, int G) {
    const int tid = tid_fresh(), lane = tid & 63, wave = __builtin_amdgcn_readfirstlane(tid >> 6);
    const int gw = vcu * NWAVES + wave, NGW = G * NWAVES;
    f32x4 gv[4], bv[4];
#pragma unroll
    for (int j = 0; j < 4; ++j) { gv[j] = ((const f32x4*)g)[64 * j + lane]; bv[j] = ((const f32x4*)b)[64 * j + lane]; }
    for (int m = gw; m < T; m += NGW) {
        f32x4* xr = (f32x4*)(X + (size_t)m * DM) + lane; u32x2* o8 = (u32x2*)(xb + (size_t)m * DM) + lane;
        f32x4 v[4]; float s = 0.f;
#pragma unroll
        for (int j = 0; j < 4; ++j) { v[j] = xr[64 * j]; s += (v[j].x + v[j].y) + (v[j].z + v[j].w); }
        const float mean = wave_sum(s) * (1.f / DM); float s2 = 0.f;
#pragma unroll
        for (int j = 0; j < 4; ++j) { v[j] = v[j] - mean; s2 += (v[j].x * v[j].x + v[j].y * v[j].y) + (v[j].z * v[j].z + v[j].w * v[j].w); }
        const float rstd = 1.f / sqrtf(wave_sum(s2) * (1.f / DM) + NORM_EPS);
#pragma unroll
        for (int j = 0; j < 4; ++j) { const f32x4 y = v[j] * rstd * gv[j] + bv[j]; xr[64 * j] = y; if (WRITE_XB) { u32x2 w; w.x = pkbf(y.x, y.y); w.y = pkbf(y.z, y.w); o8[64 * j] = w; } }
    }
}

__device__ __forceinline__ void sincos_rev(float ang, float& s, float& c) {
    double d = (double)ang * 0.15915494309189535; d -= __builtin_rint(d); const float f = (float)d;
    s = __builtin_amdgcn_sinf(f); c = __builtin_amdgcn_cosf(f);
}
__device__ __forceinline__ void rope8(float (&v)[8], bool first, float pos, int i0, KP p) {
#pragma unroll
    for (int e = 0; e < 8; ++e) {
        const float other = __shfl_xor(v[e], 2);
        const float inv = i0 ? p->inv32[8 + e] : p->inv32[e];
        float s, c; sincos_rev(pos * inv, s, c);
        v[e] = first ? (v[e] * c - other * s) : (other * s + v[e] * c);
    }
}
__device__ __forceinline__ void prep_phase(KP p, int l, int vcu, int G) {
    const int tid = tid_fresh(), lane = tid & 63, wave = __builtin_amdgcn_readfirstlane(tid >> 6);
    const int gw = vcu * NWAVES + wave, NGW = G * NWAVES;
    bf16_t* proj = (bf16_t*)(p->ws + WS_PROJ); bf16_t* qb = (bf16_t*)(p->ws + WS_QB); bf16_t* kb = (bf16_t*)(p->ws + WS_KB); bf16_t* vb = (bf16_t*)(p->ws + WS_VB);
    float cg[8];
    { const float* gsrc = (lane < 32 ? p->ax_q_norm : p->ax_k_norm) + l * 64 + 8 * (lane & 7);
#pragma unroll
      for (int e = 0; e < 8; ++e) cg[e] = gsrc[e]; }
    float km0 = 0.f, km1 = 0.f;
    float kb0 = 0.f, kb1 = 0.f, kc0 = 0.f, kc1 = 0.f;
    for (int tok = gw; tok < T; tok += NGW) {
        const int t = tok & (SEQ - 1);
        bf16_t* pr = proj + (size_t)tok * NPROJ;
        const int l48 = lane < 48 ? lane : 0, l32 = lane < 32 ? lane : 0, l4 = lane < 4 ? lane : 0;
        const u32x4 in_cq = *(const u32x4*)(pr + PCQ + 8 * l48), in_qup = *(const u32x4*)(pr + PQUP + 8 * l48), in_kv = *(const u32x4*)(pr + PKVUP + 8 * lane);
        const u32x4 in_kr = *(const u32x4*)(pr + PKR + 8 * l4), in_c = *(const u32x4*)(pr + PC + 8 * l48), in_dk = *(const u32x4*)(pr + PD + 256 + 8 * l32);
        { float s = 0.f;
          if (lane < 32) { float v[8]; unpack8(in_dk, v);
#pragma unroll
              for (int e = 0; e < 8; ++e) s += v[e] * v[e]; }
          s += __shfl_xor(s, 1); s += __shfl_xor(s, 2);
          if (tok < SEQ) km0 = fmaxf(km0, s); else km1 = fmaxf(km1, s); }
        float ssq = 0.f;
        if (lane < 48) { float v[8]; unpack8(in_cq, v);
#pragma unroll
            for (int e = 0; e < 8; ++e) ssq += v[e] * v[e]; }
        const float ssq_q = wave_sum(lane < 32 ? ssq : 0.f), ssq_kv = wave_sum(lane >= 32 ? ssq : 0.f);
        const float rstd_q = 1.f / sqrtf(ssq_q * (1.f / 256.f) + NORM_EPS), rstd_kv = 1.f / sqrtf(ssq_kv * (1.f / 128.f) + NORM_EPS);
        {
            const int r = lane % 12; float v[8];
            unpack8(in_qup, v);
#pragma unroll
            for (int e = 0; e < 8; ++e) v[e] = (lane < 48) ? v[e] * rstd_q : 0.f;
            float w[8];
#pragma unroll
            for (int e = 0; e < 8; ++e) w[e] = v[e];
            rope8(w, r < 10, (float)t, 8 * (r & 1), p);
            const bool isr = (r >= 8); const float qs = 0.10206207261596575f;
#pragma unroll
            for (int e = 0; e < 8; ++e) v[e] = (isr ? w[e] : v[e]) * qs;
            if (lane < 48) *(u32x4*)(qb + (size_t)tok * 384 + 8 * lane) = pack8(v);
        }
        float nope2;
        {
            float v[8]; unpack8(in_kv, v);
#pragma unroll
            for (int e = 0; e < 8; ++e) v[e] *= rstd_kv;
            const int hd = lane >> 4, r = lane & 15;
            { float s = 0.f;
#pragma unroll
              for (int e = 0; e < 8; ++e) s += v[e] * v[e];
              s = (r < 8) ? s : 0.f; s += __shfl_xor(s, 1); s += __shfl_xor(s, 2); s += __shfl_xor(s, 4); nope2 = s; }
            if (r < 8) *(u32x4*)(kb + (size_t)tok * 384 + hd * 96 + 8 * r) = pack8(v);
            else *(u32x4*)(vb + (size_t)tok * 256 + hd * 64 + 8 * (r - 8)) = pack8(v);
        }
        {
            float v[8]; unpack8(in_kr, v);
            rope8(v, (lane & 3) < 2, (float)t, 8 * (lane & 1), p);
            { float s = 0.f;
#pragma unroll
              for (int e = 0; e < 8; ++e) s += v[e] * v[e];
              s = (lane < 4) ? s : 0.f; s += __shfl_xor(s, 1); s += __shfl_xor(s, 2);
              const float kk = nope2 + __shfl(s, 0);
              if (tok < SEQ) kb0 = fmaxf(kb0, kk); else kb1 = fmaxf(kb1, kk); }
            if (lane < 4) { const u32x4 w = pack8(v);
#pragma unroll
                for (int hd = 0; hd < 4; ++hd) *(u32x4*)(kb + (size_t)tok * 384 + hd * 96 + 64 + 8 * lane) = w; }
        }
        {
            float v[8]; unpack8(in_c, v);
            float s = 0.f;
#pragma unroll
            for (int e = 0; e < 8; ++e) s += v[e] * v[e];
            s += __shfl_xor(s, 1); s += __shfl_xor(s, 2); s += __shfl_xor(s, 4);
            const float rs = 1.f / sqrtf(s * (1.f / 64.f) + NORM_EPS);
#pragma unroll
            for (int e = 0; e < 8; ++e) v[e] = v[e] * rs * cg[e];
            const int r = lane & 7; const float pos = (r < 4) ? (float)(t >> 6) : (float)(t & 63);
            rope8(v, (r & 3) < 2, pos, 8 * (r & 1), p);
            { float s2 = 0.f;
#pragma unroll
              for (int e = 0; e < 8; ++e) s2 += v[e] * v[e];
              s2 += __shfl_xor(s2, 1); s2 += __shfl_xor(s2, 2); s2 += __shfl_xor(s2, 4);
              if (tok < SEQ) kc0 = fmaxf(kc0, s2); else kc1 = fmaxf(kc1, s2); }
            if (lane < 32) {
#pragma unroll
                for (int e = 0; e < 8; ++e) v[e] *= 0.125f; }
            if (lane < 48) *(u32x4*)(pr + PC + 8 * lane) = pack8(v);
        }
    }
    unsigned* kmw = (unsigned*)(p->ws + WS_KMAX) + l * 32;
    if (lane < 32 && (lane & 3) == 0) { atomicMax(kmw + (lane >> 2), __builtin_bit_cast(unsigned, km0)); atomicMax(kmw + 8 + (lane >> 2), __builtin_bit_cast(unsigned, km1)); }
    if ((lane & 15) == 0) { atomicMax(kmw + 16 + (lane >> 4), __builtin_bit_cast(unsigned, kb0)); atomicMax(kmw + 20 + (lane >> 4), __builtin_bit_cast(unsigned, kb1)); }
    if (lane == 32 || lane == 40) { atomicMax(kmw + 24 + ((lane - 32) >> 3), __builtin_bit_cast(unsigned, kc0)); atomicMax(kmw + 26 + ((lane - 32) >> 3), __builtin_bit_cast(unsigned, kc1)); }
}

#ifndef ATT_TYPES
#define ATT_TYPES 15
#endif
namespace att {
typedef float f32x2 __attribute__((ext_vector_type(2)));
constexpr int VPITCH = 144, KBUF = 64 * 208, VBUF = 64 * VPITCH;
constexpr int ATT_LDS = 2 * KBUF + 2 * VBUF;
constexpr float RESCALE_T = 5.0f;
__device__ __forceinline__ s16x4 vtr(const LAS char* p) { return __builtin_bit_cast(s16x4, __builtin_amdgcn_ds_read_tr16_b64_v4i16((LAS s16x4*)p)); }
__device__ __forceinline__ void xhalf_swap(float m, float& a, float& b) {
    a = m; b = m;
    asm volatile("s_nop 1\n\tv_permlane32_swap_b32 %0, %1\n\ts_nop 1" : "+v"(a), "+v"(b));
}
__device__ __forceinline__ float xhalf_max(float m) { float a, b; xhalf_swap(m, a, b); return fmaxf(a, b); }
__device__ __forceinline__ float xhalf_sum(float m) { float a, b; xhalf_swap(m, a, b); return a + b; }
__device__ __forceinline__ float max3f(float a, float b, float c) { return fmaxf(fmaxf(a, b), c); }
__device__ __forceinline__ float fma_s(float a, float b, float c) { float r; asm("v_fma_f32 %0, %1, %2, %3" : "=v"(r) : "v"(a), "s"(b), "v"(c)); return r; }
__device__ __forceinline__ float add_s(float a, float b) { float r; asm("v_add_f32_e32 %0, %1, %2" : "=v"(r) : "v"(a), "v"(b)); return r; }
__device__ __forceinline__ float mul_s(float a, float b) { float r; asm("v_mul_f32_e32 %0, %1, %2" : "=v"(r) : "v"(a), "v"(b)); return r; }
#define ATT_MFMA(a, b, c) __builtin_amdgcn_mfma_f32_32x32x16_bf16((a), (b), (c), 0, 0, 0)

template <int DK, int MODE, bool INIT = true, bool TRACK = (MODE == 2)>
__device__ __forceinline__ void flash_pass(LAS char* lds, const bf16_t* __restrict__ Qg, int qp, const bf16_t* __restrict__ Kg, int kp, const bf16_t* __restrict__ Vg, int vp,
                                           const bf16_t* __restrict__ AUGg, int q0, int a0, int nA, int b0, int nt, float slope, f32x16& O0, f32x16& O1, float& Mout, float& Lout) {
    constexpr int DKL = DK + (MODE == 1 ? 16 : 0);
    constexpr int KPITCH = DKL * 2 + 16, NKC = 8 * DKL, CPR = DKL / 8, NKS = DK / 16;
    constexpr bool HAS_K1 = NKC > 512;
    constexpr int DUMMY = 2 * KBUF + 2 * VBUF;
    const int tid = tid_fresh(), lane = tid & 63, r32 = lane & 31, hi = lane >> 5; const int wid = __builtin_amdgcn_readfirstlane(tid >> 6);
    const int qrow = q0 + wid * 32 + r32;
    bf16x8 qf[NKS];
#pragma unroll
    for (int ks = 0; ks < NKS; ++ks) qf[ks] = *(const bf16x8*)(Qg + (size_t)qrow * qp + 16 * ks + 8 * hi);
    const int kc1 = tid + 512;
    const bool k0v = tid < NKC, k1v = HAS_K1 && kc1 < NKC;
    const int kr0 = k0v ? tid / CPR : 0, kcc0 = k0v ? tid % CPR : 0, kr1 = k1v ? kc1 / CPR : 0, kcc1 = k1v ? kc1 % CPR : 0, vr = tid >> 3, vcc = tid & 7;
    const bf16_t* kg0; size_t kst0;
    if (MODE == 1 && kcc0 >= DK / 8) { kg0 = AUGg + (size_t)kr0 * 64 + 8 * (kcc0 - DK / 8); kst0 = (size_t)64 * 64; } else { kg0 = Kg + (size_t)kr0 * kp + 8 * kcc0; kst0 = (size_t)64 * kp; }
    const bf16_t* kg1 = Kg + (size_t)kr1 * kp + 8 * kcc1; const size_t kst1 = (size_t)64 * kp;
    const bf16_t* vg = Vg + (size_t)vr * vp + 8 * vcc; const size_t vst = (size_t)64 * vp;
    const int kl0 = k0v ? kr0 * KPITCH + 16 * kcc0 : -1, kl1 = k1v ? kr1 * KPITCH + 16 * kcc1 : -1, vl = 2 * KBUF + vr * VPITCH + 16 * vcc;
    u32x4 rk0A = {0u, 0u, 0u, 0u}, rk1A = {0u, 0u, 0u, 0u}, rvA = {0u, 0u, 0u, 0u}, rk0B = {0u, 0u, 0u, 0u}, rk1B = {0u, 0u, 0u, 0u}, rvB = {0u, 0u, 0u, 0u};
#define ATT_KT(i) ((i) < nA ? a0 + (i) : b0 + ((i) - nA))
#define ATT_LOADK(X, kt) do { const size_t t_ = (size_t)(kt); rk0##X = *(const u32x4*)(kg0 + t_ * kst0); if (HAS_K1) rk1##X = *(const u32x4*)(kg1 + t_ * kst1); } while (0)
#define ATT_LOADV(X, kt) do { rv##X = *(const u32x4*)(vg + (size_t)(kt) * vst); } while (0)
#define ATT_STOREK(X, buf) do { *(LAS u32x4*)(lds + (kl0 >= 0 ? (buf) * KBUF + kl0 : DUMMY + tid * 16)) = rk0##X; if (HAS_K1) *(LAS u32x4*)(lds + (kl1 >= 0 ? (buf) * KBUF + kl1 : DUMMY + tid * 16)) = rk1##X; } while (0)
#define ATT_STOREV(X, buf) do { *(LAS u32x4*)(lds + (buf) * VBUF + vl) = rv##X; } while (0)
    const int q4 = (lane & 15) >> 2, p4 = lane & 3, b16 = (lane >> 4) & 1;
    const int vbase = 2 * KBUF + (4 * hi + q4) * VPITCH + 32 * b16 + 8 * p4;
    const int kbase = r32 * KPITCH + 16 * hi;
    const int qw = q0 + wid * 32;
    const float stq = slope * (float)qrow;
    const bf16x8 qzero = {0, 0, 0, 0, 0, 0, 0, 0};
    bf16x8 qpos = qzero, qneg = qzero;
    if (MODE == 1 && hi == 0) { qpos[0] = (short)0x3F80; qpos[1] = (short)0x3F80; qneg[0] = (short)0xBF80; qneg[1] = (short)0xBF80; }
    constexpr int NKF = NKS + (MODE == 1 ? 1 : 0);
    constexpr int KPRE = NKF > 4 ? 4 : NKF;
    bf16x8 kfa[NKF], kfb[NKF];
#define ATT_KREAD(kbuf, f0, f1) do { const LAS char* Kb_ = lds + (kbuf) * KBUF + kbase; \
        _Pragma("unroll") for (int ks_ = (f0); ks_ < (f1); ++ks_) { kfa[ks_] = *(const LAS bf16x8*)(Kb_ + 32 * ks_); kfb[ks_] = *(const LAS bf16x8*)(Kb_ + 32 * KPITCH + 32 * ks_); } } while (0)
#define ATT_QKM(sa, sb, side) do { \
        _Pragma("unroll") for (int e_ = 0; e_ < 16; ++e_) { sa[e_] = 0.f; sb[e_] = 0.f; } \
        _Pragma("unroll") for (int ks_ = 0; ks_ < NKS; ++ks_) { sa = ATT_MFMA(kfa[ks_], qf[ks_], sa); sb = ATT_MFMA(kfb[ks_], qf[ks_], sb); } \
        if (MODE == 1) { const bf16x8 qa_ = (side) < 0 ? qpos : ((side) > 0 ? qneg : qzero); sa = ATT_MFMA(kfa[NKS], qa_, sa); sb = ATT_MFMA(kfb[NKS], qa_, sb); } } while (0)
#define ATT_QK(sa, sb, kbuf, side) do { ATT_KREAD(kbuf, 0, NKF); ATT_QKM(sa, sb, side); } while (0)
    bf16x8 vfa[4], vfb[4];
#define ATT_VREAD(vbuf) do { const LAS char* Vb_ = lds + (vbuf) * VBUF + vbase; \
        _Pragma("unroll") for (int j_ = 0; j_ < 4; ++j_) { const LAS char* vp0_ = Vb_ + (16 * j_) * VPITCH; \
            { const s16x4 lo_ = vtr(vp0_), hh_ = vtr(vp0_ + 8 * VPITCH); vfa[j_] = __builtin_shufflevector(lo_, hh_, 0, 1, 2, 3, 4, 5, 6, 7); } \
            { const s16x4 lo_ = vtr(vp0_ + 64), hh_ = vtr(vp0_ + 8 * VPITCH + 64); vfb[j_] = __builtin_shufflevector(lo_, hh_, 0, 1, 2, 3, 4, 5, 6, 7); } } } while (0)
#define ATT_PVM() do { _Pragma("unroll") for (int j_ = 0; j_ < 4; ++j_) { O0 = ATT_MFMA(vfa[j_], pf[j_ >> 1][j_ & 1], O0); O1 = ATT_MFMA(vfb[j_], pf[j_ >> 1][j_ & 1], O1); } } while (0)
#define ATT_PV(vbuf) do { ATT_VREAD(vbuf); ATT_PVM(); } while (0)
#define ATT_SIDE(kt) ((MODE != 1) ? 0 : (((kt) * 64 + 63 < qw) ? -1 : (((kt) * 64 > qw + 31) ? 1 : 0)))
    ATT_LOADK(A, ATT_KT(0)); ATT_LOADK(B, ATT_KT(1)); ATT_STOREV(B, 1);
    ATT_STOREK(A, 0); ATT_STOREK(B, 1);
    ATT_LOADK(A, ATT_KT(2)); ATT_LOADV(A, ATT_KT(0));
    __syncthreads();
    float M = (INIT && TRACK) ? -1e20f : Mout, L = INIT ? 0.f : Lout;
    if (INIT) {
#pragma unroll
        for (int i = 0; i < 16; ++i) { O0[i] = 0.f; O1[i] = 0.f; } }
    bf16x8 pf[2][2];
#pragma unroll
    for (int kb = 0; kb < 2; ++kb)
#pragma unroll
        for (int st = 0; st < 2; ++st) pf[kb][st] = qzero;
    f32x16 s0, s1, n0, n1;
    int side_cur = ATT_SIDE(ATT_KT(0));
    ATT_QK(s0, s1, 0, side_cur);
#pragma unroll
    for (int e = 0; e < 16; ++e) { n0[e] = 0.f; n1[e] = 0.f; }
    __syncthreads();
    constexpr int NMF = 2 * NKS + (MODE == 1 ? 2 : 0) + 8;
#define ATT_ITER(i, C0, C1, N0, N1, LS, SS, HASN, HASK2, HASK3) do { \
        const int kt = ATT_KT(i); \
        if (HASK3) ATT_LOADK(LS, ATT_KT((i) + 3)); \
        if (HASN) ATT_LOADV(LS, ATT_KT((i) + 1)); \
        if (HASN) ATT_KREAD(((i) + 1) & 1, 0, KPRE); \
        const int k0 = kt * 64; \
          \
        float rc = 0.f; \
        if (MODE == 1) { \
            if (side_cur != 0) rc = side_cur < 0 ? -stq : stq; \
            else { const float dbase = (float)(k0 + 4 * hi - qrow); \
                _Pragma("unroll") for (int e = 0; e < 16; ++e) { const float c = (float)((e & 3) + 8 * (e >> 2)); \
                    C0[e] = fmaf(-slope, fabsf(dbase + c), C0[e]); C1[e] = fmaf(-slope, fabsf(dbase + (c + 32.f)), C1[e]); } } \
        } \
        if (MODE == 2) { const float dbase = (float)(k0 + 4 * hi - qrow); \
            _Pragma("unroll") for (int e = 0; e < 16; ++e) { const float c = (float)((e & 3) + 8 * (e >> 2)); \
                const float d0 = fabsf(dbase + c), d1 = fabsf(dbase + (c + 32.f)); \
                C0[e] = (d0 <= 128.f) ? fmaf(-slope, d0, C0[e]) : -1e30f; C1[e] = (d1 <= 128.f) ? fmaf(-slope, d1, C1[e]) : -1e30f; } } \
        if (TRACK) { \
        float mx = max3f(C0[0], C1[0], C0[1]); \
        _Pragma("unroll") for (int e = 1; e < 15; e += 2) { mx = max3f(mx, C1[e], C0[e + 1]); mx = max3f(mx, C1[e + 1], C0[e + 2]); } \
        mx = fmaxf(mx, C1[15]); \
        const float mt = xhalf_max(mx) + rc;                     \
        if (__builtin_amdgcn_ballot_w64(mt > M + RESCALE_T) != 0ull) {         \
            ATT_PV(((i) + 1) & 1); \
            _Pragma("unroll") for (int kb = 0; kb < 2; ++kb) _Pragma("unroll") for (int st = 0; st < 2; ++st) pf[kb][st] = qzero; \
            const float Mn = fmaxf(M, mt); const float alpha = __builtin_amdgcn_exp2f((M - Mn) * LOG2E); M = Mn; \
            L *= alpha; \
            _Pragma("unroll") for (int e = 0; e < 16; ++e) { O0[e] *= alpha; O1[e] *= alpha; }        \
        } } \
          \
        const int side_next = HASN ? ATT_SIDE(ATT_KT((i) + 1)) : 0; \
        if (HASN) ATT_KREAD(((i) + 1) & 1, KPRE, NKF); \
        ATT_VREAD(((i) + 1) & 1); \
        if (HASN) ATT_QKM(N0, N1, side_next); \
        ATT_PVM();                                   \
        const float cc = (rc - M) * LOG2E; \
        float ps = 0.f;                                          \
        float ps1 = 0.f; \
        _Pragma("unroll") for (int e = 0; e < 16; ++e) { float t0 = __builtin_fmaf(C0[e], LOG2E, cc), t1 = __builtin_fmaf(C1[e], LOG2E, cc); \
            asm("" : "+v"(t0)); asm("" : "+v"(t1));                 \
            C0[e] = __builtin_amdgcn_exp2f(t0); C1[e] = __builtin_amdgcn_exp2f(t1); \
            float u0 = ps + C0[e], u1 = ps1 + C1[e]; asm("" : "+v"(u0)); asm("" : "+v"(u1)); ps = u0; ps1 = u1; } \
        L += ps + ps1; \
        _Pragma("unroll") for (int st = 0; st < 2; ++st) { u32x4 w0, w1; \
            w0.x = pkbf(C0[8 * st + 0], C0[8 * st + 1]); w0.y = pkbf(C0[8 * st + 2], C0[8 * st + 3]); w0.z = pkbf(C0[8 * st + 4], C0[8 * st + 5]); w0.w = pkbf(C0[8 * st + 6], C0[8 * st + 7]); \
            w1.x = pkbf(C1[8 * st + 0], C1[8 * st + 1]); w1.y = pkbf(C1[8 * st + 2], C1[8 * st + 3]); w1.z = pkbf(C1[8 * st + 4], C1[8 * st + 5]); w1.w = pkbf(C1[8 * st + 6], C1[8 * st + 7]); \
            pf[0][st] = __builtin_bit_cast(bf16x8, w0); pf[1][st] = __builtin_bit_cast(bf16x8, w1); } \
        side_cur = side_next; \
        if (HASN) { __builtin_amdgcn_sched_group_barrier(0x100, 8, 0);        \
            _Pragma("unroll") for (int g_ = 0; g_ < NMF; ++g_) { __builtin_amdgcn_sched_group_barrier(0x008, 1, 0); __builtin_amdgcn_sched_group_barrier(0x100, 2, 0); __builtin_amdgcn_sched_group_barrier(0x002, 6, 0); } } \
        if (HASK2) ATT_STOREK(SS, (i) & 1); \
        ATT_STOREV(SS, (i) & 1); \
        __syncthreads(); } while (0)
    for (int i = 0; i + 4 < nt; i += 2) {
        ATT_ITER(i, s0, s1, n0, n1, B, A, true, true, true);
        ATT_ITER(i + 1, n0, n1, s0, s1, A, B, true, true, true);
    }
    ATT_ITER(nt - 4, s0, s1, n0, n1, B, A, true, true, true);
    ATT_ITER(nt - 3, n0, n1, s0, s1, A, B, true, true, false);
    ATT_ITER(nt - 2, s0, s1, n0, n1, B, A, true, false, false);
    ATT_ITER(nt - 1, n0, n1, s0, s1, A, B, false, false, false);
    ATT_PV((nt - 1) & 1);
    __syncthreads();
#undef ATT_ITER
#undef ATT_LOADK
#undef ATT_LOADV
#undef ATT_STOREK
#undef ATT_STOREV
#undef ATT_KT
#undef ATT_QK
#undef ATT_PV
#undef ATT_KREAD
#undef ATT_QKM
#undef ATT_VREAD
#undef ATT_PVM
#undef ATT_SIDE
    Mout = M; Lout = L;
}

template <int NE> __device__ __forceinline__ float row_norm2(const bf16_t* qrow_ptr) {
    float s = 0.f;
#pragma unroll
    for (int c = 0; c < NE / 8; ++c) { float v[8]; unpack8(((const u32x4*)qrow_ptr)[c], v);
#pragma unroll
        for (int e = 0; e < 8; ++e) s += v[e] * v[e]; }
    return s;
}
__device__ __forceinline__ void store_o(bf16_t* orow, const f32x16& O0, const f32x16& O1, int hi) {
#pragma unroll
    for (int g = 0; g < 4; ++g) {
        u32x2 w0, w1; w0.x = pkbf(O0[4 * g], O0[4 * g + 1]); w0.y = pkbf(O0[4 * g + 2], O0[4 * g + 3]); w1.x = pkbf(O1[4 * g], O1[4 * g + 1]); w1.y = pkbf(O1[4 * g + 2], O1[4 * g + 3]);
        *(u32x2*)(orow + 8 * g + 4 * hi) = w0; *(u32x2*)(orow + 32 + 8 * g + 4 * hi) = w1;
    }
}

__device__ __forceinline__ void attn_phase(KP p, int l, LAS char* lds, int vcu, int G) {
    const bf16_t* proj = (const bf16_t*)(p->ws + WS_PROJ); const bf16_t* qb = (const bf16_t*)(p->ws + WS_QB); const bf16_t* kb = (const bf16_t*)(p->ws + WS_KB); const bf16_t* vb = (const bf16_t*)(p->ws + WS_VB);
    const bf16_t* aug = (const bf16_t*)(p->ws + WS_AUG);
    bf16_t* mix = (bf16_t*)(p->ws + WS_MIX);
    for (;;) {
        const int qx = (int)(blockIdx.x & 7u);
        const int tid = tid_fresh(), lane = tid & 63, r32 = lane & 31, hi = lane >> 5; const int wid = __builtin_amdgcn_readfirstlane(tid >> 6);
        LAS unsigned* slot = (LAS unsigned*)(lds + ATT_LDS + 16384 + 64);
        if (tid == 0) *slot = __hip_atomic_fetch_add((unsigned*)(p->ws + WS_QCTR) + l * 8 + qx, 1u, __ATOMIC_RELAXED, __HIP_MEMORY_SCOPE_AGENT);
        __syncthreads();
        const int j = __builtin_amdgcn_readfirstlane((int)*slot);
        __syncthreads();
        if (j >= 256) break;
        int type, hd, qblk; const int b = qx >> 2;
        if (j < 16) { type = 0; hd = 3; qblk = 16 * (qx & 3) + j; }
        else if (j < 80) { type = 1; hd = qx & 3; qblk = j - 16; }
        else if (j < 144) { type = 2; hd = qx & 3; qblk = j - 80; }
        else if (j < 192) { type = 0; hd = 2 - ((j - 144) >> 4); qblk = 16 * (qx & 3) + ((j - 144) & 15); }
        else { type = 3; hd = qx & 3; qblk = j - 192; }
        const int q0 = qblk * 256;
        const int qrow = q0 + wid * 32 + r32;
        const size_t tok0 = (size_t)b * SEQ;
        f32x16 O0, O1; float M, L;
        if (type == 0) {
            const int bD = b, hD = hd;
            const size_t tokD = (size_t)bD * SEQ;
            const float slope = __builtin_amdgcn_exp2f(-(float)(5 + hD));
            const bf16_t* base = proj + tokD * NPROJ + PD;
            const int d0 = q0 / 64;
            LAS float* asave = (LAS float*)(lds + 65536) + tid;
#pragma unroll 1
            for (int mp = 0; mp < 2; ++mp) {
                const bf16_t* Qm = base + 64 * hD + 32 * mp; const bf16_t* Km = base + 256 + 64 * hD + 32 * mp; const bf16_t* Vm = base + 512 + 64 * hD;
                const float kmax = sqrtf(__builtin_bit_cast(float, ((const unsigned*)(p->ws + WS_KMAX))[l * 32 + bD * 8 + hD * 2 + mp]));
                const float bound = sqrtf(row_norm2<32>(Qm + (size_t)qrow * NPROJ)) * kmax * 1.01f;
                M = bound;
                flash_pass<32, 1, true>(lds, Qm, NPROJ, Km, NPROJ, Vm, NPROJ, aug + 16 * hD, q0, d0, 4, 0, 4, slope, O0, O1, M, L);
                float dc = (bound + (20.8f + __logf(2.f / slope)) - (M + __logf(fmaxf(xhalf_sum(L), 1e-37f)))) / slope;
                dc = fminf(fmaxf(dc, 0.f), 1.0e8f);
#pragma unroll
                for (int o = 1; o < 64; o <<= 1) dc = fmaxf(dc, __shfl_xor(dc, o));
                LAS float* red = (LAS float*)(lds + ATT_LDS + 16384);
                if (lane == 0) red[wid] = dc;
                __syncthreads();
#pragma unroll
                for (int w = 0; w < 8; ++w) dc = fmaxf(dc, red[w]);
                __syncthreads();
                const int dci = (int)dc + 1;
                const int lo_key = q0 - dci - 63;
                int ktlo = lo_key <= 0 ? 0 : (lo_key + 63) / 64; int kthi = (q0 + 255 + dci) / 64; if (kthi > SEQ / 64 - 1) kthi = SEQ / 64 - 1;
                if (ktlo > d0) ktlo = d0; if (kthi < d0 + 3) kthi = d0 + 3;
                if (((kthi - ktlo + 1) & 1) != 0) { if (ktlo > 0) --ktlo; else ++kthi; }
                if (kthi - ktlo + 1 == 6) { if (ktlo >= 2) ktlo -= 2; else kthi += 2; }
                const int nR = kthi - (d0 + 3), nL = d0 - ktlo;
                if (nR + nL > 0) flash_pass<32, 1, false>(lds, Qm, NPROJ, Km, NPROJ, Vm, NPROJ, aug + 16 * hD, q0, d0 + 4, nR, ktlo, nR + nL, slope, O0, O1, M, L);
                if (mp == 0) { const float i1 = 1.f / xhalf_sum(L);
#pragma unroll
                    for (int i = 0; i < 16; ++i) { asave[(2 * i) * NTHREADS] = O0[i] * i1; asave[(2 * i + 1) * NTHREADS] = O1[i] * i1; } }
            }
            float lam;
            { const float* lp = p->diff_lambda + l * 128; const float a = (lane < 32) ? lp[lane] * lp[32 + lane] : 0.f, b2 = (lane < 32) ? lp[64 + lane] * lp[96 + lane] : 0.f;
              lam = expf(wave_sum(a)) - expf(wave_sum(b2)) + p->lam_init[l]; }
            const float one_m_li = 1.f - p->lam_init[l];
            const float i2 = lam / xhalf_sum(L);
            float ss = 0.f;
            f32x16 A0, A1;
#pragma unroll
            for (int i = 0; i < 16; ++i) { A0[i] = asave[(2 * i) * NTHREADS] - O0[i] * i2; A1[i] = asave[(2 * i + 1) * NTHREADS] - O1[i] * i2; ss += A0[i] * A0[i] + A1[i] * A1[i]; }
            ss = xhalf_sum(ss);
            const float rs = one_m_li / sqrtf(ss * (1.f / 64.f) + NORM_EPS);
            const float* sg = p->diff_subln + l * 64;
#pragma unroll
            for (int i = 0; i < 16; ++i) { const int dv = (i & 3) + 8 * (i >> 2) + 4 * hi; A0[i] *= rs * sg[dv]; A1[i] *= rs * sg[32 + dv]; }
            { const int t2 = tid_fresh(); store_o(mix + (tokD + q0 + (t2 >> 6) * 32 + (t2 & 31)) * DM + 768 + 64 * hD, A0, A1, (t2 >> 5) & 1); }
        } else if (type == 1) {
            M = sqrtf(row_norm2<96>(qb + (tok0 + qrow) * 384 + 96 * hd) * __builtin_bit_cast(float, ((const unsigned*)(p->ws + WS_KMAX))[l * 32 + 16 + b * 4 + hd])) * 1.01f;
            flash_pass<96, 0>(lds, qb + tok0 * 384 + 96 * hd, 384, kb + tok0 * 384 + 96 * hd, 384, vb + tok0 * 256 + 64 * hd, 256, nullptr, q0, q0 / 64, SEQ / 64 - q0 / 64, 0, SEQ / 64, 0.f, O0, O1, M, L);
            const float il = 1.f / xhalf_sum(L);
#pragma unroll
            for (int i = 0; i < 16; ++i) { O0[i] *= il; O1[i] *= il; }
            { const int t2 = tid_fresh(); store_o(mix + (tok0 + q0 + (t2 >> 6) * 32 + (t2 & 31)) * DM + 256 + 64 * hd, O0, O1, (t2 >> 5) & 1); }
        } else if (type == 2) {
            const bf16_t* base = proj + tok0 * NPROJ + PC; const int hk = hd >> 1;
            M = sqrtf(row_norm2<64>(base + (size_t)qrow * NPROJ + 64 * hd) * __builtin_bit_cast(float, ((const unsigned*)(p->ws + WS_KMAX))[l * 32 + 24 + b * 2 + hk])) * 1.01f;
            flash_pass<64, 0>(lds, base + 64 * hd, NPROJ, base + 256 + 64 * hk, NPROJ, base + 384 + 64 * hk, NPROJ, nullptr, q0, q0 / 64, SEQ / 64 - q0 / 64, 0, SEQ / 64, 0.f, O0, O1, M, L);
            const float il = 1.f / xhalf_sum(L);
#pragma unroll
            for (int i = 0; i < 16; ++i) { O0[i] *= il; O1[i] *= il; }
            { const int t2 = tid_fresh(); store_o(mix + (tok0 + q0 + (t2 >> 6) * 32 + (t2 & 31)) * DM + 512 + 64 * hd, O0, O1, (t2 >> 5) & 1); }
        } else {
            const bf16_t* base = proj + tok0 * NPROJ + PA; const int hk = hd >> 1;
            const float slope = __builtin_amdgcn_exp2f(-(float)(1 + hd));
            const int kt0 = (q0 >= 128) ? (q0 - 128) / 64 : 0; int kt1 = (q0 + 256 + 128) / 64; if (kt1 > SEQ / 64) kt1 = SEQ / 64;
            flash_pass<64, 2>(lds, base + 64 * hd, NPROJ, base + 256 + 64 * hk, NPROJ, base + 384 + 64 * hk, NPROJ, nullptr, q0, kt0, kt1 - kt0, 0, kt1 - kt0, slope, O0, O1, M, L);
            const float sink = p->win_sink[l * 4 + hd];
            const float il = 1.f / (xhalf_sum(L) + __builtin_amdgcn_exp2f((sink - M) * LOG2E));
#pragma unroll
            for (int i = 0; i < 16; ++i) { O0[i] *= il; O1[i] *= il; }
            { const int t2 = tid_fresh(); store_o(mix + (tok0 + q0 + (t2 >> 6) * 32 + (t2 & 31)) * DM + 64 * hd, O0, O1, (t2 >> 5) & 1); }
        }
    }
}
}

#define XB_TMO      128
#define XB_XCNT(j)  (256  + 64 * (j))
#define XB_XSUB(j)  (1280 + 64 * (j))
#define XB_XGEN(j)  (2304 + 64 * (j))
#define XB_TOP      3328
#define XB_TOPGEN   3392
#define XCD_BAR_WORDS 3456
#define XB_SPIN_CAP (1u << 22)

__device__ __forceinline__ unsigned xb_ld(unsigned* p)              { return __hip_atomic_load(p, __ATOMIC_RELAXED, __HIP_MEMORY_SCOPE_AGENT); }
__device__ __forceinline__ unsigned xb_add(unsigned* p, unsigned v) { return __hip_atomic_fetch_add(p, v, __ATOMIC_RELAXED, __HIP_MEMORY_SCOPE_AGENT); }
__device__ __forceinline__ unsigned xb_xcc_id() { return (unsigned)__builtin_amdgcn_s_getreg((3 << 11) | 20) & 0xFu; }
#define XB_SPIN(cond, bar) do { unsigned _sp = 0; while (cond) { __builtin_amdgcn_s_sleep(1); \
    if ((++_sp & 255u) == 0u) { if (xb_ld(&(bar)[XB_TMO])) break; if (_sp > XB_SPIN_CAP) { atomicAdd(&(bar)[XB_TMO], 1u); break; } } } } while (0)

struct XcdBarrier {
    unsigned* bar; unsigned x;
    volatile LAS unsigned* st;
};

__device__ __forceinline__ XcdBarrier xcd_barrier_post(unsigned* bar, volatile LAS unsigned* st) {
    XcdBarrier b; b.bar = bar; b.x = xb_xcc_id(); b.st = st;
    if (threadIdx.x == 0) (void)xb_add(&bar[XB_XCNT(b.x)], 1u);
    return b;
}
__device__ __forceinline__ void xcd_barrier_complete(unsigned* bar, unsigned x, unsigned& nloc, unsigned& nx) {
    const unsigned G = gridDim.x * gridDim.y * gridDim.z;
    unsigned sum, cnt, mine, sp = 0u;
    for (;;) {
        sum = 0u; cnt = 0u; mine = 0u;
#pragma unroll
        for (unsigned j = 0; j < 16; ++j) { const unsigned c = xb_ld(&bar[XB_XCNT(j)]); sum += c; cnt += (c > 0u) ? 1u : 0u; mine = (j == x) ? c : mine; }
        if (sum == G) break;
        __builtin_amdgcn_s_sleep(1);
        if ((++sp & 255u) == 0u) { if (xb_ld(&bar[XB_TMO])) break; if (sp > XB_SPIN_CAP) { atomicAdd(&bar[XB_TMO], 1u); break; } }
    }
    nloc = mine > 0u ? mine : 1u; nx = cnt > 0u ? cnt : 1u;
}

__device__ __forceinline__ void xcd_barrier(const XcdBarrier& b) {
    asm volatile("s_waitcnt vmcnt(0)" ::: "memory");
    __syncthreads();
    if (threadIdx.x == 0) {
        unsigned* bar = b.bar;
        __builtin_amdgcn_s_waitcnt(0);
        unsigned nloc = b.st[0], nx = b.st[1];
        if (nloc == 0u) { xcd_barrier_complete(bar, b.x, nloc, nx); b.st[0] = nloc; b.st[1] = nx; }
        const unsigned old = xb_add(&bar[XB_XSUB(b.x)], 1u);
        const unsigned gen = old / nloc;
        if (old + 1u == (gen + 1u) * nloc) {
            __builtin_amdgcn_fence(__ATOMIC_RELEASE, "agent");
            asm volatile("s_waitcnt vmcnt(0)" ::: "memory");
            const unsigned og = xb_add(&bar[XB_TOP], 1u);
            const unsigned tg = og / nx;
            if (og + 1u == (tg + 1u) * nx) xb_add(&bar[XB_TOPGEN], 1u);
            else XB_SPIN(xb_ld(&bar[XB_TOPGEN]) == tg, bar);
            __builtin_amdgcn_fence(__ATOMIC_ACQUIRE, "agent");
            xb_add(&bar[XB_XGEN(b.x)], 1u);
            asm volatile("s_waitcnt vmcnt(0)" ::: "memory");
        } else {
            XB_SPIN(xb_ld(&bar[XB_XGEN(b.x)]) == gen, bar);
            __builtin_amdgcn_fence(__ATOMIC_ACQUIRE, "agent");
            asm volatile("s_waitcnt vmcnt(0)" ::: "memory");
        }
    }
    __syncthreads();
}

#define GRID_SYNC_CG() do { asm volatile("s_waitcnt vmcnt(0) lgkmcnt(0)" ::: "memory"); grid.sync(); __builtin_amdgcn_fence(__ATOMIC_ACQUIRE, "agent"); } while (0)
#define XB_ST ((volatile LAS unsigned*)(lds + LDS_BYTES - 64))
#define GRID_SYNC() do { GETP(pb_); XcdBarrier xb_; xb_.bar = (unsigned*)(pb_->ws + WS_BAR); xb_.x = xb_xcc_id(); xb_.st = XB_ST; xcd_barrier(xb_); } while (0)
#ifndef PH_MASK
#define PH_MASK 255
#endif
__global__ void __launch_bounds__(NTHREADS, 2) mega_fwd(Params p_by_value) {
    extern __shared__ __attribute__((aligned(16))) unsigned char lds_raw[];
    cg::grid_group grid = cg::this_grid();
    LAS unsigned char* lds = (LAS unsigned char*)lds_raw;
#define VCU(G_, bx_) (((G_) % 8 == 0) ? ((bx_) % 8) * ((G_) / 8) + (bx_) / 8 : (bx_))
    const float alpha = 1.681792830507429f;
#define STATS(s_) ((float*)(p->ws + WS_STATS) + (size_t)(s_) * T * 2)
#define C1(l_, off_) ((const float*)(p->ws + WS_C12) + (l_) * C12_L + (off_))
#define C2(l_, off_) ((const float*)(p->ws + WS_C12) + C2_OFF + (l_) * C12_L + (off_))

    if (threadIdx.x < 16) ((LAS unsigned*)(lds + LDS_BYTES - 64))[threadIdx.x] = 0u;
    __syncthreads();
    { GETP(p); (void)xcd_barrier_post((unsigned*)(p->ws + WS_BAR), XB_ST); }
    if (PH_MASK & 1) { GETP(p); const int G = gridDim.x, bx = blockIdx.x; phase0(p, lds, VCU(G, bx), G); }
    GRID_SYNC_CG();
#pragma unroll 1
    for (int li = 0; li < DEPTH; ++li) {
#pragma unroll 1
        for (int fi = 0; fi < 2; ++fi) {
            if (fi == 1) {
                if (PH_MASK & 2) { GETP(p); int l = li; asm volatile("" : "+s"(l)); const int G = gridDim.x, bx = blockIdx.x;
                  pg8::Gemm g{(const bf16_t*)(p->ws + WS_XB), (const bf16_t*)(p->ws + WS_WIN) + l * WIN_L, T, NPROJ, DM}; pg8::StaticOrder S; S.init(T, NPROJ, G, bx);
                  pg8::EpiStoreBf16LN E{(bf16_t*)(p->ws + WS_PROJ), NPROJ, STATS(3 * l), C1(l, 2 * NGU), C2(l, 2 * NGU)};
                  pg8::gemm_phase<pg8::EpiStoreBf16LN, pg8::StaticOrder, true, true>(lds, g, S, E); }
                GRID_SYNC();
                if (PH_MASK & 4) { GETP(p); int l = li; asm volatile("" : "+s"(l)); const int G = gridDim.x, bx = blockIdx.x; prep_phase(p, l, VCU(G, bx), G); }
                GRID_SYNC();
                if (PH_MASK & 8) { GETP(p); int l = li; asm volatile("" : "+s"(l)); const int G = gridDim.x, bx = blockIdx.x; att::attn_phase(p, l, (LAS char*)lds, VCU(G, bx), G); }
                GRID_SYNC();
                if (PH_MASK & 16) { GETP(p); int l = li; asm volatile("" : "+s"(l)); const int G = gridDim.x, bx = blockIdx.x;
                  pg8::Gemm g{(const bf16_t*)(p->ws + WS_MIX), (const bf16_t*)(p->ws + WS_WOUT) + l * WOUT_L, T, DM, DM}; pg8::StaticOrder S; S.init(T, DM, G, bx);
                  pg8::EpiResidLN<true> E{nullptr, p->out, p->ws, p->ln_g + (3 * l) * DM, p->ln_b + (3 * l) * DM, 3 * l, alpha, 1.0f};
                  pg8::gemm_phase<pg8::EpiResidLN<true>, pg8::StaticOrder, true, true>(lds, g, S, E); }
                GRID_SYNC();
            }
            if (PH_MASK & 64) { GETP(p); int l = li, f = fi; asm volatile("" : "+s"(l), "+s"(f)); const int G = gridDim.x, bx = blockIdx.x;
              const int s = 3 * l + 2 * f - 1;
              pg8::Gemm g{(const bf16_t*)(p->ws + WS_XB), (const bf16_t*)(p->ws + WS_WGU) + l * WGU_L + f * WGU_F, T, NGU, DM}; pg8::StaticOrder S; S.init(T, NGU, G, bx);
              if (s >= 0) { pg8::EpiSwiGLULN<true> E{(bf16_t*)(p->ws + WS_H), DFF, STATS(s), C1(l, f * NGU), C2(l, f * NGU)};
                            pg8::gemm_phase<pg8::EpiSwiGLULN<true>, pg8::StaticOrder, true, true>(lds, g, S, E); }
              else { pg8::EpiSwiGLULN<false> E{(bf16_t*)(p->ws + WS_H), DFF, nullptr, C1(l, f * NGU), C2(l, f * NGU)};
                     pg8::gemm_phase<pg8::EpiSwiGLULN<false>, pg8::StaticOrder, true, true>(lds, g, S, E); } }
            GRID_SYNC();
            if (PH_MASK & 128) { GETP(p); int l = li, f = fi; asm volatile("" : "+s"(l), "+s"(f)); const int G = gridDim.x, bx = blockIdx.x;
              const int s = 3 * l + 2 * f - 1;
              pg8::Gemm g{(const bf16_t*)(p->ws + WS_H), (const bf16_t*)(p->ws + WS_WD) + l * WD_L + f * WD_F, T, DM, DFF}; pg8::StaticOrder S; S.init(T, DM, G, bx);
              if (s >= 0) { pg8::EpiResidLN<true> E{nullptr, p->out, p->ws, p->ln_g + s * DM, p->ln_b + s * DM, s, alpha, 0.5f};
                            pg8::gemm_phase<pg8::EpiResidLN<true>, pg8::StaticOrder, true, true>(lds, g, S, E); }
              else { pg8::EpiResidLN<false> E{p->x, p->out, p->ws, nullptr, nullptr, -1, alpha, 0.5f};
                     pg8::gemm_phase<pg8::EpiResidLN<false>, pg8::StaticOrder, true, true>(lds, g, S, E); } }
            GRID_SYNC();
        }
    }
    if (PH_MASK & 32) { GETP(p); const int G = gridDim.x, bx = blockIdx.x;
      ln_phase<false>(p->out, (bf16_t*)(p->ws + WS_XB), p->ln_g + (3 * DEPTH - 1) * DM, p->ln_b + (3 * DEPTH - 1) * DM, VCU(G, bx), G); }
}

extern "C" void kernel_launch(void* const* d_in, const int* in_sizes, int n_in, void* d_out, int out_size, void* d_ws, size_t ws_size, hipStream_t stream) {
    static int grid = 0;
    if (grid == 0) {
        if (n_in != 16 || in_sizes[0] != T * DM || out_size != T * DM || ws_size < WS_END) { fprintf(stderr, "kernel_launch: unexpected shapes (n_in %d, in0 %d, out %d, ws %zu); nothing launched\n", n_in, n_in > 0 ? in_sizes[0] : -1, out_size, ws_size); grid = -1; return; }
        int dev = 0, cus = 0, per_cu = 0;
        hipGetDevice(&dev); hipDeviceGetAttribute(&cus, hipDeviceAttributeMultiprocessorCount, dev);
        if (hipFuncSetAttribute((const void*)mega_fwd, hipFuncAttributeMaxDynamicSharedMemorySize, LDS_BYTES) != hipSuccess) { fprintf(stderr, "kernel_launch: hipFuncSetAttribute failed\n"); grid = -1; return; }
        if (hipOccupancyMaxActiveBlocksPerMultiprocessor(&per_cu, (const void*)mega_fwd, NTHREADS, LDS_BYTES) != hipSuccess || per_cu < 1) { fprintf(stderr, "kernel_launch: occupancy query gave %d\n", per_cu); per_cu = 1; }
        (void)hipGetLastError();
        grid = cus * 1;
    }
    if (grid < 0) return;
    Params p{};
    p.x = (const float*)d_in[0]; p.w_in = (const float*)d_in[1]; p.win_sink = (const float*)d_in[2]; p.mla_q_norm = (const float*)d_in[3]; p.mla_w_uq = (const float*)d_in[4];
    p.mla_kv_norm = (const float*)d_in[5]; p.mla_w_ukv = (const float*)d_in[6]; p.ax_q_norm = (const float*)d_in[7]; p.ax_k_norm = (const float*)d_in[8]; p.diff_lambda = (const float*)d_in[9];
    p.diff_subln = (const float*)d_in[10]; p.w_out = (const float*)d_in[11]; p.ffn_w_gu = (const float*)d_in[12]; p.ffn_w_down = (const float*)d_in[13]; p.ln_g = (const float*)d_in[14]; p.ln_b = (const float*)d_in[15];
    p.out = (float*)d_out; p.ws = (unsigned char*)d_ws;
    for (int l = 0; l < 4; ++l) p.lam_init[l] = (float)(0.8 - 0.6 * exp(-0.3 * (double)l));
    for (int i = 0; i < 16; ++i) p.inv32[i] = (float)pow(10000.0, -(double)i / 16.0);
    if (hipMemsetAsync((char*)d_ws + WS_CTL, 0, CTL_BYTES, stream) != hipSuccess) { fprintf(stderr, "kernel_launch: hipMemsetAsync of the control region failed\n"); return; }
    void* args[] = {&p};
    hipError_t e = hipLaunchCooperativeKernel((const void*)mega_fwd, dim3(grid), dim3(NTHREADS), args, LDS_BYTES, stream);
    if (e != hipSuccess) fprintf(stderr, "kernel_launch: cooperative launch failed: %s (grid %d)\n", hipGetErrorString(e), grid);
}
```

```cpp
#include <hip/hip_runtime.h>
#include <hip/hip_cooperative_groups.h>
#include <cstdio>
#include <cstdint>
#include <cmath>
namespace cg = cooperative_groups;
namespace pg8 {
#define PG8_LAS __attribute__((address_space(3)))
typedef unsigned short bf16_t;
typedef short bf16x8 __attribute__((ext_vector_type(8)));
typedef float f32x4 __attribute__((ext_vector_type(4)));
typedef unsigned u32x4 __attribute__((ext_vector_type(4)));
constexpr int BM = 256, BK = 64, HALF = 128, HTB = HALF * BK * 2  , STAGE_BYTES = 8 * HTB, NXCD = 8, WGM = 4;

__host__ __device__ __forceinline__ int lds_byte(int r, int c) { const int st = (r >> 4) * 2 + (c >> 5), rr = r & 15, cc = c & 31, ob = rr * 64 + cc * 2; return st * 1024 + (ob ^ (((ob >> 9) & 1) << 5)); }
__host__ __device__ __forceinline__ void stage_rc(int b, int& R, int& C) { const int st = b / 1024, sb = b % 1024, swz = sb ^ (((sb >> 9) & 1) << 5); R = (st >> 1) * 16 + swz / 64; C = (st & 1) * 32 + (swz % 64) / 2; }
__host__ __device__ __forceinline__ int perm32(int rho) { const int n = rho >> 4, i = rho & 15; return 8 * (i >> 2) + 4 * n + (i & 3); }

struct Unit { int pm, pn; };
struct Gemm { const bf16_t* A; const bf16_t* Bt; int M, N, K; };

struct StaticOrder {
    int nM, nN, nwg, G, c;
    __host__ __device__ void init(int M, int N, int G_, int c_) { nM = M / BM; nN = N / BM; nwg = nM * nN; G = G_; c = c_; }
    __host__ __device__ bool next(int i, Unit& u) const {
        const long L = (long)i * G + c; if (L >= nwg) return false;
        int wgid = (int)L; { const int q = nwg / NXCD, r = nwg % NXCD, xcd = wgid % NXCD, off = wgid / NXCD; wgid = (xcd < r ? xcd * (q + 1) : r * (q + 1) + (xcd - r) * q) + off; }
        const int nig = WGM * nN, gid = wgid / nig, fm = gid * WGM, gsz = (nM - fm) < WGM ? (nM - fm) : WGM;
        u.pm = fm + ((wgid % nig) % gsz); u.pn = (wgid % nig) / gsz; return true;
    }
    __device__ __forceinline__ void a_ready(const Unit&) const {}
    __device__ __forceinline__ void done(const Unit&) const {}
};

__device__ __forceinline__ unsigned cvt_pk_bf16(float lo, float hi) { unsigned r; asm volatile("v_cvt_pk_bf16_f32 %0, %1, %2" : "=v"(r) : "v"(lo), "v"(hi)); return r; }
typedef float f32x2 __attribute__((ext_vector_type(2)));
typedef float f32x2 __attribute__((ext_vector_type(2)));
typedef unsigned u32x2 __attribute__((ext_vector_type(2)));

struct EpiStoreBf16 {
    static constexpr bool PERM = true, AFTER_DRAIN = false;
    bf16_t* O; int ldc;
    __device__ __forceinline__ void operator()(const f32x4 (&acc)[2][2][4][2], const Unit& u, int wr, int wc, int fr, int fq) const {
        const int row0 = u.pm * BM + wr * 64 + fr; const int col0 = u.pn * BM + wc * 32 + 8 * fq;
#pragma unroll
        for (int ai = 0; ai < 2; ++ai)
#pragma unroll
            for (int m = 0; m < 4; ++m) { bf16_t* rowp = O + (size_t)(row0 + ai * HALF + m * 16) * ldc + col0;
#pragma unroll
                for (int bj = 0; bj < 2; ++bj) { const f32x4 v0 = acc[ai][bj][m][0], v1 = acc[ai][bj][m][1];
                    u32x4 w; w.x = cvt_pk_bf16(v0[0], v0[1]); w.y = cvt_pk_bf16(v0[2], v0[3]); w.z = cvt_pk_bf16(v1[0], v1[1]); w.w = cvt_pk_bf16(v1[2], v1[3]);
                    *(u32x4*)(rowp + bj * HALF) = w; } }
    }
};

__device__ __forceinline__ float silu_mul(float g, float u) {
    const float e = __builtin_amdgcn_exp2f(-1.4426950408889634f * g);
    return g * u * __builtin_amdgcn_rcpf(1.0f + e);
}
struct EpiSwiGLU {
    static constexpr bool PERM = true, AFTER_DRAIN = false;
    bf16_t* H; int ldh;
    __device__ __forceinline__ void operator()(const f32x4 (&acc)[2][2][4][2], const Unit& u, int wr, int wc, int fr, int fq) const {
        const int row0 = u.pm * BM + wr * 64 + fr; const int col0 = u.pn * HALF + wc * 32 + 8 * fq;
#pragma unroll
        for (int ai = 0; ai < 2; ++ai)
#pragma unroll
            for (int m = 0; m < 4; ++m) { bf16_t* rowp = H + (size_t)(row0 + ai * HALF + m * 16) * ldh + col0;
                const f32x4 g0 = acc[ai][0][m][0], g1 = acc[ai][0][m][1], u0 = acc[ai][1][m][0], u1 = acc[ai][1][m][1];
                u32x4 w;
                w.x = cvt_pk_bf16(silu_mul(g0[0], u0[0]), silu_mul(g0[1], u0[1])); w.y = cvt_pk_bf16(silu_mul(g0[2], u0[2]), silu_mul(g0[3], u0[3]));
                w.z = cvt_pk_bf16(silu_mul(g1[0], u1[0]), silu_mul(g1[1], u1[1])); w.w = cvt_pk_bf16(silu_mul(g1[2], u1[2]), silu_mul(g1[3], u1[3]));
                *(u32x4*)rowp = w; }
    }
};

struct EpiResid {
    static constexpr bool PERM = false, AFTER_DRAIN = false;
    const float* src; float* dst; int ld; float alpha, beta;
    __device__ __forceinline__ void operator()(const f32x4 (&acc)[2][2][4][2], const Unit& u, int wr, int wc, int fr, int fq) const {
        const int col0 = u.pn * BM + wc * 32 + 4 * fq;
#pragma unroll
        for (int ai = 0; ai < 2; ++ai)
#pragma unroll
            for (int m = 0; m < 4; ++m) { const size_t off = (size_t)(u.pm * BM + ai * HALF + wr * 64 + m * 16 + fr) * ld + col0;
#pragma unroll
                for (int bj = 0; bj < 2; ++bj)
#pragma unroll
                    for (int n = 0; n < 2; ++n) { const f32x4 s = *(const f32x4*)(src + off + bj * HALF + n * 16);
                        *(f32x4*)(dst + off + bj * HALF + n * 16) = s * alpha + acc[ai][bj][m][n] * beta; } }
    }
};

constexpr float LN_EPS_F = 1e-5f;
template <bool HAS> __device__ __forceinline__ void ln_row_stats(const float* st, int row, float& mu, float& rs) {
    if (!HAS) { mu = 0.f; rs = 1.f; return; }
    const f32x2 s = *(const f32x2*)(st + 2 * (size_t)row);
    mu = s.x * (1.0f / 1024.0f); const float var = fmaxf(s.y * (1.0f / 1024.0f) - mu * mu, 0.f); rs = 1.0f / sqrtf(var + LN_EPS_F);
}
struct EpiStoreBf16LN {
    static constexpr bool PERM = true, AFTER_DRAIN = false;
    bf16_t* O; int ldc; const float* st; const float* c1; const float* c2;
    __device__ __forceinline__ void operator()(const f32x4 (&acc)[2][2][4][2], const Unit& u, int wr, int wc, int fr, int fq) const {
        int row0 = u.pm * BM + wr * 64 + fr; int col0 = u.pn * BM + wc * 32 + 8 * fq;
        asm volatile("" : "+v"(row0), "+v"(col0));
        f32x4 c1v[2][2], c2v[2][2];
#pragma unroll
        for (int bj = 0; bj < 2; ++bj)
#pragma unroll
            for (int n = 0; n < 2; ++n) { c1v[bj][n] = *(const f32x4*)(c1 + col0 + bj * HALF + 4 * n); c2v[bj][n] = *(const f32x4*)(c2 + col0 + bj * HALF + 4 * n); }
#pragma unroll
        for (int ai = 0; ai < 2; ++ai)
#pragma unroll
            for (int m = 0; m < 4; ++m) { const int row = row0 + ai * HALF + m * 16; float mu, rs; ln_row_stats<true>(st, row, mu, rs);
                bf16_t* rowp = O + (size_t)row * ldc + col0;
#pragma unroll
                for (int bj = 0; bj < 2; ++bj) { const f32x4 v0 = (acc[ai][bj][m][0] - c1v[bj][0] * mu) * rs + c2v[bj][0], v1 = (acc[ai][bj][m][1] - c1v[bj][1] * mu) * rs + c2v[bj][1];
                    u32x4 w; w.x = cvt_pk_bf16(v0[0], v0[1]); w.y = cvt_pk_bf16(v0[2], v0[3]); w.z = cvt_pk_bf16(v1[0], v1[1]); w.w = cvt_pk_bf16(v1[2], v1[3]);
                    *(u32x4*)(rowp + bj * HALF) = w; } }
    }
};
template <bool HAS_LN> struct EpiSwiGLULN {
    static constexpr bool PERM = true, AFTER_DRAIN = false;
    bf16_t* H; int ldh; const float* st; const float* c1; const float* c2;
    __device__ __forceinline__ void operator()(const f32x4 (&acc)[2][2][4][2], const Unit& u, int wr, int wc, int fr, int fq) const {
        int row0 = u.pm * BM + wr * 64 + fr; const int col0 = u.pn * HALF + wc * 32 + 8 * fq; int wcol0 = u.pn * BM + wc * 32 + 8 * fq;
        asm volatile("" : "+v"(row0), "+v"(wcol0));
        f32x4 c1v[2][2], c2v[2][2];
#pragma unroll
        for (int bj = 0; bj < 2; ++bj)
#pragma unroll
            for (int n = 0; n < 2; ++n) { c1v[bj][n] = *(const f32x4*)(c1 + wcol0 + bj * HALF + 4 * n); c2v[bj][n] = *(const f32x4*)(c2 + wcol0 + bj * HALF + 4 * n); }
#pragma unroll
        for (int ai = 0; ai < 2; ++ai)
#pragma unroll
            for (int m = 0; m < 4; ++m) { const int row = row0 + ai * HALF + m * 16; float mu, rs; ln_row_stats<HAS_LN>(st, row, mu, rs);
                bf16_t* rowp = H + (size_t)row * ldh + col0;
                const f32x4 g0 = (acc[ai][0][m][0] - c1v[0][0] * mu) * rs + c2v[0][0], g1 = (acc[ai][0][m][1] - c1v[0][1] * mu) * rs + c2v[0][1];
                const f32x4 u0 = (acc[ai][1][m][0] - c1v[1][0] * mu) * rs + c2v[1][0], u1 = (acc[ai][1][m][1] - c1v[1][1] * mu) * rs + c2v[1][1];
                u32x4 w;
                w.x = cvt_pk_bf16(silu_mul(g0[0], u0[0]), silu_mul(g0[1], u0[1])); w.y = cvt_pk_bf16(silu_mul(g0[2], u0[2]), silu_mul(g0[3], u0[3]));
                w.z = cvt_pk_bf16(silu_mul(g1[0], u1[0]), silu_mul(g1[1], u1[1])); w.w = cvt_pk_bf16(silu_mul(g1[2], u1[2]), silu_mul(g1[3], u1[3]));
                *(u32x4*)rowp = w; }
    }
};
constexpr size_t EPI_WS_XB = (size_t)166 << 20, EPI_WS_STATS = ((size_t)568 << 20) + ((size_t)1 << 20); constexpr int EPI_T = 32768;
template <bool HAS_LN> struct EpiResidLN {
    static constexpr bool PERM = true, AFTER_DRAIN = false;
    static constexpr int ld = 1024;
    const float* src; float* dst; unsigned char* ws; const float* g_in; const float* b_in; int s_in; float alpha, beta;
    __device__ __forceinline__ void operator()(const f32x4 (&acc)[2][2][4][2], const Unit& u, int wr, int wc, int fr, int fq) const {
        int col0 = u.pn * BM + wc * 32 + 8 * fq; int rowb = u.pm * BM + wr * 64 + fr;
        asm volatile("" : "+v"(col0), "+v"(rowb));
        const float* rd = HAS_LN ? (const float*)dst : src;
        bf16_t* yb = (bf16_t*)(ws + EPI_WS_XB);
        const float* st_in = (const float*)(ws + EPI_WS_STATS) + (size_t)s_in * EPI_T * 2; float* st_out = (float*)(ws + EPI_WS_STATS) + (size_t)(s_in + 1) * EPI_T * 2;
        f32x4 gv[2][2], bv[2][2];
#pragma unroll
        for (int bj = 0; bj < 2; ++bj)
#pragma unroll
            for (int n = 0; n < 2; ++n) { if (HAS_LN) { gv[bj][n] = *(const f32x4*)(g_in + col0 + bj * HALF + 4 * n); bv[bj][n] = *(const f32x4*)(b_in + col0 + bj * HALF + 4 * n); }
                                          else { gv[bj][n] = (f32x4){1.f, 1.f, 1.f, 1.f}; bv[bj][n] = (f32x4){0.f, 0.f, 0.f, 0.f}; } }
#pragma unroll
        for (int ai = 0; ai < 2; ++ai)
#pragma unroll
            for (int m = 0; m < 4; ++m) { const int row = rowb + ai * HALF + m * 16; const size_t off = (size_t)row * ld + col0;
                float mu, rs; ln_row_stats<HAS_LN>(st_in, row, mu, rs);
                float ps = 0.f, pq = 0.f;
#pragma unroll
                for (int bj = 0; bj < 2; ++bj) { f32x4 yn[2];
#pragma unroll
                    for (int n = 0; n < 2; ++n) { const f32x4 y = *(const f32x4*)(rd + off + bj * HALF + 4 * n);
                        const f32x4 x = HAS_LN ? (y - mu) * rs * gv[bj][n] + bv[bj][n] : y;
                        yn[n] = x * alpha + acc[ai][bj][m][n] * beta;
                        *(f32x4*)(dst + off + bj * HALF + 4 * n) = yn[n];
                        ps += (yn[n][0] + yn[n][1]) + (yn[n][2] + yn[n][3]); pq += (yn[n][0] * yn[n][0] + yn[n][1] * yn[n][1]) + (yn[n][2] * yn[n][2] + yn[n][3] * yn[n][3]); }
                    u32x4 w; w.x = cvt_pk_bf16(yn[0][0], yn[0][1]); w.y = cvt_pk_bf16(yn[0][2], yn[0][3]); w.z = cvt_pk_bf16(yn[1][0], yn[1][1]); w.w = cvt_pk_bf16(yn[1][2], yn[1][3]);
                    *(u32x4*)(yb + off + bj * HALF) = w; }
                ps += __shfl_xor(ps, 16); ps += __shfl_xor(ps, 32); pq += __shfl_xor(pq, 16); pq += __shfl_xor(pq, 32);
                if (fq == 0) { atomicAdd(st_out + 2 * (size_t)row, ps); atomicAdd(st_out + 2 * (size_t)row + 1, pq); } }
    }
};
template <class Epi, class Sched, bool ALIGN_EPI = false, bool SP2 = false>
__device__ __forceinline__ void gemm_phase(PG8_LAS unsigned char* lds, const Gemm g, const Sched S, const Epi E) {
    int tid_ = threadIdx.x; asm volatile("" : "+v"(tid_));
    const int tid = tid_, wid = __builtin_amdgcn_readfirstlane(tid >> 6), lane = tid & 63, wr = wid >> 2, wc = wid & 3, fr = lane & 15, fq = lane >> 4;
    const int K = g.K, nt = K / BK;
    unsigned voffA[2], voffB[2];
#pragma unroll
    for (int i = 0; i < 2; ++i) { int R, C; stage_rc(tid * 16 + i * 8192, R, C); const int Rb = Epi::PERM ? ((R & ~31) + perm32(R & 31)) : R;
        voffA[i] = (unsigned)(R * K + C) * 2u; voffB[i] = (unsigned)(Rb * K + C) * 2u; }
    const size_t kstep = (size_t)(BK * 2);
    const size_t hstep = (size_t)HALF * K * 2;
    const size_t tstep = 2 * hstep;
    const unsigned ldsw = (unsigned)wid * 1024u;
    const int aoff = lds_byte(wr * 64 + fr, fq * 8), boff = lds_byte(wc * 32 + fr, fq * 8);
#define PG8_SA(b, h) (((b) * 2 + (h)) * HTB)
#define PG8_SB(b, h) ((4 + (b) * 2 + (h)) * HTB)
#define PG8_STAGE(bufoff, gbase, voff) do { _Pragma("unroll") for (int _i = 0; _i < 2; ++_i) \
        __builtin_amdgcn_global_load_lds((const unsigned*)((const char*)(gbase) + (voff)[_i]), (PG8_LAS unsigned*)(lds + (bufoff) + ldsw + _i * 8192), 16, 0, 0); } while (0)
#define PG8_LDA(dst, b, h) do { _Pragma("unroll") for (int m = 0; m < 4; ++m) _Pragma("unroll") for (int k = 0; k < 2; ++k) dst[m][k] = *(const PG8_LAS bf16x8*)(lds + PG8_SA(b, h) + aoff + m * 2048 + k * 1024); } while (0)
#define PG8_LDB(dst, b, h) do { _Pragma("unroll") for (int n = 0; n < 2; ++n) _Pragma("unroll") for (int k = 0; k < 2; ++k) dst[n][k] = *(const PG8_LAS bf16x8*)(lds + PG8_SB(b, h) + boff + n * 2048 + k * 1024); } while (0)
#define PG8_MMA(ai, bj, At, Bt) do { __builtin_amdgcn_s_setprio(1); _Pragma("unroll") for (int m = 0; m < 4; ++m) _Pragma("unroll") for (int n = 0; n < 2; ++n) _Pragma("unroll") for (int k = 0; k < 2; ++k) \
        acc[ai][bj][m][n] = __builtin_amdgcn_mfma_f32_16x16x32_bf16(Bt[n][k], At[m][k], acc[ai][bj][m][n], 0, 0, 0); __builtin_amdgcn_s_setprio(0); } while (0)
#define PG8_WAIT_V(n) asm volatile("s_waitcnt vmcnt(" #n ")" ::: "memory")
#define PG8_WAIT_L(n) asm volatile("s_waitcnt lgkmcnt(" #n ")" ::: "memory")
#define PG8_BAR __builtin_amdgcn_s_barrier()
#define PG8_SCHED __builtin_amdgcn_sched_barrier(0)
    Unit cur, nxt; int ui = 0;
    if (!S.next(0, cur)) return;
    f32x4 acc[2][2][4][2];
#pragma unroll
    for (int a = 0; a < 2; ++a)
#pragma unroll
        for (int b = 0; b < 2; ++b)
#pragma unroll
            for (int m = 0; m < 4; ++m)
#pragma unroll
                for (int n = 0; n < 2; ++n) acc[a][b][m][n] = (f32x4){0.f, 0.f, 0.f, 0.f};
    bf16x8 At[4][2], B0[2][2], B1[2][2];
    const char* cA = (const char*)g.A + (size_t)cur.pm * tstep; const char* cB = (const char*)g.Bt + (size_t)cur.pn * tstep;
    S.a_ready(cur);
    if constexpr (SP2) {
        PG8_STAGE(PG8_SB(0, 0), cB, voffB); PG8_STAGE(PG8_SB(0, 1), cB + hstep, voffB); PG8_STAGE(PG8_SA(0, 0), cA, voffA); PG8_STAGE(PG8_SA(0, 1), cA + hstep, voffA);
        if (wr == 1) PG8_BAR;
        PG8_WAIT_V(2); PG8_BAR;
        PG8_STAGE(PG8_SB(1, 0), cB + kstep, voffB); PG8_STAGE(PG8_SA(1, 0), cA + kstep, voffA); PG8_STAGE(PG8_SB(1, 1), cB + hstep + kstep, voffB);
        PG8_WAIT_V(6); PG8_BAR;
    } else {
        PG8_STAGE(PG8_SB(0, 0), cB, voffB); PG8_STAGE(PG8_SA(0, 0), cA, voffA); PG8_STAGE(PG8_SB(0, 1), cB + hstep, voffB); PG8_STAGE(PG8_SA(0, 1), cA + hstep, voffA);
        if (wr == 1) PG8_BAR;
        PG8_WAIT_V(4); PG8_BAR;
        PG8_STAGE(PG8_SB(1, 0), cB + kstep, voffB); PG8_STAGE(PG8_SA(1, 0), cA + kstep, voffA); PG8_STAGE(PG8_SB(1, 1), cB + hstep + kstep, voffB);
        PG8_WAIT_V(6); PG8_BAR;
    }
    for (;;) {
        const bool has_next = S.next(ui + 1, nxt);
        const char* nA = has_next ? (const char*)g.A + (size_t)nxt.pm * tstep : cA; const char* nB = has_next ? (const char*)g.Bt + (size_t)nxt.pn * tstep : cB;
        for (int t = 0; t < nt; t += 2) {
            const bool last = (t == nt - 2);
            const char* a1 = cA + (size_t)(t + 1) * kstep;
            const char* a2 = last ? nA : cA + (size_t)(t + 2) * kstep; const char* b2 = last ? nB : cB + (size_t)(t + 2) * kstep;
            const char* a3 = a2 + kstep; const char* b3 = b2 + kstep;
            if (last && has_next) S.a_ready(nxt);
            if constexpr (SP2) {
            PG8_LDB(B0, 0, 0); PG8_LDB(B1, 0, 1); PG8_SCHED; PG8_LDA(At, 0, 0); PG8_STAGE(PG8_SA(1, 1), a1 + hstep, voffA);
            PG8_WAIT_V(8); PG8_WAIT_L(0); PG8_BAR; PG8_MMA(0, 0, At, B0); PG8_MMA(0, 1, At, B1); PG8_BAR; PG8_SCHED;
            PG8_LDA(At, 0, 1); PG8_STAGE(PG8_SB(0, 0), b2, voffB); PG8_STAGE(PG8_SB(0, 1), b2 + hstep, voffB); PG8_STAGE(PG8_SA(0, 0), a2, voffA);
            PG8_WAIT_V(8); PG8_WAIT_L(0); PG8_BAR; PG8_MMA(1, 0, At, B0); PG8_MMA(1, 1, At, B1); PG8_BAR; PG8_SCHED;
            PG8_LDB(B0, 1, 0); PG8_LDB(B1, 1, 1); PG8_SCHED; PG8_LDA(At, 1, 0); PG8_STAGE(PG8_SA(0, 1), a2 + hstep, voffA);
            PG8_WAIT_V(8); PG8_WAIT_L(0); PG8_BAR; PG8_MMA(0, 0, At, B0); PG8_MMA(0, 1, At, B1); PG8_BAR; PG8_SCHED;
            PG8_LDA(At, 1, 1); PG8_STAGE(PG8_SB(1, 0), b3, voffB); PG8_STAGE(PG8_SB(1, 1), b3 + hstep, voffB); PG8_STAGE(PG8_SA(1, 0), a3, voffA);
            PG8_WAIT_V(8); PG8_WAIT_L(0); PG8_BAR; PG8_MMA(1, 0, At, B0); PG8_MMA(1, 1, At, B1); PG8_BAR; PG8_SCHED;
            } else {
            PG8_LDB(B0, 0, 0); PG8_SCHED; PG8_LDA(At, 0, 0); PG8_STAGE(PG8_SA(1, 1), a1 + hstep, voffA);
            PG8_WAIT_L(8); PG8_BAR; PG8_WAIT_L(0); PG8_MMA(0, 0, At, B0); PG8_BAR; PG8_SCHED;
            PG8_LDB(B1, 0, 1); PG8_STAGE(PG8_SB(0, 0), b2, voffB);
            PG8_BAR; PG8_WAIT_L(0); PG8_MMA(0, 1, At, B1); PG8_BAR;
            PG8_LDA(At, 0, 1); PG8_STAGE(PG8_SA(0, 0), a2, voffA);
            PG8_BAR; PG8_WAIT_L(0); PG8_MMA(1, 0, At, B0); PG8_BAR; PG8_SCHED;
            PG8_STAGE(PG8_SB(0, 1), b2 + hstep, voffB);
            PG8_WAIT_V(6); PG8_BAR; PG8_MMA(1, 1, At, B1); PG8_BAR;
            PG8_LDB(B0, 1, 0); PG8_SCHED; PG8_LDA(At, 1, 0); PG8_STAGE(PG8_SA(0, 1), a2 + hstep, voffA);
            PG8_WAIT_L(8); PG8_BAR; PG8_WAIT_L(0); PG8_MMA(0, 0, At, B0); PG8_BAR; PG8_SCHED;
            PG8_LDB(B1, 1, 1); PG8_STAGE(PG8_SB(1, 0), b3, voffB);
            PG8_BAR; PG8_WAIT_L(0); PG8_MMA(0, 1, At, B1); PG8_BAR;
            PG8_LDA(At, 1, 1); PG8_STAGE(PG8_SA(1, 0), a3, voffA);
            PG8_BAR; PG8_WAIT_L(0); PG8_MMA(1, 0, At, B0); PG8_BAR; PG8_SCHED;
            PG8_STAGE(PG8_SB(1, 1), b3 + hstep, voffB);
            PG8_WAIT_V(6); PG8_BAR; PG8_MMA(1, 1, At, B1); PG8_BAR;
            }
        }
        if constexpr (ALIGN_EPI) { if (wr == 0) PG8_BAR; }
        if constexpr (!Epi::AFTER_DRAIN) { E(acc, cur, wr, wc, fr, fq); S.done(cur); }
        if (!has_next) break;
#pragma unroll
        for (int a = 0; a < 2; ++a)
#pragma unroll
            for (int b = 0; b < 2; ++b)
#pragma unroll
                for (int m = 0; m < 4; ++m)
#pragma unroll
                    for (int n = 0; n < 2; ++n) acc[a][b][m][n] = (f32x4){0.f, 0.f, 0.f, 0.f};
        cur = nxt; cA = nA; cB = nB; ++ui;
        if constexpr (ALIGN_EPI) { if (wr == 1) PG8_BAR; }
    }
    PG8_WAIT_V(0);
    if constexpr (!ALIGN_EPI) { if (wr == 0) PG8_BAR; }
    PG8_BAR;
    if constexpr (Epi::AFTER_DRAIN) { E.fused(acc, cur, wr, wc, fr, fq, lds, wid, lane); S.done(cur); }
#undef PG8_SA
#undef PG8_SB
#undef PG8_STAGE
#undef PG8_LDA
#undef PG8_LDB
#undef PG8_MMA
#undef PG8_WAIT_V
#undef PG8_WAIT_L
#undef PG8_BAR
#undef PG8_SCHED
}
}
#define LAS __attribute__((address_space(3)))
typedef unsigned short bf16_t;
typedef short bf16x8 __attribute__((ext_vector_type(8)));
typedef short s16x4 __attribute__((ext_vector_type(4)));
typedef float f32x4 __attribute__((ext_vector_type(4)));
typedef float f32x16 __attribute__((ext_vector_type(16)));
typedef unsigned u32x4 __attribute__((ext_vector_type(4)));
typedef unsigned u32x2 __attribute__((ext_vector_type(2)));
typedef float f32x2_t __attribute__((ext_vector_type(2)));
typedef __bf16 bf16x2_t __attribute__((ext_vector_type(2)));

constexpr int NB = 2, SEQ = 16384, T = NB * SEQ, DM = 1024, DEPTH = 4, DFF = 2816, NGU = 2 * DFF;
constexpr int NIN_SRC = 2208, NPROJ = 3328;
constexpr int PA = 0, PC = 512, PD = 1024, PCQ = 1792, PCKV = 2048, PKR = 2176, PQUP = 2208, PKVUP = 2592, PEND = 3104;
constexpr float LOG2E = 1.4426950408889634f;
constexpr float NORM_EPS = 1e-5f;
constexpr int NWAVES = 8, NTHREADS = 512;
constexpr int LDS_BYTES = 147456;

constexpr size_t MiB = 1u << 20;
constexpr size_t WS_WGU = 0, WS_WD = 88 * MiB, WS_WIN = 132 * MiB, WS_WOUT = 158 * MiB, WS_XB = 166 * MiB;
constexpr size_t WS_H = 230 * MiB, WS_PROJ = 230 * MiB, WS_QB = 438 * MiB, WS_KB = 462 * MiB, WS_VB = 486 * MiB, WS_MIX = 502 * MiB, WS_AUG = 566 * MiB, WS_CTL = 568 * MiB, WS_KMAX = WS_CTL, WS_QCTR = WS_CTL + 1024, WS_C12 = WS_CTL + 4096, WS_BAR = WS_CTL + 512 * 1024, WS_STATS = WS_CTL + 1 * MiB, CTL_BYTES = 4 * MiB, WS_END = 572 * MiB;
constexpr int C12_L = 2 * NGU + NPROJ;
constexpr size_t C2_OFF = (size_t)DEPTH * C12_L;
static_assert(pg8::EPI_WS_XB == WS_XB && pg8::EPI_WS_STATS == WS_STATS && pg8::EPI_T == T, "part1's copies of the workspace map");
static_assert(WS_C12 + 2 * C2_OFF * 4 <= WS_BAR && WS_BAR + 3456 * 4 <= WS_STATS, "control region");
static_assert(WS_C12 + 2 * C2_OFF * 4 <= WS_STATS && WS_STATS + (size_t)12 * T * 8 <= WS_CTL + CTL_BYTES, "control region");
constexpr size_t WGU_L = (size_t)2 * NGU * DM, WGU_F = (size_t)NGU * DM;
constexpr size_t WD_L = (size_t)2 * DM * DFF, WD_F = (size_t)DM * DFF;
constexpr size_t WIN_L = (size_t)NPROJ * DM, WOUT_L = (size_t)DM * DM;

struct Params {
    const float* x; const float* w_in; const float* win_sink; const float* mla_q_norm; const float* mla_w_uq; const float* mla_kv_norm; const float* mla_w_ukv;
    const float* ax_q_norm; const float* ax_k_norm; const float* diff_lambda; const float* diff_subln; const float* w_out; const float* ffn_w_gu; const float* ffn_w_down;
    const float* ln_g; const float* ln_b;
    float* out; unsigned char* ws;
    float lam_init[4];
    float inv32[16];
};

typedef const __attribute__((address_space(4))) Params* KP;
#define GETP(name) KP name = (KP)__builtin_amdgcn_kernarg_segment_ptr(); asm volatile("" : "+s"(name))

__device__ __forceinline__ int tid_fresh() { int t = threadIdx.x; asm volatile("" : "+v"(t)); return t; }
__device__ __forceinline__ unsigned pkbf(float lo, float hi) { f32x2_t v = {lo, hi}; bf16x2_t b = __builtin_convertvector(v, bf16x2_t); return __builtin_bit_cast(unsigned, b); }
__device__ __forceinline__ float bflo(unsigned w) { return __builtin_bit_cast(float, w << 16); }
__device__ __forceinline__ float bfhi(unsigned w) { return __builtin_bit_cast(float, w & 0xffff0000u); }
__device__ __forceinline__ float wave_sum(float v) {
#pragma unroll
    for (int o = 1; o < 64; o <<= 1) v += __shfl_xor(v, o);
    return v;
}
__device__ __forceinline__ void unpack8(const u32x4 w, float (&v)[8]) {
    v[0] = bflo(w.x); v[1] = bfhi(w.x); v[2] = bflo(w.y); v[3] = bfhi(w.y); v[4] = bflo(w.z); v[5] = bfhi(w.z); v[6] = bflo(w.w); v[7] = bfhi(w.w);
}
__device__ __forceinline__ u32x4 pack8(const float (&v)[8]) { u32x4 w; w.x = pkbf(v[0], v[1]); w.y = pkbf(v[2], v[3]); w.z = pkbf(v[4], v[5]); w.w = pkbf(v[6], v[7]); return w; }

__device__ __forceinline__ void transpose_item(const float* __restrict__ W, int ldw, int src_col0, float scale, bf16_t* __restrict__ WT, int K, int dst_row0, int k0, LAS float* scr, int lane,
                                               const float* __restrict__ lng, const float* __restrict__ lnb, float* c1, float* c2) {
    if (src_col0 < 0) {
        const int c = lane & 7;
#pragma unroll
        for (int j = 0; j < 4; ++j) { const int n = (lane >> 3) + 8 * j; *(u32x4*)(WT + (size_t)(dst_row0 + n) * K + k0 + 8 * c) = (u32x4){0u, 0u, 0u, 0u}; }
        return;
    }
    float a1 = 0.f, a2 = 0.f;
#pragma unroll
    for (int i = 0; i < 32; ++i) { const int kk = 2 * i + (lane >> 5); float w = W[(size_t)(k0 + kk) * ldw + src_col0 + (lane & 31)] * scale;
        if (lng) { a2 = fmaf(lnb[k0 + kk], w, a2); w *= lng[k0 + kk]; a1 += bflo(pkbf(w, 0.f)); }
        scr[kk * 33 + (lane & 31)] = w; }
    asm volatile("s_waitcnt lgkmcnt(0)" ::: "memory");
    const int c = lane & 7;
#pragma unroll
    for (int j = 0; j < 4; ++j) { const int n = (lane >> 3) + 8 * j; const LAS float* s = scr + (8 * c) * 33 + n;
        u32x4 o; o.x = pkbf(s[0 * 33], s[1 * 33]); o.y = pkbf(s[2 * 33], s[3 * 33]); o.z = pkbf(s[4 * 33], s[5 * 33]); o.w = pkbf(s[6 * 33], s[7 * 33]);
        *(u32x4*)(WT + (size_t)(dst_row0 + n) * K + k0 + 8 * c) = o; }
    asm volatile("s_waitcnt lgkmcnt(0)" ::: "memory");
    if (lng) { a1 += __shfl_xor(a1, 32); a2 += __shfl_xor(a2, 32);
        if (lane < 32) { atomicAdd(c1 + dst_row0 + lane, a1); atomicAdd(c2 + dst_row0 + lane, a2); } }
}

__device__ __forceinline__ void phase0(KP p, LAS unsigned char* lds, int vcu, int G) {
    const int tid = tid_fresh(), lane = tid & 63, wave = __builtin_amdgcn_readfirstlane(tid >> 6);
    LAS float* scr = (LAS float*)(lds + wave * 16384);
    const int gw = vcu * NWAVES + wave, NGW = G * NWAVES;
    bf16_t* wgu = (bf16_t*)(p->ws + WS_WGU); bf16_t* wd = (bf16_t*)(p->ws + WS_WD); bf16_t* win = (bf16_t*)(p->ws + WS_WIN); bf16_t* wout = (bf16_t*)(p->ws + WS_WOUT);
    float* c12 = (float*)(p->ws + WS_C12);
    constexpr int I_GU = 176 * 16, I_WD = 32 * 44, I_IN = 104 * 16, I_OUT = 32 * 16, I_CMP = 128 * 14;
    constexpr int I_LAYER = 2 * I_GU + 2 * I_WD + I_IN + I_OUT + I_CMP;
    for (int it = gw; it < DEPTH * I_LAYER; it += NGW) {
        const int l = it / I_LAYER; int r = it % I_LAYER;
        if (r < 2 * I_GU) { const int f = r / I_GU; r %= I_GU; const int nb = r / 16, kb = r % 16; const int n0 = 32 * nb;
            const int pn = n0 >> 8, bj = (n0 >> 7) & 1, i0 = n0 & 127;
            const int s = 3 * l + 2 * f - 1;
            transpose_item(p->ffn_w_gu + ((size_t)l * 2 + f) * DM * NGU, NGU, bj * DFF + 128 * pn + i0, 1.f, wgu + l * WGU_L + f * WGU_F, DM, n0, 64 * kb, scr, lane,
                           s >= 0 ? p->ln_g + s * DM : nullptr, s >= 0 ? p->ln_b + s * DM : nullptr, c12 + l * C12_L + f * NGU, c12 + C2_OFF + l * C12_L + f * NGU); continue; }
        r -= 2 * I_GU;
        if (r < 2 * I_WD) { const int f = r / I_WD; r %= I_WD; const int nb = r / 44, kb = r % 44;
            transpose_item(p->ffn_w_down + ((size_t)l * 2 + f) * DFF * DM, DM, 32 * nb, 1.f, wd + l * WD_L + f * WD_F, DFF, 32 * nb, 64 * kb, scr, lane, nullptr, nullptr, nullptr, nullptr); continue; }
        r -= 2 * I_WD;
        if (r < I_IN) { const int nb = r / 16, kb = r % 16; const int n0 = 32 * nb; int src; float sc = 1.f;
            if (n0 < PC) { src = n0; if (n0 < 256) sc = 0.125f; }
            else if (n0 < PD) src = 928 + (n0 - PC);
            else if (n0 < PCQ) { src = 1440 + (n0 - PD); if (n0 - PD < 256) sc = 0.17677669529663687f; }
            else if (n0 < PCKV) src = 512 + (n0 - PCQ);
            else if (n0 < PKR) src = 768 + (n0 - PCKV);
            else if (n0 < PQUP) src = 896;
            else if (n0 < PEND) continue;
            else src = -1;
            transpose_item(p->w_in + (size_t)l * DM * NIN_SRC, NIN_SRC, src, sc, win + l * WIN_L, DM, n0, 64 * kb, scr, lane,
                           p->ln_g + (3 * l) * DM, p->ln_b + (3 * l) * DM, c12 + l * C12_L + 2 * NGU, c12 + C2_OFF + l * C12_L + 2 * NGU); continue; }
        r -= I_IN;
        if (r < I_OUT) { const int nb = r / 16, kb = r % 16;
            transpose_item(p->w_out + (size_t)l * DM * DM, DM, 32 * nb, 1.f, wout + l * WOUT_L, DM, 32 * nb, 64 * kb, scr, lane, nullptr, nullptr, nullptr, nullptr); continue; }
        r -= I_OUT;
        {
            const int kb8 = r / 14, ng = r % 14; const int k0 = 8 * kb8;
            int J, cA, ldu, nc; const float* g; const float* U;
            if (ng < 6) { J = 256; cA = 512; g = p->mla_q_norm + l * 256; U = p->mla_w_uq + (size_t)l * 256 * 384; ldu = 384; nc = 64 * ng; }
            else { J = 128; cA = 768; g = p->mla_kv_norm + l * 128; U = p->mla_w_ukv + (size_t)l * 128 * 512; ldu = 512; nc = 64 * (ng - 6); }
            const int nglob = (ng < 6 ? 0 : 384) + nc + lane;
            const float* a = p->w_in + (size_t)l * DM * NIN_SRC + (size_t)k0 * NIN_SRC + cA;
            const float* up = U + nc + lane;
            float acc[8];
#pragma unroll
            for (int e = 0; e < 8; ++e) acc[e] = 0.f;
#pragma unroll 4
            for (int j = 0; j < J; ++j) { const float u = up[(size_t)j * ldu] * g[j];
#pragma unroll
                for (int e = 0; e < 8; ++e) acc[e] = fmaf(a[(size_t)e * NIN_SRC + j], u, acc[e]); }
            const float* lg = p->ln_g + (3 * l) * DM + k0; const float* lb = p->ln_b + (3 * l) * DM + k0;
            float s1 = 0.f, s2 = 0.f; unsigned wb[8];
#pragma unroll
            for (int e = 0; e < 8; ++e) { wb[e] = pkbf(acc[e] * lg[e], 0.f) & 0xffffu; s1 += bflo(wb[e]); s2 = fmaf(acc[e], lb[e], s2); }
            u32x4 o; o.x = wb[0] | (wb[1] << 16); o.y = wb[2] | (wb[3] << 16); o.z = wb[4] | (wb[5] << 16); o.w = wb[6] | (wb[7] << 16);
            *(u32x4*)(win + l * WIN_L + (size_t)(PQUP + nglob) * DM + k0) = o;
            atomicAdd(c12 + l * C12_L + 2 * NGU + PQUP + nglob, s1); atomicAdd(c12 + C2_OFF + l * C12_L + 2 * NGU + PQUP + nglob, s2);
        }
    }
    { u32x4* ag = (u32x4*)(p->ws + WS_AUG);
      for (int i = (vcu * NWAVES + wave) * 64 + lane; i < SEQ * 4; i += G * NWAVES * 64) { const int t = i >> 2, h = i & 3;
          const float sl = __builtin_amdgcn_exp2f(-(float)(5 + h));
          u32x4 w = {pkbf(sl * (float)(128 * (t >> 7)), sl * (float)(t & 127)), 0u, 0u, 0u}; ag[2 * i] = w; ag[2 * i + 1] = (u32x4){0u, 0u, 0u, 0u}; } }
    bf16_t* xb = (bf16_t*)(p->ws + WS_XB);
    for (int m = gw; m < T; m += NGW) {
        const f32x4* xr = (const f32x4*)(p->x + (size_t)m * DM) + lane; u32x2* o8 = (u32x2*)(xb + (size_t)m * DM) + lane;
#pragma unroll
        for (int j = 0; j < 4; ++j) { const f32x4 v = xr[64 * j]; u32x2 w; w.x = pkbf(v.x, v.y); w.y = pkbf(v.z, v.w); o8[64 * j] = w; }
    }
}

template <bool WRITE_XB> __device__ __forceinline__ void ln_phase(float* X, bf16_t* xb, const float* __restrict__ g, const float* __restrict__ b, int vcu, int G) {
    const int tid = tid_fresh(), lane = tid & 63, wave = __builtin_amdgcn_readfirstlane(tid >> 6);
    const int gw = vcu * NWAVES + wave, NGW = G * NWAVES;
    f32x4 gv[4], bv[4];
#pragma unroll
    for (int j = 0; j < 4; ++j) { gv[j] = ((const f32x4*)g)[64 * j + lane]; bv[j] = ((const f32x4*)b)[64 * j + lane]; }
    for (int m = gw; m < T; m += NGW) {
        f32x4* xr = (f32x4*)(X + (size_t)m * DM) + lane; u32x2* o8 = (u32x2*)(xb + (size_t)m * DM) + lane;
        f32x4 v[4]; float s = 0.f;
#pragma unroll
        for (int j = 0; j < 4; ++j) { v[j] = xr[64 * j]; s += (v[j].x + v[j].y) + (v[j].z + v[j].w); }
        const float mean = wave_sum(s) * (1.f / DM); float s2 = 0.f;
#pragma unroll
        for (int j = 0; j < 4; ++j) { v[j] = v[j] - mean; s2 += (v[j].x * v[j].x + v[j].y * v[j].y) + (v[j].z * v[j].z + v[j].w * v[j].w); }
        const float rstd = 1.f / sqrtf(wave_sum(s2) * (1.f / DM) + NORM_EPS);
#pragma unroll
        for (int j = 0; j < 4; ++j) { const f32x4 y = v[j] * rstd * gv[j] + bv[j]; xr[64 * j] = y; if (WRITE_XB) { u32x2 w; w.x = pkbf(y.x, y.y); w.y = pkbf(y.z, y.w); o8[64 * j] = w; } }
    }
}

__device__ __forceinline__ void sincos_rev(float ang, float& s, float& c) {
    double d = (double)ang * 0.15915494309189535; d -= __builtin_rint(d); const float f = (float)d;
    s = __builtin_amdgcn_sinf(f); c = __builtin_amdgcn_cosf(f);
}
__device__ __forceinline__ void rope8(float (&v)[8], bool first, float pos, int i0, KP p) {
#pragma unroll
    for (int e = 0; e < 8; ++e) {
        const float other = __shfl_xor(v[e], 2);
        const float inv = i0 ? p->inv32[8 + e] : p->inv32[e];
        float s, c; sincos_rev(pos * inv, s, c);
        v[e] = first ? (v[e] * c - other * s) : (other * s + v[e] * c);
    }
}
__device__ __forceinline__ void prep_phase(KP p, int l, int vcu, int G) {
    const int tid = tid_fresh(), lane = tid & 63, wave = __builtin_amdgcn_readfirstlane(tid >> 6);
    const int gw = vcu * NWAVES + wave, NGW = G * NWAVES;
    bf16_t* proj = (bf16_t*)(p->ws + WS_PROJ); bf16_t* qb = (bf16_t*)(p->ws + WS_QB); bf16_t* kb = (bf16_t*)(p->ws + WS_KB); bf16_t* vb = (bf16_t*)(p->ws + WS_VB);
    float cg[8];
    { const float* gsrc = (lane < 32 ? p->ax_q_norm : p->ax_k_norm) + l * 64 + 8 * (lane & 7);
#pragma unroll
      for (int e = 0; e < 8; ++e) cg[e] = gsrc[e]; }
    float km0 = 0.f, km1 = 0.f;
    float kb0 = 0.f, kb1 = 0.f, kc0 = 0.f, kc1 = 0.f;
    for (int tok = gw; tok < T; tok += NGW) {
        const int t = tok & (SEQ - 1);
        bf16_t* pr = proj + (size_t)tok * NPROJ;
        const int l48 = lane < 48 ? lane : 0, l32 = lane < 32 ? lane : 0, l4 = lane < 4 ? lane : 0;
        const u32x4 in_cq = *(const u32x4*)(pr + PCQ + 8 * l48), in_qup = *(const u32x4*)(pr + PQUP + 8 * l48), in_kv = *(const u32x4*)(pr + PKVUP + 8 * lane);
        const u32x4 in_kr = *(const u32x4*)(pr + PKR + 8 * l4), in_c = *(const u32x4*)(pr + PC + 8 * l48), in_dk = *(const u32x4*)(pr + PD + 256 + 8 * l32);
        { float s = 0.f;
          if (lane < 32) { float v[8]; unpack8(in_dk, v);
#pragma unroll
              for (int e = 0; e < 8; ++e) s += v[e] * v[e]; }
          s += __shfl_xor(s, 1); s += __shfl_xor(s, 2);
          if (tok < SEQ) km0 = fmaxf(km0, s); else km1 = fmaxf(km1, s); }
        float ssq = 0.f;
        if (lane < 48) { float v[8]; unpack8(in_cq, v);
#pragma unroll
            for (int e = 0; e < 8; ++e) ssq += v[e] * v[e]; }
        const float ssq_q = wave_sum(lane < 32 ? ssq : 0.f), ssq_kv = wave_sum(lane >= 32 ? ssq : 0.f);
        const float rstd_q = 1.f / sqrtf(ssq_q * (1.f / 256.f) + NORM_EPS), rstd_kv = 1.f / sqrtf(ssq_kv * (1.f / 128.f) + NORM_EPS);
        {
            const int r = lane % 12; float v[8];
            unpack8(in_qup, v);
#pragma unroll
            for (int e = 0; e < 8; ++e) v[e] = (lane < 48) ? v[e] * rstd_q : 0.f;
            float w[8];
#pragma unroll
            for (int e = 0; e < 8; ++e) w[e] = v[e];
            rope8(w, r < 10, (float)t, 8 * (r & 1), p);
            const bool isr = (r >= 8); const float qs = 0.10206207261596575f;
#pragma unroll
            for (int e = 0; e < 8; ++e) v[e] = (isr ? w[e] : v[e]) * qs;
            if (lane < 48) *(u32x4*)(qb + (size_t)tok * 384 + 8 * lane) = pack8(v);
        }
        float nope2;
        {
            float v[8]; unpack8(in_kv, v);
#pragma unroll
            for (int e = 0; e < 8; ++e) v[e] *= rstd_kv;
            const int hd = lane >> 4, r = lane & 15;
            { float s = 0.f;
#pragma unroll
              for (int e = 0; e < 8; ++e) s += v[e] * v[e];
              s = (r < 8) ? s : 0.f; s += __shfl_xor(s, 1); s += __shfl_xor(s, 2); s += __shfl_xor(s, 4); nope2 = s; }
            if (r < 8) *(u32x4*)(kb + (size_t)tok * 384 + hd * 96 + 8 * r) = pack8(v);
            else *(u32x4*)(vb + (size_t)tok * 256 + hd * 64 + 8 * (r - 8)) = pack8(v);
        }
        {
            float v[8]; unpack8(in_kr, v);
            rope8(v, (lane & 3) < 2, (float)t, 8 * (lane & 1), p);
            { float s = 0.f;
#pragma unroll
              for (int e = 0; e < 8; ++e) s += v[e] * v[e];
              s = (lane < 4) ? s : 0.f; s += __shfl_xor(s, 1); s += __shfl_xor(s, 2);
              const float kk = nope2 + __shfl(s, 0);
              if (tok < SEQ) kb0 = fmaxf(kb0, kk); else kb1 = fmaxf(kb1, kk); }
            if (lane < 4) { const u32x4 w = pack8(v);
#pragma unroll
                for (int hd = 0; hd < 4; ++hd) *(u32x4*)(kb + (size_t)tok * 384 + hd * 96 + 64 + 8 * lane) = w; }
        }
        {
            float v[8]; unpack8(in_c, v);
            float s = 0.f;
#pragma unroll
            for (int e = 0; e < 8; ++e) s += v[e] * v[e];
            s += __shfl_xor(s, 1); s += __shfl_xor(s, 2); s += __shfl_xor(s, 4);
            const float rs = 1.f / sqrtf(s * (1.f / 64.f) + NORM_EPS);
#pragma unroll
            for (int e = 0; e < 8; ++e) v[e] = v[e] * rs * cg[e];
            const int r = lane & 7; const float pos = (r < 4) ? (float)(t >> 6) : (float)(t & 63);
            rope8(v, (r & 3) < 2, pos, 8 * (r & 1), p);
            { float s2 = 0.f;
#pragma unroll
              for (int e = 0; e < 8; ++e) s2 += v[e] * v[e];
              s2 += __shfl_xor(s2, 1); s2 += __shfl_xor(s2, 2); s2 += __shfl_xor(s2, 4);
              if (tok < SEQ) kc0 = fmaxf(kc0, s2); else kc1 = fmaxf(kc1, s2); }
            if (lane < 32) {
#pragma unroll
                for (int e = 0; e < 8; ++e) v[e] *= 0.125f; }
            if (lane < 48) *(u32x4*)(pr + PC + 8 * lane) = pack8(v);
        }
    }
    unsigned* kmw = (unsigned*)(p->ws + WS_KMAX) + l * 32;
    if (lane < 32 && (lane & 3) == 0) { atomicMax(kmw + (lane >> 2), __builtin_bit_cast(unsigned, km0)); atomicMax(kmw + 8 + (lane >> 2), __builtin_bit_cast(unsigned, km1)); }
    if ((lane & 15) == 0) { atomicMax(kmw + 16 + (lane >> 4), __builtin_bit_cast(unsigned, kb0)); atomicMax(kmw + 20 + (lane >> 4), __builtin_bit_cast(unsigned, kb1)); }
    if (lane == 32 || lane == 40) { atomicMax(kmw + 24 + ((lane - 32) >> 3), __builtin_bit_cast(unsigned, kc0)); atomicMax(kmw + 26 + ((lane - 32) >> 3), __builtin_bit_cast(unsigned, kc1)); }
}

#ifndef ATT_TYPES
#define ATT_TYPES 15
#endif
namespace att {
typedef float f32x2 __attribute__((ext_vector_type(2)));
constexpr int VPITCH = 144, KBUF = 64 * 208, VBUF = 64 * VPITCH;
constexpr int ATT_LDS = 2 * KBUF + 2 * VBUF;
constexpr float RESCALE_T = 5.0f;
__device__ __forceinline__ s16x4 vtr(const LAS char* p) { return __builtin_bit_cast(s16x4, __builtin_amdgcn_ds_read_tr16_b64_v4i16((LAS s16x4*)p)); }
__device__ __forceinline__ void xhalf_swap(float m, float& a, float& b) {
    a = m; b = m;
    asm volatile("s_nop 1\n\tv_permlane32_swap_b32 %0, %1\n\ts_nop 1" : "+v"(a), "+v"(b));
}
__device__ __forceinline__ float xhalf_max(float m) { float a, b; xhalf_swap(m, a, b); return fmaxf(a, b); }
__device__ __forceinline__ float xhalf_sum(float m) { float a, b; xhalf_swap(m, a, b); return a + b; }
__device__ __forceinline__ float max3f(float a, float b, float c) { return fmaxf(fmaxf(a, b), c); }
__device__ __forceinline__ float fma_s(float a, float b, float c) { float r; asm("v_fma_f32 %0, %1, %2, %3" : "=v"(r) : "v"(a), "s"(b), "v"(c)); return r; }
__device__ __forceinline__ float add_s(float a, float b) { float r; asm("v_add_f32_e32 %0, %1, %2" : "=v"(r) : "v"(a), "v"(b)); return r; }
__device__ __forceinline__ float mul_s(float a, float b) { float r; asm("v_mul_f32_e32 %0, %1, %2" : "=v"(r) : "v"(a), "v"(b)); return r; }
#define ATT_MFMA(a, b, c) __builtin_amdgcn_mfma_f32_32x32x16_bf16((a), (b), (c), 0, 0, 0)

template <int DK, int MODE, bool INIT = true, bool TRACK = (MODE == 2)>
__device__ __forceinline__ void flash_pass(LAS char* lds, const bf16_t* __restrict__ Qg, int qp, const bf16_t* __restrict__ Kg, int kp, const bf16_t* __restrict__ Vg, int vp,
                                           const bf16_t* __restrict__ AUGg, int q0, int a0, int nA, int b0, int nt, float slope, f32x16& O0, f32x16& O1, float& Mout, float& Lout) {
    constexpr int DKL = DK + (MODE == 1 ? 16 : 0);
    constexpr int KPITCH = DKL * 2 + 16, NKC = 8 * DKL, CPR = DKL / 8, NKS = DK / 16;
    constexpr bool HAS_K1 = NKC > 512;
    constexpr int DUMMY = 2 * KBUF + 2 * VBUF;
    const int tid = tid_fresh(), lane = tid & 63, r32 = lane & 31, hi = lane >> 5; const int wid = __builtin_amdgcn_readfirstlane(tid >> 6);
    const int qrow = q0 + wid * 32 + r32;
    bf16x8 qf[NKS];
#pragma unroll
    for (int ks = 0; ks < NKS; ++ks) qf[ks] = *(const bf16x8*)(Qg + (size_t)qrow * qp + 16 * ks + 8 * hi);
    const int kc1 = tid + 512;
    const bool k0v = tid < NKC, k1v = HAS_K1 && kc1 < NKC;
    const int kr0 = k0v ? tid / CPR : 0, kcc0 = k0v ? tid % CPR : 0, kr1 = k1v ? kc1 / CPR : 0, kcc1 = k1v ? kc1 % CPR : 0, vr = tid >> 3, vcc = tid & 7;
    const bf16_t* kg0; size_t kst0;
    if (MODE == 1 && kcc0 >= DK / 8) { kg0 = AUGg + (size_t)kr0 * 64 + 8 * (kcc0 - DK / 8); kst0 = (size_t)64 * 64; } else { kg0 = Kg + (size_t)kr0 * kp + 8 * kcc0; kst0 = (size_t)64 * kp; }
    const bf16_t* kg1 = Kg + (size_t)kr1 * kp + 8 * kcc1; const size_t kst1 = (size_t)64 * kp;
    const bf16_t* vg = Vg + (size_t)vr * vp + 8 * vcc; const size_t vst = (size_t)64 * vp;
    const int kl0 = k0v ? kr0 * KPITCH + 16 * kcc0 : -1, kl1 = k1v ? kr1 * KPITCH + 16 * kcc1 : -1, vl = 2 * KBUF + vr * VPITCH + 16 * vcc;
    u32x4 rk0A = {0u, 0u, 0u, 0u}, rk1A = {0u, 0u, 0u, 0u}, rvA = {0u, 0u, 0u, 0u}, rk0B = {0u, 0u, 0u, 0u}, rk1B = {0u, 0u, 0u, 0u}, rvB = {0u, 0u, 0u, 0u};
#define ATT_KT(i) ((i) < nA ? a0 + (i) : b0 + ((i) - nA))
#define ATT_LOADK(X, kt) do { const size_t t_ = (size_t)(kt); rk0##X = *(const u32x4*)(kg0 + t_ * kst0); if (HAS_K1) rk1##X = *(const u32x4*)(kg1 + t_ * kst1); } while (0)
#define ATT_LOADV(X, kt) do { rv##X = *(const u32x4*)(vg + (size_t)(kt) * vst); } while (0)
#define ATT_STOREK(X, buf) do { *(LAS u32x4*)(lds + (kl0 >= 0 ? (buf) * KBUF + kl0 : DUMMY + tid * 16)) = rk0##X; if (HAS_K1) *(LAS u32x4*)(lds + (kl1 >= 0 ? (buf) * KBUF + kl1 : DUMMY + tid * 16)) = rk1##X; } while (0)
#define ATT_STOREV(X, buf) do { *(LAS u32x4*)(lds + (buf) * VBUF + vl) = rv##X; } while (0)
    const int q4 = (lane & 15) >> 2, p4 = lane & 3, b16 = (lane >> 4) & 1;
    const int vbase = 2 * KBUF + (4 * hi + q4) * VPITCH + 32 * b16 + 8 * p4;
    const int kbase = r32 * KPITCH + 16 * hi;
    const int qw = q0 + wid * 32;
    const float stq = slope * (float)qrow;
    const bf16x8 qzero = {0, 0, 0, 0, 0, 0, 0, 0};
    bf16x8 qpos = qzero, qneg = qzero;
    if (MODE == 1 && hi == 0) { qpos[0] = (short)0x3F80; qpos[1] = (short)0x3F80; qneg[0] = (short)0xBF80; qneg[1] = (short)0xBF80; }
    constexpr int NKF = NKS + (MODE == 1 ? 1 : 0);
    constexpr int KPRE = NKF > 4 ? 4 : NKF;
    bf16x8 kfa[NKF], kfb[NKF];
#define ATT_KREAD(kbuf, f0, f1) do { const LAS char* Kb_ = lds + (kbuf) * KBUF + kbase; \
        _Pragma("unroll") for (int ks_ = (f0); ks_ < (f1); ++ks_) { kfa[ks_] = *(const LAS bf16x8*)(Kb_ + 32 * ks_); kfb[ks_] = *(const LAS bf16x8*)(Kb_ + 32 * KPITCH + 32 * ks_); } } while (0)
#define ATT_QKM(sa, sb, side) do { \
        _Pragma("unroll") for (int e_ = 0; e_ < 16; ++e_) { sa[e_] = 0.f; sb[e_] = 0.f; } \
        _Pragma("unroll") for (int ks_ = 0; ks_ < NKS; ++ks_) { sa = ATT_MFMA(kfa[ks_], qf[ks_], sa); sb = ATT_MFMA(kfb[ks_], qf[ks_], sb); } \
        if (MODE == 1) { const bf16x8 qa_ = (side) < 0 ? qpos : ((side) > 0 ? qneg : qzero); sa = ATT_MFMA(kfa[NKS], qa_, sa); sb = ATT_MFMA(kfb[NKS], qa_, sb); } } while (0)
#define ATT_QK(sa, sb, kbuf, side) do { ATT_KREAD(kbuf, 0, NKF); ATT_QKM(sa, sb, side); } while (0)
    bf16x8 vfa[4], vfb[4];
#define ATT_VREAD(vbuf) do { const LAS char* Vb_ = lds + (vbuf) * VBUF + vbase; \
        _Pragma("unroll") for (int j_ = 0; j_ < 4; ++j_) { const LAS char* vp0_ = Vb_ + (16 * j_) * VPITCH; \
            { const s16x4 lo_ = vtr(vp0_), hh_ = vtr(vp0_ + 8 * VPITCH); vfa[j_] = __builtin_shufflevector(lo_, hh_, 0, 1, 2, 3, 4, 5, 6, 7); } \
            { const s16x4 lo_ = vtr(vp0_ + 64), hh_ = vtr(vp0_ + 8 * VPITCH + 64); vfb[j_] = __builtin_shufflevector(lo_, hh_, 0, 1, 2, 3, 4, 5, 6, 7); } } } while (0)
#define ATT_PVM() do { _Pragma("unroll") for (int j_ = 0; j_ < 4; ++j_) { O0 = ATT_MFMA(vfa[j_], pf[j_ >> 1][j_ & 1], O0); O1 = ATT_MFMA(vfb[j_], pf[j_ >> 1][j_ & 1], O1); } } while (0)
#define ATT_PV(vbuf) do { ATT_VREAD(vbuf); ATT_PVM(); } while (0)
#define ATT_SIDE(kt) ((MODE != 1) ? 0 : (((kt) * 64 + 63 < qw) ? -1 : (((kt) * 64 > qw + 31) ? 1 : 0)))
    ATT_LOADK(A, ATT_KT(0)); ATT_LOADK(B, ATT_KT(1)); ATT_STOREV(B, 1);
    ATT_STOREK(A, 0); ATT_STOREK(B, 1);
    ATT_LOADK(A, ATT_KT(2)); ATT_LOADV(A, ATT_KT(0));
    __syncthreads();
    float M = (INIT && TRACK) ? -1e20f : Mout, L = INIT ? 0.f : Lout;
    if (INIT) {
#pragma unroll
        for (int i = 0; i < 16; ++i) { O0[i] = 0.f; O1[i] = 0.f; } }
    bf16x8 pf[2][2];
#pragma unroll
    for (int kb = 0; kb < 2; ++kb)
#pragma unroll
        for (int st = 0; st < 2; ++st) pf[kb][st] = qzero;
    f32x16 s0, s1, n0, n1;
    int side_cur = ATT_SIDE(ATT_KT(0));
    ATT_QK(s0, s1, 0, side_cur);
#pragma unroll
    for (int e = 0; e < 16; ++e) { n0[e] = 0.f; n1[e] = 0.f; }
    __syncthreads();
    constexpr int NMF = 2 * NKS + (MODE == 1 ? 2 : 0) + 8;
#define ATT_ITER(i, C0, C1, N0, N1, LS, SS, HASN, HASK2, HASK3) do { \
        const int kt = ATT_KT(i); \
        if (HASK3) ATT_LOADK(LS, ATT_KT((i) + 3)); \
        if (HASN) ATT_LOADV(LS, ATT_KT((i) + 1)); \
        if (HASN) ATT_KREAD(((i) + 1) & 1, 0, KPRE); \
        const int k0 = kt * 64; \
          \
        float rc = 0.f; \
        if (MODE == 1) { \
            if (side_cur != 0) rc = side_cur < 0 ? -stq : stq; \
            else { const float dbase = (float)(k0 + 4 * hi - qrow); \
                _Pragma("unroll") for (int e = 0; e < 16; ++e) { const float c = (float)((e & 3) + 8 * (e >> 2)); \
                    C0[e] = fmaf(-slope, fabsf(dbase + c), C0[e]); C1[e] = fmaf(-slope, fabsf(dbase + (c + 32.f)), C1[e]); } } \
        } \
        if (MODE == 2) { const float dbase = (float)(k0 + 4 * hi - qrow); \
            _Pragma("unroll") for (int e = 0; e < 16; ++e) { const float c = (float)((e & 3) + 8 * (e >> 2)); \
                const float d0 = fabsf(dbase + c), d1 = fabsf(dbase + (c + 32.f)); \
                C0[e] = (d0 <= 128.f) ? fmaf(-slope, d0, C0[e]) : -1e30f; C1[e] = (d1 <= 128.f) ? fmaf(-slope, d1, C1[e]) : -1e30f; } } \
        if (TRACK) { \
        float mx = max3f(C0[0], C1[0], C0[1]); \
        _Pragma("unroll") for (int e = 1; e < 15; e += 2) { mx = max3f(mx, C1[e], C0[e + 1]); mx = max3f(mx, C1[e + 1], C0[e + 2]); } \
        mx = fmaxf(mx, C1[15]); \
        const float mt = xhalf_max(mx) + rc;                     \
        if (__builtin_amdgcn_ballot_w64(mt > M + RESCALE_T) != 0ull) {         \
            ATT_PV(((i) + 1) & 1); \
            _Pragma("unroll") for (int kb = 0; kb < 2; ++kb) _Pragma("unroll") for (int st = 0; st < 2; ++st) pf[kb][st] = qzero; \
            const float Mn = fmaxf(M, mt); const float alpha = __builtin_amdgcn_exp2f((M - Mn) * LOG2E); M = Mn; \
            L *= alpha; \
            _Pragma("unroll") for (int e = 0; e < 16; ++e) { O0[e] *= alpha; O1[e] *= alpha; }        \
        } } \
          \
        const int side_next = HASN ? ATT_SIDE(ATT_KT((i) + 1)) : 0; \
        if (HASN) ATT_KREAD(((i) + 1) & 1, KPRE, NKF); \
        ATT_VREAD(((i) + 1) & 1); \
        if (HASN) ATT_QKM(N0, N1, side_next); \
        ATT_PVM();                                   \
        const float cc = (rc - M) * LOG2E; \
        float ps = 0.f;                                          \
        float ps1 = 0.f; \
        _Pragma("unroll") for (int e = 0; e < 16; ++e) { float t0 = __builtin_fmaf(C0[e], LOG2E, cc), t1 = __builtin_fmaf(C1[e], LOG2E, cc); \
            asm("" : "+v"(t0)); asm("" : "+v"(t1));                 \
            C0[e] = __builtin_amdgcn_exp2f(t0); C1[e] = __builtin_amdgcn_exp2f(t1); \
            float u0 = ps + C0[e], u1 = ps1 + C1[e]; asm("" : "+v"(u0)); asm("" : "+v"(u1)); ps = u0; ps1 = u1; } \
        L += ps + ps1; \
        _Pragma("unroll") for (int st = 0; st < 2; ++st) { u32x4 w0, w1; \
            w0.x = pkbf(C0[8 * st + 0], C0[8 * st + 1]); w0.y = pkbf(C0[8 * st + 2], C0[8 * st + 3]); w0.z = pkbf(C0[8 * st + 4], C0[8 * st + 5]); w0.w = pkbf(C0[8 * st + 6], C0[8 * st + 7]); \
            w1.x = pkbf(C1[8 * st + 0], C1[8 * st + 1]); w1.y = pkbf(C1[8 * st + 2], C1[8 * st + 3]); w1.z = pkbf(C1[8 * st + 4], C1[8 * st + 5]); w1.w = pkbf(C1[8 * st + 6], C1[8 * st + 7]); \
            pf[0][st] = __builtin_bit_cast(bf16x8, w0); pf[1][st] = __builtin_bit_cast(bf16x8, w1); } \
        side_cur = side_next; \
        if (HASN) { __builtin_amdgcn_sched_group_barrier(0x100, 8, 0);        \
            _Pragma("unroll") for (int g_ = 0; g_ < NMF; ++g_) { __builtin_amdgcn_sched_group_barrier(0x008, 1, 0); __builtin_amdgcn_sched_group_barrier(0x100, 2, 0); __builtin_amdgcn_sched_group_barrier(0x002, 6, 0); } } \
        if (HASK2) ATT_STOREK(SS, (i) & 1); \
        ATT_STOREV(SS, (i) & 1); \
        __syncthreads(); } while (0)
    for (int i = 0; i + 4 < nt; i += 2) {
        ATT_ITER(i, s0, s1, n0, n1, B, A, true, true, true);
        ATT_ITER(i + 1, n0, n1, s0, s1, A, B, true, true, true);
    }
    ATT_ITER(nt - 4, s0, s1, n0, n1, B, A, true, true, true);
    ATT_ITER(nt - 3, n0, n1, s0, s1, A, B, true, true, false);
    ATT_ITER(nt - 2, s0, s1, n0, n1, B, A, true, false, false);
    ATT_ITER(nt - 1, n0, n1, s0, s1, A, B, false, false, false);
    ATT_PV((nt - 1) & 1);
    __syncthreads();
#undef ATT_ITER
#undef ATT_LOADK
#undef ATT_LOADV
#undef ATT_STOREK
#undef ATT_STOREV
#undef ATT_KT
#undef ATT_QK
#undef ATT_PV
#undef ATT_KREAD
#undef ATT_QKM
#undef ATT_VREAD
#undef ATT_PVM
#undef ATT_SIDE
    Mout = M; Lout = L;
}

template <int NE> __device__ __forceinline__ float row_norm2(const bf16_t* qrow_ptr) {
    float s = 0.f;
#pragma unroll
    for (int c = 0; c < NE / 8; ++c) { float v[8]; unpack8(((const u32x4*)qrow_ptr)[c], v);
#pragma unroll
        for (int e = 0; e < 8; ++e) s += v[e] * v[e]; }
    return s;
}
__device__ __forceinline__ void store_o(bf16_t* orow, const f32x16& O0, const f32x16& O1, int hi) {
#pragma unroll
    for (int g = 0; g < 4; ++g) {
        u32x2 w0, w1; w0.x = pkbf(O0[4 * g], O0[4 * g + 1]); w0.y = pkbf(O0[4 * g + 2], O0[4 * g + 3]); w1.x = pkbf(O1[4 * g], O1[4 * g + 1]); w1.y = pkbf(O1[4 * g + 2], O1[4 * g + 3]);
        *(u32x2*)(orow + 8 * g + 4 * hi) = w0; *(u32x2*)(orow + 32 + 8 * g + 4 * hi) = w1;
    }
}

__device__ __forceinline__ void attn_phase(KP p, int l, LAS char* lds, int vcu, int G) {
    const bf16_t* proj = (const bf16_t*)(p->ws + WS_PROJ); const bf16_t* qb = (const bf16_t*)(p->ws + WS_QB); const bf16_t* kb = (const bf16_t*)(p->ws + WS_KB); const bf16_t* vb = (const bf16_t*)(p->ws + WS_VB);
    const bf16_t* aug = (const bf16_t*)(p->ws + WS_AUG);
    bf16_t* mix = (bf16_t*)(p->ws + WS_MIX);
    for (;;) {
        const int qx = (int)(blockIdx.x & 7u);
        const int tid = tid_fresh(), lane = tid & 63, r32 = lane & 31, hi = lane >> 5; const int wid = __builtin_amdgcn_readfirstlane(tid >> 6);
        LAS unsigned* slot = (LAS unsigned*)(lds + ATT_LDS + 16384 + 64);
        if (tid == 0) *slot = __hip_atomic_fetch_add((unsigned*)(p->ws + WS_QCTR) + l * 8 + qx, 1u, __ATOMIC_RELAXED, __HIP_MEMORY_SCOPE_AGENT);
        __syncthreads();
        const int j = __builtin_amdgcn_readfirstlane((int)*slot);
        __syncthreads();
        if (j >= 256) break;
        int type, hd, qblk; const int b = qx >> 2;
        if (j < 16) { type = 0; hd = 3; qblk = (qx & 3) + 4 * j; }
        else if (j < 80) { type = 1; hd = qx & 3; qblk = j - 16; }
        else if (j < 144) { type = 2; hd = qx & 3; qblk = j - 80; }
        else if (j < 192) { type = 0; hd = 2 - ((j - 144) >> 4); qblk = (qx & 3) + 4 * ((j - 144) & 15); }
        else { type = 3; hd = qx & 3; qblk = j - 192; }
        const int q0 = qblk * 256;
        const int qrow = q0 + wid * 32 + r32;
        const size_t tok0 = (size_t)b * SEQ;
        f32x16 O0, O1; float M, L;
        if (type == 0) {
            const int bD = b, hD = hd;
            const size_t tokD = (size_t)bD * SEQ;
            const float slope = __builtin_amdgcn_exp2f(-(float)(5 + hD));
            const bf16_t* base = proj + tokD * NPROJ + PD;
            const int d0 = q0 / 64;
            LAS float* asave = (LAS float*)(lds + 65536) + tid;
#pragma unroll 1
            for (int mp = 0; mp < 2; ++mp) {
                const bf16_t* Qm = base + 64 * hD + 32 * mp; const bf16_t* Km = base + 256 + 64 * hD + 32 * mp; const bf16_t* Vm = base + 512 + 64 * hD;
                const float kmax = sqrtf(__builtin_bit_cast(float, ((const unsigned*)(p->ws + WS_KMAX))[l * 32 + bD * 8 + hD * 2 + mp]));
                const float bound = sqrtf(row_norm2<32>(Qm + (size_t)qrow * NPROJ)) * kmax * 1.01f;
                M = bound;
                flash_pass<32, 1, true>(lds, Qm, NPROJ, Km, NPROJ, Vm, NPROJ, aug + 16 * hD, q0, d0, 4, 0, 4, slope, O0, O1, M, L);
                float dc = (bound + (20.8f + __logf(2.f / slope)) - (M + __logf(fmaxf(xhalf_sum(L), 1e-37f)))) / slope;
                dc = fminf(fmaxf(dc, 0.f), 1.0e8f);
#pragma unroll
                for (int o = 1; o < 64; o <<= 1) dc = fmaxf(dc, __shfl_xor(dc, o));
                LAS float* red = (LAS float*)(lds + ATT_LDS + 16384);
                if (lane == 0) red[wid] = dc;
                __syncthreads();
#pragma unroll
                for (int w = 0; w < 8; ++w) dc = fmaxf(dc, red[w]);
                __syncthreads();
                const int dci = (int)dc + 1;
                const int lo_key = q0 - dci - 63;
                int ktlo = lo_key <= 0 ? 0 : (lo_key + 63) / 64; int kthi = (q0 + 255 + dci) / 64; if (kthi > SEQ / 64 - 1) kthi = SEQ / 64 - 1;
                if (ktlo > d0) ktlo = d0; if (kthi < d0 + 3) kthi = d0 + 3;
                if (((kthi - ktlo + 1) & 1) != 0) { if (ktlo > 0) --ktlo; else ++kthi; }
                if (kthi - ktlo + 1 == 6) { if (ktlo >= 2) ktlo -= 2; else kthi += 2; }
                const int nR = kthi - (d0 + 3), nL = d0 - ktlo;
                if (nR + nL > 0) flash_pass<32, 1, false>(lds, Qm, NPROJ, Km, NPROJ, Vm, NPROJ, aug + 16 * hD, q0, d0 + 4, nR, ktlo, nR + nL, slope, O0, O1, M, L);
                if (mp == 0) { const float i1 = 1.f / xhalf_sum(L);
#pragma unroll
                    for (int i = 0; i < 16; ++i) { asave[(2 * i) * NTHREADS] = O0[i] * i1; asave[(2 * i + 1) * NTHREADS] = O1[i] * i1; } }
            }
            float lam;
            { const float* lp = p->diff_lambda + l * 128; const float a = (lane < 32) ? lp[lane] * lp[32 + lane] : 0.f, b2 = (lane < 32) ? lp[64 + lane] * lp[96 + lane] : 0.f;
              lam = expf(wave_sum(a)) - expf(wave_sum(b2)) + p->lam_init[l]; }
            const float one_m_li = 1.f - p->lam_init[l];
            const float i2 = lam / xhalf_sum(L);
            float ss = 0.f;
            f32x16 A0, A1;
#pragma unroll
            for (int i = 0; i < 16; ++i) { A0[i] = asave[(2 * i) * NTHREADS] - O0[i] * i2; A1[i] = asave[(2 * i + 1) * NTHREADS] - O1[i] * i2; ss += A0[i] * A0[i] + A1[i] * A1[i]; }
            ss = xhalf_sum(ss);
            const float rs = one_m_li / sqrtf(ss * (1.f / 64.f) + NORM_EPS);
            const float* sg = p->diff_subln + l * 64;
#pragma unroll
            for (int i = 0; i < 16; ++i) { const int dv = (i & 3) + 8 * (i >> 2) + 4 * hi; A0[i] *= rs * sg[dv]; A1[i] *= rs * sg[32 + dv]; }
            { const int t2 = tid_fresh(); store_o(mix + (tokD + q0 + (t2 >> 6) * 32 + (t2 & 31)) * DM + 768 + 64 * hD, A0, A1, (t2 >> 5) & 1); }
        } else if (type == 1) {
            M = sqrtf(row_norm2<96>(qb + (tok0 + qrow) * 384 + 96 * hd) * __builtin_bit_cast(float, ((const unsigned*)(p->ws + WS_KMAX))[l * 32 + 16 + b * 4 + hd])) * 1.01f;
            flash_pass<96, 0>(lds, qb + tok0 * 384 + 96 * hd, 384, kb + tok0 * 384 + 96 * hd, 384, vb + tok0 * 256 + 64 * hd, 256, nullptr, q0, q0 / 64, SEQ / 64 - q0 / 64, 0, SEQ / 64, 0.f, O0, O1, M, L);
            const float il = 1.f / xhalf_sum(L);
#pragma unroll
            for (int i = 0; i < 16; ++i) { O0[i] *= il; O1[i] *= il; }
            { const int t2 = tid_fresh(); store_o(mix + (tok0 + q0 + (t2 >> 6) * 32 + (t2 & 31)) * DM + 256 + 64 * hd, O0, O1, (t2 >> 5) & 1); }
        } else if (type == 2) {
            const bf16_t* base = proj + tok0 * NPROJ + PC; const int hk = hd >> 1;
            M = sqrtf(row_norm2<64>(base + (size_t)qrow * NPROJ + 64 * hd) * __builtin_bit_cast(float, ((const unsigned*)(p->ws + WS_KMAX))[l * 32 + 24 + b * 2 + hk])) * 1.01f;
            flash_pass<64, 0>(lds, base + 64 * hd, NPROJ, base + 256 + 64 * hk, NPROJ, base + 384 + 64 * hk, NPROJ, nullptr, q0, q0 / 64, SEQ / 64 - q0 / 64, 0, SEQ / 64, 0.f, O0, O1, M, L);
            const float il = 1.f / xhalf_sum(L);
#pragma unroll
            for (int i = 0; i < 16; ++i) { O0[i] *= il; O1[i] *= il; }
            { const int t2 = tid_fresh(); store_o(mix + (tok0 + q0 + (t2 >> 6) * 32 + (t2 & 31)) * DM + 512 + 64 * hd, O0, O1, (t2 >> 5) & 1); }
        } else {
            const bf16_t* base = proj + tok0 * NPROJ + PA; const int hk = hd >> 1;
            const float slope = __builtin_amdgcn_exp2f(-(float)(1 + hd));
            const int kt0 = (q0 >= 128) ? (q0 - 128) / 64 : 0; int kt1 = (q0 + 256 + 128) / 64; if (kt1 > SEQ / 64) kt1 = SEQ / 64;
            flash_pass<64, 2>(lds, base + 64 * hd, NPROJ, base + 256 + 64 * hk, NPROJ, base + 384 + 64 * hk, NPROJ, nullptr, q0, kt0, kt1 - kt0, 0, kt1 - kt0, slope, O0, O1, M, L);
            const float sink = p->win_sink[l * 4 + hd];
            const float il = 1.f / (xhalf_sum(L) + __builtin_amdgcn_exp2f((sink - M) * LOG2E));
#pragma unroll
            for (int i = 0; i < 16; ++i) { O0[i] *= il; O1[i] *= il; }
            { const int t2 = tid_fresh(); store_o(mix + (tok0 + q0 + (t2 >> 6) * 32 + (t2 & 31)) * DM + 64 * hd, O0, O1, (t2 >> 5) & 1); }
        }
    }
}
}

#define XB_TMO      128
#define XB_XCNT(j)  (256  + 64 * (j))
#define XB_XSUB(j)  (1280 + 64 * (j))
#define XB_XGEN(j)  (2304 + 64 * (j))
#define XB_TOP      3328
#define XB_TOPGEN   3392
#define XCD_BAR_WORDS 3456
#define XB_SPIN_CAP (1u << 22)

__device__ __forceinline__ unsigned xb_ld(unsigned* p)              { return __hip_atomic_load(p, __ATOMIC_RELAXED, __HIP_MEMORY_SCOPE_AGENT); }
__device__ __forceinline__ unsigned xb_add(unsigned* p, unsigned v) { return __hip_atomic_fetch_add(p, v, __ATOMIC_RELAXED, __HIP_MEMORY_SCOPE_AGENT); }
__device__ __forceinline__ unsigned xb_xcc_id() { return (unsigned)__builtin_amdgcn_s_getreg((3 << 11) | 20) & 0xFu; }
#define XB_SPIN(cond, bar) do { unsigned _sp = 0; while (cond) { __builtin_amdgcn_s_sleep(1); \
    if ((++_sp & 255u) == 0u) { if (xb_ld(&(bar)[XB_TMO])) break; if (_sp > XB_SPIN_CAP) { atomicAdd(&(bar)[XB_TMO], 1u); break; } } } } while (0)

struct XcdBarrier {
    unsigned* bar; unsigned x;
    volatile LAS unsigned* st;
};

__device__ __forceinline__ XcdBarrier xcd_barrier_post(unsigned* bar, volatile LAS unsigned* st) {
    XcdBarrier b; b.bar = bar; b.x = xb_xcc_id(); b.st = st;
    if (threadIdx.x == 0) (void)xb_add(&bar[XB_XCNT(b.x)], 1u);
    return b;
}
__device__ __forceinline__ void xcd_barrier_complete(unsigned* bar, unsigned x, unsigned& nloc, unsigned& nx) {
    const unsigned G = gridDim.x * gridDim.y * gridDim.z;
    unsigned sum, cnt, mine, sp = 0u;
    for (;;) {
        sum = 0u; cnt = 0u; mine = 0u;
#pragma unroll
        for (unsigned j = 0; j < 16; ++j) { const unsigned c = xb_ld(&bar[XB_XCNT(j)]); sum += c; cnt += (c > 0u) ? 1u : 0u; mine = (j == x) ? c : mine; }
        if (sum == G) break;
        __builtin_amdgcn_s_sleep(1);
        if ((++sp & 255u) == 0u) { if (xb_ld(&bar[XB_TMO])) break; if (sp > XB_SPIN_CAP) { atomicAdd(&bar[XB_TMO], 1u); break; } }
    }
    nloc = mine > 0u ? mine : 1u; nx = cnt > 0u ? cnt : 1u;
}

__device__ __forceinline__ void xcd_barrier(const XcdBarrier& b) {
    asm volatile("s_waitcnt vmcnt(0)" ::: "memory");
    __syncthreads();
    if (threadIdx.x == 0) {
        unsigned* bar = b.bar;
        __builtin_amdgcn_s_waitcnt(0);
        unsigned nloc = b.st[0], nx = b.st[1];
        if (nloc == 0u) { xcd_barrier_complete(bar, b.x, nloc, nx); b.st[0] = nloc; b.st[1] = nx; }
        const unsigned old = xb_add(&bar[XB_XSUB(b.x)], 1u);
        const unsigned gen = old / nloc;
        if (old + 1u == (gen + 1u) * nloc) {
            __builtin_amdgcn_fence(__ATOMIC_RELEASE, "agent");
            asm volatile("s_waitcnt vmcnt(0)" ::: "memory");
            const unsigned og = xb_add(&bar[XB_TOP], 1u);
            const unsigned tg = og / nx;
            if (og + 1u == (tg + 1u) * nx) xb_add(&bar[XB_TOPGEN], 1u);
            else XB_SPIN(xb_ld(&bar[XB_TOPGEN]) == tg, bar);
            __builtin_amdgcn_fence(__ATOMIC_ACQUIRE, "agent");
            xb_add(&bar[XB_XGEN(b.x)], 1u);
            asm volatile("s_waitcnt vmcnt(0)" ::: "memory");
        } else {
            XB_SPIN(xb_ld(&bar[XB_XGEN(b.x)]) == gen, bar);
            __builtin_amdgcn_fence(__ATOMIC_ACQUIRE, "agent");
            asm volatile("s_waitcnt vmcnt(0)" ::: "memory");
        }
    }
    __syncthreads();
}

#define GRID_SYNC_CG() do { asm volatile("s_waitcnt vmcnt(0) lgkmcnt(0)" ::: "memory"); grid.sync(); __builtin_amdgcn_fence(__ATOMIC_ACQUIRE, "agent"); } while (0)
#define XB_ST ((volatile LAS unsigned*)(lds + LDS_BYTES - 64))
#define GRID_SYNC() do { GETP(pb_); XcdBarrier xb_; xb_.bar = (unsigned*)(pb_->ws + WS_BAR); xb_.x = xb_xcc_id(); xb_.st = XB_ST; xcd_barrier(xb_); } while (0)
#ifndef PH_MASK
#define PH_MASK 255
#endif
__global__ void __launch_bounds__(NTHREADS, 2) mega_fwd(Params p_by_value) {
    extern __shared__ __attribute__((aligned(16))) unsigned char lds_raw[];
    cg::grid_group grid = cg::this_grid();
    LAS unsigned char* lds = (LAS unsigned char*)lds_raw;
#define VCU(G_, bx_) (((G_) % 8 == 0) ? ((bx_) % 8) * ((G_) / 8) + (bx_) / 8 : (bx_))
    const float alpha = 1.681792830507429f;
#define STATS(s_) ((float*)(p->ws + WS_STATS) + (size_t)(s_) * T * 2)
#define C1(l_, off_) ((const float*)(p->ws + WS_C12) + (l_) * C12_L + (off_))
#define C2(l_, off_) ((const float*)(p->ws + WS_C12) + C2_OFF + (l_) * C12_L + (off_))

    if (threadIdx.x < 16) ((LAS unsigned*)(lds + LDS_BYTES - 64))[threadIdx.x] = 0u;
    __syncthreads();
    { GETP(p); (void)xcd_barrier_post((unsigned*)(p->ws + WS_BAR), XB_ST); }
    if (PH_MASK & 1) { GETP(p); const int G = gridDim.x, bx = blockIdx.x; phase0(p, lds, VCU(G, bx), G); }
    GRID_SYNC_CG();
#pragma unroll 1
    for (int li = 0; li < DEPTH; ++li) {
#pragma unroll 1
        for (int fi = 0; fi < 2; ++fi) {
            if (fi == 1) {
                if (PH_MASK & 2) { GETP(p); int l = li; asm volatile("" : "+s"(l)); const int G = gridDim.x, bx = blockIdx.x;
                  pg8::Gemm g{(const bf16_t*)(p->ws + WS_XB), (const bf16_t*)(p->ws + WS_WIN) + l * WIN_L, T, NPROJ, DM}; pg8::StaticOrder S; S.init(T, NPROJ, G, bx);
                  pg8::EpiStoreBf16LN E{(bf16_t*)(p->ws + WS_PROJ), NPROJ, STATS(3 * l), C1(l, 2 * NGU), C2(l, 2 * NGU)};
                  pg8::gemm_phase<pg8::EpiStoreBf16LN, pg8::StaticOrder, true, true>(lds, g, S, E); }
                GRID_SYNC();
                if (PH_MASK & 4) { GETP(p); int l = li; asm volatile("" : "+s"(l)); const int G = gridDim.x, bx = blockIdx.x; prep_phase(p, l, VCU(G, bx), G); }
                GRID_SYNC();
                if (PH_MASK & 8) { GETP(p); int l = li; asm volatile("" : "+s"(l)); const int G = gridDim.x, bx = blockIdx.x; att::attn_phase(p, l, (LAS char*)lds, VCU(G, bx), G); }
                GRID_SYNC();
                if (PH_MASK & 16) { GETP(p); int l = li; asm volatile("" : "+s"(l)); const int G = gridDim.x, bx = blockIdx.x;
                  pg8::Gemm g{(const bf16_t*)(p->ws + WS_MIX), (const bf16_t*)(p->ws + WS_WOUT) + l * WOUT_L, T, DM, DM}; pg8::StaticOrder S; S.init(T, DM, G, bx);
                  pg8::EpiResidLN<true> E{nullptr, p->out, p->ws, p->ln_g + (3 * l) * DM, p->ln_b + (3 * l) * DM, 3 * l, alpha, 1.0f};
                  pg8::gemm_phase<pg8::EpiResidLN<true>, pg8::StaticOrder, true, true>(lds, g, S, E); }
                GRID_SYNC();
            }
            if (PH_MASK & 64) { GETP(p); int l = li, f = fi; asm volatile("" : "+s"(l), "+s"(f)); const int G = gridDim.x, bx = blockIdx.x;
              const int s = 3 * l + 2 * f - 1;
              pg8::Gemm g{(const bf16_t*)(p->ws + WS_XB), (const bf16_t*)(p->ws + WS_WGU) + l * WGU_L + f * WGU_F, T, NGU, DM}; pg8::StaticOrder S; S.init(T, NGU, G, bx);
              if (s >= 0) { pg8::EpiSwiGLULN<true> E{(bf16_t*)(p->ws + WS_H), DFF, STATS(s), C1(l, f * NGU), C2(l, f * NGU)};
                            pg8::gemm_phase<pg8::EpiSwiGLULN<true>, pg8::StaticOrder, true, true>(lds, g, S, E); }
              else { pg8::EpiSwiGLULN<false> E{(bf16_t*)(p->ws + WS_H), DFF, nullptr, C1(l, f * NGU), C2(l, f * NGU)};
                     pg8::gemm_phase<pg8::EpiSwiGLULN<false>, pg8::StaticOrder, true, true>(lds, g, S, E); } }
            GRID_SYNC();
            if (PH_MASK & 128) { GETP(p); int l = li, f = fi; asm volatile("" : "+s"(l), "+s"(f)); const int G = gridDim.x, bx = blockIdx.x;
              const int s = 3 * l + 2 * f - 1;
              pg8::Gemm g{(const bf16_t*)(p->ws + WS_H), (const bf16_t*)(p->ws + WS_WD) + l * WD_L + f * WD_F, T, DM, DFF}; pg8::StaticOrder S; S.init(T, DM, G, bx);
              if (s >= 0) { pg8::EpiResidLN<true> E{nullptr, p->out, p->ws, p->ln_g + s * DM, p->ln_b + s * DM, s, alpha, 0.5f};
                            pg8::gemm_phase<pg8::EpiResidLN<true>, pg8::StaticOrder, true, true>(lds, g, S, E); }
              else { pg8::EpiResidLN<false> E{p->x, p->out, p->ws, nullptr, nullptr, -1, alpha, 0.5f};
                     pg8::gemm_phase<pg8::EpiResidLN<false>, pg8::StaticOrder, true, true>(lds, g, S, E); } }
            GRID_SYNC();
        }
    }
    if (PH_MASK & 32) { GETP(p); const int G = gridDim.x, bx = blockIdx.x;
      ln_phase<false>(p->out, (bf16_t*)(p->ws + WS_XB), p->ln_g + (3 * DEPTH - 1) * DM, p->ln_b + (3 * DEPTH - 1) * DM, VCU(G, bx), G); }
}

extern "C" void kernel_launch(void* const* d_in, const int* in_sizes, int n_in, void* d_out, int out_size, void* d_ws, size_t ws_size, hipStream_t stream) {
    static int grid = 0;
    if (grid == 0) {
        if (n_in != 16 || in_sizes[0] != T * DM || out_size != T * DM || ws_size < WS_END) { fprintf(stderr, "kernel_launch: unexpected shapes (n_in %d, in0 %d, out %d, ws %zu); nothing launched\n", n_in, n_in > 0 ? in_sizes[0] : -1, out_size, ws_size); grid = -1; return; }
        int dev = 0, cus = 0, per_cu = 0;
        hipGetDevice(&dev); hipDeviceGetAttribute(&cus, hipDeviceAttributeMultiprocessorCount, dev);
        if (hipFuncSetAttribute((const void*)mega_fwd, hipFuncAttributeMaxDynamicSharedMemorySize, LDS_BYTES) != hipSuccess) { fprintf(stderr, "kernel_launch: hipFuncSetAttribute failed\n"); grid = -1; return; }
        if (hipOccupancyMaxActiveBlocksPerMultiprocessor(&per_cu, (const void*)mega_fwd, NTHREADS, LDS_BYTES) != hipSuccess || per_cu < 1) { fprintf(stderr, "kernel_launch: occupancy query gave %d\n", per_cu); per_cu = 1; }
        (void)hipGetLastError();
        grid = cus * 1;
    }
    if (grid < 0) return;
    Params p{};
    p.x = (const float*)d_in[0]; p.w_in = (const float*)d_in[1]; p.win_sink = (const float*)d_in[2]; p.mla_q_norm = (const float*)d_in[3]; p.mla_w_uq = (const float*)d_in[4];
    p.mla_kv_norm = (const float*)d_in[5]; p.mla_w_ukv = (const float*)d_in[6]; p.ax_q_norm = (const float*)d_in[7]; p.ax_k_norm = (const float*)d_in[8]; p.diff_lambda = (const float*)d_in[9];
    p.diff_subln = (const float*)d_in[10]; p.w_out = (const float*)d_in[11]; p.ffn_w_gu = (const float*)d_in[12]; p.ffn_w_down = (const float*)d_in[13]; p.ln_g = (const float*)d_in[14]; p.ln_b = (const float*)d_in[15];
    p.out = (float*)d_out; p.ws = (unsigned char*)d_ws;
    for (int l = 0; l < 4; ++l) p.lam_init[l] = (float)(0.8 - 0.6 * exp(-0.3 * (double)l));
    for (int i = 0; i < 16; ++i) p.inv32[i] = (float)pow(10000.0, -(double)i / 16.0);
    if (hipMemsetAsync((char*)d_ws + WS_CTL, 0, CTL_BYTES, stream) != hipSuccess) { fprintf(stderr, "kernel_launch: hipMemsetAsync of the control region failed\n"); return; }
    void* args[] = {&p};
    hipError_t e = hipLaunchCooperativeKernel((const void*)mega_fwd, dim3(grid), dim3(NTHREADS), args, LDS_BYTES, stream);
    if (e != hipSuccess) fprintf(stderr, "kernel_launch: cooperative launch failed: %s (grid %d)\n", hipGetErrorString(e), grid);
}
```
